# Optimizing an MI355X kernel written in HIP

```python
import math
import jax, jax.numpy as jnp
from jax import lax
import numpy as np

D_MODEL = 2048
BATCH = 16
SEQ = 256
DEPTH = 4
DEC_BATCH = 4
DEC_SEQ = 4096
PAST_LEN = 256

GRID_W = 64
D_MIX = D_MODEL
D_A = D_MIX // 2
HEAD_A = 64
N_HEADS_A = D_A // HEAD_A
D_B = D_MIX - D_A
N_GROUPS_B = 8
HEAD_B = D_B // N_GROUPS_B
CHUNK = 128
DECAY_LORA = 64
A_LORA = 64
GATE_LORA = 160
C_SHIFT = 3 * D_A + DECAY_LORA + A_LORA + GATE_LORA
P_IN = C_SHIFT + 2 * D_B
D_FF = -(-8 * D_MODEL // (3 * 256)) * 256
RMS_EPS = 1e-6
GN_EPS = HEAD_A * 1e-5
LN_EPS = 1e-5
F32 = jnp.float32

kernel_name = 'hymba_rwkv7_gmlp_flow_step'


def _rmsnorm(x, g):
    xf = x.astype(F32)
    y = xf * lax.rsqrt(jnp.mean(xf * xf, axis=-1, keepdims=True) + RMS_EPS)
    return (y * g).astype(x.dtype)


def _shift_context(p, mu):
    prev = jnp.pad(p[:, :-1], ((0, 0), (1, 0), (0, 0)))
    nxt = jnp.pad(p[:, 1:], ((0, 0), (0, 1), (0, 0)))
    return p + mu[0] * (prev - p) + mu[1] * (nxt - p)


def _shift_grid(p, mu):
    B, T, C = p.shape
    rows = T // GRID_W
    g = p.reshape(B, rows, GRID_W, C)
    left = jnp.pad(g[:, :, :-1], ((0, 0), (0, 0), (1, 0), (0, 0)))
    right = jnp.pad(g[:, :, 1:], ((0, 0), (0, 0), (0, 1), (0, 0)))
    up = jnp.pad(g[:, :-1], ((0, 0), (1, 0), (0, 0), (0, 0)))
    down = jnp.pad(g[:, 1:], ((0, 0), (0, 1), (0, 0), (0, 0)))
    out = g + mu[0] * (left - g) + mu[1] * (right - g) + mu[2] * (up - g) + mu[3] * (down - g)
    return out.reshape(B, T, C)


def _delta_scan(r, w, k, v, aa, bb, s0, reverse):
    xs = tuple(jnp.moveaxis(t, 1, 0) for t in (r, w, k, v, aa, bb))

    def step(S, inp):
        r_t, w_t, k_t, v_t, a_t, b_t = inp
        sa = jnp.einsum('bhvk,bhk->bhv', S, a_t)
        S = S * w_t[:, :, None, :] + sa[..., None] * b_t[:, :, None, :] + v_t[..., None] * k_t[:, :, None, :]
        return S, jnp.einsum('bhvk,bhk->bhv', S, r_t)

    s_fin, ys = lax.scan(step, s0, xs, reverse=reverse)
    return jnp.moveaxis(ys, 0, 1), s_fin


def _group_norm(y, w, b):
    mean = jnp.mean(y, axis=-1, keepdims=True)
    yc = y - mean
    var = jnp.mean(yc * yc, axis=-1, keepdims=True)
    return yc * lax.rsqrt(var + GN_EPS) * w + b


def _rwkv7_bidir(p, s0, lp):
    dtype = p.dtype
    p = p.astype(F32)
    B, T, _ = p.shape
    r, k, v, wd, ad, gd = jnp.split(
        p, [D_A, 2 * D_A, 3 * D_A, 3 * D_A + DECAY_LORA, 3 * D_A + DECAY_LORA + A_LORA], axis=-1)
    heads = lambda t: t.reshape(B, T, N_HEADS_A, HEAD_A)
    kk = heads(k * lp['k_k'])
    kk = kk * lax.rsqrt(jnp.maximum(jnp.sum(kk * kk, axis=-1, keepdims=True), 1e-24))
    gate = jax.nn.sigmoid(gd) @ lp['g2']
    rh, vh = heads(r), heads(v)
    wt = jnp.tanh(wd)
    out = jnp.zeros((B, T, N_HEADS_A, HEAD_A), F32)
    finals = []
    for d in range(2):
        w_log = -jax.nn.softplus(-(lp['w0'][d] + wt @ lp['w2'][d])) - 0.5
        decay = heads(jnp.exp(-jnp.exp(w_log)))
        a = jax.nn.sigmoid(lp['a0'][d] + ad @ lp['a2'][d])
        kd = heads(k * (1.0 + (a - 1.0) * lp['k_a']))
        y, s_fin = _delta_scan(rh, decay, kd, vh, -kk, kk * heads(a),
                               s0[:, d].astype(F32), reverse=(d == 1))
        out = out + _group_norm(y, lp['gn_w'], lp['gn_b']) \
            + jnp.sum(rh * kd * lp['r_k'], axis=-1, keepdims=True) * vh
        finals.append(s_fin)
    o = (out.reshape(B, T, D_A) * gate).astype(dtype)
    return o, jnp.stack(finals, axis=1)


def _chunk_gmlp(p, lp):
    dtype = p.dtype
    B, T, _ = p.shape
    u, v = jnp.split(p, 2, axis=-1)
    v = v.astype(F32).reshape(B, T // CHUNK, CHUNK, N_GROUPS_B, HEAD_B)
    mean = jnp.mean(v, axis=-1, keepdims=True)
    vc = v - mean
    v = vc * lax.rsqrt(jnp.mean(vc * vc, axis=-1, keepdims=True) + LN_EPS) * lp['gmlp_ln_g'] + lp['gmlp_ln_b']
    s = jnp.einsum('gij,bnjgd->bnigd', lp['w_spatial'], v) + lp['b_spatial'].T[:, :, None]
    return (u * s.reshape(B, T, D_B)).astype(dtype)


def _layer(x, mod, s0, shift_fn, lp):
    sh1, sc1, g1, sh2, sc2, g2 = jnp.split(mod, 6, axis=-1)
    h = _rmsnorm(x, lp['norm1_g']) * (1.0 + sc1) + sh1
    p = h @ lp['w_in']
    o_a, s_fin = _rwkv7_bidir(shift_fn(p[..., :C_SHIFT], lp['mu_shift']), s0, lp)
    o_b = _chunk_gmlp(jax.nn.gelu(p[..., C_SHIFT:]), lp)
    x = x + g1 * (jnp.concatenate([o_a, o_b], axis=-1) @ lp['w_out'])
    h = _rmsnorm(x, lp['norm2_g']) * (1.0 + sc2) + sh2
    ff = (jax.nn.silu(h @ lp['w_ffn_gate']) * (h @ lp['w_ffn_up'])) @ lp['w_ffn_down']
    return x + g2 * ff, s_fin


def setup_inputs(seed: int = 0) -> dict:
    key = jax.random.key(seed)
    ks = jax.random.split(key, 32)
    nrm = lambda k, shape, s: jax.random.normal(k, shape, F32) * s
    L = DEPTH
    return {
        'x_prompt': nrm(ks[0], (BATCH, SEQ, D_MODEL), 1.0),
        'x_sample': nrm(ks[1], (DEC_BATCH, DEC_SEQ, D_MODEL), 1.0),
        'state_rwkv': nrm(ks[2], (DEC_BATCH, DEPTH, 2, N_HEADS_A, HEAD_A, HEAD_A), 1.0),
        'c': nrm(ks[3], (DEC_BATCH, D_MODEL), 1.0),
        'c_ctx': nrm(ks[4], (D_MODEL,), 1.0),
        'w_mod': nrm(ks[5], (L, D_MODEL, 6 * D_MODEL), 0.5 * D_MODEL ** -0.5),
        'b_mod': nrm(ks[6], (L, 6 * D_MODEL), 0.02),
        'norm1_g': 1.0 + nrm(ks[7], (L, D_MODEL), 0.05),
        'w_in': nrm(ks[8], (L, D_MODEL, P_IN), D_MODEL ** -0.5),
        'mu_shift': jax.random.uniform(ks[9], (L, 4, C_SHIFT), F32, 0.0, 0.5),
        'w0': jax.random.uniform(ks[10], (L, 2, D_A), F32, -4.0, 1.0),
        'w2': nrm(ks[11], (L, 2, DECAY_LORA, D_A), 0.5 * DECAY_LORA ** -0.5),
        'a0': nrm(ks[12], (L, 2, D_A), 0.5),
        'a2': nrm(ks[13], (L, 2, A_LORA, D_A), 0.5 * A_LORA ** -0.5),
        'g2': nrm(ks[14], (L, GATE_LORA, D_A), GATE_LORA ** -0.5),
        'k_k': 0.85 + nrm(ks[15], (L, D_A), 0.05),
        'k_a': 1.0 + nrm(ks[16], (L, D_A), 0.05),
        'r_k': nrm(ks[17], (L, N_HEADS_A, HEAD_A), 0.1),
        'gn_w': 1.0 + nrm(ks[18], (L, N_HEADS_A, HEAD_A), 0.05),
        'gn_b': nrm(ks[19], (L, N_HEADS_A, HEAD_A), 0.02),
        'gmlp_ln_g': 1.0 + nrm(ks[20], (L, N_GROUPS_B, HEAD_B), 0.05),
        'gmlp_ln_b': nrm(ks[21], (L, N_GROUPS_B, HEAD_B), 0.02),
        'w_spatial': nrm(ks[22], (L, N_GROUPS_B, CHUNK, CHUNK), CHUNK ** -0.5),
        'b_spatial': 1.0 + nrm(ks[23], (L, N_GROUPS_B, CHUNK), 0.05),
        'w_out': nrm(ks[24], (L, D_MIX, D_MODEL), D_MIX ** -0.5),
        'norm2_g': 1.0 + nrm(ks[25], (L, D_MODEL), 0.05),
        'w_ffn_gate': nrm(ks[26], (L, D_MODEL, D_FF), D_MODEL ** -0.5),
        'w_ffn_up': nrm(ks[27], (L, D_MODEL, D_FF), D_MODEL ** -0.5),
        'w_ffn_down': nrm(ks[28], (L, D_FF, D_MODEL), D_FF ** -0.5),
        'final_norm_g': 1.0 + nrm(ks[29], (D_MODEL,), 0.05),
    }


def reference(x_prompt, x_sample, state_rwkv, c, c_ctx, w_mod, b_mod, norm1_g, w_in, mu_shift,
              w0, w2, a0, a2, g2, k_k, k_a, r_k, gn_w, gn_b, gmlp_ln_g, gmlp_ln_b, w_spatial,
              b_spatial, w_out, norm2_g, w_ffn_gate, w_ffn_up, w_ffn_down, final_norm_g):
    x_ctx = x_prompt
    x_lat = x_sample
    s0_ctx = jnp.zeros((x_prompt.shape[0], 2, N_HEADS_A, HEAD_A, HEAD_A), F32)
    ctx_states = []
    for l in range(DEPTH):
        lp = {
            'norm1_g': norm1_g[l], 'w_in': w_in[l], 'mu_shift': mu_shift[l],
            'w0': w0[l], 'w2': w2[l], 'a0': a0[l], 'a2': a2[l], 'g2': g2[l],
            'k_k': k_k[l], 'k_a': k_a[l], 'r_k': r_k[l], 'gn_w': gn_w[l], 'gn_b': gn_b[l],
            'gmlp_ln_g': gmlp_ln_g[l], 'gmlp_ln_b': gmlp_ln_b[l],
            'w_spatial': w_spatial[l], 'b_spatial': b_spatial[l], 'w_out': w_out[l],
            'norm2_g': norm2_g[l], 'w_ffn_gate': w_ffn_gate[l], 'w_ffn_up': w_ffn_up[l],
            'w_ffn_down': w_ffn_down[l],
        }
        mod_ctx = (jax.nn.silu(c_ctx) @ w_mod[l] + b_mod[l])[None, None, :]
        mod_lat = (jax.nn.silu(c) @ w_mod[l] + b_mod[l])[:, None, :]
        x_ctx, s_ctx = _layer(x_ctx, mod_ctx, s0_ctx, _shift_context, lp)
        ctx_states.append(s_ctx)
        x_lat, _ = _layer(x_lat, mod_lat, state_rwkv[:, l], _shift_grid, lp)
    new_state_rwkv = jnp.stack(ctx_states, axis=1).astype(x_prompt.dtype)
    y_prompt = _rmsnorm(x_ctx, final_norm_g)
    y_sample = _rmsnorm(x_lat, final_norm_g)
    return (y_prompt, y_sample, new_state_rwkv)
```

```cpp
#include <hip/hip_runtime.h>
#include <cstdio>
#include <cstdint>

#ifndef MK_N_LAUNCHES
#define MK_N_LAUNCHES 0
#endif

namespace pg8 {
#define PG8_LAS __attribute__((address_space(3)))
typedef unsigned short bf16_t;
typedef short bf16x8 __attribute__((ext_vector_type(8)));
typedef float f32x4 __attribute__((ext_vector_type(4)));
typedef unsigned u32x4 __attribute__((ext_vector_type(4)));
constexpr int BM = 256, BK = 64, HALF = 128, HTB = HALF * BK * 2  , STAGE_BYTES = 8 * HTB, NXCD = 8, WGM = 8;

__host__ __device__ __forceinline__ int lds_byte(int r, int c) { const int st = (r >> 4) * 2 + (c >> 5), rr = r & 15, cc = c & 31, ob = rr * 64 + cc * 2; return st * 1024 + (ob ^ (((ob >> 9) & 1) << 5)); }
__host__ __device__ __forceinline__ void stage_rc(int b, int& R, int& C) { const int st = b / 1024, sb = b % 1024, swz = sb ^ (((sb >> 9) & 1) << 5); R = (st >> 1) * 16 + swz / 64; C = (st & 1) * 32 + (swz % 64) / 2; }
__host__ __device__ __forceinline__ int perm32(int rho) { const int n = rho >> 4, i = rho & 15; return 8 * (i >> 2) + 4 * n + (i & 3); }

struct Unit { int pm, pn; };
struct Gemm { const bf16_t* A; const bf16_t* Bt; int M, N, K; };

struct StaticOrder {
    int nM, nN, nwg, G, c;
    __host__ __device__ void init(int M, int N, int G_, int c_) { nM = M / BM; nN = N / BM; nwg = nM * nN; G = G_; c = c_; }
    __host__ __device__ bool next(int i, Unit& u) const {
        const long L = (long)i * G + c; if (L >= nwg) return false;
        int wgid = (int)L; { const int q = nwg / NXCD, r = nwg % NXCD, xcd = wgid % NXCD, off = wgid / NXCD; wgid = (xcd < r ? xcd * (q + 1) : r * (q + 1) + (xcd - r) * q) + off; }
        const int nig = WGM * nN, gid = wgid / nig, fm = gid * WGM, gsz = (nM - fm) < WGM ? (nM - fm) : WGM;
        u.pm = fm + ((wgid % nig) % gsz); u.pn = (wgid % nig) / gsz; return true;
    }
    __device__ __forceinline__ void a_ready(const Unit&) const {}
    __device__ __forceinline__ void done(const Unit&) const {}
};

__device__ __forceinline__ unsigned cvt_pk_bf16(float lo, float hi) { unsigned r; asm volatile("v_cvt_pk_bf16_f32 %0, %1, %2" : "=v"(r) : "v"(lo), "v"(hi)); return r; }

template <class Epi, class Sched, bool ALIGN_EPI = false, bool SP2 = false>
__device__ __forceinline__ void gemm_phase(PG8_LAS unsigned char* lds, const Gemm g, const Sched& S, const Epi& E) {
    int tid = threadIdx.x; asm volatile("" : "+v"(tid));
    const int wid = __builtin_amdgcn_readfirstlane(tid >> 6), lane = tid & 63, wr = wid >> 2, wc = wid & 3, fr = lane & 15, fq = lane >> 4;
    const int K = g.K, nt = K / BK;
    unsigned voffA[2], voffB[2];
#pragma unroll
    for (int i = 0; i < 2; ++i) { int R, C; stage_rc(tid * 16 + i * 8192, R, C); const int Rb = Epi::PERM ? ((R & ~31) + perm32(R & 31)) : R;
        voffA[i] = (unsigned)(R * K + C) * 2u; voffB[i] = (unsigned)(Rb * K + C) * 2u; }
    const size_t kstep = (size_t)(BK * 2);
    const size_t hstep = (size_t)HALF * K * 2;
    const size_t tstep = 2 * hstep;
    const unsigned ldsw = (unsigned)wid * 1024u;
    const int aoff = lds_byte(wr * 64 + fr, fq * 8), boff = lds_byte(wc * 32 + fr, fq * 8);
#define PG8_SA(b, h) (((b) * 2 + (h)) * HTB)
#define PG8_SB(b, h) ((4 + (b) * 2 + (h)) * HTB)
#define PG8_STAGE(bufoff, gbase, voff) do { _Pragma("unroll") for (int _i = 0; _i < 2; ++_i) \
        __builtin_amdgcn_global_load_lds((const unsigned*)((const char*)(gbase) + (voff)[_i]), (PG8_LAS unsigned*)(lds + (bufoff) + ldsw + _i * 8192), 16, 0, 0); } while (0)
#define PG8_LDA(dst, b, h) do { _Pragma("unroll") for (int m = 0; m < 4; ++m) _Pragma("unroll") for (int k = 0; k < 2; ++k) dst[m][k] = *(const PG8_LAS bf16x8*)(lds + PG8_SA(b, h) + aoff + m * 2048 + k * 1024); } while (0)
#define PG8_LDB(dst, b, h) do { _Pragma("unroll") for (int n = 0; n < 2; ++n) _Pragma("unroll") for (int k = 0; k < 2; ++k) dst[n][k] = *(const PG8_LAS bf16x8*)(lds + PG8_SB(b, h) + boff + n * 2048 + k * 1024); } while (0)
#define PG8_MMA(ai, bj, At, Bt) do { __builtin_amdgcn_s_setprio(1); _Pragma("unroll") for (int m = 0; m < 4; ++m) _Pragma("unroll") for (int n = 0; n < 2; ++n) _Pragma("unroll") for (int k = 0; k < 2; ++k) \
        acc[ai][bj][m][n] = __builtin_amdgcn_mfma_f32_16x16x32_bf16(Bt[n][k], At[m][k], acc[ai][bj][m][n], 0, 0, 0); __builtin_amdgcn_s_setprio(0); } while (0)
#define PG8_WAIT_V(n) asm volatile("s_waitcnt vmcnt(" #n ")" ::: "memory")
#define PG8_WAIT_L(n) asm volatile("s_waitcnt lgkmcnt(" #n ")" ::: "memory")
#define PG8_BAR __builtin_amdgcn_s_barrier()
#define PG8_SCHED __builtin_amdgcn_sched_barrier(0)
    Unit cur, nxt; int ui = 0;
    if (!S.next(0, cur)) return;
    f32x4 acc[2][2][4][2];
#pragma unroll
    for (int a = 0; a < 2; ++a)
#pragma unroll
        for (int b = 0; b < 2; ++b)
#pragma unroll
            for (int m = 0; m < 4; ++m)
#pragma unroll
                for (int n = 0; n < 2; ++n) acc[a][b][m][n] = (f32x4){0.f, 0.f, 0.f, 0.f};
    bf16x8 At[4][2], B0[2][2], B1[2][2];
    const char* cA = (const char*)g.A + (size_t)cur.pm * tstep; const char* cB = (const char*)g.Bt + (size_t)cur.pn * tstep;
    S.a_ready(cur);
    if constexpr (SP2) {
        PG8_STAGE(PG8_SB(0, 0), cB, voffB); PG8_STAGE(PG8_SB(0, 1), cB + hstep, voffB); PG8_STAGE(PG8_SA(0, 0), cA, voffA); PG8_STAGE(PG8_SA(0, 1), cA + hstep, voffA);
        if (wr == 1) PG8_BAR;
        PG8_WAIT_V(2); PG8_BAR;
        PG8_STAGE(PG8_SB(1, 0), cB + kstep, voffB); PG8_STAGE(PG8_SA(1, 0), cA + kstep, voffA); PG8_STAGE(PG8_SB(1, 1), cB + hstep + kstep, voffB);
        PG8_WAIT_V(6); PG8_BAR;
    } else {
        PG8_STAGE(PG8_SB(0, 0), cB, voffB); PG8_STAGE(PG8_SA(0, 0), cA, voffA); PG8_STAGE(PG8_SB(0, 1), cB + hstep, voffB); PG8_STAGE(PG8_SA(0, 1), cA + hstep, voffA);
        if (wr == 1) PG8_BAR;
        PG8_WAIT_V(4); PG8_BAR;
        PG8_STAGE(PG8_SB(1, 0), cB + kstep, voffB); PG8_STAGE(PG8_SA(1, 0), cA + kstep, voffA); PG8_STAGE(PG8_SB(1, 1), cB + hstep + kstep, voffB);
        PG8_WAIT_V(6); PG8_BAR;
    }
    for (;;) {
        const bool has_next = S.next(ui + 1, nxt);
        const char* nA = has_next ? (const char*)g.A + (size_t)nxt.pm * tstep : cA; const char* nB = has_next ? (const char*)g.Bt + (size_t)nxt.pn * tstep : cB;
        for (int t = 0; t < nt; t += 2) {
            const bool last = (t == nt - 2);
            const char* a1 = cA + (size_t)(t + 1) * kstep;
            const char* a2 = last ? nA : cA + (size_t)(t + 2) * kstep; const char* b2 = last ? nB : cB + (size_t)(t + 2) * kstep;
            const char* a3 = a2 + kstep; const char* b3 = b2 + kstep;
            if (last && has_next) S.a_ready(nxt);
            if constexpr (SP2) {
            PG8_LDB(B0, 0, 0); PG8_LDB(B1, 0, 1); PG8_SCHED; PG8_LDA(At, 0, 0); PG8_STAGE(PG8_SA(1, 1), a1 + hstep, voffA);
            PG8_WAIT_V(8); PG8_WAIT_L(0); PG8_BAR; PG8_MMA(0, 0, At, B0); PG8_MMA(0, 1, At, B1); PG8_BAR; PG8_SCHED;
            PG8_LDA(At, 0, 1); PG8_STAGE(PG8_SB(0, 0), b2, voffB); PG8_STAGE(PG8_SB(0, 1), b2 + hstep, voffB); PG8_STAGE(PG8_SA(0, 0), a2, voffA);
            PG8_WAIT_V(8); PG8_WAIT_L(0); PG8_BAR; PG8_MMA(1, 0, At, B0); PG8_MMA(1, 1, At, B1); PG8_BAR; PG8_SCHED;
            PG8_LDB(B0, 1, 0); PG8_LDB(B1, 1, 1); PG8_SCHED; PG8_LDA(At, 1, 0); PG8_STAGE(PG8_SA(0, 1), a2 + hstep, voffA);
            PG8_WAIT_V(8); PG8_WAIT_L(0); PG8_BAR; PG8_MMA(0, 0, At, B0); PG8_MMA(0, 1, At, B1); PG8_BAR; PG8_SCHED;
            PG8_LDA(At, 1, 1); PG8_STAGE(PG8_SB(1, 0), b3, voffB); PG8_STAGE(PG8_SB(1, 1), b3 + hstep, voffB); PG8_STAGE(PG8_SA(1, 0), a3, voffA);
            PG8_WAIT_V(8); PG8_WAIT_L(0); PG8_BAR; PG8_MMA(1, 0, At, B0); PG8_MMA(1, 1, At, B1); PG8_BAR; PG8_SCHED;
            } else {
            PG8_LDB(B0, 0, 0); PG8_SCHED; PG8_LDA(At, 0, 0); PG8_STAGE(PG8_SA(1, 1), a1 + hstep, voffA);
            PG8_WAIT_L(8); PG8_BAR; PG8_WAIT_L(0); PG8_MMA(0, 0, At, B0); PG8_BAR; PG8_SCHED;
            PG8_LDB(B1, 0, 1); PG8_STAGE(PG8_SB(0, 0), b2, voffB);
            PG8_BAR; PG8_WAIT_L(0); PG8_MMA(0, 1, At, B1); PG8_BAR;
            PG8_LDA(At, 0, 1); PG8_STAGE(PG8_SA(0, 0), a2, voffA);
            PG8_BAR; PG8_WAIT_L(0); PG8_MMA(1, 0, At, B0); PG8_BAR; PG8_SCHED;
            PG8_STAGE(PG8_SB(0, 1), b2 + hstep, voffB);
            PG8_WAIT_V(6); PG8_BAR; PG8_MMA(1, 1, At, B1); PG8_BAR;
            PG8_LDB(B0, 1, 0); PG8_SCHED; PG8_LDA(At, 1, 0); PG8_STAGE(PG8_SA(0, 1), a2 + hstep, voffA);
            PG8_WAIT_L(8); PG8_BAR; PG8_WAIT_L(0); PG8_MMA(0, 0, At, B0); PG8_BAR; PG8_SCHED;
            PG8_LDB(B1, 1, 1); PG8_STAGE(PG8_SB(1, 0), b3, voffB);
            PG8_BAR; PG8_WAIT_L(0); PG8_MMA(0, 1, At, B1); PG8_BAR;
            PG8_LDA(At, 1, 1); PG8_STAGE(PG8_SA(1, 0), a3, voffA);
            PG8_BAR; PG8_WAIT_L(0); PG8_MMA(1, 0, At, B0); PG8_BAR; PG8_SCHED;
            PG8_STAGE(PG8_SB(1, 1), b3 + hstep, voffB);
            PG8_WAIT_V(6); PG8_BAR; PG8_MMA(1, 1, At, B1); PG8_BAR;
            }
        }
        if constexpr (ALIGN_EPI) { if (wr == 0) PG8_BAR; }
        E(acc, cur, wr, wc, fr, fq); S.done(cur);
        if (!has_next) break;
#pragma unroll
        for (int a = 0; a < 2; ++a)
#pragma unroll
            for (int b = 0; b < 2; ++b)
#pragma unroll
                for (int m = 0; m < 4; ++m)
#pragma unroll
                    for (int n = 0; n < 2; ++n) acc[a][b][m][n] = (f32x4){0.f, 0.f, 0.f, 0.f};
        cur = nxt; cA = nA; cB = nB; ++ui;
        if constexpr (ALIGN_EPI) { if (wr == 1) PG8_BAR; }
    }
    PG8_WAIT_V(0);
    if constexpr (!ALIGN_EPI) { if (wr == 0) PG8_BAR; }
    PG8_BAR;
#undef PG8_SA
#undef PG8_SB
#undef PG8_STAGE
#undef PG8_LDA
#undef PG8_LDB
#undef PG8_MMA
#undef PG8_WAIT_V
#undef PG8_WAIT_L
#undef PG8_BAR
#undef PG8_SCHED
}
}

constexpr int NWAVES = 8;
constexpr int D = 2048, MCTX = 4096, MLAT = 16384, M = MCTX + MLAT, NL = 4;
constexpr int DA = 1024, NH = 16, DB = 1024, NG = 8, HB = 128;
constexpr int LW = 64, LAA = 64, LGT = 160;
constexpr int CSH = 3 * DA + LW + LAA + LGT;
constexpr int PIN = CSH + 2 * DB;
constexpr int PINP = 5632;
constexpr int DFF = 5632, NGU = 2 * DFF;
constexpr int MODW = 6 * D;
constexpr float RMS_EPS = 1e-6f, GN_EPS = 64.0f * 1e-5f, LN_EPS = 1e-5f;

constexpr size_t MiB = 1u << 20;
constexpr size_t WS_CTL = 0, CTL_ZERO_BYTES = 1 * MiB;
constexpr size_t WS_MOD = 1 * MiB;
constexpr size_t WS_W2T = 2 * MiB;
constexpr size_t WS_A2T = 3 * MiB;
constexpr size_t WS_G2T = 4 * MiB;
constexpr size_t WS_WSP = 6 * MiB;
constexpr size_t WS_BONUS = 7 * MiB;
constexpr size_t SZ_WIN = (size_t)PINP * D * 2, SZ_WOUT = (size_t)D * D * 2, SZ_WGU = (size_t)NGU * D * 2, SZ_WD = (size_t)D * DFF * 2;
constexpr size_t WS_WIN = 16 * MiB;
constexpr size_t WS_WOUT = WS_WIN + NL * SZ_WIN;
constexpr size_t WS_WGU = WS_WOUT + NL * SZ_WOUT;
constexpr size_t WS_WD = WS_WGU + NL * SZ_WGU;
constexpr size_t WS_H = WS_WD + NL * SZ_WD;
constexpr size_t WS_O = WS_H + (size_t)M * D * 2;
constexpr size_t WS_P = WS_O + (size_t)M * D * 2;
constexpr size_t WS_Y = WS_P;
constexpr size_t WS_PS = WS_P + (size_t)M * PINP * 2;
constexpr size_t SZ_T16 = (size_t)M * DA * 2, SZ_T32 = (size_t)M * DA * 4;
constexpr size_t WS_KK = WS_PS + (size_t)M * CSH * 2;
constexpr size_t WS_KD = WS_KK + SZ_T16;
constexpr size_t WS_BB = WS_KD + 2 * SZ_T16;
constexpr size_t WS_GATE = WS_BB + 2 * SZ_T16;
constexpr size_t WS_WDEC = WS_GATE + SZ_T16;
constexpr size_t WS_END1 = WS_WDEC + 2 * SZ_T32;
constexpr size_t WS_HID = WS_PS;
constexpr size_t WS_END = WS_END1 > WS_HID + (size_t)M * DFF * 2 ? WS_END1 : WS_HID + (size_t)M * DFF * 2;
static_assert((size_t)M * DA * 4 * 2 <= (size_t)M * PINP * 2, "Y fits in P");
constexpr int CW_BAR = 4096;

constexpr int RING_BYTES = 131072;
constexpr int LDSCTL_OFF = RING_BYTES, MISC_OFF = LDSCTL_OFF + 320;
constexpr int LDS_BYTES = 147456;

#define GAS __attribute__((address_space(1)))
#define LAS __attribute__((address_space(3)))
typedef unsigned short bf16;
typedef float f32x4 __attribute__((ext_vector_type(4)));
typedef float f32x2 __attribute__((ext_vector_type(2)));
typedef short bf16x8 __attribute__((ext_vector_type(8)));
typedef unsigned u32x4 __attribute__((ext_vector_type(4)));
typedef unsigned u32x2 __attribute__((ext_vector_type(2)));
#define LDS_WAIT() asm volatile("s_waitcnt lgkmcnt(0)" ::: "memory")
#define VM_WAIT() asm volatile("s_waitcnt vmcnt(0)" ::: "memory")
__device__ __forceinline__ unsigned f2bf(float f) { unsigned u = __builtin_bit_cast(unsigned, f); return (u + 0x7fffu + ((u >> 16) & 1u)) >> 16; }
__device__ __forceinline__ unsigned pk2(float lo, float hi) { return f2bf(lo) | (f2bf(hi) << 16); }
__device__ __forceinline__ float bf2f(unsigned short b) { return __uint_as_float(((unsigned)b) << 16); }
__device__ __forceinline__ void unpack8(const u32x4 q, float (&f)[8]) {
    f[0] = __uint_as_float(q.x << 16); f[1] = __uint_as_float(q.x & 0xffff0000u); f[2] = __uint_as_float(q.y << 16); f[3] = __uint_as_float(q.y & 0xffff0000u);
    f[4] = __uint_as_float(q.z << 16); f[5] = __uint_as_float(q.z & 0xffff0000u); f[6] = __uint_as_float(q.w << 16); f[7] = __uint_as_float(q.w & 0xffff0000u); }
__device__ __forceinline__ u32x4 pack8(const float (&f)[8]) { u32x4 o; o.x = pk2(f[0], f[1]); o.y = pk2(f[2], f[3]); o.z = pk2(f[4], f[5]); o.w = pk2(f[6], f[7]); return o; }
__device__ __forceinline__ float fsigmoid(float x) { return __builtin_amdgcn_rcpf(1.0f + __expf(-x)); }
__device__ __forceinline__ float ftanh(float x) { return 1.0f - 2.0f * __builtin_amdgcn_rcpf(1.0f + __expf(2.0f * x)); }
__device__ __forceinline__ float gelu_tanh(float x) { const float u = 1.5957691216057308f * (x + 0.044715f * x * x * x); return x * __builtin_amdgcn_rcpf(1.0f + __expf(-u)); }
__device__ __forceinline__ float wave_sum(float v) {
#pragma unroll
    for (int o = 1; o < 64; o <<= 1) v += __shfl_xor(v, o);
    return v;
}


#define PH_LOCALS(F) int tid = (F).tid; asm volatile("" : "+v"(tid)); const int lane = tid & 63, wave = __builtin_amdgcn_readfirstlane(tid >> 6); \
    int bx = (F).bx, G = (F).G; asm volatile("" : "+s"(bx), "+s"(G)); (void)lane; (void)wave;
#define PH_LAYER(l) asm volatile("" : "+s"(l))

#define XB_TMO      128
#define XB_XCNT(j)  (256  + 64 * (j))
#define XB_XSUB(j)  (1280 + 64 * (j))
#define XB_XGEN(j)  (2304 + 64 * (j))
#define XB_TOP      3328
#define XB_TOPGEN   3392
#define XCD_BAR_WORDS 3456
#define XB_SPIN_CAP (1u << 18)

__device__ __forceinline__ unsigned xb_ld(unsigned* p)              { return __hip_atomic_load(p, __ATOMIC_RELAXED, __HIP_MEMORY_SCOPE_AGENT); }
__device__ __forceinline__ unsigned xb_add(unsigned* p, unsigned v) { return __hip_atomic_fetch_add(p, v, __ATOMIC_RELAXED, __HIP_MEMORY_SCOPE_AGENT); }
__device__ __forceinline__ unsigned xb_xcc_id() { return (unsigned)__builtin_amdgcn_s_getreg((3 << 11) | 20) & 0xFu; }
#define XB_SPIN(cond, bar) do { unsigned _sp = 0; while (cond) { __builtin_amdgcn_s_sleep(1); \
    if ((++_sp & 255u) == 0u) { if (xb_ld(&(bar)[XB_TMO])) break; if (_sp > XB_SPIN_CAP) { atomicAdd(&(bar)[XB_TMO], 1u); break; } } } } while (0)

struct XcdBarrier {
    unsigned* bar; unsigned x;
    volatile LAS unsigned* st;
};
__device__ __forceinline__ XcdBarrier xcd_barrier_post(unsigned* bar, volatile LAS unsigned* st) {
    XcdBarrier b; b.bar = bar; b.x = xb_xcc_id(); b.st = st;
    if (threadIdx.x == 0) (void)xb_add(&bar[XB_XCNT(b.x)], 1u);
    return b;
}
__device__ __forceinline__ void xcd_barrier_complete(unsigned* bar, unsigned x, unsigned& nloc, unsigned& nx) {
    const unsigned G = gridDim.x * gridDim.y * gridDim.z;
    unsigned sum, cnt, mine, sp = 0u;
    for (;;) {
        sum = 0u; cnt = 0u; mine = 0u;
#pragma unroll
        for (unsigned j = 0; j < 16; ++j) { const unsigned c = xb_ld(&bar[XB_XCNT(j)]); sum += c; cnt += (c > 0u) ? 1u : 0u; mine = (j == x) ? c : mine; }
        if (sum == G) break;
        __builtin_amdgcn_s_sleep(1);
        if ((++sp & 255u) == 0u) { if (xb_ld(&bar[XB_TMO])) break; if (sp > XB_SPIN_CAP) { atomicAdd(&bar[XB_TMO], 1u); break; } }
    }
    nloc = mine > 0u ? mine : 1u; nx = cnt > 0u ? cnt : 1u;
}
__device__ __forceinline__ void xcd_barrier(const XcdBarrier& b) {
    asm volatile("s_waitcnt vmcnt(0)" ::: "memory");
    __syncthreads();
    if (threadIdx.x == 0) {
        unsigned* bar = b.bar;
        __builtin_amdgcn_s_waitcnt(0);
        unsigned nloc = b.st[0], nx = b.st[1];
        if (nloc == 0u) { xcd_barrier_complete(bar, b.x, nloc, nx); b.st[0] = nloc; b.st[1] = nx; }
        const unsigned old = xb_add(&bar[XB_XSUB(b.x)], 1u);
        const unsigned gen = old / nloc;
        if (old + 1u == (gen + 1u) * nloc) {
            __builtin_amdgcn_fence(__ATOMIC_RELEASE, "agent");
            asm volatile("s_waitcnt vmcnt(0)" ::: "memory");
            const unsigned og = xb_add(&bar[XB_TOP], 1u);
            const unsigned tg = og / nx;
            if (og + 1u == (tg + 1u) * nx) xb_add(&bar[XB_TOPGEN], 1u);
            else XB_SPIN(xb_ld(&bar[XB_TOPGEN]) == tg, bar);
            __builtin_amdgcn_fence(__ATOMIC_ACQUIRE, "agent");
            xb_add(&bar[XB_XGEN(b.x)], 1u);
            asm volatile("s_waitcnt vmcnt(0)" ::: "memory");
        } else {
            XB_SPIN(xb_ld(&bar[XB_XGEN(b.x)]) == gen, bar);
            __builtin_amdgcn_fence(__ATOMIC_ACQUIRE, "agent");
            asm volatile("s_waitcnt vmcnt(0)" ::: "memory");
        }
    }
    __syncthreads();
}

struct Args {
    const float* in[30];
    float* out; unsigned char* ws;
    int ph_lo, ph_hi, li, pad;
};
enum { I_XP = 0, I_XS, I_STATE, I_C, I_CCTX, I_WMOD, I_BMOD, I_N1G, I_WIN, I_MU, I_W0, I_W2, I_A0, I_A2, I_G2, I_KK, I_KA, I_RK, I_GNW, I_GNB, I_LNG, I_LNB, I_WSP, I_BSP, I_WOUT, I_N2G, I_WG, I_WU, I_WD, I_FNG };

struct Frame {
    LAS unsigned char* lds;
    int tid, lane, wave, G, bx;
    const float* const* in;
    float* out; unsigned char* ws;
};

struct EpiP {
    static constexpr bool PERM = true, AFTER_DRAIN = false;
    bf16* O; int ldc; int gelu_from;
    __device__ __forceinline__ void operator()(const f32x4 (&acc)[2][2][4][2], const pg8::Unit& u, int wr, int wc, int fr, int fq) const {
        const int row0 = u.pm * 256 + wr * 64 + fr, col0 = u.pn * 256 + wc * 32 + 8 * fq;
#pragma unroll
        for (int ai = 0; ai < 2; ++ai)
#pragma unroll
            for (int m = 0; m < 4; ++m) { bf16* rowp = O + (size_t)(row0 + ai * 128 + m * 16) * ldc + col0;
#pragma unroll
                for (int bj = 0; bj < 2; ++bj) { f32x4 v0 = acc[ai][bj][m][0], v1 = acc[ai][bj][m][1];
                    if (col0 + bj * 128 >= gelu_from) {
#pragma unroll
                        for (int j = 0; j < 4; ++j) { v0[j] = gelu_tanh(v0[j]); v1[j] = gelu_tanh(v1[j]); } }
                    u32x4 w; w.x = pg8::cvt_pk_bf16(v0[0], v0[1]); w.y = pg8::cvt_pk_bf16(v0[2], v0[3]); w.z = pg8::cvt_pk_bf16(v1[0], v1[1]); w.w = pg8::cvt_pk_bf16(v1[2], v1[3]);
                    *(u32x4*)(rowp + bj * 128) = w; } }
    }
};
struct EpiRes {
    static constexpr bool PERM = false, AFTER_DRAIN = false;
    const float* xlo; const float* xhi; float* xout; const float* modl; int goff;
    __device__ __forceinline__ void operator()(const f32x4 (&acc)[2][2][4][2], const pg8::Unit& u, int wr, int wc, int fr, int fq) const {
        const int pm = u.pm; const int midx = pm < 16 ? 0 : 1 + ((pm - 16) >> 4);
        const float* gv = modl + (size_t)midx * MODW + goff;
        const float* base = pm < 16 ? xlo + (size_t)pm * 256 * D : xhi + (size_t)(pm - 16) * 256 * D;
        float* ob = xout + (size_t)pm * 256 * D;
        const int col0 = u.pn * 256 + wc * 32 + 4 * fq;
        f32x4 gvv[2][2];
#pragma unroll
        for (int bj = 0; bj < 2; ++bj)
#pragma unroll
            for (int n = 0; n < 2; ++n) gvv[bj][n] = *(const f32x4*)(gv + col0 + bj * 128 + n * 16);
#pragma unroll
        for (int ai = 0; ai < 2; ++ai)
#pragma unroll
            for (int m = 0; m < 4; ++m) { const size_t off = (size_t)(ai * 128 + wr * 64 + m * 16 + fr) * D + col0;
#pragma unroll
                for (int bj = 0; bj < 2; ++bj)
#pragma unroll
                    for (int n = 0; n < 2; ++n) { const f32x4 xo = *(const f32x4*)(base + off + bj * 128 + n * 16);
                        *(f32x4*)(ob + off + bj * 128 + n * 16) = xo + gvv[bj][n] * acc[ai][bj][m][n]; }
                if (m & 1) asm volatile("" ::: "memory"); }
    }
};
struct EpiSwi {
    static constexpr bool PERM = true, AFTER_DRAIN = false;
    bf16* O; int ldc;
    __device__ __forceinline__ void operator()(const f32x4 (&acc)[2][2][4][2], const pg8::Unit& u, int wr, int wc, int fr, int fq) const {
        const int row0 = u.pm * 256 + wr * 64 + fr, col0 = u.pn * 128 + wc * 32 + 8 * fq;
#pragma unroll
        for (int ai = 0; ai < 2; ++ai)
#pragma unroll
            for (int m = 0; m < 4; ++m) { bf16* rowp = O + (size_t)(row0 + ai * 128 + m * 16) * ldc + col0;
                float h[8];
#pragma unroll
                for (int n = 0; n < 2; ++n)
#pragma unroll
                    for (int j = 0; j < 4; ++j) { const float gt = acc[ai][0][m][n][j], up = acc[ai][1][m][n][j]; h[n * 4 + j] = gt * fsigmoid(gt) * up; }
                u32x4 w; w.x = pg8::cvt_pk_bf16(h[0], h[1]); w.y = pg8::cvt_pk_bf16(h[2], h[3]); w.z = pg8::cvt_pk_bf16(h[4], h[5]); w.w = pg8::cvt_pk_bf16(h[6], h[7]);
                *(u32x4*)rowp = w; }
    }
};

template <int MAP>
__device__ __forceinline__ void tr_item(const float* W, int K, int N, bf16* WT, LAS float* scr, int item, int lane) {
    const int nblk = N / 32, kb = item / nblk, nb = item % nblk, k0 = 64 * kb, n0 = 32 * nb;
#pragma unroll 8
    for (int i = 0; i < 32; ++i) { const int kk = 2 * i + (lane >> 5); scr[kk * 33 + (lane & 31)] = W[(size_t)(k0 + kk) * N + n0 + (lane & 31)]; }
    LDS_WAIT(); asm volatile("" ::: "memory");
    const int c = lane & 7;
#pragma unroll
    for (int j = 0; j < 4; ++j) { const int n = (lane >> 3) + 8 * j; const LAS float* s = scr + (8 * c) * 33 + n;
        u32x4 o; o.x = pk2(s[0 * 33], s[1 * 33]); o.y = pk2(s[2 * 33], s[3 * 33]); o.z = pk2(s[4 * 33], s[5 * 33]); o.w = pk2(s[6 * 33], s[7 * 33]);
        const int nn = n0 + n; const int orow = MAP == 0 ? nn : (256 * (nn >> 7) + (nn & 127) + (MAP == 2 ? 128 : 0));
        *(u32x4*)(WT + (size_t)orow * K + k0 + 8 * c) = o; }
    LDS_WAIT(); asm volatile("" ::: "memory");
}
__device__ __forceinline__ void p0_prologue(Frame& F) {
    PH_LOCALS(F);
    LAS float* scr = (LAS float*)(F.lds + wave * 16384);
    const int gw = bx * NWAVES + wave, NGW = G * NWAVES;
    constexpr int I_IN = (D / 64) * (PIN / 32), I_OUT = (D / 64) * (D / 32), I_GU = (D / 64) * (DFF / 32), I_DN = (DFF / 64) * (D / 32);
    constexpr int PL = I_IN + I_OUT + 2 * I_GU + I_DN;
    for (int it = gw; it < NL * PL; it += NGW) {
        const int l = it / PL; int r = it % PL;
        if (r < I_IN) { tr_item<0>(F.in[I_WIN] + (size_t)l * D * PIN, D, PIN, (bf16*)(F.ws + WS_WIN + l * SZ_WIN), scr, r, lane); continue; } r -= I_IN;
        if (r < I_OUT) { tr_item<0>(F.in[I_WOUT] + (size_t)l * D * D, D, D, (bf16*)(F.ws + WS_WOUT + l * SZ_WOUT), scr, r, lane); continue; } r -= I_OUT;
        if (r < I_GU) { tr_item<1>(F.in[I_WG] + (size_t)l * D * DFF, D, DFF, (bf16*)(F.ws + WS_WGU + l * SZ_WGU), scr, r, lane); continue; } r -= I_GU;
        if (r < I_GU) { tr_item<2>(F.in[I_WU] + (size_t)l * D * DFF, D, DFF, (bf16*)(F.ws + WS_WGU + l * SZ_WGU), scr, r, lane); continue; } r -= I_GU;
        tr_item<0>(F.in[I_WD] + (size_t)l * DFF * D, DFF, D, (bf16*)(F.ws + WS_WD + l * SZ_WD), scr, r, lane);
    }
    const int gt = bx * 512 + tid, NGT = G * 512;
    { constexpr int PADV = (PINP - PIN) * D * 2 / 16;
      for (int i = gt; i < NL * PADV; i += NGT) { const int l = i / PADV, r = i % PADV; ((u32x4*)(F.ws + WS_WIN + l * SZ_WIN + (size_t)PIN * D * 2))[r] = (u32x4){0u, 0u, 0u, 0u}; } }
    { bf16* w2t = (bf16*)(F.ws + WS_W2T); bf16* a2t = (bf16*)(F.ws + WS_A2T); bf16* g2t = (bf16*)(F.ws + WS_G2T); bf16* wsp = (bf16*)(F.ws + WS_WSP);
      for (int i = gt; i < NL * 2 * 1024 * 64; i += NGT) { const int k = i & 63, n = (i >> 6) & 1023, ld = i >> 16;
          w2t[i] = (bf16)f2bf(F.in[I_W2][((size_t)ld * 64 + k) * 1024 + n]); a2t[i] = (bf16)f2bf(F.in[I_A2][((size_t)ld * 64 + k) * 1024 + n]); }
      for (int i = gt; i < NL * 1024 * 160; i += NGT) { const int k = i % 160, n = (i / 160) & 1023, l = i / (160 * 1024);
          g2t[i] = (bf16)f2bf(F.in[I_G2][((size_t)l * 160 + k) * 1024 + n]); }
      for (int i = gt; i < NL * 8 * 128 * 128; i += NGT) wsp[i] = (bf16)f2bf(F.in[I_WSP][i]); }
    __syncthreads();
    { LAS float* sv = (LAS float*)F.lds;
      LAS float* red = (LAS float*)(F.lds + 40960);
      for (int i = tid; i < 5 * D; i += 512) { const int r = i / D, k = i % D; const float c = r == 0 ? F.in[I_CCTX][k] : F.in[I_C][(r - 1) * D + k]; sv[i] = c * fsigmoid(c); }
      __syncthreads();
      float* mod = (float*)(F.ws + WS_MOD);
      const int c4 = tid & 15, kg = tid >> 4;
      for (int item = bx; item < NL * (MODW / 64); item += G) {
          const int l = item / (MODW / 64), n0 = (item % (MODW / 64)) * 64;
          const float* W = F.in[I_WMOD] + (size_t)l * D * MODW + n0 + 4 * c4;
          f32x4 a[5];
#pragma unroll
          for (int r = 0; r < 5; ++r) a[r] = (f32x4){0.f, 0.f, 0.f, 0.f};
#pragma unroll 4
          for (int i = 0; i < 64; ++i) { const int k = i * 32 + kg; const f32x4 w = *(const f32x4*)(W + (size_t)k * MODW);
#pragma unroll
              for (int r = 0; r < 5; ++r) a[r] += w * sv[r * D + k]; }
#pragma unroll
          for (int r = 0; r < 5; ++r) *(LAS f32x4*)(red + (kg * 5 + r) * 64 + 4 * c4) = a[r];
          __syncthreads();
          if (tid < 320) { const int r = tid >> 6, n = tid & 63; float s = 0.f;
#pragma unroll 8
              for (int g = 0; g < 32; ++g) s += red[(g * 5 + r) * 64 + n];
              mod[((size_t)l * 5 + r) * MODW + n0 + n] = s + F.in[I_BMOD][(size_t)l * MODW + n0 + n]; }
          __syncthreads();
      } }
}

__device__ __forceinline__ void p_adaln(Frame& F, int l, int which, const float* xlo, const float* xhi) {
    PH_LOCALS(F); PH_LAYER(l);
    const int gw = bx * NWAVES + wave, NGW = G * NWAVES;
    const float* ng = (which == 0 ? F.in[I_N1G] : F.in[I_N2G]) + (size_t)l * D;
    const int shoff = which == 0 ? 0 : 3 * D, scoff = shoff + D;
    const float* mod = (const float*)(F.ws + WS_MOD);
    bf16* H = (bf16*)(F.ws + WS_H);
    for (int row = gw; row < M; row += NGW) {
        const float* xr = row < MCTX ? xlo + (size_t)row * D : xhi + (size_t)(row - MCTX) * D;
        const int midx = row < MCTX ? 0 : 1 + ((row - MCTX) >> 12);
        const float* md = mod + ((size_t)l * 5 + midx) * MODW;
        f32x4 v[8]; float ss = 0.f;
#pragma unroll
        for (int j = 0; j < 8; ++j) { v[j] = *(const f32x4*)(xr + 4 * lane + 256 * j); ss += (v[j].x * v[j].x + v[j].y * v[j].y) + (v[j].z * v[j].z + v[j].w * v[j].w); }
        const float rstd = 1.0f / sqrtf(wave_sum(ss) * (1.0f / D) + RMS_EPS);
#pragma unroll
        for (int j = 0; j < 8; ++j) { const int c = 4 * lane + 256 * j;
            const f32x4 g4 = *(const f32x4*)(ng + c), sc = *(const f32x4*)(md + scoff + c), sh = *(const f32x4*)(md + shoff + c);
            const f32x4 o = v[j] * rstd * g4 * (sc + 1.0f) + sh;
            u32x2 w; w.x = pk2(o.x, o.y); w.y = pk2(o.z, o.w);
            *(u32x2*)(H + (size_t)row * D + c) = w; }
    }
}

__device__ __forceinline__ void load_shifted8(const bf16* P, const float* mu, int row, int col, float (&o)[8]) {
    float g[8]; unpack8(*(const u32x4*)(P + (size_t)row * PINP + col), g);
    float a[8];
#pragma unroll
    for (int j = 0; j < 8; ++j) a[j] = g[j];
    int nrow[4]; bool has[4]; int nn;
    if (row < MCTX) { const int t = row & 255; nn = 2; nrow[0] = row - 1; has[0] = t > 0; nrow[1] = row + 1; has[1] = t < 255; nrow[2] = row; has[2] = false; nrow[3] = row; has[3] = false; }
    else { const int t = (row - MCTX) & 4095, gc = t & 63, gr = t >> 6; nn = 4;
        nrow[0] = row - 1; has[0] = gc > 0; nrow[1] = row + 1; has[1] = gc < 63; nrow[2] = row - 64; has[2] = gr > 0; nrow[3] = row + 64; has[3] = gr < 63; }
#pragma unroll
    for (int q = 0; q < 4; ++q) {
        if (q < nn) {
            float nb[8];
            if (has[q]) unpack8(*(const u32x4*)(P + (size_t)nrow[q] * PINP + col), nb);
            else {
#pragma unroll
                for (int j = 0; j < 8; ++j) nb[j] = 0.f; }
            const f32x4 m0 = *(const f32x4*)(mu + q * CSH + col), m1 = *(const f32x4*)(mu + q * CSH + col + 4);
#pragma unroll
            for (int j = 0; j < 4; ++j) { a[j] += m0[j] * (nb[j] - g[j]); a[4 + j] += m1[j] * (nb[4 + j] - g[4 + j]); }
        }
    }
#pragma unroll
    for (int j = 0; j < 8; ++j) o[j] = a[j];
}
__device__ __forceinline__ void p_shift(Frame& F, int l) {
    PH_LOCALS(F); PH_LAYER(l);
    const bf16* P = (const bf16*)(F.ws + WS_P); bf16* PS = (bf16*)(F.ws + WS_PS);
    const float* mu = F.in[I_MU] + (size_t)l * 4 * CSH;
    const int gt = bx * 512 + tid, NGT = G * 512;
    constexpr int CG = CSH / 8;
    for (int i = gt; i < M * CG; i += NGT) { const int row = i / CG, cg = i % CG;
        float o[8]; load_shifted8(P, mu, row, cg * 8, o);
        *(u32x4*)(PS + (size_t)row * CSH + cg * 8) = pack8(o); }
}

constexpr int XS64 = 72, XS160 = 168;
constexpr int TST = 65;
__device__ __forceinline__ void p_prep(Frame& F, int l) {
    PH_LOCALS(F); PH_LAYER(l);
    const bf16* PS = (const bf16*)(F.ws + WS_PS);
    LAS bf16* XW = (LAS bf16*)F.lds; LAS bf16* XA = XW + 64 * XS64; LAS bf16* XG = XA + 64 * XS64;
    LAS float* T = (LAS float*)(F.lds + 40960);
    const bf16* w2t = (const bf16*)(F.ws + WS_W2T) + (size_t)l * 2 * 1024 * 64;
    const bf16* a2t = (const bf16*)(F.ws + WS_A2T) + (size_t)l * 2 * 1024 * 64;
    const bf16* g2t = (const bf16*)(F.ws + WS_G2T) + (size_t)l * 1024 * 160;
    bf16* KK = (bf16*)(F.ws + WS_KK); bf16* KD = (bf16*)(F.ws + WS_KD); bf16* BB = (bf16*)(F.ws + WS_BB); bf16* GATE = (bf16*)(F.ws + WS_GATE);
    float* WDEC = (float*)(F.ws + WS_WDEC); float* BONUS = (float*)(F.ws + WS_BONUS);
    const int rb = wave & 3, ch = wave >> 2, fr = lane & 15, fq = lane >> 4;
    for (int item = bx; item < (M / 64) * NH; item += G) {
        const int ci = item >> 4, h = item & 15, R0 = ci * 64;
        for (int idx = tid; idx < 64 * 36; idx += 512) { const int r = idx / 36, cg = idx % 36;
            float f[8]; unpack8(*(const u32x4*)(PS + (size_t)(R0 + r) * CSH + 3 * DA + 8 * cg), f);
            if (cg < 8) {
#pragma unroll
                for (int j = 0; j < 8; ++j) f[j] = ftanh(f[j]);
                *(LAS u32x4*)(XW + r * XS64 + 8 * cg) = pack8(f); }
            else if (cg < 16) *(LAS u32x4*)(XA + r * XS64 + 8 * (cg - 8)) = pack8(f);
            else {
#pragma unroll
                for (int j = 0; j < 8; ++j) f[j] = fsigmoid(f[j]);
                *(LAS u32x4*)(XG + r * XS160 + 8 * (cg - 16)) = pack8(f); } }
        __syncthreads();
#pragma unroll
        for (int ctl = 0; ctl < 2; ++ctl) {
            const int ct = ch * 2 + ctl; const int n = 64 * h + 16 * ct + fr;
            f32x4 acc[5];
#pragma unroll
            for (int q = 0; q < 5; ++q) acc[q] = (f32x4){0.f, 0.f, 0.f, 0.f};
#pragma unroll
            for (int ks = 0; ks < 2; ++ks) {
                const bf16x8 aw = *(const LAS bf16x8*)(XW + (16 * rb + fr) * XS64 + 8 * fq + 32 * ks);
                const bf16x8 aa = *(const LAS bf16x8*)(XA + (16 * rb + fr) * XS64 + 8 * fq + 32 * ks);
#pragma unroll
                for (int d = 0; d < 2; ++d) {
                    const bf16x8 bw = *(const bf16x8*)(w2t + ((size_t)d * 1024 + n) * 64 + 8 * fq + 32 * ks);
                    const bf16x8 ba = *(const bf16x8*)(a2t + ((size_t)d * 1024 + n) * 64 + 8 * fq + 32 * ks);
                    acc[d] = __builtin_amdgcn_mfma_f32_16x16x32_bf16(aw, bw, acc[d], 0, 0, 0);
                    acc[2 + d] = __builtin_amdgcn_mfma_f32_16x16x32_bf16(aa, ba, acc[2 + d], 0, 0, 0);
                }
            }
#pragma unroll
            for (int ks = 0; ks < 5; ++ks) {
                const bf16x8 ag = *(const LAS bf16x8*)(XG + (16 * rb + fr) * XS160 + 8 * fq + 32 * ks);
                const bf16x8 bg = *(const bf16x8*)(g2t + (size_t)n * 160 + 8 * fq + 32 * ks);
                acc[4] = __builtin_amdgcn_mfma_f32_16x16x32_bf16(ag, bg, acc[4], 0, 0, 0);
            }
            const int cl = 16 * ct + fr;
#pragma unroll
            for (int d = 0; d < 2; ++d) {
                const float w0v = F.in[I_W0][((size_t)l * 2 + d) * DA + 64 * h + cl], a0v = F.in[I_A0][((size_t)l * 2 + d) * DA + 64 * h + cl];
#pragma unroll
                for (int i = 0; i < 4; ++i) { const int r = 16 * rb + 4 * fq + i;
                    T[(d * 64 + r) * TST + cl] = __expf(-0.6065306597126334f * fsigmoid(w0v + acc[d][i]));
                    T[((2 + d) * 64 + r) * TST + cl] = fsigmoid(a0v + acc[2 + d][i]); }
            }
#pragma unroll
            for (int i = 0; i < 4; ++i) T[(4 * 64 + 16 * rb + 4 * fq + i) * TST + cl] = acc[4][i];
        }
        __syncthreads();
        { const int tk = tid >> 3, c8 = (tid & 7) * 8, row = R0 + tk, chn = 64 * h + c8;
          float r[8], k[8];
          unpack8(*(const u32x4*)(PS + (size_t)row * CSH + chn), r);
          unpack8(*(const u32x4*)(PS + (size_t)row * CSH + DA + chn), k);
          float kk[8], ss = 0.f;
#pragma unroll
          for (int j = 0; j < 8; ++j) { kk[j] = k[j] * F.in[I_KK][(size_t)l * DA + chn + j]; ss += kk[j] * kk[j]; }
          ss += __shfl_xor(ss, 1); ss += __shfl_xor(ss, 2); ss += __shfl_xor(ss, 4);
          const float rn = 1.0f / sqrtf(fmaxf(ss, 1e-24f));
#pragma unroll
          for (int j = 0; j < 8; ++j) kk[j] *= rn;
          *(u32x4*)(KK + (size_t)row * DA + chn) = pack8(kk);
          float bon = 0.f;
#pragma unroll
          for (int d = 0; d < 2; ++d) {
              float kd[8], bb[8], dec[8];
#pragma unroll
              for (int j = 0; j < 8; ++j) { const float al = T[((2 + d) * 64 + tk) * TST + c8 + j]; dec[j] = T[(d * 64 + tk) * TST + c8 + j];
                  kd[j] = k[j] * (1.0f + (al - 1.0f) * F.in[I_KA][(size_t)l * DA + chn + j]); bb[j] = kk[j] * al;
                  bon += r[j] * kd[j] * F.in[I_RK][(size_t)l * DA + chn + j]; }
              *(u32x4*)(KD + (size_t)d * M * DA + (size_t)row * DA + chn) = pack8(kd);
              *(u32x4*)(BB + (size_t)d * M * DA + (size_t)row * DA + chn) = pack8(bb);
              float* wp = WDEC + (size_t)d * M * DA + (size_t)row * DA + chn;
              *(f32x4*)wp = (f32x4){dec[0], dec[1], dec[2], dec[3]}; *(f32x4*)(wp + 4) = (f32x4){dec[4], dec[5], dec[6], dec[7]};
          }
          bon += __shfl_xor(bon, 1); bon += __shfl_xor(bon, 2); bon += __shfl_xor(bon, 4);
          if ((tid & 7) == 0) BONUS[(size_t)row * NH + h] = bon;
          float gt[8];
#pragma unroll
          for (int j = 0; j < 8; ++j) gt[j] = T[(4 * 64 + tk) * TST + c8 + j];
          *(u32x4*)(GATE + (size_t)row * DA + chn) = pack8(gt);
        }
        __syncthreads();
    }
}

constexpr int VTS = 136;
__device__ __forceinline__ void p_gmlp(Frame& F, int l) {
    PH_LOCALS(F); PH_LAYER(l);
    const bf16* P = (const bf16*)(F.ws + WS_P); bf16* O = (bf16*)(F.ws + WS_O);
    const bf16* wsp = (const bf16*)(F.ws + WS_WSP) + (size_t)l * 8 * 128 * 128;
    LAS bf16* VT = (LAS bf16*)F.lds;
    const int fr = lane & 15, fq = lane >> 4;
    for (int item = bx; item < (M / 128) * NG; item += G) {
        const int cb = item >> 3, g = item & 7, R0 = cb * 128;
        { const int j = tid >> 2, q = tid & 3;
          const bf16* src = P + (size_t)(R0 + j) * PINP + CSH + DB + 128 * g + 32 * q;
          float v[32];
#pragma unroll
          for (int i = 0; i < 4; ++i) { float f[8]; unpack8(*(const u32x4*)(src + 8 * i), f);
#pragma unroll
              for (int jj = 0; jj < 8; ++jj) v[8 * i + jj] = f[jj]; }
          float s = 0.f;
#pragma unroll
          for (int i = 0; i < 32; ++i) s += v[i];
          s += __shfl_xor(s, 1); s += __shfl_xor(s, 2);
          const float mean = s * (1.0f / 128.0f); float qq = 0.f;
#pragma unroll
          for (int i = 0; i < 32; ++i) { v[i] -= mean; qq += v[i] * v[i]; }
          qq += __shfl_xor(qq, 1); qq += __shfl_xor(qq, 2);
          const float rstd = 1.0f / sqrtf(qq * (1.0f / 128.0f) + LN_EPS);
          const float* lg = F.in[I_LNG] + ((size_t)l * 8 + g) * 128 + 32 * q; const float* lb = F.in[I_LNB] + ((size_t)l * 8 + g) * 128 + 32 * q;
#pragma unroll
          for (int i = 0; i < 32; ++i) VT[(32 * q + i) * VTS + j] = (bf16)f2bf(v[i] * rstd * lg[i] + lb[i]);
        }
        __syncthreads();
        f32x4 acc[8];
#pragma unroll
        for (int dt = 0; dt < 8; ++dt) acc[dt] = (f32x4){0.f, 0.f, 0.f, 0.f};
        const bf16* wa = wsp + ((size_t)g * 128 + 16 * wave + fr) * 128 + 8 * fq;
#pragma unroll
        for (int ks = 0; ks < 4; ++ks) {
            const bf16x8 a = *(const bf16x8*)(wa + 32 * ks);
#pragma unroll
            for (int dt = 0; dt < 8; ++dt) { const bf16x8 b = *(const LAS bf16x8*)(VT + (16 * dt + fr) * VTS + 8 * fq + 32 * ks);
                acc[dt] = __builtin_amdgcn_mfma_f32_16x16x32_bf16(a, b, acc[dt], 0, 0, 0); }
        }
#pragma unroll
        for (int r = 0; r < 4; ++r) { const int i = 16 * wave + 4 * fq + r; const float bs = F.in[I_BSP][((size_t)l * 8 + g) * 128 + i];
            const bf16* up = P + (size_t)(R0 + i) * PINP + CSH + 128 * g + fr; bf16* op = O + (size_t)(R0 + i) * D + DA + 128 * g + fr;
#pragma unroll
            for (int dt = 0; dt < 8; ++dt) op[16 * dt] = (bf16)f2bf(bf2f(up[16 * dt]) * (acc[dt][r] + bs)); }
        __syncthreads();
    }
}

__device__ __forceinline__ void p_scan(Frame& F, int l) {
    PH_LOCALS(F); PH_LAYER(l);
    const bf16* PS = (const bf16*)(F.ws + WS_PS); const bf16* KK = (const bf16*)(F.ws + WS_KK);
    LAS float* sb = (LAS float*)(F.lds + wave * 2048);
    for (int c = bx + G * wave; c < 640; c += G * NWAVES) {
        int b, h, d, rowbase, T; const bool lat = c < 128;
        if (lat) { b = c >> 5; h = (c >> 1) & 15; d = c & 1; rowbase = MCTX + b * 4096; T = 4096; }
        else { const int cc = c - 128; b = cc >> 5; h = (cc >> 1) & 15; d = cc & 1; rowbase = b * 256; T = 256; }
        float S[64];
        if (lat) { const float* src = F.in[I_STATE] + ((((size_t)b * NL + l) * 2 + d) * NH + h) * 4096 + lane * 64;
#pragma unroll
            for (int k4 = 0; k4 < 16; ++k4) { const f32x4 q = *(const f32x4*)(src + 4 * k4); S[4 * k4] = q.x; S[4 * k4 + 1] = q.y; S[4 * k4 + 2] = q.z; S[4 * k4 + 3] = q.w; } }
        else {
#pragma unroll
            for (int k = 0; k < 64; ++k) S[k] = 0.f; }
        const bf16* kkp = KK + 64 * h + lane; const bf16* bp = (const bf16*)(F.ws + WS_BB) + (size_t)d * M * DA + 64 * h + lane;
        const bf16* kp = (const bf16*)(F.ws + WS_KD) + (size_t)d * M * DA + 64 * h + lane; const float* wp = (const float*)(F.ws + WS_WDEC) + (size_t)d * M * DA + 64 * h + lane;
        const bf16* rp = PS + 64 * h + lane; const bf16* vp = PS + 2 * DA + 64 * h + lane;
        float* yp = (float*)(F.ws + WS_Y) + (size_t)d * M * DA + 64 * h + lane;
        int row = rowbase + (d ? T - 1 : 0);
        float an = -bf2f(kkp[(size_t)row * DA]), bn = bf2f(bp[(size_t)row * DA]), wn = wp[(size_t)row * DA], kn = bf2f(kp[(size_t)row * DA]), rn = bf2f(rp[(size_t)row * CSH]), vn = bf2f(vp[(size_t)row * CSH]);
        for (int step = 0; step < T; ++step) {
            const float ac = an, bc = bn, wc = wn, kc = kn, rc = rn, vc = vn; const int rowc = row;
            if (step + 1 < T) { row += d ? -1 : 1;
                an = -bf2f(kkp[(size_t)row * DA]); bn = bf2f(bp[(size_t)row * DA]); wn = wp[(size_t)row * DA]; kn = bf2f(kp[(size_t)row * DA]); rn = bf2f(rp[(size_t)row * CSH]); vn = bf2f(vp[(size_t)row * CSH]); }
            asm volatile("" ::: "memory");
            sb[lane] = ac; sb[64 + lane] = bc; sb[128 + lane] = wc; sb[192 + lane] = kc; sb[256 + lane] = rc;
            asm volatile("s_waitcnt lgkmcnt(0)" ::: "memory");
            float sa = 0.f;
#pragma unroll
            for (int k4 = 0; k4 < 16; ++k4) { const f32x4 a4 = *(const LAS f32x4*)(sb + 4 * k4);
                sa += S[4 * k4] * a4.x + S[4 * k4 + 1] * a4.y + S[4 * k4 + 2] * a4.z + S[4 * k4 + 3] * a4.w; }
            float y = 0.f;
#pragma unroll
            for (int k4 = 0; k4 < 16; ++k4) {
                const f32x4 b4 = *(const LAS f32x4*)(sb + 64 + 4 * k4), w4 = *(const LAS f32x4*)(sb + 128 + 4 * k4), q4 = *(const LAS f32x4*)(sb + 192 + 4 * k4), r4 = *(const LAS f32x4*)(sb + 256 + 4 * k4);
#pragma unroll
                for (int j = 0; j < 4; ++j) { float s = S[4 * k4 + j]; s = s * w4[j] + sa * b4[j] + vc * q4[j]; S[4 * k4 + j] = s; y += s * r4[j]; }
            }
            asm volatile("s_waitcnt lgkmcnt(0)" ::: "memory");
            yp[(size_t)rowc * DA] = y;
        }
        if (!lat) { float* dst = F.out + (size_t)M * D + ((((size_t)b * NL + l) * 2 + d) * NH + h) * 4096 + lane * 64;
#pragma unroll
            for (int k4 = 0; k4 < 16; ++k4) *(f32x4*)(dst + 4 * k4) = (f32x4){S[4 * k4], S[4 * k4 + 1], S[4 * k4 + 2], S[4 * k4 + 3]}; }
    }
}

__device__ __forceinline__ void p_post(Frame& F, int l) {
    PH_LOCALS(F); PH_LAYER(l);
    const bf16* PS = (const bf16*)(F.ws + WS_PS); const bf16* GATE = (const bf16*)(F.ws + WS_GATE);
    const float* Y = (const float*)(F.ws + WS_Y); const float* BONUS = (const float*)(F.ws + WS_BONUS);
    bf16* O = (bf16*)(F.ws + WS_O);
    const int gt = bx * 512 + tid, NGT = G * 512;
    for (int i = gt; i < M * 128; i += NGT) {
        const int row = i >> 7, hc = i & 127, chn = hc * 8, h = hc >> 3;
        float v[8], gt8[8], o[8];
        unpack8(*(const u32x4*)(PS + (size_t)row * CSH + 2 * DA + chn), v);
        unpack8(*(const u32x4*)(GATE + (size_t)row * DA + chn), gt8);
        const float bon = BONUS[(size_t)row * NH + h];
        const float* gw = F.in[I_GNW] + (size_t)l * DA + chn; const float* gb = F.in[I_GNB] + (size_t)l * DA + chn;
#pragma unroll
        for (int j = 0; j < 8; ++j) o[j] = bon * v[j];
#pragma unroll
        for (int d = 0; d < 2; ++d) {
            const float* yp = Y + (size_t)d * M * DA + (size_t)row * DA + chn;
            const f32x4 y0 = *(const f32x4*)yp, y1 = *(const f32x4*)(yp + 4);
            float y[8] = {y0.x, y0.y, y0.z, y0.w, y1.x, y1.y, y1.z, y1.w};
            float s = 0.f;
#pragma unroll
            for (int j = 0; j < 8; ++j) s += y[j];
            s += __shfl_xor(s, 1); s += __shfl_xor(s, 2); s += __shfl_xor(s, 4);
            const float mean = s * (1.0f / 64.0f); float q = 0.f;
#pragma unroll
            for (int j = 0; j < 8; ++j) { y[j] -= mean; q += y[j] * y[j]; }
            q += __shfl_xor(q, 1); q += __shfl_xor(q, 2); q += __shfl_xor(q, 4);
            const float rstd = 1.0f / sqrtf(q * (1.0f / 64.0f) + GN_EPS);
#pragma unroll
            for (int j = 0; j < 8; ++j) o[j] += y[j] * rstd * gw[j] + gb[j];
        }
#pragma unroll
        for (int j = 0; j < 8; ++j) o[j] *= gt8[j];
        *(u32x4*)(O + (size_t)row * D + chn) = pack8(o);
    }
}

__device__ __forceinline__ void p_final(Frame& F) {
    PH_LOCALS(F);
    const int gw = bx * NWAVES + wave, NGW = G * NWAVES;
    const float* fg = F.in[I_FNG];
    for (int row = gw; row < M; row += NGW) {
        float* xr = F.out + (size_t)row * D;
        f32x4 v[8]; float ss = 0.f;
#pragma unroll
        for (int j = 0; j < 8; ++j) { v[j] = *(const f32x4*)(xr + 4 * lane + 256 * j); ss += (v[j].x * v[j].x + v[j].y * v[j].y) + (v[j].z * v[j].z + v[j].w * v[j].w); }
        const float rstd = 1.0f / sqrtf(wave_sum(ss) * (1.0f / D) + RMS_EPS);
#pragma unroll
        for (int j = 0; j < 8; ++j) { const int c = 4 * lane + 256 * j; *(f32x4*)(xr + c) = v[j] * rstd * *(const f32x4*)(fg + c); }
    }
}

constexpr int PH_PER_LAYER = 10, N_PHASES = 2 + NL * PH_PER_LAYER;
__global__ void __launch_bounds__(NWAVES * 64, 2) hymba_fwd(Args args) {
    extern __shared__ __attribute__((aligned(16))) unsigned char lds[];
    Frame F;
    F.lds = (LAS unsigned char*)lds;
    F.tid = threadIdx.x; F.lane = F.tid & 63; F.wave = __builtin_amdgcn_readfirstlane(F.tid >> 6);
    F.G = gridDim.x; F.bx = blockIdx.x;
    F.in = args.in; F.out = args.out; F.ws = args.ws;
    for (int u = F.tid; u < (LDS_BYTES - LDSCTL_OFF) / 4; u += NWAVES * 64) ((LAS unsigned*)(F.lds + LDSCTL_OFF))[u] = 0u;
    __syncthreads();
    volatile LAS unsigned* MISC = (volatile LAS unsigned*)(F.lds + MISC_OFF);
    unsigned* barw = (unsigned*)(F.ws + WS_CTL) + CW_BAR;
    XcdBarrier bar; bar.bar = barw; bar.x = 0; bar.st = nullptr;
    if (MK_N_LAUNCHES == 1) bar = xcd_barrier_post(barw, MISC + 8);
    const int lo = args.ph_lo, hi = args.ph_hi;
#define IN(k) (lo <= (k) && (k) < hi)
#define SEAM(k) do { if (MK_N_LAUNCHES == 1 && IN(k) && IN((k) + 1)) xcd_barrier(bar); } while (0)

    if (IN(0)) { p0_prologue(F); } SEAM(0);
    bf16* H = (bf16*)(F.ws + WS_H); bf16* O = (bf16*)(F.ws + WS_O); bf16* P = (bf16*)(F.ws + WS_P); bf16* HID = (bf16*)(F.ws + WS_HID);
    const float* mod = (const float*)(F.ws + WS_MOD);
    for (int l = 0; l < NL; ++l) {
        const int pb = 1 + l * PH_PER_LAYER;
        const float* xlo = l == 0 ? F.in[I_XP] : F.out; const float* xhi = l == 0 ? F.in[I_XS] : F.out + (size_t)MCTX * D;
        if (IN(pb + 0)) { p_adaln(F, l, 0, xlo, xhi); } SEAM(pb + 0);
        if (IN(pb + 1)) { pg8::Gemm g{H, (const bf16*)(F.ws + WS_WIN + l * SZ_WIN), M, PINP, D}; pg8::StaticOrder S; S.init(M, PINP, F.G, F.bx);
            EpiP E{P, PINP, CSH}; pg8::gemm_phase<EpiP, pg8::StaticOrder, true, true>(F.lds, g, S, E); } SEAM(pb + 1);
        if (IN(pb + 2)) { p_shift(F, l); } SEAM(pb + 2);
        if (IN(pb + 3)) { p_prep(F, l); p_gmlp(F, l); } SEAM(pb + 3);
        if (IN(pb + 4)) { p_scan(F, l); } SEAM(pb + 4);
        if (IN(pb + 5)) { p_post(F, l); } SEAM(pb + 5);
        if (IN(pb + 6)) { pg8::Gemm g{O, (const bf16*)(F.ws + WS_WOUT + l * SZ_WOUT), M, D, D}; pg8::StaticOrder S; S.init(M, D, F.G, F.bx);
            EpiRes E{xlo, xhi, F.out, mod + (size_t)l * 5 * MODW, 2 * D}; pg8::gemm_phase<EpiRes, pg8::StaticOrder, true, true>(F.lds, g, S, E); } SEAM(pb + 6);
        if (IN(pb + 7)) { p_adaln(F, l, 1, F.out, F.out + (size_t)MCTX * D); } SEAM(pb + 7);
        if (IN(pb + 8)) { pg8::Gemm g{H, (const bf16*)(F.ws + WS_WGU + l * SZ_WGU), M, NGU, D}; pg8::StaticOrder S; S.init(M, NGU, F.G, F.bx);
            EpiSwi E{HID, DFF}; pg8::gemm_phase<EpiSwi, pg8::StaticOrder, true, true>(F.lds, g, S, E); } SEAM(pb + 8);
        if (IN(pb + 9)) { pg8::Gemm g{HID, (const bf16*)(F.ws + WS_WD + l * SZ_WD), M, D, DFF}; pg8::StaticOrder S; S.init(M, D, F.G, F.bx);
            EpiRes E{F.out, F.out + (size_t)MCTX * D, F.out, mod + (size_t)l * 5 * MODW, 5 * D}; pg8::gemm_phase<EpiRes, pg8::StaticOrder, true, true>(F.lds, g, S, E); } SEAM(pb + 9);
    }
    if (IN(N_PHASES - 1)) { p_final(F); }
#undef IN
#undef SEAM
}

extern "C" void kernel_launch(void* const* d_in, const int* in_sizes, int n_in, void* d_out, int out_size, void* d_ws, size_t ws_size, hipStream_t stream) {
    static int grid = 0;
    if (grid == 0) {
        if (n_in != 30 || ws_size < WS_END) { fprintf(stderr, "kernel_launch: need 30 inputs and >= %zu bytes of workspace; got n_in %d, ws %zu\n", (size_t)WS_END, n_in, ws_size); grid = -1; return; }
        int dev = 0, cus = 0, per_cu = 0;
        if (hipGetDevice(&dev) != hipSuccess || hipDeviceGetAttribute(&cus, hipDeviceAttributeMultiprocessorCount, dev) != hipSuccess) { grid = -1; return; }
        if (hipFuncSetAttribute((const void*)hymba_fwd, hipFuncAttributeMaxDynamicSharedMemorySize, LDS_BYTES) != hipSuccess) { fprintf(stderr, "kernel_launch: hipFuncSetAttribute failed\n"); grid = -1; return; }
        if (hipOccupancyMaxActiveBlocksPerMultiprocessor(&per_cu, (const void*)hymba_fwd, NWAVES * 64, LDS_BYTES) != hipSuccess || per_cu < 1)
            fprintf(stderr, "kernel_launch: note: occupancy query reports %d workgroups per CU\n", per_cu);
        (void)hipGetLastError();
        grid = cus;
    }
    if (grid < 0) return;
    if (hipMemsetAsync((char*)d_ws + WS_CTL, 0, CTL_ZERO_BYTES, stream) != hipSuccess) return;
    Args a{};
    for (int i = 0; i < 30; ++i) a.in[i] = (const float*)d_in[i];
    a.out = (float*)d_out; a.ws = (unsigned char*)d_ws; a.pad = 0;
    if (MK_N_LAUNCHES == 1) {
        a.ph_lo = 0; a.ph_hi = N_PHASES; a.li = 0;
        hipLaunchKernelGGL(hymba_fwd, dim3(grid), dim3(NWAVES * 64), LDS_BYTES, stream, a);
    } else {
        for (int k = 0; k < N_PHASES; ++k) { a.ph_lo = k; a.ph_hi = k + 1; a.li = k;
            hipLaunchKernelGGL(hymba_fwd, dim3(grid), dim3(NWAVES * 64), LDS_BYTES, stream, a); }
    }
}
```

```cpp
#include <hip/hip_runtime.h>
#include <cstdio>
#include <cstdint>

#ifndef MK_N_LAUNCHES
#define MK_N_LAUNCHES 1
#endif

namespace pg8 {
#define PG8_LAS __attribute__((address_space(3)))
typedef unsigned short bf16_t;
typedef short bf16x8 __attribute__((ext_vector_type(8)));
typedef float f32x4 __attribute__((ext_vector_type(4)));
typedef unsigned u32x4 __attribute__((ext_vector_type(4)));
constexpr int BM = 256, BK = 64, HALF = 128, HTB = HALF * BK * 2  , STAGE_BYTES = 8 * HTB, NXCD = 8, WGM = 8;

__host__ __device__ __forceinline__ int lds_byte(int r, int c) { const int st = (r >> 4) * 2 + (c >> 5), rr = r & 15, cc = c & 31, ob = rr * 64 + cc * 2; return st * 1024 + (ob ^ (((ob >> 9) & 1) << 5)); }
__host__ __device__ __forceinline__ void stage_rc(int b, int& R, int& C) { const int st = b / 1024, sb = b % 1024, swz = sb ^ (((sb >> 9) & 1) << 5); R = (st >> 1) * 16 + swz / 64; C = (st & 1) * 32 + (swz % 64) / 2; }
__host__ __device__ __forceinline__ int perm32(int rho) { const int n = rho >> 4, i = rho & 15; return 8 * (i >> 2) + 4 * n + (i & 3); }

struct Unit { int pm, pn; };
struct Gemm { const bf16_t* A; const bf16_t* Bt; int M, N, K; };

struct StaticOrder {
    int nM, nN, nwg, G, c;
    __host__ __device__ void init(int M, int N, int G_, int c_) { nM = M / BM; nN = N / BM; nwg = nM * nN; G = G_; c = c_; }
    __host__ __device__ bool next(int i, Unit& u) const {
        const long L = (long)i * G + c; if (L >= nwg) return false;
        int wgid = (int)L; { const int q = nwg / NXCD, r = nwg % NXCD, xcd = wgid % NXCD, off = wgid / NXCD; wgid = (xcd < r ? xcd * (q + 1) : r * (q + 1) + (xcd - r) * q) + off; }
        const int nig = WGM * nN, gid = wgid / nig, fm = gid * WGM, gsz = (nM - fm) < WGM ? (nM - fm) : WGM;
        u.pm = fm + ((wgid % nig) % gsz); u.pn = (wgid % nig) / gsz; return true;
    }
    __device__ __forceinline__ void a_ready(const Unit&) const {}
    __device__ __forceinline__ void done(const Unit&) const {}
};

__device__ __forceinline__ unsigned cvt_pk_bf16(float lo, float hi) { unsigned r; asm volatile("v_cvt_pk_bf16_f32 %0, %1, %2" : "=v"(r) : "v"(lo), "v"(hi)); return r; }

template <class Epi, class Sched, bool ALIGN_EPI = false, bool SP2 = false>
__device__ __forceinline__ void gemm_phase(PG8_LAS unsigned char* lds, const Gemm g, const Sched& S, const Epi& E) {
    int tid = threadIdx.x; asm volatile("" : "+v"(tid));
    const int wid = __builtin_amdgcn_readfirstlane(tid >> 6), lane = tid & 63, wr = wid >> 2, wc = wid & 3, fr = lane & 15, fq = lane >> 4;
    const int K = g.K, nt = K / BK;
    unsigned voffA[2], voffB[2];
#pragma unroll
    for (int i = 0; i < 2; ++i) { int R, C; stage_rc(tid * 16 + i * 8192, R, C); const int Rb = Epi::PERM ? ((R & ~31) + perm32(R & 31)) : R;
        voffA[i] = (unsigned)(R * K + C) * 2u; voffB[i] = (unsigned)(Rb * K + C) * 2u; }
    const size_t kstep = (size_t)(BK * 2);
    const size_t hstep = (size_t)HALF * K * 2;
    const size_t tstep = 2 * hstep;
    const unsigned ldsw = (unsigned)wid * 1024u;
    const int aoff = lds_byte(wr * 64 + fr, fq * 8), boff = lds_byte(wc * 32 + fr, fq * 8);
#define PG8_SA(b, h) (((b) * 2 + (h)) * HTB)
#define PG8_SB(b, h) ((4 + (b) * 2 + (h)) * HTB)
#define PG8_STAGE(bufoff, gbase, voff) do { _Pragma("unroll") for (int _i = 0; _i < 2; ++_i) \
        __builtin_amdgcn_global_load_lds((const unsigned*)((const char*)(gbase) + (voff)[_i]), (PG8_LAS unsigned*)(lds + (bufoff) + ldsw + _i * 8192), 16, 0, 0); } while (0)
#define PG8_LDA(dst, b, h) do { _Pragma("unroll") for (int m = 0; m < 4; ++m) _Pragma("unroll") for (int k = 0; k < 2; ++k) dst[m][k] = *(const PG8_LAS bf16x8*)(lds + PG8_SA(b, h) + aoff + m * 2048 + k * 1024); } while (0)
#define PG8_LDB(dst, b, h) do { _Pragma("unroll") for (int n = 0; n < 2; ++n) _Pragma("unroll") for (int k = 0; k < 2; ++k) dst[n][k] = *(const PG8_LAS bf16x8*)(lds + PG8_SB(b, h) + boff + n * 2048 + k * 1024); } while (0)
#define PG8_MMA(ai, bj, At, Bt) do { __builtin_amdgcn_s_setprio(1); _Pragma("unroll") for (int m = 0; m < 4; ++m) _Pragma("unroll") for (int n = 0; n < 2; ++n) _Pragma("unroll") for (int k = 0; k < 2; ++k) \
        acc[ai][bj][m][n] = __builtin_amdgcn_mfma_f32_16x16x32_bf16(Bt[n][k], At[m][k], acc[ai][bj][m][n], 0, 0, 0); __builtin_amdgcn_s_setprio(0); } while (0)
#define PG8_WAIT_V(n) asm volatile("s_waitcnt vmcnt(" #n ")" ::: "memory")
#define PG8_WAIT_L(n) asm volatile("s_waitcnt lgkmcnt(" #n ")" ::: "memory")
#define PG8_BAR __builtin_amdgcn_s_barrier()
#define PG8_SCHED __builtin_amdgcn_sched_barrier(0)
    Unit cur, nxt; int ui = 0;
    if (!S.next(0, cur)) return;
    f32x4 acc[2][2][4][2];
#pragma unroll
    for (int a = 0; a < 2; ++a)
#pragma unroll
        for (int b = 0; b < 2; ++b)
#pragma unroll
            for (int m = 0; m < 4; ++m)
#pragma unroll
                for (int n = 0; n < 2; ++n) acc[a][b][m][n] = (f32x4){0.f, 0.f, 0.f, 0.f};
    bf16x8 At[4][2], B0[2][2], B1[2][2];
    const char* cA = (const char*)g.A + (size_t)cur.pm * tstep; const char* cB = (const char*)g.Bt + (size_t)cur.pn * tstep;
    S.a_ready(cur);
    if constexpr (SP2) {
        PG8_STAGE(PG8_SB(0, 0), cB, voffB); PG8_STAGE(PG8_SB(0, 1), cB + hstep, voffB); PG8_STAGE(PG8_SA(0, 0), cA, voffA); PG8_STAGE(PG8_SA(0, 1), cA + hstep, voffA);
        if (wr == 1) PG8_BAR;
        PG8_WAIT_V(2); PG8_BAR;
        PG8_STAGE(PG8_SB(1, 0), cB + kstep, voffB); PG8_STAGE(PG8_SA(1, 0), cA + kstep, voffA); PG8_STAGE(PG8_SB(1, 1), cB + hstep + kstep, voffB);
        PG8_WAIT_V(6); PG8_BAR;
    } else {
        PG8_STAGE(PG8_SB(0, 0), cB, voffB); PG8_STAGE(PG8_SA(0, 0), cA, voffA); PG8_STAGE(PG8_SB(0, 1), cB + hstep, voffB); PG8_STAGE(PG8_SA(0, 1), cA + hstep, voffA);
        if (wr == 1) PG8_BAR;
        PG8_WAIT_V(4); PG8_BAR;
        PG8_STAGE(PG8_SB(1, 0), cB + kstep, voffB); PG8_STAGE(PG8_SA(1, 0), cA + kstep, voffA); PG8_STAGE(PG8_SB(1, 1), cB + hstep + kstep, voffB);
        PG8_WAIT_V(6); PG8_BAR;
    }
    for (;;) {
        const bool has_next = S.next(ui + 1, nxt);
        const char* nA = has_next ? (const char*)g.A + (size_t)nxt.pm * tstep : cA; const char* nB = has_next ? (const char*)g.Bt + (size_t)nxt.pn * tstep : cB;
        for (int t = 0; t < nt; t += 2) {
            const bool last = (t == nt - 2);
            const char* a1 = cA + (size_t)(t + 1) * kstep;
            const char* a2 = last ? nA : cA + (size_t)(t + 2) * kstep; const char* b2 = last ? nB : cB + (size_t)(t + 2) * kstep;
            const char* a3 = a2 + kstep; const char* b3 = b2 + kstep;
            if (last && has_next) S.a_ready(nxt);
            if constexpr (SP2) {
            PG8_LDB(B0, 0, 0); PG8_LDB(B1, 0, 1); PG8_SCHED; PG8_LDA(At, 0, 0); PG8_STAGE(PG8_SA(1, 1), a1 + hstep, voffA);
            PG8_WAIT_V(8); PG8_WAIT_L(0); PG8_BAR; PG8_MMA(0, 0, At, B0); PG8_MMA(0, 1, At, B1); PG8_BAR; PG8_SCHED;
            PG8_LDA(At, 0, 1); PG8_STAGE(PG8_SB(0, 0), b2, voffB); PG8_STAGE(PG8_SB(0, 1), b2 + hstep, voffB); PG8_STAGE(PG8_SA(0, 0), a2, voffA);
            PG8_WAIT_V(8); PG8_WAIT_L(0); PG8_BAR; PG8_MMA(1, 0, At, B0); PG8_MMA(1, 1, At, B1); PG8_BAR; PG8_SCHED;
            PG8_LDB(B0, 1, 0); PG8_LDB(B1, 1, 1); PG8_SCHED; PG8_LDA(At, 1, 0); PG8_STAGE(PG8_SA(0, 1), a2 + hstep, voffA);
            PG8_WAIT_V(8); PG8_WAIT_L(0); PG8_BAR; PG8_MMA(0, 0, At, B0); PG8_MMA(0, 1, At, B1); PG8_BAR; PG8_SCHED;
            PG8_LDA(At, 1, 1); PG8_STAGE(PG8_SB(1, 0), b3, voffB); PG8_STAGE(PG8_SB(1, 1), b3 + hstep, voffB); PG8_STAGE(PG8_SA(1, 0), a3, voffA);
            PG8_WAIT_V(8); PG8_WAIT_L(0); PG8_BAR; PG8_MMA(1, 0, At, B0); PG8_MMA(1, 1, At, B1); PG8_BAR; PG8_SCHED;
            } else {
            PG8_LDB(B0, 0, 0); PG8_SCHED; PG8_LDA(At, 0, 0); PG8_STAGE(PG8_SA(1, 1), a1 + hstep, voffA);
            PG8_WAIT_L(8); PG8_BAR; PG8_WAIT_L(0); PG8_MMA(0, 0, At, B0); PG8_BAR; PG8_SCHED;
            PG8_LDB(B1, 0, 1); PG8_STAGE(PG8_SB(0, 0), b2, voffB);
            PG8_BAR; PG8_WAIT_L(0); PG8_MMA(0, 1, At, B1); PG8_BAR;
            PG8_LDA(At, 0, 1); PG8_STAGE(PG8_SA(0, 0), a2, voffA);
            PG8_BAR; PG8_WAIT_L(0); PG8_MMA(1, 0, At, B0); PG8_BAR; PG8_SCHED;
            PG8_STAGE(PG8_SB(0, 1), b2 + hstep, voffB);
            PG8_WAIT_V(6); PG8_BAR; PG8_MMA(1, 1, At, B1); PG8_BAR;
            PG8_LDB(B0, 1, 0); PG8_SCHED; PG8_LDA(At, 1, 0); PG8_STAGE(PG8_SA(0, 1), a2 + hstep, voffA);
            PG8_WAIT_L(8); PG8_BAR; PG8_WAIT_L(0); PG8_MMA(0, 0, At, B0); PG8_BAR; PG8_SCHED;
            PG8_LDB(B1, 1, 1); PG8_STAGE(PG8_SB(1, 0), b3, voffB);
            PG8_BAR; PG8_WAIT_L(0); PG8_MMA(0, 1, At, B1); PG8_BAR;
            PG8_LDA(At, 1, 1); PG8_STAGE(PG8_SA(1, 0), a3, voffA);
            PG8_BAR; PG8_WAIT_L(0); PG8_MMA(1, 0, At, B0); PG8_BAR; PG8_SCHED;
            PG8_STAGE(PG8_SB(1, 1), b3 + hstep, voffB);
            PG8_WAIT_V(6); PG8_BAR; PG8_MMA(1, 1, At, B1); PG8_BAR;
            }
        }
        if constexpr (ALIGN_EPI) { if (wr == 0) PG8_BAR; }
        E(acc, cur, wr, wc, fr, fq); S.done(cur);
        if (!has_next) break;
#pragma unroll
        for (int a = 0; a < 2; ++a)
#pragma unroll
            for (int b = 0; b < 2; ++b)
#pragma unroll
                for (int m = 0; m < 4; ++m)
#pragma unroll
                    for (int n = 0; n < 2; ++n) acc[a][b][m][n] = (f32x4){0.f, 0.f, 0.f, 0.f};
        cur = nxt; cA = nA; cB = nB; ++ui;
        if constexpr (ALIGN_EPI) { if (wr == 1) PG8_BAR; }
    }
    PG8_WAIT_V(0);
    if constexpr (!ALIGN_EPI) { if (wr == 0) PG8_BAR; }
    PG8_BAR;
#undef PG8_SA
#undef PG8_SB
#undef PG8_STAGE
#undef PG8_LDA
#undef PG8_LDB
#undef PG8_MMA
#undef PG8_WAIT_V
#undef PG8_WAIT_L
#undef PG8_BAR
#undef PG8_SCHED
}
}

constexpr int NWAVES = 8;
constexpr int D = 2048, MCTX = 4096, MLAT = 16384, M = MCTX + MLAT, NL = 4;
constexpr int DA = 1024, NH = 16, DB = 1024, NG = 8, HB = 128;
constexpr int LW = 64, LAA = 64, LGT = 160;
constexpr int CSH = 3 * DA + LW + LAA + LGT;
constexpr int PIN = CSH + 2 * DB;
constexpr int PINP = 5632;
constexpr int DFF = 5632, NGU = 2 * DFF;
constexpr int MODW = 6 * D;
constexpr float RMS_EPS = 1e-6f, GN_EPS = 64.0f * 1e-5f, LN_EPS = 1e-5f;

constexpr size_t MiB = 1u << 20;
constexpr size_t WS_CTL = 0, CTL_ZERO_BYTES = 1 * MiB;
constexpr size_t WS_MOD = 1 * MiB;
constexpr size_t WS_W2T = 2 * MiB;
constexpr size_t WS_A2T = 3 * MiB;
constexpr size_t WS_G2T = 4 * MiB;
constexpr size_t WS_WSP = 6 * MiB;
constexpr size_t WS_BONUS = 7 * MiB;
constexpr size_t SZ_WIN = (size_t)PINP * D * 2, SZ_WOUT = (size_t)D * D * 2, SZ_WGU = (size_t)NGU * D * 2, SZ_WD = (size_t)D * DFF * 2;
constexpr size_t WS_WIN = 16 * MiB;
constexpr size_t WS_WOUT = WS_WIN + NL * SZ_WIN;
constexpr size_t WS_WGU = WS_WOUT + NL * SZ_WOUT;
constexpr size_t WS_WD = WS_WGU + NL * SZ_WGU;
constexpr size_t WS_H = WS_WD + NL * SZ_WD;
constexpr size_t WS_O = WS_H + (size_t)M * D * 2;
constexpr size_t WS_P = WS_O + (size_t)M * D * 2;
constexpr size_t WS_Y = WS_P;
constexpr size_t WS_PS = WS_P + (size_t)M * PINP * 2;
constexpr size_t SZ_T16 = (size_t)M * DA * 2, SZ_T32 = (size_t)M * DA * 4;
constexpr size_t WS_KK = WS_PS + (size_t)M * CSH * 2;
constexpr size_t WS_KD = WS_KK + SZ_T16;
constexpr size_t WS_BB = WS_KD + 2 * SZ_T16;
constexpr size_t WS_GATE = WS_BB + 2 * SZ_T16;
constexpr size_t WS_WDEC = WS_GATE + SZ_T16;
constexpr size_t WS_END1 = WS_WDEC + 2 * SZ_T32;
constexpr size_t WS_HID = WS_PS;
constexpr size_t WS_END = WS_END1 > WS_HID + (size_t)M * DFF * 2 ? WS_END1 : WS_HID + (size_t)M * DFF * 2;
static_assert((size_t)M * DA * 4 * 2 <= (size_t)M * PINP * 2, "Y fits in P");
constexpr int CW_BAR = 4096;

constexpr int RING_BYTES = 131072;
constexpr int LDSCTL_OFF = RING_BYTES, MISC_OFF = LDSCTL_OFF + 320;
constexpr int LDS_BYTES = 147456;

#define GAS __attribute__((address_space(1)))
#define LAS __attribute__((address_space(3)))
typedef unsigned short bf16;
typedef float f32x4 __attribute__((ext_vector_type(4)));
typedef float f32x2 __attribute__((ext_vector_type(2)));
typedef short bf16x8 __attribute__((ext_vector_type(8)));
typedef unsigned u32x4 __attribute__((ext_vector_type(4)));
typedef unsigned u32x2 __attribute__((ext_vector_type(2)));
#define LDS_WAIT() asm volatile("s_waitcnt lgkmcnt(0)" ::: "memory")
#define VM_WAIT() asm volatile("s_waitcnt vmcnt(0)" ::: "memory")
__device__ __forceinline__ unsigned f2bf(float f) { unsigned u = __builtin_bit_cast(unsigned, f); return (u + 0x7fffu + ((u >> 16) & 1u)) >> 16; }
__device__ __forceinline__ unsigned pk2(float lo, float hi) { return f2bf(lo) | (f2bf(hi) << 16); }
__device__ __forceinline__ float bf2f(unsigned short b) { return __uint_as_float(((unsigned)b) << 16); }
__device__ __forceinline__ void unpack8(const u32x4 q, float (&f)[8]) {
    f[0] = __uint_as_float(q.x << 16); f[1] = __uint_as_float(q.x & 0xffff0000u); f[2] = __uint_as_float(q.y << 16); f[3] = __uint_as_float(q.y & 0xffff0000u);
    f[4] = __uint_as_float(q.z << 16); f[5] = __uint_as_float(q.z & 0xffff0000u); f[6] = __uint_as_float(q.w << 16); f[7] = __uint_as_float(q.w & 0xffff0000u); }
__device__ __forceinline__ u32x4 pack8(const float (&f)[8]) { u32x4 o; o.x = pk2(f[0], f[1]); o.y = pk2(f[2], f[3]); o.z = pk2(f[4], f[5]); o.w = pk2(f[6], f[7]); return o; }
__device__ __forceinline__ float fsigmoid(float x) { return __builtin_amdgcn_rcpf(1.0f + __expf(-x)); }
__device__ __forceinline__ float ftanh(float x) { return 1.0f - 2.0f * __builtin_amdgcn_rcpf(1.0f + __expf(2.0f * x)); }
__device__ __forceinline__ float gelu_tanh(float x) { const float u = 1.5957691216057308f * (x + 0.044715f * x * x * x); return x * __builtin_amdgcn_rcpf(1.0f + __expf(-u)); }
__device__ __forceinline__ float wave_sum(float v) {
#pragma unroll
    for (int o = 1; o < 64; o <<= 1) v += __shfl_xor(v, o);
    return v;
}


#define PH_LOCALS(F) int tid = (F).tid; asm volatile("" : "+v"(tid)); const int lane = tid & 63, wave = __builtin_amdgcn_readfirstlane(tid >> 6); \
    int bx = (F).bx, G = (F).G; asm volatile("" : "+s"(bx), "+s"(G)); (void)lane; (void)wave;
#define PH_LAYER(l) asm volatile("" : "+s"(l))

#define XB_TMO      128
#define XB_XCNT(j)  (256  + 64 * (j))
#define XB_XSUB(j)  (1280 + 64 * (j))
#define XB_XGEN(j)  (2304 + 64 * (j))
#define XB_TOP      3328
#define XB_TOPGEN   3392
#define XCD_BAR_WORDS 3456
#define XB_SPIN_CAP (1u << 18)

__device__ __forceinline__ unsigned xb_ld(unsigned* p)              { return __hip_atomic_load(p, __ATOMIC_RELAXED, __HIP_MEMORY_SCOPE_AGENT); }
__device__ __forceinline__ unsigned xb_add(unsigned* p, unsigned v) { return __hip_atomic_fetch_add(p, v, __ATOMIC_RELAXED, __HIP_MEMORY_SCOPE_AGENT); }
__device__ __forceinline__ unsigned xb_xcc_id() { return (unsigned)__builtin_amdgcn_s_getreg((3 << 11) | 20) & 0xFu; }
#define XB_SPIN(cond, bar) do { unsigned _sp = 0; while (cond) { __builtin_amdgcn_s_sleep(1); \
    if ((++_sp & 255u) == 0u) { if (xb_ld(&(bar)[XB_TMO])) break; if (_sp > XB_SPIN_CAP) { atomicAdd(&(bar)[XB_TMO], 1u); break; } } } } while (0)

struct XcdBarrier {
    unsigned* bar; unsigned x;
    volatile LAS unsigned* st;
};
__device__ __forceinline__ XcdBarrier xcd_barrier_post(unsigned* bar, volatile LAS unsigned* st) {
    XcdBarrier b; b.bar = bar; b.x = xb_xcc_id(); b.st = st;
    if (threadIdx.x == 0) (void)xb_add(&bar[XB_XCNT(b.x)], 1u);
    return b;
}
__device__ __forceinline__ void xcd_barrier_complete(unsigned* bar, unsigned x, unsigned& nloc, unsigned& nx) {
    const unsigned G = gridDim.x * gridDim.y * gridDim.z;
    unsigned sum, cnt, mine, sp = 0u;
    for (;;) {
        sum = 0u; cnt = 0u; mine = 0u;
#pragma unroll
        for (unsigned j = 0; j < 16; ++j) { const unsigned c = xb_ld(&bar[XB_XCNT(j)]); sum += c; cnt += (c > 0u) ? 1u : 0u; mine = (j == x) ? c : mine; }
        if (sum == G) break;
        __builtin_amdgcn_s_sleep(1);
        if ((++sp & 255u) == 0u) { if (xb_ld(&bar[XB_TMO])) break; if (sp > XB_SPIN_CAP) { atomicAdd(&bar[XB_TMO], 1u); break; } }
    }
    nloc = mine > 0u ? mine : 1u; nx = cnt > 0u ? cnt : 1u;
}
__device__ __forceinline__ void xcd_barrier(const XcdBarrier& b) {
    asm volatile("s_waitcnt vmcnt(0)" ::: "memory");
    __syncthreads();
    if (threadIdx.x == 0) {
        unsigned* bar = b.bar;
        __builtin_amdgcn_s_waitcnt(0);
        unsigned nloc = b.st[0], nx = b.st[1];
        if (nloc == 0u) { xcd_barrier_complete(bar, b.x, nloc, nx); b.st[0] = nloc; b.st[1] = nx; }
        const unsigned old = xb_add(&bar[XB_XSUB(b.x)], 1u);
        const unsigned gen = old / nloc;
        if (old + 1u == (gen + 1u) * nloc) {
            __builtin_amdgcn_fence(__ATOMIC_RELEASE, "agent");
            asm volatile("s_waitcnt vmcnt(0)" ::: "memory");
            const unsigned og = xb_add(&bar[XB_TOP], 1u);
            const unsigned tg = og / nx;
            if (og + 1u == (tg + 1u) * nx) xb_add(&bar[XB_TOPGEN], 1u);
            else XB_SPIN(xb_ld(&bar[XB_TOPGEN]) == tg, bar);
            __builtin_amdgcn_fence(__ATOMIC_ACQUIRE, "agent");
            xb_add(&bar[XB_XGEN(b.x)], 1u);
            asm volatile("s_waitcnt vmcnt(0)" ::: "memory");
        } else {
            XB_SPIN(xb_ld(&bar[XB_XGEN(b.x)]) == gen, bar);
            __builtin_amdgcn_fence(__ATOMIC_ACQUIRE, "agent");
            asm volatile("s_waitcnt vmcnt(0)" ::: "memory");
        }
    }
    __syncthreads();
}

struct Args {
    const float* in[30];
    float* out; unsigned char* ws;
    int ph_lo, ph_hi, li, pad;
};
enum { I_XP = 0, I_XS, I_STATE, I_C, I_CCTX, I_WMOD, I_BMOD, I_N1G, I_WIN, I_MU, I_W0, I_W2, I_A0, I_A2, I_G2, I_KK, I_KA, I_RK, I_GNW, I_GNB, I_LNG, I_LNB, I_WSP, I_BSP, I_WOUT, I_N2G, I_WG, I_WU, I_WD, I_FNG };

struct Frame {
    LAS unsigned char* lds;
    int tid, lane, wave, G, bx;
    const float* const* in;
    float* out; unsigned char* ws;
};

struct EpiP {
    static constexpr bool PERM = true, AFTER_DRAIN = false;
    bf16* O; int ldc; int gelu_from;
    __device__ __forceinline__ void operator()(const f32x4 (&acc)[2][2][4][2], const pg8::Unit& u, int wr, int wc, int fr, int fq) const {
        const int row0 = u.pm * 256 + wr * 64 + fr, col0 = u.pn * 256 + wc * 32 + 8 * fq;
#pragma unroll
        for (int ai = 0; ai < 2; ++ai)
#pragma unroll
            for (int m = 0; m < 4; ++m) { bf16* rowp = O + (size_t)(row0 + ai * 128 + m * 16) * ldc + col0;
#pragma unroll
                for (int bj = 0; bj < 2; ++bj) { f32x4 v0 = acc[ai][bj][m][0], v1 = acc[ai][bj][m][1];
                    if (col0 + bj * 128 >= gelu_from) {
#pragma unroll
                        for (int j = 0; j < 4; ++j) { v0[j] = gelu_tanh(v0[j]); v1[j] = gelu_tanh(v1[j]); } }
                    u32x4 w; w.x = pg8::cvt_pk_bf16(v0[0], v0[1]); w.y = pg8::cvt_pk_bf16(v0[2], v0[3]); w.z = pg8::cvt_pk_bf16(v1[0], v1[1]); w.w = pg8::cvt_pk_bf16(v1[2], v1[3]);
                    *(u32x4*)(rowp + bj * 128) = w; } }
    }
};
struct EpiRes {
    static constexpr bool PERM = false, AFTER_DRAIN = false;
    const float* xlo; const float* xhi; float* xout; const float* modl; int goff;
    __device__ __forceinline__ void operator()(const f32x4 (&acc)[2][2][4][2], const pg8::Unit& u, int wr, int wc, int fr, int fq) const {
        const int pm = u.pm; const int midx = pm < 16 ? 0 : 1 + ((pm - 16) >> 4);
        const float* gv = modl + (size_t)midx * MODW + goff;
        const float* base = pm < 16 ? xlo + (size_t)pm * 256 * D : xhi + (size_t)(pm - 16) * 256 * D;
        float* ob = xout + (size_t)pm * 256 * D;
        const int col0 = u.pn * 256 + wc * 32 + 4 * fq;
        f32x4 gvv[2][2];
#pragma unroll
        for (int bj = 0; bj < 2; ++bj)
#pragma unroll
            for (int n = 0; n < 2; ++n) gvv[bj][n] = *(const f32x4*)(gv + col0 + bj * 128 + n * 16);
#pragma unroll
        for (int ai = 0; ai < 2; ++ai)
#pragma unroll
            for (int m = 0; m < 4; ++m) { const size_t off = (size_t)(ai * 128 + wr * 64 + m * 16 + fr) * D + col0;
#pragma unroll
                for (int bj = 0; bj < 2; ++bj)
#pragma unroll
                    for (int n = 0; n < 2; ++n) { const f32x4 xo = *(const f32x4*)(base + off + bj * 128 + n * 16);
                        *(f32x4*)(ob + off + bj * 128 + n * 16) = xo + gvv[bj][n] * acc[ai][bj][m][n]; }
                if (m & 1) asm volatile("" ::: "memory"); }
    }
};
struct EpiSwi {
    static constexpr bool PERM = true, AFTER_DRAIN = false;
    bf16* O; int ldc;
    __device__ __forceinline__ void operator()(const f32x4 (&acc)[2][2][4][2], const pg8::Unit& u, int wr, int wc, int fr, int fq) const {
        const int row0 = u.pm * 256 + wr * 64 + fr, col0 = u.pn * 128 + wc * 32 + 8 * fq;
#pragma unroll
        for (int ai = 0; ai < 2; ++ai)
#pragma unroll
            for (int m = 0; m < 4; ++m) { bf16* rowp = O + (size_t)(row0 + ai * 128 + m * 16) * ldc + col0;
                float h[8];
#pragma unroll
                for (int n = 0; n < 2; ++n)
#pragma unroll
                    for (int j = 0; j < 4; ++j) { const float gt = acc[ai][0][m][n][j], up = acc[ai][1][m][n][j]; h[n * 4 + j] = gt * fsigmoid(gt) * up; }
                u32x4 w; w.x = pg8::cvt_pk_bf16(h[0], h[1]); w.y = pg8::cvt_pk_bf16(h[2], h[3]); w.z = pg8::cvt_pk_bf16(h[4], h[5]); w.w = pg8::cvt_pk_bf16(h[6], h[7]);
                *(u32x4*)rowp = w; }
    }
};

template <int MAP>
__device__ __forceinline__ void tr_item(const float* W, int K, int N, bf16* WT, LAS float* scr, int item, int lane) {
    const int nblk = N / 32, kb = item / nblk, nb = item % nblk, k0 = 64 * kb, n0 = 32 * nb;
#pragma unroll 8
    for (int i = 0; i < 32; ++i) { const int kk = 2 * i + (lane >> 5); scr[kk * 33 + (lane & 31)] = W[(size_t)(k0 + kk) * N + n0 + (lane & 31)]; }
    LDS_WAIT(); asm volatile("" ::: "memory");
    const int c = lane & 7;
#pragma unroll
    for (int j = 0; j < 4; ++j) { const int n = (lane >> 3) + 8 * j; const LAS float* s = scr + (8 * c) * 33 + n;
        u32x4 o; o.x = pk2(s[0 * 33], s[1 * 33]); o.y = pk2(s[2 * 33], s[3 * 33]); o.z = pk2(s[4 * 33], s[5 * 33]); o.w = pk2(s[6 * 33], s[7 * 33]);
        const int nn = n0 + n; const int orow = MAP == 0 ? nn : (256 * (nn >> 7) + (nn & 127) + (MAP == 2 ? 128 : 0));
        *(u32x4*)(WT + (size_t)orow * K + k0 + 8 * c) = o; }
    LDS_WAIT(); asm volatile("" ::: "memory");
}
__device__ __forceinline__ void p0_prologue(Frame& F) {
    PH_LOCALS(F);
    LAS float* scr = (LAS float*)(F.lds + wave * 16384);
    const int gw = bx * NWAVES + wave, NGW = G * NWAVES;
    constexpr int I_IN = (D / 64) * (PIN / 32), I_OUT = (D / 64) * (D / 32), I_GU = (D / 64) * (DFF / 32), I_DN = (DFF / 64) * (D / 32);
    constexpr int PL = I_IN + I_OUT + 2 * I_GU + I_DN;
    for (int it = gw; it < NL * PL; it += NGW) {
        const int l = it / PL; int r = it % PL;
        if (r < I_IN) { tr_item<0>(F.in[I_WIN] + (size_t)l * D * PIN, D, PIN, (bf16*)(F.ws + WS_WIN + l * SZ_WIN), scr, r, lane); continue; } r -= I_IN;
        if (r < I_OUT) { tr_item<0>(F.in[I_WOUT] + (size_t)l * D * D, D, D, (bf16*)(F.ws + WS_WOUT + l * SZ_WOUT), scr, r, lane); continue; } r -= I_OUT;
        if (r < I_GU) { tr_item<1>(F.in[I_WG] + (size_t)l * D * DFF, D, DFF, (bf16*)(F.ws + WS_WGU + l * SZ_WGU), scr, r, lane); continue; } r -= I_GU;
        if (r < I_GU) { tr_item<2>(F.in[I_WU] + (size_t)l * D * DFF, D, DFF, (bf16*)(F.ws + WS_WGU + l * SZ_WGU), scr, r, lane); continue; } r -= I_GU;
        tr_item<0>(F.in[I_WD] + (size_t)l * DFF * D, DFF, D, (bf16*)(F.ws + WS_WD + l * SZ_WD), scr, r, lane);
    }
    const int gt = bx * 512 + tid, NGT = G * 512;
    { constexpr int PADV = (PINP - PIN) * D * 2 / 16;
      for (int i = gt; i < NL * PADV; i += NGT) { const int l = i / PADV, r = i % PADV; ((u32x4*)(F.ws + WS_WIN + l * SZ_WIN + (size_t)PIN * D * 2))[r] = (u32x4){0u, 0u, 0u, 0u}; } }
    { bf16* w2t = (bf16*)(F.ws + WS_W2T); bf16* a2t = (bf16*)(F.ws + WS_A2T); bf16* g2t = (bf16*)(F.ws + WS_G2T); bf16* wsp = (bf16*)(F.ws + WS_WSP);
      for (int i = gt; i < NL * 2 * 1024 * 64; i += NGT) { const int k = i & 63, n = (i >> 6) & 1023, ld = i >> 16;
          w2t[i] = (bf16)f2bf(F.in[I_W2][((size_t)ld * 64 + k) * 1024 + n]); a2t[i] = (bf16)f2bf(F.in[I_A2][((size_t)ld * 64 + k) * 1024 + n]); }
      for (int i = gt; i < NL * 1024 * 160; i += NGT) { const int k = i % 160, n = (i / 160) & 1023, l = i / (160 * 1024);
          g2t[i] = (bf16)f2bf(F.in[I_G2][((size_t)l * 160 + k) * 1024 + n]); }
      for (int i = gt; i < NL * 8 * 128 * 128; i += NGT) wsp[i] = (bf16)f2bf(F.in[I_WSP][i]); }
    __syncthreads();
    { LAS float* sv = (LAS float*)F.lds;
      LAS float* red = (LAS float*)(F.lds + 40960);
      for (int i = tid; i < 5 * D; i += 512) { const int r = i / D, k = i % D; const float c = r == 0 ? F.in[I_CCTX][k] : F.in[I_C][(r - 1) * D + k]; sv[i] = c * fsigmoid(c); }
      __syncthreads();
      float* mod = (float*)(F.ws + WS_MOD);
      const int c4 = tid & 15, kg = tid >> 4;
      for (int item = bx; item < NL * (MODW / 64); item += G) {
          const int l = item / (MODW / 64), n0 = (item % (MODW / 64)) * 64;
          const float* W = F.in[I_WMOD] + (size_t)l * D * MODW + n0 + 4 * c4;
          f32x4 a[5];
#pragma unroll
          for (int r = 0; r < 5; ++r) a[r] = (f32x4){0.f, 0.f, 0.f, 0.f};
#pragma unroll 4
          for (int i = 0; i < 64; ++i) { const int k = i * 32 + kg; const f32x4 w = *(const f32x4*)(W + (size_t)k * MODW);
#pragma unroll
              for (int r = 0; r < 5; ++r) a[r] += w * sv[r * D + k]; }
#pragma unroll
          for (int r = 0; r < 5; ++r) *(LAS f32x4*)(red + (kg * 5 + r) * 64 + 4 * c4) = a[r];
          __syncthreads();
          if (tid < 320) { const int r = tid >> 6, n = tid & 63; float s = 0.f;
#pragma unroll 8
              for (int g = 0; g < 32; ++g) s += red[(g * 5 + r) * 64 + n];
              mod[((size_t)l * 5 + r) * MODW + n0 + n] = s + F.in[I_BMOD][(size_t)l * MODW + n0 + n]; }
          __syncthreads();
      } }
}

__device__ __forceinline__ void p_adaln(Frame& F, int l, int which, const float* xlo, const float* xhi) {
    PH_LOCALS(F); PH_LAYER(l);
    const int gw = bx * NWAVES + wave, NGW = G * NWAVES;
    const float* ng = (which == 0 ? F.in[I_N1G] : F.in[I_N2G]) + (size_t)l * D;
    const int shoff = which == 0 ? 0 : 3 * D, scoff = shoff + D;
    const float* mod = (const float*)(F.ws + WS_MOD);
    bf16* H = (bf16*)(F.ws + WS_H);
    for (int row = gw; row < M; row += NGW) {
        const float* xr = row < MCTX ? xlo + (size_t)row * D : xhi + (size_t)(row - MCTX) * D;
        const int midx = row < MCTX ? 0 : 1 + ((row - MCTX) >> 12);
        const float* md = mod + ((size_t)l * 5 + midx) * MODW;
        f32x4 v[8]; float ss = 0.f;
#pragma unroll
        for (int j = 0; j < 8; ++j) { v[j] = *(const f32x4*)(xr + 4 * lane + 256 * j); ss += (v[j].x * v[j].x + v[j].y * v[j].y) + (v[j].z * v[j].z + v[j].w * v[j].w); }
        const float rstd = 1.0f / sqrtf(wave_sum(ss) * (1.0f / D) + RMS_EPS);
#pragma unroll
        for (int j = 0; j < 8; ++j) { const int c = 4 * lane + 256 * j;
            const f32x4 g4 = *(const f32x4*)(ng + c), sc = *(const f32x4*)(md + scoff + c), sh = *(const f32x4*)(md + shoff + c);
            const f32x4 o = v[j] * rstd * g4 * (sc + 1.0f) + sh;
            u32x2 w; w.x = pk2(o.x, o.y); w.y = pk2(o.z, o.w);
            *(u32x2*)(H + (size_t)row * D + c) = w; }
    }
}

__device__ __forceinline__ void load_shifted8(const bf16* P, const float* mu, int row, int col, float (&o)[8]) {
    float g[8]; unpack8(*(const u32x4*)(P + (size_t)row * PINP + col), g);
    float a[8];
#pragma unroll
    for (int j = 0; j < 8; ++j) a[j] = g[j];
    int nrow[4]; bool has[4]; int nn;
    if (row < MCTX) { const int t = row & 255; nn = 2; nrow[0] = row - 1; has[0] = t > 0; nrow[1] = row + 1; has[1] = t < 255; nrow[2] = row; has[2] = false; nrow[3] = row; has[3] = false; }
    else { const int t = (row - MCTX) & 4095, gc = t & 63, gr = t >> 6; nn = 4;
        nrow[0] = row - 1; has[0] = gc > 0; nrow[1] = row + 1; has[1] = gc < 63; nrow[2] = row - 64; has[2] = gr > 0; nrow[3] = row + 64; has[3] = gr < 63; }
#pragma unroll
    for (int q = 0; q < 4; ++q) {
        if (q < nn) {
            float nb[8];
            if (has[q]) unpack8(*(const u32x4*)(P + (size_t)nrow[q] * PINP + col), nb);
            else {
#pragma unroll
                for (int j = 0; j < 8; ++j) nb[j] = 0.f; }
            const f32x4 m0 = *(const f32x4*)(mu + q * CSH + col), m1 = *(const f32x4*)(mu + q * CSH + col + 4);
#pragma unroll
            for (int j = 0; j < 4; ++j) { a[j] += m0[j] * (nb[j] - g[j]); a[4 + j] += m1[j] * (nb[4 + j] - g[4 + j]); }
        }
    }
#pragma unroll
    for (int j = 0; j < 8; ++j) o[j] = a[j];
}
__device__ __forceinline__ void p_shift(Frame& F, int l) {
    PH_LOCALS(F); PH_LAYER(l);
    const bf16* P = (const bf16*)(F.ws + WS_P); bf16* PS = (bf16*)(F.ws + WS_PS);
    const float* mu = F.in[I_MU] + (size_t)l * 4 * CSH;
    const int gt = bx * 512 + tid, NGT = G * 512;
    constexpr int CG = CSH / 8;
    for (int i = gt; i < M * CG; i += NGT) { const int row = i / CG, cg = i % CG;
        float o[8]; load_shifted8(P, mu, row, cg * 8, o);
        *(u32x4*)(PS + (size_t)row * CSH + cg * 8) = pack8(o); }
}

constexpr int XS64 = 72, XS160 = 168;
constexpr int TST = 65;
__device__ __forceinline__ void p_prep(Frame& F, int l) {
    PH_LOCALS(F); PH_LAYER(l);
    const bf16* PS = (const bf16*)(F.ws + WS_PS);
    LAS bf16* XW = (LAS bf16*)F.lds; LAS bf16* XA = XW + 64 * XS64; LAS bf16* XG = XA + 64 * XS64;
    LAS float* T = (LAS float*)(F.lds + 40960);
    const bf16* w2t = (const bf16*)(F.ws + WS_W2T) + (size_t)l * 2 * 1024 * 64;
    const bf16* a2t = (const bf16*)(F.ws + WS_A2T) + (size_t)l * 2 * 1024 * 64;
    const bf16* g2t = (const bf16*)(F.ws + WS_G2T) + (size_t)l * 1024 * 160;
    bf16* KK = (bf16*)(F.ws + WS_KK); bf16* KD = (bf16*)(F.ws + WS_KD); bf16* BB = (bf16*)(F.ws + WS_BB); bf16* GATE = (bf16*)(F.ws + WS_GATE);
    float* WDEC = (float*)(F.ws + WS_WDEC); float* BONUS = (float*)(F.ws + WS_BONUS);
    const int rb = wave & 3, ch = wave >> 2, fr = lane & 15, fq = lane >> 4;
    for (int item = bx; item < (M / 64) * NH; item += G) {
        const int ci = item >> 4, h = item & 15, R0 = ci * 64;
        for (int idx = tid; idx < 64 * 36; idx += 512) { const int r = idx / 36, cg = idx % 36;
            float f[8]; unpack8(*(const u32x4*)(PS + (size_t)(R0 + r) * CSH + 3 * DA + 8 * cg), f);
            if (cg < 8) {
#pragma unroll
                for (int j = 0; j < 8; ++j) f[j] = ftanh(f[j]);
                *(LAS u32x4*)(XW + r * XS64 + 8 * cg) = pack8(f); }
            else if (cg < 16) *(LAS u32x4*)(XA + r * XS64 + 8 * (cg - 8)) = pack8(f);
            else {
#pragma unroll
                for (int j = 0; j < 8; ++j) f[j] = fsigmoid(f[j]);
                *(LAS u32x4*)(XG + r * XS160 + 8 * (cg - 16)) = pack8(f); } }
        __syncthreads();
#pragma unroll
        for (int ctl = 0; ctl < 2; ++ctl) {
            const int ct = ch * 2 + ctl; const int n = 64 * h + 16 * ct + fr;
            f32x4 acc[5];
#pragma unroll
            for (int q = 0; q < 5; ++q) acc[q] = (f32x4){0.f, 0.f, 0.f, 0.f};
#pragma unroll
            for (int ks = 0; ks < 2; ++ks) {
                const bf16x8 aw = *(const LAS bf16x8*)(XW + (16 * rb + fr) * XS64 + 8 * fq + 32 * ks);
                const bf16x8 aa = *(const LAS bf16x8*)(XA + (16 * rb + fr) * XS64 + 8 * fq + 32 * ks);
#pragma unroll
                for (int d = 0; d < 2; ++d) {
                    const bf16x8 bw = *(const bf16x8*)(w2t + ((size_t)d * 1024 + n) * 64 + 8 * fq + 32 * ks);
                    const bf16x8 ba = *(const bf16x8*)(a2t + ((size_t)d * 1024 + n) * 64 + 8 * fq + 32 * ks);
                    acc[d] = __builtin_amdgcn_mfma_f32_16x16x32_bf16(aw, bw, acc[d], 0, 0, 0);
                    acc[2 + d] = __builtin_amdgcn_mfma_f32_16x16x32_bf16(aa, ba, acc[2 + d], 0, 0, 0);
                }
            }
#pragma unroll
            for (int ks = 0; ks < 5; ++ks) {
                const bf16x8 ag = *(const LAS bf16x8*)(XG + (16 * rb + fr) * XS160 + 8 * fq + 32 * ks);
                const bf16x8 bg = *(const bf16x8*)(g2t + (size_t)n * 160 + 8 * fq + 32 * ks);
                acc[4] = __builtin_amdgcn_mfma_f32_16x16x32_bf16(ag, bg, acc[4], 0, 0, 0);
            }
            const int cl = 16 * ct + fr;
#pragma unroll
            for (int d = 0; d < 2; ++d) {
                const float w0v = F.in[I_W0][((size_t)l * 2 + d) * DA + 64 * h + cl], a0v = F.in[I_A0][((size_t)l * 2 + d) * DA + 64 * h + cl];
#pragma unroll
                for (int i = 0; i < 4; ++i) { const int r = 16 * rb + 4 * fq + i;
                    T[(d * 64 + r) * TST + cl] = __expf(-0.6065306597126334f * fsigmoid(w0v + acc[d][i]));
                    T[((2 + d) * 64 + r) * TST + cl] = fsigmoid(a0v + acc[2 + d][i]); }
            }
#pragma unroll
            for (int i = 0; i < 4; ++i) T[(4 * 64 + 16 * rb + 4 * fq + i) * TST + cl] = acc[4][i];
        }
        __syncthreads();
        { const int tk = tid >> 3, c8 = (tid & 7) * 8, row = R0 + tk, chn = 64 * h + c8;
          float r[8], k[8];
          unpack8(*(const u32x4*)(PS + (size_t)row * CSH + chn), r);
          unpack8(*(const u32x4*)(PS + (size_t)row * CSH + DA + chn), k);
          float kk[8], ss = 0.f;
#pragma unroll
          for (int j = 0; j < 8; ++j) { kk[j] = k[j] * F.in[I_KK][(size_t)l * DA + chn + j]; ss += kk[j] * kk[j]; }
          ss += __shfl_xor(ss, 1); ss += __shfl_xor(ss, 2); ss += __shfl_xor(ss, 4);
          const float rn = 1.0f / sqrtf(fmaxf(ss, 1e-24f));
#pragma unroll
          for (int j = 0; j < 8; ++j) kk[j] *= rn;
          *(u32x4*)(KK + (size_t)row * DA + chn) = pack8(kk);
          float bon = 0.f;
#pragma unroll
          for (int d = 0; d < 2; ++d) {
              float kd[8], bb[8], dec[8];
#pragma unroll
              for (int j = 0; j < 8; ++j) { const float al = T[((2 + d) * 64 + tk) * TST + c8 + j]; dec[j] = T[(d * 64 + tk) * TST + c8 + j];
                  kd[j] = k[j] * (1.0f + (al - 1.0f) * F.in[I_KA][(size_t)l * DA + chn + j]); bb[j] = kk[j] * al;
                  bon += r[j] * kd[j] * F.in[I_RK][(size_t)l * DA + chn + j]; }
              *(u32x4*)(KD + (size_t)d * M * DA + (size_t)row * DA + chn) = pack8(kd);
              *(u32x4*)(BB + (size_t)d * M * DA + (size_t)row * DA + chn) = pack8(bb);
              float* wp = WDEC + (size_t)d * M * DA + (size_t)row * DA + chn;
              *(f32x4*)wp = (f32x4){dec[0], dec[1], dec[2], dec[3]}; *(f32x4*)(wp + 4) = (f32x4){dec[4], dec[5], dec[6], dec[7]};
          }
          bon += __shfl_xor(bon, 1); bon += __shfl_xor(bon, 2); bon += __shfl_xor(bon, 4);
          if ((tid & 7) == 0) BONUS[(size_t)row * NH + h] = bon;
          float gt[8];
#pragma unroll
          for (int j = 0; j < 8; ++j) gt[j] = T[(4 * 64 + tk) * TST + c8 + j];
          *(u32x4*)(GATE + (size_t)row * DA + chn) = pack8(gt);
        }
        __syncthreads();
    }
}

constexpr int VTS = 136;
__device__ __forceinline__ void p_gmlp(Frame& F, int l) {
    PH_LOCALS(F); PH_LAYER(l);
    const bf16* P = (const bf16*)(F.ws + WS_P); bf16* O = (bf16*)(F.ws + WS_O);
    const bf16* wsp = (const bf16*)(F.ws + WS_WSP) + (size_t)l * 8 * 128 * 128;
    LAS bf16* VT = (LAS bf16*)F.lds;
    const int fr = lane & 15, fq = lane >> 4;
    for (int item = bx; item < (M / 128) * NG; item += G) {
        const int cb = item >> 3, g = item & 7, R0 = cb * 128;
        { const int j = tid >> 2, q = tid & 3;
          const bf16* src = P + (size_t)(R0 + j) * PINP + CSH + DB + 128 * g + 32 * q;
          float v[32];
#pragma unroll
          for (int i = 0; i < 4; ++i) { float f[8]; unpack8(*(const u32x4*)(src + 8 * i), f);
#pragma unroll
              for (int jj = 0; jj < 8; ++jj) v[8 * i + jj] = f[jj]; }
          float s = 0.f;
#pragma unroll
          for (int i = 0; i < 32; ++i) s += v[i];
          s += __shfl_xor(s, 1); s += __shfl_xor(s, 2);
          const float mean = s * (1.0f / 128.0f); float qq = 0.f;
#pragma unroll
          for (int i = 0; i < 32; ++i) { v[i] -= mean; qq += v[i] * v[i]; }
          qq += __shfl_xor(qq, 1); qq += __shfl_xor(qq, 2);
          const float rstd = 1.0f / sqrtf(qq * (1.0f / 128.0f) + LN_EPS);
          const float* lg = F.in[I_LNG] + ((size_t)l * 8 + g) * 128 + 32 * q; const float* lb = F.in[I_LNB] + ((size_t)l * 8 + g) * 128 + 32 * q;
#pragma unroll
          for (int i = 0; i < 32; ++i) VT[(32 * q + i) * VTS + j] = (bf16)f2bf(v[i] * rstd * lg[i] + lb[i]);
        }
        __syncthreads();
        f32x4 acc[8];
#pragma unroll
        for (int dt = 0; dt < 8; ++dt) acc[dt] = (f32x4){0.f, 0.f, 0.f, 0.f};
        const bf16* wa = wsp + ((size_t)g * 128 + 16 * wave + fr) * 128 + 8 * fq;
#pragma unroll
        for (int ks = 0; ks < 4; ++ks) {
            const bf16x8 a = *(const bf16x8*)(wa + 32 * ks);
#pragma unroll
            for (int dt = 0; dt < 8; ++dt) { const bf16x8 b = *(const LAS bf16x8*)(VT + (16 * dt + fr) * VTS + 8 * fq + 32 * ks);
                acc[dt] = __builtin_amdgcn_mfma_f32_16x16x32_bf16(a, b, acc[dt], 0, 0, 0); }
        }
#pragma unroll
        for (int r = 0; r < 4; ++r) { const int i = 16 * wave + 4 * fq + r; const float bs = F.in[I_BSP][((size_t)l * 8 + g) * 128 + i];
            const bf16* up = P + (size_t)(R0 + i) * PINP + CSH + 128 * g + fr; bf16* op = O + (size_t)(R0 + i) * D + DA + 128 * g + fr;
#pragma unroll
            for (int dt = 0; dt < 8; ++dt) op[16 * dt] = (bf16)f2bf(bf2f(up[16 * dt]) * (acc[dt][r] + bs)); }
        __syncthreads();
    }
}

__device__ __forceinline__ void p_scan(Frame& F, int l) {
    PH_LOCALS(F); PH_LAYER(l);
    const bf16* PS = (const bf16*)(F.ws + WS_PS); const bf16* KK = (const bf16*)(F.ws + WS_KK);
    LAS float* sb = (LAS float*)(F.lds + wave * 2048);
    for (int c = bx + G * wave; c < 640; c += G * NWAVES) {
        int b, h, d, rowbase, T; const bool lat = c < 128;
        if (lat) { b = c >> 5; h = (c >> 1) & 15; d = c & 1; rowbase = MCTX + b * 4096; T = 4096; }
        else { const int cc = c - 128; b = cc >> 5; h = (cc >> 1) & 15; d = cc & 1; rowbase = b * 256; T = 256; }
        float S[64];
        if (lat) { const float* src = F.in[I_STATE] + ((((size_t)b * NL + l) * 2 + d) * NH + h) * 4096 + lane * 64;
#pragma unroll
            for (int k4 = 0; k4 < 16; ++k4) { const f32x4 q = *(const f32x4*)(src + 4 * k4); S[4 * k4] = q.x; S[4 * k4 + 1] = q.y; S[4 * k4 + 2] = q.z; S[4 * k4 + 3] = q.w; } }
        else {
#pragma unroll
            for (int k = 0; k < 64; ++k) S[k] = 0.f; }
        const bf16* kkp = KK + 64 * h + lane; const bf16* bp = (const bf16*)(F.ws + WS_BB) + (size_t)d * M * DA + 64 * h + lane;
        const bf16* kp = (const bf16*)(F.ws + WS_KD) + (size_t)d * M * DA + 64 * h + lane; const float* wp = (const float*)(F.ws + WS_WDEC) + (size_t)d * M * DA + 64 * h + lane;
        const bf16* rp = PS + 64 * h + lane; const bf16* vp = PS + 2 * DA + 64 * h + lane;
        float* yp = (float*)(F.ws + WS_Y) + (size_t)d * M * DA + 64 * h + lane;
        int row = rowbase + (d ? T - 1 : 0);
        float an = -bf2f(kkp[(size_t)row * DA]), bn = bf2f(bp[(size_t)row * DA]), wn = wp[(size_t)row * DA], kn = bf2f(kp[(size_t)row * DA]), rn = bf2f(rp[(size_t)row * CSH]), vn = bf2f(vp[(size_t)row * CSH]);
        for (int step = 0; step < T; ++step) {
            const float ac = an, bc = bn, wc = wn, kc = kn, rc = rn, vc = vn; const int rowc = row;
            if (step + 1 < T) { row += d ? -1 : 1;
                an = -bf2f(kkp[(size_t)row * DA]); bn = bf2f(bp[(size_t)row * DA]); wn = wp[(size_t)row * DA]; kn = bf2f(kp[(size_t)row * DA]); rn = bf2f(rp[(size_t)row * CSH]); vn = bf2f(vp[(size_t)row * CSH]); }
            asm volatile("" ::: "memory");
            sb[lane] = ac; sb[64 + lane] = bc; sb[128 + lane] = wc; sb[192 + lane] = kc; sb[256 + lane] = rc;
            asm volatile("s_waitcnt lgkmcnt(0)" ::: "memory");
            float sa = 0.f;
#pragma unroll
            for (int k4 = 0; k4 < 16; ++k4) { const f32x4 a4 = *(const LAS f32x4*)(sb + 4 * k4);
                sa += S[4 * k4] * a4.x + S[4 * k4 + 1] * a4.y + S[4 * k4 + 2] * a4.z + S[4 * k4 + 3] * a4.w; }
            float y = 0.f;
#pragma unroll
            for (int k4 = 0; k4 < 16; ++k4) {
                const f32x4 b4 = *(const LAS f32x4*)(sb + 64 + 4 * k4), w4 = *(const LAS f32x4*)(sb + 128 + 4 * k4), q4 = *(const LAS f32x4*)(sb + 192 + 4 * k4), r4 = *(const LAS f32x4*)(sb + 256 + 4 * k4);
#pragma unroll
                for (int j = 0; j < 4; ++j) { float s = S[4 * k4 + j]; s = s * w4[j] + sa * b4[j] + vc * q4[j]; S[4 * k4 + j] = s; y += s * r4[j]; }
            }
            asm volatile("s_waitcnt lgkmcnt(0)" ::: "memory");
            yp[(size_t)rowc * DA] = y;
        }
        if (!lat) { float* dst = F.out + (size_t)M * D + ((((size_t)b * NL + l) * 2 + d) * NH + h) * 4096 + lane * 64;
#pragma unroll
            for (int k4 = 0; k4 < 16; ++k4) *(f32x4*)(dst + 4 * k4) = (f32x4){S[4 * k4], S[4 * k4 + 1], S[4 * k4 + 2], S[4 * k4 + 3]}; }
    }
}

__device__ __forceinline__ void p_post(Frame& F, int l) {
    PH_LOCALS(F); PH_LAYER(l);
    const bf16* PS = (const bf16*)(F.ws + WS_PS); const bf16* GATE = (const bf16*)(F.ws + WS_GATE);
    const float* Y = (const float*)(F.ws + WS_Y); const float* BONUS = (const float*)(F.ws + WS_BONUS);
    bf16* O = (bf16*)(F.ws + WS_O);
    const int gt = bx * 512 + tid, NGT = G * 512;
    for (int i = gt; i < M * 128; i += NGT) {
        const int row = i >> 7, hc = i & 127, chn = hc * 8, h = hc >> 3;
        float v[8], gt8[8], o[8];
        unpack8(*(const u32x4*)(PS + (size_t)row * CSH + 2 * DA + chn), v);
        unpack8(*(const u32x4*)(GATE + (size_t)row * DA + chn), gt8);
        const float bon = BONUS[(size_t)row * NH + h];
        const float* gw = F.in[I_GNW] + (size_t)l * DA + chn; const float* gb = F.in[I_GNB] + (size_t)l * DA + chn;
#pragma unroll
        for (int j = 0; j < 8; ++j) o[j] = bon * v[j];
#pragma unroll
        for (int d = 0; d < 2; ++d) {
            const float* yp = Y + (size_t)d * M * DA + (size_t)row * DA + chn;
            const f32x4 y0 = *(const f32x4*)yp, y1 = *(const f32x4*)(yp + 4);
            float y[8] = {y0.x, y0.y, y0.z, y0.w, y1.x, y1.y, y1.z, y1.w};
            float s = 0.f;
#pragma unroll
            for (int j = 0; j < 8; ++j) s += y[j];
            s += __shfl_xor(s, 1); s += __shfl_xor(s, 2); s += __shfl_xor(s, 4);
            const float mean = s * (1.0f / 64.0f); float q = 0.f;
#pragma unroll
            for (int j = 0; j < 8; ++j) { y[j] -= mean; q += y[j] * y[j]; }
            q += __shfl_xor(q, 1); q += __shfl_xor(q, 2); q += __shfl_xor(q, 4);
            const float rstd = 1.0f / sqrtf(q * (1.0f / 64.0f) + GN_EPS);
#pragma unroll
            for (int j = 0; j < 8; ++j) o[j] += y[j] * rstd * gw[j] + gb[j];
        }
#pragma unroll
        for (int j = 0; j < 8; ++j) o[j] *= gt8[j];
        *(u32x4*)(O + (size_t)row * D + chn) = pack8(o);
    }
}

__device__ __forceinline__ void p_final(Frame& F) {
    PH_LOCALS(F);
    const int gw = bx * NWAVES + wave, NGW = G * NWAVES;
    const float* fg = F.in[I_FNG];
    for (int row = gw; row < M; row += NGW) {
        float* xr = F.out + (size_t)row * D;
        f32x4 v[8]; float ss = 0.f;
#pragma unroll
        for (int j = 0; j < 8; ++j) { v[j] = *(const f32x4*)(xr + 4 * lane + 256 * j); ss += (v[j].x * v[j].x + v[j].y * v[j].y) + (v[j].z * v[j].z + v[j].w * v[j].w); }
        const float rstd = 1.0f / sqrtf(wave_sum(ss) * (1.0f / D) + RMS_EPS);
#pragma unroll
        for (int j = 0; j < 8; ++j) { const int c = 4 * lane + 256 * j; *(f32x4*)(xr + c) = v[j] * rstd * *(const f32x4*)(fg + c); }
    }
}

constexpr int PH_PER_LAYER = 10, N_PHASES = 2 + NL * PH_PER_LAYER;
__global__ void __launch_bounds__(NWAVES * 64, 2) hymba_fwd(Args args) {
    extern __shared__ __attribute__((aligned(16))) unsigned char lds[];
    Frame F;
    F.lds = (LAS unsigned char*)lds;
    F.tid = threadIdx.x; F.lane = F.tid & 63; F.wave = __builtin_amdgcn_readfirstlane(F.tid >> 6);
    F.G = gridDim.x; F.bx = blockIdx.x;
    F.in = args.in; F.out = args.out; F.ws = args.ws;
    for (int u = F.tid; u < (LDS_BYTES - LDSCTL_OFF) / 4; u += NWAVES * 64) ((LAS unsigned*)(F.lds + LDSCTL_OFF))[u] = 0u;
    __syncthreads();
    volatile LAS unsigned* MISC = (volatile LAS unsigned*)(F.lds + MISC_OFF);
    unsigned* barw = (unsigned*)(F.ws + WS_CTL) + CW_BAR;
    XcdBarrier bar; bar.bar = barw; bar.x = 0; bar.st = nullptr;
    if (MK_N_LAUNCHES == 1) bar = xcd_barrier_post(barw, MISC + 8);
    const int lo = args.ph_lo, hi = args.ph_hi;
#define IN(k) (lo <= (k) && (k) < hi)
#define SEAM(k) do { if (MK_N_LAUNCHES == 1 && IN(k) && IN((k) + 1)) xcd_barrier(bar); } while (0)

    if (IN(0)) { p0_prologue(F); } SEAM(0);
    bf16* H = (bf16*)(F.ws + WS_H); bf16* O = (bf16*)(F.ws + WS_O); bf16* P = (bf16*)(F.ws + WS_P); bf16* HID = (bf16*)(F.ws + WS_HID);
    const float* mod = (const float*)(F.ws + WS_MOD);
    for (int l = 0; l < NL; ++l) {
        const int pb = 1 + l * PH_PER_LAYER;
        const float* xlo = l == 0 ? F.in[I_XP] : F.out; const float* xhi = l == 0 ? F.in[I_XS] : F.out + (size_t)MCTX * D;
        if (IN(pb + 0)) { p_adaln(F, l, 0, xlo, xhi); } SEAM(pb + 0);
        if (IN(pb + 1)) { pg8::Gemm g{H, (const bf16*)(F.ws + WS_WIN + l * SZ_WIN), M, PINP, D}; pg8::StaticOrder S; S.init(M, PINP, F.G, F.bx);
            EpiP E{P, PINP, CSH}; pg8::gemm_phase<EpiP, pg8::StaticOrder, true, true>(F.lds, g, S, E); } SEAM(pb + 1);
        if (IN(pb + 2)) { p_shift(F, l); } SEAM(pb + 2);
        if (IN(pb + 3)) { p_prep(F, l); p_gmlp(F, l); } SEAM(pb + 3);
        if (IN(pb + 4)) { p_scan(F, l); } SEAM(pb + 4);
        if (IN(pb + 5)) { p_post(F, l); } SEAM(pb + 5);
        if (IN(pb + 6)) { pg8::Gemm g{O, (const bf16*)(F.ws + WS_WOUT + l * SZ_WOUT), M, D, D}; pg8::StaticOrder S; S.init(M, D, F.G, F.bx);
            EpiRes E{xlo, xhi, F.out, mod + (size_t)l * 5 * MODW, 2 * D}; pg8::gemm_phase<EpiRes, pg8::StaticOrder, true, true>(F.lds, g, S, E); } SEAM(pb + 6);
        if (IN(pb + 7)) { p_adaln(F, l, 1, F.out, F.out + (size_t)MCTX * D); } SEAM(pb + 7);
        if (IN(pb + 8)) { pg8::Gemm g{H, (const bf16*)(F.ws + WS_WGU + l * SZ_WGU), M, NGU, D}; pg8::StaticOrder S; S.init(M, NGU, F.G, F.bx);
            EpiSwi E{HID, DFF}; pg8::gemm_phase<EpiSwi, pg8::StaticOrder, true, true>(F.lds, g, S, E); } SEAM(pb + 8);
        if (IN(pb + 9)) { pg8::Gemm g{HID, (const bf16*)(F.ws + WS_WD + l * SZ_WD), M, D, DFF}; pg8::StaticOrder S; S.init(M, D, F.G, F.bx);
            EpiRes E{F.out, F.out + (size_t)MCTX * D, F.out, mod + (size_t)l * 5 * MODW, 5 * D}; pg8::gemm_phase<EpiRes, pg8::StaticOrder, true, true>(F.lds, g, S, E); } SEAM(pb + 9);
    }
    if (IN(N_PHASES - 1)) { p_final(F); }
#undef IN
#undef SEAM
}

extern "C" void kernel_launch(void* const* d_in, const int* in_sizes, int n_in, void* d_out, int out_size, void* d_ws, size_t ws_size, hipStream_t stream) {
    static int grid = 0;
    if (grid == 0) {
        if (n_in != 30 || ws_size < WS_END) { fprintf(stderr, "kernel_launch: need 30 inputs and >= %zu bytes of workspace; got n_in %d, ws %zu\n", (size_t)WS_END, n_in, ws_size); grid = -1; return; }
        int dev = 0, cus = 0, per_cu = 0;
        if (hipGetDevice(&dev) != hipSuccess || hipDeviceGetAttribute(&cus, hipDeviceAttributeMultiprocessorCount, dev) != hipSuccess) { grid = -1; return; }
        if (hipFuncSetAttribute((const void*)hymba_fwd, hipFuncAttributeMaxDynamicSharedMemorySize, LDS_BYTES) != hipSuccess) { fprintf(stderr, "kernel_launch: hipFuncSetAttribute failed\n"); grid = -1; return; }
        if (hipOccupancyMaxActiveBlocksPerMultiprocessor(&per_cu, (const void*)hymba_fwd, NWAVES * 64, LDS_BYTES) != hipSuccess || per_cu < 1)
            fprintf(stderr, "kernel_launch: note: occupancy query reports %d workgroups per CU\n", per_cu);
        (void)hipGetLastError();
        grid = cus;
    }
    if (grid < 0) return;
    if (hipMemsetAsync((char*)d_ws + WS_CTL, 0, CTL_ZERO_BYTES, stream) != hipSuccess) return;
    Args a{};
    for (int i = 0; i < 30; ++i) a.in[i] = (const float*)d_in[i];
    a.out = (float*)d_out; a.ws = (unsigned char*)d_ws; a.pad = 0;
    if (MK_N_LAUNCHES == 1) {
        a.ph_lo = 0; a.ph_hi = N_PHASES; a.li = 0;
        hipLaunchKernelGGL(hymba_fwd, dim3(grid), dim3(NWAVES * 64), LDS_BYTES, stream, a);
    } else {
        for (int k = 0; k < N_PHASES; ++k) { a.ph_lo = k; a.ph_hi = k + 1; a.li = k;
            hipLaunchKernelGGL(hymba_fwd, dim3(grid), dim3(NWAVES * 64), LDS_BYTES, stream, a); }
    }
}
```

```cpp
#include <hip/hip_runtime.h>
#include <cstdio>
#include <cstdint>

#ifndef MK_N_LAUNCHES
#define MK_N_LAUNCHES 1
#endif

namespace pg8 {
#define PG8_LAS __attribute__((address_space(3)))
typedef unsigned short bf16_t;
typedef short bf16x8 __attribute__((ext_vector_type(8)));
typedef float f32x4 __attribute__((ext_vector_type(4)));
typedef unsigned u32x4 __attribute__((ext_vector_type(4)));
constexpr int BM = 256, BK = 64, HALF = 128, HTB = HALF * BK * 2  , STAGE_BYTES = 8 * HTB, NXCD = 8, WGM = 8;

__host__ __device__ __forceinline__ int lds_byte(int r, int c) { const int st = (r >> 4) * 2 + (c >> 5), rr = r & 15, cc = c & 31, ob = rr * 64 + cc * 2; return st * 1024 + (ob ^ (((ob >> 9) & 1) << 5)); }
__host__ __device__ __forceinline__ void stage_rc(int b, int& R, int& C) { const int st = b / 1024, sb = b % 1024, swz = sb ^ (((sb >> 9) & 1) << 5); R = (st >> 1) * 16 + swz / 64; C = (st & 1) * 32 + (swz % 64) / 2; }
__host__ __device__ __forceinline__ int perm32(int rho) { const int n = rho >> 4, i = rho & 15; return 8 * (i >> 2) + 4 * n + (i & 3); }

struct Unit { int pm, pn; };
struct Gemm { const bf16_t* A; const bf16_t* Bt; int M, N, K; };

struct StaticOrder {
    int nM, nN, nwg, G, c;
    __host__ __device__ void init(int M, int N, int G_, int c_) { nM = M / BM; nN = N / BM; nwg = nM * nN; G = G_; c = c_; }
    __host__ __device__ bool next(int i, Unit& u) const {
        const long L = (long)i * G + c; if (L >= nwg) return false;
        int wgid = (int)L; { const int q = nwg / NXCD, r = nwg % NXCD, xcd = wgid % NXCD, off = wgid / NXCD; wgid = (xcd < r ? xcd * (q + 1) : r * (q + 1) + (xcd - r) * q) + off; }
        const int nig = WGM * nN, gid = wgid / nig, fm = gid * WGM, gsz = (nM - fm) < WGM ? (nM - fm) : WGM;
        u.pm = fm + ((wgid % nig) % gsz); u.pn = (wgid % nig) / gsz; return true;
    }
    __device__ __forceinline__ void a_ready(const Unit&) const {}
    __device__ __forceinline__ void done(const Unit&) const {}
};

__device__ __forceinline__ unsigned cvt_pk_bf16(float lo, float hi) { unsigned r; asm volatile("v_cvt_pk_bf16_f32 %0, %1, %2" : "=v"(r) : "v"(lo), "v"(hi)); return r; }

template <class Epi, class Sched, bool ALIGN_EPI = false, bool SP2 = false>
__device__ __forceinline__ void gemm_phase(PG8_LAS unsigned char* lds, const Gemm g, const Sched& S, const Epi& E, int wid) {
    asm volatile("" : "+s"(wid)); int lane; asm volatile("v_mbcnt_lo_u32_b32 %0, -1, 0\n\tv_mbcnt_hi_u32_b32 %0, -1, %0" : "=v"(lane));
    const int tid = wid * 64 + lane, wr = wid >> 2, wc = wid & 3, fr = lane & 15, fq = lane >> 4;
    const int K = g.K, nt = K / BK;
    unsigned voffA[2], voffB[2];
#pragma unroll
    for (int i = 0; i < 2; ++i) { int R, C; stage_rc(tid * 16 + i * 8192, R, C); const int Rb = Epi::PERM ? ((R & ~31) + perm32(R & 31)) : R;
        voffA[i] = (unsigned)(R * K + C) * 2u; voffB[i] = (unsigned)(Rb * K + C) * 2u; }
    const size_t kstep = (size_t)(BK * 2);
    const size_t hstep = (size_t)HALF * K * 2;
    const size_t tstep = 2 * hstep;
    const unsigned ldsw = (unsigned)wid * 1024u;
    const int aoff = lds_byte(wr * 64 + fr, fq * 8), boff = lds_byte(wc * 32 + fr, fq * 8);
#define PG8_SA(b, h) (((b) * 2 + (h)) * HTB)
#define PG8_SB(b, h) ((4 + (b) * 2 + (h)) * HTB)
#define PG8_STAGE(bufoff, gbase, voff) do { _Pragma("unroll") for (int _i = 0; _i < 2; ++_i) \
        __builtin_amdgcn_global_load_lds((const unsigned*)((const char*)(gbase) + (voff)[_i]), (PG8_LAS unsigned*)(lds + (bufoff) + ldsw + _i * 8192), 16, 0, 0); } while (0)
#define PG8_LDA(dst, b, h) do { _Pragma("unroll") for (int m = 0; m < 4; ++m) _Pragma("unroll") for (int k = 0; k < 2; ++k) dst[m][k] = *(const PG8_LAS bf16x8*)(lds + PG8_SA(b, h) + aoff + m * 2048 + k * 1024); } while (0)
#define PG8_LDB(dst, b, h) do { _Pragma("unroll") for (int n = 0; n < 2; ++n) _Pragma("unroll") for (int k = 0; k < 2; ++k) dst[n][k] = *(const PG8_LAS bf16x8*)(lds + PG8_SB(b, h) + boff + n * 2048 + k * 1024); } while (0)
#define PG8_MMA(ai, bj, At, Bt) do { __builtin_amdgcn_s_setprio(1); _Pragma("unroll") for (int m = 0; m < 4; ++m) _Pragma("unroll") for (int n = 0; n < 2; ++n) _Pragma("unroll") for (int k = 0; k < 2; ++k) \
        acc[ai][bj][m][n] = __builtin_amdgcn_mfma_f32_16x16x32_bf16(Bt[n][k], At[m][k], acc[ai][bj][m][n], 0, 0, 0); __builtin_amdgcn_s_setprio(0); } while (0)
#define PG8_WAIT_V(n) asm volatile("s_waitcnt vmcnt(" #n ")" ::: "memory")
#define PG8_WAIT_L(n) asm volatile("s_waitcnt lgkmcnt(" #n ")" ::: "memory")
#define PG8_BAR __builtin_amdgcn_s_barrier()
#define PG8_SCHED __builtin_amdgcn_sched_barrier(0)
    Unit cur, nxt; int ui = 0;
    if (!S.next(0, cur)) return;
    f32x4 acc[2][2][4][2];
#pragma unroll
    for (int a = 0; a < 2; ++a)
#pragma unroll
        for (int b = 0; b < 2; ++b)
#pragma unroll
            for (int m = 0; m < 4; ++m)
#pragma unroll
                for (int n = 0; n < 2; ++n) acc[a][b][m][n] = (f32x4){0.f, 0.f, 0.f, 0.f};
    bf16x8 At[4][2], B0[2][2], B1[2][2];
    const char* cA = (const char*)g.A + (size_t)cur.pm * tstep; const char* cB = (const char*)g.Bt + (size_t)cur.pn * tstep;
    S.a_ready(cur);
    if constexpr (SP2) {
        PG8_STAGE(PG8_SB(0, 0), cB, voffB); PG8_STAGE(PG8_SB(0, 1), cB + hstep, voffB); PG8_STAGE(PG8_SA(0, 0), cA, voffA); PG8_STAGE(PG8_SA(0, 1), cA + hstep, voffA);
        if (wr == 1) PG8_BAR;
        PG8_WAIT_V(2); PG8_BAR;
        PG8_STAGE(PG8_SB(1, 0), cB + kstep, voffB); PG8_STAGE(PG8_SA(1, 0), cA + kstep, voffA); PG8_STAGE(PG8_SB(1, 1), cB + hstep + kstep, voffB);
        PG8_WAIT_V(6); PG8_BAR;
    } else {
        PG8_STAGE(PG8_SB(0, 0), cB, voffB); PG8_STAGE(PG8_SA(0, 0), cA, voffA); PG8_STAGE(PG8_SB(0, 1), cB + hstep, voffB); PG8_STAGE(PG8_SA(0, 1), cA + hstep, voffA);
        if (wr == 1) PG8_BAR;
        PG8_WAIT_V(4); PG8_BAR;
        PG8_STAGE(PG8_SB(1, 0), cB + kstep, voffB); PG8_STAGE(PG8_SA(1, 0), cA + kstep, voffA); PG8_STAGE(PG8_SB(1, 1), cB + hstep + kstep, voffB);
        PG8_WAIT_V(6); PG8_BAR;
    }
    for (;;) {
        const bool has_next = S.next(ui + 1, nxt);
        const char* nA = has_next ? (const char*)g.A + (size_t)nxt.pm * tstep : cA; const char* nB = has_next ? (const char*)g.Bt + (size_t)nxt.pn * tstep : cB;
        for (int t = 0; t < nt; t += 2) {
            const bool last = (t == nt - 2);
            const char* a1 = cA + (size_t)(t + 1) * kstep;
            const char* a2 = last ? nA : cA + (size_t)(t + 2) * kstep; const char* b2 = last ? nB : cB + (size_t)(t + 2) * kstep;
            const char* a3 = a2 + kstep; const char* b3 = b2 + kstep;
            if (last && has_next) S.a_ready(nxt);
            if constexpr (SP2) {
            PG8_LDB(B0, 0, 0); PG8_LDB(B1, 0, 1); PG8_SCHED; PG8_LDA(At, 0, 0); PG8_STAGE(PG8_SA(1, 1), a1 + hstep, voffA);
            PG8_WAIT_V(8); PG8_WAIT_L(0); PG8_BAR; PG8_MMA(0, 0, At, B0); PG8_MMA(0, 1, At, B1); PG8_BAR; PG8_SCHED;
            PG8_LDA(At, 0, 1); PG8_STAGE(PG8_SB(0, 0), b2, voffB); PG8_STAGE(PG8_SB(0, 1), b2 + hstep, voffB); PG8_STAGE(PG8_SA(0, 0), a2, voffA);
            PG8_WAIT_V(8); PG8_WAIT_L(0); PG8_BAR; PG8_MMA(1, 0, At, B0); PG8_MMA(1, 1, At, B1); PG8_BAR; PG8_SCHED;
            PG8_LDB(B0, 1, 0); PG8_LDB(B1, 1, 1); PG8_SCHED; PG8_LDA(At, 1, 0); PG8_STAGE(PG8_SA(0, 1), a2 + hstep, voffA);
            PG8_WAIT_V(8); PG8_WAIT_L(0); PG8_BAR; PG8_MMA(0, 0, At, B0); PG8_MMA(0, 1, At, B1); PG8_BAR; PG8_SCHED;
            PG8_LDA(At, 1, 1); PG8_STAGE(PG8_SB(1, 0), b3, voffB); PG8_STAGE(PG8_SB(1, 1), b3 + hstep, voffB); PG8_STAGE(PG8_SA(1, 0), a3, voffA);
            PG8_WAIT_V(8); PG8_WAIT_L(0); PG8_BAR; PG8_MMA(1, 0, At, B0); PG8_MMA(1, 1, At, B1); PG8_BAR; PG8_SCHED;
            } else {
            PG8_LDB(B0, 0, 0); PG8_SCHED; PG8_LDA(At, 0, 0); PG8_STAGE(PG8_SA(1, 1), a1 + hstep, voffA);
            PG8_WAIT_L(8); PG8_BAR; PG8_WAIT_L(0); PG8_MMA(0, 0, At, B0); PG8_BAR; PG8_SCHED;
            PG8_LDB(B1, 0, 1); PG8_STAGE(PG8_SB(0, 0), b2, voffB);
            PG8_BAR; PG8_WAIT_L(0); PG8_MMA(0, 1, At, B1); PG8_BAR;
            PG8_LDA(At, 0, 1); PG8_STAGE(PG8_SA(0, 0), a2, voffA);
            PG8_BAR; PG8_WAIT_L(0); PG8_MMA(1, 0, At, B0); PG8_BAR; PG8_SCHED;
            PG8_STAGE(PG8_SB(0, 1), b2 + hstep, voffB);
            PG8_WAIT_V(6); PG8_BAR; PG8_MMA(1, 1, At, B1); PG8_BAR;
            PG8_LDB(B0, 1, 0); PG8_SCHED; PG8_LDA(At, 1, 0); PG8_STAGE(PG8_SA(0, 1), a2 + hstep, voffA);
            PG8_WAIT_L(8); PG8_BAR; PG8_WAIT_L(0); PG8_MMA(0, 0, At, B0); PG8_BAR; PG8_SCHED;
            PG8_LDB(B1, 1, 1); PG8_STAGE(PG8_SB(1, 0), b3, voffB);
            PG8_BAR; PG8_WAIT_L(0); PG8_MMA(0, 1, At, B1); PG8_BAR;
            PG8_LDA(At, 1, 1); PG8_STAGE(PG8_SA(1, 0), a3, voffA);
            PG8_BAR; PG8_WAIT_L(0); PG8_MMA(1, 0, At, B0); PG8_BAR; PG8_SCHED;
            PG8_STAGE(PG8_SB(1, 1), b3 + hstep, voffB);
            PG8_WAIT_V(6); PG8_BAR; PG8_MMA(1, 1, At, B1); PG8_BAR;
            }
        }
        if constexpr (ALIGN_EPI) { if (wr == 0) PG8_BAR; }
        E(acc, cur, wr, wc, fr, fq); S.done(cur);
        if (!has_next) break;
#pragma unroll
        for (int a = 0; a < 2; ++a)
#pragma unroll
            for (int b = 0; b < 2; ++b)
#pragma unroll
                for (int m = 0; m < 4; ++m)
#pragma unroll
                    for (int n = 0; n < 2; ++n) acc[a][b][m][n] = (f32x4){0.f, 0.f, 0.f, 0.f};
        cur = nxt; cA = nA; cB = nB; ++ui;
        if constexpr (ALIGN_EPI) { if (wr == 1) PG8_BAR; }
    }
    PG8_WAIT_V(0);
    if constexpr (!ALIGN_EPI) { if (wr == 0) PG8_BAR; }
    PG8_BAR;
#undef PG8_SA
#undef PG8_SB
#undef PG8_STAGE
#undef PG8_LDA
#undef PG8_LDB
#undef PG8_MMA
#undef PG8_WAIT_V
#undef PG8_WAIT_L
#undef PG8_BAR
#undef PG8_SCHED
}
}

constexpr int NWAVES = 8;
constexpr int D = 2048, MCTX = 4096, MLAT = 16384, M = MCTX + MLAT, NL = 4;
constexpr int DA = 1024, NH = 16, DB = 1024, NG = 8, HB = 128;
constexpr int LW = 64, LAA = 64, LGT = 160;
constexpr int CSH = 3 * DA + LW + LAA + LGT;
constexpr int PIN = CSH + 2 * DB;
constexpr int PINP = 5632;
constexpr int DFF = 5632, NGU = 2 * DFF;
constexpr int MODW = 6 * D;
constexpr float RMS_EPS = 1e-6f, GN_EPS = 64.0f * 1e-5f, LN_EPS = 1e-5f;

constexpr size_t MiB = 1u << 20;
constexpr size_t WS_CTL = 0, CTL_ZERO_BYTES = 1 * MiB;
constexpr size_t WS_MOD = 1 * MiB;
constexpr size_t WS_W2T = 2 * MiB;
constexpr size_t WS_A2T = 3 * MiB;
constexpr size_t WS_G2T = 4 * MiB;
constexpr size_t WS_WSP = 6 * MiB;
constexpr size_t WS_BONUS = 7 * MiB;
constexpr size_t SZ_WIN = (size_t)PINP * D * 2, SZ_WOUT = (size_t)D * D * 2, SZ_WGU = (size_t)NGU * D * 2, SZ_WD = (size_t)D * DFF * 2;
constexpr size_t WS_WIN = 16 * MiB;
constexpr size_t WS_WOUT = WS_WIN + NL * SZ_WIN;
constexpr size_t WS_WGU = WS_WOUT + NL * SZ_WOUT;
constexpr size_t WS_WD = WS_WGU + NL * SZ_WGU;
constexpr size_t WS_H = WS_WD + NL * SZ_WD;
constexpr size_t WS_O = WS_H + (size_t)M * D * 2;
constexpr size_t WS_P = WS_O + (size_t)M * D * 2;
constexpr size_t WS_PS = WS_P + (size_t)M * PINP * 2;
constexpr size_t SZ_T16 = (size_t)M * DA * 2;
constexpr size_t WS_GATE = WS_PS + (size_t)M * CSH * 2;
constexpr size_t SZ_CH = (size_t)(M / 64) * NH * 2 * 8192;
constexpr size_t WS_PST = WS_GATE + SZ_T16;
constexpr size_t WS_NCT = WS_PST + SZ_CH;
constexpr size_t WS_PYT = WS_NCT + SZ_CH;
constexpr size_t WS_QYT = WS_PYT + SZ_CH;
constexpr size_t WS_VTG = WS_QYT + SZ_CH;
constexpr size_t WS_SC = WS_VTG + SZ_CH;
constexpr size_t WS_END1 = WS_SC + SZ_CH;
constexpr size_t WS_HID = WS_GATE;
constexpr size_t WS_END = WS_END1 > WS_HID + (size_t)M * DFF * 2 ? WS_END1 : WS_HID + (size_t)M * DFF * 2;
constexpr int CW_BAR = 4096;

constexpr int RING_BYTES = 131072;
constexpr int LDSCTL_OFF = 15 * 9216, MISC_OFF = LDSCTL_OFF + 320;
constexpr int LDS_BYTES = 147456;

#define GAS __attribute__((address_space(1)))
#define LAS __attribute__((address_space(3)))
typedef unsigned short bf16;
typedef float f32x4 __attribute__((ext_vector_type(4)));
typedef float f32x2 __attribute__((ext_vector_type(2)));
typedef short bf16x8 __attribute__((ext_vector_type(8)));
typedef unsigned u32x4 __attribute__((ext_vector_type(4)));
typedef unsigned u32x2 __attribute__((ext_vector_type(2)));
#define LDS_WAIT() asm volatile("s_waitcnt lgkmcnt(0)" ::: "memory")
#define VM_WAIT() asm volatile("s_waitcnt vmcnt(0)" ::: "memory")
__device__ __forceinline__ unsigned f2bf(float f) { unsigned u = __builtin_bit_cast(unsigned, f); return (u + 0x7fffu + ((u >> 16) & 1u)) >> 16; }
__device__ __forceinline__ unsigned pk2(float lo, float hi) { return f2bf(lo) | (f2bf(hi) << 16); }
__device__ __forceinline__ float bf2f(unsigned short b) { return __uint_as_float(((unsigned)b) << 16); }
__device__ __forceinline__ void unpack8(const u32x4 q, float (&f)[8]) {
    f[0] = __uint_as_float(q.x << 16); f[1] = __uint_as_float(q.x & 0xffff0000u); f[2] = __uint_as_float(q.y << 16); f[3] = __uint_as_float(q.y & 0xffff0000u);
    f[4] = __uint_as_float(q.z << 16); f[5] = __uint_as_float(q.z & 0xffff0000u); f[6] = __uint_as_float(q.w << 16); f[7] = __uint_as_float(q.w & 0xffff0000u); }
__device__ __forceinline__ u32x4 pack8(const float (&f)[8]) { u32x4 o; o.x = pk2(f[0], f[1]); o.y = pk2(f[2], f[3]); o.z = pk2(f[4], f[5]); o.w = pk2(f[6], f[7]); return o; }
__device__ __forceinline__ float fsigmoid(float x) { return __builtin_amdgcn_rcpf(1.0f + __expf(-x)); }
__device__ __forceinline__ float ftanh(float x) { return 1.0f - 2.0f * __builtin_amdgcn_rcpf(1.0f + __expf(2.0f * x)); }
__device__ __forceinline__ float gelu_tanh(float x) { const float u = 1.5957691216057308f * (x + 0.044715f * x * x * x); return x * __builtin_amdgcn_rcpf(1.0f + __expf(-u)); }
__device__ __forceinline__ int hw_lane() { int l; asm volatile("v_mbcnt_lo_u32_b32 %0, -1, 0\n\tv_mbcnt_hi_u32_b32 %0, -1, %0" : "=v"(l)); return l; }
#define SHX(v, X) __int_as_float(__builtin_amdgcn_ds_bpermute((lane ^ (X)) << 2, __float_as_int(v)))
#define WAVE_SUM(v) do { v += SHX(v, 1); v += SHX(v, 2); v += SHX(v, 4); v += SHX(v, 8); v += SHX(v, 16); v += SHX(v, 32); } while (0)

#define PH_LOCALS(F) int wave = (F).wave; asm volatile("" : "+s"(wave)); const int lane = hw_lane(); const int tid = wave * 64 + lane; \
    int bx = (F).bx, G = (F).G; asm volatile("" : "+s"(bx), "+s"(G)); (void)lane; (void)tid;
#define PH_LAYER(l) asm volatile("" : "+s"(l))

#define XB_TMO      128
#define XB_XCNT(j)  (256  + 64 * (j))
#define XB_XSUB(j)  (1280 + 64 * (j))
#define XB_XGEN(j)  (2304 + 64 * (j))
#define XB_TOP      3328
#define XB_TOPGEN   3392
#define XCD_BAR_WORDS 3456
#define XB_SPIN_CAP (1u << 18)

__device__ __forceinline__ unsigned xb_ld(unsigned* p)              { return __hip_atomic_load(p, __ATOMIC_RELAXED, __HIP_MEMORY_SCOPE_AGENT); }
__device__ __forceinline__ unsigned xb_add(unsigned* p, unsigned v) { return __hip_atomic_fetch_add(p, v, __ATOMIC_RELAXED, __HIP_MEMORY_SCOPE_AGENT); }
__device__ __forceinline__ unsigned xb_xcc_id() { return (unsigned)__builtin_amdgcn_s_getreg((3 << 11) | 20) & 0xFu; }
#define XB_SPIN(cond, bar) do { unsigned _sp = 0; while (cond) { __builtin_amdgcn_s_sleep(1); \
    if ((++_sp & 255u) == 0u) { if (xb_ld(&(bar)[XB_TMO])) break; if (_sp > XB_SPIN_CAP) { atomicAdd(&(bar)[XB_TMO], 1u); break; } } } } while (0)

struct XcdBarrier {
    unsigned* bar; unsigned x;
    volatile LAS unsigned* st;
};
__device__ __forceinline__ XcdBarrier xcd_barrier_post(unsigned* bar, volatile LAS unsigned* st) {
    XcdBarrier b; b.bar = bar; b.x = xb_xcc_id(); b.st = st;
    if (threadIdx.x == 0) (void)xb_add(&bar[XB_XCNT(b.x)], 1u);
    return b;
}
__device__ __forceinline__ void xcd_barrier_complete(unsigned* bar, unsigned x, unsigned& nloc, unsigned& nx) {
    const unsigned G = gridDim.x * gridDim.y * gridDim.z;
    unsigned sum, cnt, mine, sp = 0u;
    for (;;) {
        sum = 0u; cnt = 0u; mine = 0u;
#pragma unroll
        for (unsigned j = 0; j < 16; ++j) { const unsigned c = xb_ld(&bar[XB_XCNT(j)]); sum += c; cnt += (c > 0u) ? 1u : 0u; mine = (j == x) ? c : mine; }
        if (sum == G) break;
        __builtin_amdgcn_s_sleep(1);
        if ((++sp & 255u) == 0u) { if (xb_ld(&bar[XB_TMO])) break; if (sp > XB_SPIN_CAP) { atomicAdd(&bar[XB_TMO], 1u); break; } }
    }
    nloc = mine > 0u ? mine : 1u; nx = cnt > 0u ? cnt : 1u;
}
__device__ __forceinline__ void xcd_barrier(const XcdBarrier& b) {
    asm volatile("s_waitcnt vmcnt(0)" ::: "memory");
    __syncthreads();
    if (threadIdx.x == 0) {
        unsigned* bar = b.bar;
        __builtin_amdgcn_s_waitcnt(0);
        unsigned nloc = b.st[0], nx = b.st[1];
        if (nloc == 0u) { xcd_barrier_complete(bar, b.x, nloc, nx); b.st[0] = nloc; b.st[1] = nx; }
        const unsigned old = xb_add(&bar[XB_XSUB(b.x)], 1u);
        const unsigned gen = old / nloc;
        if (old + 1u == (gen + 1u) * nloc) {
            __builtin_amdgcn_fence(__ATOMIC_RELEASE, "agent");
            asm volatile("s_waitcnt vmcnt(0)" ::: "memory");
            const unsigned og = xb_add(&bar[XB_TOP], 1u);
            const unsigned tg = og / nx;
            if (og + 1u == (tg + 1u) * nx) xb_add(&bar[XB_TOPGEN], 1u);
            else XB_SPIN(xb_ld(&bar[XB_TOPGEN]) == tg, bar);
            __builtin_amdgcn_fence(__ATOMIC_ACQUIRE, "agent");
            xb_add(&bar[XB_XGEN(b.x)], 1u);
            asm volatile("s_waitcnt vmcnt(0)" ::: "memory");
        } else {
            XB_SPIN(xb_ld(&bar[XB_XGEN(b.x)]) == gen, bar);
            __builtin_amdgcn_fence(__ATOMIC_ACQUIRE, "agent");
            asm volatile("s_waitcnt vmcnt(0)" ::: "memory");
        }
    }
    __syncthreads();
}

struct Args {
    const float* in[30];
    float* out; unsigned char* ws;
    int ph_lo, ph_hi, li, pad;
};
enum { I_XP = 0, I_XS, I_STATE, I_C, I_CCTX, I_WMOD, I_BMOD, I_N1G, I_WIN, I_MU, I_W0, I_W2, I_A0, I_A2, I_G2, I_KK, I_KA, I_RK, I_GNW, I_GNB, I_LNG, I_LNB, I_WSP, I_BSP, I_WOUT, I_N2G, I_WG, I_WU, I_WD, I_FNG };

struct Frame {
    LAS unsigned char* lds;
    int tid, lane, wave, G, bx;
    const float* const* in;
    float* out; unsigned char* ws;
};

struct EpiP {
    static constexpr bool PERM = true, AFTER_DRAIN = false;
    bf16* O; int ldc; int gelu_from;
    __device__ __forceinline__ void operator()(const f32x4 (&acc)[2][2][4][2], const pg8::Unit& u, int wr, int wc, int fr, int fq) const {
        const int row0 = u.pm * 256 + wr * 64 + fr, col0 = u.pn * 256 + wc * 32 + 8 * fq;
#pragma unroll
        for (int ai = 0; ai < 2; ++ai)
#pragma unroll
            for (int m = 0; m < 4; ++m) { bf16* rowp = O + (size_t)(row0 + ai * 128 + m * 16) * ldc + col0;
#pragma unroll
                for (int bj = 0; bj < 2; ++bj) { f32x4 v0 = acc[ai][bj][m][0], v1 = acc[ai][bj][m][1];
                    if (col0 + bj * 128 >= gelu_from) {
#pragma unroll
                        for (int j = 0; j < 4; ++j) { v0[j] = gelu_tanh(v0[j]); v1[j] = gelu_tanh(v1[j]); } }
                    u32x4 w; w.x = pg8::cvt_pk_bf16(v0[0], v0[1]); w.y = pg8::cvt_pk_bf16(v0[2], v0[3]); w.z = pg8::cvt_pk_bf16(v1[0], v1[1]); w.w = pg8::cvt_pk_bf16(v1[2], v1[3]);
                    *(u32x4*)(rowp + bj * 128) = w; } }
    }
};
struct EpiRes {
    static constexpr bool PERM = false, AFTER_DRAIN = false;
    const float* xlo; const float* xhi; float* xout; const float* modl; int goff;
    __device__ __forceinline__ void operator()(const f32x4 (&acc)[2][2][4][2], const pg8::Unit& u, int wr, int wc, int fr, int fq) const {
        const int pm = u.pm; const int midx = pm < 16 ? 0 : 1 + ((pm - 16) >> 4);
        const float* gv = modl + (size_t)midx * MODW + goff;
        const float* base = pm < 16 ? xlo + (size_t)pm * 256 * D : xhi + (size_t)(pm - 16) * 256 * D;
        float* ob = xout + (size_t)pm * 256 * D;
        const int col0 = u.pn * 256 + wc * 32 + 4 * fq;
        f32x4 gvv[2][2];
#pragma unroll
        for (int bj = 0; bj < 2; ++bj)
#pragma unroll
            for (int n = 0; n < 2; ++n) gvv[bj][n] = *(const f32x4*)(gv + col0 + bj * 128 + n * 16);
#pragma unroll
        for (int ai = 0; ai < 2; ++ai)
#pragma unroll
            for (int m = 0; m < 4; ++m) { const size_t off = (size_t)(ai * 128 + wr * 64 + m * 16 + fr) * D + col0;
#pragma unroll
                for (int bj = 0; bj < 2; ++bj)
#pragma unroll
                    for (int n = 0; n < 2; ++n) { const f32x4 xo = *(const f32x4*)(base + off + bj * 128 + n * 16);
                        *(f32x4*)(ob + off + bj * 128 + n * 16) = xo + gvv[bj][n] * acc[ai][bj][m][n]; }
                if (m & 1) asm volatile("" ::: "memory"); }
    }
};
struct EpiSwi {
    static constexpr bool PERM = true, AFTER_DRAIN = false;
    bf16* O; int ldc;
    __device__ __forceinline__ void operator()(const f32x4 (&acc)[2][2][4][2], const pg8::Unit& u, int wr, int wc, int fr, int fq) const {
        const int row0 = u.pm * 256 + wr * 64 + fr, col0 = u.pn * 128 + wc * 32 + 8 * fq;
#pragma unroll
        for (int ai = 0; ai < 2; ++ai)
#pragma unroll
            for (int m = 0; m < 4; ++m) { bf16* rowp = O + (size_t)(row0 + ai * 128 + m * 16) * ldc + col0;
                float h[8];
#pragma unroll
                for (int n = 0; n < 2; ++n)
#pragma unroll
                    for (int j = 0; j < 4; ++j) { const float gt = acc[ai][0][m][n][j], up = acc[ai][1][m][n][j]; h[n * 4 + j] = gt * fsigmoid(gt) * up; }
                u32x4 w; w.x = pg8::cvt_pk_bf16(h[0], h[1]); w.y = pg8::cvt_pk_bf16(h[2], h[3]); w.z = pg8::cvt_pk_bf16(h[4], h[5]); w.w = pg8::cvt_pk_bf16(h[6], h[7]);
                *(u32x4*)rowp = w; }
    }
};

template <int MAP>
__device__ __forceinline__ void tr_item(const float* W, int K, int N, bf16* WT, LAS float* scr, int item, int lane) {
    const int nblk = N / 32, kb = item / nblk, nb = item % nblk, k0 = 64 * kb, n0 = 32 * nb;
#pragma unroll 8
    for (int i = 0; i < 32; ++i) { const int kk = 2 * i + (lane >> 5); scr[kk * 33 + (lane & 31)] = W[(size_t)(k0 + kk) * N + n0 + (lane & 31)]; }
    LDS_WAIT(); asm volatile("" ::: "memory");
    const int c = lane & 7;
#pragma unroll
    for (int j = 0; j < 4; ++j) { const int n = (lane >> 3) + 8 * j; const LAS float* s = scr + (8 * c) * 33 + n;
        u32x4 o; o.x = pk2(s[0 * 33], s[1 * 33]); o.y = pk2(s[2 * 33], s[3 * 33]); o.z = pk2(s[4 * 33], s[5 * 33]); o.w = pk2(s[6 * 33], s[7 * 33]);
        const int nn = n0 + n; const int orow = MAP == 0 ? nn : (256 * (nn >> 7) + (nn & 127) + (MAP == 2 ? 128 : 0));
        *(u32x4*)(WT + (size_t)orow * K + k0 + 8 * c) = o; }
    LDS_WAIT(); asm volatile("" ::: "memory");
}
__device__ __forceinline__ void p0_prologue(Frame& F) {
    PH_LOCALS(F);
    LAS float* scr = (LAS float*)(F.lds + wave * 16384);
    const int gw = bx * NWAVES + wave, NGW = G * NWAVES;
    constexpr int I_IN = (D / 64) * (PIN / 32), I_OUT = (D / 64) * (D / 32), I_GU = (D / 64) * (DFF / 32), I_DN = (DFF / 64) * (D / 32);
    constexpr int PL = I_IN + I_OUT + 2 * I_GU + I_DN;
    for (int it = gw; it < NL * PL; it += NGW) {
        const int l = it / PL; int r = it % PL;
        if (r < I_IN) { tr_item<0>(F.in[I_WIN] + (size_t)l * D * PIN, D, PIN, (bf16*)(F.ws + WS_WIN + l * SZ_WIN), scr, r, lane); continue; } r -= I_IN;
        if (r < I_OUT) { tr_item<0>(F.in[I_WOUT] + (size_t)l * D * D, D, D, (bf16*)(F.ws + WS_WOUT + l * SZ_WOUT), scr, r, lane); continue; } r -= I_OUT;
        if (r < I_GU) { tr_item<1>(F.in[I_WG] + (size_t)l * D * DFF, D, DFF, (bf16*)(F.ws + WS_WGU + l * SZ_WGU), scr, r, lane); continue; } r -= I_GU;
        if (r < I_GU) { tr_item<2>(F.in[I_WU] + (size_t)l * D * DFF, D, DFF, (bf16*)(F.ws + WS_WGU + l * SZ_WGU), scr, r, lane); continue; } r -= I_GU;
        tr_item<0>(F.in[I_WD] + (size_t)l * DFF * D, DFF, D, (bf16*)(F.ws + WS_WD + l * SZ_WD), scr, r, lane);
    }
    const int gt = bx * 512 + tid, NGT = G * 512;
    { constexpr int PADV = (PINP - PIN) * D * 2 / 16;
      for (int i = gt; i < NL * PADV; i += NGT) { const int l = i / PADV, r = i % PADV; ((u32x4*)(F.ws + WS_WIN + l * SZ_WIN + (size_t)PIN * D * 2))[r] = (u32x4){0u, 0u, 0u, 0u}; } }
    { bf16* w2t = (bf16*)(F.ws + WS_W2T); bf16* a2t = (bf16*)(F.ws + WS_A2T); bf16* g2t = (bf16*)(F.ws + WS_G2T); bf16* wsp = (bf16*)(F.ws + WS_WSP);
      for (int i = gt; i < NL * 2 * 1024 * 64; i += NGT) { const int k = i & 63, n = (i >> 6) & 1023, ld = i >> 16;
          w2t[i] = (bf16)f2bf(F.in[I_W2][((size_t)ld * 64 + k) * 1024 + n]); a2t[i] = (bf16)f2bf(F.in[I_A2][((size_t)ld * 64 + k) * 1024 + n]); }
      for (int i = gt; i < NL * 1024 * 160; i += NGT) { const int k = i % 160, n = (i / 160) & 1023, l = i / (160 * 1024);
          g2t[i] = (bf16)f2bf(F.in[I_G2][((size_t)l * 160 + k) * 1024 + n]); }
      for (int i = gt; i < NL * 8 * 128 * 128; i += NGT) wsp[i] = (bf16)f2bf(F.in[I_WSP][i]); }
    __syncthreads();
    { LAS float* sv = (LAS float*)F.lds;
      LAS float* red = (LAS float*)(F.lds + 40960);
      for (int i = tid; i < 5 * D; i += 512) { const int r = i / D, k = i % D; const float c = r == 0 ? F.in[I_CCTX][k] : F.in[I_C][(r - 1) * D + k]; sv[i] = c * fsigmoid(c); }
      __syncthreads();
      float* mod = (float*)(F.ws + WS_MOD);
      const int c4 = tid & 15, kg = tid >> 4;
      for (int item = bx; item < NL * (MODW / 64); item += G) {
          const int l = item / (MODW / 64), n0 = (item % (MODW / 64)) * 64;
          const float* W = F.in[I_WMOD] + (size_t)l * D * MODW + n0 + 4 * c4;
          f32x4 a[5];
#pragma unroll
          for (int r = 0; r < 5; ++r) a[r] = (f32x4){0.f, 0.f, 0.f, 0.f};
#pragma unroll 4
          for (int i = 0; i < 64; ++i) { const int k = i * 32 + kg; const f32x4 w = *(const f32x4*)(W + (size_t)k * MODW);
#pragma unroll
              for (int r = 0; r < 5; ++r) a[r] += w * sv[r * D + k]; }
#pragma unroll
          for (int r = 0; r < 5; ++r) *(LAS f32x4*)(red + (kg * 5 + r) * 64 + 4 * c4) = a[r];
          __syncthreads();
          if (tid < 320) { const int r = tid >> 6, n = tid & 63; float s = 0.f;
#pragma unroll 8
              for (int g = 0; g < 32; ++g) s += red[(g * 5 + r) * 64 + n];
              mod[((size_t)l * 5 + r) * MODW + n0 + n] = s + F.in[I_BMOD][(size_t)l * MODW + n0 + n]; }
          __syncthreads();
      } }
}

__device__ __forceinline__ void p_adaln(Frame& F, int l, int which, const float* xlo, const float* xhi) {
    PH_LOCALS(F); PH_LAYER(l);
    const int gw = bx * NWAVES + wave, NGW = G * NWAVES;
    const float* ng = (which == 0 ? F.in[I_N1G] : F.in[I_N2G]) + (size_t)l * D;
    const int shoff = which == 0 ? 0 : 3 * D, scoff = shoff + D;
    const float* mod = (const float*)(F.ws + WS_MOD);
    bf16* H = (bf16*)(F.ws + WS_H);
    for (int row = gw; row < M; row += NGW) {
        const float* xr = row < MCTX ? xlo + (size_t)row * D : xhi + (size_t)(row - MCTX) * D;
        const int midx = row < MCTX ? 0 : 1 + ((row - MCTX) >> 12);
        const float* md = mod + ((size_t)l * 5 + midx) * MODW;
        f32x4 v[8]; float ss = 0.f;
#pragma unroll
        for (int j = 0; j < 8; ++j) { v[j] = *(const f32x4*)(xr + 4 * lane + 256 * j); ss += (v[j].x * v[j].x + v[j].y * v[j].y) + (v[j].z * v[j].z + v[j].w * v[j].w); }
        WAVE_SUM(ss); const float rstd = 1.0f / sqrtf(ss * (1.0f / D) + RMS_EPS);
#pragma unroll
        for (int j = 0; j < 8; ++j) { const int c = 4 * lane + 256 * j;
            const f32x4 g4 = *(const f32x4*)(ng + c), sc = *(const f32x4*)(md + scoff + c), sh = *(const f32x4*)(md + shoff + c);
            const f32x4 o = v[j] * rstd * g4 * (sc + 1.0f) + sh;
            u32x2 w; w.x = pk2(o.x, o.y); w.y = pk2(o.z, o.w);
            *(u32x2*)(H + (size_t)row * D + c) = w; }
    }
}

__device__ __forceinline__ void load_shifted8(const bf16* P, const float* mu, int row, int col, float (&o)[8]) {
    float g[8]; unpack8(*(const u32x4*)(P + (size_t)row * PINP + col), g);
    float a[8];
#pragma unroll
    for (int j = 0; j < 8; ++j) a[j] = g[j];
    int nrow[4]; bool has[4]; int nn;
    if (row < MCTX) { const int t = row & 255; nn = 2; nrow[0] = row - 1; has[0] = t > 0; nrow[1] = row + 1; has[1] = t < 255; nrow[2] = row; has[2] = false; nrow[3] = row; has[3] = false; }
    else { const int t = (row - MCTX) & 4095, gc = t & 63, gr = t >> 6; nn = 4;
        nrow[0] = row - 1; has[0] = gc > 0; nrow[1] = row + 1; has[1] = gc < 63; nrow[2] = row - 64; has[2] = gr > 0; nrow[3] = row + 64; has[3] = gr < 63; }
#pragma unroll
    for (int q = 0; q < 4; ++q) {
        if (q < nn) {
            float nb[8];
            if (has[q]) unpack8(*(const u32x4*)(P + (size_t)nrow[q] * PINP + col), nb);
            else {
#pragma unroll
                for (int j = 0; j < 8; ++j) nb[j] = 0.f; }
            const f32x4 m0 = *(const f32x4*)(mu + q * CSH + col), m1 = *(const f32x4*)(mu + q * CSH + col + 4);
#pragma unroll
            for (int j = 0; j < 4; ++j) { a[j] += m0[j] * (nb[j] - g[j]); a[4 + j] += m1[j] * (nb[4 + j] - g[4 + j]); }
        }
    }
#pragma unroll
    for (int j = 0; j < 8; ++j) o[j] = a[j];
}
__device__ __forceinline__ void p_shift(Frame& F, int l) {
    PH_LOCALS(F); PH_LAYER(l);
    const bf16* P = (const bf16*)(F.ws + WS_P); bf16* PS = (bf16*)(F.ws + WS_PS);
    const float* mu = F.in[I_MU] + (size_t)l * 4 * CSH;
    const int gt = bx * 512 + tid, NGT = G * 512;
    constexpr int CG = CSH / 8;
    for (int i = gt; i < M * CG; i += NGT) { const int row = i / CG, cg = i % CG;
        float o[8]; load_shifted8(P, mu, row, cg * 8, o);
        *(u32x4*)(PS + (size_t)row * CSH + cg * 8) = pack8(o); }
}

constexpr int VTS = 136;
__device__ __forceinline__ void p_gmlp(Frame& F, int l) {
    PH_LOCALS(F); PH_LAYER(l);
    const bf16* P = (const bf16*)(F.ws + WS_P); bf16* O = (bf16*)(F.ws + WS_O);
    const bf16* wsp = (const bf16*)(F.ws + WS_WSP) + (size_t)l * 8 * 128 * 128;
    LAS bf16* VT = (LAS bf16*)F.lds;
    const int fr = lane & 15, fq = lane >> 4;
    for (int item = bx; item < (M / 128) * NG; item += G) {
        const int cb = item >> 3, g = item & 7, R0 = cb * 128;
        { const int j = tid >> 2, q = tid & 3;
          const bf16* src = P + (size_t)(R0 + j) * PINP + CSH + DB + 128 * g + 32 * q;
          float v[32];
#pragma unroll
          for (int i = 0; i < 4; ++i) { float f[8]; unpack8(*(const u32x4*)(src + 8 * i), f);
#pragma unroll
              for (int jj = 0; jj < 8; ++jj) v[8 * i + jj] = f[jj]; }
          float s = 0.f;
#pragma unroll
          for (int i = 0; i < 32; ++i) s += v[i];
          s += SHX(s, 1); s += SHX(s, 2);
          const float mean = s * (1.0f / 128.0f); float qq = 0.f;
#pragma unroll
          for (int i = 0; i < 32; ++i) { v[i] -= mean; qq += v[i] * v[i]; }
          qq += SHX(qq, 1); qq += SHX(qq, 2);
          const float rstd = 1.0f / sqrtf(qq * (1.0f / 128.0f) + LN_EPS);
          const float* lg = F.in[I_LNG] + ((size_t)l * 8 + g) * 128 + 32 * q; const float* lb = F.in[I_LNB] + ((size_t)l * 8 + g) * 128 + 32 * q;
#pragma unroll
          for (int i = 0; i < 32; ++i) VT[(32 * q + i) * VTS + j] = (bf16)f2bf(v[i] * rstd * lg[i] + lb[i]);
        }
        __syncthreads();
        f32x4 acc[8];
#pragma unroll
        for (int dt = 0; dt < 8; ++dt) acc[dt] = (f32x4){0.f, 0.f, 0.f, 0.f};
        const bf16* wa = wsp + ((size_t)g * 128 + 16 * wave + fr) * 128 + 8 * fq;
#pragma unroll
        for (int ks = 0; ks < 4; ++ks) {
            const bf16x8 a = *(const bf16x8*)(wa + 32 * ks);
#pragma unroll
            for (int dt = 0; dt < 8; ++dt) { const bf16x8 b = *(const LAS bf16x8*)(VT + (16 * dt + fr) * VTS + 8 * fq + 32 * ks);
                acc[dt] = __builtin_amdgcn_mfma_f32_16x16x32_bf16(a, b, acc[dt], 0, 0, 0); }
        }
#pragma unroll
        for (int r = 0; r < 4; ++r) { const int i = 16 * wave + 4 * fq + r; const float bs = F.in[I_BSP][((size_t)l * 8 + g) * 128 + i];
            const bf16* up = P + (size_t)(R0 + i) * PINP + CSH + 128 * g + fr; bf16* op = O + (size_t)(R0 + i) * D + DA + 128 * g + fr;
#pragma unroll
            for (int dt = 0; dt < 8; ++dt) op[16 * dt] = (bf16)f2bf(bf2f(up[16 * dt]) * (acc[dt][r] + bs)); }
        __syncthreads();
    }
}

constexpr int T16B = 9216, LD16 = 72, LD32 = 68;
#define SLOT(i) ((LAS bf16*)(lds + (i) * T16B))
#define SLOTF(i) ((LAS float*)(lds + (i) * T16B))
template <int NK>
__device__ __forceinline__ f32x4 tile_mm(const LAS bf16* A, int lda, const LAS bf16* B, int ldb, int fr, int fq, f32x4 acc) {
#pragma unroll
    for (int ks = 0; ks < NK; ++ks) { const bf16x8 a = *(const LAS bf16x8*)(A + fr * lda + 8 * fq + 32 * ks); const bf16x8 b = *(const LAS bf16x8*)(B + fr * ldb + 8 * fq + 32 * ks);
        acc = __builtin_amdgcn_mfma_f32_16x16x32_bf16(a, b, acc, 0, 0, 0); }
    return acc;
}
__device__ __forceinline__ u32x2 pk4(const f32x4 a) { u32x2 w; w.x = pk2(a[0], a[1]); w.y = pk2(a[2], a[3]); return w; }
__device__ __forceinline__ void st_nat(LAS bf16* dst, int n0, int m0, int fr, int fq, const f32x4 a) { *(LAS u32x2*)(dst + (n0 + fr) * LD16 + m0 + 4 * fq) = pk4(a); }
__device__ __forceinline__ void st_rm(LAS bf16* dst, int n0, int m0, int fr, int fq, const f32x4 a) {
#pragma unroll
    for (int r = 0; r < 4; ++r) dst[(m0 + 4 * fq + r) * LD16 + n0 + fr] = (bf16)f2bf(a[r]); }
__device__ __forceinline__ f32x4 ld4bf(const LAS bf16* p) { const u32x2 w = *(const LAS u32x2*)p; return (f32x4){__uint_as_float(w.x << 16), __uint_as_float(w.x & 0xffff0000u), __uint_as_float(w.y << 16), __uint_as_float(w.y & 0xffff0000u)}; }

__device__ __forceinline__ void p_chunkA(Frame& F, int l) {
    PH_LOCALS(F); PH_LAYER(l);
    LAS unsigned char* lds = F.lds;
    const int lane0 = lane;
#define STG int lane_ = lane0; asm volatile("" : "+v"(lane_)); const int fr = lane_ & 15, fq = lane_ >> 4, tid = wave * 64 + lane_; (void)fr; (void)fq; (void)tid;
    const bf16* PS = (const bf16*)(F.ws + WS_PS);
    const bf16* w2t = (const bf16*)(F.ws + WS_W2T) + (size_t)l * 2 * 1024 * 64;
    const bf16* a2t = (const bf16*)(F.ws + WS_A2T) + (size_t)l * 2 * 1024 * 64;
    const bf16* g2t = (const bf16*)(F.ws + WS_G2T) + (size_t)l * 1024 * 160;
    bf16* GATE = (bf16*)(F.ws + WS_GATE); float* BONUS = (float*)(F.ws + WS_BONUS);
    LAS float* gC = (LAS float*)(lds + 14 * T16B);
    for (int item = bx; item < (M / 64) * NH; item += G) {
        const int ci = item >> 4, h = item & 15, R0 = ci * 64;
        for (int d = 0; d < 2; ++d) {
            const size_t qi = ((size_t)ci * 16 + h) * 2 + d;
            { STG; const int ncg = d == 0 ? 36 : 16;
              for (int idx = tid; idx < 64 * ncg; idx += 512) { const int r = idx / ncg, cg = idx % ncg;
                  float f[8]; unpack8(*(const u32x4*)(PS + (size_t)(R0 + r) * CSH + 3 * DA + 8 * cg), f);
                  if (cg < 8) {
#pragma unroll
                      for (int j = 0; j < 8; ++j) f[j] = ftanh(f[j]);
                      *(LAS u32x4*)(SLOT(0) + r * LD16 + 8 * cg) = pack8(f); }
                  else if (cg < 16) *(LAS u32x4*)(SLOT(1) + r * LD16 + 8 * (cg - 8)) = pack8(f);
                  else {
#pragma unroll
                      for (int j = 0; j < 8; ++j) f[j] = fsigmoid(f[j]);
                      *(LAS u32x4*)(SLOT(2) + r * 168 + 8 * (cg - 16)) = pack8(f); } } }
            __syncthreads();
            { STG; LAS float* AL = SLOTF(5); LAS float* LW = SLOTF(7);
#pragma unroll
              for (int tt = 0; tt < 4; ++tt) { const int ti = wave * 4 + tt, which = ti >> 4, t16 = ti & 15, mt = t16 >> 2, nt = t16 & 3;
                  const LAS bf16* A = (which ? SLOT(1) : SLOT(0)) + (16 * mt + fr) * LD16 + 8 * fq;
                  const bf16* B = (which ? a2t : w2t) + ((size_t)d * 1024 + 64 * h + 16 * nt + fr) * 64 + 8 * fq;
                  f32x4 acc = (f32x4){0.f, 0.f, 0.f, 0.f};
#pragma unroll
                  for (int ks = 0; ks < 2; ++ks) acc = __builtin_amdgcn_mfma_f32_16x16x32_bf16(*(const LAS bf16x8*)(A + 32 * ks), *(const bf16x8*)(B + 32 * ks), acc, 0, 0, 0);
                  const int n = 16 * nt + fr; const float bias = (which ? F.in[I_A0] : F.in[I_W0])[((size_t)l * 2 + d) * DA + 64 * h + n];
#pragma unroll
                  for (int r = 0; r < 4; ++r) { const int pos = 16 * mt + 4 * fq + r, tau = d ? 63 - pos : pos; const float sg = fsigmoid(bias + acc[r]);
                      if (which) AL[tau * LD32 + n] = sg; else LW[tau * LD32 + n] = -0.6065306597126334f * sg; } }
              if (d == 0) {
#pragma unroll
                  for (int tt = 0; tt < 2; ++tt) { const int t16 = wave * 2 + tt, mt = t16 >> 2, nt = t16 & 3;
                      const LAS bf16* A = SLOT(2) + (16 * mt + fr) * 168 + 8 * fq; const bf16* B = g2t + (size_t)(64 * h + 16 * nt + fr) * 160 + 8 * fq;
                      f32x4 acc = (f32x4){0.f, 0.f, 0.f, 0.f};
#pragma unroll
                      for (int ks = 0; ks < 5; ++ks) acc = __builtin_amdgcn_mfma_f32_16x16x32_bf16(*(const LAS bf16x8*)(A + 32 * ks), *(const bf16x8*)(B + 32 * ks), acc, 0, 0, 0);
#pragma unroll
                      for (int r = 0; r < 4; ++r) GATE[(size_t)(R0 + 16 * mt + 4 * fq + r) * DA + 64 * h + 16 * nt + fr] = (bf16)f2bf(acc[r]); } } }
            __syncthreads();
            { STG; LAS float* LW = SLOTF(7); LAS float* BT = SLOTF(9); const int k = tid & 63, blk = tid >> 6; float run = 0.f;
#pragma unroll
              for (int j = 0; j < 8; ++j) { run += LW[(8 * blk + j) * LD32 + k]; LW[(8 * blk + j) * LD32 + k] = run; }
              BT[blk * 64 + k] = run;
              __syncthreads();
              float off = 0.f;
              for (int b = 0; b < blk; ++b) off += BT[b * 64 + k];
#pragma unroll
              for (int j = 0; j < 8; ++j) LW[(8 * blk + j) * LD32 + k] += off; }
            __syncthreads();
            { STG; const LAS float* AL = SLOTF(5); const LAS float* LW = SLOTF(7);
              const int tau = tid >> 3, c8 = (tid & 7) * 8, pos = d ? 63 - tau : tau, row = R0 + pos, chn = 64 * h + c8;
              float r[8], k[8], v[8];
              unpack8(*(const u32x4*)(PS + (size_t)row * CSH + chn), r);
              unpack8(*(const u32x4*)(PS + (size_t)row * CSH + DA + chn), k);
              unpack8(*(const u32x4*)(PS + (size_t)row * CSH + 2 * DA + chn), v);
              float kk[8], ss = 0.f;
#pragma unroll
              for (int j = 0; j < 8; ++j) { kk[j] = k[j] * F.in[I_KK][(size_t)l * DA + chn + j]; ss += kk[j] * kk[j]; }
              ss += SHX(ss, 1); ss += SHX(ss, 2); ss += SHX(ss, 4);
              const float rn = 1.0f / sqrtf(fmaxf(ss, 1e-24f));
              float at[8], rt[8], bt[8], kt[8], bh[8], kh[8], bon = 0.f;
#pragma unroll
              for (int j = 0; j < 8; ++j) { const float al = AL[tau * LD32 + c8 + j], cs = LW[tau * LD32 + c8 + j], cse = tau > 0 ? LW[(tau - 1) * LD32 + c8 + j] : 0.f, csC = LW[63 * LD32 + c8 + j];
                  const float kkn = kk[j] * rn, kd = k[j] * (1.0f + (al - 1.0f) * F.in[I_KA][(size_t)l * DA + chn + j]), bb = kkn * al;
                  bon += r[j] * kd * F.in[I_RK][(size_t)l * DA + chn + j];
                  const float encs = __expf(-cs), eh = __expf(csC - cs);
                  at[j] = -__expf(cse) * kkn; rt[j] = __expf(cs) * r[j]; bt[j] = encs * bb; kt[j] = encs * kd; bh[j] = eh * bb; kh[j] = eh * kd;
                  if (tau == 63) gC[c8 + j] = __expf(csC); }
              *(LAS u32x4*)(SLOT(0) + tau * LD16 + c8) = pack8(at); *(LAS u32x4*)(SLOT(1) + tau * LD16 + c8) = pack8(rt);
              *(LAS u32x4*)(SLOT(2) + tau * LD16 + c8) = pack8(bt); *(LAS u32x4*)(SLOT(3) + tau * LD16 + c8) = pack8(kt);
#pragma unroll
              for (int j = 0; j < 8; ++j) { SLOT(4)[(c8 + j) * LD16 + tau] = (bf16)f2bf(at[j]); SLOT(9)[(c8 + j) * LD16 + tau] = (bf16)f2bf(bh[j]);
                  SLOT(10)[(c8 + j) * LD16 + tau] = (bf16)f2bf(kh[j]); SLOT(11)[(c8 + j) * LD16 + tau] = (bf16)f2bf(v[j]); }
              bon += SHX(bon, 1); bon += SHX(bon, 2); bon += SHX(bon, 4);
              if ((tid & 7) == 0) BONUS[((size_t)d * M + row) * NH + h] = bon; }
            __syncthreads();
            { STG; const int p = wave >> 1;
#pragma unroll
              for (int tt = 0; tt < 8; ++tt) { const int t16 = (wave & 1) * 8 + tt, mt = t16 >> 2, nt = t16 & 3, m0 = 16 * mt, n0 = 16 * nt;
                  const LAS bf16* A = (p == 1 ? SLOT(0) : (p == 3 ? SLOT(3) : SLOT(2))) + m0 * LD16;
                  const LAS bf16* B = (p == 0 ? SLOT(0) : (p == 1 ? SLOT(3) : SLOT(1))) + n0 * LD16;
                  f32x4 acc = tile_mm<2>(A, LD16, B, LD16, fr, fq, (f32x4){0.f, 0.f, 0.f, 0.f});
                  const int n = n0 + fr;
#pragma unroll
                  for (int r = 0; r < 4; ++r) { const int m = m0 + 4 * fq + r; const bool keep = p == 0 ? (m < n) : (p == 1 ? (n < m) : (m <= n)); acc[r] = keep ? acc[r] : 0.f; }
                  if (p == 0) { st_nat(SLOT(6), n0, m0, fr, fq, acc); st_rm(SLOT(5), n0, m0, fr, fq, acc);
                      f32x4 t0 = acc;
#pragma unroll
                      for (int r = 0; r < 4; ++r) t0[r] += (m0 + 4 * fq + r == n) ? 1.0f : 0.f;
                      st_rm(SLOT(7), n0, m0, fr, fq, t0); }
                  else st_nat(p == 1 ? SLOT(8) : (p == 2 ? SLOT(12) : SLOT(13)), n0, m0, fr, fq, acc); } }
            __syncthreads();
            { STG;
#pragma unroll
              for (int tt = 0; tt < 2; ++tt) { const int t16 = wave * 2 + tt, m0 = 16 * (t16 >> 2), n0 = 16 * (t16 & 3);
                  const f32x4 acc = tile_mm<2>(SLOT(5) + m0 * LD16, LD16, SLOT(6) + n0 * LD16, LD16, fr, fq, (f32x4){0.f, 0.f, 0.f, 0.f});
                  st_rm(SLOT(0), n0, m0, fr, fq, acc); st_nat(SLOT(2), n0, m0, fr, fq, acc); }
              __syncthreads();
#pragma unroll
              for (int kq = 1; kq <= 5; ++kq) {
                  STG; const int pin_rm = (kq & 1) ? 0 : 5, pin_t = (kq & 1) ? 2 : 6, pout_rm = (kq & 1) ? 5 : 0, pout_t = (kq & 1) ? 6 : 2, tin = (kq & 1) ? 7 : 3, tout = (kq & 1) ? 3 : 7;
                  if (wave < 4) {
#pragma unroll
                      for (int tt = 0; tt < 4; ++tt) { const int t16 = wave * 4 + tt, m0 = 16 * (t16 >> 2), n0 = 16 * (t16 & 3);
                          f32x4 acc;
#pragma unroll
                          for (int r = 0; r < 4; ++r) acc[r] = bf2f(SLOT(tin)[(m0 + 4 * fq + r) * LD16 + n0 + fr]);
                          acc = tile_mm<2>(SLOT(tin) + m0 * LD16, LD16, SLOT(pin_t) + n0 * LD16, LD16, fr, fq, acc);
                          st_rm(SLOT(tout), n0, m0, fr, fq, acc); } }
                  else if (kq < 5) {
#pragma unroll
                      for (int tt = 0; tt < 4; ++tt) { const int t16 = (wave - 4) * 4 + tt, m0 = 16 * (t16 >> 2), n0 = 16 * (t16 & 3);
                          const f32x4 acc = tile_mm<2>(SLOT(pin_rm) + m0 * LD16, LD16, SLOT(pin_t) + n0 * LD16, LD16, fr, fq, (f32x4){0.f, 0.f, 0.f, 0.f});
                          st_rm(SLOT(pout_rm), n0, m0, fr, fq, acc); st_nat(SLOT(pout_t), n0, m0, fr, fq, acc); } }
                  __syncthreads();
              } }
            { STG;
#pragma unroll
              for (int tt = 0; tt < 4; ++tt) { const int xt = wave, m0 = 16 * tt;
                  const LAS bf16* B = (xt < 4 ? SLOT(12) + 16 * xt * LD16 : SLOT(9) + 16 * (xt - 4) * LD16);
                  const f32x4 acc = tile_mm<2>(SLOT(3) + m0 * LD16, LD16, B, LD16, fr, fq, (f32x4){0.f, 0.f, 0.f, 0.f});
                  st_nat(xt < 4 ? SLOT(5) : SLOT(6), 16 * (xt & 3), m0, fr, fq, acc); } }
            __syncthreads();
            { STG; const int p = wave >> 1;
              bf16* gout = (bf16*)(F.ws + (p == 0 ? WS_PYT : (p == 1 ? WS_QYT : WS_PST))) + qi * 4096;
#pragma unroll
              for (int tt = 0; tt < 8; ++tt) { const int t16 = (wave & 1) * 8 + tt, mt = t16 >> 2, nt = t16 & 3, m0 = 16 * mt, n0 = 16 * nt;
                  const LAS bf16* A = ((p & 1) ? SLOT(8) : SLOT(4)) + m0 * LD16;
                  const LAS bf16* B = (p < 2 ? SLOT(5) : SLOT(6)) + n0 * LD16;
                  f32x4 acc = tile_mm<2>(A, LD16, B, LD16, fr, fq, (f32x4){0.f, 0.f, 0.f, 0.f});
                  const int n = n0 + fr, mb = m0 + 4 * fq;
                  if (p == 0) acc += ld4bf(SLOT(1) + n * LD16 + mb);
                  else if (p == 1) acc += ld4bf(SLOT(13) + n * LD16 + mb);
                  else if (p == 2) {
#pragma unroll
                      for (int r = 0; r < 4; ++r) acc[r] += (mb + r == n) ? gC[n] : 0.f; }
                  else acc += ld4bf(SLOT(10) + n * LD16 + mb);
                  if (p < 3) *(u32x2*)(gout + n * 64 + mb) = pk4(acc);
                  else st_nat(SLOT(0), n0, m0, fr, fq, acc); } }
            __syncthreads();
            { STG; bf16* nct = (bf16*)(F.ws + WS_NCT) + qi * 4096; bf16* vtg = (bf16*)(F.ws + WS_VTG) + qi * 4096;
#pragma unroll
              for (int tt = 0; tt < 2; ++tt) { const int t16 = wave * 2 + tt, m0 = 16 * (t16 >> 2), n0 = 16 * (t16 & 3);
                  const f32x4 acc = tile_mm<2>(SLOT(0) + m0 * LD16, LD16, SLOT(11) + n0 * LD16, LD16, fr, fq, (f32x4){0.f, 0.f, 0.f, 0.f});
                  *(u32x2*)(nct + (n0 + fr) * 64 + m0 + 4 * fq) = pk4(acc); }
              { const int vv = tid >> 3, part = tid & 7; *(u32x4*)(vtg + vv * 64 + 8 * part) = *(const LAS u32x4*)(SLOT(11) + vv * LD16 + 8 * part); } }
            __syncthreads();
        }
    }
}
#undef STG

__device__ __forceinline__ void p_chunkB(Frame& F, int l) {
    PH_LOCALS(F); PH_LAYER(l);
    const int fr = lane & 15, fq = lane >> 4;
    LAS bf16* Sl = (LAS bf16*)(F.lds + wave * 2304);
    const bf16* PST = (const bf16*)(F.ws + WS_PST); const bf16* NCT = (const bf16*)(F.ws + WS_NCT); bf16* SC = (bf16*)(F.ws + WS_SC);
    for (int t = bx + G * wave; t < 2560; t += G * NWAVES) {
        const bool lat = t < 512; const int tt = lat ? t : t - 512; const int chain = tt >> 2, vb = tt & 3;
        const int b = chain >> 5, h = (chain >> 1) & 15, d = chain & 1;
        const int cb = lat ? 64 + b * 64 : b * 4, NC = lat ? 64 : 4;
        f32x4 S[4];
        if (lat) { const float* src = F.in[I_STATE] + ((((size_t)b * NL + l) * 2 + d) * NH + h) * 4096 + (size_t)(16 * vb + fr) * 64 + 4 * fq;
#pragma unroll
            for (int T = 0; T < 4; ++T) S[T] = *(const f32x4*)(src + 16 * T); }
        else {
#pragma unroll
            for (int T = 0; T < 4; ++T) S[T] = (f32x4){0.f, 0.f, 0.f, 0.f}; }
        bf16x8 Apf[4][8]; u32x2 Npf[4][4];
#define CB_QI(step) ((((size_t)(cb + (d ? NC - 1 - (step) : (step)))) * 16 + h) * 2 + d)
#define CB_LOAD(u, step) do { const size_t q_ = CB_QI(step); const bf16* ps_ = PST + q_ * 4096 + fr * 64 + 8 * fq; const bf16* nc_ = NCT + q_ * 4096 + (16 * vb + fr) * 64 + 4 * fq; \
        _Pragma("unroll") for (int mt_ = 0; mt_ < 4; ++mt_) { Apf[u][2 * mt_] = *(const bf16x8*)(ps_ + mt_ * 1024); Apf[u][2 * mt_ + 1] = *(const bf16x8*)(ps_ + mt_ * 1024 + 32); Npf[u][mt_] = *(const u32x2*)(nc_ + 16 * mt_); } } while (0)
        CB_LOAD(0, 0); CB_LOAD(1, 1); CB_LOAD(2, 2); CB_LOAD(3, 3);
        for (int g = 0; g < NC; g += 4) {
#pragma unroll
            for (int u = 0; u < 4; ++u) {
                const int step = g + u; const size_t q = CB_QI(step);
                bf16* scg = SC + q * 4096 + (16 * vb + fr) * 64 + 4 * fq;
                asm volatile("" ::: "memory");
#pragma unroll
                for (int T = 0; T < 4; ++T) { const u32x2 w = pk4(S[T]); *(LAS u32x2*)(Sl + fr * LD16 + 16 * T + 4 * fq) = w; *(u32x2*)(scg + 16 * T) = w; }
                asm volatile("s_waitcnt lgkmcnt(0)" ::: "memory");
                const bf16x8 b0 = *(const LAS bf16x8*)(Sl + fr * LD16 + 8 * fq), b1 = *(const LAS bf16x8*)(Sl + fr * LD16 + 8 * fq + 32);
#pragma unroll
                for (int mt = 0; mt < 4; ++mt) { const u32x2 nw = Npf[u][mt];
                    f32x4 acc = (f32x4){__uint_as_float(nw.x << 16), __uint_as_float(nw.x & 0xffff0000u), __uint_as_float(nw.y << 16), __uint_as_float(nw.y & 0xffff0000u)};
                    acc = __builtin_amdgcn_mfma_f32_16x16x32_bf16(Apf[u][2 * mt], b0, acc, 0, 0, 0);
                    acc = __builtin_amdgcn_mfma_f32_16x16x32_bf16(Apf[u][2 * mt + 1], b1, acc, 0, 0, 0);
                    S[mt] = acc; }
                asm volatile("s_waitcnt lgkmcnt(0)" ::: "memory");
                if (step + 4 < NC) CB_LOAD(u, step + 4);
            }
        }
#undef CB_LOAD
#undef CB_QI
        if (!lat) { float* dst = F.out + (size_t)M * D + ((((size_t)b * NL + l) * 2 + d) * NH + h) * 4096 + (size_t)(16 * vb + fr) * 64 + 4 * fq;
#pragma unroll
            for (int T = 0; T < 4; ++T) *(f32x4*)(dst + 16 * T) = S[T]; }
    }
}

__device__ __forceinline__ void p_chunkC(Frame& F, int l) {
    PH_LOCALS(F); PH_LAYER(l);
    LAS unsigned char* lds = F.lds;
    const int fr = lane & 15, fq = lane >> 4;
    const bf16* PS = (const bf16*)(F.ws + WS_PS); const bf16* GATE = (const bf16*)(F.ws + WS_GATE); const float* BONUS = (const float*)(F.ws + WS_BONUS);
    bf16* O = (bf16*)(F.ws + WS_O);
    for (int item = bx; item < (M / 64) * NH; item += G) {
        const int ci = item >> 4, h = item & 15, R0 = ci * 64;
        { const int d = wave >> 2, nb = wave & 3; const size_t qi = ((size_t)ci * 16 + h) * 2 + d;
          const bf16* sc = (const bf16*)(F.ws + WS_SC) + qi * 4096 + fr * 64 + 8 * fq; const bf16* vt = (const bf16*)(F.ws + WS_VTG) + qi * 4096 + fr * 64 + 8 * fq;
          const bf16* py = (const bf16*)(F.ws + WS_PYT) + qi * 4096 + (16 * nb + fr) * 64 + 8 * fq; const bf16* qy = (const bf16*)(F.ws + WS_QYT) + qi * 4096 + (16 * nb + fr) * 64 + 8 * fq;
          const bf16x8 bp0 = *(const bf16x8*)py, bp1 = *(const bf16x8*)(py + 32), bq0 = *(const bf16x8*)qy, bq1 = *(const bf16x8*)(qy + 32);
          f32x4 acc[4]; float s = 0.f;
#pragma unroll
          for (int vtile = 0; vtile < 4; ++vtile) { f32x4 a = (f32x4){0.f, 0.f, 0.f, 0.f};
              a = __builtin_amdgcn_mfma_f32_16x16x32_bf16(*(const bf16x8*)(sc + vtile * 1024), bp0, a, 0, 0, 0);
              a = __builtin_amdgcn_mfma_f32_16x16x32_bf16(*(const bf16x8*)(sc + vtile * 1024 + 32), bp1, a, 0, 0, 0);
              a = __builtin_amdgcn_mfma_f32_16x16x32_bf16(*(const bf16x8*)(vt + vtile * 1024), bq0, a, 0, 0, 0);
              a = __builtin_amdgcn_mfma_f32_16x16x32_bf16(*(const bf16x8*)(vt + vtile * 1024 + 32), bq1, a, 0, 0, 0);
              acc[vtile] = a; s += (a[0] + a[1]) + (a[2] + a[3]); }
          s += SHX(s, 16); s += SHX(s, 32);
          const float mean = s * (1.0f / 64.0f); float qv = 0.f;
#pragma unroll
          for (int vtile = 0; vtile < 4; ++vtile) { acc[vtile] = acc[vtile] - mean; const f32x4 a = acc[vtile]; qv += (a[0] * a[0] + a[1] * a[1]) + (a[2] * a[2] + a[3] * a[3]); }
          qv += SHX(qv, 16); qv += SHX(qv, 32);
          const float rstd = 1.0f / sqrtf(qv * (1.0f / 64.0f) + GN_EPS);
          const int tau = 16 * nb + fr, pos = d ? 63 - tau : tau;
          LAS float* Yd = (LAS float*)(lds + d * 17408);
#pragma unroll
          for (int vtile = 0; vtile < 4; ++vtile) { const int v0 = 16 * vtile + 4 * fq;
              const f32x4 gw = *(const f32x4*)(F.in[I_GNW] + (size_t)l * DA + 64 * h + v0), gb = *(const f32x4*)(F.in[I_GNB] + (size_t)l * DA + 64 * h + v0);
              *(LAS f32x4*)(Yd + pos * LD32 + v0) = acc[vtile] * rstd * gw + gb; } }
        __syncthreads();
        { const int pos = tid >> 3, c8 = (tid & 7) * 8, row = R0 + pos, chn = 64 * h + c8;
          const LAS float* Y0 = (const LAS float*)lds; const LAS float* Y1 = (const LAS float*)(lds + 17408);
          float v[8], gt[8], o[8];
          unpack8(*(const u32x4*)(PS + (size_t)row * CSH + 2 * DA + chn), v);
          unpack8(*(const u32x4*)(GATE + (size_t)row * DA + chn), gt);
          const float bon = BONUS[(size_t)row * NH + h] + BONUS[((size_t)M + row) * NH + h];
#pragma unroll
          for (int j = 0; j < 8; ++j) o[j] = (Y0[pos * LD32 + c8 + j] + Y1[pos * LD32 + c8 + j] + bon * v[j]) * gt[j];
          *(u32x4*)(O + (size_t)row * D + chn) = pack8(o); }
        __syncthreads();
    }
}

__device__ __forceinline__ void p_final(Frame& F) {
    PH_LOCALS(F);
    const int gw = bx * NWAVES + wave, NGW = G * NWAVES;
    const float* fg = F.in[I_FNG];
    for (int row = gw; row < M; row += NGW) {
        float* xr = F.out + (size_t)row * D;
        f32x4 v[8]; float ss = 0.f;
#pragma unroll
        for (int j = 0; j < 8; ++j) { v[j] = *(const f32x4*)(xr + 4 * lane + 256 * j); ss += (v[j].x * v[j].x + v[j].y * v[j].y) + (v[j].z * v[j].z + v[j].w * v[j].w); }
        WAVE_SUM(ss); const float rstd = 1.0f / sqrtf(ss * (1.0f / D) + RMS_EPS);
#pragma unroll
        for (int j = 0; j < 8; ++j) { const int c = 4 * lane + 256 * j; *(f32x4*)(xr + c) = v[j] * rstd * *(const f32x4*)(fg + c); }
    }
}

constexpr int PH_PER_LAYER = 10, N_PHASES = 2 + NL * PH_PER_LAYER;
__global__ void __launch_bounds__(NWAVES * 64, 2) hymba_fwd(Args args) {
    extern __shared__ __attribute__((aligned(16))) unsigned char lds[];
    Frame F;
    F.lds = (LAS unsigned char*)lds;
    F.tid = threadIdx.x; F.lane = F.tid & 63; F.wave = __builtin_amdgcn_readfirstlane(F.tid >> 6);
    F.G = gridDim.x; F.bx = blockIdx.x;
    F.in = args.in; F.out = args.out; F.ws = args.ws;
    for (int u = F.tid; u < (LDS_BYTES - LDSCTL_OFF) / 4; u += NWAVES * 64) ((LAS unsigned*)(F.lds + LDSCTL_OFF))[u] = 0u;
    __syncthreads();
    volatile LAS unsigned* MISC = (volatile LAS unsigned*)(F.lds + MISC_OFF);
    unsigned* barw = (unsigned*)(F.ws + WS_CTL) + CW_BAR;
    XcdBarrier bar; bar.bar = barw; bar.x = 0; bar.st = nullptr;
    if (MK_N_LAUNCHES == 1) bar = xcd_barrier_post(barw, MISC + 8);
    const int lo = args.ph_lo, hi = args.ph_hi;
#define IN(k) (lo <= (k) && (k) < hi)
#define SEAM(k) do { if (MK_N_LAUNCHES == 1 && IN(k) && IN((k) + 1)) xcd_barrier(bar); } while (0)

    if (IN(0)) { p0_prologue(F); } SEAM(0);
    bf16* H = (bf16*)(F.ws + WS_H); bf16* O = (bf16*)(F.ws + WS_O); bf16* P = (bf16*)(F.ws + WS_P); bf16* HID = (bf16*)(F.ws + WS_HID);
    const float* mod = (const float*)(F.ws + WS_MOD);
    for (int l = 0; l < NL; ++l) {
        const int pb = 1 + l * PH_PER_LAYER;
        const float* xlo = l == 0 ? F.in[I_XP] : F.out; const float* xhi = l == 0 ? F.in[I_XS] : F.out + (size_t)MCTX * D;
        if (IN(pb + 0)) { p_adaln(F, l, 0, xlo, xhi); } SEAM(pb + 0);
        if (IN(pb + 1)) { pg8::Gemm g{H, (const bf16*)(F.ws + WS_WIN + l * SZ_WIN), M, PINP, D}; pg8::StaticOrder S; S.init(M, PINP, F.G, F.bx);
            EpiP E{P, PINP, CSH}; pg8::gemm_phase<EpiP, pg8::StaticOrder, true, true>(F.lds, g, S, E, F.wave); } SEAM(pb + 1);
        if (IN(pb + 2)) { p_shift(F, l); } SEAM(pb + 2);
        if (IN(pb + 3)) { p_chunkA(F, l); p_gmlp(F, l); } SEAM(pb + 3);
        if (IN(pb + 4)) { p_chunkB(F, l); } SEAM(pb + 4);
        if (IN(pb + 5)) { p_chunkC(F, l); } SEAM(pb + 5);
        if (IN(pb + 6)) { pg8::Gemm g{O, (const bf16*)(F.ws + WS_WOUT + l * SZ_WOUT), M, D, D}; pg8::StaticOrder S; S.init(M, D, F.G, F.bx);
            EpiRes E{xlo, xhi, F.out, mod + (size_t)l * 5 * MODW, 2 * D}; pg8::gemm_phase<EpiRes, pg8::StaticOrder, true, true>(F.lds, g, S, E, F.wave); } SEAM(pb + 6);
        if (IN(pb + 7)) { p_adaln(F, l, 1, F.out, F.out + (size_t)MCTX * D); } SEAM(pb + 7);
        if (IN(pb + 8)) { pg8::Gemm g{H, (const bf16*)(F.ws + WS_WGU + l * SZ_WGU), M, NGU, D}; pg8::StaticOrder S; S.init(M, NGU, F.G, F.bx);
            EpiSwi E{HID, DFF}; pg8::gemm_phase<EpiSwi, pg8::StaticOrder, true, true>(F.lds, g, S, E, F.wave); } SEAM(pb + 8);
        if (IN(pb + 9)) { pg8::Gemm g{HID, (const bf16*)(F.ws + WS_WD + l * SZ_WD), M, D, DFF}; pg8::StaticOrder S; S.init(M, D, F.G, F.bx);
            EpiRes E{F.out, F.out + (size_t)MCTX * D, F.out, mod + (size_t)l * 5 * MODW, 5 * D}; pg8::gemm_phase<EpiRes, pg8::StaticOrder, true, true>(F.lds, g, S, E, F.wave); } SEAM(pb + 9);
    }
    if (IN(N_PHASES - 1)) { p_final(F); }
#undef IN
#undef SEAM
}

extern "C" void kernel_launch(void* const* d_in, const int* in_sizes, int n_in, void* d_out, int out_size, void* d_ws, size_t ws_size, hipStream_t stream) {
    static int grid = 0;
    if (grid == 0) {
        if (n_in != 30 || ws_size < WS_END) { fprintf(stderr, "kernel_launch: need 30 inputs and >= %zu bytes of workspace; got n_in %d, ws %zu\n", (size_t)WS_END, n_in, ws_size); grid = -1; return; }
        int dev = 0, cus = 0, per_cu = 0;
        if (hipGetDevice(&dev) != hipSuccess || hipDeviceGetAttribute(&cus, hipDeviceAttributeMultiprocessorCount, dev) != hipSuccess) { grid = -1; return; }
        if (hipFuncSetAttribute((const void*)hymba_fwd, hipFuncAttributeMaxDynamicSharedMemorySize, LDS_BYTES) != hipSuccess) { fprintf(stderr, "kernel_launch: hipFuncSetAttribute failed\n"); grid = -1; return; }
        if (hipOccupancyMaxActiveBlocksPerMultiprocessor(&per_cu, (const void*)hymba_fwd, NWAVES * 64, LDS_BYTES) != hipSuccess || per_cu < 1)
            fprintf(stderr, "kernel_launch: note: occupancy query reports %d workgroups per CU\n", per_cu);
        (void)hipGetLastError();
        grid = cus;
    }
    if (grid < 0) return;
    if (hipMemsetAsync((char*)d_ws + WS_CTL, 0, CTL_ZERO_BYTES, stream) != hipSuccess) return;
    Args a{};
    for (int i = 0; i < 30; ++i) a.in[i] = (const float*)d_in[i];
    a.out = (float*)d_out; a.ws = (unsigned char*)d_ws; a.pad = 0;
    if (MK_N_LAUNCHES == 1) {
        a.ph_lo = 0; a.ph_hi = N_PHASES; a.li = 0;
        hipLaunchKernelGGL(hymba_fwd, dim3(grid), dim3(NWAVES * 64), LDS_BYTES, stream, a);
    } else {
        for (int k = 0; k < N_PHASES; ++k) { a.ph_lo = k; a.ph_hi = k + 1; a.li = k;
            hipLaunchKernelGGL(hymba_fwd, dim3(grid), dim3(NWAVES * 64), LDS_BYTES, stream, a); }
    }
}
```

```cpp
#include <hip/hip_runtime.h>
#include <cstdio>
#include <cstdint>

#ifndef PROBE_DUP
#define PROBE_DUP -1
#endif
#ifndef PROBE_SUB
#define PROBE_SUB 0
#endif
#ifndef MK_N_LAUNCHES
#define MK_N_LAUNCHES 1
#endif

namespace pg8 {
#define PG8_LAS __attribute__((address_space(3)))
typedef unsigned short bf16_t;
typedef short bf16x8 __attribute__((ext_vector_type(8)));
typedef float f32x4 __attribute__((ext_vector_type(4)));
typedef unsigned u32x4 __attribute__((ext_vector_type(4)));
constexpr int BM = 256, BK = 64, HALF = 128, HTB = HALF * BK * 2  , STAGE_BYTES = 8 * HTB, NXCD = 8, WGM = 8;

__host__ __device__ __forceinline__ int lds_byte(int r, int c) { const int st = (r >> 4) * 2 + (c >> 5), rr = r & 15, cc = c & 31, ob = rr * 64 + cc * 2; return st * 1024 + (ob ^ (((ob >> 9) & 1) << 5)); }
__host__ __device__ __forceinline__ void stage_rc(int b, int& R, int& C) { const int st = b / 1024, sb = b % 1024, swz = sb ^ (((sb >> 9) & 1) << 5); R = (st >> 1) * 16 + swz / 64; C = (st & 1) * 32 + (swz % 64) / 2; }
__host__ __device__ __forceinline__ int perm32(int rho) { const int n = rho >> 4, i = rho & 15; return 8 * (i >> 2) + 4 * n + (i & 3); }

struct Unit { int pm, pn; };
struct Gemm { const bf16_t* A; const bf16_t* Bt; int M, N, K; };

struct StaticOrder {
    int nM, nN, nwg, G, c;
    __host__ __device__ void init(int M, int N, int G_, int c_) { nM = M / BM; nN = N / BM; nwg = nM * nN; G = G_; c = c_; }
    __host__ __device__ bool next(int i, Unit& u) const {
        const long L = (long)i * G + c; if (L >= nwg) return false;
        int wgid = (int)L; { const int q = nwg / NXCD, r = nwg % NXCD, xcd = wgid % NXCD, off = wgid / NXCD; wgid = (xcd < r ? xcd * (q + 1) : r * (q + 1) + (xcd - r) * q) + off; }
        const int nig = WGM * nN, gid = wgid / nig, fm = gid * WGM, gsz = (nM - fm) < WGM ? (nM - fm) : WGM;
        u.pm = fm + ((wgid % nig) % gsz); u.pn = (wgid % nig) / gsz; return true;
    }
    __device__ __forceinline__ void a_ready(const Unit&) const {}
    __device__ __forceinline__ void done(const Unit&) const {}
};

__device__ __forceinline__ unsigned cvt_pk_bf16(float lo, float hi) { unsigned r; asm volatile("v_cvt_pk_bf16_f32 %0, %1, %2" : "=v"(r) : "v"(lo), "v"(hi)); return r; }

template <class Epi, class Sched, bool ALIGN_EPI = false, bool SP2 = false>
__device__ __forceinline__ void gemm_phase(PG8_LAS unsigned char* lds, const Gemm g, const Sched& S, const Epi& E, int wid) {
    asm volatile("" : "+s"(wid)); int lane; asm volatile("v_mbcnt_lo_u32_b32 %0, -1, 0\n\tv_mbcnt_hi_u32_b32 %0, -1, %0" : "=v"(lane));
    const int tid = wid * 64 + lane, wr = wid >> 2, wc = wid & 3, fr = lane & 15, fq = lane >> 4;
    const int K = g.K, nt = K / BK;
    unsigned voffA[2], voffB[2];
#pragma unroll
    for (int i = 0; i < 2; ++i) { int R, C; stage_rc(tid * 16 + i * 8192, R, C); const int Rb = Epi::PERM ? ((R & ~31) + perm32(R & 31)) : R;
        voffA[i] = (unsigned)(R * K + C) * 2u; voffB[i] = (unsigned)(Rb * K + C) * 2u; }
    const size_t kstep = (size_t)(BK * 2);
    const size_t hstep = (size_t)HALF * K * 2;
    const size_t tstep = 2 * hstep;
    const unsigned ldsw = (unsigned)wid * 1024u;
    const int aoff = lds_byte(wr * 64 + fr, fq * 8), boff = lds_byte(wc * 32 + fr, fq * 8);
#define PG8_SA(b, h) (((b) * 2 + (h)) * HTB)
#define PG8_SB(b, h) ((4 + (b) * 2 + (h)) * HTB)
#define PG8_STAGE(bufoff, gbase, voff) do { _Pragma("unroll") for (int _i = 0; _i < 2; ++_i) \
        __builtin_amdgcn_global_load_lds((const unsigned*)((const char*)(gbase) + (voff)[_i]), (PG8_LAS unsigned*)(lds + (bufoff) + ldsw + _i * 8192), 16, 0, 0); } while (0)
#define PG8_LDA(dst, b, h) do { _Pragma("unroll") for (int m = 0; m < 4; ++m) _Pragma("unroll") for (int k = 0; k < 2; ++k) dst[m][k] = *(const PG8_LAS bf16x8*)(lds + PG8_SA(b, h) + aoff + m * 2048 + k * 1024); } while (0)
#define PG8_LDB(dst, b, h) do { _Pragma("unroll") for (int n = 0; n < 2; ++n) _Pragma("unroll") for (int k = 0; k < 2; ++k) dst[n][k] = *(const PG8_LAS bf16x8*)(lds + PG8_SB(b, h) + boff + n * 2048 + k * 1024); } while (0)
#define PG8_MMA(ai, bj, At, Bt) do { __builtin_amdgcn_s_setprio(1); _Pragma("unroll") for (int m = 0; m < 4; ++m) _Pragma("unroll") for (int n = 0; n < 2; ++n) _Pragma("unroll") for (int k = 0; k < 2; ++k) \
        acc[ai][bj][m][n] = __builtin_amdgcn_mfma_f32_16x16x32_bf16(Bt[n][k], At[m][k], acc[ai][bj][m][n], 0, 0, 0); __builtin_amdgcn_s_setprio(0); } while (0)
#define PG8_WAIT_V(n) asm volatile("s_waitcnt vmcnt(" #n ")" ::: "memory")
#define PG8_WAIT_L(n) asm volatile("s_waitcnt lgkmcnt(" #n ")" ::: "memory")
#define PG8_BAR __builtin_amdgcn_s_barrier()
#define PG8_SCHED __builtin_amdgcn_sched_barrier(0)
    Unit cur, nxt; int ui = 0;
    if (!S.next(0, cur)) return;
    f32x4 acc[2][2][4][2];
#pragma unroll
    for (int a = 0; a < 2; ++a)
#pragma unroll
        for (int b = 0; b < 2; ++b)
#pragma unroll
            for (int m = 0; m < 4; ++m)
#pragma unroll
                for (int n = 0; n < 2; ++n) acc[a][b][m][n] = (f32x4){0.f, 0.f, 0.f, 0.f};
    bf16x8 At[4][2], B0[2][2], B1[2][2];
    const char* cA = (const char*)g.A + (size_t)cur.pm * tstep; const char* cB = (const char*)g.Bt + (size_t)cur.pn * tstep;
    S.a_ready(cur);
    if constexpr (SP2) {
        PG8_STAGE(PG8_SB(0, 0), cB, voffB); PG8_STAGE(PG8_SB(0, 1), cB + hstep, voffB); PG8_STAGE(PG8_SA(0, 0), cA, voffA); PG8_STAGE(PG8_SA(0, 1), cA + hstep, voffA);
        if (wr == 1) PG8_BAR;
        PG8_WAIT_V(2); PG8_BAR;
        PG8_STAGE(PG8_SB(1, 0), cB + kstep, voffB); PG8_STAGE(PG8_SA(1, 0), cA + kstep, voffA); PG8_STAGE(PG8_SB(1, 1), cB + hstep + kstep, voffB);
        PG8_WAIT_V(6); PG8_BAR;
    } else {
        PG8_STAGE(PG8_SB(0, 0), cB, voffB); PG8_STAGE(PG8_SA(0, 0), cA, voffA); PG8_STAGE(PG8_SB(0, 1), cB + hstep, voffB); PG8_STAGE(PG8_SA(0, 1), cA + hstep, voffA);
        if (wr == 1) PG8_BAR;
        PG8_WAIT_V(4); PG8_BAR;
        PG8_STAGE(PG8_SB(1, 0), cB + kstep, voffB); PG8_STAGE(PG8_SA(1, 0), cA + kstep, voffA); PG8_STAGE(PG8_SB(1, 1), cB + hstep + kstep, voffB);
        PG8_WAIT_V(6); PG8_BAR;
    }
    for (;;) {
        const bool has_next = S.next(ui + 1, nxt);
        const char* nA = has_next ? (const char*)g.A + (size_t)nxt.pm * tstep : cA; const char* nB = has_next ? (const char*)g.Bt + (size_t)nxt.pn * tstep : cB;
        for (int t = 0; t < nt; t += 2) {
            const bool last = (t == nt - 2);
            const char* a1 = cA + (size_t)(t + 1) * kstep;
            const char* a2 = last ? nA : cA + (size_t)(t + 2) * kstep; const char* b2 = last ? nB : cB + (size_t)(t + 2) * kstep;
            const char* a3 = a2 + kstep; const char* b3 = b2 + kstep;
            if (last && has_next) S.a_ready(nxt);
            if constexpr (SP2) {
            PG8_LDB(B0, 0, 0); PG8_LDB(B1, 0, 1); PG8_SCHED; PG8_LDA(At, 0, 0); PG8_STAGE(PG8_SA(1, 1), a1 + hstep, voffA);
            PG8_WAIT_V(8); PG8_WAIT_L(0); PG8_BAR; PG8_MMA(0, 0, At, B0); PG8_MMA(0, 1, At, B1); PG8_BAR; PG8_SCHED;
            PG8_LDA(At, 0, 1); PG8_STAGE(PG8_SB(0, 0), b2, voffB); PG8_STAGE(PG8_SB(0, 1), b2 + hstep, voffB); PG8_STAGE(PG8_SA(0, 0), a2, voffA);
            PG8_WAIT_V(8); PG8_WAIT_L(0); PG8_BAR; PG8_MMA(1, 0, At, B0); PG8_MMA(1, 1, At, B1); PG8_BAR; PG8_SCHED;
            PG8_LDB(B0, 1, 0); PG8_LDB(B1, 1, 1); PG8_SCHED; PG8_LDA(At, 1, 0); PG8_STAGE(PG8_SA(0, 1), a2 + hstep, voffA);
            PG8_WAIT_V(8); PG8_WAIT_L(0); PG8_BAR; PG8_MMA(0, 0, At, B0); PG8_MMA(0, 1, At, B1); PG8_BAR; PG8_SCHED;
            PG8_LDA(At, 1, 1); PG8_STAGE(PG8_SB(1, 0), b3, voffB); PG8_STAGE(PG8_SB(1, 1), b3 + hstep, voffB); PG8_STAGE(PG8_SA(1, 0), a3, voffA);
            PG8_WAIT_V(8); PG8_WAIT_L(0); PG8_BAR; PG8_MMA(1, 0, At, B0); PG8_MMA(1, 1, At, B1); PG8_BAR; PG8_SCHED;
            } else {
            PG8_LDB(B0, 0, 0); PG8_SCHED; PG8_LDA(At, 0, 0); PG8_STAGE(PG8_SA(1, 1), a1 + hstep, voffA);
            PG8_WAIT_L(8); PG8_BAR; PG8_WAIT_L(0); PG8_MMA(0, 0, At, B0); PG8_BAR; PG8_SCHED;
            PG8_LDB(B1, 0, 1); PG8_STAGE(PG8_SB(0, 0), b2, voffB);
            PG8_BAR; PG8_WAIT_L(0); PG8_MMA(0, 1, At, B1); PG8_BAR;
            PG8_LDA(At, 0, 1); PG8_STAGE(PG8_SA(0, 0), a2, voffA);
            PG8_BAR; PG8_WAIT_L(0); PG8_MMA(1, 0, At, B0); PG8_BAR; PG8_SCHED;
            PG8_STAGE(PG8_SB(0, 1), b2 + hstep, voffB);
            PG8_WAIT_V(6); PG8_BAR; PG8_MMA(1, 1, At, B1); PG8_BAR;
            PG8_LDB(B0, 1, 0); PG8_SCHED; PG8_LDA(At, 1, 0); PG8_STAGE(PG8_SA(0, 1), a2 + hstep, voffA);
            PG8_WAIT_L(8); PG8_BAR; PG8_WAIT_L(0); PG8_MMA(0, 0, At, B0); PG8_BAR; PG8_SCHED;
            PG8_LDB(B1, 1, 1); PG8_STAGE(PG8_SB(1, 0), b3, voffB);
            PG8_BAR; PG8_WAIT_L(0); PG8_MMA(0, 1, At, B1); PG8_BAR;
            PG8_LDA(At, 1, 1); PG8_STAGE(PG8_SA(1, 0), a3, voffA);
            PG8_BAR; PG8_WAIT_L(0); PG8_MMA(1, 0, At, B0); PG8_BAR; PG8_SCHED;
            PG8_STAGE(PG8_SB(1, 1), b3 + hstep, voffB);
            PG8_WAIT_V(6); PG8_BAR; PG8_MMA(1, 1, At, B1); PG8_BAR;
            }
        }
        if constexpr (ALIGN_EPI) { if (wr == 0) PG8_BAR; }
        E(acc, cur, wr, wc, fr, fq); S.done(cur);
        if (!has_next) break;
#pragma unroll
        for (int a = 0; a < 2; ++a)
#pragma unroll
            for (int b = 0; b < 2; ++b)
#pragma unroll
                for (int m = 0; m < 4; ++m)
#pragma unroll
                    for (int n = 0; n < 2; ++n) acc[a][b][m][n] = (f32x4){0.f, 0.f, 0.f, 0.f};
        cur = nxt; cA = nA; cB = nB; ++ui;
        if constexpr (ALIGN_EPI) { if (wr == 1) PG8_BAR; }
    }
    PG8_WAIT_V(0);
    if constexpr (!ALIGN_EPI) { if (wr == 0) PG8_BAR; }
    PG8_BAR;
#undef PG8_SA
#undef PG8_SB
#undef PG8_STAGE
#undef PG8_LDA
#undef PG8_LDB
#undef PG8_MMA
#undef PG8_WAIT_V
#undef PG8_WAIT_L
#undef PG8_BAR
#undef PG8_SCHED
}
}

constexpr int NWAVES = 8;
constexpr int D = 2048, MCTX = 4096, MLAT = 16384, M = MCTX + MLAT, NL = 4;
constexpr int DA = 1024, NH = 16, DB = 1024, NG = 8, HB = 128;
constexpr int LW = 64, LAA = 64, LGT = 160;
constexpr int CSH = 3 * DA + LW + LAA + LGT;
constexpr int PIN = CSH + 2 * DB;
constexpr int PINP = 5632;
constexpr int DFF = 5632, NGU = 2 * DFF;
constexpr int MODW = 6 * D;
constexpr float RMS_EPS = 1e-6f, GN_EPS = 64.0f * 1e-5f, LN_EPS = 1e-5f;

constexpr size_t MiB = 1u << 20;
constexpr size_t WS_CTL = 0, CTL_ZERO_BYTES = 1 * MiB;
constexpr size_t WS_MOD = 1 * MiB;
constexpr size_t WS_W2T = 2 * MiB;
constexpr size_t WS_A2T = 3 * MiB;
constexpr size_t WS_G2T = 4 * MiB;
constexpr size_t WS_WSP = 6 * MiB;
constexpr size_t WS_BONUS = 7 * MiB;
constexpr size_t SZ_WIN = (size_t)PINP * D * 2, SZ_WOUT = (size_t)D * D * 2, SZ_WGU = (size_t)NGU * D * 2, SZ_WD = (size_t)D * DFF * 2;
constexpr size_t WS_WIN = 16 * MiB;
constexpr size_t WS_WOUT = WS_WIN + NL * SZ_WIN;
constexpr size_t WS_WGU = WS_WOUT + NL * SZ_WOUT;
constexpr size_t WS_WD = WS_WGU + NL * SZ_WGU;
constexpr size_t WS_H = WS_WD + NL * SZ_WD;
constexpr size_t WS_O = WS_H + (size_t)M * D * 2;
constexpr size_t WS_P = WS_O + (size_t)M * D * 2;
constexpr size_t WS_PS = WS_P + (size_t)M * PINP * 2;
constexpr size_t SZ_T16 = (size_t)M * DA * 2;
constexpr size_t WS_GATE = WS_PS + (size_t)M * CSH * 2;
constexpr size_t SZ_CH = (size_t)(M / 64) * NH * 2 * 8192;
constexpr size_t WS_PST = WS_GATE + SZ_T16;
constexpr size_t WS_NCT = WS_PST + SZ_CH;
constexpr size_t WS_PYT = WS_NCT + SZ_CH;
constexpr size_t WS_QYT = WS_PYT + SZ_CH;
constexpr size_t WS_VTG = WS_QYT + SZ_CH;
constexpr size_t WS_SC = WS_VTG + SZ_CH;
constexpr size_t WS_END1 = WS_SC + SZ_CH;
constexpr size_t WS_HID = WS_GATE;
constexpr size_t WS_END = WS_END1 > WS_HID + (size_t)M * DFF * 2 ? WS_END1 : WS_HID + (size_t)M * DFF * 2;
constexpr int CW_BAR = 4096;

constexpr int RING_BYTES = 131072;
constexpr int LDSCTL_OFF = 15 * 9216, MISC_OFF = LDSCTL_OFF + 320;
constexpr int LDS_BYTES = 147456;

#define GAS __attribute__((address_space(1)))
#define LAS __attribute__((address_space(3)))
typedef unsigned short bf16;
typedef float f32x4 __attribute__((ext_vector_type(4)));
typedef float f32x2 __attribute__((ext_vector_type(2)));
typedef short bf16x8 __attribute__((ext_vector_type(8)));
typedef unsigned u32x4 __attribute__((ext_vector_type(4)));
typedef unsigned u32x2 __attribute__((ext_vector_type(2)));
#define LDS_WAIT() asm volatile("s_waitcnt lgkmcnt(0)" ::: "memory")
#define VM_WAIT() asm volatile("s_waitcnt vmcnt(0)" ::: "memory")
__device__ __forceinline__ unsigned f2bf(float f) { unsigned u = __builtin_bit_cast(unsigned, f); return (u + 0x7fffu + ((u >> 16) & 1u)) >> 16; }
typedef __bf16 bf16x2_t __attribute__((ext_vector_type(2)));
__device__ __forceinline__ unsigned pk2(float lo, float hi) { return __builtin_bit_cast(unsigned, __builtin_convertvector((f32x2){lo, hi}, bf16x2_t)); }
__device__ __forceinline__ float bf2f(unsigned short b) { return __uint_as_float(((unsigned)b) << 16); }
__device__ __forceinline__ void unpack8(const u32x4 q, float (&f)[8]) {
    f[0] = __uint_as_float(q.x << 16); f[1] = __uint_as_float(q.x & 0xffff0000u); f[2] = __uint_as_float(q.y << 16); f[3] = __uint_as_float(q.y & 0xffff0000u);
    f[4] = __uint_as_float(q.z << 16); f[5] = __uint_as_float(q.z & 0xffff0000u); f[6] = __uint_as_float(q.w << 16); f[7] = __uint_as_float(q.w & 0xffff0000u); }
__device__ __forceinline__ u32x4 pack8(const float (&f)[8]) { u32x4 o; o.x = pk2(f[0], f[1]); o.y = pk2(f[2], f[3]); o.z = pk2(f[4], f[5]); o.w = pk2(f[6], f[7]); return o; }
__device__ __forceinline__ float fsigmoid(float x) { return __builtin_amdgcn_rcpf(1.0f + __expf(-x)); }
__device__ __forceinline__ float ftanh(float x) { return 1.0f - 2.0f * __builtin_amdgcn_rcpf(1.0f + __expf(2.0f * x)); }
__device__ __forceinline__ float gelu_tanh(float x) { const float u = 1.5957691216057308f * (x + 0.044715f * x * x * x); return x * __builtin_amdgcn_rcpf(1.0f + __expf(-u)); }
__device__ __forceinline__ int hw_lane() { int l; asm volatile("v_mbcnt_lo_u32_b32 %0, -1, 0\n\tv_mbcnt_hi_u32_b32 %0, -1, %0" : "=v"(l)); return l; }
#define SHX(v, X) __int_as_float(__builtin_amdgcn_ds_bpermute((lane ^ (X)) << 2, __float_as_int(v)))
#define WAVE_SUM(v) do { v += SHX(v, 1); v += SHX(v, 2); v += SHX(v, 4); v += SHX(v, 8); v += SHX(v, 16); v += SHX(v, 32); } while (0)

#define PH_LOCALS(F) int wave = (F).wave; asm volatile("" : "+s"(wave)); const int lane = hw_lane(); const int tid = wave * 64 + lane; \
    int bx = (F).bx, G = (F).G; asm volatile("" : "+s"(bx), "+s"(G)); (void)lane; (void)tid;
#define PH_LAYER(l) asm volatile("" : "+s"(l))

#define XB_TMO      128
#define XB_XCNT(j)  (256  + 64 * (j))
#define XB_XSUB(j)  (1280 + 64 * (j))
#define XB_XGEN(j)  (2304 + 64 * (j))
#define XB_TOP      3328
#define XB_TOPGEN   3392
#define XCD_BAR_WORDS 3456
#define XB_SPIN_CAP (1u << 18)

__device__ __forceinline__ unsigned xb_ld(unsigned* p)              { return __hip_atomic_load(p, __ATOMIC_RELAXED, __HIP_MEMORY_SCOPE_AGENT); }
__device__ __forceinline__ unsigned xb_add(unsigned* p, unsigned v) { return __hip_atomic_fetch_add(p, v, __ATOMIC_RELAXED, __HIP_MEMORY_SCOPE_AGENT); }
__device__ __forceinline__ unsigned xb_xcc_id() { return (unsigned)__builtin_amdgcn_s_getreg((3 << 11) | 20) & 0xFu; }
#define XB_SPIN(cond, bar) do { unsigned _sp = 0; while (cond) { __builtin_amdgcn_s_sleep(1); \
    if ((++_sp & 255u) == 0u) { if (xb_ld(&(bar)[XB_TMO])) break; if (_sp > XB_SPIN_CAP) { atomicAdd(&(bar)[XB_TMO], 1u); break; } } } } while (0)

struct XcdBarrier {
    unsigned* bar; unsigned x;
    volatile LAS unsigned* st;
};
__device__ __forceinline__ XcdBarrier xcd_barrier_post(unsigned* bar, volatile LAS unsigned* st) {
    XcdBarrier b; b.bar = bar; b.x = xb_xcc_id(); b.st = st;
    if (threadIdx.x == 0) (void)xb_add(&bar[XB_XCNT(b.x)], 1u);
    return b;
}
__device__ __forceinline__ void xcd_barrier_complete(unsigned* bar, unsigned x, unsigned& nloc, unsigned& nx) {
    const unsigned G = gridDim.x * gridDim.y * gridDim.z;
    unsigned sum, cnt, mine, sp = 0u;
    for (;;) {
        sum = 0u; cnt = 0u; mine = 0u;
#pragma unroll
        for (unsigned j = 0; j < 16; ++j) { const unsigned c = xb_ld(&bar[XB_XCNT(j)]); sum += c; cnt += (c > 0u) ? 1u : 0u; mine = (j == x) ? c : mine; }
        if (sum == G) break;
        __builtin_amdgcn_s_sleep(1);
        if ((++sp & 255u) == 0u) { if (xb_ld(&bar[XB_TMO])) break; if (sp > XB_SPIN_CAP) { atomicAdd(&bar[XB_TMO], 1u); break; } }
    }
    nloc = mine > 0u ? mine : 1u; nx = cnt > 0u ? cnt : 1u;
}
__device__ __forceinline__ void xcd_barrier(const XcdBarrier& b) {
    asm volatile("s_waitcnt vmcnt(0)" ::: "memory");
    __syncthreads();
    if (threadIdx.x == 0) {
        unsigned* bar = b.bar;
        __builtin_amdgcn_s_waitcnt(0);
        unsigned nloc = b.st[0], nx = b.st[1];
        if (nloc == 0u) { xcd_barrier_complete(bar, b.x, nloc, nx); b.st[0] = nloc; b.st[1] = nx; }
        const unsigned old = xb_add(&bar[XB_XSUB(b.x)], 1u);
        const unsigned gen = old / nloc;
        if (old + 1u == (gen + 1u) * nloc) {
            __builtin_amdgcn_fence(__ATOMIC_RELEASE, "agent");
            asm volatile("s_waitcnt vmcnt(0)" ::: "memory");
            const unsigned og = xb_add(&bar[XB_TOP], 1u);
            const unsigned tg = og / nx;
            if (og + 1u == (tg + 1u) * nx) xb_add(&bar[XB_TOPGEN], 1u);
            else XB_SPIN(xb_ld(&bar[XB_TOPGEN]) == tg, bar);
            __builtin_amdgcn_fence(__ATOMIC_ACQUIRE, "agent");
            xb_add(&bar[XB_XGEN(b.x)], 1u);
            asm volatile("s_waitcnt vmcnt(0)" ::: "memory");
        } else {
            XB_SPIN(xb_ld(&bar[XB_XGEN(b.x)]) == gen, bar);
            __builtin_amdgcn_fence(__ATOMIC_ACQUIRE, "agent");
            asm volatile("s_waitcnt vmcnt(0)" ::: "memory");
        }
    }
    __syncthreads();
}

struct Args {
    const float* in[30];
    float* out; unsigned char* ws;
    int ph_lo, ph_hi, li, pad;
};
enum { I_XP = 0, I_XS, I_STATE, I_C, I_CCTX, I_WMOD, I_BMOD, I_N1G, I_WIN, I_MU, I_W0, I_W2, I_A0, I_A2, I_G2, I_KK, I_KA, I_RK, I_GNW, I_GNB, I_LNG, I_LNB, I_WSP, I_BSP, I_WOUT, I_N2G, I_WG, I_WU, I_WD, I_FNG };

struct Frame {
    LAS unsigned char* lds;
    int tid, lane, wave, G, bx;
    const float* const* in;
    float* out; unsigned char* ws;
};

struct EpiP {
    static constexpr bool PERM = true, AFTER_DRAIN = false;
    bf16* O; int ldc; int gelu_from;
    __device__ __forceinline__ void operator()(const f32x4 (&acc)[2][2][4][2], const pg8::Unit& u, int wr, int wc, int fr, int fq) const {
        const int row0 = u.pm * 256 + wr * 64 + fr, col0 = u.pn * 256 + wc * 32 + 8 * fq;
#pragma unroll
        for (int ai = 0; ai < 2; ++ai)
#pragma unroll
            for (int m = 0; m < 4; ++m) { bf16* rowp = O + (size_t)(row0 + ai * 128 + m * 16) * ldc + col0;
#pragma unroll
                for (int bj = 0; bj < 2; ++bj) { f32x4 v0 = acc[ai][bj][m][0], v1 = acc[ai][bj][m][1];
                    if (col0 + bj * 128 >= gelu_from) {
#pragma unroll
                        for (int j = 0; j < 4; ++j) { v0[j] = gelu_tanh(v0[j]); v1[j] = gelu_tanh(v1[j]); } }
                    u32x4 w; w.x = pg8::cvt_pk_bf16(v0[0], v0[1]); w.y = pg8::cvt_pk_bf16(v0[2], v0[3]); w.z = pg8::cvt_pk_bf16(v1[0], v1[1]); w.w = pg8::cvt_pk_bf16(v1[2], v1[3]);
                    *(u32x4*)(rowp + bj * 128) = w; } }
    }
};
struct EpiRes {
    static constexpr bool PERM = false, AFTER_DRAIN = false;
    const float* xlo; const float* xhi; float* xout; const float* modl; int goff;
    __device__ __forceinline__ void operator()(const f32x4 (&acc)[2][2][4][2], const pg8::Unit& u, int wr, int wc, int fr, int fq) const {
        const int pm = u.pm; const int midx = pm < 16 ? 0 : 1 + ((pm - 16) >> 4);
        const float* gv = modl + (size_t)midx * MODW + goff;
        const float* base = pm < 16 ? xlo + (size_t)pm * 256 * D : xhi + (size_t)(pm - 16) * 256 * D;
        float* ob = xout + (size_t)pm * 256 * D;
        const int col0 = u.pn * 256 + wc * 32 + 4 * fq;
        f32x4 gvv[2][2];
#pragma unroll
        for (int bj = 0; bj < 2; ++bj)
#pragma unroll
            for (int n = 0; n < 2; ++n) gvv[bj][n] = *(const f32x4*)(gv + col0 + bj * 128 + n * 16);
#pragma unroll
        for (int ai = 0; ai < 2; ++ai)
#pragma unroll
            for (int m = 0; m < 4; ++m) { const size_t off = (size_t)(ai * 128 + wr * 64 + m * 16 + fr) * D + col0;
#pragma unroll
                for (int bj = 0; bj < 2; ++bj)
#pragma unroll
                    for (int n = 0; n < 2; ++n) { const f32x4 xo = *(const f32x4*)(base + off + bj * 128 + n * 16);
                        *(f32x4*)(ob + off + bj * 128 + n * 16) = xo + gvv[bj][n] * acc[ai][bj][m][n]; }
                if (m & 1) asm volatile("" ::: "memory"); }
    }
};
struct EpiSwi {
    static constexpr bool PERM = true, AFTER_DRAIN = false;
    bf16* O; int ldc;
    __device__ __forceinline__ void operator()(const f32x4 (&acc)[2][2][4][2], const pg8::Unit& u, int wr, int wc, int fr, int fq) const {
        const int row0 = u.pm * 256 + wr * 64 + fr, col0 = u.pn * 128 + wc * 32 + 8 * fq;
#pragma unroll
        for (int ai = 0; ai < 2; ++ai)
#pragma unroll
            for (int m = 0; m < 4; ++m) { bf16* rowp = O + (size_t)(row0 + ai * 128 + m * 16) * ldc + col0;
                float h[8];
#pragma unroll
                for (int n = 0; n < 2; ++n)
#pragma unroll
                    for (int j = 0; j < 4; ++j) { const float gt = acc[ai][0][m][n][j], up = acc[ai][1][m][n][j]; h[n * 4 + j] = gt * fsigmoid(gt) * up; }
                u32x4 w; w.x = pg8::cvt_pk_bf16(h[0], h[1]); w.y = pg8::cvt_pk_bf16(h[2], h[3]); w.z = pg8::cvt_pk_bf16(h[4], h[5]); w.w = pg8::cvt_pk_bf16(h[6], h[7]);
                *(u32x4*)rowp = w; }
    }
};

template <int MAP>
__device__ __forceinline__ void tr_item(const float* W, int K, int N, bf16* WT, LAS float* scr, int item, int lane) {
    const int nblk = N / 32, kb = item / nblk, nb = item % nblk, k0 = 64 * kb, n0 = 32 * nb;
#pragma unroll 8
    for (int i = 0; i < 32; ++i) { const int kk = 2 * i + (lane >> 5); scr[kk * 33 + (lane & 31)] = W[(size_t)(k0 + kk) * N + n0 + (lane & 31)]; }
    LDS_WAIT(); asm volatile("" ::: "memory");
    const int c = lane & 7;
#pragma unroll
    for (int j = 0; j < 4; ++j) { const int n = (lane >> 3) + 8 * j; const LAS float* s = scr + (8 * c) * 33 + n;
        u32x4 o; o.x = pk2(s[0 * 33], s[1 * 33]); o.y = pk2(s[2 * 33], s[3 * 33]); o.z = pk2(s[4 * 33], s[5 * 33]); o.w = pk2(s[6 * 33], s[7 * 33]);
        const int nn = n0 + n; const int orow = MAP == 0 ? nn : (256 * (nn >> 7) + (nn & 127) + (MAP == 2 ? 128 : 0));
        *(u32x4*)(WT + (size_t)orow * K + k0 + 8 * c) = o; }
    LDS_WAIT(); asm volatile("" ::: "memory");
}
__device__ __forceinline__ void p0_prologue(Frame& F) {
    PH_LOCALS(F);
    LAS float* scr = (LAS float*)(F.lds + wave * 16384);
    const int gw = bx * NWAVES + wave, NGW = G * NWAVES;
    constexpr int I_IN = (D / 64) * (PIN / 32), I_OUT = (D / 64) * (D / 32), I_GU = (D / 64) * (DFF / 32), I_DN = (DFF / 64) * (D / 32);
    constexpr int PL = I_IN + I_OUT + 2 * I_GU + I_DN;
    for (int it = gw; it < NL * PL; it += NGW) {
        const int l = it / PL; int r = it % PL;
        if (r < I_IN) { tr_item<0>(F.in[I_WIN] + (size_t)l * D * PIN, D, PIN, (bf16*)(F.ws + WS_WIN + l * SZ_WIN), scr, r, lane); continue; } r -= I_IN;
        if (r < I_OUT) { tr_item<0>(F.in[I_WOUT] + (size_t)l * D * D, D, D, (bf16*)(F.ws + WS_WOUT + l * SZ_WOUT), scr, r, lane); continue; } r -= I_OUT;
        if (r < I_GU) { tr_item<1>(F.in[I_WG] + (size_t)l * D * DFF, D, DFF, (bf16*)(F.ws + WS_WGU + l * SZ_WGU), scr, r, lane); continue; } r -= I_GU;
        if (r < I_GU) { tr_item<2>(F.in[I_WU] + (size_t)l * D * DFF, D, DFF, (bf16*)(F.ws + WS_WGU + l * SZ_WGU), scr, r, lane); continue; } r -= I_GU;
        tr_item<0>(F.in[I_WD] + (size_t)l * DFF * D, DFF, D, (bf16*)(F.ws + WS_WD + l * SZ_WD), scr, r, lane);
    }
    const int gt = bx * 512 + tid, NGT = G * 512;
    { constexpr int PADV = (PINP - PIN) * D * 2 / 16;
      for (int i = gt; i < NL * PADV; i += NGT) { const int l = i / PADV, r = i % PADV; ((u32x4*)(F.ws + WS_WIN + l * SZ_WIN + (size_t)PIN * D * 2))[r] = (u32x4){0u, 0u, 0u, 0u}; } }
    { bf16* w2t = (bf16*)(F.ws + WS_W2T); bf16* a2t = (bf16*)(F.ws + WS_A2T); bf16* g2t = (bf16*)(F.ws + WS_G2T); bf16* wsp = (bf16*)(F.ws + WS_WSP);
      for (int i = gt; i < NL * 2 * 1024 * 64; i += NGT) { const int k = i & 63, n = (i >> 6) & 1023, ld = i >> 16;
          w2t[i] = (bf16)f2bf(F.in[I_W2][((size_t)ld * 64 + k) * 1024 + n]); a2t[i] = (bf16)f2bf(F.in[I_A2][((size_t)ld * 64 + k) * 1024 + n]); }
      for (int i = gt; i < NL * 1024 * 160; i += NGT) { const int k = i % 160, n = (i / 160) & 1023, l = i / (160 * 1024);
          g2t[i] = (bf16)f2bf(F.in[I_G2][((size_t)l * 160 + k) * 1024 + n]); }
      for (int i = gt; i < NL * 8 * 128 * 128; i += NGT) wsp[i] = (bf16)f2bf(F.in[I_WSP][i]); }
    __syncthreads();
    { LAS float* sv = (LAS float*)F.lds;
      LAS float* red = (LAS float*)(F.lds + 40960);
      for (int i = tid; i < 5 * D; i += 512) { const int r = i / D, k = i % D; const float c = r == 0 ? F.in[I_CCTX][k] : F.in[I_C][(r - 1) * D + k]; sv[i] = c * fsigmoid(c); }
      __syncthreads();
      float* mod = (float*)(F.ws + WS_MOD);
      const int c4 = tid & 15, kg = tid >> 4;
      for (int item = bx; item < NL * (MODW / 64); item += G) {
          const int l = item / (MODW / 64), n0 = (item % (MODW / 64)) * 64;
          const float* W = F.in[I_WMOD] + (size_t)l * D * MODW + n0 + 4 * c4;
          f32x4 a[5];
#pragma unroll
          for (int r = 0; r < 5; ++r) a[r] = (f32x4){0.f, 0.f, 0.f, 0.f};
#pragma unroll 4
          for (int i = 0; i < 64; ++i) { const int k = i * 32 + kg; const f32x4 w = *(const f32x4*)(W + (size_t)k * MODW);
#pragma unroll
              for (int r = 0; r < 5; ++r) a[r] += w * sv[r * D + k]; }
#pragma unroll
          for (int r = 0; r < 5; ++r) *(LAS f32x4*)(red + (kg * 5 + r) * 64 + 4 * c4) = a[r];
          __syncthreads();
          if (tid < 320) { const int r = tid >> 6, n = tid & 63; float s = 0.f;
#pragma unroll 8
              for (int g = 0; g < 32; ++g) s += red[(g * 5 + r) * 64 + n];
              mod[((size_t)l * 5 + r) * MODW + n0 + n] = s + F.in[I_BMOD][(size_t)l * MODW + n0 + n]; }
          __syncthreads();
      } }
}

__device__ __forceinline__ void p_adaln(Frame& F, int l, int which, const float* xlo, const float* xhi) {
    PH_LOCALS(F); PH_LAYER(l);
    const int gw = bx * NWAVES + wave, NGW = G * NWAVES;
    const float* ng = (which == 0 ? F.in[I_N1G] : F.in[I_N2G]) + (size_t)l * D;
    const int shoff = which == 0 ? 0 : 3 * D, scoff = shoff + D;
    const float* mod = (const float*)(F.ws + WS_MOD);
    bf16* H = (bf16*)(F.ws + WS_H);
    for (int row = gw; row < M; row += NGW) {
        const float* xr = row < MCTX ? xlo + (size_t)row * D : xhi + (size_t)(row - MCTX) * D;
        const int midx = row < MCTX ? 0 : 1 + ((row - MCTX) >> 12);
        const float* md = mod + ((size_t)l * 5 + midx) * MODW;
        f32x4 v[8]; float ss = 0.f;
#pragma unroll
        for (int j = 0; j < 8; ++j) { v[j] = *(const f32x4*)(xr + 4 * lane + 256 * j); ss += (v[j].x * v[j].x + v[j].y * v[j].y) + (v[j].z * v[j].z + v[j].w * v[j].w); }
        WAVE_SUM(ss); const float rstd = 1.0f / sqrtf(ss * (1.0f / D) + RMS_EPS);
#pragma unroll
        for (int j = 0; j < 8; ++j) { const int c = 4 * lane + 256 * j;
            const f32x4 g4 = *(const f32x4*)(ng + c), sc = *(const f32x4*)(md + scoff + c), sh = *(const f32x4*)(md + shoff + c);
            const f32x4 o = v[j] * rstd * g4 * (sc + 1.0f) + sh;
            u32x2 w; w.x = pk2(o.x, o.y); w.y = pk2(o.z, o.w);
            *(u32x2*)(H + (size_t)row * D + c) = w; }
    }
}

__device__ __forceinline__ void load_shifted8(const bf16* P, const float* mu, int row, int col, float (&o)[8]) {
    float g[8]; unpack8(*(const u32x4*)(P + (size_t)row * PINP + col), g);
    float a[8];
#pragma unroll
    for (int j = 0; j < 8; ++j) a[j] = g[j];
    int nrow[4]; bool has[4]; int nn;
    if (row < MCTX) { const int t = row & 255; nn = 2; nrow[0] = row - 1; has[0] = t > 0; nrow[1] = row + 1; has[1] = t < 255; nrow[2] = row; has[2] = false; nrow[3] = row; has[3] = false; }
    else { const int t = (row - MCTX) & 4095, gc = t & 63, gr = t >> 6; nn = 4;
        nrow[0] = row - 1; has[0] = gc > 0; nrow[1] = row + 1; has[1] = gc < 63; nrow[2] = row - 64; has[2] = gr > 0; nrow[3] = row + 64; has[3] = gr < 63; }
#pragma unroll
    for (int q = 0; q < 4; ++q) {
        if (q < nn) {
            float nb[8];
            if (has[q]) unpack8(*(const u32x4*)(P + (size_t)nrow[q] * PINP + col), nb);
            else {
#pragma unroll
                for (int j = 0; j < 8; ++j) nb[j] = 0.f; }
            const f32x4 m0 = *(const f32x4*)(mu + q * CSH + col), m1 = *(const f32x4*)(mu + q * CSH + col + 4);
#pragma unroll
            for (int j = 0; j < 4; ++j) { a[j] += m0[j] * (nb[j] - g[j]); a[4 + j] += m1[j] * (nb[4 + j] - g[4 + j]); }
        }
    }
#pragma unroll
    for (int j = 0; j < 8; ++j) o[j] = a[j];
}
__device__ __forceinline__ void p_shift(Frame& F, int l) {
    PH_LOCALS(F); PH_LAYER(l);
    const bf16* P = (const bf16*)(F.ws + WS_P); bf16* PS = (bf16*)(F.ws + WS_PS);
    const float* mu = F.in[I_MU] + (size_t)l * 4 * CSH;
    constexpr int CG = CSH / 8;
    const int rpw = (M + G - 1) / G, rbeg = bx * rpw, rend = (rbeg + rpw < M) ? rbeg + rpw : M;
    if (tid < CG) {
        const int col = tid * 8; const int act = (col >= 3 * DA && col < 3 * DA + LW) ? 1 : (col >= 3 * DA + LW + LAA ? 2 : 0);
        f32x4 m[4][2];
#pragma unroll
        for (int q = 0; q < 4; ++q) { m[q][0] = *(const f32x4*)(mu + q * CSH + col); m[q][1] = *(const f32x4*)(mu + q * CSH + col + 4); }
        for (int r0 = rbeg; r0 < rend; r0 += 4) {
#pragma unroll
            for (int u = 0; u < 4; ++u) { const int row = r0 + u; if (row < rend) {
                const bf16* pc = P + (size_t)row * PINP + col;
                int nrow[4]; bool has[4]; int nn;
                if (row < MCTX) { const int t = row & 255; nn = 2; nrow[0] = -1; has[0] = t > 0; nrow[1] = 1; has[1] = t < 255; nrow[2] = 0; has[2] = false; nrow[3] = 0; has[3] = false; }
                else { const int t = (row - MCTX) & 4095, gc = t & 63, gr = t >> 6; nn = 4; nrow[0] = -1; has[0] = gc > 0; nrow[1] = 1; has[1] = gc < 63; nrow[2] = -64; has[2] = gr > 0; nrow[3] = 64; has[3] = gr < 63; }
                u32x4 raw[5]; raw[0] = *(const u32x4*)pc;
#pragma unroll
                for (int q = 0; q < 4; ++q) raw[1 + q] = (q < nn && has[q]) ? *(const u32x4*)(pc + (ptrdiff_t)nrow[q] * PINP) : (u32x4){0u, 0u, 0u, 0u};
                float g[8], a[8]; unpack8(raw[0], g);
#pragma unroll
                for (int jx = 0; jx < 8; ++jx) a[jx] = g[jx];
#pragma unroll
                for (int q = 0; q < 4; ++q) if (q < nn) { float nb[8]; unpack8(raw[1 + q], nb);
#pragma unroll
                    for (int jx = 0; jx < 4; ++jx) { a[jx] += m[q][0][jx] * (nb[jx] - g[jx]); a[4 + jx] += m[q][1][jx] * (nb[4 + jx] - g[4 + jx]); } }
                if (act == 1) {
#pragma unroll
                    for (int jx = 0; jx < 8; ++jx) a[jx] = ftanh(a[jx]); }
                else if (act == 2) {
#pragma unroll
                    for (int jx = 0; jx < 8; ++jx) a[jx] = fsigmoid(a[jx]); }
                *(u32x4*)(PS + (size_t)row * CSH + col) = pack8(a); } }
        }
    }
}

#define F4Z ((f32x4){0.f, 0.f, 0.f, 0.f})
__device__ __forceinline__ u32x2 pk4(const f32x4 a) { u32x2 w; w.x = pk2(a[0], a[1]); w.y = pk2(a[2], a[3]); return w; }
#define LBAR() do { asm volatile("s_waitcnt lgkmcnt(0)" ::: "memory"); __builtin_amdgcn_s_barrier(); asm volatile("" ::: "memory"); } while (0)
constexpr int VTS = 136;
typedef short s16x4g __attribute__((ext_vector_type(4)));
__device__ __forceinline__ bf16x8 frag_tr_ld(const LAS bf16* X, int ld, int kbase, int c0, int fr, int fq) {
    const LAS bf16* p = X + (kbase + 8 * fq + (fr >> 2)) * ld + c0 + 4 * (fr & 3);
    const s16x4g lo = __builtin_amdgcn_ds_read_tr16_b64_v4i16((LAS s16x4g*)p);
    const s16x4g hi = __builtin_amdgcn_ds_read_tr16_b64_v4i16((LAS s16x4g*)(p + 4 * ld));
    return (bf16x8){lo[0], lo[1], lo[2], lo[3], hi[0], hi[1], hi[2], hi[3]};
}
__device__ __forceinline__ void p_gmlp(Frame& F, int l) {
    PH_LOCALS(F); PH_LAYER(l);
    const bf16* P = (const bf16*)(F.ws + WS_P); bf16* O = (bf16*)(F.ws + WS_O);
    const bf16* wsp = (const bf16*)(F.ws + WS_WSP) + (size_t)l * 8 * 128 * 128;
    LAS bf16* VN = (LAS bf16*)F.lds;
    LAS bf16* ST = (LAS bf16*)(F.lds + 34816);
    const int fr = lane & 15, fq = lane >> 4;
    constexpr int NIT = (M / 128) * NG;
    const int jrow = tid >> 2, q4 = tid & 3;
    u32x4 pvv[4];
#define GM_ISSUE(item_) do { const bf16* src_ = P + (size_t)(((item_) >> 3) * 128 + jrow) * PINP + CSH + DB + 128 * ((item_) & 7) + 32 * q4; \
        _Pragma("unroll") for (int i_ = 0; i_ < 4; ++i_) pvv[i_] = *(const u32x4*)(src_ + 8 * i_); } while (0)
    if (bx < NIT) GM_ISSUE(bx);
    for (int item = bx; item < NIT; item += G) {
        const int cb = item >> 3, g = item & 7, R0 = cb * 128;
        u32x4 pu[4]; { const bf16* up = P + (size_t)(R0 + jrow) * PINP + CSH + 128 * g + 32 * q4;
#pragma unroll
            for (int i = 0; i < 4; ++i) pu[i] = *(const u32x4*)(up + 8 * i); }
        bf16x8 bw[4]; { const bf16* wa = wsp + ((size_t)g * 128 + 16 * wave + fr) * 128 + 8 * fq;
#pragma unroll
            for (int ks = 0; ks < 4; ++ks) bw[ks] = *(const bf16x8*)(wa + 32 * ks); }
        const float bsp = F.in[I_BSP][((size_t)l * 8 + g) * 128 + jrow];
        { float v[32];
#pragma unroll
          for (int i = 0; i < 4; ++i) { float f[8]; unpack8(pvv[i], f);
#pragma unroll
              for (int jj = 0; jj < 8; ++jj) v[8 * i + jj] = f[jj]; }
          float s = 0.f;
#pragma unroll
          for (int i = 0; i < 32; ++i) s += v[i];
          s += SHX(s, 1); s += SHX(s, 2);
          const float mean = s * (1.0f / 128.0f); float qq = 0.f;
#pragma unroll
          for (int i = 0; i < 32; ++i) { v[i] -= mean; qq += v[i] * v[i]; }
          qq += SHX(qq, 1); qq += SHX(qq, 2);
          const float rstd = 1.0f / sqrtf(qq * (1.0f / 128.0f) + LN_EPS);
          const float* lg = F.in[I_LNG] + ((size_t)l * 8 + g) * 128 + 32 * q4; const float* lb = F.in[I_LNB] + ((size_t)l * 8 + g) * 128 + 32 * q4;
#pragma unroll
          for (int i = 0; i < 4; ++i) { float o[8]; const f32x4 g0 = *(const f32x4*)(lg + 8 * i), g1 = *(const f32x4*)(lg + 8 * i + 4), b0 = *(const f32x4*)(lb + 8 * i), b1 = *(const f32x4*)(lb + 8 * i + 4);
#pragma unroll
              for (int jj = 0; jj < 4; ++jj) { o[jj] = v[8 * i + jj] * rstd * g0[jj] + b0[jj]; o[4 + jj] = v[8 * i + 4 + jj] * rstd * g1[jj] + b1[jj]; }
              *(LAS u32x4*)(VN + jrow * VTS + 32 * q4 + 8 * i) = pack8(o); } }
        if (item + G < NIT) GM_ISSUE(item + G);
        LBAR();
#pragma unroll
        for (int mt = 0; mt < 8; ++mt) { f32x4 acc = F4Z;
#pragma unroll
            for (int ks = 0; ks < 4; ++ks) acc = __builtin_amdgcn_mfma_f32_16x16x32_bf16(frag_tr_ld(VN, VTS, 32 * ks, 16 * mt, fr, fq), bw[ks], acc, 0, 0, 0);
            *(LAS u32x2*)(ST + (16 * wave + fr) * VTS + 16 * mt + 4 * fq) = pk4(acc); }
        LBAR();
        { bf16* op = O + (size_t)(R0 + jrow) * D + DA + 128 * g + 32 * q4;
#pragma unroll
          for (int i = 0; i < 4; ++i) { float sv[8], uv[8], o[8]; unpack8(*(const LAS u32x4*)(ST + jrow * VTS + 32 * q4 + 8 * i), sv); unpack8(pu[i], uv);
#pragma unroll
              for (int jj = 0; jj < 8; ++jj) o[jj] = uv[jj] * (sv[jj] + bsp);
              *(u32x4*)(op + 8 * i) = pack8(o); } }
    }
    LBAR();
#undef GM_ISSUE
}

constexpr int T16B = 9216, LD16 = 72, LD32 = 68;
#define SLOT(i) ((LAS bf16*)(lds + (i) * T16B))
#define SLOTF(i) ((LAS float*)(lds + (i) * T16B))
template <int NK>
__device__ __forceinline__ f32x4 tile_mm(const LAS bf16* A, int lda, const LAS bf16* B, int ldb, int fr, int fq, f32x4 acc) {
#pragma unroll
    for (int ks = 0; ks < NK; ++ks) { const bf16x8 a = *(const LAS bf16x8*)(A + fr * lda + 8 * fq + 32 * ks); const bf16x8 b = *(const LAS bf16x8*)(B + fr * ldb + 8 * fq + 32 * ks);
        acc = __builtin_amdgcn_mfma_f32_16x16x32_bf16(a, b, acc, 0, 0, 0); }
    return acc;
}
__device__ __forceinline__ void st_nat(LAS bf16* dst, int n0, int m0, int fr, int fq, const f32x4 a) { *(LAS u32x2*)(dst + (n0 + fr) * LD16 + m0 + 4 * fq) = pk4(a); }
__device__ __forceinline__ void st_rm(LAS bf16* dst, int n0, int m0, int fr, int fq, const f32x4 a) {
#pragma unroll
    for (int r = 0; r < 4; ++r) dst[(m0 + 4 * fq + r) * LD16 + n0 + fr] = (bf16)f2bf(a[r]); }
__device__ __forceinline__ f32x4 ld4bf(const LAS bf16* p) { const u32x2 w = *(const LAS u32x2*)p; return (f32x4){__uint_as_float(w.x << 16), __uint_as_float(w.x & 0xffff0000u), __uint_as_float(w.y << 16), __uint_as_float(w.y & 0xffff0000u)}; }

typedef short s16x4 __attribute__((ext_vector_type(4)));
__device__ __forceinline__ bf16x8 frag_tr(const LAS bf16* X, int kbase, int c0, int fr, int fq) {
    const LAS bf16* p = X + (kbase + 8 * fq + (fr >> 2)) * LD16 + c0 + 4 * (fr & 3);
    const s16x4 lo = __builtin_amdgcn_ds_read_tr16_b64_v4i16((LAS s16x4*)p);
    const s16x4 hi = __builtin_amdgcn_ds_read_tr16_b64_v4i16((LAS s16x4*)(p + 4 * LD16));
    return (bf16x8){lo[0], lo[1], lo[2], lo[3], hi[0], hi[1], hi[2], hi[3]};
}
__device__ __forceinline__ bf16x8 frag_rm(const LAS bf16* X, int r0, int ks, int fr, int fq) { return *(const LAS bf16x8*)(X + (r0 + fr) * LD16 + 8 * fq + 32 * ks); }
__device__ __forceinline__ f32x4 mm2(const bf16x8 (&a)[2], const bf16x8 (&b)[2], f32x4 acc) {
    acc = __builtin_amdgcn_mfma_f32_16x16x32_bf16(a[0], b[0], acc, 0, 0, 0); return __builtin_amdgcn_mfma_f32_16x16x32_bf16(a[1], b[1], acc, 0, 0, 0); }
__device__ __forceinline__ bf16x8 as_frag(const u32x4 q) { return __builtin_bit_cast(bf16x8, q); }

__device__ __forceinline__ void p_chunkA(Frame& F, int l) {
    PH_LOCALS(F); PH_LAYER(l);
    LAS unsigned char* lds = F.lds;
    const int lane0 = lane, lane00 = lane;
#define STG int lane_ = lane0; asm volatile("" : "+v"(lane_)); const int lane = lane_, fr = lane_ & 15, fq = lane_ >> 4, tid = wave * 64 + lane_, mt = wave >> 1, m0 = 16 * mt, np = (wave & 1) * 2; \
    (void)lane; (void)fr; (void)fq; (void)tid; (void)mt; (void)m0; (void)np;
    const bf16* PS = (const bf16*)(F.ws + WS_PS);
    const bf16* w2t = (const bf16*)(F.ws + WS_W2T) + (size_t)l * 2 * 1024 * 64;
    const bf16* a2t = (const bf16*)(F.ws + WS_A2T) + (size_t)l * 2 * 1024 * 64;
    const bf16* g2t = (const bf16*)(F.ws + WS_G2T) + (size_t)l * 1024 * 160;
    bf16* GATE = (bf16*)(F.ws + WS_GATE); float* BONUS = (float*)(F.ws + WS_BONUS);
    LAS float* gC = (LAS float*)(lds + 14 * T16B);
    LAS float* BT = (LAS float*)(lds + 14 * T16B + 256);
    u32x4 pf_w[2], pf_a[2], pf_g[5], pf_r, pf_k, pf_v; bf16x8 Bg[2][5], Bw[2][2], Ba[2][2]; float biw[2], bia[2];
#define CA_ISSUE(item_, d_) do { const int ci_ = (item_) >> 4, h_ = (item_) & 15, R0_ = ci_ * 64; int lane0 = lane00; asm volatile("" : "+v"(lane0)); \
        const bf16* arow_ = PS + (size_t)(R0_ + 16 * (wave >> 1) + (lane0 & 15)) * CSH + 3 * DA + 8 * (lane0 >> 4); \
        pf_w[0] = *(const u32x4*)arow_; pf_w[1] = *(const u32x4*)(arow_ + 32); pf_a[0] = *(const u32x4*)(arow_ + 64); pf_a[1] = *(const u32x4*)(arow_ + 96); \
        if ((d_) == 0) { _Pragma("unroll") for (int ks_ = 0; ks_ < 5; ++ks_) { pf_g[ks_] = *(const u32x4*)(arow_ + 128 + 32 * ks_); \
            _Pragma("unroll") for (int nn_ = 0; nn_ < 2; ++nn_) Bg[nn_][ks_] = *(const bf16x8*)(g2t + (size_t)(64 * h_ + 16 * ((wave & 1) * 2 + nn_) + (lane0 & 15)) * 160 + 8 * (lane0 >> 4) + 32 * ks_); } } \
        _Pragma("unroll") for (int nn_ = 0; nn_ < 2; ++nn_) { const int n_ = 64 * h_ + 16 * ((wave & 1) * 2 + nn_) + (lane0 & 15); \
            biw[nn_] = F.in[I_W0][((size_t)l * 2 + (d_)) * DA + n_]; bia[nn_] = F.in[I_A0][((size_t)l * 2 + (d_)) * DA + n_]; \
            _Pragma("unroll") for (int ks_ = 0; ks_ < 2; ++ks_) { Bw[nn_][ks_] = *(const bf16x8*)(w2t + ((size_t)(d_) * 1024 + n_) * 64 + 8 * (lane0 >> 4) + 32 * ks_); Ba[nn_][ks_] = *(const bf16x8*)(a2t + ((size_t)(d_) * 1024 + n_) * 64 + 8 * (lane0 >> 4) + 32 * ks_); } } \
        const int tid_ = wave * 64 + lane0, tau_ = tid_ >> 3, pos_ = (d_) ? 63 - tau_ : tau_; const bf16* rrow_ = PS + (size_t)(R0_ + pos_) * CSH + 64 * h_ + (tid_ & 7) * 8; \
        pf_r = *(const u32x4*)rrow_; pf_k = *(const u32x4*)(rrow_ + DA); pf_v = *(const u32x4*)(rrow_ + 2 * DA); } while (0)
    if (bx < (M / 64) * NH) CA_ISSUE(bx, 0);
    int hcur = -1;
    LAS float* HC = (LAS float*)(lds + 14 * T16B + 1280);
    for (int item = bx; item < (M / 64) * NH; item += G) {
        const int ci = item >> 4, h = item & 15, R0 = ci * 64;
        if (h != hcur) { hcur = h;
            LBAR();
            { const int t_ = wave * 64 + lane0; if (t_ < 192) { const int w_ = t_ >> 6, c_ = t_ & 63; HC[t_] = (w_ == 0 ? F.in[I_KK] : (w_ == 1 ? F.in[I_KA] : F.in[I_RK]))[(size_t)l * DA + 64 * h + c_]; } } }
        for (int d = 0; d < 2; ++d) {
            const size_t qi = ((size_t)ci * 16 + h) * 2 + d;
            const bf16x8 cBw[2][2] = {{Bw[0][0], Bw[0][1]}, {Bw[1][0], Bw[1][1]}}, cBa[2][2] = {{Ba[0][0], Ba[0][1]}, {Ba[1][0], Ba[1][1]}}; const float cbw[2] = {biw[0], biw[1]}, cba[2] = {bia[0], bia[1]};
            u32x4 cw[2] = {pf_w[0], pf_w[1]}, ca[2] = {pf_a[0], pf_a[1]}, cg[5] = {pf_g[0], pf_g[1], pf_g[2], pf_g[3], pf_g[4]}; const u32x4 cr = pf_r, ck = pf_k, cv = pf_v;
            for (int repA = 0; repA < (PROBE_SUB == 1 ? 2 : 1); ++repA) {
            { STG; LAS float* AL = SLOTF(5); LAS float* LW = SLOTF(7);
              bf16x8 aw[2], aa[2];
#pragma unroll
              for (int ks = 0; ks < 2; ++ks) { aw[ks] = as_frag(cw[ks]); aa[ks] = as_frag(ca[ks]); }
#pragma unroll
              for (int nn = 0; nn < 2; ++nn) { const int nl = 16 * (np + nn) + fr, n = 64 * h + nl;
                  const f32x4 accw = mm2(aw, cBw[nn], F4Z), acca = mm2(aa, cBa[nn], F4Z);
                  const float biasw = cbw[nn], biasa = cba[nn]; (void)n;
                  float lw[4], c[4];
#pragma unroll
                  for (int r = 0; r < 4; ++r) lw[r] = -0.6065306597126334f * fsigmoid(biasw + accw[r]);
                  if (d == 0) { c[0] = lw[0]; c[1] = c[0] + lw[1]; c[2] = c[1] + lw[2]; c[3] = c[2] + lw[3]; }
                  else { c[3] = lw[3]; c[2] = c[3] + lw[2]; c[1] = c[2] + lw[1]; c[0] = c[1] + lw[0]; }
                  const float tot = d == 0 ? c[3] : c[0];
                  const float t1 = SHX(tot, 16), t2 = SHX(tot, 32), t3 = SHX(tot, 48);
                  float off = 0.f;
                  { const int q1 = fq ^ 1, q2 = fq ^ 2, q3 = fq ^ 3;
                    off += (d ? q1 > fq : q1 < fq) ? t1 : 0.f; off += (d ? q2 > fq : q2 < fq) ? t2 : 0.f; off += (d ? q3 > fq : q3 < fq) ? t3 : 0.f; }
#pragma unroll
                  for (int r = 0; r < 4; ++r) { const int pos = m0 + 4 * fq + r, tau = d ? 63 - pos : pos;
                      LW[tau * LD32 + nl] = c[r] + off; AL[tau * LD32 + nl] = fsigmoid(biasa + acca[r]); }
                  if (fq == 0) BT[(d ? 3 - mt : mt) * 64 + nl] = (tot + t1) + (t2 + t3); }
              if (d == 0) {
                  bf16x8 ag[5];
#pragma unroll
                  for (int ks = 0; ks < 5; ++ks) ag[ks] = as_frag(cg[ks]);
#pragma unroll
                  for (int nn = 0; nn < 2; ++nn) { const int n = 64 * h + 16 * (np + nn) + fr; f32x4 acc = F4Z;
#pragma unroll
                      for (int ks = 0; ks < 5; ++ks) acc = __builtin_amdgcn_mfma_f32_16x16x32_bf16(ag[ks], Bg[nn][ks], acc, 0, 0, 0);
#pragma unroll
                      for (int r = 0; r < 4; ++r) GATE[(size_t)(R0 + m0 + 4 * fq + r) * DA + n] = (bf16)f2bf(acc[r]); } } }
            LBAR();
            { STG; const LAS float* AL = SLOTF(5); const LAS float* LW = SLOTF(7);
              const int tau = tid >> 3, c8 = (tid & 7) * 8, pos = d ? 63 - tau : tau, row = R0 + pos, chn = 64 * h + c8, blk = tau >> 4;
              float r[8], k[8], v[8];
              unpack8(cr, r); unpack8(ck, k); const u32x4 vraw = cv; unpack8(vraw, v);
              float offb[8], totC[8];
#pragma unroll
              for (int j = 0; j < 8; ++j) { offb[j] = 0.f; totC[j] = 0.f; }
#pragma unroll
              for (int b = 0; b < 4; ++b) { const f32x4 x0 = *(const LAS f32x4*)(BT + b * 64 + c8), x1 = *(const LAS f32x4*)(BT + b * 64 + c8 + 4);
#pragma unroll
                  for (int j = 0; j < 4; ++j) { totC[j] += x0[j]; totC[4 + j] += x1[j]; if (b < blk) { offb[j] += x0[j]; offb[4 + j] += x1[j]; } } }
              float kk[8], ss = 0.f, ckk[8], cka[8], crk[8];
#pragma unroll
              for (int j = 0; j < 8; ++j) { ckk[j] = HC[c8 + j]; cka[j] = HC[64 + c8 + j]; crk[j] = HC[128 + c8 + j]; }
#pragma unroll
              for (int j = 0; j < 8; ++j) { kk[j] = k[j] * ckk[j]; ss += kk[j] * kk[j]; }
              ss += SHX(ss, 1); ss += SHX(ss, 2); ss += SHX(ss, 4);
              const float rn = 1.0f / sqrtf(fmaxf(ss, 1e-24f));
              float alv[8], csv[8], csm[8];
              { const f32x4 a0 = *(const LAS f32x4*)(AL + tau * LD32 + c8), a1 = *(const LAS f32x4*)(AL + tau * LD32 + c8 + 4), c0 = *(const LAS f32x4*)(LW + tau * LD32 + c8), c1 = *(const LAS f32x4*)(LW + tau * LD32 + c8 + 4);
                const int tm = (tau & 15) ? tau - 1 : tau; const f32x4 e0 = *(const LAS f32x4*)(LW + tm * LD32 + c8), e1 = *(const LAS f32x4*)(LW + tm * LD32 + c8 + 4);
#pragma unroll
                for (int j = 0; j < 4; ++j) { alv[j] = a0[j]; alv[4 + j] = a1[j]; csv[j] = c0[j] + offb[j]; csv[4 + j] = c1[j] + offb[4 + j];
                    csm[j] = (tau & 15) ? e0[j] + offb[j] : offb[j]; csm[4 + j] = (tau & 15) ? e1[j] + offb[4 + j] : offb[4 + j]; } }
              float at[8], rt[8], bt[8], kt[8], bh[8], kh[8], bon = 0.f;
#pragma unroll
              for (int j = 0; j < 8; ++j) { const float al = alv[j], cs = csv[j], csC = totC[j];
                  const float kkn = kk[j] * rn, kd = k[j] * (1.0f + (al - 1.0f) * cka[j]), bb = kkn * al;
                  bon += r[j] * kd * crk[j];
                  const float encs = __expf(-cs), eh = __expf(csC - cs);
                  at[j] = -__expf(csm[j]) * kkn; rt[j] = __expf(cs) * r[j]; bt[j] = encs * bb; kt[j] = encs * kd; bh[j] = eh * bb; kh[j] = eh * kd;
                  if (tau == 63) gC[c8 + j] = __expf(csC); }
              *(LAS u32x4*)(SLOT(0) + tau * LD16 + c8) = pack8(at); *(LAS u32x4*)(SLOT(1) + tau * LD16 + c8) = pack8(rt);
              *(LAS u32x4*)(SLOT(2) + tau * LD16 + c8) = pack8(bt); *(LAS u32x4*)(SLOT(3) + tau * LD16 + c8) = pack8(kt);
              *(LAS u32x4*)(SLOT(4) + tau * LD16 + c8) = pack8(bh); *(LAS u32x4*)(SLOT(9) + tau * LD16 + c8) = pack8(kh);
              *(LAS u32x4*)(SLOT(10) + tau * LD16 + c8) = vraw;
              bon += SHX(bon, 1); bon += SHX(bon, 2); bon += SHX(bon, 4);
              if ((tid & 7) == 0) BONUS[((size_t)d * M + row) * NH + h] = bon; }
            LBAR();
            }
            { const int nitem = d == 0 ? item : item + G, nd = d ^ 1; if (nitem < (M / 64) * NH) CA_ISSUE(nitem, nd); }
            for (int repB = 0; repB < (PROBE_SUB == 2 ? 2 : 1); ++repB) {
            { STG; bf16x8 aB[2], aA[2], aK[2];
#pragma unroll
              for (int ks = 0; ks < 2; ++ks) { aB[ks] = frag_rm(SLOT(2), m0, ks, fr, fq); aA[ks] = frag_rm(SLOT(0), m0, ks, fr, fq); aK[ks] = frag_rm(SLOT(3), m0, ks, fr, fq); }
#pragma unroll
              for (int nn = 0; nn < 2; ++nn) { const int n0 = 16 * (np + nn), n = n0 + fr; bf16x8 bA[2], bB[2], bK[2], bR[2];
#pragma unroll
                  for (int ks = 0; ks < 2; ++ks) { bA[ks] = frag_rm(SLOT(0), n0, ks, fr, fq); bB[ks] = frag_rm(SLOT(2), n0, ks, fr, fq); bK[ks] = frag_rm(SLOT(3), n0, ks, fr, fq); bR[ks] = frag_rm(SLOT(1), n0, ks, fr, fq); }
                  f32x4 p0 = mm2(aB, bA, F4Z), p1 = mm2(aA, bB, F4Z), p2 = mm2(aA, bK, F4Z), p3 = mm2(aB, bR, F4Z), p4 = mm2(aK, bR, F4Z), t0;
#pragma unroll
                  for (int r = 0; r < 4; ++r) { const int m = m0 + 4 * fq + r;
                      p0[r] = m < n ? p0[r] : 0.f; p1[r] = n < m ? p1[r] : 0.f; p2[r] = n < m ? p2[r] : 0.f; p3[r] = m <= n ? p3[r] : 0.f; p4[r] = m <= n ? p4[r] : 0.f;
                      t0[r] = p1[r] + (m == n ? 1.0f : 0.f); }
                  st_nat(SLOT(5), n0, m0, fr, fq, p0); st_nat(SLOT(6), n0, m0, fr, fq, p1); st_nat(SLOT(7), n0, m0, fr, fq, t0);
                  st_nat(SLOT(8), n0, m0, fr, fq, p2); st_nat(SLOT(11), n0, m0, fr, fq, p3); st_nat(SLOT(12), n0, m0, fr, fq, p4); } }
            LBAR();
            { STG; bf16x8 aR[2], aT[2];
#pragma unroll
              for (int ks = 0; ks < 2; ++ks) { aR[ks] = frag_rm(SLOT(6), m0, ks, fr, fq); aT[ks] = frag_rm(SLOT(5), m0, ks, fr, fq); }
#pragma unroll
              for (int nn = 0; nn < 2; ++nn) { const int n0 = 16 * (np + nn); bf16x8 bT[2], bR[2];
#pragma unroll
                  for (int ks = 0; ks < 2; ++ks) { bT[ks] = frag_rm(SLOT(5), n0, ks, fr, fq); bR[ks] = frag_rm(SLOT(6), n0, ks, fr, fq); }
                  st_nat(SLOT(3), n0, m0, fr, fq, mm2(aR, bT, F4Z)); st_nat(SLOT(2), n0, m0, fr, fq, mm2(aT, bR, F4Z)); } }
            LBAR();
#pragma unroll
            for (int kq = 1; kq <= 5; ++kq) {
                STG; const int pin_rm = (kq & 1) ? 2 : 6, pin_t = (kq & 1) ? 3 : 5, pout_rm = (kq & 1) ? 6 : 2, pout_t = (kq & 1) ? 5 : 3, tin = (kq & 1) ? 7 : 13, tout = (kq & 1) ? 13 : 7;
                bf16x8 aPT[2], aPR[2];
#pragma unroll
                for (int ks = 0; ks < 2; ++ks) { aPT[ks] = frag_rm(SLOT(pin_t), m0, ks, fr, fq); aPR[ks] = frag_rm(SLOT(pin_rm), m0, ks, fr, fq); }
#pragma unroll
                for (int nn = 0; nn < 2; ++nn) { const int n0 = 16 * (np + nn); bf16x8 bT[2], bPT[2], bPR[2];
#pragma unroll
                    for (int ks = 0; ks < 2; ++ks) { bT[ks] = frag_rm(SLOT(tin), n0, ks, fr, fq); bPT[ks] = frag_rm(SLOT(pin_t), n0, ks, fr, fq); bPR[ks] = frag_rm(SLOT(pin_rm), n0, ks, fr, fq); }
                    st_nat(SLOT(tout), n0, m0, fr, fq, mm2(aPT, bT, ld4bf(SLOT(tin) + (n0 + fr) * LD16 + m0 + 4 * fq)));
                    if (kq < 5) { st_nat(SLOT(pout_t), n0, m0, fr, fq, mm2(aPR, bPT, F4Z)); st_nat(SLOT(pout_rm), n0, m0, fr, fq, mm2(aPT, bPR, F4Z)); } }
                LBAR();
            }
            { STG; const int xt = wave, n0 = 16 * (xt & 3); bf16x8 b[2];
              if (xt < 4) { b[0] = frag_rm(SLOT(11), n0, 0, fr, fq); b[1] = frag_rm(SLOT(11), n0, 1, fr, fq); }
              else { b[0] = frag_tr(SLOT(4), 0, n0, fr, fq); b[1] = frag_tr(SLOT(4), 32, n0, fr, fq); }
#pragma unroll
              for (int mm = 0; mm < 4; ++mm) { bf16x8 a[2] = {frag_rm(SLOT(13), 16 * mm, 0, fr, fq), frag_rm(SLOT(13), 16 * mm, 1, fr, fq)};
                  st_nat(xt < 4 ? SLOT(5) : SLOT(6), n0, 16 * mm, fr, fq, mm2(a, b, F4Z)); } }
            LBAR();
            }
            for (int repC = 0; repC < (PROBE_SUB == 3 ? 2 : 1); ++repC) {
            { STG; bf16x8 aAt[2] = {frag_tr(SLOT(0), 0, m0, fr, fq), frag_tr(SLOT(0), 32, m0, fr, fq)}, aAk[2] = {frag_rm(SLOT(8), m0, 0, fr, fq), frag_rm(SLOT(8), m0, 1, fr, fq)};
              bf16* pyt = (bf16*)(F.ws + WS_PYT) + qi * 4096; bf16* qyt = (bf16*)(F.ws + WS_QYT) + qi * 4096; bf16* pst = (bf16*)(F.ws + WS_PST) + qi * 4096;
#pragma unroll
              for (int nn = 0; nn < 2; ++nn) { const int n0 = 16 * (np + nn), n = n0 + fr, mb = m0 + 4 * fq;
                  bf16x8 bRb[2] = {frag_rm(SLOT(5), n0, 0, fr, fq), frag_rm(SLOT(5), n0, 1, fr, fq)}, bBh[2] = {frag_rm(SLOT(6), n0, 0, fr, fq), frag_rm(SLOT(6), n0, 1, fr, fq)};
                  const f32x4 py = mm2(aAt, bRb, ld4bf(SLOT(1) + n * LD16 + mb)), qy = mm2(aAk, bRb, ld4bf(SLOT(12) + n * LD16 + mb));
                  f32x4 psi, qsi;
#pragma unroll
                  for (int r = 0; r < 4; ++r) { psi[r] = (mb + r == n) ? gC[n] : 0.f; qsi[r] = bf2f(SLOT(9)[(mb + r) * LD16 + n]); }
                  const f32x4 ps = mm2(aAt, bBh, psi), qs = mm2(aAk, bBh, qsi);
                  *(u32x2*)(pyt + n * 64 + mb) = pk4(py); *(u32x2*)(qyt + n * 64 + mb) = pk4(qy); *(u32x2*)(pst + n * 64 + mb) = pk4(ps);
                  st_nat(SLOT(2), n0, m0, fr, fq, qs); } }
            LBAR();
            { STG; bf16* nct = (bf16*)(F.ws + WS_NCT) + qi * 4096; bf16* vtg = (bf16*)(F.ws + WS_VTG) + qi * 4096;
              bf16x8 a[2] = {frag_rm(SLOT(2), m0, 0, fr, fq), frag_rm(SLOT(2), m0, 1, fr, fq)};
#pragma unroll
              for (int nn = 0; nn < 2; ++nn) { const int n0 = 16 * (np + nn); bf16x8 b[2] = {frag_tr(SLOT(10), 0, n0, fr, fq), frag_tr(SLOT(10), 32, n0, fr, fq)};
                  *(u32x2*)(nct + (n0 + fr) * 64 + m0 + 4 * fq) = pk4(mm2(a, b, F4Z));
                  if (mt == 0) { *(bf16x8*)(vtg + (n0 + fr) * 64 + 8 * fq) = b[0]; *(bf16x8*)(vtg + (n0 + fr) * 64 + 32 + 8 * fq) = b[1]; } } }
            LBAR();
            }
        }
    }
#undef STG
#undef CA_ISSUE
}

__device__ __forceinline__ void p_chunkB(Frame& F, int l) {
    PH_LOCALS(F); PH_LAYER(l);
    const int fr = lane & 15, fq = lane >> 4;
    LAS bf16* Sl = (LAS bf16*)(F.lds + wave * 2304);
    const bf16* PST = (const bf16*)(F.ws + WS_PST); const bf16* NCT = (const bf16*)(F.ws + WS_NCT); bf16* SC = (bf16*)(F.ws + WS_SC);
    for (int t = bx + G * wave; t < 2560; t += G * NWAVES) {
        const bool lat = t < 512; const int tt = lat ? t : t - 512; const int chain = tt >> 2, vb = tt & 3;
        const int b = chain >> 5, h = (chain >> 1) & 15, d = chain & 1;
        const int cb = lat ? 64 + b * 64 : b * 4, NC = lat ? 64 : 4;
        f32x4 S[4];
        if (lat) { const float* src = F.in[I_STATE] + ((((size_t)b * NL + l) * 2 + d) * NH + h) * 4096 + (size_t)(16 * vb + fr) * 64 + 4 * fq;
#pragma unroll
            for (int T = 0; T < 4; ++T) S[T] = *(const f32x4*)(src + 16 * T); }
        else {
#pragma unroll
            for (int T = 0; T < 4; ++T) S[T] = (f32x4){0.f, 0.f, 0.f, 0.f}; }
        bf16x8 Apf[4][8]; u32x2 Npf[4][4];
#define CB_QI(step) ((((size_t)(cb + (d ? NC - 1 - (step) : (step)))) * 16 + h) * 2 + d)
#define CB_LOAD(u, step) do { const size_t q_ = CB_QI(step); const bf16* ps_ = PST + q_ * 4096 + fr * 64 + 8 * fq; const bf16* nc_ = NCT + q_ * 4096 + (16 * vb + fr) * 64 + 4 * fq; \
        _Pragma("unroll") for (int mt_ = 0; mt_ < 4; ++mt_) { Apf[u][2 * mt_] = *(const bf16x8*)(ps_ + mt_ * 1024); Apf[u][2 * mt_ + 1] = *(const bf16x8*)(ps_ + mt_ * 1024 + 32); Npf[u][mt_] = *(const u32x2*)(nc_ + 16 * mt_); } } while (0)
        CB_LOAD(0, 0); CB_LOAD(1, 1); CB_LOAD(2, 2); CB_LOAD(3, 3);
        for (int g = 0; g < NC; g += 4) {
#pragma unroll
            for (int u = 0; u < 4; ++u) {
                const int step = g + u; const size_t q = CB_QI(step);
                bf16* scg = SC + q * 4096 + (16 * vb + fr) * 64 + 4 * fq;
                asm volatile("" ::: "memory");
#pragma unroll
                for (int T = 0; T < 4; ++T) { const u32x2 w = pk4(S[T]); *(LAS u32x2*)(Sl + fr * LD16 + 16 * T + 4 * fq) = w; *(u32x2*)(scg + 16 * T) = w; }
                asm volatile("s_waitcnt lgkmcnt(0)" ::: "memory");
                const bf16x8 b0 = *(const LAS bf16x8*)(Sl + fr * LD16 + 8 * fq), b1 = *(const LAS bf16x8*)(Sl + fr * LD16 + 8 * fq + 32);
#pragma unroll
                for (int mt = 0; mt < 4; ++mt) { const u32x2 nw = Npf[u][mt];
                    f32x4 acc = (f32x4){__uint_as_float(nw.x << 16), __uint_as_float(nw.x & 0xffff0000u), __uint_as_float(nw.y << 16), __uint_as_float(nw.y & 0xffff0000u)};
                    acc = __builtin_amdgcn_mfma_f32_16x16x32_bf16(Apf[u][2 * mt], b0, acc, 0, 0, 0);
                    acc = __builtin_amdgcn_mfma_f32_16x16x32_bf16(Apf[u][2 * mt + 1], b1, acc, 0, 0, 0);
                    S[mt] = acc; }
                asm volatile("s_waitcnt lgkmcnt(0)" ::: "memory");
                if (step + 4 < NC) CB_LOAD(u, step + 4);
            }
        }
#undef CB_LOAD
#undef CB_QI
        if (!lat) { float* dst = F.out + (size_t)M * D + ((((size_t)b * NL + l) * 2 + d) * NH + h) * 4096 + (size_t)(16 * vb + fr) * 64 + 4 * fq;
#pragma unroll
            for (int T = 0; T < 4; ++T) *(f32x4*)(dst + 16 * T) = S[T]; }
    }
}

__device__ __forceinline__ void p_chunkC(Frame& F, int l) {
    PH_LOCALS(F); PH_LAYER(l);
    LAS unsigned char* lds = F.lds;
    const int fr = lane & 15, fq = lane >> 4, d = wave >> 2, nb = wave & 3;
    const bf16* PS = (const bf16*)(F.ws + WS_PS); const bf16* GATE = (const bf16*)(F.ws + WS_GATE); const float* BONUS = (const float*)(F.ws + WS_BONUS);
    bf16* O = (bf16*)(F.ws + WS_O);
    constexpr int NIT = (M / 64) * NH;
    bf16x8 fa[4][4], fb[4]; u32x4 pv, pg; float pb0, pb1;
#define CC_ISSUE(item_) do { const int ci_ = (item_) >> 4, h_ = (item_) & 15; const size_t qi_ = ((size_t)ci_ * 16 + h_) * 2 + d; \
        const bf16* sc_ = (const bf16*)(F.ws + WS_SC) + qi_ * 4096 + fr * 64 + 8 * fq; const bf16* vt_ = (const bf16*)(F.ws + WS_VTG) + qi_ * 4096 + fr * 64 + 8 * fq; \
        const bf16* py_ = (const bf16*)(F.ws + WS_PYT) + qi_ * 4096 + (16 * nb + fr) * 64 + 8 * fq; const bf16* qy_ = (const bf16*)(F.ws + WS_QYT) + qi_ * 4096 + (16 * nb + fr) * 64 + 8 * fq; \
        fb[0] = *(const bf16x8*)py_; fb[1] = *(const bf16x8*)(py_ + 32); fb[2] = *(const bf16x8*)qy_; fb[3] = *(const bf16x8*)(qy_ + 32); \
        _Pragma("unroll") for (int vt4_ = 0; vt4_ < 4; ++vt4_) { fa[vt4_][0] = *(const bf16x8*)(sc_ + vt4_ * 1024); fa[vt4_][1] = *(const bf16x8*)(sc_ + vt4_ * 1024 + 32); fa[vt4_][2] = *(const bf16x8*)(vt_ + vt4_ * 1024); fa[vt4_][3] = *(const bf16x8*)(vt_ + vt4_ * 1024 + 32); } \
        const int row_ = ci_ * 64 + (tid >> 3), chn_ = 64 * h_ + (tid & 7) * 8; \
        pv = *(const u32x4*)(PS + (size_t)row_ * CSH + 2 * DA + chn_); pg = *(const u32x4*)(GATE + (size_t)row_ * DA + chn_); pb0 = BONUS[(size_t)row_ * NH + h_]; pb1 = BONUS[((size_t)M + row_) * NH + h_]; } while (0)
    if (bx < NIT) CC_ISSUE(bx);
    for (int item = bx; item < NIT; item += G) {
        const int ci = item >> 4, h = item & 15, R0 = ci * 64;
        f32x4 acc[4]; float s = 0.f;
#pragma unroll
        for (int vtile = 0; vtile < 4; ++vtile) { f32x4 a = F4Z;
#pragma unroll
            for (int ks = 0; ks < 4; ++ks) a = __builtin_amdgcn_mfma_f32_16x16x32_bf16(fa[vtile][ks], fb[ks], a, 0, 0, 0);
            acc[vtile] = a; s += (a[0] + a[1]) + (a[2] + a[3]); }
        const u32x4 cv = pv, cgt = pg; const float bon = pb0 + pb1;
        if (item + G < NIT) CC_ISSUE(item + G);
        s += SHX(s, 16); s += SHX(s, 32);
        const float mean = s * (1.0f / 64.0f); float qv = 0.f;
#pragma unroll
        for (int vtile = 0; vtile < 4; ++vtile) { acc[vtile] = acc[vtile] - mean; const f32x4 a = acc[vtile]; qv += (a[0] * a[0] + a[1] * a[1]) + (a[2] * a[2] + a[3] * a[3]); }
        qv += SHX(qv, 16); qv += SHX(qv, 32);
        const float rstd = 1.0f / sqrtf(qv * (1.0f / 64.0f) + GN_EPS);
        const int tau = 16 * nb + fr, pos = d ? 63 - tau : tau;
        LAS float* Yd = (LAS float*)(lds + d * 17408);
#pragma unroll
        for (int vtile = 0; vtile < 4; ++vtile) { const int v0 = 16 * vtile + 4 * fq;
            const f32x4 gw = *(const f32x4*)(F.in[I_GNW] + (size_t)l * DA + 64 * h + v0), gb = *(const f32x4*)(F.in[I_GNB] + (size_t)l * DA + 64 * h + v0);
            *(LAS f32x4*)(Yd + pos * LD32 + v0) = acc[vtile] * rstd * gw + gb; }
        LBAR();
        { const int pos2 = tid >> 3, c8 = (tid & 7) * 8, row = R0 + pos2, chn = 64 * h + c8;
          const LAS float* Y0 = (const LAS float*)lds; const LAS float* Y1 = (const LAS float*)(lds + 17408);
          float v[8], gt[8], o[8]; unpack8(cv, v); unpack8(cgt, gt);
          const f32x4 y00 = *(const LAS f32x4*)(Y0 + pos2 * LD32 + c8), y01 = *(const LAS f32x4*)(Y0 + pos2 * LD32 + c8 + 4), y10 = *(const LAS f32x4*)(Y1 + pos2 * LD32 + c8), y11 = *(const LAS f32x4*)(Y1 + pos2 * LD32 + c8 + 4);
#pragma unroll
          for (int j = 0; j < 4; ++j) { o[j] = (y00[j] + y10[j] + bon * v[j]) * gt[j]; o[4 + j] = (y01[j] + y11[j] + bon * v[4 + j]) * gt[4 + j]; }
          *(u32x4*)(O + (size_t)row * D + chn) = pack8(o); }
        LBAR();
    }
#undef CC_ISSUE
}

__device__ __forceinline__ void p_final(Frame& F) {
    PH_LOCALS(F);
    const int gw = bx * NWAVES + wave, NGW = G * NWAVES;
    const float* fg = F.in[I_FNG];
    for (int row = gw; row < M; row += NGW) {
        float* xr = F.out + (size_t)row * D;
        f32x4 v[8]; float ss = 0.f;
#pragma unroll
        for (int j = 0; j < 8; ++j) { v[j] = *(const f32x4*)(xr + 4 * lane + 256 * j); ss += (v[j].x * v[j].x + v[j].y * v[j].y) + (v[j].z * v[j].z + v[j].w * v[j].w); }
        WAVE_SUM(ss); const float rstd = 1.0f / sqrtf(ss * (1.0f / D) + RMS_EPS);
#pragma unroll
        for (int j = 0; j < 8; ++j) { const int c = 4 * lane + 256 * j; *(f32x4*)(xr + c) = v[j] * rstd * *(const f32x4*)(fg + c); }
    }
}

constexpr int PH_PER_LAYER = 10, N_PHASES = 2 + NL * PH_PER_LAYER;
__global__ void __launch_bounds__(NWAVES * 64, 2) hymba_fwd(Args args) {
    extern __shared__ __attribute__((aligned(16))) unsigned char lds[];
    Frame F;
    F.lds = (LAS unsigned char*)lds;
    F.tid = threadIdx.x; F.lane = F.tid & 63; F.wave = __builtin_amdgcn_readfirstlane(F.tid >> 6);
    F.G = gridDim.x; F.bx = blockIdx.x;
    F.in = args.in; F.out = args.out; F.ws = args.ws;
    for (int u = F.tid; u < (LDS_BYTES - LDSCTL_OFF) / 4; u += NWAVES * 64) ((LAS unsigned*)(F.lds + LDSCTL_OFF))[u] = 0u;
    __syncthreads();
    volatile LAS unsigned* MISC = (volatile LAS unsigned*)(F.lds + MISC_OFF);
    unsigned* barw = (unsigned*)(F.ws + WS_CTL) + CW_BAR;
    XcdBarrier bar; bar.bar = barw; bar.x = 0; bar.st = nullptr;
    if (MK_N_LAUNCHES == 1) bar = xcd_barrier_post(barw, MISC + 8);
    const int lo = args.ph_lo, hi = args.ph_hi;
#define IN(k) (lo <= (k) && (k) < hi)
#define SEAM(k) do { if (MK_N_LAUNCHES == 1 && IN(k) && IN((k) + 1)) xcd_barrier(bar); } while (0)

    for (int rep = 0; rep < ((PROBE_DUP == 30) ? 2 : 1); ++rep)
    if (IN(0)) { p0_prologue(F); __syncthreads(); } SEAM(0);
    bf16* H = (bf16*)(F.ws + WS_H); bf16* O = (bf16*)(F.ws + WS_O); bf16* P = (bf16*)(F.ws + WS_P); bf16* HID = (bf16*)(F.ws + WS_HID);
    const float* mod = (const float*)(F.ws + WS_MOD);
    for (int l = 0; l < NL; ++l) {
        const int pb = 1 + l * PH_PER_LAYER;
        const float* xlo = l == 0 ? F.in[I_XP] : F.out; const float* xhi = l == 0 ? F.in[I_XS] : F.out + (size_t)MCTX * D;
        float* dummy = (float*)(F.ws + WS_P);
        for (int rep = 0; rep < ((PROBE_DUP == 7) ? 2 : 1); ++rep)
        if (IN(pb + 0)) { p_adaln(F, l, 0, xlo, xhi); } SEAM(pb + 0);
        for (int rep = 0; rep < ((PROBE_DUP == 1 || PROBE_DUP == 20) ? 2 : 1); ++rep)
        if (IN(pb + 1)) { pg8::Gemm g{H, (const bf16*)(F.ws + WS_WIN + l * SZ_WIN), M, PINP, D}; pg8::StaticOrder S; S.init(M, PINP, F.G, F.bx);
            EpiP E{P, PINP, CSH}; pg8::gemm_phase<EpiP, pg8::StaticOrder, true, true>(F.lds, g, S, E, F.wave); } SEAM(pb + 1);
        for (int rep = 0; rep < ((PROBE_DUP == 2) ? 2 : 1); ++rep)
        if (IN(pb + 2)) { p_shift(F, l); } SEAM(pb + 2);
        if (IN(pb + 3)) { for (int rep = 0; rep < ((PROBE_DUP == 3) ? 2 : 1); ++rep) p_chunkA(F, l); for (int rep = 0; rep < ((PROBE_DUP == 13) ? 2 : 1); ++rep) p_gmlp(F, l); } SEAM(pb + 3);
        for (int rep = 0; rep < ((PROBE_DUP == 4) ? 2 : 1); ++rep)
        if (IN(pb + 4)) { p_chunkB(F, l); } SEAM(pb + 4);
        for (int rep = 0; rep < ((PROBE_DUP == 5) ? 2 : 1); ++rep)
        if (IN(pb + 5)) { p_chunkC(F, l); } SEAM(pb + 5);
        if ((PROBE_DUP == 6 || PROBE_DUP == 20) && IN(pb + 6)) { pg8::Gemm g{O, (const bf16*)(F.ws + WS_WOUT + l * SZ_WOUT), M, D, D}; pg8::StaticOrder S; S.init(M, D, F.G, F.bx);
            EpiRes E{xlo, xhi, dummy, mod + (size_t)l * 5 * MODW, 2 * D}; pg8::gemm_phase<EpiRes, pg8::StaticOrder, true, true>(F.lds, g, S, E, F.wave); }
        if (IN(pb + 6)) { pg8::Gemm g{O, (const bf16*)(F.ws + WS_WOUT + l * SZ_WOUT), M, D, D}; pg8::StaticOrder S; S.init(M, D, F.G, F.bx);
            EpiRes E{xlo, xhi, F.out, mod + (size_t)l * 5 * MODW, 2 * D}; pg8::gemm_phase<EpiRes, pg8::StaticOrder, true, true>(F.lds, g, S, E, F.wave); } SEAM(pb + 6);
        for (int rep = 0; rep < ((PROBE_DUP == 7) ? 2 : 1); ++rep)
        if (IN(pb + 7)) { p_adaln(F, l, 1, F.out, F.out + (size_t)MCTX * D); } SEAM(pb + 7);
        for (int rep = 0; rep < ((PROBE_DUP == 8 || PROBE_DUP == 20) ? 2 : 1); ++rep)
        if (IN(pb + 8)) { pg8::Gemm g{H, (const bf16*)(F.ws + WS_WGU + l * SZ_WGU), M, NGU, D}; pg8::StaticOrder S; S.init(M, NGU, F.G, F.bx);
            EpiSwi E{HID, DFF}; pg8::gemm_phase<EpiSwi, pg8::StaticOrder, true, true>(F.lds, g, S, E, F.wave); } SEAM(pb + 8);
        if ((PROBE_DUP == 9 || PROBE_DUP == 20) && IN(pb + 9)) { pg8::Gemm g{HID, (const bf16*)(F.ws + WS_WD + l * SZ_WD), M, D, DFF}; pg8::StaticOrder S; S.init(M, D, F.G, F.bx);
            EpiRes E{F.out, F.out + (size_t)MCTX * D, dummy, mod + (size_t)l * 5 * MODW, 5 * D}; pg8::gemm_phase<EpiRes, pg8::StaticOrder, true, true>(F.lds, g, S, E, F.wave); }
        if (IN(pb + 9)) { pg8::Gemm g{HID, (const bf16*)(F.ws + WS_WD + l * SZ_WD), M, D, DFF}; pg8::StaticOrder S; S.init(M, D, F.G, F.bx);
            EpiRes E{F.out, F.out + (size_t)MCTX * D, F.out, mod + (size_t)l * 5 * MODW, 5 * D}; pg8::gemm_phase<EpiRes, pg8::StaticOrder, true, true>(F.lds, g, S, E, F.wave); } SEAM(pb + 9);
    }
    if (IN(N_PHASES - 1)) { p_final(F); }
#undef IN
#undef SEAM
}

extern "C" void kernel_launch(void* const* d_in, const int* in_sizes, int n_in, void* d_out, int out_size, void* d_ws, size_t ws_size, hipStream_t stream) {
    static int grid = 0;
    if (grid == 0) {
        if (n_in != 30 || ws_size < WS_END) { fprintf(stderr, "kernel_launch: need 30 inputs and >= %zu bytes of workspace; got n_in %d, ws %zu\n", (size_t)WS_END, n_in, ws_size); grid = -1; return; }
        int dev = 0, cus = 0, per_cu = 0;
        if (hipGetDevice(&dev) != hipSuccess || hipDeviceGetAttribute(&cus, hipDeviceAttributeMultiprocessorCount, dev) != hipSuccess) { grid = -1; return; }
        if (hipFuncSetAttribute((const void*)hymba_fwd, hipFuncAttributeMaxDynamicSharedMemorySize, LDS_BYTES) != hipSuccess) { fprintf(stderr, "kernel_launch: hipFuncSetAttribute failed\n"); grid = -1; return; }
        if (hipOccupancyMaxActiveBlocksPerMultiprocessor(&per_cu, (const void*)hymba_fwd, NWAVES * 64, LDS_BYTES) != hipSuccess || per_cu < 1)
            fprintf(stderr, "kernel_launch: note: occupancy query reports %d workgroups per CU\n", per_cu);
        (void)hipGetLastError();
        grid = cus;
    }
    if (grid < 0) return;
    if (hipMemsetAsync((char*)d_ws + WS_CTL, 0, CTL_ZERO_BYTES, stream) != hipSuccess) return;
    Args a{};
    for (int i = 0; i < 30; ++i) a.in[i] = (const float*)d_in[i];
    a.out = (float*)d_out; a.ws = (unsigned char*)d_ws; a.pad = 0;
    if (MK_N_LAUNCHES == 1) {
        a.ph_lo = 0; a.ph_hi = N_PHASES; a.li = 0;
        hipLaunchKernelGGL(hymba_fwd, dim3(grid), dim3(NWAVES * 64), LDS_BYTES, stream, a);
    } else {
        for (int k = 0; k < N_PHASES; ++k) { a.ph_lo = k; a.ph_hi = k + 1; a.li = k;
            hipLaunchKernelGGL(hymba_fwd, dim3(grid), dim3(NWAVES * 64), LDS_BYTES, stream, a); }
    }
}
```

```cpp
#include <hip/hip_runtime.h>
#include <cstdio>
#include <cstdint>

#ifndef PROBE_DUP
#define PROBE_DUP -1
#endif
#ifndef PROBE_SUB
#define PROBE_SUB 0
#endif
#ifndef MK_N_LAUNCHES
#define MK_N_LAUNCHES 1
#endif

namespace pg8 {
#define PG8_LAS __attribute__((address_space(3)))
typedef unsigned short bf16_t;
typedef short bf16x8 __attribute__((ext_vector_type(8)));
typedef float f32x4 __attribute__((ext_vector_type(4)));
typedef unsigned u32x4 __attribute__((ext_vector_type(4)));
constexpr int BM = 256, BK = 64, HALF = 128, HTB = HALF * BK * 2  , STAGE_BYTES = 8 * HTB, NXCD = 8, WGM = 8;

__host__ __device__ __forceinline__ int lds_byte(int r, int c) { const int st = (r >> 4) * 2 + (c >> 5), rr = r & 15, cc = c & 31, ob = rr * 64 + cc * 2; return st * 1024 + (ob ^ (((ob >> 9) & 1) << 5)); }
__host__ __device__ __forceinline__ void stage_rc(int b, int& R, int& C) { const int st = b / 1024, sb = b % 1024, swz = sb ^ (((sb >> 9) & 1) << 5); R = (st >> 1) * 16 + swz / 64; C = (st & 1) * 32 + (swz % 64) / 2; }
__host__ __device__ __forceinline__ int perm32(int rho) { const int n = rho >> 4, i = rho & 15; return 8 * (i >> 2) + 4 * n + (i & 3); }

struct Unit { int pm, pn, k0, nk; };
struct Gemm { const bf16_t* A; const bf16_t* Bt; int M, N, K; };

struct StaticOrder {
    int nM, nN, nwg, G, c, nkt, full, rem;
    __host__ __device__ void init(int M, int N, int G_, int c_, int K_) { nM = M / BM; nN = N / BM; nwg = nM * nN; G = G_; c = c_; nkt = K_ / BK; full = nwg / G; rem = nwg - full * G; }
    __host__ __device__ bool next(int i, Unit& u) const {
        const long L = (long)i * G + c; if (L >= nwg) return false;
        int wgid = (int)L; { const int q = nwg / NXCD, r = nwg % NXCD, xcd = wgid % NXCD, off = wgid / NXCD; wgid = (xcd < r ? xcd * (q + 1) : r * (q + 1) + (xcd - r) * q) + off; }
        const int nig = WGM * nN, gid = wgid / nig, fm = gid * WGM, gsz = (nM - fm) < WGM ? (nM - fm) : WGM;
        u.pm = fm + ((wgid % nig) % gsz); u.pn = (wgid % nig) / gsz; u.k0 = 0; u.nk = nkt;
#if defined(__HIP_DEVICE_COMPILE__)
        u.pm = __builtin_amdgcn_readfirstlane(u.pm); u.pn = __builtin_amdgcn_readfirstlane(u.pn);
#endif
        return true;
    }
    __device__ __forceinline__ void a_ready(const Unit&) const {}
    __device__ __forceinline__ void done(const Unit&) const {}
};
struct SplitTailOrder : StaticOrder {
    __host__ __device__ bool next(int i, Unit& u) const {
        if (i < full || 2 * rem > G || (nkt & 3)) return StaticOrder::next(i, u);
        if (i > full || c >= 2 * rem) return false;
        StaticOrder t = *this; t.c = c >> 1; if (!t.StaticOrder::next(full, u)) return false;
        u.nk = nkt / 2; u.k0 = (c & 1) * u.nk; return true;
    }
};

__device__ __forceinline__ unsigned cvt_pk_bf16(float lo, float hi) { unsigned r; asm volatile("v_cvt_pk_bf16_f32 %0, %1, %2" : "=v"(r) : "v"(lo), "v"(hi)); return r; }

template <class Epi, class Sched, bool ALIGN_EPI = false, bool SP2 = false>
__device__ __forceinline__ void gemm_phase(PG8_LAS unsigned char* lds, const Gemm g, const Sched& S, const Epi& E, int wid) {
    asm volatile("" : "+s"(wid)); int lane; asm volatile("v_mbcnt_lo_u32_b32 %0, -1, 0\n\tv_mbcnt_hi_u32_b32 %0, -1, %0" : "=v"(lane));
    const int tid = wid * 64 + lane, wr = wid >> 2, wc = wid & 3, fr = lane & 15, fq = lane >> 4;
    const int K = g.K;
    unsigned voffA[2], voffB[2];
#pragma unroll
    for (int i = 0; i < 2; ++i) { int R, C; stage_rc(tid * 16 + i * 8192, R, C); const int Rb = Epi::PERM ? ((R & ~31) + perm32(R & 31)) : R;
        voffA[i] = (unsigned)(R * K + C) * 2u; voffB[i] = (unsigned)(Rb * K + C) * 2u; }
    const size_t kstep = (size_t)(BK * 2);
    const size_t hstep = (size_t)HALF * K * 2;
    const size_t tstep = 2 * hstep;
    const unsigned ldsw = (unsigned)wid * 1024u;
    const int aoff = lds_byte(wr * 64 + fr, fq * 8), boff = lds_byte(wc * 32 + fr, fq * 8);
#define PG8_SA(b, h) (((b) * 2 + (h)) * HTB)
#define PG8_SB(b, h) ((4 + (b) * 2 + (h)) * HTB)
#define PG8_STAGE(bufoff, gbase, voff) do { _Pragma("unroll") for (int _i = 0; _i < 2; ++_i) \
        __builtin_amdgcn_global_load_lds((const unsigned*)((const char*)(gbase) + (voff)[_i]), (PG8_LAS unsigned*)(lds + (bufoff) + ldsw + _i * 8192), 16, 0, 0); } while (0)
#define PG8_LDA(dst, b, h) do { _Pragma("unroll") for (int m = 0; m < 4; ++m) _Pragma("unroll") for (int k = 0; k < 2; ++k) dst[m][k] = *(const PG8_LAS bf16x8*)(lds + PG8_SA(b, h) + aoff + m * 2048 + k * 1024); } while (0)
#define PG8_LDB(dst, b, h) do { _Pragma("unroll") for (int n = 0; n < 2; ++n) _Pragma("unroll") for (int k = 0; k < 2; ++k) dst[n][k] = *(const PG8_LAS bf16x8*)(lds + PG8_SB(b, h) + boff + n * 2048 + k * 1024); } while (0)
#define PG8_MMA(ai, bj, At, Bt) do { __builtin_amdgcn_s_setprio(1); _Pragma("unroll") for (int m = 0; m < 4; ++m) _Pragma("unroll") for (int n = 0; n < 2; ++n) _Pragma("unroll") for (int k = 0; k < 2; ++k) \
        acc[ai][bj][m][n] = __builtin_amdgcn_mfma_f32_16x16x32_bf16(Bt[n][k], At[m][k], acc[ai][bj][m][n], 0, 0, 0); __builtin_amdgcn_s_setprio(0); } while (0)
#define PG8_WAIT_V(n) asm volatile("s_waitcnt vmcnt(" #n ")" ::: "memory")
#define PG8_WAIT_L(n) asm volatile("s_waitcnt lgkmcnt(" #n ")" ::: "memory")
#define PG8_BAR __builtin_amdgcn_s_barrier()
#define PG8_SCHED __builtin_amdgcn_sched_barrier(0)
    Unit cur, nxt; int ui = 0;
    if (!S.next(0, cur)) return;
    f32x4 acc[2][2][4][2];
#pragma unroll
    for (int a = 0; a < 2; ++a)
#pragma unroll
        for (int b = 0; b < 2; ++b)
#pragma unroll
            for (int m = 0; m < 4; ++m)
#pragma unroll
                for (int n = 0; n < 2; ++n) acc[a][b][m][n] = (f32x4){0.f, 0.f, 0.f, 0.f};
    bf16x8 At[4][2], B0[2][2], B1[2][2];
    const char* cA = (const char*)g.A + (size_t)cur.pm * tstep + (size_t)cur.k0 * kstep; const char* cB = (const char*)g.Bt + (size_t)cur.pn * tstep + (size_t)cur.k0 * kstep;
    S.a_ready(cur);
    if constexpr (SP2) {
        PG8_STAGE(PG8_SB(0, 0), cB, voffB); PG8_STAGE(PG8_SB(0, 1), cB + hstep, voffB); PG8_STAGE(PG8_SA(0, 0), cA, voffA); PG8_STAGE(PG8_SA(0, 1), cA + hstep, voffA);
        if (wr == 1) PG8_BAR;
        PG8_WAIT_V(2); PG8_BAR;
        PG8_STAGE(PG8_SB(1, 0), cB + kstep, voffB); PG8_STAGE(PG8_SA(1, 0), cA + kstep, voffA); PG8_STAGE(PG8_SB(1, 1), cB + hstep + kstep, voffB);
        PG8_WAIT_V(6); PG8_BAR;
    } else {
        PG8_STAGE(PG8_SB(0, 0), cB, voffB); PG8_STAGE(PG8_SA(0, 0), cA, voffA); PG8_STAGE(PG8_SB(0, 1), cB + hstep, voffB); PG8_STAGE(PG8_SA(0, 1), cA + hstep, voffA);
        if (wr == 1) PG8_BAR;
        PG8_WAIT_V(4); PG8_BAR;
        PG8_STAGE(PG8_SB(1, 0), cB + kstep, voffB); PG8_STAGE(PG8_SA(1, 0), cA + kstep, voffA); PG8_STAGE(PG8_SB(1, 1), cB + hstep + kstep, voffB);
        PG8_WAIT_V(6); PG8_BAR;
    }
    for (;;) {
        const bool has_next = S.next(ui + 1, nxt);
        const char* nA = has_next ? (const char*)g.A + (size_t)nxt.pm * tstep + (size_t)nxt.k0 * kstep : cA; const char* nB = has_next ? (const char*)g.Bt + (size_t)nxt.pn * tstep + (size_t)nxt.k0 * kstep : cB;
        const int nt = cur.nk;
        for (int t = 0; t < nt; t += 2) {
            const bool last = (t == nt - 2);
            const char* a1 = cA + (size_t)(t + 1) * kstep;
            const char* a2 = last ? nA : cA + (size_t)(t + 2) * kstep; const char* b2 = last ? nB : cB + (size_t)(t + 2) * kstep;
            const char* a3 = a2 + kstep; const char* b3 = b2 + kstep;
            if (last && has_next) S.a_ready(nxt);
            if constexpr (SP2) {
            PG8_LDB(B0, 0, 0); PG8_LDB(B1, 0, 1); PG8_SCHED; PG8_LDA(At, 0, 0); PG8_STAGE(PG8_SA(1, 1), a1 + hstep, voffA);
            PG8_WAIT_V(8); PG8_WAIT_L(0); PG8_BAR; PG8_MMA(0, 0, At, B0); PG8_MMA(0, 1, At, B1); PG8_BAR; PG8_SCHED;
            PG8_LDA(At, 0, 1); PG8_STAGE(PG8_SB(0, 0), b2, voffB); PG8_STAGE(PG8_SB(0, 1), b2 + hstep, voffB); PG8_STAGE(PG8_SA(0, 0), a2, voffA);
            PG8_WAIT_V(8); PG8_WAIT_L(0); PG8_BAR; PG8_MMA(1, 0, At, B0); PG8_MMA(1, 1, At, B1); PG8_BAR; PG8_SCHED;
            PG8_LDB(B0, 1, 0); PG8_LDB(B1, 1, 1); PG8_SCHED; PG8_LDA(At, 1, 0); PG8_STAGE(PG8_SA(0, 1), a2 + hstep, voffA);
            PG8_WAIT_V(8); PG8_WAIT_L(0); PG8_BAR; PG8_MMA(0, 0, At, B0); PG8_MMA(0, 1, At, B1); PG8_BAR; PG8_SCHED;
            PG8_LDA(At, 1, 1); PG8_STAGE(PG8_SB(1, 0), b3, voffB); PG8_STAGE(PG8_SB(1, 1), b3 + hstep, voffB); PG8_STAGE(PG8_SA(1, 0), a3, voffA);
            PG8_WAIT_V(8); PG8_WAIT_L(0); PG8_BAR; PG8_MMA(1, 0, At, B0); PG8_MMA(1, 1, At, B1); PG8_BAR; PG8_SCHED;
            } else {
            PG8_LDB(B0, 0, 0); PG8_SCHED; PG8_LDA(At, 0, 0); PG8_STAGE(PG8_SA(1, 1), a1 + hstep, voffA);
            PG8_WAIT_L(8); PG8_BAR; PG8_WAIT_L(0); PG8_MMA(0, 0, At, B0); PG8_BAR; PG8_SCHED;
            PG8_LDB(B1, 0, 1); PG8_STAGE(PG8_SB(0, 0), b2, voffB);
            PG8_BAR; PG8_WAIT_L(0); PG8_MMA(0, 1, At, B1); PG8_BAR;
            PG8_LDA(At, 0, 1); PG8_STAGE(PG8_SA(0, 0), a2, voffA);
            PG8_BAR; PG8_WAIT_L(0); PG8_MMA(1, 0, At, B0); PG8_BAR; PG8_SCHED;
            PG8_STAGE(PG8_SB(0, 1), b2 + hstep, voffB);
            PG8_WAIT_V(6); PG8_BAR; PG8_MMA(1, 1, At, B1); PG8_BAR;
            PG8_LDB(B0, 1, 0); PG8_SCHED; PG8_LDA(At, 1, 0); PG8_STAGE(PG8_SA(0, 1), a2 + hstep, voffA);
            PG8_WAIT_L(8); PG8_BAR; PG8_WAIT_L(0); PG8_MMA(0, 0, At, B0); PG8_BAR; PG8_SCHED;
            PG8_LDB(B1, 1, 1); PG8_STAGE(PG8_SB(1, 0), b3, voffB);
            PG8_BAR; PG8_WAIT_L(0); PG8_MMA(0, 1, At, B1); PG8_BAR;
            PG8_LDA(At, 1, 1); PG8_STAGE(PG8_SA(1, 0), a3, voffA);
            PG8_BAR; PG8_WAIT_L(0); PG8_MMA(1, 0, At, B0); PG8_BAR; PG8_SCHED;
            PG8_STAGE(PG8_SB(1, 1), b3 + hstep, voffB);
            PG8_WAIT_V(6); PG8_BAR; PG8_MMA(1, 1, At, B1); PG8_BAR;
            }
        }
        if constexpr (ALIGN_EPI) { if (wr == 0) PG8_BAR; }
        E(acc, cur, wr, wc, fr, fq); S.done(cur);
        if (!has_next) break;
#pragma unroll
        for (int a = 0; a < 2; ++a)
#pragma unroll
            for (int b = 0; b < 2; ++b)
#pragma unroll
                for (int m = 0; m < 4; ++m)
#pragma unroll
                    for (int n = 0; n < 2; ++n) acc[a][b][m][n] = (f32x4){0.f, 0.f, 0.f, 0.f};
        cur = nxt; cA = nA; cB = nB; ++ui;
        if constexpr (ALIGN_EPI) { if (wr == 1) PG8_BAR; }
    }
    PG8_WAIT_V(0);
    if constexpr (!ALIGN_EPI) { if (wr == 0) PG8_BAR; }
    PG8_BAR;
#undef PG8_SA
#undef PG8_SB
#undef PG8_STAGE
#undef PG8_LDA
#undef PG8_LDB
#undef PG8_MMA
#undef PG8_WAIT_V
#undef PG8_WAIT_L
#undef PG8_BAR
#undef PG8_SCHED
}
}

constexpr int NWAVES = 8;
constexpr int D = 2048, MCTX = 4096, MLAT = 16384, M = MCTX + MLAT, NL = 4;
constexpr int DA = 1024, NH = 16, DB = 1024, NG = 8, HB = 128;
constexpr int LW = 64, LAA = 64, LGT = 160;
constexpr int CSH = 3 * DA + LW + LAA + LGT;
constexpr int PIN = CSH + 2 * DB;
constexpr int PINP = 5632;
constexpr int DFF = 5632, NGU = 2 * DFF;
constexpr int MODW = 6 * D;
constexpr float RMS_EPS = 1e-6f, GN_EPS = 64.0f * 1e-5f, LN_EPS = 1e-5f;

constexpr size_t MiB = 1u << 20;
constexpr size_t WS_CTL = 0, CTL_ZERO_BYTES = 1 * MiB;
constexpr size_t WS_MOD = 1 * MiB;
constexpr size_t WS_W2T = 2 * MiB;
constexpr size_t WS_A2T = 3 * MiB;
constexpr size_t WS_G2T = 4 * MiB;
constexpr size_t WS_WSP = 6 * MiB;
constexpr size_t WS_BONUS = 7 * MiB;
constexpr size_t SZ_WIN = (size_t)PINP * D * 2, SZ_WOUT = (size_t)D * D * 2, SZ_WGU = (size_t)NGU * D * 2, SZ_WD = (size_t)D * DFF * 2;
constexpr size_t WS_WIN = 16 * MiB;
constexpr size_t WS_WOUT = WS_WIN + NL * SZ_WIN;
constexpr size_t WS_WGU = WS_WOUT + NL * SZ_WOUT;
constexpr size_t WS_WD = WS_WGU + NL * SZ_WGU;
constexpr size_t WS_H = WS_WD + NL * SZ_WD;
constexpr size_t WS_O = WS_H + (size_t)M * D * 2;
constexpr size_t WS_P = WS_O + (size_t)M * D * 2;
constexpr size_t WS_PS = WS_P + (size_t)M * PINP * 2;
constexpr size_t SZ_T16 = (size_t)M * DA * 2;
constexpr size_t WS_GATE = WS_PS + (size_t)M * CSH * 2;
constexpr size_t SZ_CH = (size_t)(M / 64) * NH * 2 * 8192;
constexpr size_t WS_PST = WS_GATE + SZ_T16;
constexpr size_t WS_NCT = WS_PST + SZ_CH;
constexpr size_t WS_PYT = WS_NCT + SZ_CH;
constexpr size_t WS_QYT = WS_PYT + SZ_CH;
constexpr size_t WS_VTG = WS_QYT + SZ_CH;
constexpr size_t WS_SC = WS_VTG + SZ_CH;
constexpr size_t WS_END1 = WS_SC + SZ_CH;
constexpr size_t WS_HID = WS_GATE;
constexpr size_t WS_END = WS_END1 > WS_HID + (size_t)M * DFF * 2 ? WS_END1 : WS_HID + (size_t)M * DFF * 2;
constexpr int CW_BAR = 4096;
constexpr int CW_SPLIT = 16384;
static_assert((CW_SPLIT + NL * 640 * 64) * 4 <= (int)CTL_ZERO_BYTES, "control words inside the memset region");

constexpr int RING_BYTES = 131072;
constexpr int LDSCTL_OFF = 15 * 9216, MISC_OFF = LDSCTL_OFF + 320;
constexpr int LDS_BYTES = 147456;

#define GAS __attribute__((address_space(1)))
#define LAS __attribute__((address_space(3)))
typedef unsigned short bf16;
typedef float f32x4 __attribute__((ext_vector_type(4)));
typedef float f32x2 __attribute__((ext_vector_type(2)));
typedef short bf16x8 __attribute__((ext_vector_type(8)));
typedef unsigned u32x4 __attribute__((ext_vector_type(4)));
typedef unsigned u32x2 __attribute__((ext_vector_type(2)));
#define LDS_WAIT() asm volatile("s_waitcnt lgkmcnt(0)" ::: "memory")
#define VM_WAIT() asm volatile("s_waitcnt vmcnt(0)" ::: "memory")
__device__ __forceinline__ unsigned f2bf(float f) { unsigned u = __builtin_bit_cast(unsigned, f); return (u + 0x7fffu + ((u >> 16) & 1u)) >> 16; }
typedef __bf16 bf16x2_t __attribute__((ext_vector_type(2)));
__device__ __forceinline__ unsigned pk2(float lo, float hi) { return __builtin_bit_cast(unsigned, __builtin_convertvector((f32x2){lo, hi}, bf16x2_t)); }
__device__ __forceinline__ float bf2f(unsigned short b) { return __uint_as_float(((unsigned)b) << 16); }
__device__ __forceinline__ void unpack8(const u32x4 q, float (&f)[8]) {
    f[0] = __uint_as_float(q.x << 16); f[1] = __uint_as_float(q.x & 0xffff0000u); f[2] = __uint_as_float(q.y << 16); f[3] = __uint_as_float(q.y & 0xffff0000u);
    f[4] = __uint_as_float(q.z << 16); f[5] = __uint_as_float(q.z & 0xffff0000u); f[6] = __uint_as_float(q.w << 16); f[7] = __uint_as_float(q.w & 0xffff0000u); }
__device__ __forceinline__ u32x4 pack8(const float (&f)[8]) { u32x4 o; o.x = pk2(f[0], f[1]); o.y = pk2(f[2], f[3]); o.z = pk2(f[4], f[5]); o.w = pk2(f[6], f[7]); return o; }
__device__ __forceinline__ float fsigmoid(float x) { return __builtin_amdgcn_rcpf(1.0f + __expf(-x)); }
__device__ __forceinline__ float ftanh(float x) { return 1.0f - 2.0f * __builtin_amdgcn_rcpf(1.0f + __expf(2.0f * x)); }
__device__ __forceinline__ float gelu_tanh(float x) { const float u = 1.5957691216057308f * (x + 0.044715f * x * x * x); return x * __builtin_amdgcn_rcpf(1.0f + __expf(-u)); }
__device__ __forceinline__ int hw_lane() { int l; asm volatile("v_mbcnt_lo_u32_b32 %0, -1, 0\n\tv_mbcnt_hi_u32_b32 %0, -1, %0" : "=v"(l)); return l; }
#define SHX(v, X) __int_as_float(__builtin_amdgcn_ds_bpermute((lane ^ (X)) << 2, __float_as_int(v)))
#define WAVE_SUM(v) do { v += SHX(v, 1); v += SHX(v, 2); v += SHX(v, 4); v += SHX(v, 8); v += SHX(v, 16); v += SHX(v, 32); } while (0)

#define PH_LOCALS(F) int wave = (F).wave; asm volatile("" : "+s"(wave)); const int lane = hw_lane(); const int tid = wave * 64 + lane; \
    int bx = (F).bx, G = (F).G; asm volatile("" : "+s"(bx), "+s"(G)); (void)lane; (void)tid;
#define PH_LAYER(l) asm volatile("" : "+s"(l))

#define XB_TMO      128
#define XB_XCNT(j)  (256  + 64 * (j))
#define XB_XSUB(j)  (1280 + 64 * (j))
#define XB_XGEN(j)  (2304 + 64 * (j))
#define XB_TOP      3328
#define XB_TOPGEN   3392
#define XCD_BAR_WORDS 3456
#define XB_SPIN_CAP (1u << 18)

__device__ __forceinline__ unsigned xb_ld(unsigned* p)              { return __hip_atomic_load(p, __ATOMIC_RELAXED, __HIP_MEMORY_SCOPE_AGENT); }
__device__ __forceinline__ unsigned xb_add(unsigned* p, unsigned v) { return __hip_atomic_fetch_add(p, v, __ATOMIC_RELAXED, __HIP_MEMORY_SCOPE_AGENT); }
__device__ __forceinline__ unsigned xb_xcc_id() { return (unsigned)__builtin_amdgcn_s_getreg((3 << 11) | 20) & 0xFu; }
#define XB_SPIN(cond, bar) do { unsigned _sp = 0; while (cond) { __builtin_amdgcn_s_sleep(1); \
    if ((++_sp & 255u) == 0u) { if (xb_ld(&(bar)[XB_TMO])) break; if (_sp > XB_SPIN_CAP) { atomicAdd(&(bar)[XB_TMO], 1u); break; } } } } while (0)

struct XcdBarrier {
    unsigned* bar; unsigned x;
    volatile LAS unsigned* st;
};
__device__ __forceinline__ XcdBarrier xcd_barrier_post(unsigned* bar, volatile LAS unsigned* st) {
    XcdBarrier b; b.bar = bar; b.x = xb_xcc_id(); b.st = st;
    if (threadIdx.x == 0) (void)xb_add(&bar[XB_XCNT(b.x)], 1u);
    return b;
}
__device__ __forceinline__ void xcd_barrier_complete(unsigned* bar, unsigned x, unsigned& nloc, unsigned& nx) {
    const unsigned G = gridDim.x * gridDim.y * gridDim.z;
    unsigned sum, cnt, mine, sp = 0u;
    for (;;) {
        sum = 0u; cnt = 0u; mine = 0u;
#pragma unroll
        for (unsigned j = 0; j < 16; ++j) { const unsigned c = xb_ld(&bar[XB_XCNT(j)]); sum += c; cnt += (c > 0u) ? 1u : 0u; mine = (j == x) ? c : mine; }
        if (sum == G) break;
        __builtin_amdgcn_s_sleep(1);
        if ((++sp & 255u) == 0u) { if (xb_ld(&bar[XB_TMO])) break; if (sp > XB_SPIN_CAP) { atomicAdd(&bar[XB_TMO], 1u); break; } }
    }
    nloc = mine > 0u ? mine : 1u; nx = cnt > 0u ? cnt : 1u;
}
__device__ __forceinline__ void xcd_barrier(const XcdBarrier& b) {
    asm volatile("s_waitcnt vmcnt(0)" ::: "memory");
    __syncthreads();
    if (threadIdx.x == 0) {
        unsigned* bar = b.bar;
        __builtin_amdgcn_s_waitcnt(0);
        unsigned nloc = b.st[0], nx = b.st[1];
        if (nloc == 0u) { xcd_barrier_complete(bar, b.x, nloc, nx); b.st[0] = nloc; b.st[1] = nx; }
        const unsigned old = xb_add(&bar[XB_XSUB(b.x)], 1u);
        const unsigned gen = old / nloc;
        if (old + 1u == (gen + 1u) * nloc) {
            __builtin_amdgcn_fence(__ATOMIC_RELEASE, "agent");
            asm volatile("s_waitcnt vmcnt(0)" ::: "memory");
            const unsigned og = xb_add(&bar[XB_TOP], 1u);
            const unsigned tg = og / nx;
            if (og + 1u == (tg + 1u) * nx) xb_add(&bar[XB_TOPGEN], 1u);
            else XB_SPIN(xb_ld(&bar[XB_TOPGEN]) == tg, bar);
            __builtin_amdgcn_fence(__ATOMIC_ACQUIRE, "agent");
            xb_add(&bar[XB_XGEN(b.x)], 1u);
            asm volatile("s_waitcnt vmcnt(0)" ::: "memory");
        } else {
            XB_SPIN(xb_ld(&bar[XB_XGEN(b.x)]) == gen, bar);
            __builtin_amdgcn_fence(__ATOMIC_ACQUIRE, "agent");
            asm volatile("s_waitcnt vmcnt(0)" ::: "memory");
        }
    }
    __syncthreads();
}

struct Args {
    const float* in[30];
    float* out; unsigned char* ws;
    int ph_lo, ph_hi, li, pad;
};
enum { I_XP = 0, I_XS, I_STATE, I_C, I_CCTX, I_WMOD, I_BMOD, I_N1G, I_WIN, I_MU, I_W0, I_W2, I_A0, I_A2, I_G2, I_KK, I_KA, I_RK, I_GNW, I_GNB, I_LNG, I_LNB, I_WSP, I_BSP, I_WOUT, I_N2G, I_WG, I_WU, I_WD, I_FNG };

struct Frame {
    LAS unsigned char* lds;
    int tid, lane, wave, G, bx;
    const float* const* in;
    float* out; unsigned char* ws;
};

struct EpiP {
    static constexpr bool PERM = true, AFTER_DRAIN = false;
    bf16* O; int ldc; int gelu_from;
    __device__ __forceinline__ void operator()(const f32x4 (&acc)[2][2][4][2], const pg8::Unit& u, int wr, int wc, int fr, int fq) const {
        const int row0 = u.pm * 256 + wr * 64 + fr, col0 = u.pn * 256 + wc * 32 + 8 * fq;
#pragma unroll
        for (int ai = 0; ai < 2; ++ai)
#pragma unroll
            for (int m = 0; m < 4; ++m) { bf16* rowp = O + (size_t)(row0 + ai * 128 + m * 16) * ldc + col0;
#pragma unroll
                for (int bj = 0; bj < 2; ++bj) { f32x4 v0 = acc[ai][bj][m][0], v1 = acc[ai][bj][m][1];
                    if (col0 + bj * 128 >= gelu_from) {
#pragma unroll
                        for (int j = 0; j < 4; ++j) { v0[j] = gelu_tanh(v0[j]); v1[j] = gelu_tanh(v1[j]); } }
                    u32x4 w; w.x = pg8::cvt_pk_bf16(v0[0], v0[1]); w.y = pg8::cvt_pk_bf16(v0[2], v0[3]); w.z = pg8::cvt_pk_bf16(v1[0], v1[1]); w.w = pg8::cvt_pk_bf16(v1[2], v1[3]);
                    *(u32x4*)(rowp + bj * 128) = w; } }
    }
};
struct EpiRes {
    static constexpr bool PERM = false, AFTER_DRAIN = false;
    const float* xlo; const float* xhi; float* xout; const float* modl; int goff, nk_full; float* parts; unsigned* cnts;
    __device__ __forceinline__ void operator()(const f32x4 (&acc)[2][2][4][2], const pg8::Unit& u, int wr, int wc, int fr, int fq) const {
        const int pm = u.pm; const int midx = pm < 16 ? 0 : 1 + ((pm - 16) >> 4); const int role = u.nk == nk_full ? 0 : (u.k0 == 0 ? 1 : 2);
        float* part = parts + (size_t)pm * 256 * D;
        unsigned* cnt = cnts + (size_t)(pm * 8 + u.pn) * 64;
        if (role == 1) {
            const unsigned long long t0 = __builtin_amdgcn_s_memrealtime();
            while ((unsigned)__builtin_amdgcn_readfirstlane(__hip_atomic_load(cnt, __ATOMIC_RELAXED, __HIP_MEMORY_SCOPE_AGENT)) < 8u) { if (__builtin_amdgcn_s_memrealtime() - t0 > 2000000ull) break; __builtin_amdgcn_s_sleep(2); }
            __builtin_amdgcn_fence(__ATOMIC_ACQUIRE, "agent"); asm volatile("s_waitcnt vmcnt(0)" ::: "memory"); }
        const float* gv = modl + (size_t)midx * MODW + goff;
        const float* base = pm < 16 ? xlo + (size_t)pm * 256 * D : xhi + (size_t)(pm - 16) * 256 * D;
        float* ob = xout + (size_t)pm * 256 * D;
        const int col0 = u.pn * 256 + wc * 32 + 4 * fq;
        f32x4 gvv[2][2];
#pragma unroll
        for (int bj = 0; bj < 2; ++bj)
#pragma unroll
            for (int n = 0; n < 2; ++n) gvv[bj][n] = *(const f32x4*)(gv + col0 + bj * 128 + n * 16);
#pragma unroll
        for (int ai = 0; ai < 2; ++ai)
#pragma unroll
            for (int m = 0; m < 4; ++m) { const size_t off = (size_t)(ai * 128 + wr * 64 + m * 16 + fr) * D + col0;
#pragma unroll
                for (int bj = 0; bj < 2; ++bj)
#pragma unroll
                    for (int n = 0; n < 2; ++n) { const size_t o = off + bj * 128 + n * 16;
                        if (role == 2) {
                            const f32x4 a = gvv[bj][n] * acc[ai][bj][m][n]; unsigned long long* q = (unsigned long long*)(part + o);
                            __hip_atomic_store(q, ((unsigned long long)__float_as_uint(a[1]) << 32) | __float_as_uint(a[0]), __ATOMIC_RELAXED, __HIP_MEMORY_SCOPE_AGENT);
                            __hip_atomic_store(q + 1, ((unsigned long long)__float_as_uint(a[3]) << 32) | __float_as_uint(a[2]), __ATOMIC_RELAXED, __HIP_MEMORY_SCOPE_AGENT); }
                        else { f32x4 xo = *(const f32x4*)(base + o);
                            if (role == 1) xo += *(const f32x4*)(part + o);
                            *(f32x4*)(ob + o) = xo + gvv[bj][n] * acc[ai][bj][m][n]; } }
                if (m & 1) asm volatile("" ::: "memory"); }
        if (role == 2) { asm volatile("s_waitcnt vmcnt(0)" ::: "memory"); if (fr == 0 && fq == 0) __hip_atomic_fetch_add(cnt, 1u, __ATOMIC_RELAXED, __HIP_MEMORY_SCOPE_AGENT); }
    }
};
struct EpiSwi {
    static constexpr bool PERM = true, AFTER_DRAIN = false;
    bf16* O; int ldc;
    __device__ __forceinline__ void operator()(const f32x4 (&acc)[2][2][4][2], const pg8::Unit& u, int wr, int wc, int fr, int fq) const {
        const int row0 = u.pm * 256 + wr * 64 + fr, col0 = u.pn * 128 + wc * 32 + 8 * fq;
#pragma unroll
        for (int ai = 0; ai < 2; ++ai)
#pragma unroll
            for (int m = 0; m < 4; ++m) { bf16* rowp = O + (size_t)(row0 + ai * 128 + m * 16) * ldc + col0;
                float h[8];
#pragma unroll
                for (int n = 0; n < 2; ++n)
#pragma unroll
                    for (int j = 0; j < 4; ++j) { const float gt = acc[ai][0][m][n][j], up = acc[ai][1][m][n][j]; h[n * 4 + j] = gt * fsigmoid(gt) * up; }
                u32x4 w; w.x = pg8::cvt_pk_bf16(h[0], h[1]); w.y = pg8::cvt_pk_bf16(h[2], h[3]); w.z = pg8::cvt_pk_bf16(h[4], h[5]); w.w = pg8::cvt_pk_bf16(h[6], h[7]);
                *(u32x4*)rowp = w; }
    }
};

template <int MAP>
__device__ __forceinline__ void tr_item(const float* W, int K, int N, bf16* WT, LAS float* scr, int item, int lane) {
    const int nblk = N / 32, kb = item / nblk, nb = item % nblk, k0 = 64 * kb, n0 = 32 * nb;
#pragma unroll 8
    for (int i = 0; i < 32; ++i) { const int kk = 2 * i + (lane >> 5); scr[kk * 33 + (lane & 31)] = W[(size_t)(k0 + kk) * N + n0 + (lane & 31)]; }
    LDS_WAIT(); asm volatile("" ::: "memory");
    const int c = lane & 7;
#pragma unroll
    for (int j = 0; j < 4; ++j) { const int n = (lane >> 3) + 8 * j; const LAS float* s = scr + (8 * c) * 33 + n;
        u32x4 o; o.x = pk2(s[0 * 33], s[1 * 33]); o.y = pk2(s[2 * 33], s[3 * 33]); o.z = pk2(s[4 * 33], s[5 * 33]); o.w = pk2(s[6 * 33], s[7 * 33]);
        const int nn = n0 + n; const int orow = MAP == 0 ? nn : (256 * (nn >> 7) + (nn & 127) + (MAP == 2 ? 128 : 0));
        *(u32x4*)(WT + (size_t)orow * K + k0 + 8 * c) = o; }
    LDS_WAIT(); asm volatile("" ::: "memory");
}
__device__ __forceinline__ void p0_prologue(Frame& F) {
    PH_LOCALS(F);
    LAS float* scr = (LAS float*)(F.lds + wave * 16384);
    const int gw = bx * NWAVES + wave, NGW = G * NWAVES;
    constexpr int I_IN = (D / 64) * (PIN / 32), I_OUT = (D / 64) * (D / 32), I_GU = (D / 64) * (DFF / 32), I_DN = (DFF / 64) * (D / 32);
    constexpr int PL = I_IN + I_OUT + 2 * I_GU + I_DN;
    for (int it = gw; it < NL * PL; it += NGW) {
        const int l = it / PL; int r = it % PL;
        if (r < I_IN) { tr_item<0>(F.in[I_WIN] + (size_t)l * D * PIN, D, PIN, (bf16*)(F.ws + WS_WIN + l * SZ_WIN), scr, r, lane); continue; } r -= I_IN;
        if (r < I_OUT) { tr_item<0>(F.in[I_WOUT] + (size_t)l * D * D, D, D, (bf16*)(F.ws + WS_WOUT + l * SZ_WOUT), scr, r, lane); continue; } r -= I_OUT;
        if (r < I_GU) { tr_item<1>(F.in[I_WG] + (size_t)l * D * DFF, D, DFF, (bf16*)(F.ws + WS_WGU + l * SZ_WGU), scr, r, lane); continue; } r -= I_GU;
        if (r < I_GU) { tr_item<2>(F.in[I_WU] + (size_t)l * D * DFF, D, DFF, (bf16*)(F.ws + WS_WGU + l * SZ_WGU), scr, r, lane); continue; } r -= I_GU;
        tr_item<0>(F.in[I_WD] + (size_t)l * DFF * D, DFF, D, (bf16*)(F.ws + WS_WD + l * SZ_WD), scr, r, lane);
    }
    const int gt = bx * 512 + tid, NGT = G * 512;
    { constexpr int PADV = (PINP - PIN) * D * 2 / 16;
      for (int i = gt; i < NL * PADV; i += NGT) { const int l = i / PADV, r = i % PADV; ((u32x4*)(F.ws + WS_WIN + l * SZ_WIN + (size_t)PIN * D * 2))[r] = (u32x4){0u, 0u, 0u, 0u}; } }
    { bf16* w2t = (bf16*)(F.ws + WS_W2T); bf16* a2t = (bf16*)(F.ws + WS_A2T); bf16* g2t = (bf16*)(F.ws + WS_G2T); bf16* wsp = (bf16*)(F.ws + WS_WSP);
      for (int i = gt; i < NL * 2 * 1024 * 64; i += NGT) { const int k = i & 63, n = (i >> 6) & 1023, ld = i >> 16;
          w2t[i] = (bf16)f2bf(F.in[I_W2][((size_t)ld * 64 + k) * 1024 + n]); a2t[i] = (bf16)f2bf(F.in[I_A2][((size_t)ld * 64 + k) * 1024 + n]); }
      for (int i = gt; i < NL * 1024 * 160; i += NGT) { const int k = i % 160, n = (i / 160) & 1023, l = i / (160 * 1024);
          g2t[i] = (bf16)f2bf(F.in[I_G2][((size_t)l * 160 + k) * 1024 + n]); }
      for (int i = gt; i < NL * 8 * 128 * 128; i += NGT) wsp[i] = (bf16)f2bf(F.in[I_WSP][i]); }
    __syncthreads();
    { LAS float* sv = (LAS float*)F.lds;
      LAS float* red = (LAS float*)(F.lds + 40960);
      for (int i = tid; i < 5 * D; i += 512) { const int r = i / D, k = i % D; const float c = r == 0 ? F.in[I_CCTX][k] : F.in[I_C][(r - 1) * D + k]; sv[i] = c * fsigmoid(c); }
      __syncthreads();
      float* mod = (float*)(F.ws + WS_MOD);
      const int c4 = tid & 15, kg = tid >> 4;
      for (int item = bx; item < NL * (MODW / 64); item += G) {
          const int l = item / (MODW / 64), n0 = (item % (MODW / 64)) * 64;
          const float* W = F.in[I_WMOD] + (size_t)l * D * MODW + n0 + 4 * c4;
          f32x4 a[5];
#pragma unroll
          for (int r = 0; r < 5; ++r) a[r] = (f32x4){0.f, 0.f, 0.f, 0.f};
#pragma unroll 4
          for (int i = 0; i < 64; ++i) { const int k = i * 32 + kg; const f32x4 w = *(const f32x4*)(W + (size_t)k * MODW);
#pragma unroll
              for (int r = 0; r < 5; ++r) a[r] += w * sv[r * D + k]; }
#pragma unroll
          for (int r = 0; r < 5; ++r) *(LAS f32x4*)(red + (kg * 5 + r) * 64 + 4 * c4) = a[r];
          __syncthreads();
          if (tid < 320) { const int r = tid >> 6, n = tid & 63; float s = 0.f;
#pragma unroll 8
              for (int g = 0; g < 32; ++g) s += red[(g * 5 + r) * 64 + n];
              mod[((size_t)l * 5 + r) * MODW + n0 + n] = s + F.in[I_BMOD][(size_t)l * MODW + n0 + n]; }
          __syncthreads();
      } }
}

__device__ __forceinline__ void p_adaln(Frame& F, int l, int which, const float* xlo, const float* xhi) {
    PH_LOCALS(F); PH_LAYER(l);
    const int gw = bx * NWAVES + wave, NGW = G * NWAVES;
    const float* ng = (which == 0 ? F.in[I_N1G] : F.in[I_N2G]) + (size_t)l * D;
    const int shoff = which == 0 ? 0 : 3 * D, scoff = shoff + D;
    const float* mod = (const float*)(F.ws + WS_MOD);
    bf16* H = (bf16*)(F.ws + WS_H);
    for (int row = gw; row < M; row += NGW) {
        const float* xr = row < MCTX ? xlo + (size_t)row * D : xhi + (size_t)(row - MCTX) * D;
        const int midx = row < MCTX ? 0 : 1 + ((row - MCTX) >> 12);
        const float* md = mod + ((size_t)l * 5 + midx) * MODW;
        f32x4 v[8]; float ss = 0.f;
#pragma unroll
        for (int j = 0; j < 8; ++j) { v[j] = *(const f32x4*)(xr + 4 * lane + 256 * j); ss += (v[j].x * v[j].x + v[j].y * v[j].y) + (v[j].z * v[j].z + v[j].w * v[j].w); }
        WAVE_SUM(ss); const float rstd = 1.0f / sqrtf(ss * (1.0f / D) + RMS_EPS);
#pragma unroll
        for (int j = 0; j < 8; ++j) { const int c = 4 * lane + 256 * j;
            const f32x4 g4 = *(const f32x4*)(ng + c), sc = *(const f32x4*)(md + scoff + c), sh = *(const f32x4*)(md + shoff + c);
            const f32x4 o = v[j] * rstd * g4 * (sc + 1.0f) + sh;
            u32x2 w; w.x = pk2(o.x, o.y); w.y = pk2(o.z, o.w);
            *(u32x2*)(H + (size_t)row * D + c) = w; }
    }
}

__device__ __forceinline__ void load_shifted8(const bf16* P, const float* mu, int row, int col, float (&o)[8]) {
    float g[8]; unpack8(*(const u32x4*)(P + (size_t)row * PINP + col), g);
    float a[8];
#pragma unroll
    for (int j = 0; j < 8; ++j) a[j] = g[j];
    int nrow[4]; bool has[4]; int nn;
    if (row < MCTX) { const int t = row & 255; nn = 2; nrow[0] = row - 1; has[0] = t > 0; nrow[1] = row + 1; has[1] = t < 255; nrow[2] = row; has[2] = false; nrow[3] = row; has[3] = false; }
    else { const int t = (row - MCTX) & 4095, gc = t & 63, gr = t >> 6; nn = 4;
        nrow[0] = row - 1; has[0] = gc > 0; nrow[1] = row + 1; has[1] = gc < 63; nrow[2] = row - 64; has[2] = gr > 0; nrow[3] = row + 64; has[3] = gr < 63; }
#pragma unroll
    for (int q = 0; q < 4; ++q) {
        if (q < nn) {
            float nb[8];
            if (has[q]) unpack8(*(const u32x4*)(P + (size_t)nrow[q] * PINP + col), nb);
            else {
#pragma unroll
                for (int j = 0; j < 8; ++j) nb[j] = 0.f; }
            const f32x4 m0 = *(const f32x4*)(mu + q * CSH + col), m1 = *(const f32x4*)(mu + q * CSH + col + 4);
#pragma unroll
            for (int j = 0; j < 4; ++j) { a[j] += m0[j] * (nb[j] - g[j]); a[4 + j] += m1[j] * (nb[4 + j] - g[4 + j]); }
        }
    }
#pragma unroll
    for (int j = 0; j < 8; ++j) o[j] = a[j];
}
__device__ __forceinline__ void p_shift(Frame& F, int l) {
    PH_LOCALS(F); PH_LAYER(l);
    const bf16* P = (const bf16*)(F.ws + WS_P); bf16* PS = (bf16*)(F.ws + WS_PS);
    const float* mu = F.in[I_MU] + (size_t)l * 4 * CSH;
    constexpr int CG = CSH / 8;
    const int rpw = (M + G - 1) / G, rbeg = bx * rpw, rend = (rbeg + rpw < M) ? rbeg + rpw : M;
    if (tid < CG) {
        const int col = tid * 8; const int act = (col >= 3 * DA && col < 3 * DA + LW) ? 1 : (col >= 3 * DA + LW + LAA ? 2 : 0);
        f32x4 m[4][2];
#pragma unroll
        for (int q = 0; q < 4; ++q) { m[q][0] = *(const f32x4*)(mu + q * CSH + col); m[q][1] = *(const f32x4*)(mu + q * CSH + col + 4); }
        for (int r0 = rbeg; r0 < rend; r0 += 4) {
#pragma unroll
            for (int u = 0; u < 4; ++u) { const int row = r0 + u; if (row < rend) {
                const bf16* pc = P + (size_t)row * PINP + col;
                int nrow[4]; bool has[4]; int nn;
                if (row < MCTX) { const int t = row & 255; nn = 2; nrow[0] = -1; has[0] = t > 0; nrow[1] = 1; has[1] = t < 255; nrow[2] = 0; has[2] = false; nrow[3] = 0; has[3] = false; }
                else { const int t = (row - MCTX) & 4095, gc = t & 63, gr = t >> 6; nn = 4; nrow[0] = -1; has[0] = gc > 0; nrow[1] = 1; has[1] = gc < 63; nrow[2] = -64; has[2] = gr > 0; nrow[3] = 64; has[3] = gr < 63; }
                u32x4 raw[5]; raw[0] = *(const u32x4*)pc;
#pragma unroll
                for (int q = 0; q < 4; ++q) raw[1 + q] = (q < nn && has[q]) ? *(const u32x4*)(pc + (ptrdiff_t)nrow[q] * PINP) : (u32x4){0u, 0u, 0u, 0u};
                float g[8], a[8]; unpack8(raw[0], g);
#pragma unroll
                for (int jx = 0; jx < 8; ++jx) a[jx] = g[jx];
#pragma unroll
                for (int q = 0; q < 4; ++q) if (q < nn) { float nb[8]; unpack8(raw[1 + q], nb);
#pragma unroll
                    for (int jx = 0; jx < 4; ++jx) { a[jx] += m[q][0][jx] * (nb[jx] - g[jx]); a[4 + jx] += m[q][1][jx] * (nb[4 + jx] - g[4 + jx]); } }
                if (act == 1) {
#pragma unroll
                    for (int jx = 0; jx < 8; ++jx) a[jx] = ftanh(a[jx]); }
                else if (act == 2) {
#pragma unroll
                    for (int jx = 0; jx < 8; ++jx) a[jx] = fsigmoid(a[jx]); }
                *(u32x4*)(PS + (size_t)row * CSH + col) = pack8(a); } }
        }
    }
}

#define F4Z ((f32x4){0.f, 0.f, 0.f, 0.f})
__device__ __forceinline__ u32x2 pk4(const f32x4 a) { u32x2 w; w.x = pk2(a[0], a[1]); w.y = pk2(a[2], a[3]); return w; }
#define LBAR() do { asm volatile("s_waitcnt lgkmcnt(0)" ::: "memory"); __builtin_amdgcn_s_barrier(); asm volatile("" ::: "memory"); } while (0)
constexpr int VTS = 136;
typedef short s16x4g __attribute__((ext_vector_type(4)));
__device__ __forceinline__ bf16x8 frag_tr_ld(const LAS bf16* X, int ld, int kbase, int c0, int fr, int fq) {
    const LAS bf16* p = X + (kbase + 8 * fq + (fr >> 2)) * ld + c0 + 4 * (fr & 3);
    const s16x4g lo = __builtin_amdgcn_ds_read_tr16_b64_v4i16((LAS s16x4g*)p);
    const s16x4g hi = __builtin_amdgcn_ds_read_tr16_b64_v4i16((LAS s16x4g*)(p + 4 * ld));
    return (bf16x8){lo[0], lo[1], lo[2], lo[3], hi[0], hi[1], hi[2], hi[3]};
}
__device__ __forceinline__ void p_gmlp(Frame& F, int l) {
    PH_LOCALS(F); PH_LAYER(l);
    const bf16* P = (const bf16*)(F.ws + WS_P); bf16* O = (bf16*)(F.ws + WS_O);
    const bf16* wsp = (const bf16*)(F.ws + WS_WSP) + (size_t)l * 8 * 128 * 128;
    LAS bf16* VN = (LAS bf16*)F.lds;
    LAS bf16* ST = (LAS bf16*)(F.lds + 34816);
    const int fr = lane & 15, fq = lane >> 4;
    constexpr int NIT = (M / 128) * NG;
    const int jrow = tid >> 2, q4 = tid & 3;
    u32x4 pvv[4];
#define GM_ISSUE(item_) do { const bf16* src_ = P + (size_t)(((item_) >> 3) * 128 + jrow) * PINP + CSH + DB + 128 * ((item_) & 7) + 32 * q4; \
        _Pragma("unroll") for (int i_ = 0; i_ < 4; ++i_) pvv[i_] = *(const u32x4*)(src_ + 8 * i_); } while (0)
    if (bx < NIT) GM_ISSUE(bx);
    for (int item = bx; item < NIT; item += G) {
        const int cb = item >> 3, g = item & 7, R0 = cb * 128;
        u32x4 pu[4]; { const bf16* up = P + (size_t)(R0 + jrow) * PINP + CSH + 128 * g + 32 * q4;
#pragma unroll
            for (int i = 0; i < 4; ++i) pu[i] = *(const u32x4*)(up + 8 * i); }
        bf16x8 bw[4]; { const bf16* wa = wsp + ((size_t)g * 128 + 16 * wave + fr) * 128 + 8 * fq;
#pragma unroll
            for (int ks = 0; ks < 4; ++ks) bw[ks] = *(const bf16x8*)(wa + 32 * ks); }
        const float bsp = F.in[I_BSP][((size_t)l * 8 + g) * 128 + jrow];
        { float v[32];
#pragma unroll
          for (int i = 0; i < 4; ++i) { float f[8]; unpack8(pvv[i], f);
#pragma unroll
              for (int jj = 0; jj < 8; ++jj) v[8 * i + jj] = f[jj]; }
          float s = 0.f;
#pragma unroll
          for (int i = 0; i < 32; ++i) s += v[i];
          s += SHX(s, 1); s += SHX(s, 2);
          const float mean = s * (1.0f / 128.0f); float qq = 0.f;
#pragma unroll
          for (int i = 0; i < 32; ++i) { v[i] -= mean; qq += v[i] * v[i]; }
          qq += SHX(qq, 1); qq += SHX(qq, 2);
          const float rstd = 1.0f / sqrtf(qq * (1.0f / 128.0f) + LN_EPS);
          const float* lg = F.in[I_LNG] + ((size_t)l * 8 + g) * 128 + 32 * q4; const float* lb = F.in[I_LNB] + ((size_t)l * 8 + g) * 128 + 32 * q4;
#pragma unroll
          for (int i = 0; i < 4; ++i) { float o[8]; const f32x4 g0 = *(const f32x4*)(lg + 8 * i), g1 = *(const f32x4*)(lg + 8 * i + 4), b0 = *(const f32x4*)(lb + 8 * i), b1 = *(const f32x4*)(lb + 8 * i + 4);
#pragma unroll
              for (int jj = 0; jj < 4; ++jj) { o[jj] = v[8 * i + jj] * rstd * g0[jj] + b0[jj]; o[4 + jj] = v[8 * i + 4 + jj] * rstd * g1[jj] + b1[jj]; }
              *(LAS u32x4*)(VN + jrow * VTS + 32 * q4 + 8 * i) = pack8(o); } }
        if (item + G < NIT) GM_ISSUE(item + G);
        LBAR();
#pragma unroll
        for (int mt = 0; mt < 8; ++mt) { f32x4 acc = F4Z;
#pragma unroll
            for (int ks = 0; ks < 4; ++ks) acc = __builtin_amdgcn_mfma_f32_16x16x32_bf16(frag_tr_ld(VN, VTS, 32 * ks, 16 * mt, fr, fq), bw[ks], acc, 0, 0, 0);
            *(LAS u32x2*)(ST + (16 * wave + fr) * VTS + 16 * mt + 4 * fq) = pk4(acc); }
        LBAR();
        { bf16* op = O + (size_t)(R0 + jrow) * D + DA + 128 * g + 32 * q4;
#pragma unroll
          for (int i = 0; i < 4; ++i) { float sv[8], uv[8], o[8]; unpack8(*(const LAS u32x4*)(ST + jrow * VTS + 32 * q4 + 8 * i), sv); unpack8(pu[i], uv);
#pragma unroll
              for (int jj = 0; jj < 8; ++jj) o[jj] = uv[jj] * (sv[jj] + bsp);
              *(u32x4*)(op + 8 * i) = pack8(o); } }
    }
    LBAR();
#undef GM_ISSUE
}

constexpr int T16B = 9216, LD16 = 72, LD32 = 68;
#define SLOT(i) ((LAS bf16*)(lds + (i) * T16B))
#define SLOTF(i) ((LAS float*)(lds + (i) * T16B))
template <int NK>
__device__ __forceinline__ f32x4 tile_mm(const LAS bf16* A, int lda, const LAS bf16* B, int ldb, int fr, int fq, f32x4 acc) {
#pragma unroll
    for (int ks = 0; ks < NK; ++ks) { const bf16x8 a = *(const LAS bf16x8*)(A + fr * lda + 8 * fq + 32 * ks); const bf16x8 b = *(const LAS bf16x8*)(B + fr * ldb + 8 * fq + 32 * ks);
        acc = __builtin_amdgcn_mfma_f32_16x16x32_bf16(a, b, acc, 0, 0, 0); }
    return acc;
}
__device__ __forceinline__ void st_nat(LAS bf16* dst, int n0, int m0, int fr, int fq, const f32x4 a) { *(LAS u32x2*)(dst + (n0 + fr) * LD16 + m0 + 4 * fq) = pk4(a); }
__device__ __forceinline__ void st_rm(LAS bf16* dst, int n0, int m0, int fr, int fq, const f32x4 a) {
#pragma unroll
    for (int r = 0; r < 4; ++r) dst[(m0 + 4 * fq + r) * LD16 + n0 + fr] = (bf16)f2bf(a[r]); }
__device__ __forceinline__ f32x4 ld4bf(const LAS bf16* p) { const u32x2 w = *(const LAS u32x2*)p; return (f32x4){__uint_as_float(w.x << 16), __uint_as_float(w.x & 0xffff0000u), __uint_as_float(w.y << 16), __uint_as_float(w.y & 0xffff0000u)}; }

typedef short s16x4 __attribute__((ext_vector_type(4)));
__device__ __forceinline__ bf16x8 frag_tr(const LAS bf16* X, int kbase, int c0, int fr, int fq) {
    const LAS bf16* p = X + (kbase + 8 * fq + (fr >> 2)) * LD16 + c0 + 4 * (fr & 3);
    const s16x4 lo = __builtin_amdgcn_ds_read_tr16_b64_v4i16((LAS s16x4*)p);
    const s16x4 hi = __builtin_amdgcn_ds_read_tr16_b64_v4i16((LAS s16x4*)(p + 4 * LD16));
    return (bf16x8){lo[0], lo[1], lo[2], lo[3], hi[0], hi[1], hi[2], hi[3]};
}
__device__ __forceinline__ bf16x8 frag_rm(const LAS bf16* X, int r0, int ks, int fr, int fq) { return *(const LAS bf16x8*)(X + (r0 + fr) * LD16 + 8 * fq + 32 * ks); }
__device__ __forceinline__ f32x4 mm2(const bf16x8 (&a)[2], const bf16x8 (&b)[2], f32x4 acc) {
    acc = __builtin_amdgcn_mfma_f32_16x16x32_bf16(a[0], b[0], acc, 0, 0, 0); return __builtin_amdgcn_mfma_f32_16x16x32_bf16(a[1], b[1], acc, 0, 0, 0); }
__device__ __forceinline__ bf16x8 as_frag(const u32x4 q) { return __builtin_bit_cast(bf16x8, q); }

__device__ __forceinline__ void p_chunkA(Frame& F, int l) {
    PH_LOCALS(F); PH_LAYER(l);
    LAS unsigned char* lds = F.lds;
    const int lane0 = lane, lane00 = lane;
#define STG int lane_ = lane0; asm volatile("" : "+v"(lane_)); const int lane = lane_, fr = lane_ & 15, fq = lane_ >> 4, tid = wave * 64 + lane_, mt = wave >> 1, m0 = 16 * mt, np = (wave & 1) * 2; \
    (void)lane; (void)fr; (void)fq; (void)tid; (void)mt; (void)m0; (void)np;
    const bf16* PS = (const bf16*)(F.ws + WS_PS);
    const bf16* w2t = (const bf16*)(F.ws + WS_W2T) + (size_t)l * 2 * 1024 * 64;
    const bf16* a2t = (const bf16*)(F.ws + WS_A2T) + (size_t)l * 2 * 1024 * 64;
    const bf16* g2t = (const bf16*)(F.ws + WS_G2T) + (size_t)l * 1024 * 160;
    bf16* GATE = (bf16*)(F.ws + WS_GATE); float* BONUS = (float*)(F.ws + WS_BONUS);
    LAS float* gC = (LAS float*)(lds + 14 * T16B);
    LAS float* BT = (LAS float*)(lds + 14 * T16B + 256);
    u32x4 pf_w[2], pf_a[2], pf_g[5], pf_r, pf_k, pf_v; bf16x8 Bg[2][5], Bw[2][2], Ba[2][2]; float biw[2], bia[2];
#define CA_ISSUE(item_, d_) do { const int ci_ = (item_) >> 4, h_ = (item_) & 15, R0_ = ci_ * 64; int lane0 = lane00; asm volatile("" : "+v"(lane0)); \
        const bf16* arow_ = PS + (size_t)(R0_ + 16 * (wave >> 1) + (lane0 & 15)) * CSH + 3 * DA + 8 * (lane0 >> 4); \
        pf_w[0] = *(const u32x4*)arow_; pf_w[1] = *(const u32x4*)(arow_ + 32); pf_a[0] = *(const u32x4*)(arow_ + 64); pf_a[1] = *(const u32x4*)(arow_ + 96); \
        if ((d_) == 0) { _Pragma("unroll") for (int ks_ = 0; ks_ < 5; ++ks_) { pf_g[ks_] = *(const u32x4*)(arow_ + 128 + 32 * ks_); \
            _Pragma("unroll") for (int nn_ = 0; nn_ < 2; ++nn_) Bg[nn_][ks_] = *(const bf16x8*)(g2t + (size_t)(64 * h_ + 16 * ((wave & 1) * 2 + nn_) + (lane0 & 15)) * 160 + 8 * (lane0 >> 4) + 32 * ks_); } } \
        _Pragma("unroll") for (int nn_ = 0; nn_ < 2; ++nn_) { const int n_ = 64 * h_ + 16 * ((wave & 1) * 2 + nn_) + (lane0 & 15); \
            biw[nn_] = F.in[I_W0][((size_t)l * 2 + (d_)) * DA + n_]; bia[nn_] = F.in[I_A0][((size_t)l * 2 + (d_)) * DA + n_]; \
            _Pragma("unroll") for (int ks_ = 0; ks_ < 2; ++ks_) { Bw[nn_][ks_] = *(const bf16x8*)(w2t + ((size_t)(d_) * 1024 + n_) * 64 + 8 * (lane0 >> 4) + 32 * ks_); Ba[nn_][ks_] = *(const bf16x8*)(a2t + ((size_t)(d_) * 1024 + n_) * 64 + 8 * (lane0 >> 4) + 32 * ks_); } } \
        const int tid_ = wave * 64 + lane0, tau_ = tid_ >> 3, pos_ = (d_) ? 63 - tau_ : tau_; const bf16* rrow_ = PS + (size_t)(R0_ + pos_) * CSH + 64 * h_ + (tid_ & 7) * 8; \
        pf_r = *(const u32x4*)rrow_; pf_k = *(const u32x4*)(rrow_ + DA); pf_v = *(const u32x4*)(rrow_ + 2 * DA); } while (0)
    if (bx < (M / 64) * NH) CA_ISSUE(bx, 0);
    int hcur = -1;
    LAS float* HC = (LAS float*)(lds + 14 * T16B + 1280);
    for (int item = bx; item < (M / 64) * NH; item += G) {
        const int ci = item >> 4, h = item & 15, R0 = ci * 64;
        if (h != hcur) { hcur = h;
            LBAR();
            { const int t_ = wave * 64 + lane0; if (t_ < 192) { const int w_ = t_ >> 6, c_ = t_ & 63; HC[t_] = (w_ == 0 ? F.in[I_KK] : (w_ == 1 ? F.in[I_KA] : F.in[I_RK]))[(size_t)l * DA + 64 * h + c_]; } } }
        for (int d = 0; d < 2; ++d) {
            const size_t qi = ((size_t)ci * 16 + h) * 2 + d;
            const bf16x8 cBw[2][2] = {{Bw[0][0], Bw[0][1]}, {Bw[1][0], Bw[1][1]}}, cBa[2][2] = {{Ba[0][0], Ba[0][1]}, {Ba[1][0], Ba[1][1]}}; const float cbw[2] = {biw[0], biw[1]}, cba[2] = {bia[0], bia[1]};
            u32x4 cw[2] = {pf_w[0], pf_w[1]}, ca[2] = {pf_a[0], pf_a[1]}, cg[5] = {pf_g[0], pf_g[1], pf_g[2], pf_g[3], pf_g[4]}; const u32x4 cr = pf_r, ck = pf_k, cv = pf_v;
            for (int repA = 0; repA < (PROBE_SUB == 1 ? 2 : 1); ++repA) {
            { STG; LAS float* AL = SLOTF(5); LAS float* LW = SLOTF(7);
              bf16x8 aw[2], aa[2];
#pragma unroll
              for (int ks = 0; ks < 2; ++ks) { aw[ks] = as_frag(cw[ks]); aa[ks] = as_frag(ca[ks]); }
#pragma unroll
              for (int nn = 0; nn < 2; ++nn) { const int nl = 16 * (np + nn) + fr, n = 64 * h + nl;
                  const f32x4 accw = mm2(aw, cBw[nn], F4Z), acca = mm2(aa, cBa[nn], F4Z);
                  const float biasw = cbw[nn], biasa = cba[nn]; (void)n;
                  float lw[4], c[4];
#pragma unroll
                  for (int r = 0; r < 4; ++r) lw[r] = -0.8750345269f * fsigmoid(biasw + accw[r]);
                  if (d == 0) { c[0] = lw[0]; c[1] = c[0] + lw[1]; c[2] = c[1] + lw[2]; c[3] = c[2] + lw[3]; }
                  else { c[3] = lw[3]; c[2] = c[3] + lw[2]; c[1] = c[2] + lw[1]; c[0] = c[1] + lw[0]; }
                  const float tot = d == 0 ? c[3] : c[0];
                  const float t1 = SHX(tot, 16), t2 = SHX(tot, 32), t3 = SHX(tot, 48);
                  float off = 0.f;
                  { const int q1 = fq ^ 1, q2 = fq ^ 2, q3 = fq ^ 3;
                    off += (d ? q1 > fq : q1 < fq) ? t1 : 0.f; off += (d ? q2 > fq : q2 < fq) ? t2 : 0.f; off += (d ? q3 > fq : q3 < fq) ? t3 : 0.f; }
#pragma unroll
                  for (int r = 0; r < 4; ++r) { const int pos = m0 + 4 * fq + r, tau = d ? 63 - pos : pos;
                      LW[tau * LD32 + nl] = c[r] + off; AL[tau * LD32 + nl] = fsigmoid(biasa + acca[r]); }
                  if (fq == 0) BT[(d ? 3 - mt : mt) * 64 + nl] = (tot + t1) + (t2 + t3); }
              if (d == 0) {
                  bf16x8 ag[5];
#pragma unroll
                  for (int ks = 0; ks < 5; ++ks) ag[ks] = as_frag(cg[ks]);
#pragma unroll
                  for (int nn = 0; nn < 2; ++nn) { const int n = 64 * h + 16 * (np + nn) + fr; f32x4 acc = F4Z;
#pragma unroll
                      for (int ks = 0; ks < 5; ++ks) acc = __builtin_amdgcn_mfma_f32_16x16x32_bf16(ag[ks], Bg[nn][ks], acc, 0, 0, 0);
#pragma unroll
                      for (int r = 0; r < 4; ++r) GATE[(size_t)(R0 + m0 + 4 * fq + r) * DA + n] = (bf16)f2bf(acc[r]); } } }
            LBAR();
            { STG; const LAS float* AL = SLOTF(5); const LAS float* LW = SLOTF(7);
              const int tau = tid >> 3, c8 = (tid & 7) * 8, pos = d ? 63 - tau : tau, row = R0 + pos, blk = wave >> 1;
              f32x2 r[4], k[4];
              { const u32x4 q = cr; r[0] = (f32x2){__uint_as_float(q.x << 16), __uint_as_float(q.x & 0xffff0000u)}; r[1] = (f32x2){__uint_as_float(q.y << 16), __uint_as_float(q.y & 0xffff0000u)};
                r[2] = (f32x2){__uint_as_float(q.z << 16), __uint_as_float(q.z & 0xffff0000u)}; r[3] = (f32x2){__uint_as_float(q.w << 16), __uint_as_float(q.w & 0xffff0000u)}; }
              { const u32x4 q = ck; k[0] = (f32x2){__uint_as_float(q.x << 16), __uint_as_float(q.x & 0xffff0000u)}; k[1] = (f32x2){__uint_as_float(q.y << 16), __uint_as_float(q.y & 0xffff0000u)};
                k[2] = (f32x2){__uint_as_float(q.z << 16), __uint_as_float(q.z & 0xffff0000u)}; k[3] = (f32x2){__uint_as_float(q.w << 16), __uint_as_float(q.w & 0xffff0000u)}; }
              f32x2 offb[4], totC[4];
#pragma unroll
              for (int j = 0; j < 4; ++j) { offb[j] = (f32x2){0.f, 0.f}; totC[j] = (f32x2){0.f, 0.f}; }
#pragma unroll
              for (int b = 0; b < 4; ++b) { const f32x4 x0 = *(const LAS f32x4*)(BT + b * 64 + c8), x1 = *(const LAS f32x4*)(BT + b * 64 + c8 + 4);
                  const f32x2 y[4] = {{x0[0], x0[1]}, {x0[2], x0[3]}, {x1[0], x1[1]}, {x1[2], x1[3]}};
#pragma unroll
                  for (int j = 0; j < 4; ++j) totC[j] += y[j];
                  if (b < blk) {
#pragma unroll
                      for (int j = 0; j < 4; ++j) offb[j] += y[j]; } }
              f32x2 ckk[4], cka[4], crk[4];
              { const f32x4 a0 = *(const LAS f32x4*)(HC + c8), a1 = *(const LAS f32x4*)(HC + c8 + 4), b0 = *(const LAS f32x4*)(HC + 64 + c8), b1 = *(const LAS f32x4*)(HC + 64 + c8 + 4), c0 = *(const LAS f32x4*)(HC + 128 + c8), c1 = *(const LAS f32x4*)(HC + 128 + c8 + 4);
                ckk[0] = (f32x2){a0[0], a0[1]}; ckk[1] = (f32x2){a0[2], a0[3]}; ckk[2] = (f32x2){a1[0], a1[1]}; ckk[3] = (f32x2){a1[2], a1[3]};
                cka[0] = (f32x2){b0[0], b0[1]}; cka[1] = (f32x2){b0[2], b0[3]}; cka[2] = (f32x2){b1[0], b1[1]}; cka[3] = (f32x2){b1[2], b1[3]};
                crk[0] = (f32x2){c0[0], c0[1]}; crk[1] = (f32x2){c0[2], c0[3]}; crk[2] = (f32x2){c1[0], c1[1]}; crk[3] = (f32x2){c1[2], c1[3]}; }
              f32x2 kk[4], s2 = (f32x2){0.f, 0.f};
#pragma unroll
              for (int j = 0; j < 4; ++j) { kk[j] = k[j] * ckk[j]; s2 += kk[j] * kk[j]; }
              float ss = s2.x + s2.y;
              ss += SHX(ss, 1); ss += SHX(ss, 2); ss += SHX(ss, 4);
              const float rn = 1.0f / sqrtf(fmaxf(ss, 1e-24f));
              f32x2 alv[4], csv[4], csm[4];
              { const f32x4 a0 = *(const LAS f32x4*)(AL + tau * LD32 + c8), a1 = *(const LAS f32x4*)(AL + tau * LD32 + c8 + 4), c0 = *(const LAS f32x4*)(LW + tau * LD32 + c8), c1 = *(const LAS f32x4*)(LW + tau * LD32 + c8 + 4);
                const int tm = (tau & 15) ? tau - 1 : tau; f32x4 e0 = *(const LAS f32x4*)(LW + tm * LD32 + c8), e1 = *(const LAS f32x4*)(LW + tm * LD32 + c8 + 4);
                if ((tau & 15) == 0) { e0 = F4Z; e1 = F4Z; }
                alv[0] = (f32x2){a0[0], a0[1]}; alv[1] = (f32x2){a0[2], a0[3]}; alv[2] = (f32x2){a1[0], a1[1]}; alv[3] = (f32x2){a1[2], a1[3]};
                csv[0] = (f32x2){c0[0], c0[1]} + offb[0]; csv[1] = (f32x2){c0[2], c0[3]} + offb[1]; csv[2] = (f32x2){c1[0], c1[1]} + offb[2]; csv[3] = (f32x2){c1[2], c1[3]} + offb[3];
                csm[0] = (f32x2){e0[0], e0[1]} + offb[0]; csm[1] = (f32x2){e0[2], e0[3]} + offb[1]; csm[2] = (f32x2){e1[0], e1[1]} + offb[2]; csm[3] = (f32x2){e1[2], e1[3]} + offb[3]; }
              f32x2 at[4], rt[4], bt[4], kt[4], bh[4], kh[4], bon2 = (f32x2){0.f, 0.f};
#pragma unroll
              for (int j = 0; j < 4; ++j) { const f32x2 al = alv[j], cs = csv[j], dh = totC[j] - cs;
                  const f32x2 kkn = kk[j] * rn, kd = k[j] * ((al - 1.0f) * cka[j] + 1.0f), bb = kkn * al;
                  bon2 += r[j] * kd * crk[j];
                  const f32x2 encs = (f32x2){__builtin_amdgcn_exp2f(-cs.x), __builtin_amdgcn_exp2f(-cs.y)}, eh = (f32x2){__builtin_amdgcn_exp2f(dh.x), __builtin_amdgcn_exp2f(dh.y)};
                  const f32x2 ecm = (f32x2){__builtin_amdgcn_exp2f(csm[j].x), __builtin_amdgcn_exp2f(csm[j].y)}, ecs = (f32x2){__builtin_amdgcn_exp2f(cs.x), __builtin_amdgcn_exp2f(cs.y)};
                  at[j] = -(ecm * kkn); rt[j] = ecs * r[j]; bt[j] = encs * bb; kt[j] = encs * kd; bh[j] = eh * bb; kh[j] = eh * kd; }
              if (tau == 63) {
#pragma unroll
                  for (int j = 0; j < 4; ++j) { gC[c8 + 2 * j] = __builtin_amdgcn_exp2f(totC[j].x); gC[c8 + 2 * j + 1] = __builtin_amdgcn_exp2f(totC[j].y); } }
#define PK8V(a) ((u32x4){pk2(a[0].x, a[0].y), pk2(a[1].x, a[1].y), pk2(a[2].x, a[2].y), pk2(a[3].x, a[3].y)})
              *(LAS u32x4*)(SLOT(0) + tau * LD16 + c8) = PK8V(at); *(LAS u32x4*)(SLOT(1) + tau * LD16 + c8) = PK8V(rt);
              *(LAS u32x4*)(SLOT(2) + tau * LD16 + c8) = PK8V(bt); *(LAS u32x4*)(SLOT(3) + tau * LD16 + c8) = PK8V(kt);
              *(LAS u32x4*)(SLOT(4) + tau * LD16 + c8) = PK8V(bh); *(LAS u32x4*)(SLOT(9) + tau * LD16 + c8) = PK8V(kh);
#undef PK8V
              *(LAS u32x4*)(SLOT(10) + tau * LD16 + c8) = cv;
              float bon = bon2.x + bon2.y;
              bon += SHX(bon, 1); bon += SHX(bon, 2); bon += SHX(bon, 4);
              if ((tid & 7) == 0) BONUS[((size_t)d * M + row) * NH + h] = bon; }
            LBAR();
            }
            { const int nitem = d == 0 ? item : item + G, nd = d ^ 1; if (nitem < (M / 64) * NH) CA_ISSUE(nitem, nd); }
            for (int repB = 0; repB < (PROBE_SUB == 2 ? 2 : 1); ++repB) {
            { STG; bf16x8 aB[2], aA[2], aK[2];
#pragma unroll
              for (int ks = 0; ks < 2; ++ks) { aB[ks] = frag_rm(SLOT(2), m0, ks, fr, fq); aA[ks] = frag_rm(SLOT(0), m0, ks, fr, fq); aK[ks] = frag_rm(SLOT(3), m0, ks, fr, fq); }
#pragma unroll
              for (int nn = 0; nn < 2; ++nn) { const int n0 = 16 * (np + nn), n = n0 + fr; bf16x8 bA[2], bB[2], bK[2], bR[2];
#pragma unroll
                  for (int ks = 0; ks < 2; ++ks) { bA[ks] = frag_rm(SLOT(0), n0, ks, fr, fq); bB[ks] = frag_rm(SLOT(2), n0, ks, fr, fq); bK[ks] = frag_rm(SLOT(3), n0, ks, fr, fq); bR[ks] = frag_rm(SLOT(1), n0, ks, fr, fq); }
                  f32x4 p0 = mm2(aB, bA, F4Z), p1 = mm2(aA, bB, F4Z), p2 = mm2(aA, bK, F4Z), p3 = mm2(aB, bR, F4Z), p4 = mm2(aK, bR, F4Z), t0;
#pragma unroll
                  for (int r = 0; r < 4; ++r) { const int m = m0 + 4 * fq + r;
                      p0[r] = m < n ? p0[r] : 0.f; p1[r] = n < m ? p1[r] : 0.f; p2[r] = n < m ? p2[r] : 0.f; p3[r] = m <= n ? p3[r] : 0.f; p4[r] = m <= n ? p4[r] : 0.f;
                      t0[r] = p1[r] + (m == n ? 1.0f : 0.f); }
                  st_nat(SLOT(5), n0, m0, fr, fq, p0); st_nat(SLOT(6), n0, m0, fr, fq, p1); st_nat(SLOT(7), n0, m0, fr, fq, t0);
                  st_nat(SLOT(8), n0, m0, fr, fq, p2); st_nat(SLOT(11), n0, m0, fr, fq, p3); st_nat(SLOT(12), n0, m0, fr, fq, p4); } }
            LBAR();
#define MM1(a, b, c) __builtin_amdgcn_mfma_f32_16x16x32_bf16(a, b, c, 0, 0, 0)
            { STG; const int b = wave >> 2, bm0 = 32 * b + 16 * ((wave >> 1) & 1), bn0 = 32 * b + 16 * (wave & 1), oc = 32 * (1 - b) - 32 * b;
              const bf16x8 aT = frag_rm(SLOT(5), bm0, b, fr, fq), aR = frag_rm(SLOT(6), bm0, b, fr, fq), bR = frag_rm(SLOT(6), bn0, b, fr, fq), bT = frag_rm(SLOT(5), bn0, b, fr, fq);
              st_nat(SLOT(2), bn0, bm0, fr, fq, MM1(aT, bR, F4Z)); st_nat(SLOT(2), bn0, bm0 + oc, fr, fq, MM1(aR, bT, F4Z)); }
            LBAR();
#pragma unroll
            for (int kq = 1; kq <= 4; ++kq) {
                STG; const int b = wave >> 2, bm0 = 32 * b + 16 * ((wave >> 1) & 1), bn0 = 32 * b + 16 * (wave & 1), oc = 32 * (1 - b) - 32 * b;
                const int pin = (kq & 1) ? 2 : 3, pout = (kq & 1) ? 3 : 2, tin = (kq & 1) ? 7 : 13, tout = (kq & 1) ? 13 : 7;
                const bf16x8 aPT = frag_rm(SLOT(pin), bm0, 1 - b, fr, fq), bTn = frag_rm(SLOT(tin), bn0, b, fr, fq);
                st_nat(SLOT(tout), bn0, bm0, fr, fq, MM1(aPT, bTn, ld4bf(SLOT(tin) + (bn0 + fr) * LD16 + bm0 + 4 * fq)));
                if (kq < 4) { const bf16x8 aPR = frag_rm(SLOT(pin), bm0, b, fr, fq), bPR = frag_rm(SLOT(pin), bn0, b, fr, fq), bPT = frag_rm(SLOT(pin), bn0, 1 - b, fr, fq);
                    st_nat(SLOT(pout), bn0, bm0, fr, fq, MM1(aPT, bPR, F4Z));
                    st_nat(SLOT(pout), bn0, bm0 + oc, fr, fq, MM1(aPR, bPT, F4Z)); }
                LBAR();
            }
            { STG; if (wave < 4) { const int xm0 = 16 * ((wave >> 1) & 1), xn0 = 32 + 16 * (wave & 1);
                  const bf16x8 a = frag_rm(SLOT(6), xm0, 1, fr, fq), bb = frag_tr(SLOT(7), 32, xn0, fr, fq);
                  st_nat(SLOT(13), xn0, xm0, fr, fq, MM1(a, bb, F4Z)); } }
            LBAR();
            { STG; if (wave < 4) { const int tn0 = 32 + 16 * ((wave >> 1) & 1), tm0 = 16 * (wave & 1);
                  const bf16x8 a = frag_rm(SLOT(13), tn0, 0, fr, fq), bb = frag_rm(SLOT(7), tm0, 0, fr, fq);
                  st_nat(SLOT(7), tm0, tn0, fr, fq, MM1(a, bb, F4Z)); } }
            LBAR();
#undef MM1
            { STG; const int xt = wave, n0 = 16 * (xt & 3); bf16x8 b[2];
              if (xt < 4) { b[0] = frag_rm(SLOT(11), n0, 0, fr, fq); b[1] = frag_rm(SLOT(11), n0, 1, fr, fq); }
              else { b[0] = frag_tr(SLOT(4), 0, n0, fr, fq); b[1] = frag_tr(SLOT(4), 32, n0, fr, fq); }
#pragma unroll
              for (int mm = 0; mm < 4; ++mm) { bf16x8 a[2] = {frag_rm(SLOT(7), 16 * mm, 0, fr, fq), frag_rm(SLOT(7), 16 * mm, 1, fr, fq)};
                  st_nat(xt < 4 ? SLOT(5) : SLOT(6), n0, 16 * mm, fr, fq, mm2(a, b, F4Z)); } }
            LBAR();
            }
            for (int repC = 0; repC < (PROBE_SUB == 3 ? 2 : 1); ++repC) {
            { STG; bf16x8 aAt[2] = {frag_tr(SLOT(0), 0, m0, fr, fq), frag_tr(SLOT(0), 32, m0, fr, fq)}, aAk[2] = {frag_rm(SLOT(8), m0, 0, fr, fq), frag_rm(SLOT(8), m0, 1, fr, fq)};
              bf16* pyt = (bf16*)(F.ws + WS_PYT) + qi * 4096; bf16* qyt = (bf16*)(F.ws + WS_QYT) + qi * 4096; bf16* pst = (bf16*)(F.ws + WS_PST) + qi * 4096;
#pragma unroll
              for (int nn = 0; nn < 2; ++nn) { const int n0 = 16 * (np + nn), n = n0 + fr, mb = m0 + 4 * fq;
                  bf16x8 bRb[2] = {frag_rm(SLOT(5), n0, 0, fr, fq), frag_rm(SLOT(5), n0, 1, fr, fq)}, bBh[2] = {frag_rm(SLOT(6), n0, 0, fr, fq), frag_rm(SLOT(6), n0, 1, fr, fq)};
                  const f32x4 py = mm2(aAt, bRb, ld4bf(SLOT(1) + n * LD16 + mb)), qy = mm2(aAk, bRb, ld4bf(SLOT(12) + n * LD16 + mb));
                  f32x4 psi, qsi;
#pragma unroll
                  for (int r = 0; r < 4; ++r) { psi[r] = (mb + r == n) ? gC[n] : 0.f; qsi[r] = bf2f(SLOT(9)[(mb + r) * LD16 + n]); }
                  const f32x4 ps = mm2(aAt, bBh, psi), qs = mm2(aAk, bBh, qsi);
                  *(u32x2*)(pyt + n * 64 + mb) = pk4(py); *(u32x2*)(qyt + n * 64 + mb) = pk4(qy); *(u32x2*)(pst + n * 64 + mb) = pk4(ps);
                  st_nat(SLOT(2), n0, m0, fr, fq, qs); } }
            LBAR();
            { STG; bf16* nct = (bf16*)(F.ws + WS_NCT) + qi * 4096; bf16* vtg = (bf16*)(F.ws + WS_VTG) + qi * 4096;
              bf16x8 a[2] = {frag_rm(SLOT(2), m0, 0, fr, fq), frag_rm(SLOT(2), m0, 1, fr, fq)};
#pragma unroll
              for (int nn = 0; nn < 2; ++nn) { const int n0 = 16 * (np + nn); bf16x8 b[2] = {frag_tr(SLOT(10), 0, n0, fr, fq), frag_tr(SLOT(10), 32, n0, fr, fq)};
                  *(u32x2*)(nct + (n0 + fr) * 64 + m0 + 4 * fq) = pk4(mm2(a, b, F4Z));
                  if (mt == 0) { *(bf16x8*)(vtg + (n0 + fr) * 64 + 8 * fq) = b[0]; *(bf16x8*)(vtg + (n0 + fr) * 64 + 32 + 8 * fq) = b[1]; } } }
            LBAR();
            }
        }
    }
#undef STG
#undef CA_ISSUE
}

__device__ __forceinline__ void p_chunkB(Frame& F, int l) {
    PH_LOCALS(F); PH_LAYER(l);
    const int fr = lane & 15, fq = lane >> 4;
    LAS bf16* Sl = (LAS bf16*)(F.lds + wave * 2304);
    const bf16* PST = (const bf16*)(F.ws + WS_PST); const bf16* NCT = (const bf16*)(F.ws + WS_NCT); bf16* SC = (bf16*)(F.ws + WS_SC);
    for (int t = bx + G * wave; t < 2560; t += G * NWAVES) {
        const bool lat = t < 512; const int tt = lat ? t : t - 512; const int chain = tt >> 2, vb = tt & 3;
        const int b = chain >> 5, h = (chain >> 1) & 15, d = chain & 1;
        const int cb = lat ? 64 + b * 64 : b * 4, NC = lat ? 64 : 4;
        f32x4 S[4];
        if (lat) { const float* src = F.in[I_STATE] + ((((size_t)b * NL + l) * 2 + d) * NH + h) * 4096 + (size_t)(16 * vb + fr) * 64 + 4 * fq;
#pragma unroll
            for (int T = 0; T < 4; ++T) S[T] = *(const f32x4*)(src + 16 * T); }
        else {
#pragma unroll
            for (int T = 0; T < 4; ++T) S[T] = (f32x4){0.f, 0.f, 0.f, 0.f}; }
        bf16x8 Apf[4][8]; u32x2 Npf[4][4];
#define CB_QI(step) ((((size_t)(cb + (d ? NC - 1 - (step) : (step)))) * 16 + h) * 2 + d)
#define CB_LOAD(u, step) do { const size_t q_ = CB_QI(step); const bf16* ps_ = PST + q_ * 4096 + fr * 64 + 8 * fq; const bf16* nc_ = NCT + q_ * 4096 + (16 * vb + fr) * 64 + 4 * fq; \
        _Pragma("unroll") for (int mt_ = 0; mt_ < 4; ++mt_) { Apf[u][2 * mt_] = *(const bf16x8*)(ps_ + mt_ * 1024); Apf[u][2 * mt_ + 1] = *(const bf16x8*)(ps_ + mt_ * 1024 + 32); Npf[u][mt_] = *(const u32x2*)(nc_ + 16 * mt_); } } while (0)
        CB_LOAD(0, 0); CB_LOAD(1, 1); CB_LOAD(2, 2); CB_LOAD(3, 3);
#define CB_GROUP(g) do { _Pragma("unroll") for (int u = 0; u < 4; ++u) { \
                const int step = (g) + u; const size_t q = CB_QI(step); \
                bf16* scg = SC + q * 4096 + (16 * vb + fr) * 64 + 4 * fq; \
                asm volatile("" ::: "memory"); \
                _Pragma("unroll") for (int T = 0; T < 4; ++T) { const u32x2 w = pk4(S[T]); *(LAS u32x2*)(Sl + fr * LD16 + 16 * T + 4 * fq) = w; *(u32x2*)(scg + 16 * T) = w; } \
                asm volatile("s_waitcnt lgkmcnt(0)" ::: "memory"); \
                const bf16x8 b0 = *(const LAS bf16x8*)(Sl + fr * LD16 + 8 * fq), b1 = *(const LAS bf16x8*)(Sl + fr * LD16 + 8 * fq + 32); \
                _Pragma("unroll") for (int mt = 0; mt < 4; ++mt) { const u32x2 nw = Npf[u][mt]; \
                    f32x4 acc = (f32x4){__uint_as_float(nw.x << 16), __uint_as_float(nw.x & 0xffff0000u), __uint_as_float(nw.y << 16), __uint_as_float(nw.y & 0xffff0000u)}; \
                    acc = __builtin_amdgcn_mfma_f32_16x16x32_bf16(Apf[u][2 * mt], b0, acc, 0, 0, 0); \
                    acc = __builtin_amdgcn_mfma_f32_16x16x32_bf16(Apf[u][2 * mt + 1], b1, acc, 0, 0, 0); \
                    S[mt] = acc; } \
                asm volatile("s_waitcnt lgkmcnt(0)" ::: "memory"); \
                { const int ns_ = step + 4 < NC ? step + 4 : NC - 1; CB_LOAD(u, ns_); } } } while (0)
        for (int g = 0; g < NC; g += 4) CB_GROUP(g);
#undef CB_GROUP
#undef CB_LOAD
#undef CB_QI
        if (!lat) { float* dst = F.out + (size_t)M * D + ((((size_t)b * NL + l) * 2 + d) * NH + h) * 4096 + (size_t)(16 * vb + fr) * 64 + 4 * fq;
#pragma unroll
            for (int T = 0; T < 4; ++T) *(f32x4*)(dst + 16 * T) = S[T]; }
    }
}

__device__ __forceinline__ void p_chunkC(Frame& F, int l) {
    PH_LOCALS(F); PH_LAYER(l);
    LAS unsigned char* lds = F.lds;
    const int fr = lane & 15, fq = lane >> 4, d = wave >> 2, nb = wave & 3;
    const bf16* PS = (const bf16*)(F.ws + WS_PS); const bf16* GATE = (const bf16*)(F.ws + WS_GATE); const float* BONUS = (const float*)(F.ws + WS_BONUS);
    bf16* O = (bf16*)(F.ws + WS_O);
    constexpr int NIT = (M / 64) * NH;
    f32x4 gnw[4], gnb[4]; int hcur = -1;
    bf16x8 fa0[4][4], fb0[4]; u32x4 pv0, pg0; float pb00, pb01;
#define CC_ISSUE(item_, fa, fb, pv, pg, pb0, pb1) do { const int ci_ = (item_) >> 4, h_ = (item_) & 15; const size_t qi_ = ((size_t)ci_ * 16 + h_) * 2 + d; \
        const bf16* sc_ = (const bf16*)(F.ws + WS_SC) + qi_ * 4096 + fr * 64 + 8 * fq; const bf16* vt_ = (const bf16*)(F.ws + WS_VTG) + qi_ * 4096 + fr * 64 + 8 * fq; \
        const bf16* py_ = (const bf16*)(F.ws + WS_PYT) + qi_ * 4096 + (16 * nb + fr) * 64 + 8 * fq; const bf16* qy_ = (const bf16*)(F.ws + WS_QYT) + qi_ * 4096 + (16 * nb + fr) * 64 + 8 * fq; \
        fb[0] = *(const bf16x8*)py_; fb[1] = *(const bf16x8*)(py_ + 32); fb[2] = *(const bf16x8*)qy_; fb[3] = *(const bf16x8*)(qy_ + 32); \
        _Pragma("unroll") for (int vt4_ = 0; vt4_ < 4; ++vt4_) { fa[vt4_][0] = *(const bf16x8*)(sc_ + vt4_ * 1024); fa[vt4_][1] = *(const bf16x8*)(sc_ + vt4_ * 1024 + 32); fa[vt4_][2] = *(const bf16x8*)(vt_ + vt4_ * 1024); fa[vt4_][3] = *(const bf16x8*)(vt_ + vt4_ * 1024 + 32); } \
        const int row_ = ci_ * 64 + (tid >> 3), chn_ = 64 * h_ + (tid & 7) * 8; \
        pv = *(const u32x4*)(PS + (size_t)row_ * CSH + 2 * DA + chn_); pg = *(const u32x4*)(GATE + (size_t)row_ * DA + chn_); pb0 = BONUS[(size_t)row_ * NH + h_]; pb1 = BONUS[((size_t)M + row_) * NH + h_]; } while (0)
#define CC_BODY(item_, fa, fb, pv, pg, pb0, pb1, next_) do { const int ci = (item_) >> 4, h = (item_) & 15, R0 = ci * 64; \
        if (h != hcur) { hcur = h; _Pragma("unroll") for (int vtile = 0; vtile < 4; ++vtile) { gnw[vtile] = *(const f32x4*)(F.in[I_GNW] + (size_t)l * DA + 64 * h + 16 * vtile + 4 * fq); gnb[vtile] = *(const f32x4*)(F.in[I_GNB] + (size_t)l * DA + 64 * h + 16 * vtile + 4 * fq); } } \
        f32x4 acc[4]; float s = 0.f; \
        _Pragma("unroll") for (int vtile = 0; vtile < 4; ++vtile) { f32x4 a = F4Z; \
            _Pragma("unroll") for (int ks = 0; ks < 4; ++ks) a = __builtin_amdgcn_mfma_f32_16x16x32_bf16(fa[vtile][ks], fb[ks], a, 0, 0, 0); \
            acc[vtile] = a; s += (a[0] + a[1]) + (a[2] + a[3]); } \
        const u32x4 cv = pv, cgt = pg; const float bon = pb0 + pb1; \
        if ((next_) < NIT) CC_ISSUE((next_), fa, fb, pv, pg, pb0, pb1); \
        s += SHX(s, 16); s += SHX(s, 32); \
        const float mean = s * (1.0f / 64.0f); float qv = 0.f; \
        _Pragma("unroll") for (int vtile = 0; vtile < 4; ++vtile) { acc[vtile] = acc[vtile] - mean; const f32x4 a = acc[vtile]; qv += (a[0] * a[0] + a[1] * a[1]) + (a[2] * a[2] + a[3] * a[3]); } \
        qv += SHX(qv, 16); qv += SHX(qv, 32); \
        const float rstd = 1.0f / sqrtf(qv * (1.0f / 64.0f) + GN_EPS); \
        const int tau = 16 * nb + fr, pos = d ? 63 - tau : tau; \
        LAS float* Yd = (LAS float*)(lds + d * 17408); \
        _Pragma("unroll") for (int vtile = 0; vtile < 4; ++vtile) { const int v0 = 16 * vtile + 4 * fq; \
            *(LAS f32x4*)(Yd + pos * LD32 + v0) = acc[vtile] * rstd * gnw[vtile] + gnb[vtile]; } \
        LBAR(); \
        { const int pos2 = tid >> 3, c8 = (tid & 7) * 8, row = R0 + pos2, chn = 64 * h + c8; \
          const LAS float* Y0 = (const LAS float*)lds; const LAS float* Y1 = (const LAS float*)(lds + 17408); \
          float v[8], gt[8], o[8]; unpack8(cv, v); unpack8(cgt, gt); \
          const f32x4 y00 = *(const LAS f32x4*)(Y0 + pos2 * LD32 + c8), y01 = *(const LAS f32x4*)(Y0 + pos2 * LD32 + c8 + 4), y10 = *(const LAS f32x4*)(Y1 + pos2 * LD32 + c8), y11 = *(const LAS f32x4*)(Y1 + pos2 * LD32 + c8 + 4); \
          _Pragma("unroll") for (int j = 0; j < 4; ++j) { o[j] = (y00[j] + y10[j] + bon * v[j]) * gt[j]; o[4 + j] = (y01[j] + y11[j] + bon * v[4 + j]) * gt[4 + j]; } \
          *(u32x4*)(O + (size_t)row * D + chn) = pack8(o); } \
        LBAR(); } while (0)
    if (bx < NIT) CC_ISSUE(bx, fa0, fb0, pv0, pg0, pb00, pb01);
    for (int item = bx; item < NIT; item += G) {
        CC_BODY(item, fa0, fb0, pv0, pg0, pb00, pb01, item + G);
    }
#undef CC_BODY
#undef CC_ISSUE
}

__device__ __forceinline__ void p_final(Frame& F) {
    PH_LOCALS(F);
    const int gw = bx * NWAVES + wave, NGW = G * NWAVES;
    const float* fg = F.in[I_FNG];
    for (int row = gw; row < M; row += NGW) {
        float* xr = F.out + (size_t)row * D;
        f32x4 v[8]; float ss = 0.f;
#pragma unroll
        for (int j = 0; j < 8; ++j) { v[j] = *(const f32x4*)(xr + 4 * lane + 256 * j); ss += (v[j].x * v[j].x + v[j].y * v[j].y) + (v[j].z * v[j].z + v[j].w * v[j].w); }
        WAVE_SUM(ss); const float rstd = 1.0f / sqrtf(ss * (1.0f / D) + RMS_EPS);
#pragma unroll
        for (int j = 0; j < 8; ++j) { const int c = 4 * lane + 256 * j; *(f32x4*)(xr + c) = v[j] * rstd * *(const f32x4*)(fg + c); }
    }
}

constexpr int PH_PER_LAYER = 10, N_PHASES = 2 + NL * PH_PER_LAYER;
__global__ void __launch_bounds__(NWAVES * 64, 2) hymba_fwd(Args args) {
    extern __shared__ __attribute__((aligned(16))) unsigned char lds[];
    Frame F;
    F.lds = (LAS unsigned char*)lds;
    F.tid = threadIdx.x; F.lane = F.tid & 63; F.wave = __builtin_amdgcn_readfirstlane(F.tid >> 6);
    F.G = gridDim.x; F.bx = blockIdx.x;
    F.in = args.in; F.out = args.out; F.ws = args.ws;
    for (int u = F.tid; u < (LDS_BYTES - LDSCTL_OFF) / 4; u += NWAVES * 64) ((LAS unsigned*)(F.lds + LDSCTL_OFF))[u] = 0u;
    __syncthreads();
    volatile LAS unsigned* MISC = (volatile LAS unsigned*)(F.lds + MISC_OFF);
    unsigned* barw = (unsigned*)(F.ws + WS_CTL) + CW_BAR;
    XcdBarrier bar; bar.bar = barw; bar.x = 0; bar.st = nullptr;
    if (MK_N_LAUNCHES == 1) bar = xcd_barrier_post(barw, MISC + 8);
    const int lo = args.ph_lo, hi = args.ph_hi;
#define IN(k) (lo <= (k) && (k) < hi)
#define SEAM(k) do { if (MK_N_LAUNCHES == 1 && IN(k) && IN((k) + 1)) xcd_barrier(bar); } while (0)

    for (int rep = 0; rep < ((PROBE_DUP == 30) ? 2 : 1); ++rep)
    if (IN(0)) { p0_prologue(F); __syncthreads(); } SEAM(0);
    bf16* H = (bf16*)(F.ws + WS_H); bf16* O = (bf16*)(F.ws + WS_O); bf16* P = (bf16*)(F.ws + WS_P); bf16* HID = (bf16*)(F.ws + WS_HID);
    const float* mod = (const float*)(F.ws + WS_MOD);
    for (int l = 0; l < NL; ++l) {
        const int pb = 1 + l * PH_PER_LAYER;
        const float* xlo = l == 0 ? F.in[I_XP] : F.out; const float* xhi = l == 0 ? F.in[I_XS] : F.out + (size_t)MCTX * D;
        float* dummy = (float*)(F.ws + WS_P);
        for (int rep = 0; rep < ((PROBE_DUP == 7) ? 2 : 1); ++rep)
        if (IN(pb + 0)) { p_adaln(F, l, 0, xlo, xhi); } SEAM(pb + 0);
        for (int rep = 0; rep < ((PROBE_DUP == 1 || PROBE_DUP == 20) ? 2 : 1); ++rep)
        if (IN(pb + 1)) { pg8::Gemm g{H, (const bf16*)(F.ws + WS_WIN + l * SZ_WIN), M, PINP, D}; pg8::StaticOrder S; { int cb_ = F.bx, cg_ = F.G; asm volatile("" : "+s"(cb_), "+s"(cg_)); S.init(M, PINP, cg_, cb_, D); }
            EpiP E{P, PINP, CSH}; pg8::gemm_phase<EpiP, pg8::StaticOrder, true, true>(F.lds, g, S, E, F.wave); } SEAM(pb + 1);
        for (int rep = 0; rep < ((PROBE_DUP == 2) ? 2 : 1); ++rep)
        if (IN(pb + 2)) { p_shift(F, l); } SEAM(pb + 2);
        if (IN(pb + 3)) { for (int rep = 0; rep < ((PROBE_DUP == 3) ? 2 : 1); ++rep) p_chunkA(F, l); for (int rep = 0; rep < ((PROBE_DUP == 13) ? 2 : 1); ++rep) p_gmlp(F, l); } SEAM(pb + 3);
        for (int rep = 0; rep < ((PROBE_DUP == 4) ? 2 : 1); ++rep)
        if (IN(pb + 4)) { p_chunkB(F, l); } SEAM(pb + 4);
        for (int rep = 0; rep < ((PROBE_DUP == 5) ? 2 : 1); ++rep)
        if (IN(pb + 5)) { p_chunkC(F, l); } SEAM(pb + 5);
        if ((PROBE_DUP == 6 || PROBE_DUP == 20) && IN(pb + 6)) { pg8::Gemm g{O, (const bf16*)(F.ws + WS_WOUT + l * SZ_WOUT), M, D, D}; pg8::StaticOrder S; { int cb_ = F.bx, cg_ = F.G; asm volatile("" : "+s"(cb_), "+s"(cg_)); S.init(M, D, cg_, cb_, D); }
            EpiRes E{xlo, xhi, dummy, mod + (size_t)l * 5 * MODW, 2 * D, D / 64, nullptr, nullptr}; pg8::gemm_phase<EpiRes, pg8::StaticOrder, true, true>(F.lds, g, S, E, F.wave); }
        if (IN(pb + 6)) { pg8::Gemm g{O, (const bf16*)(F.ws + WS_WOUT + l * SZ_WOUT), M, D, D}; pg8::StaticOrder S; { int cb_ = F.bx, cg_ = F.G; asm volatile("" : "+s"(cb_), "+s"(cg_)); S.init(M, D, cg_, cb_, D); }
            EpiRes E{xlo, xhi, F.out, mod + (size_t)l * 5 * MODW, 2 * D, D / 64, nullptr, nullptr}; pg8::gemm_phase<EpiRes, pg8::StaticOrder, true, true>(F.lds, g, S, E, F.wave); } SEAM(pb + 6);
        for (int rep = 0; rep < ((PROBE_DUP == 7) ? 2 : 1); ++rep)
        if (IN(pb + 7)) { p_adaln(F, l, 1, F.out, F.out + (size_t)MCTX * D); } SEAM(pb + 7);
        for (int rep = 0; rep < ((PROBE_DUP == 8 || PROBE_DUP == 20) ? 2 : 1); ++rep)
        if (IN(pb + 8)) { pg8::Gemm g{H, (const bf16*)(F.ws + WS_WGU + l * SZ_WGU), M, NGU, D}; pg8::StaticOrder S; { int cb_ = F.bx, cg_ = F.G; asm volatile("" : "+s"(cb_), "+s"(cg_)); S.init(M, NGU, cg_, cb_, D); }
            EpiSwi E{HID, DFF}; pg8::gemm_phase<EpiSwi, pg8::StaticOrder, true, true>(F.lds, g, S, E, F.wave); } SEAM(pb + 8);
        if ((PROBE_DUP == 9 || PROBE_DUP == 20) && IN(pb + 9)) { pg8::Gemm g{HID, (const bf16*)(F.ws + WS_WD + l * SZ_WD), M, D, DFF}; pg8::StaticOrder S; { int cb_ = F.bx, cg_ = F.G; asm volatile("" : "+s"(cb_), "+s"(cg_)); S.init(M, D, cg_, cb_, DFF); }
            EpiRes E{F.out, F.out + (size_t)MCTX * D, dummy, mod + (size_t)l * 5 * MODW, 5 * D, DFF / 64, nullptr, nullptr}; pg8::gemm_phase<EpiRes, pg8::StaticOrder, true, true>(F.lds, g, S, E, F.wave); }
        if (IN(pb + 9)) { pg8::Gemm g{HID, (const bf16*)(F.ws + WS_WD + l * SZ_WD), M, D, DFF}; pg8::StaticOrder S; { int cb_ = F.bx, cg_ = F.G; asm volatile("" : "+s"(cb_), "+s"(cg_)); S.init(M, D, cg_, cb_, DFF); }
            EpiRes E{F.out, F.out + (size_t)MCTX * D, F.out, mod + (size_t)l * 5 * MODW, 5 * D, DFF / 64, (float*)(F.ws + WS_P), (unsigned*)(F.ws + WS_CTL) + CW_SPLIT + (size_t)l * 640 * 64}; pg8::gemm_phase<EpiRes, pg8::StaticOrder, true, true>(F.lds, g, S, E, F.wave); } SEAM(pb + 9);
    }
    if (IN(N_PHASES - 1)) { p_final(F); }
#undef IN
#undef SEAM
}

extern "C" void kernel_launch(void* const* d_in, const int* in_sizes, int n_in, void* d_out, int out_size, void* d_ws, size_t ws_size, hipStream_t stream) {
    static int grid = 0;
    if (grid == 0) {
        if (n_in != 30 || ws_size < WS_END) { fprintf(stderr, "kernel_launch: need 30 inputs and >= %zu bytes of workspace; got n_in %d, ws %zu\n", (size_t)WS_END, n_in, ws_size); grid = -1; return; }
        int dev = 0, cus = 0, per_cu = 0;
        if (hipGetDevice(&dev) != hipSuccess || hipDeviceGetAttribute(&cus, hipDeviceAttributeMultiprocessorCount, dev) != hipSuccess) { grid = -1; return; }
        if (hipFuncSetAttribute((const void*)hymba_fwd, hipFuncAttributeMaxDynamicSharedMemorySize, LDS_BYTES) != hipSuccess) { fprintf(stderr, "kernel_launch: hipFuncSetAttribute failed\n"); grid = -1; return; }
        if (hipOccupancyMaxActiveBlocksPerMultiprocessor(&per_cu, (const void*)hymba_fwd, NWAVES * 64, LDS_BYTES) != hipSuccess || per_cu < 1)
            fprintf(stderr, "kernel_launch: note: occupancy query reports %d workgroups per CU\n", per_cu);
        (void)hipGetLastError();
        grid = cus;
    }
    if (grid < 0) return;
    if (hipMemsetAsync((char*)d_ws + WS_CTL, 0, CTL_ZERO_BYTES, stream) != hipSuccess) return;
    Args a{};
    for (int i = 0; i < 30; ++i) a.in[i] = (const float*)d_in[i];
    a.out = (float*)d_out; a.ws = (unsigned char*)d_ws; a.pad = 0;
    if (MK_N_LAUNCHES == 1) {
        a.ph_lo = 0; a.ph_hi = N_PHASES; a.li = 0;
        hipLaunchKernelGGL(hymba_fwd, dim3(grid), dim3(NWAVES * 64), LDS_BYTES, stream, a);
    } else {
        for (int k = 0; k < N_PHASES; ++k) { a.ph_lo = k; a.ph_hi = k + 1; a.li = k;
            hipLaunchKernelGGL(hymba_fwd, dim3(grid), dim3(NWAVES * 64), LDS_BYTES, stream, a); }
    }
}
```

```cpp
#include <hip/hip_runtime.h>
#include <cstdio>
#include <cstdint>

#ifndef PROBE_DUP
#define PROBE_DUP -1
#endif
#ifndef PROBE_SUB
#define PROBE_SUB 0
#endif
#ifndef MK_N_LAUNCHES
#define MK_N_LAUNCHES 1
#endif

namespace pg8 {
#define PG8_LAS __attribute__((address_space(3)))
typedef unsigned short bf16_t;
typedef short bf16x8 __attribute__((ext_vector_type(8)));
typedef float f32x4 __attribute__((ext_vector_type(4)));
typedef unsigned u32x4 __attribute__((ext_vector_type(4)));
constexpr int BM = 256, BK = 64, HALF = 128, HTB = HALF * BK * 2  , STAGE_BYTES = 8 * HTB, NXCD = 8, WGM = 8;

__host__ __device__ __forceinline__ int lds_byte(int r, int c) { const int st = (r >> 4) * 2 + (c >> 5), rr = r & 15, cc = c & 31, ob = rr * 64 + cc * 2; return st * 1024 + (ob ^ (((ob >> 9) & 1) << 5)); }
__host__ __device__ __forceinline__ void stage_rc(int b, int& R, int& C) { const int st = b / 1024, sb = b % 1024, swz = sb ^ (((sb >> 9) & 1) << 5); R = (st >> 1) * 16 + swz / 64; C = (st & 1) * 32 + (swz % 64) / 2; }
__host__ __device__ __forceinline__ int perm32(int rho) { const int n = rho >> 4, i = rho & 15; return 8 * (i >> 2) + 4 * n + (i & 3); }

struct Unit { int pm, pn, k0, nk; };
struct Gemm { const bf16_t* A; const bf16_t* Bt; int M, N, K; };

struct StaticOrder {
    int nM, nN, nwg, G, c, nkt, full, rem;
    __host__ __device__ void init(int M, int N, int G_, int c_, int K_) { nM = M / BM; nN = N / BM; nwg = nM * nN; G = G_; c = c_; nkt = K_ / BK; full = nwg / G; rem = nwg - full * G; }
    __host__ __device__ bool next(int i, Unit& u) const {
        const long L = (long)i * G + c; if (L >= nwg) return false;
        int wgid = (int)L; { const int q = nwg / NXCD, r = nwg % NXCD, xcd = wgid % NXCD, off = wgid / NXCD; wgid = (xcd < r ? xcd * (q + 1) : r * (q + 1) + (xcd - r) * q) + off; }
        const int nig = WGM * nN, gid = wgid / nig, fm = gid * WGM, gsz = (nM - fm) < WGM ? (nM - fm) : WGM;
        u.pm = fm + ((wgid % nig) % gsz); u.pn = (wgid % nig) / gsz; u.k0 = 0; u.nk = nkt;
#if defined(__HIP_DEVICE_COMPILE__)
        u.pm = __builtin_amdgcn_readfirstlane(u.pm); u.pn = __builtin_amdgcn_readfirstlane(u.pn);
#endif
        return true;
    }
    __device__ __forceinline__ void a_ready(const Unit&) const {}
    __device__ __forceinline__ void done(const Unit&) const {}
};
struct SplitTailOrder : StaticOrder {
    __host__ __device__ bool next(int i, Unit& u) const {
        if (i < full || 2 * rem > G || (nkt & 3)) return StaticOrder::next(i, u);
        if (i > full || c >= 2 * rem) return false;
        StaticOrder t = *this; t.c = c >> 1; if (!t.StaticOrder::next(full, u)) return false;
        u.nk = nkt / 2; u.k0 = (c & 1) * u.nk; return true;
    }
};

__device__ __forceinline__ unsigned cvt_pk_bf16(float lo, float hi) { unsigned r; asm volatile("v_cvt_pk_bf16_f32 %0, %1, %2" : "=v"(r) : "v"(lo), "v"(hi)); return r; }

template <class Epi, class Sched, bool ALIGN_EPI = false, bool SP2 = false>
__device__ __forceinline__ void gemm_phase(PG8_LAS unsigned char* lds, const Gemm g, const Sched& S, const Epi& E, int wid) {
    asm volatile("" : "+s"(wid)); int lane; asm volatile("v_mbcnt_lo_u32_b32 %0, -1, 0\n\tv_mbcnt_hi_u32_b32 %0, -1, %0" : "=v"(lane));
    const int tid = wid * 64 + lane, wr = wid >> 2, wc = wid & 3, fr = lane & 15, fq = lane >> 4;
    const int K = g.K;
    unsigned voffA[2], voffB[2];
#pragma unroll
    for (int i = 0; i < 2; ++i) { int R, C; stage_rc(tid * 16 + i * 8192, R, C); const int Rb = Epi::PERM ? ((R & ~31) + perm32(R & 31)) : R;
        voffA[i] = (unsigned)(R * K + C) * 2u; voffB[i] = (unsigned)(Rb * K + C) * 2u; }
    const size_t kstep = (size_t)(BK * 2);
    const size_t hstep = (size_t)HALF * K * 2;
    const size_t tstep = 2 * hstep;
    const unsigned ldsw = (unsigned)wid * 1024u;
    const int aoff = lds_byte(wr * 64 + fr, fq * 8), boff = lds_byte(wc * 32 + fr, fq * 8);
#define PG8_SA(b, h) (((b) * 2 + (h)) * HTB)
#define PG8_SB(b, h) ((4 + (b) * 2 + (h)) * HTB)
#define PG8_STAGE(bufoff, gbase, voff) do { _Pragma("unroll") for (int _i = 0; _i < 2; ++_i) \
        __builtin_amdgcn_global_load_lds((const unsigned*)((const char*)(gbase) + (voff)[_i]), (PG8_LAS unsigned*)(lds + (bufoff) + ldsw + _i * 8192), 16, 0, 0); } while (0)
#define PG8_LDA(dst, b, h) do { _Pragma("unroll") for (int m = 0; m < 4; ++m) _Pragma("unroll") for (int k = 0; k < 2; ++k) dst[m][k] = *(const PG8_LAS bf16x8*)(lds + PG8_SA(b, h) + aoff + m * 2048 + k * 1024); } while (0)
#define PG8_LDB(dst, b, h) do { _Pragma("unroll") for (int n = 0; n < 2; ++n) _Pragma("unroll") for (int k = 0; k < 2; ++k) dst[n][k] = *(const PG8_LAS bf16x8*)(lds + PG8_SB(b, h) + boff + n * 2048 + k * 1024); } while (0)
#define PG8_MMA(ai, bj, At, Bt) do { __builtin_amdgcn_s_setprio(1); _Pragma("unroll") for (int m = 0; m < 4; ++m) _Pragma("unroll") for (int n = 0; n < 2; ++n) _Pragma("unroll") for (int k = 0; k < 2; ++k) \
        acc[ai][bj][m][n] = __builtin_amdgcn_mfma_f32_16x16x32_bf16(Bt[n][k], At[m][k], acc[ai][bj][m][n], 0, 0, 0); __builtin_amdgcn_s_setprio(0); } while (0)
#define PG8_WAIT_V(n) asm volatile("s_waitcnt vmcnt(" #n ")" ::: "memory")
#define PG8_WAIT_L(n) asm volatile("s_waitcnt lgkmcnt(" #n ")" ::: "memory")
#define PG8_BAR __builtin_amdgcn_s_barrier()
#define PG8_SCHED __builtin_amdgcn_sched_barrier(0)
    Unit cur, nxt; int ui = 0;
    if (!S.next(0, cur)) return;
    f32x4 acc[2][2][4][2];
#pragma unroll
    for (int a = 0; a < 2; ++a)
#pragma unroll
        for (int b = 0; b < 2; ++b)
#pragma unroll
            for (int m = 0; m < 4; ++m)
#pragma unroll
                for (int n = 0; n < 2; ++n) acc[a][b][m][n] = (f32x4){0.f, 0.f, 0.f, 0.f};
    bf16x8 At[4][2], B0[2][2], B1[2][2];
    const char* cA = (const char*)g.A + (size_t)cur.pm * tstep + (size_t)cur.k0 * kstep; const char* cB = (const char*)g.Bt + (size_t)cur.pn * tstep + (size_t)cur.k0 * kstep;
    S.a_ready(cur);
    if constexpr (SP2) {
        PG8_STAGE(PG8_SB(0, 0), cB, voffB); PG8_STAGE(PG8_SB(0, 1), cB + hstep, voffB); PG8_STAGE(PG8_SA(0, 0), cA, voffA); PG8_STAGE(PG8_SA(0, 1), cA + hstep, voffA);
        if (wr == 1) PG8_BAR;
        PG8_WAIT_V(2); PG8_BAR;
        PG8_STAGE(PG8_SB(1, 0), cB + kstep, voffB); PG8_STAGE(PG8_SA(1, 0), cA + kstep, voffA); PG8_STAGE(PG8_SB(1, 1), cB + hstep + kstep, voffB);
        PG8_WAIT_V(6); PG8_BAR;
    } else {
        PG8_STAGE(PG8_SB(0, 0), cB, voffB); PG8_STAGE(PG8_SA(0, 0), cA, voffA); PG8_STAGE(PG8_SB(0, 1), cB + hstep, voffB); PG8_STAGE(PG8_SA(0, 1), cA + hstep, voffA);
        if (wr == 1) PG8_BAR;
        PG8_WAIT_V(4); PG8_BAR;
        PG8_STAGE(PG8_SB(1, 0), cB + kstep, voffB); PG8_STAGE(PG8_SA(1, 0), cA + kstep, voffA); PG8_STAGE(PG8_SB(1, 1), cB + hstep + kstep, voffB);
        PG8_WAIT_V(6); PG8_BAR;
    }
    for (;;) {
        const bool has_next = S.next(ui + 1, nxt);
        const char* nA = has_next ? (const char*)g.A + (size_t)nxt.pm * tstep + (size_t)nxt.k0 * kstep : cA; const char* nB = has_next ? (const char*)g.Bt + (size_t)nxt.pn * tstep + (size_t)nxt.k0 * kstep : cB;
        const int nt = cur.nk;
        for (int t = 0; t < nt; t += 2) {
            const bool last = (t == nt - 2);
            const char* a1 = cA + (size_t)(t + 1) * kstep;
            const char* a2 = last ? nA : cA + (size_t)(t + 2) * kstep; const char* b2 = last ? nB : cB + (size_t)(t + 2) * kstep;
            const char* a3 = a2 + kstep; const char* b3 = b2 + kstep;
            if (last && has_next) S.a_ready(nxt);
            if constexpr (SP2) {
            PG8_LDB(B0, 0, 0); PG8_LDB(B1, 0, 1); PG8_SCHED; PG8_LDA(At, 0, 0); PG8_STAGE(PG8_SA(1, 1), a1 + hstep, voffA);
            PG8_WAIT_V(8); PG8_WAIT_L(0); PG8_BAR; PG8_MMA(0, 0, At, B0); PG8_MMA(0, 1, At, B1); PG8_BAR; PG8_SCHED;
            PG8_LDA(At, 0, 1); PG8_STAGE(PG8_SB(0, 0), b2, voffB); PG8_STAGE(PG8_SB(0, 1), b2 + hstep, voffB); PG8_STAGE(PG8_SA(0, 0), a2, voffA);
            PG8_WAIT_V(8); PG8_WAIT_L(0); PG8_BAR; PG8_MMA(1, 0, At, B0); PG8_MMA(1, 1, At, B1); PG8_BAR; PG8_SCHED;
            PG8_LDB(B0, 1, 0); PG8_LDB(B1, 1, 1); PG8_SCHED; PG8_LDA(At, 1, 0); PG8_STAGE(PG8_SA(0, 1), a2 + hstep, voffA);
            PG8_WAIT_V(8); PG8_WAIT_L(0); PG8_BAR; PG8_MMA(0, 0, At, B0); PG8_MMA(0, 1, At, B1); PG8_BAR; PG8_SCHED;
            PG8_LDA(At, 1, 1); PG8_STAGE(PG8_SB(1, 0), b3, voffB); PG8_STAGE(PG8_SB(1, 1), b3 + hstep, voffB); PG8_STAGE(PG8_SA(1, 0), a3, voffA);
            PG8_WAIT_V(8); PG8_WAIT_L(0); PG8_BAR; PG8_MMA(1, 0, At, B0); PG8_MMA(1, 1, At, B1); PG8_BAR; PG8_SCHED;
            } else {
            PG8_LDB(B0, 0, 0); PG8_SCHED; PG8_LDA(At, 0, 0); PG8_STAGE(PG8_SA(1, 1), a1 + hstep, voffA);
            PG8_WAIT_L(8); PG8_BAR; PG8_WAIT_L(0); PG8_MMA(0, 0, At, B0); PG8_BAR; PG8_SCHED;
            PG8_LDB(B1, 0, 1); PG8_STAGE(PG8_SB(0, 0), b2, voffB);
            PG8_BAR; PG8_WAIT_L(0); PG8_MMA(0, 1, At, B1); PG8_BAR;
            PG8_LDA(At, 0, 1); PG8_STAGE(PG8_SA(0, 0), a2, voffA);
            PG8_BAR; PG8_WAIT_L(0); PG8_MMA(1, 0, At, B0); PG8_BAR; PG8_SCHED;
            PG8_STAGE(PG8_SB(0, 1), b2 + hstep, voffB);
            PG8_WAIT_V(6); PG8_BAR; PG8_MMA(1, 1, At, B1); PG8_BAR;
            PG8_LDB(B0, 1, 0); PG8_SCHED; PG8_LDA(At, 1, 0); PG8_STAGE(PG8_SA(0, 1), a2 + hstep, voffA);
            PG8_WAIT_L(8); PG8_BAR; PG8_WAIT_L(0); PG8_MMA(0, 0, At, B0); PG8_BAR; PG8_SCHED;
            PG8_LDB(B1, 1, 1); PG8_STAGE(PG8_SB(1, 0), b3, voffB);
            PG8_BAR; PG8_WAIT_L(0); PG8_MMA(0, 1, At, B1); PG8_BAR;
            PG8_LDA(At, 1, 1); PG8_STAGE(PG8_SA(1, 0), a3, voffA);
            PG8_BAR; PG8_WAIT_L(0); PG8_MMA(1, 0, At, B0); PG8_BAR; PG8_SCHED;
            PG8_STAGE(PG8_SB(1, 1), b3 + hstep, voffB);
            PG8_WAIT_V(6); PG8_BAR; PG8_MMA(1, 1, At, B1); PG8_BAR;
            }
        }
        if constexpr (ALIGN_EPI) { if (wr == 0) PG8_BAR; }
        E(acc, cur, wr, wc, fr, fq); S.done(cur);
        if (!has_next) break;
#pragma unroll
        for (int a = 0; a < 2; ++a)
#pragma unroll
            for (int b = 0; b < 2; ++b)
#pragma unroll
                for (int m = 0; m < 4; ++m)
#pragma unroll
                    for (int n = 0; n < 2; ++n) acc[a][b][m][n] = (f32x4){0.f, 0.f, 0.f, 0.f};
        cur = nxt; cA = nA; cB = nB; ++ui;
        if constexpr (ALIGN_EPI) { if (wr == 1) PG8_BAR; }
    }
    PG8_WAIT_V(0);
    if constexpr (!ALIGN_EPI) { if (wr == 0) PG8_BAR; }
    PG8_BAR;
#undef PG8_SA
#undef PG8_SB
#undef PG8_STAGE
#undef PG8_LDA
#undef PG8_LDB
#undef PG8_MMA
#undef PG8_WAIT_V
#undef PG8_WAIT_L
#undef PG8_BAR
#undef PG8_SCHED
}
}

constexpr int NWAVES = 8;
constexpr int D = 2048, MCTX = 4096, MLAT = 16384, M = MCTX + MLAT, NL = 4;
constexpr int DA = 1024, NH = 16, DB = 1024, NG = 8, HB = 128;
constexpr int LW = 64, LAA = 64, LGT = 160;
constexpr int CSH = 3 * DA + LW + LAA + LGT;
constexpr int PIN = CSH + 2 * DB;
constexpr int PINP = 5632;
constexpr int DFF = 5632, NGU = 2 * DFF;
constexpr int MODW = 6 * D;
constexpr float RMS_EPS = 1e-6f, GN_EPS = 64.0f * 1e-5f, LN_EPS = 1e-5f;

constexpr size_t MiB = 1u << 20;
constexpr size_t WS_CTL = 0, CTL_ZERO_BYTES = 1 * MiB;
constexpr size_t WS_MOD = 1 * MiB;
constexpr size_t WS_W2T = 2 * MiB;
constexpr size_t WS_A2T = 3 * MiB;
constexpr size_t WS_G2T = 4 * MiB;
constexpr size_t WS_WSP = 6 * MiB;
constexpr size_t WS_BONUS = 7 * MiB;
constexpr size_t SZ_WIN = (size_t)PINP * D * 2, SZ_WOUT = (size_t)D * D * 2, SZ_WGU = (size_t)NGU * D * 2, SZ_WD = (size_t)D * DFF * 2;
constexpr size_t WS_WIN = 16 * MiB;
constexpr size_t WS_WOUT = WS_WIN + NL * SZ_WIN;
constexpr size_t WS_WGU = WS_WOUT + NL * SZ_WOUT;
constexpr size_t WS_WD = WS_WGU + NL * SZ_WGU;
constexpr size_t WS_H = WS_WD + NL * SZ_WD;
constexpr size_t WS_O = WS_H + (size_t)M * D * 2;
constexpr size_t WS_P = WS_O + (size_t)M * D * 2;
constexpr size_t WS_PS = WS_P + (size_t)M * PINP * 2;
constexpr size_t SZ_T16 = (size_t)M * DA * 2;
constexpr size_t WS_GATE = WS_PS + (size_t)M * CSH * 2;
constexpr size_t SZ_CH = (size_t)(M / 64) * NH * 2 * 8192;
constexpr size_t WS_PST = WS_GATE + SZ_T16;
constexpr size_t WS_NCT = WS_PST + SZ_CH;
constexpr size_t WS_PYT = WS_NCT + SZ_CH;
constexpr size_t WS_QYT = WS_PYT + SZ_CH;
constexpr size_t WS_VTG = WS_QYT + SZ_CH;
constexpr size_t WS_SC = WS_VTG + SZ_CH;
constexpr size_t WS_LORA = WS_SC + SZ_CH;
constexpr size_t WS_END1 = WS_LORA + (size_t)M * 288 * 2;
constexpr size_t WS_HID = WS_GATE;
constexpr size_t WS_END = WS_END1 > WS_HID + (size_t)M * DFF * 2 ? WS_END1 : WS_HID + (size_t)M * DFF * 2;
constexpr int CW_BAR = 4096;
constexpr int CW_SPLIT = 16384;
static_assert((CW_SPLIT + NL * 640 * 64) * 4 <= (int)CTL_ZERO_BYTES, "control words inside the memset region");

constexpr int RING_BYTES = 131072;
constexpr int LDSCTL_OFF = 15 * 9216, MISC_OFF = LDSCTL_OFF + 320;
constexpr int LDS_BYTES = 147456;

#define GAS __attribute__((address_space(1)))
#define LAS __attribute__((address_space(3)))
typedef unsigned short bf16;
typedef float f32x4 __attribute__((ext_vector_type(4)));
typedef float f32x2 __attribute__((ext_vector_type(2)));
typedef short bf16x8 __attribute__((ext_vector_type(8)));
typedef unsigned u32x4 __attribute__((ext_vector_type(4)));
typedef unsigned u32x2 __attribute__((ext_vector_type(2)));
#define LDS_WAIT() asm volatile("s_waitcnt lgkmcnt(0)" ::: "memory")
#define VM_WAIT() asm volatile("s_waitcnt vmcnt(0)" ::: "memory")
__device__ __forceinline__ unsigned f2bf(float f) { unsigned u = __builtin_bit_cast(unsigned, f); return (u + 0x7fffu + ((u >> 16) & 1u)) >> 16; }
typedef __bf16 bf16x2_t __attribute__((ext_vector_type(2)));
__device__ __forceinline__ unsigned pk2(float lo, float hi) { return __builtin_bit_cast(unsigned, __builtin_convertvector((f32x2){lo, hi}, bf16x2_t)); }
__device__ __forceinline__ float bf2f(unsigned short b) { return __uint_as_float(((unsigned)b) << 16); }
__device__ __forceinline__ void unpack8(const u32x4 q, float (&f)[8]) {
    f[0] = __uint_as_float(q.x << 16); f[1] = __uint_as_float(q.x & 0xffff0000u); f[2] = __uint_as_float(q.y << 16); f[3] = __uint_as_float(q.y & 0xffff0000u);
    f[4] = __uint_as_float(q.z << 16); f[5] = __uint_as_float(q.z & 0xffff0000u); f[6] = __uint_as_float(q.w << 16); f[7] = __uint_as_float(q.w & 0xffff0000u); }
__device__ __forceinline__ u32x4 pack8(const float (&f)[8]) { u32x4 o; o.x = pk2(f[0], f[1]); o.y = pk2(f[2], f[3]); o.z = pk2(f[4], f[5]); o.w = pk2(f[6], f[7]); return o; }
__device__ __forceinline__ float fsigmoid(float x) { return __builtin_amdgcn_rcpf(1.0f + __expf(-x)); }
__device__ __forceinline__ float ftanh(float x) { return 1.0f - 2.0f * __builtin_amdgcn_rcpf(1.0f + __expf(2.0f * x)); }
__device__ __forceinline__ float gelu_tanh(float x) { const float u = 1.5957691216057308f * (x + 0.044715f * x * x * x); return x * __builtin_amdgcn_rcpf(1.0f + __expf(-u)); }
__device__ __forceinline__ int hw_lane() { int l; asm volatile("v_mbcnt_lo_u32_b32 %0, -1, 0\n\tv_mbcnt_hi_u32_b32 %0, -1, %0" : "=v"(l)); return l; }
#define SHX(v, X) __int_as_float(__builtin_amdgcn_ds_bpermute((lane ^ (X)) << 2, __float_as_int(v)))
#define WAVE_SUM(v) do { v += SHX(v, 1); v += SHX(v, 2); v += SHX(v, 4); v += SHX(v, 8); v += SHX(v, 16); v += SHX(v, 32); } while (0)

#define PH_LOCALS(F) int wave = (F).wave; asm volatile("" : "+s"(wave)); const int lane = hw_lane(); const int tid = wave * 64 + lane; \
    int bx = (F).bx, G = (F).G; asm volatile("" : "+s"(bx), "+s"(G)); (void)lane; (void)tid;
#define PH_LAYER(l) asm volatile("" : "+s"(l))

#define XB_TMO      128
#define XB_XCNT(j)  (256  + 64 * (j))
#define XB_XSUB(j)  (1280 + 64 * (j))
#define XB_XGEN(j)  (2304 + 64 * (j))
#define XB_TOP      3328
#define XB_TOPGEN   3392
#define XCD_BAR_WORDS 3456
#define XB_SPIN_CAP (1u << 18)

__device__ __forceinline__ unsigned xb_ld(unsigned* p)              { return __hip_atomic_load(p, __ATOMIC_RELAXED, __HIP_MEMORY_SCOPE_AGENT); }
__device__ __forceinline__ unsigned xb_add(unsigned* p, unsigned v) { return __hip_atomic_fetch_add(p, v, __ATOMIC_RELAXED, __HIP_MEMORY_SCOPE_AGENT); }
__device__ __forceinline__ unsigned xb_xcc_id() { return (unsigned)__builtin_amdgcn_s_getreg((3 << 11) | 20) & 0xFu; }
#define XB_SPIN(cond, bar) do { unsigned _sp = 0; while (cond) { __builtin_amdgcn_s_sleep(1); \
    if ((++_sp & 255u) == 0u) { if (xb_ld(&(bar)[XB_TMO])) break; if (_sp > XB_SPIN_CAP) { atomicAdd(&(bar)[XB_TMO], 1u); break; } } } } while (0)

struct XcdBarrier {
    unsigned* bar; unsigned x;
    volatile LAS unsigned* st;
};
__device__ __forceinline__ XcdBarrier xcd_barrier_post(unsigned* bar, volatile LAS unsigned* st) {
    XcdBarrier b; b.bar = bar; b.x = xb_xcc_id(); b.st = st;
    if (threadIdx.x == 0) (void)xb_add(&bar[XB_XCNT(b.x)], 1u);
    return b;
}
__device__ __forceinline__ void xcd_barrier_complete(unsigned* bar, unsigned x, unsigned& nloc, unsigned& nx) {
    const unsigned G = gridDim.x * gridDim.y * gridDim.z;
    unsigned sum, cnt, mine, sp = 0u;
    for (;;) {
        sum = 0u; cnt = 0u; mine = 0u;
#pragma unroll
        for (unsigned j = 0; j < 16; ++j) { const unsigned c = xb_ld(&bar[XB_XCNT(j)]); sum += c; cnt += (c > 0u) ? 1u : 0u; mine = (j == x) ? c : mine; }
        if (sum == G) break;
        __builtin_amdgcn_s_sleep(1);
        if ((++sp & 255u) == 0u) { if (xb_ld(&bar[XB_TMO])) break; if (sp > XB_SPIN_CAP) { atomicAdd(&bar[XB_TMO], 1u); break; } }
    }
    nloc = mine > 0u ? mine : 1u; nx = cnt > 0u ? cnt : 1u;
}
__device__ __forceinline__ void xcd_barrier(const XcdBarrier& b) {
    asm volatile("s_waitcnt vmcnt(0)" ::: "memory");
    __syncthreads();
    if (threadIdx.x == 0) {
        unsigned* bar = b.bar;
        __builtin_amdgcn_s_waitcnt(0);
        unsigned nloc = b.st[0], nx = b.st[1];
        if (nloc == 0u) { xcd_barrier_complete(bar, b.x, nloc, nx); b.st[0] = nloc; b.st[1] = nx; }
        const unsigned old = xb_add(&bar[XB_XSUB(b.x)], 1u);
        const unsigned gen = old / nloc;
        if (old + 1u == (gen + 1u) * nloc) {
            __builtin_amdgcn_fence(__ATOMIC_RELEASE, "agent");
            asm volatile("s_waitcnt vmcnt(0)" ::: "memory");
            const unsigned og = xb_add(&bar[XB_TOP], 1u);
            const unsigned tg = og / nx;
            if (og + 1u == (tg + 1u) * nx) xb_add(&bar[XB_TOPGEN], 1u);
            else XB_SPIN(xb_ld(&bar[XB_TOPGEN]) == tg, bar);
            __builtin_amdgcn_fence(__ATOMIC_ACQUIRE, "agent");
            xb_add(&bar[XB_XGEN(b.x)], 1u);
            asm volatile("s_waitcnt vmcnt(0)" ::: "memory");
        } else {
            XB_SPIN(xb_ld(&bar[XB_XGEN(b.x)]) == gen, bar);
            __builtin_amdgcn_fence(__ATOMIC_ACQUIRE, "agent");
            asm volatile("s_waitcnt vmcnt(0)" ::: "memory");
        }
    }
    __syncthreads();
}

struct Args {
    const float* in[30];
    float* out; unsigned char* ws;
    int ph_lo, ph_hi, li, pad;
};
enum { I_XP = 0, I_XS, I_STATE, I_C, I_CCTX, I_WMOD, I_BMOD, I_N1G, I_WIN, I_MU, I_W0, I_W2, I_A0, I_A2, I_G2, I_KK, I_KA, I_RK, I_GNW, I_GNB, I_LNG, I_LNB, I_WSP, I_BSP, I_WOUT, I_N2G, I_WG, I_WU, I_WD, I_FNG };

struct Frame {
    LAS unsigned char* lds;
    int tid, lane, wave, G, bx;
    const float* const* in;
    float* out; unsigned char* ws;
};

struct EpiP {
    static constexpr bool PERM = true, AFTER_DRAIN = false;
    bf16* O; int ldc; int gelu_from;
    __device__ __forceinline__ void operator()(const f32x4 (&acc)[2][2][4][2], const pg8::Unit& u, int wr, int wc, int fr, int fq) const {
        const int row0 = u.pm * 256 + wr * 64 + fr, col0 = u.pn * 256 + wc * 32 + 8 * fq;
#pragma unroll
        for (int ai = 0; ai < 2; ++ai)
#pragma unroll
            for (int m = 0; m < 4; ++m) { bf16* rowp = O + (size_t)(row0 + ai * 128 + m * 16) * ldc + col0;
#pragma unroll
                for (int bj = 0; bj < 2; ++bj) { f32x4 v0 = acc[ai][bj][m][0], v1 = acc[ai][bj][m][1];
                    if (col0 + bj * 128 >= gelu_from) {
#pragma unroll
                        for (int j = 0; j < 4; ++j) { v0[j] = gelu_tanh(v0[j]); v1[j] = gelu_tanh(v1[j]); } }
                    u32x4 w; w.x = pg8::cvt_pk_bf16(v0[0], v0[1]); w.y = pg8::cvt_pk_bf16(v0[2], v0[3]); w.z = pg8::cvt_pk_bf16(v1[0], v1[1]); w.w = pg8::cvt_pk_bf16(v1[2], v1[3]);
                    *(u32x4*)(rowp + bj * 128) = w; } }
    }
};
struct EpiRes {
    static constexpr bool PERM = false, AFTER_DRAIN = false;
    const float* xlo; const float* xhi; float* xout; const float* modl; int goff, nk_full; float* parts; unsigned* cnts;
    __device__ __forceinline__ void operator()(const f32x4 (&acc)[2][2][4][2], const pg8::Unit& u, int wr, int wc, int fr, int fq) const {
        const int pm = u.pm; const int midx = pm < 16 ? 0 : 1 + ((pm - 16) >> 4); const int role = u.nk == nk_full ? 0 : (u.k0 == 0 ? 1 : 2);
        float* part = parts + (size_t)pm * 256 * D;
        unsigned* cnt = cnts + (size_t)(pm * 8 + u.pn) * 64;
        if (role == 1) {
            const unsigned long long t0 = __builtin_amdgcn_s_memrealtime();
            while ((unsigned)__builtin_amdgcn_readfirstlane(__hip_atomic_load(cnt, __ATOMIC_RELAXED, __HIP_MEMORY_SCOPE_AGENT)) < 8u) { if (__builtin_amdgcn_s_memrealtime() - t0 > 2000000ull) break; __builtin_amdgcn_s_sleep(2); }
            __builtin_amdgcn_fence(__ATOMIC_ACQUIRE, "agent"); asm volatile("s_waitcnt vmcnt(0)" ::: "memory"); }
        const float* gv = modl + (size_t)midx * MODW + goff;
        const float* base = pm < 16 ? xlo + (size_t)pm * 256 * D : xhi + (size_t)(pm - 16) * 256 * D;
        float* ob = xout + (size_t)pm * 256 * D;
        const int col0 = u.pn * 256 + wc * 32 + 4 * fq;
        f32x4 gvv[2][2];
#pragma unroll
        for (int bj = 0; bj < 2; ++bj)
#pragma unroll
            for (int n = 0; n < 2; ++n) gvv[bj][n] = *(const f32x4*)(gv + col0 + bj * 128 + n * 16);
#pragma unroll
        for (int ai = 0; ai < 2; ++ai)
#pragma unroll
            for (int m = 0; m < 4; ++m) { const size_t off = (size_t)(ai * 128 + wr * 64 + m * 16 + fr) * D + col0;
#pragma unroll
                for (int bj = 0; bj < 2; ++bj)
#pragma unroll
                    for (int n = 0; n < 2; ++n) { const size_t o = off + bj * 128 + n * 16;
                        if (role == 2) {
                            const f32x4 a = gvv[bj][n] * acc[ai][bj][m][n]; unsigned long long* q = (unsigned long long*)(part + o);
                            __hip_atomic_store(q, ((unsigned long long)__float_as_uint(a[1]) << 32) | __float_as_uint(a[0]), __ATOMIC_RELAXED, __HIP_MEMORY_SCOPE_AGENT);
                            __hip_atomic_store(q + 1, ((unsigned long long)__float_as_uint(a[3]) << 32) | __float_as_uint(a[2]), __ATOMIC_RELAXED, __HIP_MEMORY_SCOPE_AGENT); }
                        else { f32x4 xo = *(const f32x4*)(base + o);
                            if (role == 1) xo += *(const f32x4*)(part + o);
                            *(f32x4*)(ob + o) = xo + gvv[bj][n] * acc[ai][bj][m][n]; } }
                if (m & 1) asm volatile("" ::: "memory"); }
        if (role == 2) { asm volatile("s_waitcnt vmcnt(0)" ::: "memory"); if (fr == 0 && fq == 0) __hip_atomic_fetch_add(cnt, 1u, __ATOMIC_RELAXED, __HIP_MEMORY_SCOPE_AGENT); }
    }
};
struct EpiSwi {
    static constexpr bool PERM = true, AFTER_DRAIN = false;
    bf16* O; int ldc;
    __device__ __forceinline__ void operator()(const f32x4 (&acc)[2][2][4][2], const pg8::Unit& u, int wr, int wc, int fr, int fq) const {
        const int row0 = u.pm * 256 + wr * 64 + fr, col0 = u.pn * 128 + wc * 32 + 8 * fq;
#pragma unroll
        for (int ai = 0; ai < 2; ++ai)
#pragma unroll
            for (int m = 0; m < 4; ++m) { bf16* rowp = O + (size_t)(row0 + ai * 128 + m * 16) * ldc + col0;
                float h[8];
#pragma unroll
                for (int n = 0; n < 2; ++n)
#pragma unroll
                    for (int j = 0; j < 4; ++j) { const float gt = acc[ai][0][m][n][j], up = acc[ai][1][m][n][j]; h[n * 4 + j] = gt * fsigmoid(gt) * up; }
                u32x4 w; w.x = pg8::cvt_pk_bf16(h[0], h[1]); w.y = pg8::cvt_pk_bf16(h[2], h[3]); w.z = pg8::cvt_pk_bf16(h[4], h[5]); w.w = pg8::cvt_pk_bf16(h[6], h[7]);
                *(u32x4*)rowp = w; }
    }
};

template <int MAP>
__device__ __forceinline__ void tr_item(const float* W, int K, int N, bf16* WT, LAS float* scr, int item, int lane) {
    const int nblk = N / 32, kb = item / nblk, nb = item % nblk, k0 = 64 * kb, n0 = 32 * nb;
#pragma unroll 8
    for (int i = 0; i < 32; ++i) { const int kk = 2 * i + (lane >> 5); scr[kk * 33 + (lane & 31)] = W[(size_t)(k0 + kk) * N + n0 + (lane & 31)]; }
    LDS_WAIT(); asm volatile("" ::: "memory");
    const int c = lane & 7;
#pragma unroll
    for (int j = 0; j < 4; ++j) { const int n = (lane >> 3) + 8 * j; const LAS float* s = scr + (8 * c) * 33 + n;
        u32x4 o; o.x = pk2(s[0 * 33], s[1 * 33]); o.y = pk2(s[2 * 33], s[3 * 33]); o.z = pk2(s[4 * 33], s[5 * 33]); o.w = pk2(s[6 * 33], s[7 * 33]);
        const int nn = n0 + n; const int orow = MAP == 0 ? nn : (256 * (nn >> 7) + (nn & 127) + (MAP == 2 ? 128 : 0));
        *(u32x4*)(WT + (size_t)orow * K + k0 + 8 * c) = o; }
    LDS_WAIT(); asm volatile("" ::: "memory");
}
__device__ __forceinline__ void p0_prologue(Frame& F) {
    PH_LOCALS(F);
    LAS float* scr = (LAS float*)(F.lds + wave * 16384);
    const int gw = bx * NWAVES + wave, NGW = G * NWAVES;
    constexpr int I_IN = (D / 64) * (PIN / 32), I_OUT = (D / 64) * (D / 32), I_GU = (D / 64) * (DFF / 32), I_DN = (DFF / 64) * (D / 32);
    constexpr int PL = I_IN + I_OUT + 2 * I_GU + I_DN;
    for (int it = gw; it < NL * PL; it += NGW) {
        const int l = it / PL; int r = it % PL;
        if (r < I_IN) { tr_item<0>(F.in[I_WIN] + (size_t)l * D * PIN, D, PIN, (bf16*)(F.ws + WS_WIN + l * SZ_WIN), scr, r, lane); continue; } r -= I_IN;
        if (r < I_OUT) { tr_item<0>(F.in[I_WOUT] + (size_t)l * D * D, D, D, (bf16*)(F.ws + WS_WOUT + l * SZ_WOUT), scr, r, lane); continue; } r -= I_OUT;
        if (r < I_GU) { tr_item<1>(F.in[I_WG] + (size_t)l * D * DFF, D, DFF, (bf16*)(F.ws + WS_WGU + l * SZ_WGU), scr, r, lane); continue; } r -= I_GU;
        if (r < I_GU) { tr_item<2>(F.in[I_WU] + (size_t)l * D * DFF, D, DFF, (bf16*)(F.ws + WS_WGU + l * SZ_WGU), scr, r, lane); continue; } r -= I_GU;
        tr_item<0>(F.in[I_WD] + (size_t)l * DFF * D, DFF, D, (bf16*)(F.ws + WS_WD + l * SZ_WD), scr, r, lane);
    }
    const int gt = bx * 512 + tid, NGT = G * 512;
    { constexpr int PADV = (PINP - PIN) * D * 2 / 16;
      for (int i = gt; i < NL * PADV; i += NGT) { const int l = i / PADV, r = i % PADV; ((u32x4*)(F.ws + WS_WIN + l * SZ_WIN + (size_t)PIN * D * 2))[r] = (u32x4){0u, 0u, 0u, 0u}; } }
    { bf16* w2t = (bf16*)(F.ws + WS_W2T); bf16* a2t = (bf16*)(F.ws + WS_A2T); bf16* g2t = (bf16*)(F.ws + WS_G2T); bf16* wsp = (bf16*)(F.ws + WS_WSP);
      for (int i = gt; i < NL * 2 * 1024 * 64; i += NGT) { const int k = i & 63, n = (i >> 6) & 1023, ld = i >> 16;
          w2t[i] = (bf16)f2bf(F.in[I_W2][((size_t)ld * 64 + k) * 1024 + n]); a2t[i] = (bf16)f2bf(F.in[I_A2][((size_t)ld * 64 + k) * 1024 + n]); }
      for (int i = gt; i < NL * 1024 * 160; i += NGT) { const int k = i % 160, n = (i / 160) & 1023, l = i / (160 * 1024);
          g2t[i] = (bf16)f2bf(F.in[I_G2][((size_t)l * 160 + k) * 1024 + n]); }
      for (int i = gt; i < NL * 8 * 128 * 128; i += NGT) wsp[i] = (bf16)f2bf(F.in[I_WSP][i]); }
    __syncthreads();
    { LAS float* sv = (LAS float*)F.lds;
      LAS float* red = (LAS float*)(F.lds + 40960);
      for (int i = tid; i < 5 * D; i += 512) { const int r = i / D, k = i % D; const float c = r == 0 ? F.in[I_CCTX][k] : F.in[I_C][(r - 1) * D + k]; sv[i] = c * fsigmoid(c); }
      __syncthreads();
      float* mod = (float*)(F.ws + WS_MOD);
      const int c4 = tid & 15, kg = tid >> 4;
      for (int item = bx; item < NL * (MODW / 64); item += G) {
          const int l = item / (MODW / 64), n0 = (item % (MODW / 64)) * 64;
          const float* W = F.in[I_WMOD] + (size_t)l * D * MODW + n0 + 4 * c4;
          f32x4 a[5];
#pragma unroll
          for (int r = 0; r < 5; ++r) a[r] = (f32x4){0.f, 0.f, 0.f, 0.f};
#pragma unroll 4
          for (int i = 0; i < 64; ++i) { const int k = i * 32 + kg; const f32x4 w = *(const f32x4*)(W + (size_t)k * MODW);
#pragma unroll
              for (int r = 0; r < 5; ++r) a[r] += w * sv[r * D + k]; }
#pragma unroll
          for (int r = 0; r < 5; ++r) *(LAS f32x4*)(red + (kg * 5 + r) * 64 + 4 * c4) = a[r];
          __syncthreads();
          if (tid < 320) { const int r = tid >> 6, n = tid & 63; float s = 0.f;
#pragma unroll 8
              for (int g = 0; g < 32; ++g) s += red[(g * 5 + r) * 64 + n];
              mod[((size_t)l * 5 + r) * MODW + n0 + n] = s + F.in[I_BMOD][(size_t)l * MODW + n0 + n]; }
          __syncthreads();
      } }
}

__device__ __forceinline__ void p_adaln(Frame& F, int l, int which, const float* xlo, const float* xhi) {
    PH_LOCALS(F); PH_LAYER(l);
    const int gw = bx * NWAVES + wave, NGW = G * NWAVES;
    const float* ng = (which == 0 ? F.in[I_N1G] : F.in[I_N2G]) + (size_t)l * D;
    const int shoff = which == 0 ? 0 : 3 * D, scoff = shoff + D;
    const float* mod = (const float*)(F.ws + WS_MOD);
    bf16* H = (bf16*)(F.ws + WS_H);
    for (int row = gw; row < M; row += NGW) {
        const float* xr = row < MCTX ? xlo + (size_t)row * D : xhi + (size_t)(row - MCTX) * D;
        const int midx = row < MCTX ? 0 : 1 + ((row - MCTX) >> 12);
        const float* md = mod + ((size_t)l * 5 + midx) * MODW;
        f32x4 v[8]; float ss = 0.f;
#pragma unroll
        for (int j = 0; j < 8; ++j) { v[j] = *(const f32x4*)(xr + 4 * lane + 256 * j); ss += (v[j].x * v[j].x + v[j].y * v[j].y) + (v[j].z * v[j].z + v[j].w * v[j].w); }
        WAVE_SUM(ss); const float rstd = 1.0f / sqrtf(ss * (1.0f / D) + RMS_EPS);
#pragma unroll
        for (int j = 0; j < 8; ++j) { const int c = 4 * lane + 256 * j;
            const f32x4 g4 = *(const f32x4*)(ng + c), sc = *(const f32x4*)(md + scoff + c), sh = *(const f32x4*)(md + shoff + c);
            const f32x4 o = v[j] * rstd * g4 * (sc + 1.0f) + sh;
            u32x2 w; w.x = pk2(o.x, o.y); w.y = pk2(o.z, o.w);
            *(u32x2*)(H + (size_t)row * D + c) = w; }
    }
}

__device__ __forceinline__ void load_shifted8(const bf16* P, const float* mu, int row, int col, float (&o)[8]) {
    float g[8]; unpack8(*(const u32x4*)(P + (size_t)row * PINP + col), g);
    float a[8];
#pragma unroll
    for (int j = 0; j < 8; ++j) a[j] = g[j];
    int nrow[4]; bool has[4]; int nn;
    if (row < MCTX) { const int t = row & 255; nn = 2; nrow[0] = row - 1; has[0] = t > 0; nrow[1] = row + 1; has[1] = t < 255; nrow[2] = row; has[2] = false; nrow[3] = row; has[3] = false; }
    else { const int t = (row - MCTX) & 4095, gc = t & 63, gr = t >> 6; nn = 4;
        nrow[0] = row - 1; has[0] = gc > 0; nrow[1] = row + 1; has[1] = gc < 63; nrow[2] = row - 64; has[2] = gr > 0; nrow[3] = row + 64; has[3] = gr < 63; }
#pragma unroll
    for (int q = 0; q < 4; ++q) {
        if (q < nn) {
            float nb[8];
            if (has[q]) unpack8(*(const u32x4*)(P + (size_t)nrow[q] * PINP + col), nb);
            else {
#pragma unroll
                for (int j = 0; j < 8; ++j) nb[j] = 0.f; }
            const f32x4 m0 = *(const f32x4*)(mu + q * CSH + col), m1 = *(const f32x4*)(mu + q * CSH + col + 4);
#pragma unroll
            for (int j = 0; j < 4; ++j) { a[j] += m0[j] * (nb[j] - g[j]); a[4 + j] += m1[j] * (nb[4 + j] - g[4 + j]); }
        }
    }
#pragma unroll
    for (int j = 0; j < 8; ++j) o[j] = a[j];
}
__device__ __forceinline__ void p_shift(Frame& F, int l) {
    PH_LOCALS(F); PH_LAYER(l);
    const bf16* P = (const bf16*)(F.ws + WS_P); bf16* PS = (bf16*)(F.ws + WS_PS); bf16* LORA = (bf16*)(F.ws + WS_LORA);
    const float* mu = F.in[I_MU] + (size_t)l * 4 * CSH;
    constexpr int CG = CSH / 8;
    const int rpw = (M + G - 1) / G, rbeg = bx * rpw, rend = (rbeg + rpw < M) ? rbeg + rpw : M;
    if (tid < CG) {
        const int col = tid * 8; const int act = (col >= 3 * DA && col < 3 * DA + LW) ? 1 : (col >= 3 * DA + LW + LAA ? 2 : 0);
        f32x4 m[4][2];
#pragma unroll
        for (int q = 0; q < 4; ++q) { m[q][0] = *(const f32x4*)(mu + q * CSH + col); m[q][1] = *(const f32x4*)(mu + q * CSH + col + 4); }
        for (int r0 = rbeg; r0 < rend; r0 += 4) {
#pragma unroll
            for (int u = 0; u < 4; ++u) { const int row = r0 + u; if (row < rend) {
                const bf16* pc = P + (size_t)row * PINP + col;
                int nrow[4]; bool has[4]; int nn;
                if (row < MCTX) { const int t = row & 255; nn = 2; nrow[0] = -1; has[0] = t > 0; nrow[1] = 1; has[1] = t < 255; nrow[2] = 0; has[2] = false; nrow[3] = 0; has[3] = false; }
                else { const int t = (row - MCTX) & 4095, gc = t & 63, gr = t >> 6; nn = 4; nrow[0] = -1; has[0] = gc > 0; nrow[1] = 1; has[1] = gc < 63; nrow[2] = -64; has[2] = gr > 0; nrow[3] = 64; has[3] = gr < 63; }
                u32x4 raw[5]; raw[0] = *(const u32x4*)pc;
#pragma unroll
                for (int q = 0; q < 4; ++q) raw[1 + q] = (q < nn && has[q]) ? *(const u32x4*)(pc + (ptrdiff_t)nrow[q] * PINP) : (u32x4){0u, 0u, 0u, 0u};
                float g[8], a[8]; unpack8(raw[0], g);
#pragma unroll
                for (int jx = 0; jx < 8; ++jx) a[jx] = g[jx];
#pragma unroll
                for (int q = 0; q < 4; ++q) if (q < nn) { float nb[8]; unpack8(raw[1 + q], nb);
#pragma unroll
                    for (int jx = 0; jx < 4; ++jx) { a[jx] += m[q][0][jx] * (nb[jx] - g[jx]); a[4 + jx] += m[q][1][jx] * (nb[4 + jx] - g[4 + jx]); } }
                if (act == 1) {
#pragma unroll
                    for (int jx = 0; jx < 8; ++jx) a[jx] = ftanh(a[jx]); }
                else if (act == 2) {
#pragma unroll
                    for (int jx = 0; jx < 8; ++jx) a[jx] = fsigmoid(a[jx]); }
                if (col >= 3 * DA) { const int cgl = (col - 3 * DA) >> 3;
                    *(u32x4*)(LORA + ((((size_t)(row >> 4) * 9 + (cgl >> 2)) * 64 + 16 * (cgl & 3) + (row & 15)) << 3)) = pack8(a); }
                else *(u32x4*)(PS + (size_t)row * CSH + col) = pack8(a); } }
        }
    }
}

#define F4Z ((f32x4){0.f, 0.f, 0.f, 0.f})
__device__ __forceinline__ u32x2 pk4(const f32x4 a) { u32x2 w; w.x = pk2(a[0], a[1]); w.y = pk2(a[2], a[3]); return w; }
#define LBAR() do { asm volatile("s_waitcnt lgkmcnt(0)" ::: "memory"); __builtin_amdgcn_s_barrier(); asm volatile("" ::: "memory"); } while (0)
constexpr int VTS = 136;
typedef short s16x4g __attribute__((ext_vector_type(4)));
__device__ __forceinline__ bf16x8 frag_tr_ld(const LAS bf16* X, int ld, int kbase, int c0, int fr, int fq) {
    const LAS bf16* p = X + (kbase + 8 * fq + (fr >> 2)) * ld + c0 + 4 * (fr & 3);
    const s16x4g lo = __builtin_amdgcn_ds_read_tr16_b64_v4i16((LAS s16x4g*)p);
    const s16x4g hi = __builtin_amdgcn_ds_read_tr16_b64_v4i16((LAS s16x4g*)(p + 4 * ld));
    return (bf16x8){lo[0], lo[1], lo[2], lo[3], hi[0], hi[1], hi[2], hi[3]};
}
__device__ __forceinline__ void p_gmlp(Frame& F, int l) {
    PH_LOCALS(F); PH_LAYER(l);
    const bf16* P = (const bf16*)(F.ws + WS_P); bf16* O = (bf16*)(F.ws + WS_O);
    const bf16* wsp = (const bf16*)(F.ws + WS_WSP) + (size_t)l * 8 * 128 * 128;
    LAS bf16* VN = (LAS bf16*)F.lds;
    LAS bf16* ST = (LAS bf16*)(F.lds + 34816);
    const int fr = lane & 15, fq = lane >> 4;
    constexpr int NIT = (M / 128) * NG;
    const int jrow = tid >> 2, q4 = tid & 3;
    u32x4 pvv[4];
#define GM_ISSUE(item_) do { const bf16* src_ = P + (size_t)(((item_) >> 3) * 128 + jrow) * PINP + CSH + DB + 128 * ((item_) & 7) + 32 * q4; \
        _Pragma("unroll") for (int i_ = 0; i_ < 4; ++i_) pvv[i_] = *(const u32x4*)(src_ + 8 * i_); } while (0)
    if (bx < NIT) GM_ISSUE(bx);
    for (int item = bx; item < NIT; item += G) {
        const int cb = item >> 3, g = item & 7, R0 = cb * 128;
        u32x4 pu[4]; { const bf16* up = P + (size_t)(R0 + jrow) * PINP + CSH + 128 * g + 32 * q4;
#pragma unroll
            for (int i = 0; i < 4; ++i) pu[i] = *(const u32x4*)(up + 8 * i); }
        bf16x8 bw[4]; { const bf16* wa = wsp + ((size_t)g * 128 + 16 * wave + fr) * 128 + 8 * fq;
#pragma unroll
            for (int ks = 0; ks < 4; ++ks) bw[ks] = *(const bf16x8*)(wa + 32 * ks); }
        const float bsp = F.in[I_BSP][((size_t)l * 8 + g) * 128 + jrow];
        { float v[32];
#pragma unroll
          for (int i = 0; i < 4; ++i) { float f[8]; unpack8(pvv[i], f);
#pragma unroll
              for (int jj = 0; jj < 8; ++jj) v[8 * i + jj] = f[jj]; }
          float s = 0.f;
#pragma unroll
          for (int i = 0; i < 32; ++i) s += v[i];
          s += SHX(s, 1); s += SHX(s, 2);
          const float mean = s * (1.0f / 128.0f); float qq = 0.f;
#pragma unroll
          for (int i = 0; i < 32; ++i) { v[i] -= mean; qq += v[i] * v[i]; }
          qq += SHX(qq, 1); qq += SHX(qq, 2);
          const float rstd = 1.0f / sqrtf(qq * (1.0f / 128.0f) + LN_EPS);
          const float* lg = F.in[I_LNG] + ((size_t)l * 8 + g) * 128 + 32 * q4; const float* lb = F.in[I_LNB] + ((size_t)l * 8 + g) * 128 + 32 * q4;
#pragma unroll
          for (int i = 0; i < 4; ++i) { float o[8]; const f32x4 g0 = *(const f32x4*)(lg + 8 * i), g1 = *(const f32x4*)(lg + 8 * i + 4), b0 = *(const f32x4*)(lb + 8 * i), b1 = *(const f32x4*)(lb + 8 * i + 4);
#pragma unroll
              for (int jj = 0; jj < 4; ++jj) { o[jj] = v[8 * i + jj] * rstd * g0[jj] + b0[jj]; o[4 + jj] = v[8 * i + 4 + jj] * rstd * g1[jj] + b1[jj]; }
              *(LAS u32x4*)(VN + jrow * VTS + 32 * q4 + 8 * i) = pack8(o); } }
        if (item + G < NIT) GM_ISSUE(item + G);
        LBAR();
#pragma unroll
        for (int mt = 0; mt < 8; ++mt) { f32x4 acc = F4Z;
#pragma unroll
            for (int ks = 0; ks < 4; ++ks) acc = __builtin_amdgcn_mfma_f32_16x16x32_bf16(frag_tr_ld(VN, VTS, 32 * ks, 16 * mt, fr, fq), bw[ks], acc, 0, 0, 0);
            *(LAS u32x2*)(ST + (16 * wave + fr) * VTS + 16 * mt + 4 * fq) = pk4(acc); }
        LBAR();
        { bf16* op = O + (size_t)(R0 + jrow) * D + DA + 128 * g + 32 * q4;
#pragma unroll
          for (int i = 0; i < 4; ++i) { float sv[8], uv[8], o[8]; unpack8(*(const LAS u32x4*)(ST + jrow * VTS + 32 * q4 + 8 * i), sv); unpack8(pu[i], uv);
#pragma unroll
              for (int jj = 0; jj < 8; ++jj) o[jj] = uv[jj] * (sv[jj] + bsp);
              *(u32x4*)(op + 8 * i) = pack8(o); } }
    }
    LBAR();
#undef GM_ISSUE
}

constexpr int T16B = 9216, LD16 = 72, LD32 = 68;
#define SLOT(i) ((LAS bf16*)(lds + (i) * T16B))
#define SLOTF(i) ((LAS float*)(lds + (i) * T16B))
template <int NK>
__device__ __forceinline__ f32x4 tile_mm(const LAS bf16* A, int lda, const LAS bf16* B, int ldb, int fr, int fq, f32x4 acc) {
#pragma unroll
    for (int ks = 0; ks < NK; ++ks) { const bf16x8 a = *(const LAS bf16x8*)(A + fr * lda + 8 * fq + 32 * ks); const bf16x8 b = *(const LAS bf16x8*)(B + fr * ldb + 8 * fq + 32 * ks);
        acc = __builtin_amdgcn_mfma_f32_16x16x32_bf16(a, b, acc, 0, 0, 0); }
    return acc;
}
__device__ __forceinline__ void st_nat(LAS bf16* dst, int n0, int m0, int fr, int fq, const f32x4 a) { *(LAS u32x2*)(dst + (n0 + fr) * LD16 + m0 + 4 * fq) = pk4(a); }
__device__ __forceinline__ void st_rm(LAS bf16* dst, int n0, int m0, int fr, int fq, const f32x4 a) {
#pragma unroll
    for (int r = 0; r < 4; ++r) dst[(m0 + 4 * fq + r) * LD16 + n0 + fr] = (bf16)f2bf(a[r]); }
__device__ __forceinline__ f32x4 ld4bf(const LAS bf16* p) { const u32x2 w = *(const LAS u32x2*)p; return (f32x4){__uint_as_float(w.x << 16), __uint_as_float(w.x & 0xffff0000u), __uint_as_float(w.y << 16), __uint_as_float(w.y & 0xffff0000u)}; }

__device__ __forceinline__ int fm_off(int n0, int m0, int fr, int fq) { return ((((n0 >> 4) * 2 + (m0 >> 5)) * 64 + (2 * ((m0 >> 4) & 1) + (fq >> 1)) * 16 + fr) << 3) + 4 * (fq & 1); }
typedef short s16x4 __attribute__((ext_vector_type(4)));
__device__ __forceinline__ bf16x8 frag_tr(const LAS bf16* X, int kbase, int c0, int fr, int fq) {
    const LAS bf16* p = X + (kbase + 8 * fq + (fr >> 2)) * LD16 + c0 + 4 * (fr & 3);
    const s16x4 lo = __builtin_amdgcn_ds_read_tr16_b64_v4i16((LAS s16x4*)p);
    const s16x4 hi = __builtin_amdgcn_ds_read_tr16_b64_v4i16((LAS s16x4*)(p + 4 * LD16));
    return (bf16x8){lo[0], lo[1], lo[2], lo[3], hi[0], hi[1], hi[2], hi[3]};
}
__device__ __forceinline__ bf16x8 frag_rm(const LAS bf16* X, int r0, int ks, int fr, int fq) { return *(const LAS bf16x8*)(X + (r0 + fr) * LD16 + 8 * fq + 32 * ks); }
__device__ __forceinline__ f32x4 mm2(const bf16x8 (&a)[2], const bf16x8 (&b)[2], f32x4 acc) {
    acc = __builtin_amdgcn_mfma_f32_16x16x32_bf16(a[0], b[0], acc, 0, 0, 0); return __builtin_amdgcn_mfma_f32_16x16x32_bf16(a[1], b[1], acc, 0, 0, 0); }
__device__ __forceinline__ bf16x8 as_frag(const u32x4 q) { return __builtin_bit_cast(bf16x8, q); }

__device__ __forceinline__ void p_chunkA(Frame& F, int l) {
    PH_LOCALS(F); PH_LAYER(l);
    LAS unsigned char* lds = F.lds;
    const int lane0 = lane, lane00 = lane;
#define STG int lane_ = lane0; asm volatile("" : "+v"(lane_)); const int lane = lane_, fr = lane_ & 15, fq = lane_ >> 4, tid = wave * 64 + lane_, mt = wave >> 1, m0 = 16 * mt, np = (wave & 1) * 2; \
    (void)lane; (void)fr; (void)fq; (void)tid; (void)mt; (void)m0; (void)np;
    const bf16* PS = (const bf16*)(F.ws + WS_PS);
    const bf16* w2t = (const bf16*)(F.ws + WS_W2T) + (size_t)l * 2 * 1024 * 64;
    const bf16* a2t = (const bf16*)(F.ws + WS_A2T) + (size_t)l * 2 * 1024 * 64;
    const bf16* g2t = (const bf16*)(F.ws + WS_G2T) + (size_t)l * 1024 * 160;
    bf16* GATE = (bf16*)(F.ws + WS_GATE); float* BONUS = (float*)(F.ws + WS_BONUS);
    LAS float* gC = (LAS float*)(lds + 14 * T16B);
    LAS float* BT = (LAS float*)(lds + 14 * T16B + 256);
    u32x4 pf_w[2], pf_a[2], pf_g[5], pf_r, pf_k, pf_v; bf16x8 Bg[2][5], Bw[2][2], Ba[2][2]; float biw[2], bia[2];
#define CA_ISSUE(item_, d_) do { const int ci_ = (item_) >> 4, h_ = (item_) & 15, R0_ = ci_ * 64; int lane0 = lane00; asm volatile("" : "+v"(lane0)); \
        const bf16* arow_ = (const bf16*)(F.ws + WS_LORA) + ((((size_t)(R0_ >> 4) + (wave >> 1)) * 9 * 64 + lane0) << 3); \
        pf_w[0] = *(const u32x4*)arow_; pf_w[1] = *(const u32x4*)(arow_ + 512); pf_a[0] = *(const u32x4*)(arow_ + 1024); pf_a[1] = *(const u32x4*)(arow_ + 1536); \
        if ((d_) == 0) { _Pragma("unroll") for (int ks_ = 0; ks_ < 5; ++ks_) { pf_g[ks_] = *(const u32x4*)(arow_ + 2048 + 512 * ks_); \
            _Pragma("unroll") for (int nn_ = 0; nn_ < 2; ++nn_) Bg[nn_][ks_] = *(const bf16x8*)(g2t + (size_t)(64 * h_ + 16 * ((wave & 1) * 2 + nn_) + (lane0 & 15)) * 160 + 8 * (lane0 >> 4) + 32 * ks_); } } \
        _Pragma("unroll") for (int nn_ = 0; nn_ < 2; ++nn_) { const int n_ = 64 * h_ + 16 * ((wave & 1) * 2 + nn_) + (lane0 & 15); \
            biw[nn_] = F.in[I_W0][((size_t)l * 2 + (d_)) * DA + n_]; bia[nn_] = F.in[I_A0][((size_t)l * 2 + (d_)) * DA + n_]; \
            _Pragma("unroll") for (int ks_ = 0; ks_ < 2; ++ks_) { Bw[nn_][ks_] = *(const bf16x8*)(w2t + ((size_t)(d_) * 1024 + n_) * 64 + 8 * (lane0 >> 4) + 32 * ks_); Ba[nn_][ks_] = *(const bf16x8*)(a2t + ((size_t)(d_) * 1024 + n_) * 64 + 8 * (lane0 >> 4) + 32 * ks_); } } \
        const int tid_ = wave * 64 + lane0, tau_ = tid_ >> 3, pos_ = (d_) ? 63 - tau_ : tau_; const bf16* rrow_ = PS + (size_t)(R0_ + pos_) * CSH + 64 * h_ + (tid_ & 7) * 8; \
        pf_r = *(const u32x4*)rrow_; pf_k = *(const u32x4*)(rrow_ + DA); pf_v = *(const u32x4*)(rrow_ + 2 * DA); } while (0)
    if (bx < (M / 64) * NH) CA_ISSUE(bx, 0);
    int hcur = -1;
    LAS float* HC = (LAS float*)(lds + 14 * T16B + 1280);
    for (int item = bx; item < (M / 64) * NH; item += G) {
        const int ci = item >> 4, h = item & 15, R0 = ci * 64;
        { (void)hcur;
            LBAR();
            { const int t_ = wave * 64 + lane0; if (t_ < 192) { const int w_ = t_ >> 6, c_ = t_ & 63; HC[t_] = (w_ == 0 ? F.in[I_KK] : (w_ == 1 ? F.in[I_KA] : F.in[I_RK]))[(size_t)l * DA + 64 * h + c_]; } } }
#pragma unroll
        for (int d = 0; d < 2; ++d) {
            const size_t qi = ((size_t)ci * 16 + h) * 2 + d;
            const bf16x8 cBw[2][2] = {{Bw[0][0], Bw[0][1]}, {Bw[1][0], Bw[1][1]}}, cBa[2][2] = {{Ba[0][0], Ba[0][1]}, {Ba[1][0], Ba[1][1]}}; const float cbw[2] = {biw[0], biw[1]}, cba[2] = {bia[0], bia[1]};
            u32x4 cw[2] = {pf_w[0], pf_w[1]}, ca[2] = {pf_a[0], pf_a[1]}, cg[5] = {pf_g[0], pf_g[1], pf_g[2], pf_g[3], pf_g[4]}; const u32x4 cr = pf_r, ck = pf_k, cv = pf_v;
            for (int repA = 0; repA < (PROBE_SUB == 1 ? 2 : 1); ++repA) {
            { STG; LAS float* AL = SLOTF(5); LAS float* LW = SLOTF(7);
              bf16x8 aw[2], aa[2];
#pragma unroll
              for (int ks = 0; ks < 2; ++ks) { aw[ks] = as_frag(cw[ks]); aa[ks] = as_frag(ca[ks]); }
#pragma unroll
              for (int nn = 0; nn < 2; ++nn) { const int nl = 16 * (np + nn) + fr, n = 64 * h + nl;
                  const f32x4 accw = mm2(aw, cBw[nn], F4Z), acca = mm2(aa, cBa[nn], F4Z);
                  const float biasw = cbw[nn], biasa = cba[nn]; (void)n;
                  float lw[4], c[4];
#pragma unroll
                  for (int r = 0; r < 4; ++r) lw[r] = -0.8750345269f * fsigmoid(biasw + accw[r]);
                  if (d == 0) { c[0] = lw[0]; c[1] = c[0] + lw[1]; c[2] = c[1] + lw[2]; c[3] = c[2] + lw[3]; }
                  else { c[3] = lw[3]; c[2] = c[3] + lw[2]; c[1] = c[2] + lw[1]; c[0] = c[1] + lw[0]; }
                  const float tot = d == 0 ? c[3] : c[0];
                  const float t1 = SHX(tot, 16), t2 = SHX(tot, 32), t3 = SHX(tot, 48);
                  float off;
                  { const int sg = d ? -1 : 1, q1 = fq ^ 1, q2 = fq ^ 2, q3 = fq ^ 3;
                    const int k1 = (sg * (q1 - fq)) >> 31, k2 = (sg * (q2 - fq)) >> 31, k3 = (sg * (q3 - fq)) >> 31;
                    off = (__int_as_float(__float_as_int(t1) & k1) + __int_as_float(__float_as_int(t2) & k2)) + __int_as_float(__float_as_int(t3) & k3); }
#pragma unroll
                  for (int r = 0; r < 4; ++r) { const int pos = m0 + 4 * fq + r, tau = d ? 63 - pos : pos;
                      LW[tau * LD32 + nl] = c[r] + off; AL[tau * LD32 + nl] = fsigmoid(biasa + acca[r]); }
                  if (fq == 0) BT[(d ? 3 - mt : mt) * 64 + nl] = (tot + t1) + (t2 + t3); }
              if (d == 0) {
                  bf16x8 ag[5];
#pragma unroll
                  for (int ks = 0; ks < 5; ++ks) ag[ks] = as_frag(cg[ks]);
#pragma unroll
                  for (int nn = 0; nn < 2; ++nn) { const int n = 64 * h + 16 * (np + nn) + fr; f32x4 acc = F4Z;
#pragma unroll
                      for (int ks = 0; ks < 5; ++ks) acc = __builtin_amdgcn_mfma_f32_16x16x32_bf16(ag[ks], Bg[nn][ks], acc, 0, 0, 0);
#pragma unroll
                      for (int r = 0; r < 4; ++r) SLOT(11)[(m0 + 4 * fq + r) * LD16 + 16 * (np + nn) + fr] = (bf16)f2bf(acc[r]); (void)n; } } }
            LBAR();
            { STG; const LAS float* AL = SLOTF(5); const LAS float* LW = SLOTF(7);
              const int tau = tid >> 3, c8 = (tid & 7) * 8, pos = d ? 63 - tau : tau, row = R0 + pos, blk = wave >> 1;
              f32x2 r[4], k[4];
              { const u32x4 q = cr; r[0] = (f32x2){__uint_as_float(q.x << 16), __uint_as_float(q.x & 0xffff0000u)}; r[1] = (f32x2){__uint_as_float(q.y << 16), __uint_as_float(q.y & 0xffff0000u)};
                r[2] = (f32x2){__uint_as_float(q.z << 16), __uint_as_float(q.z & 0xffff0000u)}; r[3] = (f32x2){__uint_as_float(q.w << 16), __uint_as_float(q.w & 0xffff0000u)}; }
              { const u32x4 q = ck; k[0] = (f32x2){__uint_as_float(q.x << 16), __uint_as_float(q.x & 0xffff0000u)}; k[1] = (f32x2){__uint_as_float(q.y << 16), __uint_as_float(q.y & 0xffff0000u)};
                k[2] = (f32x2){__uint_as_float(q.z << 16), __uint_as_float(q.z & 0xffff0000u)}; k[3] = (f32x2){__uint_as_float(q.w << 16), __uint_as_float(q.w & 0xffff0000u)}; }
              f32x2 offb[4], totC[4];
#pragma unroll
              for (int j = 0; j < 4; ++j) { offb[j] = (f32x2){0.f, 0.f}; totC[j] = (f32x2){0.f, 0.f}; }
#pragma unroll
              for (int b = 0; b < 4; ++b) { const f32x4 x0 = *(const LAS f32x4*)(BT + b * 64 + c8), x1 = *(const LAS f32x4*)(BT + b * 64 + c8 + 4);
                  const f32x2 y[4] = {{x0[0], x0[1]}, {x0[2], x0[3]}, {x1[0], x1[1]}, {x1[2], x1[3]}};
                  const float fb = b < blk ? 1.0f : 0.0f;
#pragma unroll
                  for (int j = 0; j < 4; ++j) { totC[j] += y[j]; offb[j] += y[j] * fb; } }
              f32x2 ckk[4], cka[4], crk[4];
              { const f32x4 a0 = *(const LAS f32x4*)(HC + c8), a1 = *(const LAS f32x4*)(HC + c8 + 4), b0 = *(const LAS f32x4*)(HC + 64 + c8), b1 = *(const LAS f32x4*)(HC + 64 + c8 + 4), c0 = *(const LAS f32x4*)(HC + 128 + c8), c1 = *(const LAS f32x4*)(HC + 128 + c8 + 4);
                ckk[0] = (f32x2){a0[0], a0[1]}; ckk[1] = (f32x2){a0[2], a0[3]}; ckk[2] = (f32x2){a1[0], a1[1]}; ckk[3] = (f32x2){a1[2], a1[3]};
                cka[0] = (f32x2){b0[0], b0[1]}; cka[1] = (f32x2){b0[2], b0[3]}; cka[2] = (f32x2){b1[0], b1[1]}; cka[3] = (f32x2){b1[2], b1[3]};
                crk[0] = (f32x2){c0[0], c0[1]}; crk[1] = (f32x2){c0[2], c0[3]}; crk[2] = (f32x2){c1[0], c1[1]}; crk[3] = (f32x2){c1[2], c1[3]}; }
              f32x2 kk[4], s2 = (f32x2){0.f, 0.f};
#pragma unroll
              for (int j = 0; j < 4; ++j) { kk[j] = k[j] * ckk[j]; s2 += kk[j] * kk[j]; }
              float ss = s2.x + s2.y;
              ss += SHX(ss, 1); ss += SHX(ss, 2); ss += SHX(ss, 4);
              const float rn = 1.0f / sqrtf(fmaxf(ss, 1e-24f));
              f32x2 alv[4], csv[4], csm[4];
              { const f32x4 a0 = *(const LAS f32x4*)(AL + tau * LD32 + c8), a1 = *(const LAS f32x4*)(AL + tau * LD32 + c8 + 4), c0 = *(const LAS f32x4*)(LW + tau * LD32 + c8), c1 = *(const LAS f32x4*)(LW + tau * LD32 + c8 + 4);
                const int tm = (tau & 15) ? tau - 1 : tau; f32x4 e0 = *(const LAS f32x4*)(LW + tm * LD32 + c8), e1 = *(const LAS f32x4*)(LW + tm * LD32 + c8 + 4);
                if ((tau & 15) == 0) { e0 = F4Z; e1 = F4Z; }
                alv[0] = (f32x2){a0[0], a0[1]}; alv[1] = (f32x2){a0[2], a0[3]}; alv[2] = (f32x2){a1[0], a1[1]}; alv[3] = (f32x2){a1[2], a1[3]};
                csv[0] = (f32x2){c0[0], c0[1]} + offb[0]; csv[1] = (f32x2){c0[2], c0[3]} + offb[1]; csv[2] = (f32x2){c1[0], c1[1]} + offb[2]; csv[3] = (f32x2){c1[2], c1[3]} + offb[3];
                csm[0] = (f32x2){e0[0], e0[1]} + offb[0]; csm[1] = (f32x2){e0[2], e0[3]} + offb[1]; csm[2] = (f32x2){e1[0], e1[1]} + offb[2]; csm[3] = (f32x2){e1[2], e1[3]} + offb[3]; }
              f32x2 at[4], rt[4], bt[4], kt[4], bh[4], kh[4], bon2 = (f32x2){0.f, 0.f};
#pragma unroll
              for (int j = 0; j < 4; ++j) { const f32x2 al = alv[j], cs = csv[j], dh = totC[j] - cs;
                  const f32x2 kkn = kk[j] * rn, kd = k[j] * ((al - 1.0f) * cka[j] + 1.0f), bb = kkn * al;
                  bon2 += r[j] * kd * crk[j];
                  const f32x2 encs = (f32x2){__builtin_amdgcn_exp2f(-cs.x), __builtin_amdgcn_exp2f(-cs.y)}, eh = (f32x2){__builtin_amdgcn_exp2f(dh.x), __builtin_amdgcn_exp2f(dh.y)};
                  const f32x2 ecm = (f32x2){__builtin_amdgcn_exp2f(csm[j].x), __builtin_amdgcn_exp2f(csm[j].y)}, ecs = (f32x2){__builtin_amdgcn_exp2f(cs.x), __builtin_amdgcn_exp2f(cs.y)};
                  at[j] = -(ecm * kkn); rt[j] = ecs * r[j]; bt[j] = encs * bb; kt[j] = encs * kd; bh[j] = eh * bb; kh[j] = eh * kd; }
              if (tau == 63) {
#pragma unroll
                  for (int j = 0; j < 4; ++j) { gC[c8 + 2 * j] = __builtin_amdgcn_exp2f(totC[j].x); gC[c8 + 2 * j + 1] = __builtin_amdgcn_exp2f(totC[j].y); } }
#define PK8V(a) ((u32x4){pk2(a[0].x, a[0].y), pk2(a[1].x, a[1].y), pk2(a[2].x, a[2].y), pk2(a[3].x, a[3].y)})
              *(LAS u32x4*)(SLOT(0) + tau * LD16 + c8) = PK8V(at); *(LAS u32x4*)(SLOT(1) + tau * LD16 + c8) = PK8V(rt);
              *(LAS u32x4*)(SLOT(2) + tau * LD16 + c8) = PK8V(bt); *(LAS u32x4*)(SLOT(3) + tau * LD16 + c8) = PK8V(kt);
              *(LAS u32x4*)(SLOT(4) + tau * LD16 + c8) = PK8V(bh); *(LAS u32x4*)(SLOT(9) + tau * LD16 + c8) = PK8V(kh);
#undef PK8V
              *(LAS u32x4*)(SLOT(10) + tau * LD16 + c8) = cv;
              if (d == 0) *(u32x4*)(GATE + (size_t)row * DA + 64 * h + c8) = *(const LAS u32x4*)(SLOT(11) + pos * LD16 + c8);
              float bon = bon2.x + bon2.y;
              bon += SHX(bon, 1); bon += SHX(bon, 2); bon += SHX(bon, 4);
              BONUS[((size_t)d * M + row) * NH + h] = bon; }
            LBAR();
            }
            { int nitem = d == 0 ? item : item + G; const int nd = d ^ 1; if (nitem >= (M / 64) * NH) nitem = item; CA_ISSUE(nitem, nd); }
            for (int repB = 0; repB < (PROBE_SUB == 2 ? 2 : 1); ++repB) {
            { STG; bf16x8 aB[2], aA[2], aK[2];
#pragma unroll
              for (int ks = 0; ks < 2; ++ks) { aB[ks] = frag_rm(SLOT(2), m0, ks, fr, fq); aA[ks] = frag_rm(SLOT(0), m0, ks, fr, fq); aK[ks] = frag_rm(SLOT(3), m0, ks, fr, fq); }
#pragma unroll
              for (int nn = 0; nn < 2; ++nn) { const int n0 = 16 * (np + nn), n = n0 + fr; bf16x8 bA[2], bB[2], bK[2], bR[2];
#pragma unroll
                  for (int ks = 0; ks < 2; ++ks) { bA[ks] = frag_rm(SLOT(0), n0, ks, fr, fq); bB[ks] = frag_rm(SLOT(2), n0, ks, fr, fq); bK[ks] = frag_rm(SLOT(3), n0, ks, fr, fq); bR[ks] = frag_rm(SLOT(1), n0, ks, fr, fq); }
                  f32x4 p0 = mm2(aB, bA, F4Z), p1 = mm2(aA, bB, F4Z), p2 = mm2(aA, bK, F4Z), p3 = mm2(aB, bR, F4Z), p4 = mm2(aK, bR, F4Z), t0;
#pragma unroll
                  for (int r = 0; r < 4; ++r) { const int m = m0 + 4 * fq + r;
                      p0[r] = m < n ? p0[r] : 0.f; p1[r] = n < m ? p1[r] : 0.f; p2[r] = n < m ? p2[r] : 0.f; p3[r] = m <= n ? p3[r] : 0.f; p4[r] = m <= n ? p4[r] : 0.f;
                      t0[r] = p1[r] + (m == n ? 1.0f : 0.f); }
                  st_nat(SLOT(5), n0, m0, fr, fq, p0); st_nat(SLOT(6), n0, m0, fr, fq, p1); st_nat(SLOT(7), n0, m0, fr, fq, t0);
                  st_nat(SLOT(8), n0, m0, fr, fq, p2); st_nat(SLOT(11), n0, m0, fr, fq, p3); st_nat(SLOT(12), n0, m0, fr, fq, p4); } }
            LBAR();
#define MM1(a, b, c) __builtin_amdgcn_mfma_f32_16x16x32_bf16(a, b, c, 0, 0, 0)
            { STG; const int b = wave >> 2, bm0 = 32 * b + 16 * ((wave >> 1) & 1), bn0 = 32 * b + 16 * (wave & 1), oc = 32 * (1 - b) - 32 * b;
              const bf16x8 aT = frag_rm(SLOT(5), bm0, b, fr, fq), aR = frag_rm(SLOT(6), bm0, b, fr, fq), bR = frag_rm(SLOT(6), bn0, b, fr, fq), bT = frag_rm(SLOT(5), bn0, b, fr, fq);
              st_nat(SLOT(2), bn0, bm0, fr, fq, MM1(aT, bR, F4Z)); st_nat(SLOT(2), bn0, bm0 + oc, fr, fq, MM1(aR, bT, F4Z)); }
            LBAR();
#pragma unroll
            for (int kq = 1; kq <= 4; ++kq) {
                STG; const int b = wave >> 2, bm0 = 32 * b + 16 * ((wave >> 1) & 1), bn0 = 32 * b + 16 * (wave & 1), oc = 32 * (1 - b) - 32 * b;
                const int pin = (kq & 1) ? 2 : 3, pout = (kq & 1) ? 3 : 2, tin = (kq & 1) ? 7 : 13, tout = (kq & 1) ? 13 : 7;
                const bf16x8 aPT = frag_rm(SLOT(pin), bm0, 1 - b, fr, fq), bTn = frag_rm(SLOT(tin), bn0, b, fr, fq);
                st_nat(SLOT(tout), bn0, bm0, fr, fq, MM1(aPT, bTn, ld4bf(SLOT(tin) + (bn0 + fr) * LD16 + bm0 + 4 * fq)));
                if (kq < 4) { const bf16x8 aPR = frag_rm(SLOT(pin), bm0, b, fr, fq), bPR = frag_rm(SLOT(pin), bn0, b, fr, fq), bPT = frag_rm(SLOT(pin), bn0, 1 - b, fr, fq);
                    st_nat(SLOT(pout), bn0, bm0, fr, fq, MM1(aPT, bPR, F4Z));
                    st_nat(SLOT(pout), bn0, bm0 + oc, fr, fq, MM1(aPR, bPT, F4Z)); }
                LBAR();
            }
            { STG; if (wave < 4) { const int xm0 = 16 * ((wave >> 1) & 1), xn0 = 32 + 16 * (wave & 1);
                  const bf16x8 a = frag_rm(SLOT(6), xm0, 1, fr, fq), bb = frag_tr(SLOT(7), 32, xn0, fr, fq);
                  st_nat(SLOT(13), xn0, xm0, fr, fq, MM1(a, bb, F4Z)); } }
            LBAR();
            { STG; if (wave < 4) { const int tn0 = 32 + 16 * ((wave >> 1) & 1), tm0 = 16 * (wave & 1);
                  const bf16x8 a = frag_rm(SLOT(13), tn0, 0, fr, fq), bb = frag_rm(SLOT(7), tm0, 0, fr, fq);
                  st_nat(SLOT(7), tm0, tn0, fr, fq, MM1(a, bb, F4Z)); } }
            LBAR();
#undef MM1
            { STG; const int xt = wave, n0 = 16 * (xt & 3); bf16x8 b[2];
              if (xt < 4) { b[0] = frag_rm(SLOT(11), n0, 0, fr, fq); b[1] = frag_rm(SLOT(11), n0, 1, fr, fq); }
              else { b[0] = frag_tr(SLOT(4), 0, n0, fr, fq); b[1] = frag_tr(SLOT(4), 32, n0, fr, fq); }
#pragma unroll
              for (int mm = 0; mm < 4; ++mm) { bf16x8 a[2] = {frag_rm(SLOT(7), 16 * mm, 0, fr, fq), frag_rm(SLOT(7), 16 * mm, 1, fr, fq)};
                  st_nat(xt < 4 ? SLOT(5) : SLOT(6), n0, 16 * mm, fr, fq, mm2(a, b, F4Z)); } }
            LBAR();
            }
            for (int repC = 0; repC < (PROBE_SUB == 3 ? 2 : 1); ++repC) {
            { STG; bf16x8 aAt[2] = {frag_tr(SLOT(0), 0, m0, fr, fq), frag_tr(SLOT(0), 32, m0, fr, fq)}, aAk[2] = {frag_rm(SLOT(8), m0, 0, fr, fq), frag_rm(SLOT(8), m0, 1, fr, fq)};
              bf16* pyt = (bf16*)(F.ws + WS_PYT) + qi * 4096; bf16* qyt = (bf16*)(F.ws + WS_QYT) + qi * 4096; bf16* pst = (bf16*)(F.ws + WS_PST) + qi * 4096;
#pragma unroll
              for (int nn = 0; nn < 2; ++nn) { const int n0 = 16 * (np + nn), n = n0 + fr, mb = m0 + 4 * fq;
                  bf16x8 bRb[2] = {frag_rm(SLOT(5), n0, 0, fr, fq), frag_rm(SLOT(5), n0, 1, fr, fq)}, bBh[2] = {frag_rm(SLOT(6), n0, 0, fr, fq), frag_rm(SLOT(6), n0, 1, fr, fq)};
                  const f32x4 py = mm2(aAt, bRb, ld4bf(SLOT(1) + n * LD16 + mb)), qy = mm2(aAk, bRb, ld4bf(SLOT(12) + n * LD16 + mb));
                  f32x4 psi, qsi;
#pragma unroll
                  for (int r = 0; r < 4; ++r) { psi[r] = (mb + r == n) ? gC[n] : 0.f; qsi[r] = bf2f(SLOT(9)[(mb + r) * LD16 + n]); }
                  const f32x4 ps = mm2(aAt, bBh, psi), qs = mm2(aAk, bBh, qsi);
                  { const int fo = fm_off(n0, m0, fr, fq); *(u32x2*)(pyt + fo) = pk4(py); *(u32x2*)(qyt + fo) = pk4(qy); *(u32x2*)(pst + fo) = pk4(ps); }
                  st_nat(SLOT(2), n0, m0, fr, fq, qs); } }
            LBAR();
            { STG; bf16* nct = (bf16*)(F.ws + WS_NCT) + qi * 4096; bf16* vtg = (bf16*)(F.ws + WS_VTG) + qi * 4096;
              bf16x8 a[2] = {frag_rm(SLOT(2), m0, 0, fr, fq), frag_rm(SLOT(2), m0, 1, fr, fq)};
#pragma unroll
              for (int nn = 0; nn < 2; ++nn) { const int n0 = 16 * (np + nn); bf16x8 b[2] = {frag_tr(SLOT(10), 0, n0, fr, fq), frag_tr(SLOT(10), 32, n0, fr, fq)};
                  *(u32x2*)(nct + ((((n0 >> 4) * 4 + mt) * 64 + lane) << 2)) = pk4(mm2(a, b, F4Z));
                  if (nn == (mt >> 1)) { const bf16x8 bs = (mt & 1) ? b[1] : b[0]; *(bf16x8*)(vtg + ((((n0 >> 4) * 2 + (mt & 1)) * 64 + lane) << 3)) = bs; } } }
            LBAR();
            }
        }
    }
#undef STG
#undef CA_ISSUE
}

__device__ __forceinline__ void p_chunkB(Frame& F, int l) {
    PH_LOCALS(F); PH_LAYER(l);
    const int fr = lane & 15, fq = lane >> 4;
    LAS bf16* Sl = (LAS bf16*)(F.lds + wave * 2304);
    const bf16* PST = (const bf16*)(F.ws + WS_PST); const bf16* NCT = (const bf16*)(F.ws + WS_NCT); bf16* SC = (bf16*)(F.ws + WS_SC);
    for (int t = bx + G * wave; t < 2560; t += G * NWAVES) {
        const bool lat = t < 512; const int tt = lat ? t : t - 512; const int chain = tt >> 2, vb = tt & 3;
        const int b = chain >> 5, h = (chain >> 1) & 15, d = chain & 1;
        const int cb = lat ? 64 + b * 64 : b * 4, NC = lat ? 64 : 4;
        f32x4 S[4];
        if (lat) { const float* src = F.in[I_STATE] + ((((size_t)b * NL + l) * 2 + d) * NH + h) * 4096 + (size_t)(16 * vb + fr) * 64 + 4 * fq;
#pragma unroll
            for (int T = 0; T < 4; ++T) S[T] = *(const f32x4*)(src + 16 * T); }
        else {
#pragma unroll
            for (int T = 0; T < 4; ++T) S[T] = (f32x4){0.f, 0.f, 0.f, 0.f}; }
        bf16x8 Apf[4][8]; u32x2 Npf[4][4];
#define CB_QI(step) ((((size_t)(cb + (d ? NC - 1 - (step) : (step)))) * 16 + h) * 2 + d)
#define CB_LOAD(u, step) do { const size_t q_ = CB_QI(step); const bf16* ps_ = PST + q_ * 4096 + lane * 8; const bf16* nc_ = NCT + q_ * 4096 + ((vb * 4 * 64 + lane) << 2); \
        _Pragma("unroll") for (int mt_ = 0; mt_ < 4; ++mt_) { Apf[u][2 * mt_] = *(const bf16x8*)(ps_ + mt_ * 1024); Apf[u][2 * mt_ + 1] = *(const bf16x8*)(ps_ + mt_ * 1024 + 512); Npf[u][mt_] = *(const u32x2*)(nc_ + mt_ * 256); } } while (0)
        CB_LOAD(0, 0); CB_LOAD(1, 1); CB_LOAD(2, 2); CB_LOAD(3, 3);
#define CB_GROUP(g) do { _Pragma("unroll") for (int u = 0; u < 4; ++u) { \
                const int step = (g) + u; const size_t q = CB_QI(step); \
                bf16* scg = SC + q * 4096; \
                asm volatile("" ::: "memory"); \
                _Pragma("unroll") for (int T = 0; T < 4; ++T) { const u32x2 w = pk4(S[T]); *(LAS u32x2*)(Sl + fr * LD16 + 16 * T + 4 * fq) = w; *(u32x2*)(scg + fm_off(16 * vb, 16 * T, fr, fq)) = w; } \
                asm volatile("s_waitcnt lgkmcnt(0)" ::: "memory"); \
                const bf16x8 b0 = *(const LAS bf16x8*)(Sl + fr * LD16 + 8 * fq), b1 = *(const LAS bf16x8*)(Sl + fr * LD16 + 8 * fq + 32); \
                _Pragma("unroll") for (int mt = 0; mt < 4; ++mt) { const u32x2 nw = Npf[u][mt]; \
                    f32x4 acc = (f32x4){__uint_as_float(nw.x << 16), __uint_as_float(nw.x & 0xffff0000u), __uint_as_float(nw.y << 16), __uint_as_float(nw.y & 0xffff0000u)}; \
                    acc = __builtin_amdgcn_mfma_f32_16x16x32_bf16(Apf[u][2 * mt], b0, acc, 0, 0, 0); \
                    acc = __builtin_amdgcn_mfma_f32_16x16x32_bf16(Apf[u][2 * mt + 1], b1, acc, 0, 0, 0); \
                    S[mt] = acc; } \
                asm volatile("s_waitcnt lgkmcnt(0)" ::: "memory"); \
                { const int ns_ = step + 4 < NC ? step + 4 : NC - 1; CB_LOAD(u, ns_); } } } while (0)
        for (int g = 0; g < NC; g += 4) CB_GROUP(g);
#undef CB_GROUP
#undef CB_LOAD
#undef CB_QI
        if (!lat) { float* dst = F.out + (size_t)M * D + ((((size_t)b * NL + l) * 2 + d) * NH + h) * 4096 + (size_t)(16 * vb + fr) * 64 + 4 * fq;
#pragma unroll
            for (int T = 0; T < 4; ++T) *(f32x4*)(dst + 16 * T) = S[T]; }
    }
}

__device__ __forceinline__ void p_chunkC(Frame& F, int l) {
    PH_LOCALS(F); PH_LAYER(l);
    LAS unsigned char* lds = F.lds;
    const int fr = lane & 15, fq = lane >> 4, d = wave >> 2, nb = wave & 3;
    const bf16* PS = (const bf16*)(F.ws + WS_PS); const bf16* GATE = (const bf16*)(F.ws + WS_GATE); const float* BONUS = (const float*)(F.ws + WS_BONUS);
    bf16* O = (bf16*)(F.ws + WS_O);
    constexpr int NIT = (M / 64) * NH;
    f32x4 gnw[4], gnb[4]; int hcur = -1;
    bf16x8 fa0[4][4], fb0[4]; u32x4 pv0, pg0; float pb00, pb01;
#define CC_ISSUE(item_, fa, fb, pv, pg, pb0, pb1) do { const int ci_ = (item_) >> 4, h_ = (item_) & 15; const size_t qi_ = ((size_t)ci_ * 16 + h_) * 2 + d; \
        const bf16* sc_ = (const bf16*)(F.ws + WS_SC) + qi_ * 4096 + lane * 8; const bf16* vt_ = (const bf16*)(F.ws + WS_VTG) + qi_ * 4096 + lane * 8; \
        const bf16* py_ = (const bf16*)(F.ws + WS_PYT) + qi_ * 4096 + nb * 1024 + lane * 8; const bf16* qy_ = (const bf16*)(F.ws + WS_QYT) + qi_ * 4096 + nb * 1024 + lane * 8; \
        fb[0] = *(const bf16x8*)py_; fb[1] = *(const bf16x8*)(py_ + 512); fb[2] = *(const bf16x8*)qy_; fb[3] = *(const bf16x8*)(qy_ + 512); \
        _Pragma("unroll") for (int vt4_ = 0; vt4_ < 4; ++vt4_) { fa[vt4_][0] = *(const bf16x8*)(sc_ + vt4_ * 1024); fa[vt4_][1] = *(const bf16x8*)(sc_ + vt4_ * 1024 + 512); fa[vt4_][2] = *(const bf16x8*)(vt_ + vt4_ * 1024); fa[vt4_][3] = *(const bf16x8*)(vt_ + vt4_ * 1024 + 512); } \
        const int row_ = ci_ * 64 + (tid >> 3), chn_ = 64 * h_ + (tid & 7) * 8; \
        pv = *(const u32x4*)(PS + (size_t)row_ * CSH + 2 * DA + chn_); pg = *(const u32x4*)(GATE + (size_t)row_ * DA + chn_); pb0 = BONUS[(size_t)row_ * NH + h_]; pb1 = BONUS[((size_t)M + row_) * NH + h_]; } while (0)
#define CC_BODY(item_, fa, fb, pv, pg, pb0, pb1, next_) do { const int ci = (item_) >> 4, h = (item_) & 15, R0 = ci * 64; \
        if (h != hcur) { hcur = h; _Pragma("unroll") for (int vtile = 0; vtile < 4; ++vtile) { gnw[vtile] = *(const f32x4*)(F.in[I_GNW] + (size_t)l * DA + 64 * h + 16 * vtile + 4 * fq); gnb[vtile] = *(const f32x4*)(F.in[I_GNB] + (size_t)l * DA + 64 * h + 16 * vtile + 4 * fq); } } \
        f32x4 acc[4]; float s = 0.f; \
        _Pragma("unroll") for (int vtile = 0; vtile < 4; ++vtile) { f32x4 a = F4Z; \
            _Pragma("unroll") for (int ks = 0; ks < 4; ++ks) a = __builtin_amdgcn_mfma_f32_16x16x32_bf16(fa[vtile][ks], fb[ks], a, 0, 0, 0); \
            acc[vtile] = a; s += (a[0] + a[1]) + (a[2] + a[3]); } \
        const u32x4 cv = pv, cgt = pg; const float bon = pb0 + pb1; \
        if ((next_) < NIT) CC_ISSUE((next_), fa, fb, pv, pg, pb0, pb1); \
        s += SHX(s, 16); s += SHX(s, 32); \
        const float mean = s * (1.0f / 64.0f); float qv = 0.f; \
        _Pragma("unroll") for (int vtile = 0; vtile < 4; ++vtile) { acc[vtile] = acc[vtile] - mean; const f32x4 a = acc[vtile]; qv += (a[0] * a[0] + a[1] * a[1]) + (a[2] * a[2] + a[3] * a[3]); } \
        qv += SHX(qv, 16); qv += SHX(qv, 32); \
        const float rstd = 1.0f / sqrtf(qv * (1.0f / 64.0f) + GN_EPS); \
        const int tau = 16 * nb + fr, pos = d ? 63 - tau : tau; \
        LAS float* Yd = (LAS float*)(lds + d * 17408); \
        _Pragma("unroll") for (int vtile = 0; vtile < 4; ++vtile) { const int v0 = 16 * vtile + 4 * fq; \
            *(LAS f32x4*)(Yd + pos * LD32 + v0) = acc[vtile] * rstd * gnw[vtile] + gnb[vtile]; } \
        LBAR(); \
        { const int pos2 = tid >> 3, c8 = (tid & 7) * 8, row = R0 + pos2, chn = 64 * h + c8; \
          const LAS float* Y0 = (const LAS float*)lds; const LAS float* Y1 = (const LAS float*)(lds + 17408); \
          float v[8], gt[8], o[8]; unpack8(cv, v); unpack8(cgt, gt); \
          const f32x4 y00 = *(const LAS f32x4*)(Y0 + pos2 * LD32 + c8), y01 = *(const LAS f32x4*)(Y0 + pos2 * LD32 + c8 + 4), y10 = *(const LAS f32x4*)(Y1 + pos2 * LD32 + c8), y11 = *(const LAS f32x4*)(Y1 + pos2 * LD32 + c8 + 4); \
          _Pragma("unroll") for (int j = 0; j < 4; ++j) { o[j] = (y00[j] + y10[j] + bon * v[j]) * gt[j]; o[4 + j] = (y01[j] + y11[j] + bon * v[4 + j]) * gt[4 + j]; } \
          *(u32x4*)(O + (size_t)row * D + chn) = pack8(o); } \
        LBAR(); } while (0)
    if (bx < NIT) CC_ISSUE(bx, fa0, fb0, pv0, pg0, pb00, pb01);
    for (int item = bx; item < NIT; item += G) {
        CC_BODY(item, fa0, fb0, pv0, pg0, pb00, pb01, item + G);
    }
#undef CC_BODY
#undef CC_ISSUE
}

__device__ __forceinline__ void p_final(Frame& F) {
    PH_LOCALS(F);
    const int gw = bx * NWAVES + wave, NGW = G * NWAVES;
    const float* fg = F.in[I_FNG];
    for (int row = gw; row < M; row += NGW) {
        float* xr = F.out + (size_t)row * D;
        f32x4 v[8]; float ss = 0.f;
#pragma unroll
        for (int j = 0; j < 8; ++j) { v[j] = *(const f32x4*)(xr + 4 * lane + 256 * j); ss += (v[j].x * v[j].x + v[j].y * v[j].y) + (v[j].z * v[j].z + v[j].w * v[j].w); }
        WAVE_SUM(ss); const float rstd = 1.0f / sqrtf(ss * (1.0f / D) + RMS_EPS);
#pragma unroll
        for (int j = 0; j < 8; ++j) { const int c = 4 * lane + 256 * j; *(f32x4*)(xr + c) = v[j] * rstd * *(const f32x4*)(fg + c); }
    }
}

constexpr int PH_PER_LAYER = 10, N_PHASES = 2 + NL * PH_PER_LAYER;
__global__ void __launch_bounds__(NWAVES * 64, 2) hymba_fwd(Args args) {
    extern __shared__ __attribute__((aligned(16))) unsigned char lds[];
    Frame F;
    F.lds = (LAS unsigned char*)lds;
    F.tid = threadIdx.x; F.lane = F.tid & 63; F.wave = __builtin_amdgcn_readfirstlane(F.tid >> 6);
    F.G = gridDim.x; F.bx = blockIdx.x;
    F.in = args.in; F.out = args.out; F.ws = args.ws;
    for (int u = F.tid; u < (LDS_BYTES - LDSCTL_OFF) / 4; u += NWAVES * 64) ((LAS unsigned*)(F.lds + LDSCTL_OFF))[u] = 0u;
    __syncthreads();
    volatile LAS unsigned* MISC = (volatile LAS unsigned*)(F.lds + MISC_OFF);
    unsigned* barw = (unsigned*)(F.ws + WS_CTL) + CW_BAR;
    XcdBarrier bar; bar.bar = barw; bar.x = 0; bar.st = nullptr;
    if (MK_N_LAUNCHES == 1) bar = xcd_barrier_post(barw, MISC + 8);
    const int lo = args.ph_lo, hi = args.ph_hi;
#define IN(k) (lo <= (k) && (k) < hi)
#define SEAM(k) do { if (MK_N_LAUNCHES == 1 && IN(k) && IN((k) + 1)) xcd_barrier(bar); } while (0)

    for (int rep = 0; rep < ((PROBE_DUP == 30) ? 2 : 1); ++rep)
    if (IN(0)) { p0_prologue(F); __syncthreads(); } SEAM(0);
    bf16* H = (bf16*)(F.ws + WS_H); bf16* O = (bf16*)(F.ws + WS_O); bf16* P = (bf16*)(F.ws + WS_P); bf16* HID = (bf16*)(F.ws + WS_HID);
    const float* mod = (const float*)(F.ws + WS_MOD);
    for (int l = 0; l < NL; ++l) {
        const int pb = 1 + l * PH_PER_LAYER;
        const float* xlo = l == 0 ? F.in[I_XP] : F.out; const float* xhi = l == 0 ? F.in[I_XS] : F.out + (size_t)MCTX * D;
        float* dummy = (float*)(F.ws + WS_P);
        for (int rep = 0; rep < ((PROBE_DUP == 7) ? 2 : 1); ++rep)
        if (IN(pb + 0)) { p_adaln(F, l, 0, xlo, xhi); } SEAM(pb + 0);
        for (int rep = 0; rep < ((PROBE_DUP == 1 || PROBE_DUP == 20) ? 2 : 1); ++rep)
        if (IN(pb + 1)) { pg8::Gemm g{H, (const bf16*)(F.ws + WS_WIN + l * SZ_WIN), M, PINP, D}; pg8::StaticOrder S; { int cb_ = F.bx, cg_ = F.G; asm volatile("" : "+s"(cb_), "+s"(cg_)); S.init(M, PINP, cg_, cb_, D); }
            EpiP E{P, PINP, CSH}; pg8::gemm_phase<EpiP, pg8::StaticOrder, true, true>(F.lds, g, S, E, F.wave); } SEAM(pb + 1);
        for (int rep = 0; rep < ((PROBE_DUP == 2) ? 2 : 1); ++rep)
        if (IN(pb + 2)) { p_shift(F, l); } SEAM(pb + 2);
        if (IN(pb + 3)) { for (int rep = 0; rep < ((PROBE_DUP == 3) ? 2 : 1); ++rep) p_chunkA(F, l); for (int rep = 0; rep < ((PROBE_DUP == 13) ? 2 : 1); ++rep) p_gmlp(F, l); } SEAM(pb + 3);
        for (int rep = 0; rep < ((PROBE_DUP == 4) ? 2 : 1); ++rep)
        if (IN(pb + 4)) { p_chunkB(F, l); } SEAM(pb + 4);
        for (int rep = 0; rep < ((PROBE_DUP == 5) ? 2 : 1); ++rep)
        if (IN(pb + 5)) { p_chunkC(F, l); } SEAM(pb + 5);
        if ((PROBE_DUP == 6 || PROBE_DUP == 20) && IN(pb + 6)) { pg8::Gemm g{O, (const bf16*)(F.ws + WS_WOUT + l * SZ_WOUT), M, D, D}; pg8::StaticOrder S; { int cb_ = F.bx, cg_ = F.G; asm volatile("" : "+s"(cb_), "+s"(cg_)); S.init(M, D, cg_, cb_, D); }
            EpiRes E{xlo, xhi, dummy, mod + (size_t)l * 5 * MODW, 2 * D, D / 64, nullptr, nullptr}; pg8::gemm_phase<EpiRes, pg8::StaticOrder, true, true>(F.lds, g, S, E, F.wave); }
        if (IN(pb + 6)) { pg8::Gemm g{O, (const bf16*)(F.ws + WS_WOUT + l * SZ_WOUT), M, D, D}; pg8::StaticOrder S; { int cb_ = F.bx, cg_ = F.G; asm volatile("" : "+s"(cb_), "+s"(cg_)); S.init(M, D, cg_, cb_, D); }
            EpiRes E{xlo, xhi, F.out, mod + (size_t)l * 5 * MODW, 2 * D, D / 64, nullptr, nullptr}; pg8::gemm_phase<EpiRes, pg8::StaticOrder, true, true>(F.lds, g, S, E, F.wave); } SEAM(pb + 6);
        for (int rep = 0; rep < ((PROBE_DUP == 7) ? 2 : 1); ++rep)
        if (IN(pb + 7)) { p_adaln(F, l, 1, F.out, F.out + (size_t)MCTX * D); } SEAM(pb + 7);
        for (int rep = 0; rep < ((PROBE_DUP == 8 || PROBE_DUP == 20) ? 2 : 1); ++rep)
        if (IN(pb + 8)) { pg8::Gemm g{H, (const bf16*)(F.ws + WS_WGU + l * SZ_WGU), M, NGU, D}; pg8::StaticOrder S; { int cb_ = F.bx, cg_ = F.G; asm volatile("" : "+s"(cb_), "+s"(cg_)); S.init(M, NGU, cg_, cb_, D); }
            EpiSwi E{HID, DFF}; pg8::gemm_phase<EpiSwi, pg8::StaticOrder, true, true>(F.lds, g, S, E, F.wave); } SEAM(pb + 8);
        if ((PROBE_DUP == 9 || PROBE_DUP == 20) && IN(pb + 9)) { pg8::Gemm g{HID, (const bf16*)(F.ws + WS_WD + l * SZ_WD), M, D, DFF}; pg8::StaticOrder S; { int cb_ = F.bx, cg_ = F.G; asm volatile("" : "+s"(cb_), "+s"(cg_)); S.init(M, D, cg_, cb_, DFF); }
            EpiRes E{F.out, F.out + (size_t)MCTX * D, dummy, mod + (size_t)l * 5 * MODW, 5 * D, DFF / 64, nullptr, nullptr}; pg8::gemm_phase<EpiRes, pg8::StaticOrder, true, true>(F.lds, g, S, E, F.wave); }
        if (IN(pb + 9)) { pg8::Gemm g{HID, (const bf16*)(F.ws + WS_WD + l * SZ_WD), M, D, DFF}; pg8::StaticOrder S; { int cb_ = F.bx, cg_ = F.G; asm volatile("" : "+s"(cb_), "+s"(cg_)); S.init(M, D, cg_, cb_, DFF); }
            EpiRes E{F.out, F.out + (size_t)MCTX * D, F.out, mod + (size_t)l * 5 * MODW, 5 * D, DFF / 64, (float*)(F.ws + WS_P), (unsigned*)(F.ws + WS_CTL) + CW_SPLIT + (size_t)l * 640 * 64}; pg8::gemm_phase<EpiRes, pg8::StaticOrder, true, true>(F.lds, g, S, E, F.wave); } SEAM(pb + 9);
    }
    if (IN(N_PHASES - 1)) { p_final(F); }
#undef IN
#undef SEAM
}

extern "C" void kernel_launch(void* const* d_in, const int* in_sizes, int n_in, void* d_out, int out_size, void* d_ws, size_t ws_size, hipStream_t stream) {
    static int grid = 0;
    if (grid == 0) {
        if (n_in != 30 || ws_size < WS_END) { fprintf(stderr, "kernel_launch: need 30 inputs and >= %zu bytes of workspace; got n_in %d, ws %zu\n", (size_t)WS_END, n_in, ws_size); grid = -1; return; }
        int dev = 0, cus = 0, per_cu = 0;
        if (hipGetDevice(&dev) != hipSuccess || hipDeviceGetAttribute(&cus, hipDeviceAttributeMultiprocessorCount, dev) != hipSuccess) { grid = -1; return; }
        if (hipFuncSetAttribute((const void*)hymba_fwd, hipFuncAttributeMaxDynamicSharedMemorySize, LDS_BYTES) != hipSuccess) { fprintf(stderr, "kernel_launch: hipFuncSetAttribute failed\n"); grid = -1; return; }
        if (hipOccupancyMaxActiveBlocksPerMultiprocessor(&per_cu, (const void*)hymba_fwd, NWAVES * 64, LDS_BYTES) != hipSuccess || per_cu < 1)
            fprintf(stderr, "kernel_launch: note: occupancy query reports %d workgroups per CU\n", per_cu);
        (void)hipGetLastError();
        grid = cus;
    }
    if (grid < 0) return;
    if (hipMemsetAsync((char*)d_ws + WS_CTL, 0, CTL_ZERO_BYTES, stream) != hipSuccess) return;
    Args a{};
    for (int i = 0; i < 30; ++i) a.in[i] = (const float*)d_in[i];
    a.out = (float*)d_out; a.ws = (unsigned char*)d_ws; a.pad = 0;
    if (MK_N_LAUNCHES == 1) {
        a.ph_lo = 0; a.ph_hi = N_PHASES; a.li = 0;
        hipLaunchKernelGGL(hymba_fwd, dim3(grid), dim3(NWAVES * 64), LDS_BYTES, stream, a);
    } else {
        for (int k = 0; k < N_PHASES; ++k) { a.ph_lo = k; a.ph_hi = k + 1; a.li = k;
            hipLaunchKernelGGL(hymba_fwd, dim3(grid), dim3(NWAVES * 64), LDS_BYTES, stream, a); }
    }
}
```

```cpp
#include <hip/hip_runtime.h>
#include <cstdio>
#include <cstdint>

#ifndef PROBE_DUP
#define PROBE_DUP -1
#endif
#ifndef PROBE_SUB
#define PROBE_SUB 0
#endif
#ifndef MK_N_LAUNCHES
#define MK_N_LAUNCHES 1
#endif

namespace pg8 {
#define PG8_LAS __attribute__((address_space(3)))
typedef unsigned short bf16_t;
typedef short bf16x8 __attribute__((ext_vector_type(8)));
typedef float f32x4 __attribute__((ext_vector_type(4)));
typedef unsigned u32x4 __attribute__((ext_vector_type(4)));
constexpr int BM = 256, BK = 64, HALF = 128, HTB = HALF * BK * 2  , STAGE_BYTES = 8 * HTB, NXCD = 8, WGM = 8;

__host__ __device__ __forceinline__ int lds_byte(int r, int c) { const int st = (r >> 4) * 2 + (c >> 5), rr = r & 15, cc = c & 31, ob = rr * 64 + cc * 2; return st * 1024 + (ob ^ (((ob >> 9) & 1) << 5)); }
__host__ __device__ __forceinline__ void stage_rc(int b, int& R, int& C) { const int st = b / 1024, sb = b % 1024, swz = sb ^ (((sb >> 9) & 1) << 5); R = (st >> 1) * 16 + swz / 64; C = (st & 1) * 32 + (swz % 64) / 2; }
__host__ __device__ __forceinline__ int perm32(int rho) { const int n = rho >> 4, i = rho & 15; return 8 * (i >> 2) + 4 * n + (i & 3); }

struct Unit { int pm, pn, k0, nk; };
struct Gemm { const bf16_t* A; const bf16_t* Bt; int M, N, K; };

struct StaticOrder {
    int nM, nN, nwg, G, c, nkt, full, rem;
    __host__ __device__ void init(int M, int N, int G_, int c_, int K_) { nM = M / BM; nN = N / BM; nwg = nM * nN; G = G_; c = c_; nkt = K_ / BK; full = nwg / G; rem = nwg - full * G; }
    __host__ __device__ bool next(int i, Unit& u) const {
        const long L = (long)i * G + c; if (L >= nwg) return false;
        int wgid = (int)L; { const int q = nwg / NXCD, r = nwg % NXCD, xcd = wgid % NXCD, off = wgid / NXCD; wgid = (xcd < r ? xcd * (q + 1) : r * (q + 1) + (xcd - r) * q) + off; }
        const int nig = WGM * nN, gid = wgid / nig, fm = gid * WGM, gsz = (nM - fm) < WGM ? (nM - fm) : WGM;
        u.pm = fm + ((wgid % nig) % gsz); u.pn = (wgid % nig) / gsz; u.k0 = 0; u.nk = nkt;
#if defined(__HIP_DEVICE_COMPILE__)
        u.pm = __builtin_amdgcn_readfirstlane(u.pm); u.pn = __builtin_amdgcn_readfirstlane(u.pn);
#endif
        return true;
    }
    __device__ __forceinline__ void a_ready(const Unit&) const {}
    __device__ __forceinline__ void done(const Unit&) const {}
};
struct SplitTailOrder : StaticOrder {
    __host__ __device__ bool next(int i, Unit& u) const {
        if (i < full || 2 * rem > G || (nkt & 3)) return StaticOrder::next(i, u);
        if (i > full || c >= 2 * rem) return false;
        StaticOrder t = *this; t.c = c >> 1; if (!t.StaticOrder::next(full, u)) return false;
        u.nk = nkt / 2; u.k0 = (c & 1) * u.nk; return true;
    }
};

__device__ __forceinline__ unsigned cvt_pk_bf16(float lo, float hi) { unsigned r; asm volatile("v_cvt_pk_bf16_f32 %0, %1, %2" : "=v"(r) : "v"(lo), "v"(hi)); return r; }

template <class Epi, class Sched, bool ALIGN_EPI = false, bool SP2 = false>
__device__ __forceinline__ void gemm_phase(PG8_LAS unsigned char* lds, const Gemm g, const Sched& S, const Epi& E, int wid) {
    asm volatile("" : "+s"(wid)); int lane; asm volatile("v_mbcnt_lo_u32_b32 %0, -1, 0\n\tv_mbcnt_hi_u32_b32 %0, -1, %0" : "=v"(lane));
    const int tid = wid * 64 + lane, wr = wid >> 2, wc = wid & 3, fr = lane & 15, fq = lane >> 4;
    const int K = g.K;
    unsigned voffA[2], voffB[2];
#pragma unroll
    for (int i = 0; i < 2; ++i) { int R, C; stage_rc(tid * 16 + i * 8192, R, C); const int Rb = Epi::PERM ? ((R & ~31) + perm32(R & 31)) : R;
        voffA[i] = (unsigned)(R * K + C) * 2u; voffB[i] = (unsigned)(Rb * K + C) * 2u; }
    const size_t kstep = (size_t)(BK * 2);
    const size_t hstep = (size_t)HALF * K * 2;
    const size_t tstep = 2 * hstep;
    const unsigned ldsw = (unsigned)wid * 1024u;
    const int aoff = lds_byte(wr * 64 + fr, fq * 8), boff = lds_byte(wc * 32 + fr, fq * 8);
#define PG8_SA(b, h) (((b) * 2 + (h)) * HTB)
#define PG8_SB(b, h) ((4 + (b) * 2 + (h)) * HTB)
#define PG8_STAGE(bufoff, gbase, voff) do { _Pragma("unroll") for (int _i = 0; _i < 2; ++_i) \
        __builtin_amdgcn_global_load_lds((const unsigned*)((const char*)(gbase) + (voff)[_i]), (PG8_LAS unsigned*)(lds + (bufoff) + ldsw + _i * 8192), 16, 0, 0); } while (0)
#define PG8_LDA(dst, b, h) do { _Pragma("unroll") for (int m = 0; m < 4; ++m) _Pragma("unroll") for (int k = 0; k < 2; ++k) dst[m][k] = *(const PG8_LAS bf16x8*)(lds + PG8_SA(b, h) + aoff + m * 2048 + k * 1024); } while (0)
#define PG8_LDB(dst, b, h) do { _Pragma("unroll") for (int n = 0; n < 2; ++n) _Pragma("unroll") for (int k = 0; k < 2; ++k) dst[n][k] = *(const PG8_LAS bf16x8*)(lds + PG8_SB(b, h) + boff + n * 2048 + k * 1024); } while (0)
#define PG8_MMA(ai, bj, At, Bt) do { __builtin_amdgcn_s_setprio(1); _Pragma("unroll") for (int m = 0; m < 4; ++m) _Pragma("unroll") for (int n = 0; n < 2; ++n) _Pragma("unroll") for (int k = 0; k < 2; ++k) \
        acc[ai][bj][m][n] = __builtin_amdgcn_mfma_f32_16x16x32_bf16(Bt[n][k], At[m][k], acc[ai][bj][m][n], 0, 0, 0); __builtin_amdgcn_s_setprio(0); } while (0)
#define PG8_WAIT_V(n) asm volatile("s_waitcnt vmcnt(" #n ")" ::: "memory")
#define PG8_WAIT_L(n) asm volatile("s_waitcnt lgkmcnt(" #n ")" ::: "memory")
#define PG8_BAR __builtin_amdgcn_s_barrier()
#define PG8_SCHED __builtin_amdgcn_sched_barrier(0)
    Unit cur, nxt; int ui = 0;
    if (!S.next(0, cur)) return;
    f32x4 acc[2][2][4][2];
#pragma unroll
    for (int a = 0; a < 2; ++a)
#pragma unroll
        for (int b = 0; b < 2; ++b)
#pragma unroll
            for (int m = 0; m < 4; ++m)
#pragma unroll
                for (int n = 0; n < 2; ++n) acc[a][b][m][n] = (f32x4){0.f, 0.f, 0.f, 0.f};
    bf16x8 At[4][2], B0[2][2], B1[2][2];
    const char* cA = (const char*)g.A + (size_t)cur.pm * tstep + (size_t)cur.k0 * kstep; const char* cB = (const char*)g.Bt + (size_t)cur.pn * tstep + (size_t)cur.k0 * kstep;
    S.a_ready(cur);
    if constexpr (SP2) {
        PG8_STAGE(PG8_SB(0, 0), cB, voffB); PG8_STAGE(PG8_SB(0, 1), cB + hstep, voffB); PG8_STAGE(PG8_SA(0, 0), cA, voffA); PG8_STAGE(PG8_SA(0, 1), cA + hstep, voffA);
        if (wr == 1) PG8_BAR;
        PG8_WAIT_V(2); PG8_BAR;
        PG8_STAGE(PG8_SB(1, 0), cB + kstep, voffB); PG8_STAGE(PG8_SA(1, 0), cA + kstep, voffA); PG8_STAGE(PG8_SB(1, 1), cB + hstep + kstep, voffB);
        PG8_WAIT_V(6); PG8_BAR;
    } else {
        PG8_STAGE(PG8_SB(0, 0), cB, voffB); PG8_STAGE(PG8_SA(0, 0), cA, voffA); PG8_STAGE(PG8_SB(0, 1), cB + hstep, voffB); PG8_STAGE(PG8_SA(0, 1), cA + hstep, voffA);
        if (wr == 1) PG8_BAR;
        PG8_WAIT_V(4); PG8_BAR;
        PG8_STAGE(PG8_SB(1, 0), cB + kstep, voffB); PG8_STAGE(PG8_SA(1, 0), cA + kstep, voffA); PG8_STAGE(PG8_SB(1, 1), cB + hstep + kstep, voffB);
        PG8_WAIT_V(6); PG8_BAR;
    }
    for (;;) {
        const bool has_next = S.next(ui + 1, nxt);
        const char* nA = has_next ? (const char*)g.A + (size_t)nxt.pm * tstep + (size_t)nxt.k0 * kstep : cA; const char* nB = has_next ? (const char*)g.Bt + (size_t)nxt.pn * tstep + (size_t)nxt.k0 * kstep : cB;
        const int nt = cur.nk;
        for (int t = 0; t < nt; t += 2) {
            const bool last = (t == nt - 2);
            const char* a1 = cA + (size_t)(t + 1) * kstep;
            const char* a2 = last ? nA : cA + (size_t)(t + 2) * kstep; const char* b2 = last ? nB : cB + (size_t)(t + 2) * kstep;
            const char* a3 = a2 + kstep; const char* b3 = b2 + kstep;
            if (last && has_next) S.a_ready(nxt);
            if constexpr (SP2) {
            PG8_LDB(B0, 0, 0); PG8_LDB(B1, 0, 1); PG8_SCHED; PG8_LDA(At, 0, 0); PG8_STAGE(PG8_SA(1, 1), a1 + hstep, voffA);
            PG8_WAIT_V(8); PG8_WAIT_L(0); PG8_BAR; PG8_MMA(0, 0, At, B0); PG8_MMA(0, 1, At, B1); PG8_BAR; PG8_SCHED;
            PG8_LDA(At, 0, 1); PG8_STAGE(PG8_SB(0, 0), b2, voffB); PG8_STAGE(PG8_SB(0, 1), b2 + hstep, voffB); PG8_STAGE(PG8_SA(0, 0), a2, voffA);
            PG8_WAIT_V(8); PG8_WAIT_L(0); PG8_BAR; PG8_MMA(1, 0, At, B0); PG8_MMA(1, 1, At, B1); PG8_BAR; PG8_SCHED;
            PG8_LDB(B0, 1, 0); PG8_LDB(B1, 1, 1); PG8_SCHED; PG8_LDA(At, 1, 0); PG8_STAGE(PG8_SA(0, 1), a2 + hstep, voffA);
            PG8_WAIT_V(8); PG8_WAIT_L(0); PG8_BAR; PG8_MMA(0, 0, At, B0); PG8_MMA(0, 1, At, B1); PG8_BAR; PG8_SCHED;
            PG8_LDA(At, 1, 1); PG8_STAGE(PG8_SB(1, 0), b3, voffB); PG8_STAGE(PG8_SB(1, 1), b3 + hstep, voffB); PG8_STAGE(PG8_SA(1, 0), a3, voffA);
            PG8_WAIT_V(8); PG8_WAIT_L(0); PG8_BAR; PG8_MMA(1, 0, At, B0); PG8_MMA(1, 1, At, B1); PG8_BAR; PG8_SCHED;
            } else {
            PG8_LDB(B0, 0, 0); PG8_SCHED; PG8_LDA(At, 0, 0); PG8_STAGE(PG8_SA(1, 1), a1 + hstep, voffA);
            PG8_WAIT_L(8); PG8_BAR; PG8_WAIT_L(0); PG8_MMA(0, 0, At, B0); PG8_BAR; PG8_SCHED;
            PG8_LDB(B1, 0, 1); PG8_STAGE(PG8_SB(0, 0), b2, voffB);
            PG8_BAR; PG8_WAIT_L(0); PG8_MMA(0, 1, At, B1); PG8_BAR;
            PG8_LDA(At, 0, 1); PG8_STAGE(PG8_SA(0, 0), a2, voffA);
            PG8_BAR; PG8_WAIT_L(0); PG8_MMA(1, 0, At, B0); PG8_BAR; PG8_SCHED;
            PG8_STAGE(PG8_SB(0, 1), b2 + hstep, voffB);
            PG8_WAIT_V(6); PG8_BAR; PG8_MMA(1, 1, At, B1); PG8_BAR;
            PG8_LDB(B0, 1, 0); PG8_SCHED; PG8_LDA(At, 1, 0); PG8_STAGE(PG8_SA(0, 1), a2 + hstep, voffA);
            PG8_WAIT_L(8); PG8_BAR; PG8_WAIT_L(0); PG8_MMA(0, 0, At, B0); PG8_BAR; PG8_SCHED;
            PG8_LDB(B1, 1, 1); PG8_STAGE(PG8_SB(1, 0), b3, voffB);
            PG8_BAR; PG8_WAIT_L(0); PG8_MMA(0, 1, At, B1); PG8_BAR;
            PG8_LDA(At, 1, 1); PG8_STAGE(PG8_SA(1, 0), a3, voffA);
            PG8_BAR; PG8_WAIT_L(0); PG8_MMA(1, 0, At, B0); PG8_BAR; PG8_SCHED;
            PG8_STAGE(PG8_SB(1, 1), b3 + hstep, voffB);
            PG8_WAIT_V(6); PG8_BAR; PG8_MMA(1, 1, At, B1); PG8_BAR;
            }
        }
        if constexpr (ALIGN_EPI) { if (wr == 0) PG8_BAR; }
        E(acc, cur, wr, wc, fr, fq); S.done(cur);
        if (!has_next) break;
#pragma unroll
        for (int a = 0; a < 2; ++a)
#pragma unroll
            for (int b = 0; b < 2; ++b)
#pragma unroll
                for (int m = 0; m < 4; ++m)
#pragma unroll
                    for (int n = 0; n < 2; ++n) acc[a][b][m][n] = (f32x4){0.f, 0.f, 0.f, 0.f};
        cur = nxt; cA = nA; cB = nB; ++ui;
        if constexpr (ALIGN_EPI) { if (wr == 1) PG8_BAR; }
    }
    PG8_WAIT_V(0);
    if constexpr (!ALIGN_EPI) { if (wr == 0) PG8_BAR; }
    PG8_BAR;
#undef PG8_SA
#undef PG8_SB
#undef PG8_STAGE
#undef PG8_LDA
#undef PG8_LDB
#undef PG8_MMA
#undef PG8_WAIT_V
#undef PG8_WAIT_L
#undef PG8_BAR
#undef PG8_SCHED
}
}

constexpr int NWAVES = 8;
constexpr int D = 2048, MCTX = 4096, MLAT = 16384, M = MCTX + MLAT, NL = 4;
constexpr int DA = 1024, NH = 16, DB = 1024, NG = 8, HB = 128;
constexpr int LW = 64, LAA = 64, LGT = 160;
constexpr int CSH = 3 * DA + LW + LAA + LGT;
constexpr int PIN = CSH + 2 * DB;
constexpr int PINP = 5632;
constexpr int DFF = 5632, NGU = 2 * DFF;
constexpr int MODW = 6 * D;
constexpr float RMS_EPS = 1e-6f, GN_EPS = 64.0f * 1e-5f, LN_EPS = 1e-5f;

constexpr size_t MiB = 1u << 20;
constexpr size_t WS_CTL = 0, CTL_ZERO_BYTES = 1 * MiB;
constexpr size_t WS_MOD = 1 * MiB;
constexpr size_t WS_W2T = 2 * MiB;
constexpr size_t WS_A2T = 3 * MiB;
constexpr size_t WS_G2T = 4 * MiB;
constexpr size_t WS_WSP = 6 * MiB;
constexpr size_t WS_BONUS = 7 * MiB;
constexpr size_t SZ_WIN = (size_t)PINP * D * 2, SZ_WOUT = (size_t)D * D * 2, SZ_WGU = (size_t)NGU * D * 2, SZ_WD = (size_t)D * DFF * 2;
constexpr size_t WS_WIN = 16 * MiB;
constexpr size_t WS_WOUT = WS_WIN + NL * SZ_WIN;
constexpr size_t WS_WGU = WS_WOUT + NL * SZ_WOUT;
constexpr size_t WS_WD = WS_WGU + NL * SZ_WGU;
constexpr size_t WS_H = WS_WD + NL * SZ_WD;
constexpr size_t WS_O = WS_H + (size_t)M * D * 2;
constexpr size_t WS_P = WS_O + (size_t)M * D * 2;
constexpr size_t WS_PS = WS_P + (size_t)M * PINP * 2;
constexpr size_t SZ_T16 = (size_t)M * DA * 2;
constexpr size_t WS_GATE = WS_PS + (size_t)M * CSH * 2;
constexpr size_t SZ_CH = (size_t)(M / 64) * NH * 2 * 8192;
constexpr size_t WS_PST = WS_GATE + SZ_T16;
constexpr size_t WS_NCT = WS_PST + SZ_CH;
constexpr size_t WS_PYT = WS_NCT + SZ_CH;
constexpr size_t WS_QYT = WS_PYT + SZ_CH;
constexpr size_t WS_VTG = WS_QYT + SZ_CH;
constexpr size_t WS_SC = WS_VTG + SZ_CH;
constexpr size_t WS_LORA = WS_SC + SZ_CH;
constexpr size_t WS_END1 = WS_LORA + (size_t)M * 288 * 2;
constexpr size_t WS_HID = WS_GATE;
constexpr size_t WS_END = WS_END1 > WS_HID + (size_t)M * DFF * 2 ? WS_END1 : WS_HID + (size_t)M * DFF * 2;
constexpr int CW_BAR = 4096;
constexpr int CW_SPLIT = 16384;
static_assert((CW_SPLIT + NL * 640 * 64) * 4 <= (int)CTL_ZERO_BYTES, "control words inside the memset region");

constexpr int RING_BYTES = 131072;
constexpr int LDSCTL_OFF = 15 * 9216, MISC_OFF = LDSCTL_OFF + 320;
constexpr int LDS_BYTES = 147456;

#define GAS __attribute__((address_space(1)))
#define LAS __attribute__((address_space(3)))
typedef unsigned short bf16;
typedef float f32x4 __attribute__((ext_vector_type(4)));
typedef float f32x2 __attribute__((ext_vector_type(2)));
typedef short bf16x8 __attribute__((ext_vector_type(8)));
typedef unsigned u32x4 __attribute__((ext_vector_type(4)));
typedef unsigned u32x2 __attribute__((ext_vector_type(2)));
#define LDS_WAIT() asm volatile("s_waitcnt lgkmcnt(0)" ::: "memory")
#define VM_WAIT() asm volatile("s_waitcnt vmcnt(0)" ::: "memory")
__device__ __forceinline__ unsigned f2bf(float f) { unsigned u = __builtin_bit_cast(unsigned, f); return (u + 0x7fffu + ((u >> 16) & 1u)) >> 16; }
typedef __bf16 bf16x2_t __attribute__((ext_vector_type(2)));
__device__ __forceinline__ unsigned pk2(float lo, float hi) { return __builtin_bit_cast(unsigned, __builtin_convertvector((f32x2){lo, hi}, bf16x2_t)); }
__device__ __forceinline__ float bf2f(unsigned short b) { return __uint_as_float(((unsigned)b) << 16); }
__device__ __forceinline__ void unpack8(const u32x4 q, float (&f)[8]) {
    f[0] = __uint_as_float(q.x << 16); f[1] = __uint_as_float(q.x & 0xffff0000u); f[2] = __uint_as_float(q.y << 16); f[3] = __uint_as_float(q.y & 0xffff0000u);
    f[4] = __uint_as_float(q.z << 16); f[5] = __uint_as_float(q.z & 0xffff0000u); f[6] = __uint_as_float(q.w << 16); f[7] = __uint_as_float(q.w & 0xffff0000u); }
__device__ __forceinline__ u32x4 pack8(const float (&f)[8]) { u32x4 o; o.x = pk2(f[0], f[1]); o.y = pk2(f[2], f[3]); o.z = pk2(f[4], f[5]); o.w = pk2(f[6], f[7]); return o; }
__device__ __forceinline__ float fsigmoid(float x) { return __builtin_amdgcn_rcpf(1.0f + __expf(-x)); }
__device__ __forceinline__ float ftanh(float x) { return 1.0f - 2.0f * __builtin_amdgcn_rcpf(1.0f + __expf(2.0f * x)); }
__device__ __forceinline__ float gelu_tanh(float x) { const float u = 1.5957691216057308f * (x + 0.044715f * x * x * x); return x * __builtin_amdgcn_rcpf(1.0f + __expf(-u)); }
__device__ __forceinline__ int hw_lane() { int l; asm volatile("v_mbcnt_lo_u32_b32 %0, -1, 0\n\tv_mbcnt_hi_u32_b32 %0, -1, %0" : "=v"(l)); return l; }
#define SHX(v, X) __int_as_float(__builtin_amdgcn_ds_bpermute((lane ^ (X)) << 2, __float_as_int(v)))
#define WAVE_SUM(v) do { v += SHX(v, 1); v += SHX(v, 2); v += SHX(v, 4); v += SHX(v, 8); v += SHX(v, 16); v += SHX(v, 32); } while (0)

#define PH_LOCALS(F) int wave = (F).wave; asm volatile("" : "+s"(wave)); const int lane = hw_lane(); const int tid = wave * 64 + lane; \
    int bx = (F).bx, G = (F).G; asm volatile("" : "+s"(bx), "+s"(G)); (void)lane; (void)tid;
#define PH_LAYER(l) asm volatile("" : "+s"(l))

#define XB_TMO      128
#define XB_XCNT(j)  (256  + 64 * (j))
#define XB_XSUB(j)  (1280 + 64 * (j))
#define XB_XGEN(j)  (2304 + 64 * (j))
#define XB_TOP      3328
#define XB_TOPGEN   3392
#define XCD_BAR_WORDS 3456
#define XB_SPIN_CAP (1u << 18)

__device__ __forceinline__ unsigned xb_ld(unsigned* p)              { return __hip_atomic_load(p, __ATOMIC_RELAXED, __HIP_MEMORY_SCOPE_AGENT); }
__device__ __forceinline__ unsigned xb_add(unsigned* p, unsigned v) { return __hip_atomic_fetch_add(p, v, __ATOMIC_RELAXED, __HIP_MEMORY_SCOPE_AGENT); }
__device__ __forceinline__ unsigned xb_xcc_id() { return (unsigned)__builtin_amdgcn_s_getreg((3 << 11) | 20) & 0xFu; }
#define XB_SPIN(cond, bar) do { unsigned _sp = 0; while (cond) { __builtin_amdgcn_s_sleep(1); \
    if ((++_sp & 255u) == 0u) { if (xb_ld(&(bar)[XB_TMO])) break; if (_sp > XB_SPIN_CAP) { atomicAdd(&(bar)[XB_TMO], 1u); break; } } } } while (0)

struct XcdBarrier {
    unsigned* bar; unsigned x;
    volatile LAS unsigned* st;
};
__device__ __forceinline__ XcdBarrier xcd_barrier_post(unsigned* bar, volatile LAS unsigned* st) {
    XcdBarrier b; b.bar = bar; b.x = xb_xcc_id(); b.st = st;
    if (threadIdx.x == 0) (void)xb_add(&bar[XB_XCNT(b.x)], 1u);
    return b;
}
__device__ __forceinline__ void xcd_barrier_complete(unsigned* bar, unsigned x, unsigned& nloc, unsigned& nx) {
    const unsigned G = gridDim.x * gridDim.y * gridDim.z;
    unsigned sum, cnt, mine, sp = 0u;
    for (;;) {
        sum = 0u; cnt = 0u; mine = 0u;
#pragma unroll
        for (unsigned j = 0; j < 16; ++j) { const unsigned c = xb_ld(&bar[XB_XCNT(j)]); sum += c; cnt += (c > 0u) ? 1u : 0u; mine = (j == x) ? c : mine; }
        if (sum == G) break;
        __builtin_amdgcn_s_sleep(1);
        if ((++sp & 255u) == 0u) { if (xb_ld(&bar[XB_TMO])) break; if (sp > XB_SPIN_CAP) { atomicAdd(&bar[XB_TMO], 1u); break; } }
    }
    nloc = mine > 0u ? mine : 1u; nx = cnt > 0u ? cnt : 1u;
}
__device__ __forceinline__ void xcd_barrier(const XcdBarrier& b) {
    asm volatile("s_waitcnt vmcnt(0)" ::: "memory");
    __syncthreads();
    if (threadIdx.x == 0) {
        unsigned* bar = b.bar;
        __builtin_amdgcn_s_waitcnt(0);
        unsigned nloc = b.st[0], nx = b.st[1];
        if (nloc == 0u) { xcd_barrier_complete(bar, b.x, nloc, nx); b.st[0] = nloc; b.st[1] = nx; }
        const unsigned old = xb_add(&bar[XB_XSUB(b.x)], 1u);
        const unsigned gen = old / nloc;
        if (old + 1u == (gen + 1u) * nloc) {
            __builtin_amdgcn_fence(__ATOMIC_RELEASE, "agent");
            asm volatile("s_waitcnt vmcnt(0)" ::: "memory");
            const unsigned og = xb_add(&bar[XB_TOP], 1u);
            const unsigned tg = og / nx;
            if (og + 1u == (tg + 1u) * nx) xb_add(&bar[XB_TOPGEN], 1u);
            else XB_SPIN(xb_ld(&bar[XB_TOPGEN]) == tg, bar);
            __builtin_amdgcn_fence(__ATOMIC_ACQUIRE, "agent");
            xb_add(&bar[XB_XGEN(b.x)], 1u);
            asm volatile("s_waitcnt vmcnt(0)" ::: "memory");
        } else {
            XB_SPIN(xb_ld(&bar[XB_XGEN(b.x)]) == gen, bar);
            __builtin_amdgcn_fence(__ATOMIC_ACQUIRE, "agent");
            asm volatile("s_waitcnt vmcnt(0)" ::: "memory");
        }
    }
    __syncthreads();
}

struct Args {
    const float* in[30];
    float* out; unsigned char* ws;
    int ph_lo, ph_hi, li, pad;
};
enum { I_XP = 0, I_XS, I_STATE, I_C, I_CCTX, I_WMOD, I_BMOD, I_N1G, I_WIN, I_MU, I_W0, I_W2, I_A0, I_A2, I_G2, I_KK, I_KA, I_RK, I_GNW, I_GNB, I_LNG, I_LNB, I_WSP, I_BSP, I_WOUT, I_N2G, I_WG, I_WU, I_WD, I_FNG };

struct Frame {
    LAS unsigned char* lds;
    int tid, lane, wave, G, bx;
    const float* const* in;
    float* out; unsigned char* ws;
};

struct EpiP {
    static constexpr bool PERM = true, AFTER_DRAIN = false;
    bf16* O; int ldc; int gelu_from;
    __device__ __forceinline__ void operator()(const f32x4 (&acc)[2][2][4][2], const pg8::Unit& u, int wr, int wc, int fr, int fq) const {
        const int row0 = u.pm * 256 + wr * 64 + fr, col0 = u.pn * 256 + wc * 32 + 8 * fq;
#pragma unroll
        for (int ai = 0; ai < 2; ++ai)
#pragma unroll
            for (int m = 0; m < 4; ++m) { bf16* rowp = O + (size_t)(row0 + ai * 128 + m * 16) * ldc + col0;
#pragma unroll
                for (int bj = 0; bj < 2; ++bj) { f32x4 v0 = acc[ai][bj][m][0], v1 = acc[ai][bj][m][1];
                    if (col0 + bj * 128 >= gelu_from) {
#pragma unroll
                        for (int j = 0; j < 4; ++j) { v0[j] = gelu_tanh(v0[j]); v1[j] = gelu_tanh(v1[j]); } }
                    u32x4 w; w.x = pg8::cvt_pk_bf16(v0[0], v0[1]); w.y = pg8::cvt_pk_bf16(v0[2], v0[3]); w.z = pg8::cvt_pk_bf16(v1[0], v1[1]); w.w = pg8::cvt_pk_bf16(v1[2], v1[3]);
                    *(u32x4*)(rowp + bj * 128) = w; } }
    }
};
struct EpiRes {
    static constexpr bool PERM = false, AFTER_DRAIN = false;
    const float* xlo; const float* xhi; float* xout; const float* modl; int goff, nk_full; float* parts; unsigned* cnts;
    __device__ __forceinline__ void operator()(const f32x4 (&acc)[2][2][4][2], const pg8::Unit& u, int wr, int wc, int fr, int fq) const {
        const int pm = u.pm; const int midx = pm < 16 ? 0 : 1 + ((pm - 16) >> 4); const int role = u.nk == nk_full ? 0 : (u.k0 == 0 ? 1 : 2);
        float* part = parts + (size_t)pm * 256 * D;
        unsigned* cnt = cnts + (size_t)(pm * 8 + u.pn) * 64;
        if (role == 1) {
            const unsigned long long t0 = __builtin_amdgcn_s_memrealtime();
            while ((unsigned)__builtin_amdgcn_readfirstlane(__hip_atomic_load(cnt, __ATOMIC_RELAXED, __HIP_MEMORY_SCOPE_AGENT)) < 8u) { if (__builtin_amdgcn_s_memrealtime() - t0 > 2000000ull) break; __builtin_amdgcn_s_sleep(2); }
            __builtin_amdgcn_fence(__ATOMIC_ACQUIRE, "agent"); asm volatile("s_waitcnt vmcnt(0)" ::: "memory"); }
        const float* gv = modl + (size_t)midx * MODW + goff;
        const float* base = pm < 16 ? xlo + (size_t)pm * 256 * D : xhi + (size_t)(pm - 16) * 256 * D;
        float* ob = xout + (size_t)pm * 256 * D;
        const int col0 = u.pn * 256 + wc * 32 + 4 * fq;
        f32x4 gvv[2][2];
#pragma unroll
        for (int bj = 0; bj < 2; ++bj)
#pragma unroll
            for (int n = 0; n < 2; ++n) gvv[bj][n] = *(const f32x4*)(gv + col0 + bj * 128 + n * 16);
#pragma unroll
        for (int ai = 0; ai < 2; ++ai)
#pragma unroll
            for (int m = 0; m < 4; ++m) { const size_t off = (size_t)(ai * 128 + wr * 64 + m * 16 + fr) * D + col0;
#pragma unroll
                for (int bj = 0; bj < 2; ++bj)
#pragma unroll
                    for (int n = 0; n < 2; ++n) { const size_t o = off + bj * 128 + n * 16;
                        if (role == 2) {
                            const f32x4 a = gvv[bj][n] * acc[ai][bj][m][n]; unsigned long long* q = (unsigned long long*)(part + o);
                            __hip_atomic_store(q, ((unsigned long long)__float_as_uint(a[1]) << 32) | __float_as_uint(a[0]), __ATOMIC_RELAXED, __HIP_MEMORY_SCOPE_AGENT);
                            __hip_atomic_store(q + 1, ((unsigned long long)__float_as_uint(a[3]) << 32) | __float_as_uint(a[2]), __ATOMIC_RELAXED, __HIP_MEMORY_SCOPE_AGENT); }
                        else { f32x4 xo = *(const f32x4*)(base + o);
                            if (role == 1) xo += *(const f32x4*)(part + o);
                            *(f32x4*)(ob + o) = xo + gvv[bj][n] * acc[ai][bj][m][n]; } }
                if (m & 1) asm volatile("" ::: "memory"); }
        if (role == 2) { asm volatile("s_waitcnt vmcnt(0)" ::: "memory"); if (fr == 0 && fq == 0) __hip_atomic_fetch_add(cnt, 1u, __ATOMIC_RELAXED, __HIP_MEMORY_SCOPE_AGENT); }
    }
};
struct EpiSwi {
    static constexpr bool PERM = true, AFTER_DRAIN = false;
    bf16* O; int ldc;
    __device__ __forceinline__ void operator()(const f32x4 (&acc)[2][2][4][2], const pg8::Unit& u, int wr, int wc, int fr, int fq) const {
        const int row0 = u.pm * 256 + wr * 64 + fr, col0 = u.pn * 128 + wc * 32 + 8 * fq;
#pragma unroll
        for (int ai = 0; ai < 2; ++ai)
#pragma unroll
            for (int m = 0; m < 4; ++m) { bf16* rowp = O + (size_t)(row0 + ai * 128 + m * 16) * ldc + col0;
                float h[8];
#pragma unroll
                for (int n = 0; n < 2; ++n)
#pragma unroll
                    for (int j = 0; j < 4; ++j) { const float gt = acc[ai][0][m][n][j], up = acc[ai][1][m][n][j]; h[n * 4 + j] = gt * fsigmoid(gt) * up; }
                u32x4 w; w.x = pg8::cvt_pk_bf16(h[0], h[1]); w.y = pg8::cvt_pk_bf16(h[2], h[3]); w.z = pg8::cvt_pk_bf16(h[4], h[5]); w.w = pg8::cvt_pk_bf16(h[6], h[7]);
                *(u32x4*)rowp = w; }
    }
};

template <int MAP>
__device__ __forceinline__ void tr_item(const float* W, int K, int N, bf16* WT, LAS float* scr, int item, int lane) {
    const int nblk = N / 32, kb = item / nblk, nb = item % nblk, k0 = 64 * kb, n0 = 32 * nb;
#pragma unroll 8
    for (int i = 0; i < 32; ++i) { const int kk = 2 * i + (lane >> 5); scr[kk * 33 + (lane & 31)] = W[(size_t)(k0 + kk) * N + n0 + (lane & 31)]; }
    LDS_WAIT(); asm volatile("" ::: "memory");
    const int c = lane & 7;
#pragma unroll
    for (int j = 0; j < 4; ++j) { const int n = (lane >> 3) + 8 * j; const LAS float* s = scr + (8 * c) * 33 + n;
        u32x4 o; o.x = pk2(s[0 * 33], s[1 * 33]); o.y = pk2(s[2 * 33], s[3 * 33]); o.z = pk2(s[4 * 33], s[5 * 33]); o.w = pk2(s[6 * 33], s[7 * 33]);
        const int nn = n0 + n; const int orow = MAP == 0 ? nn : (256 * (nn >> 7) + (nn & 127) + (MAP == 2 ? 128 : 0));
        *(u32x4*)(WT + (size_t)orow * K + k0 + 8 * c) = o; }
    LDS_WAIT(); asm volatile("" ::: "memory");
}
__device__ __forceinline__ void p0_prologue(Frame& F) {
    PH_LOCALS(F);
    LAS float* scr = (LAS float*)(F.lds + wave * 16384);
    const int gw = bx * NWAVES + wave, NGW = G * NWAVES;
    constexpr int I_IN = (D / 64) * (PIN / 32), I_OUT = (D / 64) * (D / 32), I_GU = (D / 64) * (DFF / 32), I_DN = (DFF / 64) * (D / 32);
    constexpr int PL = I_IN + I_OUT + 2 * I_GU + I_DN;
    for (int it = gw; it < NL * PL; it += NGW) {
        const int l = it / PL; int r = it % PL;
        if (r < I_IN) { tr_item<0>(F.in[I_WIN] + (size_t)l * D * PIN, D, PIN, (bf16*)(F.ws + WS_WIN + l * SZ_WIN), scr, r, lane); continue; } r -= I_IN;
        if (r < I_OUT) { tr_item<0>(F.in[I_WOUT] + (size_t)l * D * D, D, D, (bf16*)(F.ws + WS_WOUT + l * SZ_WOUT), scr, r, lane); continue; } r -= I_OUT;
        if (r < I_GU) { tr_item<1>(F.in[I_WG] + (size_t)l * D * DFF, D, DFF, (bf16*)(F.ws + WS_WGU + l * SZ_WGU), scr, r, lane); continue; } r -= I_GU;
        if (r < I_GU) { tr_item<2>(F.in[I_WU] + (size_t)l * D * DFF, D, DFF, (bf16*)(F.ws + WS_WGU + l * SZ_WGU), scr, r, lane); continue; } r -= I_GU;
        tr_item<0>(F.in[I_WD] + (size_t)l * DFF * D, DFF, D, (bf16*)(F.ws + WS_WD + l * SZ_WD), scr, r, lane);
    }
    const int gt = bx * 512 + tid, NGT = G * 512;
    { constexpr int PADV = (PINP - PIN) * D * 2 / 16;
      for (int i = gt; i < NL * PADV; i += NGT) { const int l = i / PADV, r = i % PADV; ((u32x4*)(F.ws + WS_WIN + l * SZ_WIN + (size_t)PIN * D * 2))[r] = (u32x4){0u, 0u, 0u, 0u}; } }
    { bf16* w2t = (bf16*)(F.ws + WS_W2T); bf16* a2t = (bf16*)(F.ws + WS_A2T); bf16* g2t = (bf16*)(F.ws + WS_G2T); bf16* wsp = (bf16*)(F.ws + WS_WSP);
      for (int i = gt; i < NL * 2 * 1024 * 64; i += NGT) { const int k = i & 63, n = (i >> 6) & 1023, ld = i >> 16;
          w2t[i] = (bf16)f2bf(F.in[I_W2][((size_t)ld * 64 + k) * 1024 + n]); a2t[i] = (bf16)f2bf(F.in[I_A2][((size_t)ld * 64 + k) * 1024 + n]); }
      for (int i = gt; i < NL * 1024 * 160; i += NGT) { const int k = i % 160, n = (i / 160) & 1023, l = i / (160 * 1024);
          g2t[i] = (bf16)f2bf(F.in[I_G2][((size_t)l * 160 + k) * 1024 + n]); }
      for (int i = gt; i < NL * 8 * 128 * 128; i += NGT) wsp[i] = (bf16)f2bf(F.in[I_WSP][i]); }
    __syncthreads();
    { LAS float* sv = (LAS float*)F.lds;
      LAS float* red = (LAS float*)(F.lds + 40960);
      for (int i = tid; i < 5 * D; i += 512) { const int r = i / D, k = i % D; const float c = r == 0 ? F.in[I_CCTX][k] : F.in[I_C][(r - 1) * D + k]; sv[i] = c * fsigmoid(c); }
      __syncthreads();
      float* mod = (float*)(F.ws + WS_MOD);
      const int c4 = tid & 15, kg = tid >> 4;
      for (int item = bx; item < NL * (MODW / 64); item += G) {
          const int l = item / (MODW / 64), n0 = (item % (MODW / 64)) * 64;
          const float* W = F.in[I_WMOD] + (size_t)l * D * MODW + n0 + 4 * c4;
          f32x4 a[5];
#pragma unroll
          for (int r = 0; r < 5; ++r) a[r] = (f32x4){0.f, 0.f, 0.f, 0.f};
#pragma unroll 4
          for (int i = 0; i < 64; ++i) { const int k = i * 32 + kg; const f32x4 w = *(const f32x4*)(W + (size_t)k * MODW);
#pragma unroll
              for (int r = 0; r < 5; ++r) a[r] += w * sv[r * D + k]; }
#pragma unroll
          for (int r = 0; r < 5; ++r) *(LAS f32x4*)(red + (kg * 5 + r) * 64 + 4 * c4) = a[r];
          __syncthreads();
          if (tid < 320) { const int r = tid >> 6, n = tid & 63; float s = 0.f;
#pragma unroll 8
              for (int g = 0; g < 32; ++g) s += red[(g * 5 + r) * 64 + n];
              mod[((size_t)l * 5 + r) * MODW + n0 + n] = s + F.in[I_BMOD][(size_t)l * MODW + n0 + n]; }
          __syncthreads();
      } }
}

__device__ __forceinline__ void p_adaln(Frame& F, int l, int which, const float* xlo, const float* xhi) {
    PH_LOCALS(F); PH_LAYER(l);
    const int gw = bx * NWAVES + wave, NGW = G * NWAVES;
    const float* ng = (which == 0 ? F.in[I_N1G] : F.in[I_N2G]) + (size_t)l * D;
    const int shoff = which == 0 ? 0 : 3 * D, scoff = shoff + D;
    const float* mod = (const float*)(F.ws + WS_MOD);
    bf16* H = (bf16*)(F.ws + WS_H);
    for (int row = gw; row < M; row += NGW) {
        const float* xr = row < MCTX ? xlo + (size_t)row * D : xhi + (size_t)(row - MCTX) * D;
        const int midx = row < MCTX ? 0 : 1 + ((row - MCTX) >> 12);
        const float* md = mod + ((size_t)l * 5 + midx) * MODW;
        f32x4 v[8]; float ss = 0.f;
#pragma unroll
        for (int j = 0; j < 8; ++j) { v[j] = *(const f32x4*)(xr + 4 * lane + 256 * j); ss += (v[j].x * v[j].x + v[j].y * v[j].y) + (v[j].z * v[j].z + v[j].w * v[j].w); }
        WAVE_SUM(ss); const float rstd = 1.0f / sqrtf(ss * (1.0f / D) + RMS_EPS);
#pragma unroll
        for (int j = 0; j < 8; ++j) { const int c = 4 * lane + 256 * j;
            const f32x4 g4 = *(const f32x4*)(ng + c), sc = *(const f32x4*)(md + scoff + c), sh = *(const f32x4*)(md + shoff + c);
            const f32x4 o = v[j] * rstd * g4 * (sc + 1.0f) + sh;
            u32x2 w; w.x = pk2(o.x, o.y); w.y = pk2(o.z, o.w);
            *(u32x2*)(H + (size_t)row * D + c) = w; }
    }
}

__device__ __forceinline__ void load_shifted8(const bf16* P, const float* mu, int row, int col, float (&o)[8]) {
    float g[8]; unpack8(*(const u32x4*)(P + (size_t)row * PINP + col), g);
    float a[8];
#pragma unroll
    for (int j = 0; j < 8; ++j) a[j] = g[j];
    int nrow[4]; bool has[4]; int nn;
    if (row < MCTX) { const int t = row & 255; nn = 2; nrow[0] = row - 1; has[0] = t > 0; nrow[1] = row + 1; has[1] = t < 255; nrow[2] = row; has[2] = false; nrow[3] = row; has[3] = false; }
    else { const int t = (row - MCTX) & 4095, gc = t & 63, gr = t >> 6; nn = 4;
        nrow[0] = row - 1; has[0] = gc > 0; nrow[1] = row + 1; has[1] = gc < 63; nrow[2] = row - 64; has[2] = gr > 0; nrow[3] = row + 64; has[3] = gr < 63; }
#pragma unroll
    for (int q = 0; q < 4; ++q) {
        if (q < nn) {
            float nb[8];
            if (has[q]) unpack8(*(const u32x4*)(P + (size_t)nrow[q] * PINP + col), nb);
            else {
#pragma unroll
                for (int j = 0; j < 8; ++j) nb[j] = 0.f; }
            const f32x4 m0 = *(const f32x4*)(mu + q * CSH + col), m1 = *(const f32x4*)(mu + q * CSH + col + 4);
#pragma unroll
            for (int j = 0; j < 4; ++j) { a[j] += m0[j] * (nb[j] - g[j]); a[4 + j] += m1[j] * (nb[4 + j] - g[4 + j]); }
        }
    }
#pragma unroll
    for (int j = 0; j < 8; ++j) o[j] = a[j];
}
__device__ __forceinline__ void p_shift(Frame& F, int l) {
    PH_LOCALS(F); PH_LAYER(l);
    const bf16* P = (const bf16*)(F.ws + WS_P); bf16* PS = (bf16*)(F.ws + WS_PS); bf16* LORA = (bf16*)(F.ws + WS_LORA);
    const float* mu = F.in[I_MU] + (size_t)l * 4 * CSH;
    constexpr int CG = CSH / 8;
    const int rpw = (M + G - 1) / G, rbeg = bx * rpw, rend = (rbeg + rpw < M) ? rbeg + rpw : M;
    if (tid < CG) {
        const int col = tid * 8; const int act = (col >= 3 * DA && col < 3 * DA + LW) ? 1 : (col >= 3 * DA + LW + LAA ? 2 : 0);
        f32x4 m[4][2];
#pragma unroll
        for (int q = 0; q < 4; ++q) { m[q][0] = *(const f32x4*)(mu + q * CSH + col); m[q][1] = *(const f32x4*)(mu + q * CSH + col + 4); }
        for (int r0 = rbeg; r0 < rend; r0 += 4) {
#pragma unroll
            for (int u = 0; u < 4; ++u) { const int row = r0 + u; if (row < rend) {
                const bf16* pc = P + (size_t)row * PINP + col;
                int nrow[4]; bool has[4]; int nn;
                if (row < MCTX) { const int t = row & 255; nn = 2; nrow[0] = -1; has[0] = t > 0; nrow[1] = 1; has[1] = t < 255; nrow[2] = 0; has[2] = false; nrow[3] = 0; has[3] = false; }
                else { const int t = (row - MCTX) & 4095, gc = t & 63, gr = t >> 6; nn = 4; nrow[0] = -1; has[0] = gc > 0; nrow[1] = 1; has[1] = gc < 63; nrow[2] = -64; has[2] = gr > 0; nrow[3] = 64; has[3] = gr < 63; }
                u32x4 raw[5]; raw[0] = *(const u32x4*)pc;
#pragma unroll
                for (int q = 0; q < 4; ++q) raw[1 + q] = (q < nn && has[q]) ? *(const u32x4*)(pc + (ptrdiff_t)nrow[q] * PINP) : (u32x4){0u, 0u, 0u, 0u};
                float g[8], a[8]; unpack8(raw[0], g);
#pragma unroll
                for (int jx = 0; jx < 8; ++jx) a[jx] = g[jx];
#pragma unroll
                for (int q = 0; q < 4; ++q) if (q < nn) { float nb[8]; unpack8(raw[1 + q], nb);
#pragma unroll
                    for (int jx = 0; jx < 4; ++jx) { a[jx] += m[q][0][jx] * (nb[jx] - g[jx]); a[4 + jx] += m[q][1][jx] * (nb[4 + jx] - g[4 + jx]); } }
                if (act == 1) {
#pragma unroll
                    for (int jx = 0; jx < 8; ++jx) a[jx] = ftanh(a[jx]); }
                else if (act == 2) {
#pragma unroll
                    for (int jx = 0; jx < 8; ++jx) a[jx] = fsigmoid(a[jx]); }
                if (col >= 3 * DA) { const int cgl = (col - 3 * DA) >> 3;
                    *(u32x4*)(LORA + ((((size_t)(row >> 4) * 9 + (cgl >> 2)) * 64 + 16 * (cgl & 3) + (row & 15)) << 3)) = pack8(a); }
                else *(u32x4*)(PS + (size_t)row * CSH + col) = pack8(a); } }
        }
    }
}

#define F4Z ((f32x4){0.f, 0.f, 0.f, 0.f})
__device__ __forceinline__ u32x2 pk4(const f32x4 a) { u32x2 w; w.x = pk2(a[0], a[1]); w.y = pk2(a[2], a[3]); return w; }
#define LBAR() do { asm volatile("s_waitcnt lgkmcnt(0)" ::: "memory"); __builtin_amdgcn_s_barrier(); asm volatile("" ::: "memory"); } while (0)
constexpr int VTS = 136;
typedef short s16x4g __attribute__((ext_vector_type(4)));
__device__ __forceinline__ bf16x8 frag_tr_ld(const LAS bf16* X, int ld, int kbase, int c0, int fr, int fq) {
    const LAS bf16* p = X + (kbase + 8 * fq + (fr >> 2)) * ld + c0 + 4 * (fr & 3);
    const s16x4g lo = __builtin_amdgcn_ds_read_tr16_b64_v4i16((LAS s16x4g*)p);
    const s16x4g hi = __builtin_amdgcn_ds_read_tr16_b64_v4i16((LAS s16x4g*)(p + 4 * ld));
    return (bf16x8){lo[0], lo[1], lo[2], lo[3], hi[0], hi[1], hi[2], hi[3]};
}
__device__ __forceinline__ void p_gmlp(Frame& F, int l, int slot, int nslots) {
    PH_LOCALS(F); PH_LAYER(l); (void)bx; (void)G;
    const bf16* P = (const bf16*)(F.ws + WS_P); bf16* O = (bf16*)(F.ws + WS_O);
    const bf16* wsp = (const bf16*)(F.ws + WS_WSP) + (size_t)l * 8 * 128 * 128;
    LAS bf16* VN = (LAS bf16*)F.lds;
    LAS bf16* ST = (LAS bf16*)(F.lds + 34816);
    const int fr = lane & 15, fq = lane >> 4;
    constexpr int NIT = (M / 128) * NG;
    const int jrow = tid >> 2, q4 = tid & 3;
    u32x4 pvv[4];
#define GM_ISSUE(item_) do { const bf16* src_ = P + (size_t)(((item_) >> 3) * 128 + jrow) * PINP + CSH + DB + 128 * ((item_) & 7) + 32 * q4; \
        _Pragma("unroll") for (int i_ = 0; i_ < 4; ++i_) pvv[i_] = *(const u32x4*)(src_ + 8 * i_); } while (0)
    if (slot < 0) return;
    LBAR();
    if (slot < NIT) GM_ISSUE(slot);
    for (int item = slot; item < NIT; item += nslots) {
        const int cb = item >> 3, g = item & 7, R0 = cb * 128;
        u32x4 pu[4]; { const bf16* up = P + (size_t)(R0 + jrow) * PINP + CSH + 128 * g + 32 * q4;
#pragma unroll
            for (int i = 0; i < 4; ++i) pu[i] = *(const u32x4*)(up + 8 * i); }
        bf16x8 bw[4]; { const bf16* wa = wsp + ((size_t)g * 128 + 16 * wave + fr) * 128 + 8 * fq;
#pragma unroll
            for (int ks = 0; ks < 4; ++ks) bw[ks] = *(const bf16x8*)(wa + 32 * ks); }
        const float bsp = F.in[I_BSP][((size_t)l * 8 + g) * 128 + jrow];
        { float v[32];
#pragma unroll
          for (int i = 0; i < 4; ++i) { float f[8]; unpack8(pvv[i], f);
#pragma unroll
              for (int jj = 0; jj < 8; ++jj) v[8 * i + jj] = f[jj]; }
          float s = 0.f;
#pragma unroll
          for (int i = 0; i < 32; ++i) s += v[i];
          s += SHX(s, 1); s += SHX(s, 2);
          const float mean = s * (1.0f / 128.0f); float qq = 0.f;
#pragma unroll
          for (int i = 0; i < 32; ++i) { v[i] -= mean; qq += v[i] * v[i]; }
          qq += SHX(qq, 1); qq += SHX(qq, 2);
          const float rstd = 1.0f / sqrtf(qq * (1.0f / 128.0f) + LN_EPS);
          const float* lg = F.in[I_LNG] + ((size_t)l * 8 + g) * 128 + 32 * q4; const float* lb = F.in[I_LNB] + ((size_t)l * 8 + g) * 128 + 32 * q4;
#pragma unroll
          for (int i = 0; i < 4; ++i) { float o[8]; const f32x4 g0 = *(const f32x4*)(lg + 8 * i), g1 = *(const f32x4*)(lg + 8 * i + 4), b0 = *(const f32x4*)(lb + 8 * i), b1 = *(const f32x4*)(lb + 8 * i + 4);
#pragma unroll
              for (int jj = 0; jj < 4; ++jj) { o[jj] = v[8 * i + jj] * rstd * g0[jj] + b0[jj]; o[4 + jj] = v[8 * i + 4 + jj] * rstd * g1[jj] + b1[jj]; }
              *(LAS u32x4*)(VN + jrow * VTS + 32 * q4 + 8 * i) = pack8(o); } }
        if (item + nslots < NIT) GM_ISSUE(item + nslots);
        LBAR();
#pragma unroll
        for (int mt = 0; mt < 8; ++mt) { f32x4 acc = F4Z;
#pragma unroll
            for (int ks = 0; ks < 4; ++ks) acc = __builtin_amdgcn_mfma_f32_16x16x32_bf16(frag_tr_ld(VN, VTS, 32 * ks, 16 * mt, fr, fq), bw[ks], acc, 0, 0, 0);
            *(LAS u32x2*)(ST + (16 * wave + fr) * VTS + 16 * mt + 4 * fq) = pk4(acc); }
        LBAR();
        { bf16* op = O + (size_t)(R0 + jrow) * D + DA + 128 * g + 32 * q4;
#pragma unroll
          for (int i = 0; i < 4; ++i) { float sv[8], uv[8], o[8]; unpack8(*(const LAS u32x4*)(ST + jrow * VTS + 32 * q4 + 8 * i), sv); unpack8(pu[i], uv);
#pragma unroll
              for (int jj = 0; jj < 8; ++jj) o[jj] = uv[jj] * (sv[jj] + bsp);
              *(u32x4*)(op + 8 * i) = pack8(o); } }
    }
    LBAR();
#undef GM_ISSUE
}

constexpr int T16B = 9216, LD16 = 72, LD32 = 68;
#define SLOT(i) ((LAS bf16*)(lds + (i) * T16B))
#define SLOTF(i) ((LAS float*)(lds + (i) * T16B))
template <int NK>
__device__ __forceinline__ f32x4 tile_mm(const LAS bf16* A, int lda, const LAS bf16* B, int ldb, int fr, int fq, f32x4 acc) {
#pragma unroll
    for (int ks = 0; ks < NK; ++ks) { const bf16x8 a = *(const LAS bf16x8*)(A + fr * lda + 8 * fq + 32 * ks); const bf16x8 b = *(const LAS bf16x8*)(B + fr * ldb + 8 * fq + 32 * ks);
        acc = __builtin_amdgcn_mfma_f32_16x16x32_bf16(a, b, acc, 0, 0, 0); }
    return acc;
}
__device__ __forceinline__ void st_nat(LAS bf16* dst, int n0, int m0, int fr, int fq, const f32x4 a) { *(LAS u32x2*)(dst + (n0 + fr) * LD16 + m0 + 4 * fq) = pk4(a); }
__device__ __forceinline__ void st_rm(LAS bf16* dst, int n0, int m0, int fr, int fq, const f32x4 a) {
#pragma unroll
    for (int r = 0; r < 4; ++r) dst[(m0 + 4 * fq + r) * LD16 + n0 + fr] = (bf16)f2bf(a[r]); }
__device__ __forceinline__ f32x4 ld4bf(const LAS bf16* p) { const u32x2 w = *(const LAS u32x2*)p; return (f32x4){__uint_as_float(w.x << 16), __uint_as_float(w.x & 0xffff0000u), __uint_as_float(w.y << 16), __uint_as_float(w.y & 0xffff0000u)}; }

__device__ __forceinline__ int fm_off(int n0, int m0, int fr, int fq) { return ((((n0 >> 4) * 2 + (m0 >> 5)) * 64 + (2 * ((m0 >> 4) & 1) + (fq >> 1)) * 16 + fr) << 3) + 4 * (fq & 1); }
typedef short s16x4 __attribute__((ext_vector_type(4)));
__device__ __forceinline__ bf16x8 frag_tr(const LAS bf16* X, int kbase, int c0, int fr, int fq) {
    const LAS bf16* p = X + (kbase + 8 * fq + (fr >> 2)) * LD16 + c0 + 4 * (fr & 3);
    const s16x4 lo = __builtin_amdgcn_ds_read_tr16_b64_v4i16((LAS s16x4*)p);
    const s16x4 hi = __builtin_amdgcn_ds_read_tr16_b64_v4i16((LAS s16x4*)(p + 4 * LD16));
    return (bf16x8){lo[0], lo[1], lo[2], lo[3], hi[0], hi[1], hi[2], hi[3]};
}
__device__ __forceinline__ bf16x8 frag_rm(const LAS bf16* X, int r0, int ks, int fr, int fq) { return *(const LAS bf16x8*)(X + (r0 + fr) * LD16 + 8 * fq + 32 * ks); }
__device__ __forceinline__ f32x4 mm2(const bf16x8 (&a)[2], const bf16x8 (&b)[2], f32x4 acc) {
    acc = __builtin_amdgcn_mfma_f32_16x16x32_bf16(a[0], b[0], acc, 0, 0, 0); return __builtin_amdgcn_mfma_f32_16x16x32_bf16(a[1], b[1], acc, 0, 0, 0); }
__device__ __forceinline__ bf16x8 as_frag(const u32x4 q) { return __builtin_bit_cast(bf16x8, q); }

__device__ __forceinline__ void p_chunkA(Frame& F, int l) {
    PH_LOCALS(F); PH_LAYER(l);
    LAS unsigned char* lds = F.lds;
    const int lane0 = lane, lane00 = lane;
#define STG int lane_ = lane0; asm volatile("" : "+v"(lane_)); const int lane = lane_, fr = lane_ & 15, fq = lane_ >> 4, tid = wave * 64 + lane_, mt = wave >> 1, m0 = 16 * mt, np = (wave & 1) * 2; \
    (void)lane; (void)fr; (void)fq; (void)tid; (void)mt; (void)m0; (void)np;
    const bf16* PS = (const bf16*)(F.ws + WS_PS);
    const bf16* w2t = (const bf16*)(F.ws + WS_W2T) + (size_t)l * 2 * 1024 * 64;
    const bf16* a2t = (const bf16*)(F.ws + WS_A2T) + (size_t)l * 2 * 1024 * 64;
    const bf16* g2t = (const bf16*)(F.ws + WS_G2T) + (size_t)l * 1024 * 160;
    bf16* GATE = (bf16*)(F.ws + WS_GATE); float* BONUS = (float*)(F.ws + WS_BONUS);
    LAS float* gC = (LAS float*)(lds + 14 * T16B);
    LAS float* BT = (LAS float*)(lds + 14 * T16B + 256);
    u32x4 pf_w[2], pf_a[2], pf_g[5], pf_r, pf_k, pf_v; bf16x8 Bg[2][5], Bw[2][2], Ba[2][2]; float biw[2], bia[2];
#define CA_ISSUE(item_, d_) do { const int ci_ = (item_) >> 4, h_ = (item_) & 15, R0_ = ci_ * 64; int lane0 = lane00; asm volatile("" : "+v"(lane0)); \
        const bf16* arow_ = (const bf16*)(F.ws + WS_LORA) + ((((size_t)(R0_ >> 4) + (wave >> 1)) * 9 * 64 + lane0) << 3); \
        pf_w[0] = *(const u32x4*)arow_; pf_w[1] = *(const u32x4*)(arow_ + 512); pf_a[0] = *(const u32x4*)(arow_ + 1024); pf_a[1] = *(const u32x4*)(arow_ + 1536); \
        if ((d_) == 0) { _Pragma("unroll") for (int ks_ = 0; ks_ < 5; ++ks_) { pf_g[ks_] = *(const u32x4*)(arow_ + 2048 + 512 * ks_); \
            _Pragma("unroll") for (int nn_ = 0; nn_ < 2; ++nn_) Bg[nn_][ks_] = *(const bf16x8*)(g2t + (size_t)(64 * h_ + 16 * ((wave & 1) * 2 + nn_) + (lane0 & 15)) * 160 + 8 * (lane0 >> 4) + 32 * ks_); } } \
        _Pragma("unroll") for (int nn_ = 0; nn_ < 2; ++nn_) { const int n_ = 64 * h_ + 16 * ((wave & 1) * 2 + nn_) + (lane0 & 15); \
            biw[nn_] = F.in[I_W0][((size_t)l * 2 + (d_)) * DA + n_]; bia[nn_] = F.in[I_A0][((size_t)l * 2 + (d_)) * DA + n_]; \
            _Pragma("unroll") for (int ks_ = 0; ks_ < 2; ++ks_) { Bw[nn_][ks_] = *(const bf16x8*)(w2t + ((size_t)(d_) * 1024 + n_) * 64 + 8 * (lane0 >> 4) + 32 * ks_); Ba[nn_][ks_] = *(const bf16x8*)(a2t + ((size_t)(d_) * 1024 + n_) * 64 + 8 * (lane0 >> 4) + 32 * ks_); } } \
        const int tid_ = wave * 64 + lane0, tau_ = tid_ >> 3, pos_ = (d_) ? 63 - tau_ : tau_; const bf16* rrow_ = PS + (size_t)(R0_ + pos_) * CSH + 64 * h_ + (tid_ & 7) * 8; \
        pf_r = *(const u32x4*)rrow_; pf_k = *(const u32x4*)(rrow_ + DA); pf_v = *(const u32x4*)(rrow_ + 2 * DA); } while (0)
    if (bx < (M / 64) * NH) CA_ISSUE(bx, 0);
    int hcur = -1;
    LAS float* HC = (LAS float*)(lds + 14 * T16B + 1280);
    for (int item = bx; item < (M / 64) * NH; item += G) {
        const int ci = item >> 4, h = item & 15, R0 = ci * 64;
        { (void)hcur;
            LBAR();
            { const int t_ = wave * 64 + lane0; if (t_ < 192) { const int w_ = t_ >> 6, c_ = t_ & 63; HC[t_] = (w_ == 0 ? F.in[I_KK] : (w_ == 1 ? F.in[I_KA] : F.in[I_RK]))[(size_t)l * DA + 64 * h + c_]; } } }
#pragma unroll
        for (int d = 0; d < 2; ++d) {
            const size_t qi = ((size_t)ci * 16 + h) * 2 + d;
            const bf16x8 cBw[2][2] = {{Bw[0][0], Bw[0][1]}, {Bw[1][0], Bw[1][1]}}, cBa[2][2] = {{Ba[0][0], Ba[0][1]}, {Ba[1][0], Ba[1][1]}}; const float cbw[2] = {biw[0], biw[1]}, cba[2] = {bia[0], bia[1]};
            u32x4 cw[2] = {pf_w[0], pf_w[1]}, ca[2] = {pf_a[0], pf_a[1]}, cg[5] = {pf_g[0], pf_g[1], pf_g[2], pf_g[3], pf_g[4]}; const u32x4 cr = pf_r, ck = pf_k, cv = pf_v;
            for (int repA = 0; repA < (PROBE_SUB == 1 ? 2 : 1); ++repA) {
            { STG; LAS float* AL = SLOTF(5); LAS float* LW = SLOTF(7);
              bf16x8 aw[2], aa[2];
#pragma unroll
              for (int ks = 0; ks < 2; ++ks) { aw[ks] = as_frag(cw[ks]); aa[ks] = as_frag(ca[ks]); }
#pragma unroll
              for (int nn = 0; nn < 2; ++nn) { const int nl = 16 * (np + nn) + fr, n = 64 * h + nl;
                  const f32x4 accw = mm2(aw, cBw[nn], F4Z), acca = mm2(aa, cBa[nn], F4Z);
                  const float biasw = cbw[nn], biasa = cba[nn]; (void)n;
                  float lw[4], c[4];
#pragma unroll
                  for (int r = 0; r < 4; ++r) lw[r] = -0.8750345269f * fsigmoid(biasw + accw[r]);
                  if (d == 0) { c[0] = lw[0]; c[1] = c[0] + lw[1]; c[2] = c[1] + lw[2]; c[3] = c[2] + lw[3]; }
                  else { c[3] = lw[3]; c[2] = c[3] + lw[2]; c[1] = c[2] + lw[1]; c[0] = c[1] + lw[0]; }
                  const float tot = d == 0 ? c[3] : c[0];
                  const float t1 = SHX(tot, 16), t2 = SHX(tot, 32), t3 = SHX(tot, 48);
                  float off;
                  { const int sg = d ? -1 : 1, q1 = fq ^ 1, q2 = fq ^ 2, q3 = fq ^ 3;
                    const int k1 = (sg * (q1 - fq)) >> 31, k2 = (sg * (q2 - fq)) >> 31, k3 = (sg * (q3 - fq)) >> 31;
                    off = (__int_as_float(__float_as_int(t1) & k1) + __int_as_float(__float_as_int(t2) & k2)) + __int_as_float(__float_as_int(t3) & k3); }
#pragma unroll
                  for (int r = 0; r < 4; ++r) { const int pos = m0 + 4 * fq + r, tau = d ? 63 - pos : pos;
                      LW[tau * LD32 + nl] = c[r] + off; AL[tau * LD32 + nl] = fsigmoid(biasa + acca[r]); }
                  if (fq == 0) BT[(d ? 3 - mt : mt) * 64 + nl] = (tot + t1) + (t2 + t3); }
              if (d == 0) {
                  bf16x8 ag[5];
#pragma unroll
                  for (int ks = 0; ks < 5; ++ks) ag[ks] = as_frag(cg[ks]);
#pragma unroll
                  for (int nn = 0; nn < 2; ++nn) { const int n = 64 * h + 16 * (np + nn) + fr; f32x4 acc = F4Z;
#pragma unroll
                      for (int ks = 0; ks < 5; ++ks) acc = __builtin_amdgcn_mfma_f32_16x16x32_bf16(ag[ks], Bg[nn][ks], acc, 0, 0, 0);
#pragma unroll
                      for (int r = 0; r < 4; ++r) SLOT(11)[(m0 + 4 * fq + r) * LD16 + 16 * (np + nn) + fr] = (bf16)f2bf(acc[r]); (void)n; } } }
            LBAR();
            { STG; const LAS float* AL = SLOTF(5); const LAS float* LW = SLOTF(7);
              const int tau = tid >> 3, c8 = (tid & 7) * 8, pos = d ? 63 - tau : tau, row = R0 + pos, blk = wave >> 1;
              f32x2 r[4], k[4];
              { const u32x4 q = cr; r[0] = (f32x2){__uint_as_float(q.x << 16), __uint_as_float(q.x & 0xffff0000u)}; r[1] = (f32x2){__uint_as_float(q.y << 16), __uint_as_float(q.y & 0xffff0000u)};
                r[2] = (f32x2){__uint_as_float(q.z << 16), __uint_as_float(q.z & 0xffff0000u)}; r[3] = (f32x2){__uint_as_float(q.w << 16), __uint_as_float(q.w & 0xffff0000u)}; }
              { const u32x4 q = ck; k[0] = (f32x2){__uint_as_float(q.x << 16), __uint_as_float(q.x & 0xffff0000u)}; k[1] = (f32x2){__uint_as_float(q.y << 16), __uint_as_float(q.y & 0xffff0000u)};
                k[2] = (f32x2){__uint_as_float(q.z << 16), __uint_as_float(q.z & 0xffff0000u)}; k[3] = (f32x2){__uint_as_float(q.w << 16), __uint_as_float(q.w & 0xffff0000u)}; }
              f32x2 offb[4], totC[4];
#pragma unroll
              for (int j = 0; j < 4; ++j) { offb[j] = (f32x2){0.f, 0.f}; totC[j] = (f32x2){0.f, 0.f}; }
#pragma unroll
              for (int b = 0; b < 4; ++b) { const f32x4 x0 = *(const LAS f32x4*)(BT + b * 64 + c8), x1 = *(const LAS f32x4*)(BT + b * 64 + c8 + 4);
                  const f32x2 y[4] = {{x0[0], x0[1]}, {x0[2], x0[3]}, {x1[0], x1[1]}, {x1[2], x1[3]}};
                  const float fb = b < blk ? 1.0f : 0.0f;
#pragma unroll
                  for (int j = 0; j < 4; ++j) { totC[j] += y[j]; offb[j] += y[j] * fb; } }
              f32x2 ckk[4], cka[4], crk[4];
              { const f32x4 a0 = *(const LAS f32x4*)(HC + c8), a1 = *(const LAS f32x4*)(HC + c8 + 4), b0 = *(const LAS f32x4*)(HC + 64 + c8), b1 = *(const LAS f32x4*)(HC + 64 + c8 + 4), c0 = *(const LAS f32x4*)(HC + 128 + c8), c1 = *(const LAS f32x4*)(HC + 128 + c8 + 4);
                ckk[0] = (f32x2){a0[0], a0[1]}; ckk[1] = (f32x2){a0[2], a0[3]}; ckk[2] = (f32x2){a1[0], a1[1]}; ckk[3] = (f32x2){a1[2], a1[3]};
                cka[0] = (f32x2){b0[0], b0[1]}; cka[1] = (f32x2){b0[2], b0[3]}; cka[2] = (f32x2){b1[0], b1[1]}; cka[3] = (f32x2){b1[2], b1[3]};
                crk[0] = (f32x2){c0[0], c0[1]}; crk[1] = (f32x2){c0[2], c0[3]}; crk[2] = (f32x2){c1[0], c1[1]}; crk[3] = (f32x2){c1[2], c1[3]}; }
              f32x2 kk[4], s2 = (f32x2){0.f, 0.f};
#pragma unroll
              for (int j = 0; j < 4; ++j) { kk[j] = k[j] * ckk[j]; s2 += kk[j] * kk[j]; }
              float ss = s2.x + s2.y;
              ss += SHX(ss, 1); ss += SHX(ss, 2); ss += SHX(ss, 4);
              const float rn = 1.0f / sqrtf(fmaxf(ss, 1e-24f));
              f32x2 alv[4], csv[4], csm[4];
              { const f32x4 a0 = *(const LAS f32x4*)(AL + tau * LD32 + c8), a1 = *(const LAS f32x4*)(AL + tau * LD32 + c8 + 4), c0 = *(const LAS f32x4*)(LW + tau * LD32 + c8), c1 = *(const LAS f32x4*)(LW + tau * LD32 + c8 + 4);
                const int tm = (tau & 15) ? tau - 1 : tau; f32x4 e0 = *(const LAS f32x4*)(LW + tm * LD32 + c8), e1 = *(const LAS f32x4*)(LW + tm * LD32 + c8 + 4);
                if ((tau & 15) == 0) { e0 = F4Z; e1 = F4Z; }
                alv[0] = (f32x2){a0[0], a0[1]}; alv[1] = (f32x2){a0[2], a0[3]}; alv[2] = (f32x2){a1[0], a1[1]}; alv[3] = (f32x2){a1[2], a1[3]};
                csv[0] = (f32x2){c0[0], c0[1]} + offb[0]; csv[1] = (f32x2){c0[2], c0[3]} + offb[1]; csv[2] = (f32x2){c1[0], c1[1]} + offb[2]; csv[3] = (f32x2){c1[2], c1[3]} + offb[3];
                csm[0] = (f32x2){e0[0], e0[1]} + offb[0]; csm[1] = (f32x2){e0[2], e0[3]} + offb[1]; csm[2] = (f32x2){e1[0], e1[1]} + offb[2]; csm[3] = (f32x2){e1[2], e1[3]} + offb[3]; }
              f32x2 at[4], rt[4], bt[4], kt[4], bh[4], kh[4], bon2 = (f32x2){0.f, 0.f};
#pragma unroll
              for (int j = 0; j < 4; ++j) { const f32x2 al = alv[j], cs = csv[j], dh = totC[j] - cs;
                  const f32x2 kkn = kk[j] * rn, kd = k[j] * ((al - 1.0f) * cka[j] + 1.0f), bb = kkn * al;
                  bon2 += r[j] * kd * crk[j];
                  const f32x2 encs = (f32x2){__builtin_amdgcn_exp2f(-cs.x), __builtin_amdgcn_exp2f(-cs.y)}, eh = (f32x2){__builtin_amdgcn_exp2f(dh.x), __builtin_amdgcn_exp2f(dh.y)};
                  const f32x2 ecm = (f32x2){__builtin_amdgcn_exp2f(csm[j].x), __builtin_amdgcn_exp2f(csm[j].y)}, ecs = (f32x2){__builtin_amdgcn_exp2f(cs.x), __builtin_amdgcn_exp2f(cs.y)};
                  at[j] = -(ecm * kkn); rt[j] = ecs * r[j]; bt[j] = encs * bb; kt[j] = encs * kd; bh[j] = eh * bb; kh[j] = eh * kd; }
              if (tau == 63) {
#pragma unroll
                  for (int j = 0; j < 4; ++j) { gC[c8 + 2 * j] = __builtin_amdgcn_exp2f(totC[j].x); gC[c8 + 2 * j + 1] = __builtin_amdgcn_exp2f(totC[j].y); } }
#define PK8V(a) ((u32x4){pk2(a[0].x, a[0].y), pk2(a[1].x, a[1].y), pk2(a[2].x, a[2].y), pk2(a[3].x, a[3].y)})
              *(LAS u32x4*)(SLOT(0) + tau * LD16 + c8) = PK8V(at); *(LAS u32x4*)(SLOT(1) + tau * LD16 + c8) = PK8V(rt);
              *(LAS u32x4*)(SLOT(2) + tau * LD16 + c8) = PK8V(bt); *(LAS u32x4*)(SLOT(3) + tau * LD16 + c8) = PK8V(kt);
              *(LAS u32x4*)(SLOT(4) + tau * LD16 + c8) = PK8V(bh); *(LAS u32x4*)(SLOT(9) + tau * LD16 + c8) = PK8V(kh);
#undef PK8V
              *(LAS u32x4*)(SLOT(10) + tau * LD16 + c8) = cv;
              if (d == 0) *(u32x4*)(GATE + (size_t)row * DA + 64 * h + c8) = *(const LAS u32x4*)(SLOT(11) + pos * LD16 + c8);
              float bon = bon2.x + bon2.y;
              bon += SHX(bon, 1); bon += SHX(bon, 2); bon += SHX(bon, 4);
              BONUS[((size_t)d * M + row) * NH + h] = bon; }
            LBAR();
            }
            { int nitem = d == 0 ? item : item + G; const int nd = d ^ 1; if (nitem >= (M / 64) * NH) nitem = item; CA_ISSUE(nitem, nd); }
            for (int repB = 0; repB < (PROBE_SUB == 2 ? 2 : 1); ++repB) {
            { STG; bf16x8 aB[2], aA[2], aK[2];
#pragma unroll
              for (int ks = 0; ks < 2; ++ks) { aB[ks] = frag_rm(SLOT(2), m0, ks, fr, fq); aA[ks] = frag_rm(SLOT(0), m0, ks, fr, fq); aK[ks] = frag_rm(SLOT(3), m0, ks, fr, fq); }
#pragma unroll
              for (int nn = 0; nn < 2; ++nn) { const int n0 = 16 * (np + nn), n = n0 + fr; bf16x8 bA[2], bB[2], bK[2], bR[2];
#pragma unroll
                  for (int ks = 0; ks < 2; ++ks) { bA[ks] = frag_rm(SLOT(0), n0, ks, fr, fq); bB[ks] = frag_rm(SLOT(2), n0, ks, fr, fq); bK[ks] = frag_rm(SLOT(3), n0, ks, fr, fq); bR[ks] = frag_rm(SLOT(1), n0, ks, fr, fq); }
                  f32x4 p0 = mm2(aB, bA, F4Z), p1 = mm2(aA, bB, F4Z), p2 = mm2(aA, bK, F4Z), p3 = mm2(aB, bR, F4Z), p4 = mm2(aK, bR, F4Z), t0;
#pragma unroll
                  for (int r = 0; r < 4; ++r) { const int m = m0 + 4 * fq + r;
                      p0[r] = m < n ? p0[r] : 0.f; p1[r] = n < m ? p1[r] : 0.f; p2[r] = n < m ? p2[r] : 0.f; p3[r] = m <= n ? p3[r] : 0.f; p4[r] = m <= n ? p4[r] : 0.f;
                      t0[r] = p1[r] + (m == n ? 1.0f : 0.f); }
                  st_nat(SLOT(5), n0, m0, fr, fq, p0); st_nat(SLOT(6), n0, m0, fr, fq, p1); st_nat(SLOT(7), n0, m0, fr, fq, t0);
                  st_nat(SLOT(8), n0, m0, fr, fq, p2); st_nat(SLOT(11), n0, m0, fr, fq, p3); st_nat(SLOT(12), n0, m0, fr, fq, p4); } }
            LBAR();
#define MM1(a, b, c) __builtin_amdgcn_mfma_f32_16x16x32_bf16(a, b, c, 0, 0, 0)
            { STG; const int b = wave >> 2, bm0 = 32 * b + 16 * ((wave >> 1) & 1), bn0 = 32 * b + 16 * (wave & 1), oc = 32 * (1 - b) - 32 * b;
              const bf16x8 aT = frag_rm(SLOT(5), bm0, b, fr, fq), aR = frag_rm(SLOT(6), bm0, b, fr, fq), bR = frag_rm(SLOT(6), bn0, b, fr, fq), bT = frag_rm(SLOT(5), bn0, b, fr, fq);
              st_nat(SLOT(2), bn0, bm0, fr, fq, MM1(aT, bR, F4Z)); st_nat(SLOT(2), bn0, bm0 + oc, fr, fq, MM1(aR, bT, F4Z)); }
            LBAR();
#pragma unroll
            for (int kq = 1; kq <= 4; ++kq) {
                STG; const int b = wave >> 2, bm0 = 32 * b + 16 * ((wave >> 1) & 1), bn0 = 32 * b + 16 * (wave & 1), oc = 32 * (1 - b) - 32 * b;
                const int pin = (kq & 1) ? 2 : 3, pout = (kq & 1) ? 3 : 2, tin = (kq & 1) ? 7 : 13, tout = (kq & 1) ? 13 : 7;
                const bf16x8 aPT = frag_rm(SLOT(pin), bm0, 1 - b, fr, fq), bTn = frag_rm(SLOT(tin), bn0, b, fr, fq);
                st_nat(SLOT(tout), bn0, bm0, fr, fq, MM1(aPT, bTn, ld4bf(SLOT(tin) + (bn0 + fr) * LD16 + bm0 + 4 * fq)));
                if (kq < 4) { const bf16x8 aPR = frag_rm(SLOT(pin), bm0, b, fr, fq), bPR = frag_rm(SLOT(pin), bn0, b, fr, fq), bPT = frag_rm(SLOT(pin), bn0, 1 - b, fr, fq);
                    st_nat(SLOT(pout), bn0, bm0, fr, fq, MM1(aPT, bPR, F4Z));
                    st_nat(SLOT(pout), bn0, bm0 + oc, fr, fq, MM1(aPR, bPT, F4Z)); }
                LBAR();
            }
            { STG; if (wave < 4) { const int xm0 = 16 * ((wave >> 1) & 1), xn0 = 32 + 16 * (wave & 1);
                  const bf16x8 a = frag_rm(SLOT(6), xm0, 1, fr, fq), bb = frag_tr(SLOT(7), 32, xn0, fr, fq);
                  st_nat(SLOT(13), xn0, xm0, fr, fq, MM1(a, bb, F4Z)); } }
            LBAR();
            { STG; if (wave < 4) { const int tn0 = 32 + 16 * ((wave >> 1) & 1), tm0 = 16 * (wave & 1);
                  const bf16x8 a = frag_rm(SLOT(13), tn0, 0, fr, fq), bb = frag_rm(SLOT(7), tm0, 0, fr, fq);
                  st_nat(SLOT(7), tm0, tn0, fr, fq, MM1(a, bb, F4Z)); } }
            LBAR();
#undef MM1
            { STG; const int xt = wave, n0 = 16 * (xt & 3); bf16x8 b[2];
              if (xt < 4) { b[0] = frag_rm(SLOT(11), n0, 0, fr, fq); b[1] = frag_rm(SLOT(11), n0, 1, fr, fq); }
              else { b[0] = frag_tr(SLOT(4), 0, n0, fr, fq); b[1] = frag_tr(SLOT(4), 32, n0, fr, fq); }
#pragma unroll
              for (int mm = 0; mm < 4; ++mm) { bf16x8 a[2] = {frag_rm(SLOT(7), 16 * mm, 0, fr, fq), frag_rm(SLOT(7), 16 * mm, 1, fr, fq)};
                  st_nat(xt < 4 ? SLOT(5) : SLOT(6), n0, 16 * mm, fr, fq, mm2(a, b, F4Z)); } }
            LBAR();
            }
            for (int repC = 0; repC < (PROBE_SUB == 3 ? 2 : 1); ++repC) {
            { STG; bf16x8 aAt[2] = {frag_tr(SLOT(0), 0, m0, fr, fq), frag_tr(SLOT(0), 32, m0, fr, fq)}, aAk[2] = {frag_rm(SLOT(8), m0, 0, fr, fq), frag_rm(SLOT(8), m0, 1, fr, fq)};
              bf16* pyt = (bf16*)(F.ws + WS_PYT) + qi * 4096; bf16* qyt = (bf16*)(F.ws + WS_QYT) + qi * 4096; bf16* pst = (bf16*)(F.ws + WS_PST) + qi * 4096;
#pragma unroll
              for (int nn = 0; nn < 2; ++nn) { const int n0 = 16 * (np + nn), n = n0 + fr, mb = m0 + 4 * fq;
                  bf16x8 bRb[2] = {frag_rm(SLOT(5), n0, 0, fr, fq), frag_rm(SLOT(5), n0, 1, fr, fq)}, bBh[2] = {frag_rm(SLOT(6), n0, 0, fr, fq), frag_rm(SLOT(6), n0, 1, fr, fq)};
                  const f32x4 py = mm2(aAt, bRb, ld4bf(SLOT(1) + n * LD16 + mb)), qy = mm2(aAk, bRb, ld4bf(SLOT(12) + n * LD16 + mb));
                  f32x4 psi, qsi;
#pragma unroll
                  for (int r = 0; r < 4; ++r) { psi[r] = (mb + r == n) ? gC[n] : 0.f; qsi[r] = bf2f(SLOT(9)[(mb + r) * LD16 + n]); }
                  const f32x4 ps = mm2(aAt, bBh, psi), qs = mm2(aAk, bBh, qsi);
                  { const int fo = fm_off(n0, m0, fr, fq); *(u32x2*)(pyt + fo) = pk4(py); *(u32x2*)(qyt + fo) = pk4(qy); *(u32x2*)(pst + fo) = pk4(ps); }
                  st_nat(SLOT(2), n0, m0, fr, fq, qs); } }
            LBAR();
            { STG; bf16* nct = (bf16*)(F.ws + WS_NCT) + qi * 4096; bf16* vtg = (bf16*)(F.ws + WS_VTG) + qi * 4096;
              bf16x8 a[2] = {frag_rm(SLOT(2), m0, 0, fr, fq), frag_rm(SLOT(2), m0, 1, fr, fq)};
#pragma unroll
              for (int nn = 0; nn < 2; ++nn) { const int n0 = 16 * (np + nn); bf16x8 b[2] = {frag_tr(SLOT(10), 0, n0, fr, fq), frag_tr(SLOT(10), 32, n0, fr, fq)};
                  *(u32x2*)(nct + ((((n0 >> 4) * 4 + mt) * 64 + lane) << 2)) = pk4(mm2(a, b, F4Z));
                  if (nn == (mt >> 1)) { const bf16x8 bs = (mt & 1) ? b[1] : b[0]; *(bf16x8*)(vtg + ((((n0 >> 4) * 2 + (mt & 1)) * 64 + lane) << 3)) = bs; } } }
            LBAR();
            }
        }
    }
#undef STG
#undef CA_ISSUE
}

__device__ __forceinline__ void p_chunkB(Frame& F, int l) {
    PH_LOCALS(F); PH_LAYER(l);
    const int fr = lane & 15, fq = lane >> 4;
    LAS bf16* Sl = (LAS bf16*)(F.lds + wave * 2304);
    const bf16* PST = (const bf16*)(F.ws + WS_PST); const bf16* NCT = (const bf16*)(F.ws + WS_NCT); bf16* SC = (bf16*)(F.ws + WS_SC);
    for (int cp = bx; cp < 64; cp += G) {
        const int cslot = wave >> 2, chain = 2 * cp + cslot, vb = wave & 3, b = chain >> 5, h = (chain >> 1) & 15, d = chain & 1, cb = 64 + b * 64; constexpr int NC = 64;
        LAS bf16* AL = (LAS bf16*)(F.lds + 20480) + cslot * 3 * 4096;
        f32x4 S[4];
        { const float* src = F.in[I_STATE] + ((((size_t)b * NL + l) * 2 + d) * NH + h) * 4096 + (size_t)(16 * vb + fr) * 64 + 4 * fq;
#pragma unroll
          for (int T = 0; T < 4; ++T) S[T] = *(const f32x4*)(src + 16 * T); }
        bf16x8 Aq[8][2]; u32x2 Nq[8][4];
#define LB_QI(step) ((((size_t)(cb + (d ? NC - 1 - (step) : (step)))) * 16 + h) * 2 + d)
#define LB_LDA(u, step) do { const int st_ = (step) < NC ? (step) : NC - 1; const bf16* ps_ = PST + LB_QI(st_) * 4096 + vb * 1024 + lane * 8; Aq[u][0] = *(const bf16x8*)ps_; Aq[u][1] = *(const bf16x8*)(ps_ + 512); } while (0)
#define LB_LDN(u, step) do { const int st_ = (step) < NC ? (step) : NC - 1; const bf16* nc_ = NCT + LB_QI(st_) * 4096 + ((vb * 4 * 64 + lane) << 2); \
        _Pragma("unroll") for (int mt_ = 0; mt_ < 4; ++mt_) Nq[u][mt_] = *(const u32x2*)(nc_ + mt_ * 256); } while (0)
#pragma unroll
        for (int u = 0; u < 8; ++u) { LB_LDA(u, u); LB_LDN(u, u); }
        *(LAS bf16x8*)(AL + ((vb * 2 + 0) * 64 + lane) * 8) = Aq[0][0]; *(LAS bf16x8*)(AL + ((vb * 2 + 1) * 64 + lane) * 8) = Aq[0][1];
        LB_LDA(0, 8);
        for (int g = 0; g < NC; g += 8) {
#pragma unroll
            for (int u = 0; u < 8; ++u) {
                const int step = g + u; const size_t q = LB_QI(step); bf16* scg = SC + q * 4096;
#pragma unroll
                for (int T = 0; T < 4; ++T) { const u32x2 w = pk4(S[T]); *(LAS u32x2*)(Sl + fr * LD16 + 16 * T + 4 * fq) = w; *(u32x2*)(scg + fm_off(16 * vb, 16 * T, fr, fq)) = w; }
                { LAS bf16* nb_ = AL + ((step + 1) % 3) * 4096; const int u1 = (u + 1) & 7;
                  *(LAS bf16x8*)(nb_ + ((vb * 2 + 0) * 64 + lane) * 8) = Aq[u1][0]; *(LAS bf16x8*)(nb_ + ((vb * 2 + 1) * 64 + lane) * 8) = Aq[u1][1];
                  LB_LDA(u1, step + 9); }
                LBAR();
                const LAS bf16* cbuf = AL + (step % 3) * 4096 + lane * 8;
                const bf16x8 b0 = *(const LAS bf16x8*)(Sl + fr * LD16 + 8 * fq), b1 = *(const LAS bf16x8*)(Sl + fr * LD16 + 8 * fq + 32);
#pragma unroll
                for (int mt = 0; mt < 4; ++mt) { const u32x2 nw = Nq[u][mt];
                    f32x4 acc = (f32x4){__uint_as_float(nw.x << 16), __uint_as_float(nw.x & 0xffff0000u), __uint_as_float(nw.y << 16), __uint_as_float(nw.y & 0xffff0000u)};
                    acc = __builtin_amdgcn_mfma_f32_16x16x32_bf16(*(const LAS bf16x8*)(cbuf + (mt * 2) * 512), b0, acc, 0, 0, 0);
                    acc = __builtin_amdgcn_mfma_f32_16x16x32_bf16(*(const LAS bf16x8*)(cbuf + (mt * 2 + 1) * 512), b1, acc, 0, 0, 0);
                    S[mt] = acc; }
                LB_LDN(u, step + 8);
            }
        }
#undef LB_LDA
#undef LB_LDN
#undef LB_QI
        LBAR();
    }
    const int w0 = (G > 64) ? (bx - 64) * NWAVES + wave : bx * NWAVES + wave, wst = (G > 64) ? (G - 64) * NWAVES : G * NWAVES;
    if (G > 64 && bx < 64) return;
    for (int t = w0; t < 2048; t += wst) {
        const int chain = t >> 2, vb = t & 3, b = chain >> 5, h = (chain >> 1) & 15, d = chain & 1, cb = b * 4; constexpr int NC = 4;
        f32x4 S[4];
#pragma unroll
        for (int T = 0; T < 4; ++T) S[T] = (f32x4){0.f, 0.f, 0.f, 0.f};
        bf16x8 Apf[4][8]; u32x2 Npf[4][4];
#define CB_QI(step) ((((size_t)(cb + (d ? NC - 1 - (step) : (step)))) * 16 + h) * 2 + d)
#define CB_LOAD(u, step) do { const size_t q_ = CB_QI(step); const bf16* ps_ = PST + q_ * 4096 + lane * 8; const bf16* nc_ = NCT + q_ * 4096 + ((vb * 4 * 64 + lane) << 2); \
        _Pragma("unroll") for (int mt_ = 0; mt_ < 4; ++mt_) { Apf[u][2 * mt_] = *(const bf16x8*)(ps_ + mt_ * 1024); Apf[u][2 * mt_ + 1] = *(const bf16x8*)(ps_ + mt_ * 1024 + 512); Npf[u][mt_] = *(const u32x2*)(nc_ + mt_ * 256); } } while (0)
        CB_LOAD(0, 0); CB_LOAD(1, 1); CB_LOAD(2, 2); CB_LOAD(3, 3);
#pragma unroll
        for (int u = 0; u < 4; ++u) {
            const int step = u; const size_t q = CB_QI(step); bf16* scg = SC + q * 4096;
            asm volatile("" ::: "memory");
#pragma unroll
            for (int T = 0; T < 4; ++T) { const u32x2 w = pk4(S[T]); *(LAS u32x2*)(Sl + fr * LD16 + 16 * T + 4 * fq) = w; *(u32x2*)(scg + fm_off(16 * vb, 16 * T, fr, fq)) = w; }
            asm volatile("s_waitcnt lgkmcnt(0)" ::: "memory");
            const bf16x8 b0 = *(const LAS bf16x8*)(Sl + fr * LD16 + 8 * fq), b1 = *(const LAS bf16x8*)(Sl + fr * LD16 + 8 * fq + 32);
#pragma unroll
            for (int mt = 0; mt < 4; ++mt) { const u32x2 nw = Npf[u][mt];
                f32x4 acc = (f32x4){__uint_as_float(nw.x << 16), __uint_as_float(nw.x & 0xffff0000u), __uint_as_float(nw.y << 16), __uint_as_float(nw.y & 0xffff0000u)};
                acc = __builtin_amdgcn_mfma_f32_16x16x32_bf16(Apf[u][2 * mt], b0, acc, 0, 0, 0);
                acc = __builtin_amdgcn_mfma_f32_16x16x32_bf16(Apf[u][2 * mt + 1], b1, acc, 0, 0, 0);
                S[mt] = acc; }
            asm volatile("s_waitcnt lgkmcnt(0)" ::: "memory");
        }
#undef CB_LOAD
#undef CB_QI
        { float* dst = F.out + (size_t)M * D + ((((size_t)b * NL + l) * 2 + d) * NH + h) * 4096 + (size_t)(16 * vb + fr) * 64 + 4 * fq;
#pragma unroll
          for (int T = 0; T < 4; ++T) *(f32x4*)(dst + 16 * T) = S[T]; }
    }
}

__device__ __forceinline__ void p_chunkC(Frame& F, int l) {
    PH_LOCALS(F); PH_LAYER(l);
    LAS unsigned char* lds = F.lds;
    const int fr = lane & 15, fq = lane >> 4, d = wave >> 2, nb = wave & 3;
    const bf16* PS = (const bf16*)(F.ws + WS_PS); const bf16* GATE = (const bf16*)(F.ws + WS_GATE); const float* BONUS = (const float*)(F.ws + WS_BONUS);
    bf16* O = (bf16*)(F.ws + WS_O);
    constexpr int NIT = (M / 64) * NH;
    f32x4 gnw[4], gnb[4]; int hcur = -1;
    bf16x8 fa0[4][4], fb0[4]; u32x4 pv0, pg0; float pb00, pb01;
#define CC_ISSUE(item_, fa, fb, pv, pg, pb0, pb1) do { const int ci_ = (item_) >> 4, h_ = (item_) & 15; const size_t qi_ = ((size_t)ci_ * 16 + h_) * 2 + d; \
        const bf16* sc_ = (const bf16*)(F.ws + WS_SC) + qi_ * 4096 + lane * 8; const bf16* vt_ = (const bf16*)(F.ws + WS_VTG) + qi_ * 4096 + lane * 8; \
        const bf16* py_ = (const bf16*)(F.ws + WS_PYT) + qi_ * 4096 + nb * 1024 + lane * 8; const bf16* qy_ = (const bf16*)(F.ws + WS_QYT) + qi_ * 4096 + nb * 1024 + lane * 8; \
        fb[0] = *(const bf16x8*)py_; fb[1] = *(const bf16x8*)(py_ + 512); fb[2] = *(const bf16x8*)qy_; fb[3] = *(const bf16x8*)(qy_ + 512); \
        _Pragma("unroll") for (int vt4_ = 0; vt4_ < 4; ++vt4_) { fa[vt4_][0] = *(const bf16x8*)(sc_ + vt4_ * 1024); fa[vt4_][1] = *(const bf16x8*)(sc_ + vt4_ * 1024 + 512); fa[vt4_][2] = *(const bf16x8*)(vt_ + vt4_ * 1024); fa[vt4_][3] = *(const bf16x8*)(vt_ + vt4_ * 1024 + 512); } \
        const int row_ = ci_ * 64 + (tid >> 3), chn_ = 64 * h_ + (tid & 7) * 8; \
        pv = *(const u32x4*)(PS + (size_t)row_ * CSH + 2 * DA + chn_); pg = *(const u32x4*)(GATE + (size_t)row_ * DA + chn_); pb0 = BONUS[(size_t)row_ * NH + h_]; pb1 = BONUS[((size_t)M + row_) * NH + h_]; } while (0)
#define CC_BODY(item_, fa, fb, pv, pg, pb0, pb1, next_) do { const int ci = (item_) >> 4, h = (item_) & 15, R0 = ci * 64; \
        if (h != hcur) { hcur = h; _Pragma("unroll") for (int vtile = 0; vtile < 4; ++vtile) { gnw[vtile] = *(const f32x4*)(F.in[I_GNW] + (size_t)l * DA + 64 * h + 16 * vtile + 4 * fq); gnb[vtile] = *(const f32x4*)(F.in[I_GNB] + (size_t)l * DA + 64 * h + 16 * vtile + 4 * fq); } } \
        f32x4 acc[4]; float s = 0.f; \
        _Pragma("unroll") for (int vtile = 0; vtile < 4; ++vtile) { f32x4 a = F4Z; \
            _Pragma("unroll") for (int ks = 0; ks < 4; ++ks) a = __builtin_amdgcn_mfma_f32_16x16x32_bf16(fa[vtile][ks], fb[ks], a, 0, 0, 0); \
            acc[vtile] = a; s += (a[0] + a[1]) + (a[2] + a[3]); } \
        const u32x4 cv = pv, cgt = pg; const float bon = pb0 + pb1; \
        if ((next_) < NIT) CC_ISSUE((next_), fa, fb, pv, pg, pb0, pb1); \
        s += SHX(s, 16); s += SHX(s, 32); \
        const float mean = s * (1.0f / 64.0f); float qv = 0.f; \
        _Pragma("unroll") for (int vtile = 0; vtile < 4; ++vtile) { acc[vtile] = acc[vtile] - mean; const f32x4 a = acc[vtile]; qv += (a[0] * a[0] + a[1] * a[1]) + (a[2] * a[2] + a[3] * a[3]); } \
        qv += SHX(qv, 16); qv += SHX(qv, 32); \
        const float rstd = 1.0f / sqrtf(qv * (1.0f / 64.0f) + GN_EPS); \
        const int tau = 16 * nb + fr, pos = d ? 63 - tau : tau; \
        LAS float* Yd = (LAS float*)(lds + d * 17408); \
        _Pragma("unroll") for (int vtile = 0; vtile < 4; ++vtile) { const int v0 = 16 * vtile + 4 * fq; \
            *(LAS f32x4*)(Yd + pos * LD32 + v0) = acc[vtile] * rstd * gnw[vtile] + gnb[vtile]; } \
        LBAR(); \
        { const int pos2 = tid >> 3, c8 = (tid & 7) * 8, row = R0 + pos2, chn = 64 * h + c8; \
          const LAS float* Y0 = (const LAS float*)lds; const LAS float* Y1 = (const LAS float*)(lds + 17408); \
          float v[8], gt[8], o[8]; unpack8(cv, v); unpack8(cgt, gt); \
          const f32x4 y00 = *(const LAS f32x4*)(Y0 + pos2 * LD32 + c8), y01 = *(const LAS f32x4*)(Y0 + pos2 * LD32 + c8 + 4), y10 = *(const LAS f32x4*)(Y1 + pos2 * LD32 + c8), y11 = *(const LAS f32x4*)(Y1 + pos2 * LD32 + c8 + 4); \
          _Pragma("unroll") for (int j = 0; j < 4; ++j) { o[j] = (y00[j] + y10[j] + bon * v[j]) * gt[j]; o[4 + j] = (y01[j] + y11[j] + bon * v[4 + j]) * gt[4 + j]; } \
          *(u32x4*)(O + (size_t)row * D + chn) = pack8(o); } \
        LBAR(); } while (0)
    if (bx < NIT) CC_ISSUE(bx, fa0, fb0, pv0, pg0, pb00, pb01);
    for (int item = bx; item < NIT; item += G) {
        CC_BODY(item, fa0, fb0, pv0, pg0, pb00, pb01, item + G);
    }
#undef CC_BODY
#undef CC_ISSUE
}

__device__ __forceinline__ void p_final(Frame& F) {
    PH_LOCALS(F);
    const int gw = bx * NWAVES + wave, NGW = G * NWAVES;
    const float* fg = F.in[I_FNG];
    for (int row = gw; row < M; row += NGW) {
        float* xr = F.out + (size_t)row * D;
        f32x4 v[8]; float ss = 0.f;
#pragma unroll
        for (int j = 0; j < 8; ++j) { v[j] = *(const f32x4*)(xr + 4 * lane + 256 * j); ss += (v[j].x * v[j].x + v[j].y * v[j].y) + (v[j].z * v[j].z + v[j].w * v[j].w); }
        WAVE_SUM(ss); const float rstd = 1.0f / sqrtf(ss * (1.0f / D) + RMS_EPS);
#pragma unroll
        for (int j = 0; j < 8; ++j) { const int c = 4 * lane + 256 * j; *(f32x4*)(xr + c) = v[j] * rstd * *(const f32x4*)(fg + c); }
    }
}

constexpr int PH_PER_LAYER = 10, N_PHASES = 2 + NL * PH_PER_LAYER;
__global__ void __launch_bounds__(NWAVES * 64, 2) hymba_fwd(Args args) {
    extern __shared__ __attribute__((aligned(16))) unsigned char lds[];
    Frame F;
    F.lds = (LAS unsigned char*)lds;
    F.tid = threadIdx.x; F.lane = F.tid & 63; F.wave = __builtin_amdgcn_readfirstlane(F.tid >> 6);
    F.G = gridDim.x; F.bx = blockIdx.x;
    F.in = args.in; F.out = args.out; F.ws = args.ws;
    for (int u = F.tid; u < (LDS_BYTES - LDSCTL_OFF) / 4; u += NWAVES * 64) ((LAS unsigned*)(F.lds + LDSCTL_OFF))[u] = 0u;
    __syncthreads();
    volatile LAS unsigned* MISC = (volatile LAS unsigned*)(F.lds + MISC_OFF);
    unsigned* barw = (unsigned*)(F.ws + WS_CTL) + CW_BAR;
    XcdBarrier bar; bar.bar = barw; bar.x = 0; bar.st = nullptr;
    if (MK_N_LAUNCHES == 1) bar = xcd_barrier_post(barw, MISC + 8);
    const int lo = args.ph_lo, hi = args.ph_hi;
#define IN(k) (lo <= (k) && (k) < hi)
#define SEAM(k) do { if (MK_N_LAUNCHES == 1 && IN(k) && IN((k) + 1)) xcd_barrier(bar); } while (0)

    for (int rep = 0; rep < ((PROBE_DUP == 30) ? 2 : 1); ++rep)
    if (IN(0)) { p0_prologue(F); __syncthreads(); } SEAM(0);
    bf16* H = (bf16*)(F.ws + WS_H); bf16* O = (bf16*)(F.ws + WS_O); bf16* P = (bf16*)(F.ws + WS_P); bf16* HID = (bf16*)(F.ws + WS_HID);
    const float* mod = (const float*)(F.ws + WS_MOD);
    for (int l = 0; l < NL; ++l) {
        const int pb = 1 + l * PH_PER_LAYER;
        const float* xlo = l == 0 ? F.in[I_XP] : F.out; const float* xhi = l == 0 ? F.in[I_XS] : F.out + (size_t)MCTX * D;
        float* dummy = (float*)(F.ws + WS_P);
        for (int rep = 0; rep < ((PROBE_DUP == 7) ? 2 : 1); ++rep)
        if (IN(pb + 0)) { p_adaln(F, l, 0, xlo, xhi); } SEAM(pb + 0);
        for (int rep = 0; rep < ((PROBE_DUP == 1 || PROBE_DUP == 20) ? 2 : 1); ++rep)
        if (IN(pb + 1)) { pg8::Gemm g{H, (const bf16*)(F.ws + WS_WIN + l * SZ_WIN), M, PINP, D}; pg8::StaticOrder S; { int cb_ = F.bx, cg_ = F.G; asm volatile("" : "+s"(cb_), "+s"(cg_)); S.init(M, PINP, cg_, cb_, D); }
            EpiP E{P, PINP, CSH}; pg8::gemm_phase<EpiP, pg8::StaticOrder, true, true>(F.lds, g, S, E, F.wave); } SEAM(pb + 1);
        for (int rep = 0; rep < ((PROBE_DUP == 2) ? 2 : 1); ++rep)
        if (IN(pb + 2)) { p_shift(F, l); } SEAM(pb + 2);
        if (IN(pb + 3)) { for (int rep = 0; rep < ((PROBE_DUP == 3) ? 2 : 1); ++rep) p_chunkA(F, l); } SEAM(pb + 3);
        for (int rep = 0; rep < ((PROBE_DUP == 4) ? 2 : 1); ++rep)
        if (IN(pb + 4)) { p_chunkB(F, l);
            for (int rep = 0; rep < ((PROBE_DUP == 13) ? 2 : 1); ++rep) p_gmlp(F, l, F.G > 64 ? (F.bx >= 64 ? F.bx - 64 : -1) : F.bx, F.G > 64 ? F.G - 64 : F.G); } SEAM(pb + 4);
        for (int rep = 0; rep < ((PROBE_DUP == 5) ? 2 : 1); ++rep)
        if (IN(pb + 5)) { p_chunkC(F, l); } SEAM(pb + 5);
        if ((PROBE_DUP == 6 || PROBE_DUP == 20) && IN(pb + 6)) { pg8::Gemm g{O, (const bf16*)(F.ws + WS_WOUT + l * SZ_WOUT), M, D, D}; pg8::StaticOrder S; { int cb_ = F.bx, cg_ = F.G; asm volatile("" : "+s"(cb_), "+s"(cg_)); S.init(M, D, cg_, cb_, D); }
            EpiRes E{xlo, xhi, dummy, mod + (size_t)l * 5 * MODW, 2 * D, D / 64, nullptr, nullptr}; pg8::gemm_phase<EpiRes, pg8::StaticOrder, true, true>(F.lds, g, S, E, F.wave); }
        if (IN(pb + 6)) { pg8::Gemm g{O, (const bf16*)(F.ws + WS_WOUT + l * SZ_WOUT), M, D, D}; pg8::StaticOrder S; { int cb_ = F.bx, cg_ = F.G; asm volatile("" : "+s"(cb_), "+s"(cg_)); S.init(M, D, cg_, cb_, D); }
            EpiRes E{xlo, xhi, F.out, mod + (size_t)l * 5 * MODW, 2 * D, D / 64, nullptr, nullptr}; pg8::gemm_phase<EpiRes, pg8::StaticOrder, true, true>(F.lds, g, S, E, F.wave); } SEAM(pb + 6);
        for (int rep = 0; rep < ((PROBE_DUP == 7) ? 2 : 1); ++rep)
        if (IN(pb + 7)) { p_adaln(F, l, 1, F.out, F.out + (size_t)MCTX * D); } SEAM(pb + 7);
        for (int rep = 0; rep < ((PROBE_DUP == 8 || PROBE_DUP == 20) ? 2 : 1); ++rep)
        if (IN(pb + 8)) { pg8::Gemm g{H, (const bf16*)(F.ws + WS_WGU + l * SZ_WGU), M, NGU, D}; pg8::StaticOrder S; { int cb_ = F.bx, cg_ = F.G; asm volatile("" : "+s"(cb_), "+s"(cg_)); S.init(M, NGU, cg_, cb_, D); }
            EpiSwi E{HID, DFF}; pg8::gemm_phase<EpiSwi, pg8::StaticOrder, true, true>(F.lds, g, S, E, F.wave); } SEAM(pb + 8);
        if ((PROBE_DUP == 9 || PROBE_DUP == 20) && IN(pb + 9)) { pg8::Gemm g{HID, (const bf16*)(F.ws + WS_WD + l * SZ_WD), M, D, DFF}; pg8::StaticOrder S; { int cb_ = F.bx, cg_ = F.G; asm volatile("" : "+s"(cb_), "+s"(cg_)); S.init(M, D, cg_, cb_, DFF); }
            EpiRes E{F.out, F.out + (size_t)MCTX * D, dummy, mod + (size_t)l * 5 * MODW, 5 * D, DFF / 64, nullptr, nullptr}; pg8::gemm_phase<EpiRes, pg8::StaticOrder, true, true>(F.lds, g, S, E, F.wave); }
        if (IN(pb + 9)) { pg8::Gemm g{HID, (const bf16*)(F.ws + WS_WD + l * SZ_WD), M, D, DFF}; pg8::StaticOrder S; { int cb_ = F.bx, cg_ = F.G; asm volatile("" : "+s"(cb_), "+s"(cg_)); S.init(M, D, cg_, cb_, DFF); }
            EpiRes E{F.out, F.out + (size_t)MCTX * D, F.out, mod + (size_t)l * 5 * MODW, 5 * D, DFF / 64, (float*)(F.ws + WS_P), (unsigned*)(F.ws + WS_CTL) + CW_SPLIT + (size_t)l * 640 * 64}; pg8::gemm_phase<EpiRes, pg8::StaticOrder, true, true>(F.lds, g, S, E, F.wave); } SEAM(pb + 9);
    }
    if (IN(N_PHASES - 1)) { p_final(F); }
#undef IN
#undef SEAM
}

extern "C" void kernel_launch(void* const* d_in, const int* in_sizes, int n_in, void* d_out, int out_size, void* d_ws, size_t ws_size, hipStream_t stream) {
    static int grid = 0;
    if (grid == 0) {
        if (n_in != 30 || ws_size < WS_END) { fprintf(stderr, "kernel_launch: need 30 inputs and >= %zu bytes of workspace; got n_in %d, ws %zu\n", (size_t)WS_END, n_in, ws_size); grid = -1; return; }
        int dev = 0, cus = 0, per_cu = 0;
        if (hipGetDevice(&dev) != hipSuccess || hipDeviceGetAttribute(&cus, hipDeviceAttributeMultiprocessorCount, dev) != hipSuccess) { grid = -1; return; }
        if (hipFuncSetAttribute((const void*)hymba_fwd, hipFuncAttributeMaxDynamicSharedMemorySize, LDS_BYTES) != hipSuccess) { fprintf(stderr, "kernel_launch: hipFuncSetAttribute failed\n"); grid = -1; return; }
        if (hipOccupancyMaxActiveBlocksPerMultiprocessor(&per_cu, (const void*)hymba_fwd, NWAVES * 64, LDS_BYTES) != hipSuccess || per_cu < 1)
            fprintf(stderr, "kernel_launch: note: occupancy query reports %d workgroups per CU\n", per_cu);
        (void)hipGetLastError();
        grid = cus;
    }
    if (grid < 0) return;
    if (hipMemsetAsync((char*)d_ws + WS_CTL, 0, CTL_ZERO_BYTES, stream) != hipSuccess) return;
    Args a{};
    for (int i = 0; i < 30; ++i) a.in[i] = (const float*)d_in[i];
    a.out = (float*)d_out; a.ws = (unsigned char*)d_ws; a.pad = 0;
    if (MK_N_LAUNCHES == 1) {
        a.ph_lo = 0; a.ph_hi = N_PHASES; a.li = 0;
        hipLaunchKernelGGL(hymba_fwd, dim3(grid), dim3(NWAVES * 64), LDS_BYTES, stream, a);
    } else {
        for (int k = 0; k < N_PHASES; ++k) { a.ph_lo = k; a.ph_hi = k + 1; a.li = k;
            hipLaunchKernelGGL(hymba_fwd, dim3(grid), dim3(NWAVES * 64), LDS_BYTES, stream, a); }
    }
}
```

```cpp
#include <hip/hip_runtime.h>
#include <cstdio>
#include <cstdint>

#ifndef PROBE_DUP
#define PROBE_DUP -1
#endif
#ifndef PROBE_SUB
#define PROBE_SUB 0
#endif
#ifndef MK_N_LAUNCHES
#define MK_N_LAUNCHES 1
#endif

namespace pg8 {
#define PG8_LAS __attribute__((address_space(3)))
typedef unsigned short bf16_t;
typedef short bf16x8 __attribute__((ext_vector_type(8)));
typedef float f32x4 __attribute__((ext_vector_type(4)));
typedef unsigned u32x4 __attribute__((ext_vector_type(4)));
constexpr int BM = 256, BK = 64, HALF = 128, HTB = HALF * BK * 2  , STAGE_BYTES = 8 * HTB, NXCD = 8, WGM = 8;

__host__ __device__ __forceinline__ int lds_byte(int r, int c) { const int st = (r >> 4) * 2 + (c >> 5), rr = r & 15, cc = c & 31, ob = rr * 64 + cc * 2; return st * 1024 + (ob ^ (((ob >> 9) & 1) << 5)); }
__host__ __device__ __forceinline__ void stage_rc(int b, int& R, int& C) { const int st = b / 1024, sb = b % 1024, swz = sb ^ (((sb >> 9) & 1) << 5); R = (st >> 1) * 16 + swz / 64; C = (st & 1) * 32 + (swz % 64) / 2; }
__host__ __device__ __forceinline__ int perm32(int rho) { const int n = rho >> 4, i = rho & 15; return 8 * (i >> 2) + 4 * n + (i & 3); }

struct Unit { int pm, pn, k0, nk, bh; };
struct Gemm { const bf16_t* A; const bf16_t* Bt; int M, N, K; };

struct StaticOrder {
    int nM, nN, nwg, G, c, nkt, full, rem;
    __host__ __device__ void init(int M, int N, int G_, int c_, int K_) { nM = M / BM; nN = N / BM; nwg = nM * nN; G = G_; c = c_; nkt = K_ / BK; full = nwg / G; rem = nwg - full * G; }
    __host__ __device__ bool next(int i, Unit& u) const {
        const long L = (long)i * G + c; if (L >= nwg) return false;
        int wgid = (int)L; { const int q = nwg / NXCD, r = nwg % NXCD, xcd = wgid % NXCD, off = wgid / NXCD; wgid = (xcd < r ? xcd * (q + 1) : r * (q + 1) + (xcd - r) * q) + off; }
        const int nig = WGM * nN, gid = wgid / nig, fm = gid * WGM, gsz = (nM - fm) < WGM ? (nM - fm) : WGM;
        u.pm = fm + ((wgid % nig) % gsz); u.pn = (wgid % nig) / gsz; u.k0 = 0; u.nk = nkt; u.bh = -1;
#if defined(__HIP_DEVICE_COMPILE__)
        u.pm = __builtin_amdgcn_readfirstlane(u.pm); u.pn = __builtin_amdgcn_readfirstlane(u.pn);
#endif
        return true;
    }
    __device__ __forceinline__ void a_ready(const Unit&) const {}
    __device__ __forceinline__ void done(const Unit&) const {}
};
struct FullRoundsOrder : StaticOrder {
    __host__ __device__ bool split() const { return rem > 0 && 2 * rem <= G; }
    __host__ __device__ bool next(int i, Unit& u) const { if (split() && i >= full) return false; return StaticOrder::next(i, u); }
};
struct TailHalfOrder : StaticOrder {
    __host__ __device__ bool next(int i, Unit& u) const {
        if (!(rem > 0 && 2 * rem <= G) || i > 0 || c >= 2 * rem) return false;
        StaticOrder t = *this; t.c = c >> 1; if (!t.StaticOrder::next(full, u)) return false;
        u.bh = c & 1; return true;
    }
};

__device__ __forceinline__ unsigned cvt_pk_bf16(float lo, float hi) { unsigned r; asm volatile("v_cvt_pk_bf16_f32 %0, %1, %2" : "=v"(r) : "v"(lo), "v"(hi)); return r; }

template <class Epi, class Sched, bool ALIGN_EPI = false, bool SP2 = false, bool HALFB = false>
__device__ __forceinline__ void gemm_phase(PG8_LAS unsigned char* lds, const Gemm g, const Sched& S, const Epi& E, int wid) {
    asm volatile("" : "+s"(wid)); int lane; asm volatile("v_mbcnt_lo_u32_b32 %0, -1, 0\n\tv_mbcnt_hi_u32_b32 %0, -1, %0" : "=v"(lane));
    const int tid = wid * 64 + lane, wr = wid >> 2, wc = wid & 3, fr = lane & 15, fq = lane >> 4;
    const int K = g.K;
    unsigned voffA[2], voffB[2];
#pragma unroll
    for (int i = 0; i < 2; ++i) { int R, C; stage_rc(tid * 16 + i * 8192, R, C); const int Rb = Epi::PERM ? ((R & ~31) + perm32(R & 31)) : R;
        voffA[i] = (unsigned)(R * K + C) * 2u; voffB[i] = (unsigned)(Rb * K + C) * 2u; }
    const size_t kstep = (size_t)(BK * 2);
    const size_t hstep = (size_t)HALF * K * 2;
    const size_t tstep = 2 * hstep;
    const size_t bhs = HALFB ? 0 : hstep;
    const unsigned ldsw = (unsigned)wid * 1024u;
    const int aoff = lds_byte(wr * 64 + fr, fq * 8), boff = lds_byte(wc * 32 + fr, fq * 8);
#define PG8_SA(b, h) (((b) * 2 + (h)) * HTB)
#define PG8_SB(b, h) ((4 + (b) * 2 + (h)) * HTB)
#define PG8_STAGE(bufoff, gbase, voff) do { _Pragma("unroll") for (int _i = 0; _i < 2; ++_i) \
        __builtin_amdgcn_global_load_lds((const unsigned*)((const char*)(gbase) + (voff)[_i]), (PG8_LAS unsigned*)(lds + (bufoff) + ldsw + _i * 8192), 16, 0, 0); } while (0)
#define PG8_LDA(dst, b, h) do { _Pragma("unroll") for (int m = 0; m < 4; ++m) _Pragma("unroll") for (int k = 0; k < 2; ++k) dst[m][k] = *(const PG8_LAS bf16x8*)(lds + PG8_SA(b, h) + aoff + m * 2048 + k * 1024); } while (0)
#define PG8_LDB(dst, b, h) do { _Pragma("unroll") for (int n = 0; n < 2; ++n) _Pragma("unroll") for (int k = 0; k < 2; ++k) dst[n][k] = *(const PG8_LAS bf16x8*)(lds + PG8_SB(b, h) + boff + n * 2048 + k * 1024); } while (0)
#define PG8_MMA(ai, bj, At, Bt) do { __builtin_amdgcn_s_setprio(1); _Pragma("unroll") for (int m = 0; m < 4; ++m) _Pragma("unroll") for (int n = 0; n < 2; ++n) _Pragma("unroll") for (int k = 0; k < 2; ++k) \
        acc[ai][bj][m][n] = __builtin_amdgcn_mfma_f32_16x16x32_bf16(Bt[n][k], At[m][k], acc[ai][bj][m][n], 0, 0, 0); __builtin_amdgcn_s_setprio(0); } while (0)
#define PG8_WAIT_V(n) asm volatile("s_waitcnt vmcnt(" #n ")" ::: "memory")
#define PG8_WAIT_L(n) asm volatile("s_waitcnt lgkmcnt(" #n ")" ::: "memory")
#define PG8_BAR __builtin_amdgcn_s_barrier()
#define PG8_SCHED __builtin_amdgcn_sched_barrier(0)
    Unit cur, nxt; int ui = 0;
    if (!S.next(0, cur)) return;
    f32x4 acc[2][2][4][2];
#pragma unroll
    for (int a = 0; a < 2; ++a)
#pragma unroll
        for (int b = 0; b < 2; ++b)
#pragma unroll
            for (int m = 0; m < 4; ++m)
#pragma unroll
                for (int n = 0; n < 2; ++n) acc[a][b][m][n] = (f32x4){0.f, 0.f, 0.f, 0.f};
    bf16x8 At[4][2], B0[2][2], B1[2][2];
    const char* cA = (const char*)g.A + (size_t)cur.pm * tstep + (size_t)cur.k0 * kstep; const char* cB = (const char*)g.Bt + (size_t)cur.pn * tstep + (size_t)cur.k0 * kstep + (HALFB ? (size_t)cur.bh * hstep : 0);
    S.a_ready(cur);
    if constexpr (SP2) {
        PG8_STAGE(PG8_SB(0, 0), cB, voffB); PG8_STAGE(PG8_SB(0, 1), cB + bhs, voffB); PG8_STAGE(PG8_SA(0, 0), cA, voffA); PG8_STAGE(PG8_SA(0, 1), cA + hstep, voffA);
        if (wr == 1) PG8_BAR;
        PG8_WAIT_V(2); PG8_BAR;
        PG8_STAGE(PG8_SB(1, 0), cB + kstep, voffB); PG8_STAGE(PG8_SA(1, 0), cA + kstep, voffA); PG8_STAGE(PG8_SB(1, 1), cB + bhs + kstep, voffB);
        PG8_WAIT_V(6); PG8_BAR;
    } else {
        PG8_STAGE(PG8_SB(0, 0), cB, voffB); PG8_STAGE(PG8_SA(0, 0), cA, voffA); PG8_STAGE(PG8_SB(0, 1), cB + bhs, voffB); PG8_STAGE(PG8_SA(0, 1), cA + hstep, voffA);
        if (wr == 1) PG8_BAR;
        PG8_WAIT_V(4); PG8_BAR;
        PG8_STAGE(PG8_SB(1, 0), cB + kstep, voffB); PG8_STAGE(PG8_SA(1, 0), cA + kstep, voffA); PG8_STAGE(PG8_SB(1, 1), cB + bhs + kstep, voffB);
        PG8_WAIT_V(6); PG8_BAR;
    }
    for (;;) {
        const bool has_next = S.next(ui + 1, nxt);
        const char* nA = has_next ? (const char*)g.A + (size_t)nxt.pm * tstep + (size_t)nxt.k0 * kstep : cA; const char* nB = has_next ? (const char*)g.Bt + (size_t)nxt.pn * tstep + (size_t)nxt.k0 * kstep + (HALFB ? (size_t)nxt.bh * hstep : 0) : cB;
        const int nt = cur.nk;
        for (int t = 0; t < nt; t += 2) {
            const bool last = (t == nt - 2);
            const char* a1 = cA + (size_t)(t + 1) * kstep;
            const char* a2 = last ? nA : cA + (size_t)(t + 2) * kstep; const char* b2 = last ? nB : cB + (size_t)(t + 2) * kstep;
            const char* a3 = a2 + kstep; const char* b3 = b2 + kstep;
            if (last && has_next) S.a_ready(nxt);
            if constexpr (SP2) {
            PG8_LDB(B0, 0, 0); if constexpr (!HALFB) PG8_LDB(B1, 0, 1); PG8_SCHED; PG8_LDA(At, 0, 0); PG8_STAGE(PG8_SA(1, 1), a1 + hstep, voffA);
            PG8_WAIT_V(8); PG8_WAIT_L(0); PG8_BAR; PG8_MMA(0, 0, At, B0); if constexpr (!HALFB) PG8_MMA(0, 1, At, B1); PG8_BAR; PG8_SCHED;
            PG8_LDA(At, 0, 1); PG8_STAGE(PG8_SB(0, 0), b2, voffB); PG8_STAGE(PG8_SB(0, 1), b2 + bhs, voffB); PG8_STAGE(PG8_SA(0, 0), a2, voffA);
            PG8_WAIT_V(8); PG8_WAIT_L(0); PG8_BAR; PG8_MMA(1, 0, At, B0); if constexpr (!HALFB) PG8_MMA(1, 1, At, B1); PG8_BAR; PG8_SCHED;
            PG8_LDB(B0, 1, 0); if constexpr (!HALFB) PG8_LDB(B1, 1, 1); PG8_SCHED; PG8_LDA(At, 1, 0); PG8_STAGE(PG8_SA(0, 1), a2 + hstep, voffA);
            PG8_WAIT_V(8); PG8_WAIT_L(0); PG8_BAR; PG8_MMA(0, 0, At, B0); if constexpr (!HALFB) PG8_MMA(0, 1, At, B1); PG8_BAR; PG8_SCHED;
            PG8_LDA(At, 1, 1); PG8_STAGE(PG8_SB(1, 0), b3, voffB); PG8_STAGE(PG8_SB(1, 1), b3 + bhs, voffB); PG8_STAGE(PG8_SA(1, 0), a3, voffA);
            PG8_WAIT_V(8); PG8_WAIT_L(0); PG8_BAR; PG8_MMA(1, 0, At, B0); if constexpr (!HALFB) PG8_MMA(1, 1, At, B1); PG8_BAR; PG8_SCHED;
            } else {
            PG8_LDB(B0, 0, 0); PG8_SCHED; PG8_LDA(At, 0, 0); PG8_STAGE(PG8_SA(1, 1), a1 + hstep, voffA);
            PG8_WAIT_L(8); PG8_BAR; PG8_WAIT_L(0); PG8_MMA(0, 0, At, B0); PG8_BAR; PG8_SCHED;
            PG8_LDB(B1, 0, 1); PG8_STAGE(PG8_SB(0, 0), b2, voffB);
            PG8_BAR; PG8_WAIT_L(0); PG8_MMA(0, 1, At, B1); PG8_BAR;
            PG8_LDA(At, 0, 1); PG8_STAGE(PG8_SA(0, 0), a2, voffA);
            PG8_BAR; PG8_WAIT_L(0); PG8_MMA(1, 0, At, B0); PG8_BAR; PG8_SCHED;
            PG8_STAGE(PG8_SB(0, 1), b2 + bhs, voffB);
            PG8_WAIT_V(6); PG8_BAR; PG8_MMA(1, 1, At, B1); PG8_BAR;
            PG8_LDB(B0, 1, 0); PG8_SCHED; PG8_LDA(At, 1, 0); PG8_STAGE(PG8_SA(0, 1), a2 + hstep, voffA);
            PG8_WAIT_L(8); PG8_BAR; PG8_WAIT_L(0); PG8_MMA(0, 0, At, B0); PG8_BAR; PG8_SCHED;
            PG8_LDB(B1, 1, 1); PG8_STAGE(PG8_SB(1, 0), b3, voffB);
            PG8_BAR; PG8_WAIT_L(0); PG8_MMA(0, 1, At, B1); PG8_BAR;
            PG8_LDA(At, 1, 1); PG8_STAGE(PG8_SA(1, 0), a3, voffA);
            PG8_BAR; PG8_WAIT_L(0); PG8_MMA(1, 0, At, B0); PG8_BAR; PG8_SCHED;
            PG8_STAGE(PG8_SB(1, 1), b3 + bhs, voffB);
            PG8_WAIT_V(6); PG8_BAR; PG8_MMA(1, 1, At, B1); PG8_BAR;
            }
        }
        if constexpr (ALIGN_EPI) { if (wr == 0) PG8_BAR; }
        E(acc, cur, wr, wc, fr, fq); S.done(cur);
        if (!has_next) break;
#pragma unroll
        for (int a = 0; a < 2; ++a)
#pragma unroll
            for (int b = 0; b < 2; ++b)
#pragma unroll
                for (int m = 0; m < 4; ++m)
#pragma unroll
                    for (int n = 0; n < 2; ++n) acc[a][b][m][n] = (f32x4){0.f, 0.f, 0.f, 0.f};
        cur = nxt; cA = nA; cB = nB; ++ui;
        if constexpr (ALIGN_EPI) { if (wr == 1) PG8_BAR; }
    }
    PG8_WAIT_V(0);
    if constexpr (!ALIGN_EPI) { if (wr == 0) PG8_BAR; }
    PG8_BAR;
#undef PG8_SA
#undef PG8_SB
#undef PG8_STAGE
#undef PG8_LDA
#undef PG8_LDB
#undef PG8_MMA
#undef PG8_WAIT_V
#undef PG8_WAIT_L
#undef PG8_BAR
#undef PG8_SCHED
}
}

constexpr int NWAVES = 8;
constexpr int D = 2048, MCTX = 4096, MLAT = 16384, M = MCTX + MLAT, NL = 4;
constexpr int DA = 1024, NH = 16, DB = 1024, NG = 8, HB = 128;
constexpr int LW = 64, LAA = 64, LGT = 160;
constexpr int CSH = 3 * DA + LW + LAA + LGT;
constexpr int PIN = CSH + 2 * DB;
constexpr int PINP = 5632;
constexpr int DFF = 5632, NGU = 2 * DFF;
constexpr int MODW = 6 * D;
constexpr float RMS_EPS = 1e-6f, GN_EPS = 64.0f * 1e-5f, LN_EPS = 1e-5f;

constexpr size_t MiB = 1u << 20;
constexpr size_t WS_CTL = 0, CTL_ZERO_BYTES = 1 * MiB;
constexpr size_t WS_MOD = 1 * MiB;
constexpr size_t WS_W2T = 2 * MiB;
constexpr size_t WS_A2T = 3 * MiB;
constexpr size_t WS_G2T = 4 * MiB;
constexpr size_t WS_WSP = 6 * MiB;
constexpr size_t WS_BONUS = 7 * MiB;
constexpr size_t SZ_WIN = (size_t)PINP * D * 2, SZ_WOUT = (size_t)D * D * 2, SZ_WGU = (size_t)NGU * D * 2, SZ_WD = (size_t)D * DFF * 2;
constexpr size_t WS_WIN = 16 * MiB;
constexpr size_t WS_WOUT = WS_WIN + NL * SZ_WIN;
constexpr size_t WS_WGU = WS_WOUT + NL * SZ_WOUT;
constexpr size_t WS_WD = WS_WGU + NL * SZ_WGU;
constexpr size_t WS_H = WS_WD + NL * SZ_WD;
constexpr size_t WS_O = WS_H + (size_t)M * D * 2;
constexpr size_t WS_P = WS_O + (size_t)M * D * 2;
constexpr size_t WS_PS = WS_P + (size_t)M * PINP * 2;
constexpr size_t SZ_T16 = (size_t)M * DA * 2;
constexpr size_t WS_GATE = WS_PS + (size_t)M * CSH * 2;
constexpr size_t SZ_CH = (size_t)(M / 64) * NH * 2 * 8192;
constexpr size_t WS_PST = WS_GATE + SZ_T16;
constexpr size_t WS_NCT = WS_PST + SZ_CH;
constexpr size_t WS_PYT = WS_NCT + SZ_CH;
constexpr size_t WS_QYT = WS_PYT + SZ_CH;
constexpr size_t WS_VTG = WS_QYT + SZ_CH;
constexpr size_t WS_SC = WS_VTG + SZ_CH;
constexpr size_t WS_LORA = WS_SC + SZ_CH;
constexpr size_t WS_END1 = WS_LORA + (size_t)M * 288 * 2;
constexpr size_t WS_HID = WS_GATE;
constexpr size_t WS_END = WS_END1 > WS_HID + (size_t)M * DFF * 2 ? WS_END1 : WS_HID + (size_t)M * DFF * 2;
constexpr int CW_BAR = 4096;
constexpr int CW_SPLIT = 16384;
static_assert((CW_SPLIT + NL * 640 * 64) * 4 <= (int)CTL_ZERO_BYTES, "control words inside the memset region");

constexpr int RING_BYTES = 131072;
constexpr int LDSCTL_OFF = 15 * 9216, MISC_OFF = LDSCTL_OFF + 320;
constexpr int LDS_BYTES = 147456;

#define GAS __attribute__((address_space(1)))
#define LAS __attribute__((address_space(3)))
typedef unsigned short bf16;
typedef float f32x4 __attribute__((ext_vector_type(4)));
typedef float f32x2 __attribute__((ext_vector_type(2)));
typedef short bf16x8 __attribute__((ext_vector_type(8)));
typedef unsigned u32x4 __attribute__((ext_vector_type(4)));
typedef unsigned u32x2 __attribute__((ext_vector_type(2)));
#define LDS_WAIT() asm volatile("s_waitcnt lgkmcnt(0)" ::: "memory")
#define VM_WAIT() asm volatile("s_waitcnt vmcnt(0)" ::: "memory")
__device__ __forceinline__ unsigned f2bf(float f) { unsigned u = __builtin_bit_cast(unsigned, f); return (u + 0x7fffu + ((u >> 16) & 1u)) >> 16; }
typedef __bf16 bf16x2_t __attribute__((ext_vector_type(2)));
__device__ __forceinline__ unsigned pk2(float lo, float hi) { return __builtin_bit_cast(unsigned, __builtin_convertvector((f32x2){lo, hi}, bf16x2_t)); }
__device__ __forceinline__ float bf2f(unsigned short b) { return __uint_as_float(((unsigned)b) << 16); }
__device__ __forceinline__ void unpack8(const u32x4 q, float (&f)[8]) {
    f[0] = __uint_as_float(q.x << 16); f[1] = __uint_as_float(q.x & 0xffff0000u); f[2] = __uint_as_float(q.y << 16); f[3] = __uint_as_float(q.y & 0xffff0000u);
    f[4] = __uint_as_float(q.z << 16); f[5] = __uint_as_float(q.z & 0xffff0000u); f[6] = __uint_as_float(q.w << 16); f[7] = __uint_as_float(q.w & 0xffff0000u); }
__device__ __forceinline__ u32x4 pack8(const float (&f)[8]) { u32x4 o; o.x = pk2(f[0], f[1]); o.y = pk2(f[2], f[3]); o.z = pk2(f[4], f[5]); o.w = pk2(f[6], f[7]); return o; }
__device__ __forceinline__ float fsigmoid(float x) { return __builtin_amdgcn_rcpf(1.0f + __expf(-x)); }
__device__ __forceinline__ float ftanh(float x) { return 1.0f - 2.0f * __builtin_amdgcn_rcpf(1.0f + __expf(2.0f * x)); }
__device__ __forceinline__ float gelu_tanh(float x) { const float u = 1.5957691216057308f * (x + 0.044715f * x * x * x); return x * __builtin_amdgcn_rcpf(1.0f + __expf(-u)); }
__device__ __forceinline__ int hw_lane() { int l; asm volatile("v_mbcnt_lo_u32_b32 %0, -1, 0\n\tv_mbcnt_hi_u32_b32 %0, -1, %0" : "=v"(l)); return l; }
#define SHX(v, X) __int_as_float(__builtin_amdgcn_ds_bpermute((lane ^ (X)) << 2, __float_as_int(v)))
#define WAVE_SUM(v) do { v += SHX(v, 1); v += SHX(v, 2); v += SHX(v, 4); v += SHX(v, 8); v += SHX(v, 16); v += SHX(v, 32); } while (0)

#define PH_LOCALS(F) int wave = (F).wave; asm volatile("" : "+s"(wave)); const int lane = hw_lane(); const int tid = wave * 64 + lane; \
    int bx = (F).bx, G = (F).G; asm volatile("" : "+s"(bx), "+s"(G)); (void)lane; (void)tid;
#define PH_LAYER(l) asm volatile("" : "+s"(l))

#define XB_TMO      128
#define XB_XCNT(j)  (256  + 64 * (j))
#define XB_XSUB(j)  (1280 + 64 * (j))
#define XB_XGEN(j)  (2304 + 64 * (j))
#define XB_TOP      3328
#define XB_TOPGEN   3392
#define XCD_BAR_WORDS 3456
#define XB_SPIN_CAP (1u << 18)

__device__ __forceinline__ unsigned xb_ld(unsigned* p)              { return __hip_atomic_load(p, __ATOMIC_RELAXED, __HIP_MEMORY_SCOPE_AGENT); }
__device__ __forceinline__ unsigned xb_add(unsigned* p, unsigned v) { return __hip_atomic_fetch_add(p, v, __ATOMIC_RELAXED, __HIP_MEMORY_SCOPE_AGENT); }
__device__ __forceinline__ unsigned xb_xcc_id() { return (unsigned)__builtin_amdgcn_s_getreg((3 << 11) | 20) & 0xFu; }
#define XB_SPIN(cond, bar) do { unsigned _sp = 0; while (cond) { __builtin_amdgcn_s_sleep(1); \
    if ((++_sp & 255u) == 0u) { if (xb_ld(&(bar)[XB_TMO])) break; if (_sp > XB_SPIN_CAP) { atomicAdd(&(bar)[XB_TMO], 1u); break; } } } } while (0)

struct XcdBarrier {
    unsigned* bar; unsigned x;
    volatile LAS unsigned* st;
};
__device__ __forceinline__ XcdBarrier xcd_barrier_post(unsigned* bar, volatile LAS unsigned* st) {
    XcdBarrier b; b.bar = bar; b.x = xb_xcc_id(); b.st = st;
    if (threadIdx.x == 0) (void)xb_add(&bar[XB_XCNT(b.x)], 1u);
    return b;
}
__device__ __forceinline__ void xcd_barrier_complete(unsigned* bar, unsigned x, unsigned& nloc, unsigned& nx) {
    const unsigned G = gridDim.x * gridDim.y * gridDim.z;
    unsigned sum, cnt, mine, sp = 0u;
    for (;;) {
        sum = 0u; cnt = 0u; mine = 0u;
#pragma unroll
        for (unsigned j = 0; j < 16; ++j) { const unsigned c = xb_ld(&bar[XB_XCNT(j)]); sum += c; cnt += (c > 0u) ? 1u : 0u; mine = (j == x) ? c : mine; }
        if (sum == G) break;
        __builtin_amdgcn_s_sleep(1);
        if ((++sp & 255u) == 0u) { if (xb_ld(&bar[XB_TMO])) break; if (sp > XB_SPIN_CAP) { atomicAdd(&bar[XB_TMO], 1u); break; } }
    }
    nloc = mine > 0u ? mine : 1u; nx = cnt > 0u ? cnt : 1u;
}
__device__ __forceinline__ void xcd_barrier(const XcdBarrier& b) {
    asm volatile("s_waitcnt vmcnt(0)" ::: "memory");
    __syncthreads();
    if (threadIdx.x == 0) {
        unsigned* bar = b.bar;
        __builtin_amdgcn_s_waitcnt(0);
        unsigned nloc = b.st[0], nx = b.st[1];
        if (nloc == 0u) { xcd_barrier_complete(bar, b.x, nloc, nx); b.st[0] = nloc; b.st[1] = nx; }
        const unsigned old = xb_add(&bar[XB_XSUB(b.x)], 1u);
        const unsigned gen = old / nloc;
        if (old + 1u == (gen + 1u) * nloc) {
            __builtin_amdgcn_fence(__ATOMIC_RELEASE, "agent");
            asm volatile("s_waitcnt vmcnt(0)" ::: "memory");
            const unsigned og = xb_add(&bar[XB_TOP], 1u);
            const unsigned tg = og / nx;
            if (og + 1u == (tg + 1u) * nx) xb_add(&bar[XB_TOPGEN], 1u);
            else XB_SPIN(xb_ld(&bar[XB_TOPGEN]) == tg, bar);
            __builtin_amdgcn_fence(__ATOMIC_ACQUIRE, "agent");
            xb_add(&bar[XB_XGEN(b.x)], 1u);
            asm volatile("s_waitcnt vmcnt(0)" ::: "memory");
        } else {
            XB_SPIN(xb_ld(&bar[XB_XGEN(b.x)]) == gen, bar);
            __builtin_amdgcn_fence(__ATOMIC_ACQUIRE, "agent");
            asm volatile("s_waitcnt vmcnt(0)" ::: "memory");
        }
    }
    __syncthreads();
}

struct Args {
    const float* in[30];
    float* out; unsigned char* ws;
    int ph_lo, ph_hi, li, pad;
};
enum { I_XP = 0, I_XS, I_STATE, I_C, I_CCTX, I_WMOD, I_BMOD, I_N1G, I_WIN, I_MU, I_W0, I_W2, I_A0, I_A2, I_G2, I_KK, I_KA, I_RK, I_GNW, I_GNB, I_LNG, I_LNB, I_WSP, I_BSP, I_WOUT, I_N2G, I_WG, I_WU, I_WD, I_FNG };

struct Frame {
    LAS unsigned char* lds;
    int tid, lane, wave, G, bx;
    const float* const* in;
    float* out; unsigned char* ws;
};

struct EpiP {
    static constexpr bool PERM = true, AFTER_DRAIN = false;
    bf16* O; int ldc; int gelu_from;
    __device__ __forceinline__ void operator()(const f32x4 (&acc)[2][2][4][2], const pg8::Unit& u, int wr, int wc, int fr, int fq) const {
        const int row0 = u.pm * 256 + wr * 64 + fr, col0 = u.pn * 256 + wc * 32 + 8 * fq;
#pragma unroll
        for (int ai = 0; ai < 2; ++ai)
#pragma unroll
            for (int m = 0; m < 4; ++m) { bf16* rowp = O + (size_t)(row0 + ai * 128 + m * 16) * ldc + col0;
#pragma unroll
                for (int bj = 0; bj < 2; ++bj) { f32x4 v0 = acc[ai][bj][m][0], v1 = acc[ai][bj][m][1];
                    if (col0 + bj * 128 >= gelu_from) {
#pragma unroll
                        for (int j = 0; j < 4; ++j) { v0[j] = gelu_tanh(v0[j]); v1[j] = gelu_tanh(v1[j]); } }
                    u32x4 w; w.x = pg8::cvt_pk_bf16(v0[0], v0[1]); w.y = pg8::cvt_pk_bf16(v0[2], v0[3]); w.z = pg8::cvt_pk_bf16(v1[0], v1[1]); w.w = pg8::cvt_pk_bf16(v1[2], v1[3]);
                    *(u32x4*)(rowp + bj * 128) = w; } }
    }
};
struct EpiRes {
    static constexpr bool PERM = false, AFTER_DRAIN = false;
    const float* xlo; const float* xhi; float* xout; const float* modl; int goff;
    __device__ __forceinline__ void operator()(const f32x4 (&acc)[2][2][4][2], const pg8::Unit& u, int wr, int wc, int fr, int fq) const {
        const int pm = u.pm; const int midx = pm < 16 ? 0 : 1 + ((pm - 16) >> 4);
        const float* gv = modl + (size_t)midx * MODW + goff;
        const float* base = pm < 16 ? xlo + (size_t)pm * 256 * D : xhi + (size_t)(pm - 16) * 256 * D;
        float* ob = xout + (size_t)pm * 256 * D;
        const bool half = u.bh >= 0;
        const int col0 = u.pn * 256 + (u.bh > 0 ? 128 : 0) + wc * 32 + 4 * fq;
        f32x4 gvv[2][2];
#pragma unroll
        for (int bj = 0; bj < 2; ++bj)
#pragma unroll
            for (int n = 0; n < 2; ++n) gvv[bj][n] = (bj == 1 && half) ? (f32x4){0.f, 0.f, 0.f, 0.f} : *(const f32x4*)(gv + col0 + bj * 128 + n * 16);
#pragma unroll
        for (int ai = 0; ai < 2; ++ai)
#pragma unroll
            for (int m = 0; m < 4; ++m) { const size_t off = (size_t)(ai * 128 + wr * 64 + m * 16 + fr) * D + col0;
#pragma unroll
                for (int bj = 0; bj < 2; ++bj) { if (bj == 1 && half) continue;
#pragma unroll
                    for (int n = 0; n < 2; ++n) { const size_t o = off + bj * 128 + n * 16;
                        *(f32x4*)(ob + o) = *(const f32x4*)(base + o) + gvv[bj][n] * acc[ai][bj][m][n]; } }
                if (m & 1) asm volatile("" ::: "memory"); }
    }
};
struct EpiSwi {
    static constexpr bool PERM = true, AFTER_DRAIN = false;
    bf16* O; int ldc;
    __device__ __forceinline__ void operator()(const f32x4 (&acc)[2][2][4][2], const pg8::Unit& u, int wr, int wc, int fr, int fq) const {
        const int row0 = u.pm * 256 + wr * 64 + fr, col0 = u.pn * 128 + wc * 32 + 8 * fq;
#pragma unroll
        for (int ai = 0; ai < 2; ++ai)
#pragma unroll
            for (int m = 0; m < 4; ++m) { bf16* rowp = O + (size_t)(row0 + ai * 128 + m * 16) * ldc + col0;
                float h[8];
#pragma unroll
                for (int n = 0; n < 2; ++n)
#pragma unroll
                    for (int j = 0; j < 4; ++j) { const float gt = acc[ai][0][m][n][j], up = acc[ai][1][m][n][j]; h[n * 4 + j] = gt * fsigmoid(gt) * up; }
                u32x4 w; w.x = pg8::cvt_pk_bf16(h[0], h[1]); w.y = pg8::cvt_pk_bf16(h[2], h[3]); w.z = pg8::cvt_pk_bf16(h[4], h[5]); w.w = pg8::cvt_pk_bf16(h[6], h[7]);
                *(u32x4*)rowp = w; }
    }
};

template <int MAP>
__device__ __forceinline__ void tr_item(const float* W, int K, int N, bf16* WT, LAS float* scr, int item, int lane) {
    const int nblk = N / 32, kb = item / nblk, nb = item % nblk, k0 = 64 * kb, n0 = 32 * nb;
#pragma unroll 8
    for (int i = 0; i < 32; ++i) { const int kk = 2 * i + (lane >> 5); scr[kk * 33 + (lane & 31)] = W[(size_t)(k0 + kk) * N + n0 + (lane & 31)]; }
    LDS_WAIT(); asm volatile("" ::: "memory");
    const int c = lane & 7;
#pragma unroll
    for (int j = 0; j < 4; ++j) { const int n = (lane >> 3) + 8 * j; const LAS float* s = scr + (8 * c) * 33 + n;
        u32x4 o; o.x = pk2(s[0 * 33], s[1 * 33]); o.y = pk2(s[2 * 33], s[3 * 33]); o.z = pk2(s[4 * 33], s[5 * 33]); o.w = pk2(s[6 * 33], s[7 * 33]);
        const int nn = n0 + n; const int orow = MAP == 0 ? nn : (256 * (nn >> 7) + (nn & 127) + (MAP == 2 ? 128 : 0));
        *(u32x4*)(WT + (size_t)orow * K + k0 + 8 * c) = o; }
    LDS_WAIT(); asm volatile("" ::: "memory");
}
__device__ __forceinline__ void p0_prologue(Frame& F) {
    PH_LOCALS(F);
    LAS float* scr = (LAS float*)(F.lds + wave * 16384);
    const int gw = bx * NWAVES + wave, NGW = G * NWAVES;
    constexpr int I_IN = (D / 64) * (PIN / 32), I_OUT = (D / 64) * (D / 32), I_GU = (D / 64) * (DFF / 32), I_DN = (DFF / 64) * (D / 32);
    constexpr int PL = I_IN + I_OUT + 2 * I_GU + I_DN;
    for (int it = gw; it < NL * PL; it += NGW) {
        const int l = it / PL; int r = it % PL;
        if (r < I_IN) { tr_item<0>(F.in[I_WIN] + (size_t)l * D * PIN, D, PIN, (bf16*)(F.ws + WS_WIN + l * SZ_WIN), scr, r, lane); continue; } r -= I_IN;
        if (r < I_OUT) { tr_item<0>(F.in[I_WOUT] + (size_t)l * D * D, D, D, (bf16*)(F.ws + WS_WOUT + l * SZ_WOUT), scr, r, lane); continue; } r -= I_OUT;
        if (r < I_GU) { tr_item<1>(F.in[I_WG] + (size_t)l * D * DFF, D, DFF, (bf16*)(F.ws + WS_WGU + l * SZ_WGU), scr, r, lane); continue; } r -= I_GU;
        if (r < I_GU) { tr_item<2>(F.in[I_WU] + (size_t)l * D * DFF, D, DFF, (bf16*)(F.ws + WS_WGU + l * SZ_WGU), scr, r, lane); continue; } r -= I_GU;
        tr_item<0>(F.in[I_WD] + (size_t)l * DFF * D, DFF, D, (bf16*)(F.ws + WS_WD + l * SZ_WD), scr, r, lane);
    }
    const int gt = bx * 512 + tid, NGT = G * 512;
    { constexpr int PADV = (PINP - PIN) * D * 2 / 16;
      for (int i = gt; i < NL * PADV; i += NGT) { const int l = i / PADV, r = i % PADV; ((u32x4*)(F.ws + WS_WIN + l * SZ_WIN + (size_t)PIN * D * 2))[r] = (u32x4){0u, 0u, 0u, 0u}; } }
    { bf16* w2t = (bf16*)(F.ws + WS_W2T); bf16* a2t = (bf16*)(F.ws + WS_A2T); bf16* g2t = (bf16*)(F.ws + WS_G2T); bf16* wsp = (bf16*)(F.ws + WS_WSP);
      for (int i = gt; i < NL * 2 * 1024 * 64; i += NGT) { const int k = i & 63, n = (i >> 6) & 1023, ld = i >> 16;
          w2t[i] = (bf16)f2bf(F.in[I_W2][((size_t)ld * 64 + k) * 1024 + n]); a2t[i] = (bf16)f2bf(F.in[I_A2][((size_t)ld * 64 + k) * 1024 + n]); }
      for (int i = gt; i < NL * 1024 * 160; i += NGT) { const int k = i % 160, n = (i / 160) & 1023, l = i / (160 * 1024);
          g2t[i] = (bf16)f2bf(F.in[I_G2][((size_t)l * 160 + k) * 1024 + n]); }
      for (int i = gt; i < NL * 8 * 128 * 128; i += NGT) wsp[i] = (bf16)f2bf(F.in[I_WSP][i]); }
    __syncthreads();
    { LAS float* sv = (LAS float*)F.lds;
      LAS float* red = (LAS float*)(F.lds + 40960);
      for (int i = tid; i < 5 * D; i += 512) { const int r = i / D, k = i % D; const float c = r == 0 ? F.in[I_CCTX][k] : F.in[I_C][(r - 1) * D + k]; sv[i] = c * fsigmoid(c); }
      __syncthreads();
      float* mod = (float*)(F.ws + WS_MOD);
      const int c4 = tid & 15, kg = tid >> 4;
      for (int item = bx; item < NL * (MODW / 64); item += G) {
          const int l = item / (MODW / 64), n0 = (item % (MODW / 64)) * 64;
          const float* W = F.in[I_WMOD] + (size_t)l * D * MODW + n0 + 4 * c4;
          f32x4 a[5];
#pragma unroll
          for (int r = 0; r < 5; ++r) a[r] = (f32x4){0.f, 0.f, 0.f, 0.f};
#pragma unroll 4
          for (int i = 0; i < 64; ++i) { const int k = i * 32 + kg; const f32x4 w = *(const f32x4*)(W + (size_t)k * MODW);
#pragma unroll
              for (int r = 0; r < 5; ++r) a[r] += w * sv[r * D + k]; }
#pragma unroll
          for (int r = 0; r < 5; ++r) *(LAS f32x4*)(red + (kg * 5 + r) * 64 + 4 * c4) = a[r];
          __syncthreads();
          if (tid < 320) { const int r = tid >> 6, n = tid & 63; float s = 0.f;
#pragma unroll 8
              for (int g = 0; g < 32; ++g) s += red[(g * 5 + r) * 64 + n];
              mod[((size_t)l * 5 + r) * MODW + n0 + n] = s + F.in[I_BMOD][(size_t)l * MODW + n0 + n]; }
          __syncthreads();
      } }
}

__device__ __forceinline__ void p_adaln(Frame& F, int l, int which, const float* xlo, const float* xhi) {
    PH_LOCALS(F); PH_LAYER(l);
    const int gw = bx * NWAVES + wave, NGW = G * NWAVES;
    const float* ng = (which == 0 ? F.in[I_N1G] : F.in[I_N2G]) + (size_t)l * D;
    const int shoff = which == 0 ? 0 : 3 * D, scoff = shoff + D;
    const float* mod = (const float*)(F.ws + WS_MOD);
    bf16* H = (bf16*)(F.ws + WS_H);
    for (int row = gw; row < M; row += NGW) {
        const float* xr = row < MCTX ? xlo + (size_t)row * D : xhi + (size_t)(row - MCTX) * D;
        const int midx = row < MCTX ? 0 : 1 + ((row - MCTX) >> 12);
        const float* md = mod + ((size_t)l * 5 + midx) * MODW;
        f32x4 v[8]; float ss = 0.f;
#pragma unroll
        for (int j = 0; j < 8; ++j) { v[j] = *(const f32x4*)(xr + 4 * lane + 256 * j); ss += (v[j].x * v[j].x + v[j].y * v[j].y) + (v[j].z * v[j].z + v[j].w * v[j].w); }
        WAVE_SUM(ss); const float rstd = 1.0f / sqrtf(ss * (1.0f / D) + RMS_EPS);
#pragma unroll
        for (int j = 0; j < 8; ++j) { const int c = 4 * lane + 256 * j;
            const f32x4 g4 = *(const f32x4*)(ng + c), sc = *(const f32x4*)(md + scoff + c), sh = *(const f32x4*)(md + shoff + c);
            const f32x4 o = v[j] * rstd * g4 * (sc + 1.0f) + sh;
            u32x2 w; w.x = pk2(o.x, o.y); w.y = pk2(o.z, o.w);
            *(u32x2*)(H + (size_t)row * D + c) = w; }
    }
}

__device__ __forceinline__ void load_shifted8(const bf16* P, const float* mu, int row, int col, float (&o)[8]) {
    float g[8]; unpack8(*(const u32x4*)(P + (size_t)row * PINP + col), g);
    float a[8];
#pragma unroll
    for (int j = 0; j < 8; ++j) a[j] = g[j];
    int nrow[4]; bool has[4]; int nn;
    if (row < MCTX) { const int t = row & 255; nn = 2; nrow[0] = row - 1; has[0] = t > 0; nrow[1] = row + 1; has[1] = t < 255; nrow[2] = row; has[2] = false; nrow[3] = row; has[3] = false; }
    else { const int t = (row - MCTX) & 4095, gc = t & 63, gr = t >> 6; nn = 4;
        nrow[0] = row - 1; has[0] = gc > 0; nrow[1] = row + 1; has[1] = gc < 63; nrow[2] = row - 64; has[2] = gr > 0; nrow[3] = row + 64; has[3] = gr < 63; }
#pragma unroll
    for (int q = 0; q < 4; ++q) {
        if (q < nn) {
            float nb[8];
            if (has[q]) unpack8(*(const u32x4*)(P + (size_t)nrow[q] * PINP + col), nb);
            else {
#pragma unroll
                for (int j = 0; j < 8; ++j) nb[j] = 0.f; }
            const f32x4 m0 = *(const f32x4*)(mu + q * CSH + col), m1 = *(const f32x4*)(mu + q * CSH + col + 4);
#pragma unroll
            for (int j = 0; j < 4; ++j) { a[j] += m0[j] * (nb[j] - g[j]); a[4 + j] += m1[j] * (nb[4 + j] - g[4 + j]); }
        }
    }
#pragma unroll
    for (int j = 0; j < 8; ++j) o[j] = a[j];
}
__device__ __forceinline__ void p_shift(Frame& F, int l) {
    PH_LOCALS(F); PH_LAYER(l);
    const bf16* P = (const bf16*)(F.ws + WS_P); bf16* PS = (bf16*)(F.ws + WS_PS); bf16* LORA = (bf16*)(F.ws + WS_LORA);
    const float* mu = F.in[I_MU] + (size_t)l * 4 * CSH;
    constexpr int CG = CSH / 8;
    const int rpw = (M + G - 1) / G, rbeg = bx * rpw, rend = (rbeg + rpw < M) ? rbeg + rpw : M;
    if (tid < CG) {
        const int col = tid * 8; const int act = (col >= 3 * DA && col < 3 * DA + LW) ? 1 : (col >= 3 * DA + LW + LAA ? 2 : 0);
        f32x4 m[4][2];
#pragma unroll
        for (int q = 0; q < 4; ++q) { m[q][0] = *(const f32x4*)(mu + q * CSH + col); m[q][1] = *(const f32x4*)(mu + q * CSH + col + 4); }
        for (int r0 = rbeg; r0 < rend; r0 += 4) {
#pragma unroll
            for (int u = 0; u < 4; ++u) { const int row = r0 + u; if (row < rend) {
                const bf16* pc = P + (size_t)row * PINP + col;
                int nrow[4]; bool has[4]; int nn;
                if (row < MCTX) { const int t = row & 255; nn = 2; nrow[0] = -1; has[0] = t > 0; nrow[1] = 1; has[1] = t < 255; nrow[2] = 0; has[2] = false; nrow[3] = 0; has[3] = false; }
                else { const int t = (row - MCTX) & 4095, gc = t & 63, gr = t >> 6; nn = 4; nrow[0] = -1; has[0] = gc > 0; nrow[1] = 1; has[1] = gc < 63; nrow[2] = -64; has[2] = gr > 0; nrow[3] = 64; has[3] = gr < 63; }
                u32x4 raw[5]; raw[0] = *(const u32x4*)pc;
#pragma unroll
                for (int q = 0; q < 4; ++q) raw[1 + q] = (q < nn && has[q]) ? *(const u32x4*)(pc + (ptrdiff_t)nrow[q] * PINP) : (u32x4){0u, 0u, 0u, 0u};
                float g[8], a[8]; unpack8(raw[0], g);
#pragma unroll
                for (int jx = 0; jx < 8; ++jx) a[jx] = g[jx];
#pragma unroll
                for (int q = 0; q < 4; ++q) if (q < nn) { float nb[8]; unpack8(raw[1 + q], nb);
#pragma unroll
                    for (int jx = 0; jx < 4; ++jx) { a[jx] += m[q][0][jx] * (nb[jx] - g[jx]); a[4 + jx] += m[q][1][jx] * (nb[4 + jx] - g[4 + jx]); } }
                if (act == 1) {
#pragma unroll
                    for (int jx = 0; jx < 8; ++jx) a[jx] = ftanh(a[jx]); }
                else if (act == 2) {
#pragma unroll
                    for (int jx = 0; jx < 8; ++jx) a[jx] = fsigmoid(a[jx]); }
                if (col >= 3 * DA) { const int cgl = (col - 3 * DA) >> 3;
                    *(u32x4*)(LORA + ((((size_t)(row >> 4) * 9 + (cgl >> 2)) * 64 + 16 * (cgl & 3) + (row & 15)) << 3)) = pack8(a); }
                else *(u32x4*)(PS + (size_t)row * CSH + col) = pack8(a); } }
        }
    }
}

#define F4Z ((f32x4){0.f, 0.f, 0.f, 0.f})
__device__ __forceinline__ u32x2 pk4(const f32x4 a) { u32x2 w; w.x = pk2(a[0], a[1]); w.y = pk2(a[2], a[3]); return w; }
#define LBAR() do { asm volatile("s_waitcnt lgkmcnt(0)" ::: "memory"); __builtin_amdgcn_s_barrier(); asm volatile("" ::: "memory"); } while (0)
constexpr int VTS = 136;
typedef short s16x4g __attribute__((ext_vector_type(4)));
__device__ __forceinline__ bf16x8 frag_tr_ld(const LAS bf16* X, int ld, int kbase, int c0, int fr, int fq) {
    const LAS bf16* p = X + (kbase + 8 * fq + (fr >> 2)) * ld + c0 + 4 * (fr & 3);
    const s16x4g lo = __builtin_amdgcn_ds_read_tr16_b64_v4i16((LAS s16x4g*)p);
    const s16x4g hi = __builtin_amdgcn_ds_read_tr16_b64_v4i16((LAS s16x4g*)(p + 4 * ld));
    return (bf16x8){lo[0], lo[1], lo[2], lo[3], hi[0], hi[1], hi[2], hi[3]};
}
__device__ __forceinline__ void p_gmlp(Frame& F, int l, int slot, int nslots) {
    PH_LOCALS(F); PH_LAYER(l); (void)bx; (void)G;
    const bf16* P = (const bf16*)(F.ws + WS_P); bf16* O = (bf16*)(F.ws + WS_O);
    const bf16* wsp = (const bf16*)(F.ws + WS_WSP) + (size_t)l * 8 * 128 * 128;
    LAS bf16* VN = (LAS bf16*)F.lds;
    LAS bf16* ST = (LAS bf16*)(F.lds + 34816);
    const int fr = lane & 15, fq = lane >> 4;
    constexpr int NIT = (M / 128) * NG;
    const int jrow = tid >> 2, q4 = tid & 3;
    u32x4 pvv[4];
#define GM_ISSUE(item_) do { const bf16* src_ = P + (size_t)(((item_) >> 3) * 128 + jrow) * PINP + CSH + DB + 128 * ((item_) & 7) + 32 * q4; \
        _Pragma("unroll") for (int i_ = 0; i_ < 4; ++i_) pvv[i_] = *(const u32x4*)(src_ + 8 * i_); } while (0)
    if (slot < 0) return;
    LBAR();
    if (slot < NIT) GM_ISSUE(slot);
    for (int item = slot; item < NIT; item += nslots) {
        const int cb = item >> 3, g = item & 7, R0 = cb * 128;
        u32x4 pu[4]; { const bf16* up = P + (size_t)(R0 + jrow) * PINP + CSH + 128 * g + 32 * q4;
#pragma unroll
            for (int i = 0; i < 4; ++i) pu[i] = *(const u32x4*)(up + 8 * i); }
        bf16x8 bw[4]; { const bf16* wa = wsp + ((size_t)g * 128 + 16 * wave + fr) * 128 + 8 * fq;
#pragma unroll
            for (int ks = 0; ks < 4; ++ks) bw[ks] = *(const bf16x8*)(wa + 32 * ks); }
        const float bsp = F.in[I_BSP][((size_t)l * 8 + g) * 128 + jrow];
        { float v[32];
#pragma unroll
          for (int i = 0; i < 4; ++i) { float f[8]; unpack8(pvv[i], f);
#pragma unroll
              for (int jj = 0; jj < 8; ++jj) v[8 * i + jj] = f[jj]; }
          float s = 0.f;
#pragma unroll
          for (int i = 0; i < 32; ++i) s += v[i];
          s += SHX(s, 1); s += SHX(s, 2);
          const float mean = s * (1.0f / 128.0f); float qq = 0.f;
#pragma unroll
          for (int i = 0; i < 32; ++i) { v[i] -= mean; qq += v[i] * v[i]; }
          qq += SHX(qq, 1); qq += SHX(qq, 2);
          const float rstd = 1.0f / sqrtf(qq * (1.0f / 128.0f) + LN_EPS);
          const float* lg = F.in[I_LNG] + ((size_t)l * 8 + g) * 128 + 32 * q4; const float* lb = F.in[I_LNB] + ((size_t)l * 8 + g) * 128 + 32 * q4;
#pragma unroll
          for (int i = 0; i < 4; ++i) { float o[8]; const f32x4 g0 = *(const f32x4*)(lg + 8 * i), g1 = *(const f32x4*)(lg + 8 * i + 4), b0 = *(const f32x4*)(lb + 8 * i), b1 = *(const f32x4*)(lb + 8 * i + 4);
#pragma unroll
              for (int jj = 0; jj < 4; ++jj) { o[jj] = v[8 * i + jj] * rstd * g0[jj] + b0[jj]; o[4 + jj] = v[8 * i + 4 + jj] * rstd * g1[jj] + b1[jj]; }
              *(LAS u32x4*)(VN + jrow * VTS + 32 * q4 + 8 * i) = pack8(o); } }
        if (item + nslots < NIT) GM_ISSUE(item + nslots);
        LBAR();
#pragma unroll
        for (int mt = 0; mt < 8; ++mt) { f32x4 acc = F4Z;
#pragma unroll
            for (int ks = 0; ks < 4; ++ks) acc = __builtin_amdgcn_mfma_f32_16x16x32_bf16(frag_tr_ld(VN, VTS, 32 * ks, 16 * mt, fr, fq), bw[ks], acc, 0, 0, 0);
            *(LAS u32x2*)(ST + (16 * wave + fr) * VTS + 16 * mt + 4 * fq) = pk4(acc); }
        LBAR();
        { bf16* op = O + (size_t)(R0 + jrow) * D + DA + 128 * g + 32 * q4;
#pragma unroll
          for (int i = 0; i < 4; ++i) { float sv[8], uv[8], o[8]; unpack8(*(const LAS u32x4*)(ST + jrow * VTS + 32 * q4 + 8 * i), sv); unpack8(pu[i], uv);
#pragma unroll
              for (int jj = 0; jj < 8; ++jj) o[jj] = uv[jj] * (sv[jj] + bsp);
              *(u32x4*)(op + 8 * i) = pack8(o); } }
    }
    LBAR();
#undef GM_ISSUE
}

constexpr int T16B = 9216, LD16 = 72, LD32 = 68;
#define SLOT(i) ((LAS bf16*)(lds + (i) * T16B))
#define SLOTF(i) ((LAS float*)(lds + (i) * T16B))
template <int NK>
__device__ __forceinline__ f32x4 tile_mm(const LAS bf16* A, int lda, const LAS bf16* B, int ldb, int fr, int fq, f32x4 acc) {
#pragma unroll
    for (int ks = 0; ks < NK; ++ks) { const bf16x8 a = *(const LAS bf16x8*)(A + fr * lda + 8 * fq + 32 * ks); const bf16x8 b = *(const LAS bf16x8*)(B + fr * ldb + 8 * fq + 32 * ks);
        acc = __builtin_amdgcn_mfma_f32_16x16x32_bf16(a, b, acc, 0, 0, 0); }
    return acc;
}
__device__ __forceinline__ void st_nat(LAS bf16* dst, int n0, int m0, int fr, int fq, const f32x4 a) { *(LAS u32x2*)(dst + (n0 + fr) * LD16 + m0 + 4 * fq) = pk4(a); }
__device__ __forceinline__ void st_rm(LAS bf16* dst, int n0, int m0, int fr, int fq, const f32x4 a) {
#pragma unroll
    for (int r = 0; r < 4; ++r) dst[(m0 + 4 * fq + r) * LD16 + n0 + fr] = (bf16)f2bf(a[r]); }
__device__ __forceinline__ f32x4 ld4bf(const LAS bf16* p) { const u32x2 w = *(const LAS u32x2*)p; return (f32x4){__uint_as_float(w.x << 16), __uint_as_float(w.x & 0xffff0000u), __uint_as_float(w.y << 16), __uint_as_float(w.y & 0xffff0000u)}; }

__device__ __forceinline__ int fm_off(int n0, int m0, int fr, int fq) { return ((((n0 >> 4) * 2 + (m0 >> 5)) * 64 + (2 * ((m0 >> 4) & 1) + (fq >> 1)) * 16 + fr) << 3) + 4 * (fq & 1); }
typedef short s16x4 __attribute__((ext_vector_type(4)));
__device__ __forceinline__ bf16x8 frag_tr(const LAS bf16* X, int kbase, int c0, int fr, int fq) {
    const LAS bf16* p = X + (kbase + 8 * fq + (fr >> 2)) * LD16 + c0 + 4 * (fr & 3);
    const s16x4 lo = __builtin_amdgcn_ds_read_tr16_b64_v4i16((LAS s16x4*)p);
    const s16x4 hi = __builtin_amdgcn_ds_read_tr16_b64_v4i16((LAS s16x4*)(p + 4 * LD16));
    return (bf16x8){lo[0], lo[1], lo[2], lo[3], hi[0], hi[1], hi[2], hi[3]};
}
__device__ __forceinline__ bf16x8 frag_rm(const LAS bf16* X, int r0, int ks, int fr, int fq) { return *(const LAS bf16x8*)(X + (r0 + fr) * LD16 + 8 * fq + 32 * ks); }
__device__ __forceinline__ f32x4 mm2(const bf16x8 (&a)[2], const bf16x8 (&b)[2], f32x4 acc) {
    acc = __builtin_amdgcn_mfma_f32_16x16x32_bf16(a[0], b[0], acc, 0, 0, 0); return __builtin_amdgcn_mfma_f32_16x16x32_bf16(a[1], b[1], acc, 0, 0, 0); }
__device__ __forceinline__ bf16x8 as_frag(const u32x4 q) { return __builtin_bit_cast(bf16x8, q); }

__device__ __forceinline__ void p_chunkA(Frame& F, int l) {
    PH_LOCALS(F); PH_LAYER(l);
    LAS unsigned char* lds = F.lds;
    const int lane0 = lane, lane00 = lane;
#define STG int lane_ = lane0; asm volatile("" : "+v"(lane_)); const int lane = lane_, fr = lane_ & 15, fq = lane_ >> 4, tid = wave * 64 + lane_, mt = wave >> 1, m0 = 16 * mt, np = (wave & 1) * 2; \
    (void)lane; (void)fr; (void)fq; (void)tid; (void)mt; (void)m0; (void)np;
    const bf16* PS = (const bf16*)(F.ws + WS_PS);
    const bf16* w2t = (const bf16*)(F.ws + WS_W2T) + (size_t)l * 2 * 1024 * 64;
    const bf16* a2t = (const bf16*)(F.ws + WS_A2T) + (size_t)l * 2 * 1024 * 64;
    const bf16* g2t = (const bf16*)(F.ws + WS_G2T) + (size_t)l * 1024 * 160;
    bf16* GATE = (bf16*)(F.ws + WS_GATE); float* BONUS = (float*)(F.ws + WS_BONUS);
    LAS float* gC = (LAS float*)(lds + 14 * T16B);
    LAS float* BT = (LAS float*)(lds + 14 * T16B + 256);
    u32x4 pf_w[2], pf_a[2], pf_g[5], pf_r, pf_k, pf_v; bf16x8 Bg[2][5], Bw[2][2], Ba[2][2]; float biw[2], bia[2];
#define CA_ISSUE(item_, d_) do { const int ci_ = (item_) >> 4, h_ = (item_) & 15, R0_ = ci_ * 64; int lane0 = lane00; asm volatile("" : "+v"(lane0)); \
        const bf16* arow_ = (const bf16*)(F.ws + WS_LORA) + ((((size_t)(R0_ >> 4) + (wave >> 1)) * 9 * 64 + lane0) << 3); \
        pf_w[0] = *(const u32x4*)arow_; pf_w[1] = *(const u32x4*)(arow_ + 512); pf_a[0] = *(const u32x4*)(arow_ + 1024); pf_a[1] = *(const u32x4*)(arow_ + 1536); \
        if ((d_) == 0) { _Pragma("unroll") for (int ks_ = 0; ks_ < 5; ++ks_) { pf_g[ks_] = *(const u32x4*)(arow_ + 2048 + 512 * ks_); \
            _Pragma("unroll") for (int nn_ = 0; nn_ < 2; ++nn_) Bg[nn_][ks_] = *(const bf16x8*)(g2t + (size_t)(64 * h_ + 16 * ((wave & 1) * 2 + nn_) + (lane0 & 15)) * 160 + 8 * (lane0 >> 4) + 32 * ks_); } } \
        _Pragma("unroll") for (int nn_ = 0; nn_ < 2; ++nn_) { const int n_ = 64 * h_ + 16 * ((wave & 1) * 2 + nn_) + (lane0 & 15); \
            biw[nn_] = F.in[I_W0][((size_t)l * 2 + (d_)) * DA + n_]; bia[nn_] = F.in[I_A0][((size_t)l * 2 + (d_)) * DA + n_]; \
            _Pragma("unroll") for (int ks_ = 0; ks_ < 2; ++ks_) { Bw[nn_][ks_] = *(const bf16x8*)(w2t + ((size_t)(d_) * 1024 + n_) * 64 + 8 * (lane0 >> 4) + 32 * ks_); Ba[nn_][ks_] = *(const bf16x8*)(a2t + ((size_t)(d_) * 1024 + n_) * 64 + 8 * (lane0 >> 4) + 32 * ks_); } } \
        const int tid_ = wave * 64 + lane0, tau_ = tid_ >> 3, pos_ = (d_) ? 63 - tau_ : tau_; const bf16* rrow_ = PS + (size_t)(R0_ + pos_) * CSH + 64 * h_ + (tid_ & 7) * 8; \
        pf_r = *(const u32x4*)rrow_; pf_k = *(const u32x4*)(rrow_ + DA); pf_v = *(const u32x4*)(rrow_ + 2 * DA); } while (0)
    if (bx < (M / 64) * NH) CA_ISSUE(bx, 0);
    int hcur = -1;
    LAS float* HC = (LAS float*)(lds + 14 * T16B + 1280);
    for (int item = bx; item < (M / 64) * NH; item += G) {
        const int ci = item >> 4, h = item & 15, R0 = ci * 64;
        { (void)hcur;
            LBAR();
            { const int t_ = wave * 64 + lane0; if (t_ < 192) { const int w_ = t_ >> 6, c_ = t_ & 63; HC[t_] = (w_ == 0 ? F.in[I_KK] : (w_ == 1 ? F.in[I_KA] : F.in[I_RK]))[(size_t)l * DA + 64 * h + c_]; } } }
#pragma unroll
        for (int d = 0; d < 2; ++d) {
            const size_t qi = ((size_t)ci * 16 + h) * 2 + d;
            const bf16x8 cBw[2][2] = {{Bw[0][0], Bw[0][1]}, {Bw[1][0], Bw[1][1]}}, cBa[2][2] = {{Ba[0][0], Ba[0][1]}, {Ba[1][0], Ba[1][1]}}; const float cbw[2] = {biw[0], biw[1]}, cba[2] = {bia[0], bia[1]};
            u32x4 cw[2] = {pf_w[0], pf_w[1]}, ca[2] = {pf_a[0], pf_a[1]}, cg[5] = {pf_g[0], pf_g[1], pf_g[2], pf_g[3], pf_g[4]}; const u32x4 cr = pf_r, ck = pf_k, cv = pf_v;
            for (int repA = 0; repA < (PROBE_SUB == 1 ? 2 : 1); ++repA) {
            { STG; LAS float* AL = SLOTF(5); LAS float* LW = SLOTF(7);
              bf16x8 aw[2], aa[2];
#pragma unroll
              for (int ks = 0; ks < 2; ++ks) { aw[ks] = as_frag(cw[ks]); aa[ks] = as_frag(ca[ks]); }
#pragma unroll
              for (int nn = 0; nn < 2; ++nn) { const int nl = 16 * (np + nn) + fr, n = 64 * h + nl;
                  const f32x4 accw = mm2(aw, cBw[nn], F4Z), acca = mm2(aa, cBa[nn], F4Z);
                  const float biasw = cbw[nn], biasa = cba[nn]; (void)n;
                  float lw[4], c[4];
#pragma unroll
                  for (int r = 0; r < 4; ++r) lw[r] = -0.8750345269f * fsigmoid(biasw + accw[r]);
                  if (d == 0) { c[0] = lw[0]; c[1] = c[0] + lw[1]; c[2] = c[1] + lw[2]; c[3] = c[2] + lw[3]; }
                  else { c[3] = lw[3]; c[2] = c[3] + lw[2]; c[1] = c[2] + lw[1]; c[0] = c[1] + lw[0]; }
                  const float tot = d == 0 ? c[3] : c[0];
                  const float t1 = SHX(tot, 16), t2 = SHX(tot, 32), t3 = SHX(tot, 48);
                  float off;
                  { const int sg = d ? -1 : 1, q1 = fq ^ 1, q2 = fq ^ 2, q3 = fq ^ 3;
                    const int k1 = (sg * (q1 - fq)) >> 31, k2 = (sg * (q2 - fq)) >> 31, k3 = (sg * (q3 - fq)) >> 31;
                    off = (__int_as_float(__float_as_int(t1) & k1) + __int_as_float(__float_as_int(t2) & k2)) + __int_as_float(__float_as_int(t3) & k3); }
#pragma unroll
                  for (int r = 0; r < 4; ++r) { const int pos = m0 + 4 * fq + r, tau = d ? 63 - pos : pos;
                      LW[tau * LD32 + nl] = c[r] + off; AL[tau * LD32 + nl] = fsigmoid(biasa + acca[r]); }
                  if (fq == 0) BT[(d ? 3 - mt : mt) * 64 + nl] = (tot + t1) + (t2 + t3); }
              if (d == 0) {
                  bf16x8 ag[5];
#pragma unroll
                  for (int ks = 0; ks < 5; ++ks) ag[ks] = as_frag(cg[ks]);
#pragma unroll
                  for (int nn = 0; nn < 2; ++nn) { const int n = 64 * h + 16 * (np + nn) + fr; f32x4 acc = F4Z;
#pragma unroll
                      for (int ks = 0; ks < 5; ++ks) acc = __builtin_amdgcn_mfma_f32_16x16x32_bf16(ag[ks], Bg[nn][ks], acc, 0, 0, 0);
#pragma unroll
                      for (int r = 0; r < 4; ++r) SLOT(11)[(m0 + 4 * fq + r) * LD16 + 16 * (np + nn) + fr] = (bf16)f2bf(acc[r]); (void)n; } } }
            LBAR();
            { STG; const LAS float* AL = SLOTF(5); const LAS float* LW = SLOTF(7);
              const int tau = tid >> 3, c8 = (tid & 7) * 8, pos = d ? 63 - tau : tau, row = R0 + pos, blk = wave >> 1;
              f32x2 r[4], k[4];
              { const u32x4 q = cr; r[0] = (f32x2){__uint_as_float(q.x << 16), __uint_as_float(q.x & 0xffff0000u)}; r[1] = (f32x2){__uint_as_float(q.y << 16), __uint_as_float(q.y & 0xffff0000u)};
                r[2] = (f32x2){__uint_as_float(q.z << 16), __uint_as_float(q.z & 0xffff0000u)}; r[3] = (f32x2){__uint_as_float(q.w << 16), __uint_as_float(q.w & 0xffff0000u)}; }
              { const u32x4 q = ck; k[0] = (f32x2){__uint_as_float(q.x << 16), __uint_as_float(q.x & 0xffff0000u)}; k[1] = (f32x2){__uint_as_float(q.y << 16), __uint_as_float(q.y & 0xffff0000u)};
                k[2] = (f32x2){__uint_as_float(q.z << 16), __uint_as_float(q.z & 0xffff0000u)}; k[3] = (f32x2){__uint_as_float(q.w << 16), __uint_as_float(q.w & 0xffff0000u)}; }
              f32x2 offb[4], totC[4];
#pragma unroll
              for (int j = 0; j < 4; ++j) { offb[j] = (f32x2){0.f, 0.f}; totC[j] = (f32x2){0.f, 0.f}; }
#pragma unroll
              for (int b = 0; b < 4; ++b) { const f32x4 x0 = *(const LAS f32x4*)(BT + b * 64 + c8), x1 = *(const LAS f32x4*)(BT + b * 64 + c8 + 4);
                  const f32x2 y[4] = {{x0[0], x0[1]}, {x0[2], x0[3]}, {x1[0], x1[1]}, {x1[2], x1[3]}};
                  const float fb = b < blk ? 1.0f : 0.0f;
#pragma unroll
                  for (int j = 0; j < 4; ++j) { totC[j] += y[j]; offb[j] += y[j] * fb; } }
              f32x2 ckk[4], cka[4], crk[4];
              { const f32x4 a0 = *(const LAS f32x4*)(HC + c8), a1 = *(const LAS f32x4*)(HC + c8 + 4), b0 = *(const LAS f32x4*)(HC + 64 + c8), b1 = *(const LAS f32x4*)(HC + 64 + c8 + 4), c0 = *(const LAS f32x4*)(HC + 128 + c8), c1 = *(const LAS f32x4*)(HC + 128 + c8 + 4);
                ckk[0] = (f32x2){a0[0], a0[1]}; ckk[1] = (f32x2){a0[2], a0[3]}; ckk[2] = (f32x2){a1[0], a1[1]}; ckk[3] = (f32x2){a1[2], a1[3]};
                cka[0] = (f32x2){b0[0], b0[1]}; cka[1] = (f32x2){b0[2], b0[3]}; cka[2] = (f32x2){b1[0], b1[1]}; cka[3] = (f32x2){b1[2], b1[3]};
                crk[0] = (f32x2){c0[0], c0[1]}; crk[1] = (f32x2){c0[2], c0[3]}; crk[2] = (f32x2){c1[0], c1[1]}; crk[3] = (f32x2){c1[2], c1[3]}; }
              f32x2 kk[4], s2 = (f32x2){0.f, 0.f};
#pragma unroll
              for (int j = 0; j < 4; ++j) { kk[j] = k[j] * ckk[j]; s2 += kk[j] * kk[j]; }
              float ss = s2.x + s2.y;
              ss += SHX(ss, 1); ss += SHX(ss, 2); ss += SHX(ss, 4);
              const float rn = 1.0f / sqrtf(fmaxf(ss, 1e-24f));
              f32x2 alv[4], csv[4], csm[4];
              { const f32x4 a0 = *(const LAS f32x4*)(AL + tau * LD32 + c8), a1 = *(const LAS f32x4*)(AL + tau * LD32 + c8 + 4), c0 = *(const LAS f32x4*)(LW + tau * LD32 + c8), c1 = *(const LAS f32x4*)(LW + tau * LD32 + c8 + 4);
                const int tm = (tau & 15) ? tau - 1 : tau; f32x4 e0 = *(const LAS f32x4*)(LW + tm * LD32 + c8), e1 = *(const LAS f32x4*)(LW + tm * LD32 + c8 + 4);
                if ((tau & 15) == 0) { e0 = F4Z; e1 = F4Z; }
                alv[0] = (f32x2){a0[0], a0[1]}; alv[1] = (f32x2){a0[2], a0[3]}; alv[2] = (f32x2){a1[0], a1[1]}; alv[3] = (f32x2){a1[2], a1[3]};
                csv[0] = (f32x2){c0[0], c0[1]} + offb[0]; csv[1] = (f32x2){c0[2], c0[3]} + offb[1]; csv[2] = (f32x2){c1[0], c1[1]} + offb[2]; csv[3] = (f32x2){c1[2], c1[3]} + offb[3];
                csm[0] = (f32x2){e0[0], e0[1]} + offb[0]; csm[1] = (f32x2){e0[2], e0[3]} + offb[1]; csm[2] = (f32x2){e1[0], e1[1]} + offb[2]; csm[3] = (f32x2){e1[2], e1[3]} + offb[3]; }
              f32x2 at[4], rt[4], bt[4], kt[4], bh[4], kh[4], bon2 = (f32x2){0.f, 0.f};
#pragma unroll
              for (int j = 0; j < 4; ++j) { const f32x2 al = alv[j], cs = csv[j], dh = totC[j] - cs;
                  const f32x2 kkn = kk[j] * rn, kd = k[j] * ((al - 1.0f) * cka[j] + 1.0f), bb = kkn * al;
                  bon2 += r[j] * kd * crk[j];
                  const f32x2 encs = (f32x2){__builtin_amdgcn_exp2f(-cs.x), __builtin_amdgcn_exp2f(-cs.y)}, eh = (f32x2){__builtin_amdgcn_exp2f(dh.x), __builtin_amdgcn_exp2f(dh.y)};
                  const f32x2 ecm = (f32x2){__builtin_amdgcn_exp2f(csm[j].x), __builtin_amdgcn_exp2f(csm[j].y)}, ecs = (f32x2){__builtin_amdgcn_exp2f(cs.x), __builtin_amdgcn_exp2f(cs.y)};
                  at[j] = -(ecm * kkn); rt[j] = ecs * r[j]; bt[j] = encs * bb; kt[j] = encs * kd; bh[j] = eh * bb; kh[j] = eh * kd; }
              if (tau == 63) {
#pragma unroll
                  for (int j = 0; j < 4; ++j) { gC[c8 + 2 * j] = __builtin_amdgcn_exp2f(totC[j].x); gC[c8 + 2 * j + 1] = __builtin_amdgcn_exp2f(totC[j].y); } }
#define PK8V(a) ((u32x4){pk2(a[0].x, a[0].y), pk2(a[1].x, a[1].y), pk2(a[2].x, a[2].y), pk2(a[3].x, a[3].y)})
              *(LAS u32x4*)(SLOT(0) + tau * LD16 + c8) = PK8V(at); *(LAS u32x4*)(SLOT(1) + tau * LD16 + c8) = PK8V(rt);
              *(LAS u32x4*)(SLOT(2) + tau * LD16 + c8) = PK8V(bt); *(LAS u32x4*)(SLOT(3) + tau * LD16 + c8) = PK8V(kt);
              *(LAS u32x4*)(SLOT(4) + tau * LD16 + c8) = PK8V(bh); *(LAS u32x4*)(SLOT(9) + tau * LD16 + c8) = PK8V(kh);
#undef PK8V
              *(LAS u32x4*)(SLOT(10) + tau * LD16 + c8) = cv;
              if (d == 0) *(u32x4*)(GATE + (size_t)row * DA + 64 * h + c8) = *(const LAS u32x4*)(SLOT(11) + pos * LD16 + c8);
              float bon = bon2.x + bon2.y;
              bon += SHX(bon, 1); bon += SHX(bon, 2); bon += SHX(bon, 4);
              BONUS[((size_t)d * M + row) * NH + h] = bon; }
            LBAR();
            }
            { int nitem = d == 0 ? item : item + G; const int nd = d ^ 1; if (nitem >= (M / 64) * NH) nitem = item; CA_ISSUE(nitem, nd); }
            for (int repB = 0; repB < (PROBE_SUB == 2 ? 2 : 1); ++repB) {
            { STG; bf16x8 aB[2], aA[2], aK[2];
#pragma unroll
              for (int ks = 0; ks < 2; ++ks) { aB[ks] = frag_rm(SLOT(2), m0, ks, fr, fq); aA[ks] = frag_rm(SLOT(0), m0, ks, fr, fq); aK[ks] = frag_rm(SLOT(3), m0, ks, fr, fq); }
#pragma unroll
              for (int nn = 0; nn < 2; ++nn) { const int n0 = 16 * (np + nn), n = n0 + fr; bf16x8 bA[2], bB[2], bK[2], bR[2];
#pragma unroll
                  for (int ks = 0; ks < 2; ++ks) { bA[ks] = frag_rm(SLOT(0), n0, ks, fr, fq); bB[ks] = frag_rm(SLOT(2), n0, ks, fr, fq); bK[ks] = frag_rm(SLOT(3), n0, ks, fr, fq); bR[ks] = frag_rm(SLOT(1), n0, ks, fr, fq); }
                  f32x4 p0 = mm2(aB, bA, F4Z), p1 = mm2(aA, bB, F4Z), p2 = mm2(aA, bK, F4Z), p3 = mm2(aB, bR, F4Z), p4 = mm2(aK, bR, F4Z), t0;
#pragma unroll
                  for (int r = 0; r < 4; ++r) { const int m = m0 + 4 * fq + r;
                      p0[r] = m < n ? p0[r] : 0.f; p1[r] = n < m ? p1[r] : 0.f; p2[r] = n < m ? p2[r] : 0.f; p3[r] = m <= n ? p3[r] : 0.f; p4[r] = m <= n ? p4[r] : 0.f;
                      t0[r] = p1[r] + (m == n ? 1.0f : 0.f); }
                  st_nat(SLOT(5), n0, m0, fr, fq, p0); st_nat(SLOT(6), n0, m0, fr, fq, p1); st_nat(SLOT(7), n0, m0, fr, fq, t0);
                  st_nat(SLOT(8), n0, m0, fr, fq, p2); st_nat(SLOT(11), n0, m0, fr, fq, p3); st_nat(SLOT(12), n0, m0, fr, fq, p4); } }
            LBAR();
#define MM1(a, b, c) __builtin_amdgcn_mfma_f32_16x16x32_bf16(a, b, c, 0, 0, 0)
            { STG; const int b = wave >> 2, bm0 = 32 * b + 16 * ((wave >> 1) & 1), bn0 = 32 * b + 16 * (wave & 1), oc = 32 * (1 - b) - 32 * b;
              const bf16x8 aT = frag_rm(SLOT(5), bm0, b, fr, fq), aR = frag_rm(SLOT(6), bm0, b, fr, fq), bR = frag_rm(SLOT(6), bn0, b, fr, fq), bT = frag_rm(SLOT(5), bn0, b, fr, fq);
              st_nat(SLOT(2), bn0, bm0, fr, fq, MM1(aT, bR, F4Z)); st_nat(SLOT(2), bn0, bm0 + oc, fr, fq, MM1(aR, bT, F4Z)); }
            LBAR();
#pragma unroll
            for (int kq = 1; kq <= 4; ++kq) {
                STG; const int b = wave >> 2, bm0 = 32 * b + 16 * ((wave >> 1) & 1), bn0 = 32 * b + 16 * (wave & 1), oc = 32 * (1 - b) - 32 * b;
                const int pin = (kq & 1) ? 2 : 3, pout = (kq & 1) ? 3 : 2, tin = (kq & 1) ? 7 : 13, tout = (kq & 1) ? 13 : 7;
                const bf16x8 aPT = frag_rm(SLOT(pin), bm0, 1 - b, fr, fq), bTn = frag_rm(SLOT(tin), bn0, b, fr, fq);
                st_nat(SLOT(tout), bn0, bm0, fr, fq, MM1(aPT, bTn, ld4bf(SLOT(tin) + (bn0 + fr) * LD16 + bm0 + 4 * fq)));
                if (kq < 4) { const bf16x8 aPR = frag_rm(SLOT(pin), bm0, b, fr, fq), bPR = frag_rm(SLOT(pin), bn0, b, fr, fq), bPT = frag_rm(SLOT(pin), bn0, 1 - b, fr, fq);
                    st_nat(SLOT(pout), bn0, bm0, fr, fq, MM1(aPT, bPR, F4Z));
                    st_nat(SLOT(pout), bn0, bm0 + oc, fr, fq, MM1(aPR, bPT, F4Z)); }
                LBAR();
            }
            { STG; if (wave < 4) { const int xm0 = 16 * ((wave >> 1) & 1), xn0 = 32 + 16 * (wave & 1);
                  const bf16x8 a = frag_rm(SLOT(6), xm0, 1, fr, fq), bb = frag_tr(SLOT(7), 32, xn0, fr, fq);
                  st_nat(SLOT(13), xn0, xm0, fr, fq, MM1(a, bb, F4Z)); } }
            LBAR();
            { STG; if (wave < 4) { const int tn0 = 32 + 16 * ((wave >> 1) & 1), tm0 = 16 * (wave & 1);
                  const bf16x8 a = frag_rm(SLOT(13), tn0, 0, fr, fq), bb = frag_rm(SLOT(7), tm0, 0, fr, fq);
                  st_nat(SLOT(7), tm0, tn0, fr, fq, MM1(a, bb, F4Z)); } }
            LBAR();
#undef MM1
            { STG; const int xt = wave, n0 = 16 * (xt & 3); bf16x8 b[2];
              if (xt < 4) { b[0] = frag_rm(SLOT(11), n0, 0, fr, fq); b[1] = frag_rm(SLOT(11), n0, 1, fr, fq); }
              else { b[0] = frag_tr(SLOT(4), 0, n0, fr, fq); b[1] = frag_tr(SLOT(4), 32, n0, fr, fq); }
#pragma unroll
              for (int mm = 0; mm < 4; ++mm) { bf16x8 a[2] = {frag_rm(SLOT(7), 16 * mm, 0, fr, fq), frag_rm(SLOT(7), 16 * mm, 1, fr, fq)};
                  st_nat(xt < 4 ? SLOT(5) : SLOT(6), n0, 16 * mm, fr, fq, mm2(a, b, F4Z)); } }
            LBAR();
            }
            for (int repC = 0; repC < (PROBE_SUB == 3 ? 2 : 1); ++repC) {
            { STG; bf16x8 aAt[2] = {frag_tr(SLOT(0), 0, m0, fr, fq), frag_tr(SLOT(0), 32, m0, fr, fq)}, aAk[2] = {frag_rm(SLOT(8), m0, 0, fr, fq), frag_rm(SLOT(8), m0, 1, fr, fq)};
              bf16* pyt = (bf16*)(F.ws + WS_PYT) + qi * 4096; bf16* qyt = (bf16*)(F.ws + WS_QYT) + qi * 4096; bf16* pst = (bf16*)(F.ws + WS_PST) + qi * 4096;
#pragma unroll
              for (int nn = 0; nn < 2; ++nn) { const int n0 = 16 * (np + nn), n = n0 + fr, mb = m0 + 4 * fq;
                  bf16x8 bRb[2] = {frag_rm(SLOT(5), n0, 0, fr, fq), frag_rm(SLOT(5), n0, 1, fr, fq)}, bBh[2] = {frag_rm(SLOT(6), n0, 0, fr, fq), frag_rm(SLOT(6), n0, 1, fr, fq)};
                  const f32x4 py = mm2(aAt, bRb, ld4bf(SLOT(1) + n * LD16 + mb)), qy = mm2(aAk, bRb, ld4bf(SLOT(12) + n * LD16 + mb));
                  f32x4 psi, qsi;
#pragma unroll
                  for (int r = 0; r < 4; ++r) { psi[r] = (mb + r == n) ? gC[n] : 0.f; qsi[r] = bf2f(SLOT(9)[(mb + r) * LD16 + n]); }
                  const f32x4 ps = mm2(aAt, bBh, psi), qs = mm2(aAk, bBh, qsi);
                  { const int fo = fm_off(n0, m0, fr, fq); *(u32x2*)(pyt + fo) = pk4(py); *(u32x2*)(qyt + fo) = pk4(qy); *(u32x2*)(pst + fo) = pk4(ps); }
                  st_nat(SLOT(2), n0, m0, fr, fq, qs); } }
            LBAR();
            { STG; bf16* nct = (bf16*)(F.ws + WS_NCT) + qi * 4096; bf16* vtg = (bf16*)(F.ws + WS_VTG) + qi * 4096;
              bf16x8 a[2] = {frag_rm(SLOT(2), m0, 0, fr, fq), frag_rm(SLOT(2), m0, 1, fr, fq)};
#pragma unroll
              for (int nn = 0; nn < 2; ++nn) { const int n0 = 16 * (np + nn); bf16x8 b[2] = {frag_tr(SLOT(10), 0, n0, fr, fq), frag_tr(SLOT(10), 32, n0, fr, fq)};
                  *(u32x2*)(nct + ((((n0 >> 4) * 4 + mt) * 64 + lane) << 2)) = pk4(mm2(a, b, F4Z));
                  if (nn == (mt >> 1)) { const bf16x8 bs = (mt & 1) ? b[1] : b[0]; *(bf16x8*)(vtg + ((((n0 >> 4) * 2 + (mt & 1)) * 64 + lane) << 3)) = bs; } } }
            LBAR();
            }
        }
    }
#undef STG
#undef CA_ISSUE
}

__device__ __forceinline__ void p_chunkB(Frame& F, int l) {
    PH_LOCALS(F); PH_LAYER(l);
    const int fr = lane & 15, fq = lane >> 4;
    LAS bf16* Sl = (LAS bf16*)(F.lds + wave * 2304);
    const bf16* PST = (const bf16*)(F.ws + WS_PST); const bf16* NCT = (const bf16*)(F.ws + WS_NCT); bf16* SC = (bf16*)(F.ws + WS_SC);
    for (int cp = bx; cp < 64; cp += G) {
        const int cslot = wave >> 2, chain = 2 * cp + cslot, vb = wave & 3, b = chain >> 5, h = (chain >> 1) & 15, d = chain & 1, cb = 64 + b * 64; constexpr int NC = 64;
        LAS bf16* AL = (LAS bf16*)(F.lds + 20480) + cslot * 3 * 4096;
        f32x4 S[4];
        { const float* src = F.in[I_STATE] + ((((size_t)b * NL + l) * 2 + d) * NH + h) * 4096 + (size_t)(16 * vb + fr) * 64 + 4 * fq;
#pragma unroll
          for (int T = 0; T < 4; ++T) S[T] = *(const f32x4*)(src + 16 * T); }
        bf16x8 Aq[8][2]; u32x2 Nq[8][4];
#define LB_QI(step) ((((size_t)(cb + (d ? NC - 1 - (step) : (step)))) * 16 + h) * 2 + d)
#define LB_LDA(u, step) do { const int st_ = (step) < NC ? (step) : NC - 1; const bf16* ps_ = PST + LB_QI(st_) * 4096 + vb * 1024 + lane * 8; Aq[u][0] = *(const bf16x8*)ps_; Aq[u][1] = *(const bf16x8*)(ps_ + 512); } while (0)
#define LB_LDN(u, step) do { const int st_ = (step) < NC ? (step) : NC - 1; const bf16* nc_ = NCT + LB_QI(st_) * 4096 + ((vb * 4 * 64 + lane) << 2); \
        _Pragma("unroll") for (int mt_ = 0; mt_ < 4; ++mt_) Nq[u][mt_] = *(const u32x2*)(nc_ + mt_ * 256); } while (0)
#pragma unroll
        for (int u = 0; u < 8; ++u) { LB_LDA(u, u); LB_LDN(u, u); }
        *(LAS bf16x8*)(AL + ((vb * 2 + 0) * 64 + lane) * 8) = Aq[0][0]; *(LAS bf16x8*)(AL + ((vb * 2 + 1) * 64 + lane) * 8) = Aq[0][1];
        LB_LDA(0, 8);
        for (int g = 0; g < NC; g += 8) {
#pragma unroll
            for (int u = 0; u < 8; ++u) {
                const int step = g + u; const size_t q = LB_QI(step); bf16* scg = SC + q * 4096;
#pragma unroll
                for (int T = 0; T < 4; ++T) { const u32x2 w = pk4(S[T]); *(LAS u32x2*)(Sl + fr * LD16 + 16 * T + 4 * fq) = w; *(u32x2*)(scg + fm_off(16 * vb, 16 * T, fr, fq)) = w; }
                { LAS bf16* nb_ = AL + ((step + 1) % 3) * 4096; const int u1 = (u + 1) & 7;
                  *(LAS bf16x8*)(nb_ + ((vb * 2 + 0) * 64 + lane) * 8) = Aq[u1][0]; *(LAS bf16x8*)(nb_ + ((vb * 2 + 1) * 64 + lane) * 8) = Aq[u1][1];
                  LB_LDA(u1, step + 9); }
                LBAR();
                const LAS bf16* cbuf = AL + (step % 3) * 4096 + lane * 8;
                const bf16x8 b0 = *(const LAS bf16x8*)(Sl + fr * LD16 + 8 * fq), b1 = *(const LAS bf16x8*)(Sl + fr * LD16 + 8 * fq + 32);
#pragma unroll
                for (int mt = 0; mt < 4; ++mt) { const u32x2 nw = Nq[u][mt];
                    f32x4 acc = (f32x4){__uint_as_float(nw.x << 16), __uint_as_float(nw.x & 0xffff0000u), __uint_as_float(nw.y << 16), __uint_as_float(nw.y & 0xffff0000u)};
                    acc = __builtin_amdgcn_mfma_f32_16x16x32_bf16(*(const LAS bf16x8*)(cbuf + (mt * 2) * 512), b0, acc, 0, 0, 0);
                    acc = __builtin_amdgcn_mfma_f32_16x16x32_bf16(*(const LAS bf16x8*)(cbuf + (mt * 2 + 1) * 512), b1, acc, 0, 0, 0);
                    S[mt] = acc; }
                LB_LDN(u, step + 8);
            }
        }
#undef LB_LDA
#undef LB_LDN
#undef LB_QI
        LBAR();
    }
    const int w0 = (G > 64) ? (bx - 64) * NWAVES + wave : bx * NWAVES + wave, wst = (G > 64) ? (G - 64) * NWAVES : G * NWAVES;
    if (G > 64 && bx < 64) return;
    for (int t = w0; t < 2048; t += wst) {
        const int chain = t >> 2, vb = t & 3, b = chain >> 5, h = (chain >> 1) & 15, d = chain & 1, cb = b * 4; constexpr int NC = 4;
        f32x4 S[4];
#pragma unroll
        for (int T = 0; T < 4; ++T) S[T] = (f32x4){0.f, 0.f, 0.f, 0.f};
        bf16x8 Apf[4][8]; u32x2 Npf[4][4];
#define CB_QI(step) ((((size_t)(cb + (d ? NC - 1 - (step) : (step)))) * 16 + h) * 2 + d)
#define CB_LOAD(u, step) do { const size_t q_ = CB_QI(step); const bf16* ps_ = PST + q_ * 4096 + lane * 8; const bf16* nc_ = NCT + q_ * 4096 + ((vb * 4 * 64 + lane) << 2); \
        _Pragma("unroll") for (int mt_ = 0; mt_ < 4; ++mt_) { Apf[u][2 * mt_] = *(const bf16x8*)(ps_ + mt_ * 1024); Apf[u][2 * mt_ + 1] = *(const bf16x8*)(ps_ + mt_ * 1024 + 512); Npf[u][mt_] = *(const u32x2*)(nc_ + mt_ * 256); } } while (0)
        CB_LOAD(0, 0); CB_LOAD(1, 1); CB_LOAD(2, 2); CB_LOAD(3, 3);
#pragma unroll
        for (int u = 0; u < 4; ++u) {
            const int step = u; const size_t q = CB_QI(step); bf16* scg = SC + q * 4096;
            asm volatile("" ::: "memory");
#pragma unroll
            for (int T = 0; T < 4; ++T) { const u32x2 w = pk4(S[T]); *(LAS u32x2*)(Sl + fr * LD16 + 16 * T + 4 * fq) = w; *(u32x2*)(scg + fm_off(16 * vb, 16 * T, fr, fq)) = w; }
            asm volatile("s_waitcnt lgkmcnt(0)" ::: "memory");
            const bf16x8 b0 = *(const LAS bf16x8*)(Sl + fr * LD16 + 8 * fq), b1 = *(const LAS bf16x8*)(Sl + fr * LD16 + 8 * fq + 32);
#pragma unroll
            for (int mt = 0; mt < 4; ++mt) { const u32x2 nw = Npf[u][mt];
                f32x4 acc = (f32x4){__uint_as_float(nw.x << 16), __uint_as_float(nw.x & 0xffff0000u), __uint_as_float(nw.y << 16), __uint_as_float(nw.y & 0xffff0000u)};
                acc = __builtin_amdgcn_mfma_f32_16x16x32_bf16(Apf[u][2 * mt], b0, acc, 0, 0, 0);
                acc = __builtin_amdgcn_mfma_f32_16x16x32_bf16(Apf[u][2 * mt + 1], b1, acc, 0, 0, 0);
                S[mt] = acc; }
            asm volatile("s_waitcnt lgkmcnt(0)" ::: "memory");
        }
#undef CB_LOAD
#undef CB_QI
        { float* dst = F.out + (size_t)M * D + ((((size_t)b * NL + l) * 2 + d) * NH + h) * 4096 + (size_t)(16 * vb + fr) * 64 + 4 * fq;
#pragma unroll
          for (int T = 0; T < 4; ++T) *(f32x4*)(dst + 16 * T) = S[T]; }
    }
}

__device__ __forceinline__ void p_chunkC(Frame& F, int l) {
    PH_LOCALS(F); PH_LAYER(l);
    LAS unsigned char* lds = F.lds;
    const int fr = lane & 15, fq = lane >> 4, d = wave >> 2, nb = wave & 3;
    const bf16* PS = (const bf16*)(F.ws + WS_PS); const bf16* GATE = (const bf16*)(F.ws + WS_GATE); const float* BONUS = (const float*)(F.ws + WS_BONUS);
    bf16* O = (bf16*)(F.ws + WS_O);
    constexpr int NIT = (M / 64) * NH;
    f32x4 gnw[4], gnb[4]; int hcur = -1;
    bf16x8 fa0[4][4], fb0[4]; u32x4 pv0, pg0; float pb00, pb01;
#define CC_ISSUE(item_, fa, fb, pv, pg, pb0, pb1) do { const int ci_ = (item_) >> 4, h_ = (item_) & 15; const size_t qi_ = ((size_t)ci_ * 16 + h_) * 2 + d; \
        const bf16* sc_ = (const bf16*)(F.ws + WS_SC) + qi_ * 4096 + lane * 8; const bf16* vt_ = (const bf16*)(F.ws + WS_VTG) + qi_ * 4096 + lane * 8; \
        const bf16* py_ = (const bf16*)(F.ws + WS_PYT) + qi_ * 4096 + nb * 1024 + lane * 8; const bf16* qy_ = (const bf16*)(F.ws + WS_QYT) + qi_ * 4096 + nb * 1024 + lane * 8; \
        fb[0] = *(const bf16x8*)py_; fb[1] = *(const bf16x8*)(py_ + 512); fb[2] = *(const bf16x8*)qy_; fb[3] = *(const bf16x8*)(qy_ + 512); \
        _Pragma("unroll") for (int vt4_ = 0; vt4_ < 4; ++vt4_) { fa[vt4_][0] = *(const bf16x8*)(sc_ + vt4_ * 1024); fa[vt4_][1] = *(const bf16x8*)(sc_ + vt4_ * 1024 + 512); fa[vt4_][2] = *(const bf16x8*)(vt_ + vt4_ * 1024); fa[vt4_][3] = *(const bf16x8*)(vt_ + vt4_ * 1024 + 512); } \
        const int row_ = ci_ * 64 + (tid >> 3), chn_ = 64 * h_ + (tid & 7) * 8; \
        pv = *(const u32x4*)(PS + (size_t)row_ * CSH + 2 * DA + chn_); pg = *(const u32x4*)(GATE + (size_t)row_ * DA + chn_); pb0 = BONUS[(size_t)row_ * NH + h_]; pb1 = BONUS[((size_t)M + row_) * NH + h_]; } while (0)
#define CC_BODY(item_, fa, fb, pv, pg, pb0, pb1, next_) do { const int ci = (item_) >> 4, h = (item_) & 15, R0 = ci * 64; \
        if (h != hcur) { hcur = h; _Pragma("unroll") for (int vtile = 0; vtile < 4; ++vtile) { gnw[vtile] = *(const f32x4*)(F.in[I_GNW] + (size_t)l * DA + 64 * h + 16 * vtile + 4 * fq); gnb[vtile] = *(const f32x4*)(F.in[I_GNB] + (size_t)l * DA + 64 * h + 16 * vtile + 4 * fq); } } \
        f32x4 acc[4]; float s = 0.f; \
        _Pragma("unroll") for (int vtile = 0; vtile < 4; ++vtile) { f32x4 a = F4Z; \
            _Pragma("unroll") for (int ks = 0; ks < 4; ++ks) a = __builtin_amdgcn_mfma_f32_16x16x32_bf16(fa[vtile][ks], fb[ks], a, 0, 0, 0); \
            acc[vtile] = a; s += (a[0] + a[1]) + (a[2] + a[3]); } \
        const u32x4 cv = pv, cgt = pg; const float bon = pb0 + pb1; \
        if ((next_) < NIT) CC_ISSUE((next_), fa, fb, pv, pg, pb0, pb1); \
        s += SHX(s, 16); s += SHX(s, 32); \
        const float mean = s * (1.0f / 64.0f); float qv = 0.f; \
        _Pragma("unroll") for (int vtile = 0; vtile < 4; ++vtile) { acc[vtile] = acc[vtile] - mean; const f32x4 a = acc[vtile]; qv += (a[0] * a[0] + a[1] * a[1]) + (a[2] * a[2] + a[3] * a[3]); } \
        qv += SHX(qv, 16); qv += SHX(qv, 32); \
        const float rstd = 1.0f / sqrtf(qv * (1.0f / 64.0f) + GN_EPS); \
        const int tau = 16 * nb + fr, pos = d ? 63 - tau : tau; \
        LAS float* Yd = (LAS float*)(lds + d * 17408); \
        _Pragma("unroll") for (int vtile = 0; vtile < 4; ++vtile) { const int v0 = 16 * vtile + 4 * fq; \
            *(LAS f32x4*)(Yd + pos * LD32 + v0) = acc[vtile] * rstd * gnw[vtile] + gnb[vtile]; } \
        LBAR(); \
        { const int pos2 = tid >> 3, c8 = (tid & 7) * 8, row = R0 + pos2, chn = 64 * h + c8; \
          const LAS float* Y0 = (const LAS float*)lds; const LAS float* Y1 = (const LAS float*)(lds + 17408); \
          float v[8], gt[8], o[8]; unpack8(cv, v); unpack8(cgt, gt); \
          const f32x4 y00 = *(const LAS f32x4*)(Y0 + pos2 * LD32 + c8), y01 = *(const LAS f32x4*)(Y0 + pos2 * LD32 + c8 + 4), y10 = *(const LAS f32x4*)(Y1 + pos2 * LD32 + c8), y11 = *(const LAS f32x4*)(Y1 + pos2 * LD32 + c8 + 4); \
          _Pragma("unroll") for (int j = 0; j < 4; ++j) { o[j] = (y00[j] + y10[j] + bon * v[j]) * gt[j]; o[4 + j] = (y01[j] + y11[j] + bon * v[4 + j]) * gt[4 + j]; } \
          *(u32x4*)(O + (size_t)row * D + chn) = pack8(o); } \
        LBAR(); } while (0)
    if (bx < NIT) CC_ISSUE(bx, fa0, fb0, pv0, pg0, pb00, pb01);
    for (int item = bx; item < NIT; item += G) {
        CC_BODY(item, fa0, fb0, pv0, pg0, pb00, pb01, item + G);
    }
#undef CC_BODY
#undef CC_ISSUE
}

__device__ __forceinline__ void p_final(Frame& F) {
    PH_LOCALS(F);
    const int gw = bx * NWAVES + wave, NGW = G * NWAVES;
    const float* fg = F.in[I_FNG];
    for (int row = gw; row < M; row += NGW) {
        float* xr = F.out + (size_t)row * D;
        f32x4 v[8]; float ss = 0.f;
#pragma unroll
        for (int j = 0; j < 8; ++j) { v[j] = *(const f32x4*)(xr + 4 * lane + 256 * j); ss += (v[j].x * v[j].x + v[j].y * v[j].y) + (v[j].z * v[j].z + v[j].w * v[j].w); }
        WAVE_SUM(ss); const float rstd = 1.0f / sqrtf(ss * (1.0f / D) + RMS_EPS);
#pragma unroll
        for (int j = 0; j < 8; ++j) { const int c = 4 * lane + 256 * j; *(f32x4*)(xr + c) = v[j] * rstd * *(const f32x4*)(fg + c); }
    }
}

constexpr int PH_PER_LAYER = 10, N_PHASES = 2 + NL * PH_PER_LAYER;
__global__ void __launch_bounds__(NWAVES * 64, 2) hymba_fwd(Args args) {
    extern __shared__ __attribute__((aligned(16))) unsigned char lds[];
    Frame F;
    F.lds = (LAS unsigned char*)lds;
    F.tid = threadIdx.x; F.lane = F.tid & 63; F.wave = __builtin_amdgcn_readfirstlane(F.tid >> 6);
    F.G = gridDim.x; F.bx = blockIdx.x;
    F.in = args.in; F.out = args.out; F.ws = args.ws;
    for (int u = F.tid; u < (LDS_BYTES - LDSCTL_OFF) / 4; u += NWAVES * 64) ((LAS unsigned*)(F.lds + LDSCTL_OFF))[u] = 0u;
    __syncthreads();
    volatile LAS unsigned* MISC = (volatile LAS unsigned*)(F.lds + MISC_OFF);
    unsigned* barw = (unsigned*)(F.ws + WS_CTL) + CW_BAR;
    XcdBarrier bar; bar.bar = barw; bar.x = 0; bar.st = nullptr;
    if (MK_N_LAUNCHES == 1) bar = xcd_barrier_post(barw, MISC + 8);
    const int lo = args.ph_lo, hi = args.ph_hi;
#define IN(k) (lo <= (k) && (k) < hi)
#define SEAM(k) do { if (MK_N_LAUNCHES == 1 && IN(k) && IN((k) + 1)) xcd_barrier(bar); } while (0)

    for (int rep = 0; rep < ((PROBE_DUP == 30) ? 2 : 1); ++rep)
    if (IN(0)) { p0_prologue(F); __syncthreads(); } SEAM(0);
    bf16* H = (bf16*)(F.ws + WS_H); bf16* O = (bf16*)(F.ws + WS_O); bf16* P = (bf16*)(F.ws + WS_P); bf16* HID = (bf16*)(F.ws + WS_HID);
    const float* mod = (const float*)(F.ws + WS_MOD);
    for (int l = 0; l < NL; ++l) {
        const int pb = 1 + l * PH_PER_LAYER;
        const float* xlo = l == 0 ? F.in[I_XP] : F.out; const float* xhi = l == 0 ? F.in[I_XS] : F.out + (size_t)MCTX * D;
        float* dummy = (float*)(F.ws + WS_P);
        for (int rep = 0; rep < ((PROBE_DUP == 7) ? 2 : 1); ++rep)
        if (IN(pb + 0)) { p_adaln(F, l, 0, xlo, xhi); } SEAM(pb + 0);
        for (int rep = 0; rep < ((PROBE_DUP == 1 || PROBE_DUP == 20) ? 2 : 1); ++rep)
        if (IN(pb + 1)) { pg8::Gemm g{H, (const bf16*)(F.ws + WS_WIN + l * SZ_WIN), M, PINP, D}; pg8::StaticOrder S; { int cb_ = F.bx, cg_ = F.G; asm volatile("" : "+s"(cb_), "+s"(cg_)); S.init(M, PINP, cg_, cb_, D); }
            EpiP E{P, PINP, CSH}; pg8::gemm_phase<EpiP, pg8::StaticOrder, true, true>(F.lds, g, S, E, F.wave); } SEAM(pb + 1);
        for (int rep = 0; rep < ((PROBE_DUP == 2) ? 2 : 1); ++rep)
        if (IN(pb + 2)) { p_shift(F, l); } SEAM(pb + 2);
        if (IN(pb + 3)) { for (int rep = 0; rep < ((PROBE_DUP == 3) ? 2 : 1); ++rep) p_chunkA(F, l); } SEAM(pb + 3);
        for (int rep = 0; rep < ((PROBE_DUP == 4) ? 2 : 1); ++rep)
        if (IN(pb + 4)) { p_chunkB(F, l);
            for (int rep = 0; rep < ((PROBE_DUP == 13) ? 2 : 1); ++rep) p_gmlp(F, l, F.G > 64 ? (F.bx >= 64 ? F.bx - 64 : -1) : F.bx, F.G > 64 ? F.G - 64 : F.G); } SEAM(pb + 4);
        for (int rep = 0; rep < ((PROBE_DUP == 5) ? 2 : 1); ++rep)
        if (IN(pb + 5)) { p_chunkC(F, l); } SEAM(pb + 5);
        if ((PROBE_DUP == 6 || PROBE_DUP == 20) && IN(pb + 6)) { pg8::Gemm g{O, (const bf16*)(F.ws + WS_WOUT + l * SZ_WOUT), M, D, D}; pg8::StaticOrder S; { int cb_ = F.bx, cg_ = F.G; asm volatile("" : "+s"(cb_), "+s"(cg_)); S.init(M, D, cg_, cb_, D); }
            EpiRes E{xlo, xhi, dummy, mod + (size_t)l * 5 * MODW, 2 * D}; pg8::gemm_phase<EpiRes, pg8::StaticOrder, true, true>(F.lds, g, S, E, F.wave); }
        if (IN(pb + 6)) { pg8::Gemm g{O, (const bf16*)(F.ws + WS_WOUT + l * SZ_WOUT), M, D, D}; pg8::FullRoundsOrder S; pg8::TailHalfOrder S2; { int cb_ = F.bx, cg_ = F.G; asm volatile("" : "+s"(cb_), "+s"(cg_)); S.init(M, D, cg_, cb_, D); S2.init(M, D, cg_, cb_, D); }
            EpiRes E{xlo, xhi, F.out, mod + (size_t)l * 5 * MODW, 2 * D}; pg8::gemm_phase<EpiRes, pg8::FullRoundsOrder, true, true>(F.lds, g, S, E, F.wave);
            pg8::gemm_phase<EpiRes, pg8::TailHalfOrder, true, true, true>(F.lds, g, S2, E, F.wave); } SEAM(pb + 6);
        for (int rep = 0; rep < ((PROBE_DUP == 7) ? 2 : 1); ++rep)
        if (IN(pb + 7)) { p_adaln(F, l, 1, F.out, F.out + (size_t)MCTX * D); } SEAM(pb + 7);
        for (int rep = 0; rep < ((PROBE_DUP == 8 || PROBE_DUP == 20) ? 2 : 1); ++rep)
        if (IN(pb + 8)) { pg8::Gemm g{H, (const bf16*)(F.ws + WS_WGU + l * SZ_WGU), M, NGU, D}; pg8::StaticOrder S; { int cb_ = F.bx, cg_ = F.G; asm volatile("" : "+s"(cb_), "+s"(cg_)); S.init(M, NGU, cg_, cb_, D); }
            EpiSwi E{HID, DFF}; pg8::gemm_phase<EpiSwi, pg8::StaticOrder, true, true>(F.lds, g, S, E, F.wave); } SEAM(pb + 8);
        if ((PROBE_DUP == 9 || PROBE_DUP == 20) && IN(pb + 9)) { pg8::Gemm g{HID, (const bf16*)(F.ws + WS_WD + l * SZ_WD), M, D, DFF}; pg8::StaticOrder S; { int cb_ = F.bx, cg_ = F.G; asm volatile("" : "+s"(cb_), "+s"(cg_)); S.init(M, D, cg_, cb_, DFF); }
            EpiRes E{F.out, F.out + (size_t)MCTX * D, dummy, mod + (size_t)l * 5 * MODW, 5 * D}; pg8::gemm_phase<EpiRes, pg8::StaticOrder, true, true>(F.lds, g, S, E, F.wave); }
        if (IN(pb + 9)) { pg8::Gemm g{HID, (const bf16*)(F.ws + WS_WD + l * SZ_WD), M, D, DFF}; pg8::FullRoundsOrder S; pg8::TailHalfOrder S2; { int cb_ = F.bx, cg_ = F.G; asm volatile("" : "+s"(cb_), "+s"(cg_)); S.init(M, D, cg_, cb_, DFF); S2.init(M, D, cg_, cb_, DFF); }
            EpiRes E{F.out, F.out + (size_t)MCTX * D, F.out, mod + (size_t)l * 5 * MODW, 5 * D}; pg8::gemm_phase<EpiRes, pg8::FullRoundsOrder, true, true>(F.lds, g, S, E, F.wave);
            pg8::gemm_phase<EpiRes, pg8::TailHalfOrder, true, true, true>(F.lds, g, S2, E, F.wave); } SEAM(pb + 9);
    }
    if (IN(N_PHASES - 1)) { p_final(F); }
#undef IN
#undef SEAM
}

extern "C" void kernel_launch(void* const* d_in, const int* in_sizes, int n_in, void* d_out, int out_size, void* d_ws, size_t ws_size, hipStream_t stream) {
    static int grid = 0;
    if (grid == 0) {
        if (n_in != 30 || ws_size < WS_END) { fprintf(stderr, "kernel_launch: need 30 inputs and >= %zu bytes of workspace; got n_in %d, ws %zu\n", (size_t)WS_END, n_in, ws_size); grid = -1; return; }
        int dev = 0, cus = 0, per_cu = 0;
        if (hipGetDevice(&dev) != hipSuccess || hipDeviceGetAttribute(&cus, hipDeviceAttributeMultiprocessorCount, dev) != hipSuccess) { grid = -1; return; }
        if (hipFuncSetAttribute((const void*)hymba_fwd, hipFuncAttributeMaxDynamicSharedMemorySize, LDS_BYTES) != hipSuccess) { fprintf(stderr, "kernel_launch: hipFuncSetAttribute failed\n"); grid = -1; return; }
        if (hipOccupancyMaxActiveBlocksPerMultiprocessor(&per_cu, (const void*)hymba_fwd, NWAVES * 64, LDS_BYTES) != hipSuccess || per_cu < 1)
            fprintf(stderr, "kernel_launch: note: occupancy query reports %d workgroups per CU\n", per_cu);
        (void)hipGetLastError();
        grid = cus;
    }
    if (grid < 0) return;
    if (hipMemsetAsync((char*)d_ws + WS_CTL, 0, CTL_ZERO_BYTES, stream) != hipSuccess) return;
    Args a{};
    for (int i = 0; i < 30; ++i) a.in[i] = (const float*)d_in[i];
    a.out = (float*)d_out; a.ws = (unsigned char*)d_ws; a.pad = 0;
    if (MK_N_LAUNCHES == 1) {
        a.ph_lo = 0; a.ph_hi = N_PHASES; a.li = 0;
        hipLaunchKernelGGL(hymba_fwd, dim3(grid), dim3(NWAVES * 64), LDS_BYTES, stream, a);
    } else {
        for (int k = 0; k < N_PHASES; ++k) { a.ph_lo = k; a.ph_hi = k + 1; a.li = k;
            hipLaunchKernelGGL(hymba_fwd, dim3(grid), dim3(NWAVES * 64), LDS_BYTES, stream, a); }
    }
}
```

```cpp
#include <hip/hip_runtime.h>
#include <cstdio>
#include <cstdint>

#ifndef PROBE_DUP
#define PROBE_DUP -1
#endif
#ifndef PROBE_SUB
#define PROBE_SUB 0
#endif
#ifndef MK_N_LAUNCHES
#define MK_N_LAUNCHES 1
#endif

namespace pg8 {
#define PG8_LAS __attribute__((address_space(3)))
typedef unsigned short bf16_t;
typedef short bf16x8 __attribute__((ext_vector_type(8)));
typedef float f32x4 __attribute__((ext_vector_type(4)));
typedef unsigned u32x4 __attribute__((ext_vector_type(4)));
constexpr int BM = 256, BK = 64, HALF = 128, HTB = HALF * BK * 2  , STAGE_BYTES = 8 * HTB, NXCD = 8, WGM = 8;

__host__ __device__ __forceinline__ int lds_byte(int r, int c) { const int st = (r >> 4) * 2 + (c >> 5), rr = r & 15, cc = c & 31, ob = rr * 64 + cc * 2; return st * 1024 + (ob ^ (((ob >> 9) & 1) << 5)); }
__host__ __device__ __forceinline__ void stage_rc(int b, int& R, int& C) { const int st = b / 1024, sb = b % 1024, swz = sb ^ (((sb >> 9) & 1) << 5); R = (st >> 1) * 16 + swz / 64; C = (st & 1) * 32 + (swz % 64) / 2; }
__host__ __device__ __forceinline__ int perm32(int rho) { const int n = rho >> 4, i = rho & 15; return 8 * (i >> 2) + 4 * n + (i & 3); }

struct Unit { int pm, pn, k0, nk, bh; };
struct Gemm { const bf16_t* A; const bf16_t* Bt; int M, N, K; };

struct StaticOrder {
    int nM, nN, nwg, G, c, nkt, full, rem;
    __host__ __device__ void init(int M, int N, int G_, int c_, int K_) { nM = M / BM; nN = N / BM; nwg = nM * nN; G = G_; c = c_; nkt = K_ / BK; full = nwg / G; rem = nwg - full * G; }
    __host__ __device__ bool next(int i, Unit& u) const {
        const long L = (long)i * G + c; if (L >= nwg) return false;
        int wgid = (int)L; { const int q = nwg / NXCD, r = nwg % NXCD, xcd = wgid % NXCD, off = wgid / NXCD; wgid = (xcd < r ? xcd * (q + 1) : r * (q + 1) + (xcd - r) * q) + off; }
        const int nig = WGM * nN, gid = wgid / nig, fm = gid * WGM, gsz = (nM - fm) < WGM ? (nM - fm) : WGM;
        u.pm = fm + ((wgid % nig) % gsz); u.pn = (wgid % nig) / gsz; u.k0 = 0; u.nk = nkt; u.bh = -1;
#if defined(__HIP_DEVICE_COMPILE__)
        u.pm = __builtin_amdgcn_readfirstlane(u.pm); u.pn = __builtin_amdgcn_readfirstlane(u.pn);
#endif
        return true;
    }
    __device__ __forceinline__ void a_ready(const Unit&) const {}
    __device__ __forceinline__ void done(const Unit&) const {}
};
struct FullRoundsOrder : StaticOrder {
    __host__ __device__ bool split() const { return rem > 0 && 2 * rem <= G; }
    __host__ __device__ bool next(int i, Unit& u) const { if (split() && i >= full) return false; return StaticOrder::next(i, u); }
};
struct TailHalfOrder : StaticOrder {
    __host__ __device__ bool next(int i, Unit& u) const {
        if (!(rem > 0 && 2 * rem <= G) || i > 0 || c >= 2 * rem) return false;
        StaticOrder t = *this; t.c = c >> 1; if (!t.StaticOrder::next(full, u)) return false;
        u.bh = c & 1; return true;
    }
};

__device__ __forceinline__ unsigned cvt_pk_bf16(float lo, float hi) { unsigned r; asm volatile("v_cvt_pk_bf16_f32 %0, %1, %2" : "=v"(r) : "v"(lo), "v"(hi)); return r; }

template <class Epi, class Sched, bool ALIGN_EPI = false, bool SP2 = false, bool HALFB = false>
__device__ __forceinline__ void gemm_phase(PG8_LAS unsigned char* lds, const Gemm g, const Sched& S, const Epi& E, int wid) {
    asm volatile("" : "+s"(wid)); int lane; asm volatile("v_mbcnt_lo_u32_b32 %0, -1, 0\n\tv_mbcnt_hi_u32_b32 %0, -1, %0" : "=v"(lane));
    const int tid = wid * 64 + lane, wr = wid >> 2, wc = wid & 3, fr = lane & 15, fq = lane >> 4;
    const int K = g.K;
    unsigned voffA[2], voffB[2];
#pragma unroll
    for (int i = 0; i < 2; ++i) { int R, C; stage_rc(tid * 16 + i * 8192, R, C); const int Rb = Epi::PERM ? ((R & ~31) + perm32(R & 31)) : R;
        voffA[i] = (unsigned)(R * K + C) * 2u; voffB[i] = (unsigned)(Rb * K + C) * 2u; }
    const size_t kstep = (size_t)(BK * 2);
    const size_t hstep = (size_t)HALF * K * 2;
    const size_t tstep = 2 * hstep;
    const size_t bhs = HALFB ? 0 : hstep;
    const unsigned ldsw = (unsigned)wid * 1024u;
    const int aoff = lds_byte(wr * 64 + fr, fq * 8), boff = lds_byte(wc * 32 + fr, fq * 8);
#define PG8_SA(b, h) (((b) * 2 + (h)) * HTB)
#define PG8_SB(b, h) ((4 + (b) * 2 + (h)) * HTB)
#define PG8_STAGE(bufoff, gbase, voff) do { _Pragma("unroll") for (int _i = 0; _i < 2; ++_i) \
        __builtin_amdgcn_global_load_lds((const unsigned*)((const char*)(gbase) + (voff)[_i]), (PG8_LAS unsigned*)(lds + (bufoff) + ldsw + _i * 8192), 16, 0, 0); } while (0)
#define PG8_LDA(dst, b, h) do { _Pragma("unroll") for (int m = 0; m < 4; ++m) _Pragma("unroll") for (int k = 0; k < 2; ++k) dst[m][k] = *(const PG8_LAS bf16x8*)(lds + PG8_SA(b, h) + aoff + m * 2048 + k * 1024); } while (0)
#define PG8_LDB(dst, b, h) do { _Pragma("unroll") for (int n = 0; n < 2; ++n) _Pragma("unroll") for (int k = 0; k < 2; ++k) dst[n][k] = *(const PG8_LAS bf16x8*)(lds + PG8_SB(b, h) + boff + n * 2048 + k * 1024); } while (0)
#define PG8_MMA(ai, bj, At, Bt) do { __builtin_amdgcn_s_setprio(1); _Pragma("unroll") for (int m = 0; m < 4; ++m) _Pragma("unroll") for (int n = 0; n < 2; ++n) _Pragma("unroll") for (int k = 0; k < 2; ++k) \
        acc[ai][bj][m][n] = __builtin_amdgcn_mfma_f32_16x16x32_bf16(Bt[n][k], At[m][k], acc[ai][bj][m][n], 0, 0, 0); __builtin_amdgcn_s_setprio(0); } while (0)
#define PG8_WAIT_V(n) asm volatile("s_waitcnt vmcnt(" #n ")" ::: "memory")
#define PG8_WAIT_L(n) asm volatile("s_waitcnt lgkmcnt(" #n ")" ::: "memory")
#define PG8_BAR __builtin_amdgcn_s_barrier()
#define PG8_SCHED __builtin_amdgcn_sched_barrier(0)
    Unit cur, nxt; int ui = 0;
    if (!S.next(0, cur)) return;
    f32x4 acc[2][2][4][2];
#pragma unroll
    for (int a = 0; a < 2; ++a)
#pragma unroll
        for (int b = 0; b < 2; ++b)
#pragma unroll
            for (int m = 0; m < 4; ++m)
#pragma unroll
                for (int n = 0; n < 2; ++n) acc[a][b][m][n] = (f32x4){0.f, 0.f, 0.f, 0.f};
    bf16x8 At[4][2], B0[2][2], B1[2][2];
    const char* cA = (const char*)g.A + (size_t)cur.pm * tstep + (size_t)cur.k0 * kstep; const char* cB = (const char*)g.Bt + (size_t)cur.pn * tstep + (size_t)cur.k0 * kstep + (HALFB ? (size_t)cur.bh * hstep : 0);
    S.a_ready(cur);
    if constexpr (SP2) {
        PG8_STAGE(PG8_SB(0, 0), cB, voffB); PG8_STAGE(PG8_SB(0, 1), cB + bhs, voffB); PG8_STAGE(PG8_SA(0, 0), cA, voffA); PG8_STAGE(PG8_SA(0, 1), cA + hstep, voffA);
        if (wr == 1) PG8_BAR;
        PG8_WAIT_V(2); PG8_BAR;
        PG8_STAGE(PG8_SB(1, 0), cB + kstep, voffB); PG8_STAGE(PG8_SA(1, 0), cA + kstep, voffA); PG8_STAGE(PG8_SB(1, 1), cB + bhs + kstep, voffB);
        PG8_WAIT_V(6); PG8_BAR;
    } else {
        PG8_STAGE(PG8_SB(0, 0), cB, voffB); PG8_STAGE(PG8_SA(0, 0), cA, voffA); PG8_STAGE(PG8_SB(0, 1), cB + bhs, voffB); PG8_STAGE(PG8_SA(0, 1), cA + hstep, voffA);
        if (wr == 1) PG8_BAR;
        PG8_WAIT_V(4); PG8_BAR;
        PG8_STAGE(PG8_SB(1, 0), cB + kstep, voffB); PG8_STAGE(PG8_SA(1, 0), cA + kstep, voffA); PG8_STAGE(PG8_SB(1, 1), cB + bhs + kstep, voffB);
        PG8_WAIT_V(6); PG8_BAR;
    }
    for (;;) {
        const bool has_next = S.next(ui + 1, nxt);
        const char* nA = has_next ? (const char*)g.A + (size_t)nxt.pm * tstep + (size_t)nxt.k0 * kstep : cA; const char* nB = has_next ? (const char*)g.Bt + (size_t)nxt.pn * tstep + (size_t)nxt.k0 * kstep + (HALFB ? (size_t)nxt.bh * hstep : 0) : cB;
        const int nt = cur.nk;
        for (int t = 0; t < nt; t += 2) {
            const bool last = (t == nt - 2);
            const char* a1 = cA + (size_t)(t + 1) * kstep;
            const char* a2 = last ? nA : cA + (size_t)(t + 2) * kstep; const char* b2 = last ? nB : cB + (size_t)(t + 2) * kstep;
            const char* a3 = a2 + kstep; const char* b3 = b2 + kstep;
            if (last && has_next) S.a_ready(nxt);
            if constexpr (SP2) {
            PG8_LDB(B0, 0, 0); if constexpr (!HALFB) PG8_LDB(B1, 0, 1); PG8_SCHED; PG8_LDA(At, 0, 0); PG8_STAGE(PG8_SA(1, 1), a1 + hstep, voffA);
            PG8_WAIT_V(8); PG8_WAIT_L(0); PG8_BAR; PG8_MMA(0, 0, At, B0); if constexpr (!HALFB) PG8_MMA(0, 1, At, B1); PG8_BAR; PG8_SCHED;
            PG8_LDA(At, 0, 1); PG8_STAGE(PG8_SB(0, 0), b2, voffB); PG8_STAGE(PG8_SB(0, 1), b2 + bhs, voffB); PG8_STAGE(PG8_SA(0, 0), a2, voffA);
            PG8_WAIT_V(8); PG8_WAIT_L(0); PG8_BAR; PG8_MMA(1, 0, At, B0); if constexpr (!HALFB) PG8_MMA(1, 1, At, B1); PG8_BAR; PG8_SCHED;
            PG8_LDB(B0, 1, 0); if constexpr (!HALFB) PG8_LDB(B1, 1, 1); PG8_SCHED; PG8_LDA(At, 1, 0); PG8_STAGE(PG8_SA(0, 1), a2 + hstep, voffA);
            PG8_WAIT_V(8); PG8_WAIT_L(0); PG8_BAR; PG8_MMA(0, 0, At, B0); if constexpr (!HALFB) PG8_MMA(0, 1, At, B1); PG8_BAR; PG8_SCHED;
            PG8_LDA(At, 1, 1); PG8_STAGE(PG8_SB(1, 0), b3, voffB); PG8_STAGE(PG8_SB(1, 1), b3 + bhs, voffB); PG8_STAGE(PG8_SA(1, 0), a3, voffA);
            PG8_WAIT_V(8); PG8_WAIT_L(0); PG8_BAR; PG8_MMA(1, 0, At, B0); if constexpr (!HALFB) PG8_MMA(1, 1, At, B1); PG8_BAR; PG8_SCHED;
            } else {
            PG8_LDB(B0, 0, 0); PG8_SCHED; PG8_LDA(At, 0, 0); PG8_STAGE(PG8_SA(1, 1), a1 + hstep, voffA);
            PG8_WAIT_L(8); PG8_BAR; PG8_WAIT_L(0); PG8_MMA(0, 0, At, B0); PG8_BAR; PG8_SCHED;
            PG8_LDB(B1, 0, 1); PG8_STAGE(PG8_SB(0, 0), b2, voffB);
            PG8_BAR; PG8_WAIT_L(0); PG8_MMA(0, 1, At, B1); PG8_BAR;
            PG8_LDA(At, 0, 1); PG8_STAGE(PG8_SA(0, 0), a2, voffA);
            PG8_BAR; PG8_WAIT_L(0); PG8_MMA(1, 0, At, B0); PG8_BAR; PG8_SCHED;
            PG8_STAGE(PG8_SB(0, 1), b2 + bhs, voffB);
            PG8_WAIT_V(6); PG8_BAR; PG8_MMA(1, 1, At, B1); PG8_BAR;
            PG8_LDB(B0, 1, 0); PG8_SCHED; PG8_LDA(At, 1, 0); PG8_STAGE(PG8_SA(0, 1), a2 + hstep, voffA);
            PG8_WAIT_L(8); PG8_BAR; PG8_WAIT_L(0); PG8_MMA(0, 0, At, B0); PG8_BAR; PG8_SCHED;
            PG8_LDB(B1, 1, 1); PG8_STAGE(PG8_SB(1, 0), b3, voffB);
            PG8_BAR; PG8_WAIT_L(0); PG8_MMA(0, 1, At, B1); PG8_BAR;
            PG8_LDA(At, 1, 1); PG8_STAGE(PG8_SA(1, 0), a3, voffA);
            PG8_BAR; PG8_WAIT_L(0); PG8_MMA(1, 0, At, B0); PG8_BAR; PG8_SCHED;
            PG8_STAGE(PG8_SB(1, 1), b3 + bhs, voffB);
            PG8_WAIT_V(6); PG8_BAR; PG8_MMA(1, 1, At, B1); PG8_BAR;
            }
        }
        if constexpr (ALIGN_EPI) { if (wr == 0) PG8_BAR; }
        E(acc, cur, wr, wc, fr, fq); S.done(cur);
        if (!has_next) break;
#pragma unroll
        for (int a = 0; a < 2; ++a)
#pragma unroll
            for (int b = 0; b < 2; ++b)
#pragma unroll
                for (int m = 0; m < 4; ++m)
#pragma unroll
                    for (int n = 0; n < 2; ++n) acc[a][b][m][n] = (f32x4){0.f, 0.f, 0.f, 0.f};
        cur = nxt; cA = nA; cB = nB; ++ui;
        if constexpr (ALIGN_EPI) { if (wr == 1) PG8_BAR; }
    }
    PG8_WAIT_V(0);
    if constexpr (!ALIGN_EPI) { if (wr == 0) PG8_BAR; }
    PG8_BAR;
#undef PG8_SA
#undef PG8_SB
#undef PG8_STAGE
#undef PG8_LDA
#undef PG8_LDB
#undef PG8_MMA
#undef PG8_WAIT_V
#undef PG8_WAIT_L
#undef PG8_BAR
#undef PG8_SCHED
}
}

constexpr int NWAVES = 8;
constexpr int D = 2048, MCTX = 4096, MLAT = 16384, M = MCTX + MLAT, NL = 4;
constexpr int DA = 1024, NH = 16, DB = 1024, NG = 8, HB = 128;
constexpr int LW = 64, LAA = 64, LGT = 160;
constexpr int CSH = 3 * DA + LW + LAA + LGT;
constexpr int PIN = CSH + 2 * DB;
constexpr int PINP = 5632;
constexpr int DFF = 5632, NGU = 2 * DFF;
constexpr int MODW = 6 * D;
constexpr float RMS_EPS = 1e-6f, GN_EPS = 64.0f * 1e-5f, LN_EPS = 1e-5f;

constexpr size_t MiB = 1u << 20;
constexpr size_t WS_CTL = 0, CTL_ZERO_BYTES = 1 * MiB;
constexpr size_t WS_MOD = 1 * MiB;
constexpr size_t WS_W2T = 2 * MiB;
constexpr size_t WS_A2T = 3 * MiB;
constexpr size_t WS_G2T = 4 * MiB;
constexpr size_t WS_WSP = 6 * MiB;
constexpr size_t WS_BONUS = 7 * MiB;
constexpr size_t SZ_WIN = (size_t)PINP * D * 2, SZ_WOUT = (size_t)D * D * 2, SZ_WGU = (size_t)NGU * D * 2, SZ_WD = (size_t)D * DFF * 2;
constexpr size_t WS_WIN = 16 * MiB;
constexpr size_t WS_WOUT = WS_WIN + NL * SZ_WIN;
constexpr size_t WS_WGU = WS_WOUT + NL * SZ_WOUT;
constexpr size_t WS_WD = WS_WGU + NL * SZ_WGU;
constexpr size_t WS_H = WS_WD + NL * SZ_WD;
constexpr size_t WS_O = WS_H + (size_t)M * D * 2;
constexpr size_t WS_P = WS_O + (size_t)M * D * 2;
constexpr size_t WS_PS = WS_P + (size_t)M * PINP * 2;
constexpr size_t SZ_T16 = (size_t)M * DA * 2;
constexpr size_t WS_GATE = WS_PS + (size_t)M * CSH * 2;
constexpr size_t SZ_CH = (size_t)(M / 64) * NH * 2 * 8192;
constexpr size_t WS_PST = WS_GATE + SZ_T16;
constexpr size_t WS_NCT = WS_PST + SZ_CH;
constexpr size_t WS_PYT = WS_NCT + SZ_CH;
constexpr size_t WS_QYT = WS_PYT + SZ_CH;
constexpr size_t WS_VTG = WS_QYT + SZ_CH;
constexpr size_t WS_SC = WS_VTG + SZ_CH;
constexpr size_t WS_LORA = WS_SC + SZ_CH;
constexpr size_t WS_END1 = WS_LORA + (size_t)M * 288 * 2;
constexpr size_t WS_HID = WS_GATE;
constexpr size_t WS_END = WS_END1 > WS_HID + (size_t)M * DFF * 2 ? WS_END1 : WS_HID + (size_t)M * DFF * 2;
constexpr int CW_BAR = 4096;
constexpr int CW_SPLIT = 16384;
static_assert((CW_SPLIT + NL * 640 * 64) * 4 <= (int)CTL_ZERO_BYTES, "control words inside the memset region");

constexpr int RING_BYTES = 131072;
constexpr int LDSCTL_OFF = 15 * 9216, MISC_OFF = LDSCTL_OFF + 320;
constexpr int LDS_BYTES = 147456;

#define GAS __attribute__((address_space(1)))
#define LAS __attribute__((address_space(3)))
typedef unsigned short bf16;
typedef float f32x4 __attribute__((ext_vector_type(4)));
typedef float f32x2 __attribute__((ext_vector_type(2)));
typedef short bf16x8 __attribute__((ext_vector_type(8)));
typedef unsigned u32x4 __attribute__((ext_vector_type(4)));
typedef unsigned u32x2 __attribute__((ext_vector_type(2)));
#define LDS_WAIT() asm volatile("s_waitcnt lgkmcnt(0)" ::: "memory")
#define VM_WAIT() asm volatile("s_waitcnt vmcnt(0)" ::: "memory")
__device__ __forceinline__ unsigned f2bf(float f) { unsigned u = __builtin_bit_cast(unsigned, f); return (u + 0x7fffu + ((u >> 16) & 1u)) >> 16; }
typedef __bf16 bf16x2_t __attribute__((ext_vector_type(2)));
__device__ __forceinline__ unsigned pk2(float lo, float hi) { return __builtin_bit_cast(unsigned, __builtin_convertvector((f32x2){lo, hi}, bf16x2_t)); }
__device__ __forceinline__ float bf2f(unsigned short b) { return __uint_as_float(((unsigned)b) << 16); }
__device__ __forceinline__ void unpack8(const u32x4 q, float (&f)[8]) {
    f[0] = __uint_as_float(q.x << 16); f[1] = __uint_as_float(q.x & 0xffff0000u); f[2] = __uint_as_float(q.y << 16); f[3] = __uint_as_float(q.y & 0xffff0000u);
    f[4] = __uint_as_float(q.z << 16); f[5] = __uint_as_float(q.z & 0xffff0000u); f[6] = __uint_as_float(q.w << 16); f[7] = __uint_as_float(q.w & 0xffff0000u); }
__device__ __forceinline__ u32x4 pack8(const float (&f)[8]) { u32x4 o; o.x = pk2(f[0], f[1]); o.y = pk2(f[2], f[3]); o.z = pk2(f[4], f[5]); o.w = pk2(f[6], f[7]); return o; }
__device__ __forceinline__ float fsigmoid(float x) { return __builtin_amdgcn_rcpf(1.0f + __expf(-x)); }
__device__ __forceinline__ float ftanh(float x) { return 1.0f - 2.0f * __builtin_amdgcn_rcpf(1.0f + __expf(2.0f * x)); }
__device__ __forceinline__ float gelu_tanh(float x) { const float u = 1.5957691216057308f * (x + 0.044715f * x * x * x); return x * __builtin_amdgcn_rcpf(1.0f + __expf(-u)); }
__device__ __forceinline__ int hw_lane() { int l; asm volatile("v_mbcnt_lo_u32_b32 %0, -1, 0\n\tv_mbcnt_hi_u32_b32 %0, -1, %0" : "=v"(l)); return l; }
#define SHX(v, X) __int_as_float(__builtin_amdgcn_ds_bpermute((lane ^ (X)) << 2, __float_as_int(v)))
#define WAVE_SUM(v) do { v += SHX(v, 1); v += SHX(v, 2); v += SHX(v, 4); v += SHX(v, 8); v += SHX(v, 16); v += SHX(v, 32); } while (0)

#define PH_LOCALS(F) int wave = (F).wave; asm volatile("" : "+s"(wave)); const int lane = hw_lane(); const int tid = wave * 64 + lane; \
    int bx = (F).bx, G = (F).G; asm volatile("" : "+s"(bx), "+s"(G)); (void)lane; (void)tid;
#define PH_LAYER(l) asm volatile("" : "+s"(l))

#define XB_TMO      128
#define XB_XCNT(j)  (256  + 64 * (j))
#define XB_XSUB(j)  (1280 + 64 * (j))
#define XB_XGEN(j)  (2304 + 64 * (j))
#define XB_TOP      3328
#define XB_TOPGEN   3392
#define XCD_BAR_WORDS 3456
#define XB_SPIN_CAP (1u << 18)

__device__ __forceinline__ unsigned xb_ld(unsigned* p)              { return __hip_atomic_load(p, __ATOMIC_RELAXED, __HIP_MEMORY_SCOPE_AGENT); }
__device__ __forceinline__ unsigned xb_add(unsigned* p, unsigned v) { return __hip_atomic_fetch_add(p, v, __ATOMIC_RELAXED, __HIP_MEMORY_SCOPE_AGENT); }
__device__ __forceinline__ unsigned xb_xcc_id() { return (unsigned)__builtin_amdgcn_s_getreg((3 << 11) | 20) & 0xFu; }
#define XB_SPIN(cond, bar) do { unsigned _sp = 0; while (cond) { __builtin_amdgcn_s_sleep(1); \
    if ((++_sp & 255u) == 0u) { if (xb_ld(&(bar)[XB_TMO])) break; if (_sp > XB_SPIN_CAP) { atomicAdd(&(bar)[XB_TMO], 1u); break; } } } } while (0)

struct XcdBarrier {
    unsigned* bar; unsigned x;
    volatile LAS unsigned* st;
};
__device__ __forceinline__ XcdBarrier xcd_barrier_post(unsigned* bar, volatile LAS unsigned* st) {
    XcdBarrier b; b.bar = bar; b.x = xb_xcc_id(); b.st = st;
    if (threadIdx.x == 0) (void)xb_add(&bar[XB_XCNT(b.x)], 1u);
    return b;
}
__device__ __forceinline__ void xcd_barrier_complete(unsigned* bar, unsigned x, unsigned& nloc, unsigned& nx) {
    const unsigned G = gridDim.x * gridDim.y * gridDim.z;
    unsigned sum, cnt, mine, sp = 0u;
    for (;;) {
        sum = 0u; cnt = 0u; mine = 0u;
#pragma unroll
        for (unsigned j = 0; j < 16; ++j) { const unsigned c = xb_ld(&bar[XB_XCNT(j)]); sum += c; cnt += (c > 0u) ? 1u : 0u; mine = (j == x) ? c : mine; }
        if (sum == G) break;
        __builtin_amdgcn_s_sleep(1);
        if ((++sp & 255u) == 0u) { if (xb_ld(&bar[XB_TMO])) break; if (sp > XB_SPIN_CAP) { atomicAdd(&bar[XB_TMO], 1u); break; } }
    }
    nloc = mine > 0u ? mine : 1u; nx = cnt > 0u ? cnt : 1u;
}
__device__ __forceinline__ void xcd_barrier(const XcdBarrier& b) {
    asm volatile("s_waitcnt vmcnt(0)" ::: "memory");
    __syncthreads();
    if (threadIdx.x == 0) {
        unsigned* bar = b.bar;
        __builtin_amdgcn_s_waitcnt(0);
        unsigned nloc = b.st[0], nx = b.st[1];
        if (nloc == 0u) { xcd_barrier_complete(bar, b.x, nloc, nx); b.st[0] = nloc; b.st[1] = nx; }
        const unsigned old = xb_add(&bar[XB_XSUB(b.x)], 1u);
        const unsigned gen = old / nloc;
        if (old + 1u == (gen + 1u) * nloc) {
            __builtin_amdgcn_fence(__ATOMIC_RELEASE, "agent");
            asm volatile("s_waitcnt vmcnt(0)" ::: "memory");
            const unsigned og = xb_add(&bar[XB_TOP], 1u);
            const unsigned tg = og / nx;
            if (og + 1u == (tg + 1u) * nx) xb_add(&bar[XB_TOPGEN], 1u);
            else XB_SPIN(xb_ld(&bar[XB_TOPGEN]) == tg, bar);
            __builtin_amdgcn_fence(__ATOMIC_ACQUIRE, "agent");
            xb_add(&bar[XB_XGEN(b.x)], 1u);
            asm volatile("s_waitcnt vmcnt(0)" ::: "memory");
        } else {
            XB_SPIN(xb_ld(&bar[XB_XGEN(b.x)]) == gen, bar);
            __builtin_amdgcn_fence(__ATOMIC_ACQUIRE, "agent");
            asm volatile("s_waitcnt vmcnt(0)" ::: "memory");
        }
    }
    __syncthreads();
}

struct Args {
    const float* in[30];
    float* out; unsigned char* ws;
    int ph_lo, ph_hi, li, pad;
};
enum { I_XP = 0, I_XS, I_STATE, I_C, I_CCTX, I_WMOD, I_BMOD, I_N1G, I_WIN, I_MU, I_W0, I_W2, I_A0, I_A2, I_G2, I_KK, I_KA, I_RK, I_GNW, I_GNB, I_LNG, I_LNB, I_WSP, I_BSP, I_WOUT, I_N2G, I_WG, I_WU, I_WD, I_FNG };

struct Frame {
    LAS unsigned char* lds;
    int tid, lane, wave, G, bx;
    const float* const* in;
    float* out; unsigned char* ws;
};

struct EpiP {
    static constexpr bool PERM = true, AFTER_DRAIN = false;
    bf16* O; int ldc; int gelu_from;
    __device__ __forceinline__ void operator()(const f32x4 (&acc)[2][2][4][2], const pg8::Unit& u, int wr, int wc, int fr, int fq) const {
        const int row0 = u.pm * 256 + wr * 64 + fr, col0 = u.pn * 256 + wc * 32 + 8 * fq;
#pragma unroll
        for (int ai = 0; ai < 2; ++ai)
#pragma unroll
            for (int m = 0; m < 4; ++m) { bf16* rowp = O + (size_t)(row0 + ai * 128 + m * 16) * ldc + col0;
#pragma unroll
                for (int bj = 0; bj < 2; ++bj) { f32x4 v0 = acc[ai][bj][m][0], v1 = acc[ai][bj][m][1];
                    if (col0 + bj * 128 >= gelu_from) {
#pragma unroll
                        for (int j = 0; j < 4; ++j) { v0[j] = gelu_tanh(v0[j]); v1[j] = gelu_tanh(v1[j]); } }
                    u32x4 w; w.x = pg8::cvt_pk_bf16(v0[0], v0[1]); w.y = pg8::cvt_pk_bf16(v0[2], v0[3]); w.z = pg8::cvt_pk_bf16(v1[0], v1[1]); w.w = pg8::cvt_pk_bf16(v1[2], v1[3]);
                    *(u32x4*)(rowp + bj * 128) = w; } }
    }
};
struct EpiRes {
    static constexpr bool PERM = false, AFTER_DRAIN = false;
    const float* xlo; const float* xhi; float* xout; const float* modl; int goff;
    __device__ __forceinline__ void operator()(const f32x4 (&acc)[2][2][4][2], const pg8::Unit& u, int wr, int wc, int fr, int fq) const {
        const int pm = u.pm; const int midx = pm < 16 ? 0 : 1 + ((pm - 16) >> 4);
        const float* gv = modl + (size_t)midx * MODW + goff;
        const float* base = pm < 16 ? xlo + (size_t)pm * 256 * D : xhi + (size_t)(pm - 16) * 256 * D;
        float* ob = xout + (size_t)pm * 256 * D;
        const bool half = u.bh >= 0;
        const int col0 = u.pn * 256 + (u.bh > 0 ? 128 : 0) + wc * 32 + 4 * fq;
        f32x4 gvv[2][2];
#pragma unroll
        for (int bj = 0; bj < 2; ++bj)
#pragma unroll
            for (int n = 0; n < 2; ++n) gvv[bj][n] = (bj == 1 && half) ? (f32x4){0.f, 0.f, 0.f, 0.f} : *(const f32x4*)(gv + col0 + bj * 128 + n * 16);
#pragma unroll
        for (int ai = 0; ai < 2; ++ai)
#pragma unroll
            for (int m = 0; m < 4; ++m) { const size_t off = (size_t)(ai * 128 + wr * 64 + m * 16 + fr) * D + col0;
#pragma unroll
                for (int bj = 0; bj < 2; ++bj) { if (bj == 1 && half) continue;
#pragma unroll
                    for (int n = 0; n < 2; ++n) { const size_t o = off + bj * 128 + n * 16;
                        *(f32x4*)(ob + o) = *(const f32x4*)(base + o) + gvv[bj][n] * acc[ai][bj][m][n]; } }
                if (m & 1) asm volatile("" ::: "memory"); }
    }
};
struct EpiSwi {
    static constexpr bool PERM = true, AFTER_DRAIN = false;
    bf16* O; int ldc;
    __device__ __forceinline__ void operator()(const f32x4 (&acc)[2][2][4][2], const pg8::Unit& u, int wr, int wc, int fr, int fq) const {
        const int row0 = u.pm * 256 + wr * 64 + fr, col0 = u.pn * 128 + wc * 32 + 8 * fq;
#pragma unroll
        for (int ai = 0; ai < 2; ++ai)
#pragma unroll
            for (int m = 0; m < 4; ++m) { bf16* rowp = O + (size_t)(row0 + ai * 128 + m * 16) * ldc + col0;
                float h[8];
#pragma unroll
                for (int n = 0; n < 2; ++n)
#pragma unroll
                    for (int j = 0; j < 4; ++j) { const float gt = acc[ai][0][m][n][j], up = acc[ai][1][m][n][j]; h[n * 4 + j] = gt * fsigmoid(gt) * up; }
                u32x4 w; w.x = pg8::cvt_pk_bf16(h[0], h[1]); w.y = pg8::cvt_pk_bf16(h[2], h[3]); w.z = pg8::cvt_pk_bf16(h[4], h[5]); w.w = pg8::cvt_pk_bf16(h[6], h[7]);
                *(u32x4*)rowp = w; }
    }
};

template <int MAP>
__device__ __forceinline__ void tr_item(const float* W, int K, int N, bf16* WT, LAS float* scr, int item, int lane) {
    const int nblk = N / 32, kb = item / nblk, nb = item % nblk, k0 = 64 * kb, n0 = 32 * nb;
#pragma unroll 8
    for (int i = 0; i < 32; ++i) { const int kk = 2 * i + (lane >> 5); scr[kk * 33 + (lane & 31)] = W[(size_t)(k0 + kk) * N + n0 + (lane & 31)]; }
    LDS_WAIT(); asm volatile("" ::: "memory");
    const int c = lane & 7;
#pragma unroll
    for (int j = 0; j < 4; ++j) { const int n = (lane >> 3) + 8 * j; const LAS float* s = scr + (8 * c) * 33 + n;
        u32x4 o; o.x = pk2(s[0 * 33], s[1 * 33]); o.y = pk2(s[2 * 33], s[3 * 33]); o.z = pk2(s[4 * 33], s[5 * 33]); o.w = pk2(s[6 * 33], s[7 * 33]);
        const int nn = n0 + n; const int orow = MAP == 0 ? nn : (256 * (nn >> 7) + (nn & 127) + (MAP == 2 ? 128 : 0));
        *(u32x4*)(WT + (size_t)orow * K + k0 + 8 * c) = o; }
    LDS_WAIT(); asm volatile("" ::: "memory");
}
__device__ __forceinline__ void p0_prologue(Frame& F) {
    PH_LOCALS(F);
    LAS float* scr = (LAS float*)(F.lds + wave * 16384);
    const int gw = bx * NWAVES + wave, NGW = G * NWAVES;
    constexpr int I_IN = (D / 64) * (PIN / 32), I_OUT = (D / 64) * (D / 32), I_GU = (D / 64) * (DFF / 32), I_DN = (DFF / 64) * (D / 32);
    constexpr int PL = I_IN + I_OUT + 2 * I_GU + I_DN;
    for (int it = gw; it < NL * PL; it += NGW) {
        const int l = it / PL; int r = it % PL;
        if (r < I_IN) { tr_item<0>(F.in[I_WIN] + (size_t)l * D * PIN, D, PIN, (bf16*)(F.ws + WS_WIN + l * SZ_WIN), scr, r, lane); continue; } r -= I_IN;
        if (r < I_OUT) { tr_item<0>(F.in[I_WOUT] + (size_t)l * D * D, D, D, (bf16*)(F.ws + WS_WOUT + l * SZ_WOUT), scr, r, lane); continue; } r -= I_OUT;
        if (r < I_GU) { tr_item<1>(F.in[I_WG] + (size_t)l * D * DFF, D, DFF, (bf16*)(F.ws + WS_WGU + l * SZ_WGU), scr, r, lane); continue; } r -= I_GU;
        if (r < I_GU) { tr_item<2>(F.in[I_WU] + (size_t)l * D * DFF, D, DFF, (bf16*)(F.ws + WS_WGU + l * SZ_WGU), scr, r, lane); continue; } r -= I_GU;
        tr_item<0>(F.in[I_WD] + (size_t)l * DFF * D, DFF, D, (bf16*)(F.ws + WS_WD + l * SZ_WD), scr, r, lane);
    }
    const int gt = bx * 512 + tid, NGT = G * 512;
    { constexpr int PADV = (PINP - PIN) * D * 2 / 16;
      for (int i = gt; i < NL * PADV; i += NGT) { const int l = i / PADV, r = i % PADV; ((u32x4*)(F.ws + WS_WIN + l * SZ_WIN + (size_t)PIN * D * 2))[r] = (u32x4){0u, 0u, 0u, 0u}; } }
    { bf16* w2t = (bf16*)(F.ws + WS_W2T); bf16* a2t = (bf16*)(F.ws + WS_A2T); bf16* g2t = (bf16*)(F.ws + WS_G2T); bf16* wsp = (bf16*)(F.ws + WS_WSP);
      for (int i = gt; i < NL * 2 * 1024 * 64; i += NGT) { const int k = i & 63, n = (i >> 6) & 1023, ld = i >> 16;
          w2t[i] = (bf16)f2bf(F.in[I_W2][((size_t)ld * 64 + k) * 1024 + n]); a2t[i] = (bf16)f2bf(F.in[I_A2][((size_t)ld * 64 + k) * 1024 + n]); }
      for (int i = gt; i < NL * 1024 * 160; i += NGT) { const int k = i % 160, n = (i / 160) & 1023, l = i / (160 * 1024);
          g2t[i] = (bf16)f2bf(F.in[I_G2][((size_t)l * 160 + k) * 1024 + n]); }
      for (int i = gt; i < NL * 8 * 128 * 128; i += NGT) wsp[i] = (bf16)f2bf(F.in[I_WSP][i]); }
    __syncthreads();
    { LAS float* sv = (LAS float*)F.lds;
      LAS float* red = (LAS float*)(F.lds + 40960);
      for (int i = tid; i < 5 * D; i += 512) { const int r = i / D, k = i % D; const float c = r == 0 ? F.in[I_CCTX][k] : F.in[I_C][(r - 1) * D + k]; sv[i] = c * fsigmoid(c); }
      __syncthreads();
      float* mod = (float*)(F.ws + WS_MOD);
      const int c4 = tid & 15, kg = tid >> 4;
      for (int item = bx; item < NL * (MODW / 64); item += G) {
          const int l = item / (MODW / 64), n0 = (item % (MODW / 64)) * 64;
          const float* W = F.in[I_WMOD] + (size_t)l * D * MODW + n0 + 4 * c4;
          f32x4 a[5];
#pragma unroll
          for (int r = 0; r < 5; ++r) a[r] = (f32x4){0.f, 0.f, 0.f, 0.f};
#pragma unroll 4
          for (int i = 0; i < 64; ++i) { const int k = i * 32 + kg; const f32x4 w = *(const f32x4*)(W + (size_t)k * MODW);
#pragma unroll
              for (int r = 0; r < 5; ++r) a[r] += w * sv[r * D + k]; }
#pragma unroll
          for (int r = 0; r < 5; ++r) *(LAS f32x4*)(red + (kg * 5 + r) * 64 + 4 * c4) = a[r];
          __syncthreads();
          if (tid < 320) { const int r = tid >> 6, n = tid & 63; float s = 0.f;
#pragma unroll 8
              for (int g = 0; g < 32; ++g) s += red[(g * 5 + r) * 64 + n];
              mod[((size_t)l * 5 + r) * MODW + n0 + n] = s + F.in[I_BMOD][(size_t)l * MODW + n0 + n]; }
          __syncthreads();
      } }
}

__device__ __forceinline__ void p_adaln(Frame& F, int l, int which, const float* xlo, const float* xhi) {
    PH_LOCALS(F); PH_LAYER(l);
    const int gw = bx * NWAVES + wave, NGW = G * NWAVES;
    const float* ng = (which == 0 ? F.in[I_N1G] : F.in[I_N2G]) + (size_t)l * D;
    const int shoff = which == 0 ? 0 : 3 * D, scoff = shoff + D;
    const float* mod = (const float*)(F.ws + WS_MOD);
    bf16* H = (bf16*)(F.ws + WS_H);
    const int rpw = (M + NGW - 1) / NGW, rbeg = gw * rpw, rend = rbeg + rpw < M ? rbeg + rpw : M;
    f32x4 ca[8], cb[8]; int mcur = -1;
    for (int row = rbeg; row < rend; ++row) {
        const float* xr = row < MCTX ? xlo + (size_t)row * D : xhi + (size_t)(row - MCTX) * D;
        const int midx = row < MCTX ? 0 : 1 + ((row - MCTX) >> 12);
        if (midx != mcur) { mcur = midx; const float* md = mod + ((size_t)l * 5 + midx) * MODW;
#pragma unroll
            for (int j = 0; j < 8; ++j) { const int c = 4 * lane + 256 * j; ca[j] = *(const f32x4*)(ng + c) * (*(const f32x4*)(md + scoff + c) + 1.0f); cb[j] = *(const f32x4*)(md + shoff + c); } }
        f32x4 v[8]; float ss = 0.f;
#pragma unroll
        for (int j = 0; j < 8; ++j) { v[j] = *(const f32x4*)(xr + 4 * lane + 256 * j); ss += (v[j].x * v[j].x + v[j].y * v[j].y) + (v[j].z * v[j].z + v[j].w * v[j].w); }
        WAVE_SUM(ss); const float rstd = 1.0f / sqrtf(ss * (1.0f / D) + RMS_EPS);
#pragma unroll
        for (int j = 0; j < 8; ++j) { const int c = 4 * lane + 256 * j;
            const f32x4 o = v[j] * rstd * ca[j] + cb[j];
            u32x2 w; w.x = pk2(o.x, o.y); w.y = pk2(o.z, o.w);
            *(u32x2*)(H + (size_t)row * D + c) = w; }
    }
}

__device__ __forceinline__ void load_shifted8(const bf16* P, const float* mu, int row, int col, float (&o)[8]) {
    float g[8]; unpack8(*(const u32x4*)(P + (size_t)row * PINP + col), g);
    float a[8];
#pragma unroll
    for (int j = 0; j < 8; ++j) a[j] = g[j];
    int nrow[4]; bool has[4]; int nn;
    if (row < MCTX) { const int t = row & 255; nn = 2; nrow[0] = row - 1; has[0] = t > 0; nrow[1] = row + 1; has[1] = t < 255; nrow[2] = row; has[2] = false; nrow[3] = row; has[3] = false; }
    else { const int t = (row - MCTX) & 4095, gc = t & 63, gr = t >> 6; nn = 4;
        nrow[0] = row - 1; has[0] = gc > 0; nrow[1] = row + 1; has[1] = gc < 63; nrow[2] = row - 64; has[2] = gr > 0; nrow[3] = row + 64; has[3] = gr < 63; }
#pragma unroll
    for (int q = 0; q < 4; ++q) {
        if (q < nn) {
            float nb[8];
            if (has[q]) unpack8(*(const u32x4*)(P + (size_t)nrow[q] * PINP + col), nb);
            else {
#pragma unroll
                for (int j = 0; j < 8; ++j) nb[j] = 0.f; }
            const f32x4 m0 = *(const f32x4*)(mu + q * CSH + col), m1 = *(const f32x4*)(mu + q * CSH + col + 4);
#pragma unroll
            for (int j = 0; j < 4; ++j) { a[j] += m0[j] * (nb[j] - g[j]); a[4 + j] += m1[j] * (nb[4 + j] - g[4 + j]); }
        }
    }
#pragma unroll
    for (int j = 0; j < 8; ++j) o[j] = a[j];
}
__device__ __forceinline__ void p_shift(Frame& F, int l) {
    PH_LOCALS(F); PH_LAYER(l);
    const bf16* P = (const bf16*)(F.ws + WS_P); bf16* PS = (bf16*)(F.ws + WS_PS); bf16* LORA = (bf16*)(F.ws + WS_LORA);
    const float* mu = F.in[I_MU] + (size_t)l * 4 * CSH;
    constexpr int CG = CSH / 8;
    if (tid >= CG) return;
    const int col = tid * 8; const int act = (col >= 3 * DA && col < 3 * DA + LW) ? 1 : (col >= 3 * DA + LW + LAA ? 2 : 0);
    f32x2 m[4][4];
#pragma unroll
    for (int q = 0; q < 4; ++q) { const f32x4 a = *(const f32x4*)(mu + q * CSH + col), b = *(const f32x4*)(mu + q * CSH + col + 4); m[q][0] = (f32x2){a[0], a[1]}; m[q][1] = (f32x2){a[2], a[3]}; m[q][2] = (f32x2){b[0], b[1]}; m[q][3] = (f32x2){b[2], b[3]}; }
#define SH_UNPK(q_, v_) do { v_[0] = (f32x2){__uint_as_float((q_).x << 16), __uint_as_float((q_).x & 0xffff0000u)}; v_[1] = (f32x2){__uint_as_float((q_).y << 16), __uint_as_float((q_).y & 0xffff0000u)}; \
        v_[2] = (f32x2){__uint_as_float((q_).z << 16), __uint_as_float((q_).z & 0xffff0000u)}; v_[3] = (f32x2){__uint_as_float((q_).w << 16), __uint_as_float((q_).w & 0xffff0000u)}; } while (0)
#define SH_STORE(row_, a_) do { float o_[8] = {a_[0].x, a_[0].y, a_[1].x, a_[1].y, a_[2].x, a_[2].y, a_[3].x, a_[3].y}; \
        if (act == 1) { _Pragma("unroll") for (int jx = 0; jx < 8; ++jx) o_[jx] = ftanh(o_[jx]); } else if (act == 2) { _Pragma("unroll") for (int jx = 0; jx < 8; ++jx) o_[jx] = fsigmoid(o_[jx]); } \
        if (col >= 3 * DA) { const int cgl = (col - 3 * DA) >> 3; *(u32x4*)(LORA + ((((size_t)((row_) >> 4) * 9 + (cgl >> 2)) * 64 + 16 * (cgl & 3) + ((row_) & 15)) << 3)) = pack8(o_); } \
        else *(u32x4*)(PS + (size_t)(row_) * CSH + col) = pack8(o_); } while (0)
    const u32x4 Z4 = (u32x4){0u, 0u, 0u, 0u};
    { f32x2 c0[4];
#pragma unroll
      for (int e = 0; e < 4; ++e) c0[e] = (f32x2){1.f, 1.f} - ((m[0][e] + m[1][e]) + (m[2][e] + m[3][e]));
      for (int u = bx; u < 256; u += G) {
          const int gc = u & 63; const bf16* pc = P + ((size_t)MCTX + (size_t)(u >> 6) * 4096 + gc) * PINP + col;
          const int rowb = MCTX + (u >> 6) * 4096 + gc;
          u32x4 up = Z4, cur = *(const u32x4*)pc;
          for (int g0 = 0; g0 < 64; g0 += 4) {
              u32x4 dn[4], lf[4], rt[4];
#pragma unroll
              for (int i = 0; i < 4; ++i) { const int gr = g0 + i; const bf16* pr = pc + (size_t)gr * 64 * PINP;
                  dn[i] = gr < 63 ? *(const u32x4*)(pr + (size_t)64 * PINP) : Z4; lf[i] = gc > 0 ? *(const u32x4*)(pr - PINP) : Z4; rt[i] = gc < 63 ? *(const u32x4*)(pr + PINP) : Z4; }
#pragma unroll
              for (int i = 0; i < 4; ++i) { f32x2 g[4], a[4], nb[4]; SH_UNPK(cur, g);
#pragma unroll
                  for (int e = 0; e < 4; ++e) a[e] = c0[e] * g[e];
                  SH_UNPK(lf[i], nb);
#pragma unroll
                  for (int e = 0; e < 4; ++e) a[e] += m[0][e] * nb[e];
                  SH_UNPK(rt[i], nb);
#pragma unroll
                  for (int e = 0; e < 4; ++e) a[e] += m[1][e] * nb[e];
                  SH_UNPK(up, nb);
#pragma unroll
                  for (int e = 0; e < 4; ++e) a[e] += m[2][e] * nb[e];
                  SH_UNPK(dn[i], nb);
#pragma unroll
                  for (int e = 0; e < 4; ++e) a[e] += m[3][e] * nb[e];
                  const int row = rowb + (g0 + i) * 64; SH_STORE(row, a);
                  up = cur; cur = dn[i]; }
          }
      } }
    { f32x2 c0[4];
#pragma unroll
      for (int e = 0; e < 4; ++e) c0[e] = (f32x2){1.f, 1.f} - (m[0][e] + m[1][e]);
      const int rpw = (MCTX + G - 1) / G, rbeg = bx * rpw, rend = rbeg + rpw < MCTX ? rbeg + rpw : MCTX;
      if (rbeg < rend) {
          const bf16* pc = P + (size_t)rbeg * PINP + col;
          u32x4 prev = (rbeg & 255) ? *(const u32x4*)(pc - PINP) : Z4, cur = *(const u32x4*)pc;
          for (int row = rbeg; row < rend; ++row) { const bf16* pr = P + (size_t)row * PINP + col;
              const u32x4 nxt = (row & 255) != 255 ? *(const u32x4*)(pr + PINP) : Z4;
              f32x2 g[4], a[4], nb[4]; SH_UNPK(cur, g);
#pragma unroll
              for (int e = 0; e < 4; ++e) a[e] = c0[e] * g[e];
              SH_UNPK(prev, nb);
#pragma unroll
              for (int e = 0; e < 4; ++e) a[e] += m[0][e] * nb[e];
              SH_UNPK(nxt, nb);
#pragma unroll
              for (int e = 0; e < 4; ++e) a[e] += m[1][e] * nb[e];
              SH_STORE(row, a);
              prev = (row & 255) != 255 ? cur : Z4; cur = ((row & 255) != 255 || row + 1 >= rend) ? nxt : *(const u32x4*)(pr + PINP); }
      } }
#undef SH_UNPK
#undef SH_STORE
}

#define F4Z ((f32x4){0.f, 0.f, 0.f, 0.f})
__device__ __forceinline__ u32x2 pk4(const f32x4 a) { u32x2 w; w.x = pk2(a[0], a[1]); w.y = pk2(a[2], a[3]); return w; }
#define LBAR() do { asm volatile("s_waitcnt lgkmcnt(0)" ::: "memory"); __builtin_amdgcn_s_barrier(); asm volatile("" ::: "memory"); } while (0)
constexpr int VTS = 136;
typedef short s16x4g __attribute__((ext_vector_type(4)));
__device__ __forceinline__ bf16x8 frag_tr_ld(const LAS bf16* X, int ld, int kbase, int c0, int fr, int fq) {
    const LAS bf16* p = X + (kbase + 8 * fq + (fr >> 2)) * ld + c0 + 4 * (fr & 3);
    const s16x4g lo = __builtin_amdgcn_ds_read_tr16_b64_v4i16((LAS s16x4g*)p);
    const s16x4g hi = __builtin_amdgcn_ds_read_tr16_b64_v4i16((LAS s16x4g*)(p + 4 * ld));
    return (bf16x8){lo[0], lo[1], lo[2], lo[3], hi[0], hi[1], hi[2], hi[3]};
}
__device__ __forceinline__ void p_gmlp(Frame& F, int l, int slot, int nslots) {
    PH_LOCALS(F); PH_LAYER(l); (void)bx; (void)G;
    const bf16* P = (const bf16*)(F.ws + WS_P); bf16* O = (bf16*)(F.ws + WS_O);
    const bf16* wsp = (const bf16*)(F.ws + WS_WSP) + (size_t)l * 8 * 128 * 128;
    LAS bf16* VN = (LAS bf16*)F.lds;
    LAS bf16* ST = (LAS bf16*)(F.lds + 34816);
    const int fr = lane & 15, fq = lane >> 4;
    constexpr int NIT = (M / 128) * NG;
    const int jrow = tid >> 2, q4 = tid & 3;
    u32x4 pvv[4]; f32x4 lgv[8], lbv[8]; bf16x8 bw[4]; float bsp = 0.f; int gcur = -1;
#define GM_ISSUE(item_) do { const bf16* src_ = P + (size_t)(((item_) >> 3) * 128 + jrow) * PINP + CSH + DB + 128 * ((item_) & 7) + 32 * q4; \
        _Pragma("unroll") for (int i_ = 0; i_ < 4; ++i_) pvv[i_] = *(const u32x4*)(src_ + 8 * i_); } while (0)
    if (slot < 0) return;
    LBAR();
    if (slot < NIT) GM_ISSUE(slot);
    for (int item = slot; item < NIT; item += nslots) {
        const int cb = item >> 3, g = item & 7, R0 = cb * 128;
        u32x4 pu[4]; { const bf16* up = P + (size_t)(R0 + jrow) * PINP + CSH + 128 * g + 32 * q4;
#pragma unroll
            for (int i = 0; i < 4; ++i) pu[i] = *(const u32x4*)(up + 8 * i); }
        if (g != gcur) { gcur = g; const bf16* wa = wsp + ((size_t)g * 128 + 16 * wave + fr) * 128 + 8 * fq;
#pragma unroll
            for (int ks = 0; ks < 4; ++ks) bw[ks] = *(const bf16x8*)(wa + 32 * ks);
            bsp = F.in[I_BSP][((size_t)l * 8 + g) * 128 + jrow];
            const float* lg = F.in[I_LNG] + ((size_t)l * 8 + g) * 128 + 32 * q4; const float* lb = F.in[I_LNB] + ((size_t)l * 8 + g) * 128 + 32 * q4;
#pragma unroll
            for (int i = 0; i < 8; ++i) { lgv[i] = *(const f32x4*)(lg + 4 * i); lbv[i] = *(const f32x4*)(lb + 4 * i); } }
        { float v[32];
#pragma unroll
          for (int i = 0; i < 4; ++i) { float f[8]; unpack8(pvv[i], f);
#pragma unroll
              for (int jj = 0; jj < 8; ++jj) v[8 * i + jj] = f[jj]; }
          float s = 0.f;
#pragma unroll
          for (int i = 0; i < 32; ++i) s += v[i];
          s += SHX(s, 1); s += SHX(s, 2);
          const float mean = s * (1.0f / 128.0f); float qq = 0.f;
#pragma unroll
          for (int i = 0; i < 32; ++i) { v[i] -= mean; qq += v[i] * v[i]; }
          qq += SHX(qq, 1); qq += SHX(qq, 2);
          const float rstd = 1.0f / sqrtf(qq * (1.0f / 128.0f) + LN_EPS);
#pragma unroll
          for (int i = 0; i < 4; ++i) { float o[8]; const f32x4 g0 = lgv[2 * i], g1 = lgv[2 * i + 1], b0 = lbv[2 * i], b1 = lbv[2 * i + 1];
#pragma unroll
              for (int jj = 0; jj < 4; ++jj) { o[jj] = v[8 * i + jj] * rstd * g0[jj] + b0[jj]; o[4 + jj] = v[8 * i + 4 + jj] * rstd * g1[jj] + b1[jj]; }
              *(LAS u32x4*)(VN + jrow * VTS + 32 * q4 + 8 * i) = pack8(o); } }
        if (item + nslots < NIT) GM_ISSUE(item + nslots);
        LBAR();
#pragma unroll
        for (int mt = 0; mt < 8; ++mt) { f32x4 acc = F4Z;
#pragma unroll
            for (int ks = 0; ks < 4; ++ks) acc = __builtin_amdgcn_mfma_f32_16x16x32_bf16(frag_tr_ld(VN, VTS, 32 * ks, 16 * mt, fr, fq), bw[ks], acc, 0, 0, 0);
            *(LAS u32x2*)(ST + (16 * wave + fr) * VTS + 16 * mt + 4 * fq) = pk4(acc); }
        LBAR();
        { bf16* op = O + (size_t)(R0 + jrow) * D + DA + 128 * g + 32 * q4;
#pragma unroll
          for (int i = 0; i < 4; ++i) { float sv[8], uv[8], o[8]; unpack8(*(const LAS u32x4*)(ST + jrow * VTS + 32 * q4 + 8 * i), sv); unpack8(pu[i], uv);
#pragma unroll
              for (int jj = 0; jj < 8; ++jj) o[jj] = uv[jj] * (sv[jj] + bsp);
              *(u32x4*)(op + 8 * i) = pack8(o); } }
    }
    LBAR();
#undef GM_ISSUE
}

constexpr int T16B = 9216, LD16 = 72, LD32 = 68;
#define SLOT(i) ((LAS bf16*)(lds + (i) * T16B))
#define SLOTF(i) ((LAS float*)(lds + (i) * T16B))
template <int NK>
__device__ __forceinline__ f32x4 tile_mm(const LAS bf16* A, int lda, const LAS bf16* B, int ldb, int fr, int fq, f32x4 acc) {
#pragma unroll
    for (int ks = 0; ks < NK; ++ks) { const bf16x8 a = *(const LAS bf16x8*)(A + fr * lda + 8 * fq + 32 * ks); const bf16x8 b = *(const LAS bf16x8*)(B + fr * ldb + 8 * fq + 32 * ks);
        acc = __builtin_amdgcn_mfma_f32_16x16x32_bf16(a, b, acc, 0, 0, 0); }
    return acc;
}
__device__ __forceinline__ void st_nat(LAS bf16* dst, int n0, int m0, int fr, int fq, const f32x4 a) { *(LAS u32x2*)(dst + (n0 + fr) * LD16 + m0 + 4 * fq) = pk4(a); }
__device__ __forceinline__ void st_rm(LAS bf16* dst, int n0, int m0, int fr, int fq, const f32x4 a) {
#pragma unroll
    for (int r = 0; r < 4; ++r) dst[(m0 + 4 * fq + r) * LD16 + n0 + fr] = (bf16)f2bf(a[r]); }
__device__ __forceinline__ f32x4 ld4bf(const LAS bf16* p) { const u32x2 w = *(const LAS u32x2*)p; return (f32x4){__uint_as_float(w.x << 16), __uint_as_float(w.x & 0xffff0000u), __uint_as_float(w.y << 16), __uint_as_float(w.y & 0xffff0000u)}; }

__device__ __forceinline__ int fm_off(int n0, int m0, int fr, int fq) { return ((((n0 >> 4) * 2 + (m0 >> 5)) * 64 + (2 * ((m0 >> 4) & 1) + (fq >> 1)) * 16 + fr) << 3) + 4 * (fq & 1); }
typedef short s16x4 __attribute__((ext_vector_type(4)));
__device__ __forceinline__ bf16x8 frag_tr(const LAS bf16* X, int kbase, int c0, int fr, int fq) {
    const LAS bf16* p = X + (kbase + 8 * fq + (fr >> 2)) * LD16 + c0 + 4 * (fr & 3);
    const s16x4 lo = __builtin_amdgcn_ds_read_tr16_b64_v4i16((LAS s16x4*)p);
    const s16x4 hi = __builtin_amdgcn_ds_read_tr16_b64_v4i16((LAS s16x4*)(p + 4 * LD16));
    return (bf16x8){lo[0], lo[1], lo[2], lo[3], hi[0], hi[1], hi[2], hi[3]};
}
__device__ __forceinline__ bf16x8 frag_rm(const LAS bf16* X, int r0, int ks, int fr, int fq) { return *(const LAS bf16x8*)(X + (r0 + fr) * LD16 + 8 * fq + 32 * ks); }
__device__ __forceinline__ f32x4 mm2(const bf16x8 (&a)[2], const bf16x8 (&b)[2], f32x4 acc) {
    acc = __builtin_amdgcn_mfma_f32_16x16x32_bf16(a[0], b[0], acc, 0, 0, 0); return __builtin_amdgcn_mfma_f32_16x16x32_bf16(a[1], b[1], acc, 0, 0, 0); }
__device__ __forceinline__ bf16x8 as_frag(const u32x4 q) { return __builtin_bit_cast(bf16x8, q); }

__device__ __forceinline__ void p_chunkA(Frame& F, int l) {
    PH_LOCALS(F); PH_LAYER(l);
    LAS unsigned char* lds = F.lds;
    const int lane0 = lane, lane00 = lane;
#define STG int lane_ = lane0; asm volatile("" : "+v"(lane_)); const int lane = lane_, fr = lane_ & 15, fq = lane_ >> 4, tid = wave * 64 + lane_, mt = wave >> 1, m0 = 16 * mt, np = (wave & 1) * 2; \
    (void)lane; (void)fr; (void)fq; (void)tid; (void)mt; (void)m0; (void)np;
    const bf16* PS = (const bf16*)(F.ws + WS_PS);
    const bf16* w2t = (const bf16*)(F.ws + WS_W2T) + (size_t)l * 2 * 1024 * 64;
    const bf16* a2t = (const bf16*)(F.ws + WS_A2T) + (size_t)l * 2 * 1024 * 64;
    const bf16* g2t = (const bf16*)(F.ws + WS_G2T) + (size_t)l * 1024 * 160;
    bf16* GATE = (bf16*)(F.ws + WS_GATE); float* BONUS = (float*)(F.ws + WS_BONUS);
    LAS float* gC = (LAS float*)(lds + 14 * T16B);
    LAS float* BT = (LAS float*)(lds + 14 * T16B + 256);
    u32x4 pf_w[2], pf_a[2], pf_g[5], pf_r, pf_k, pf_v; bf16x8 Bg[2][5], Bw[2][2], Ba[2][2]; float biw[2], bia[2];
#define CA_ISSUE(item_, d_) do { const int ci_ = (item_) >> 4, h_ = (item_) & 15, R0_ = ci_ * 64; int lane0 = lane00; asm volatile("" : "+v"(lane0)); \
        const bf16* arow_ = (const bf16*)(F.ws + WS_LORA) + ((((size_t)(R0_ >> 4) + (wave >> 1)) * 9 * 64 + lane0) << 3); \
        pf_w[0] = *(const u32x4*)arow_; pf_w[1] = *(const u32x4*)(arow_ + 512); pf_a[0] = *(const u32x4*)(arow_ + 1024); pf_a[1] = *(const u32x4*)(arow_ + 1536); \
        if ((d_) == 0) { _Pragma("unroll") for (int ks_ = 0; ks_ < 5; ++ks_) { pf_g[ks_] = *(const u32x4*)(arow_ + 2048 + 512 * ks_); \
            _Pragma("unroll") for (int nn_ = 0; nn_ < 2; ++nn_) Bg[nn_][ks_] = *(const bf16x8*)(g2t + (size_t)(64 * h_ + 16 * ((wave & 1) * 2 + nn_) + (lane0 & 15)) * 160 + 8 * (lane0 >> 4) + 32 * ks_); } } \
        _Pragma("unroll") for (int nn_ = 0; nn_ < 2; ++nn_) { const int n_ = 64 * h_ + 16 * ((wave & 1) * 2 + nn_) + (lane0 & 15); \
            biw[nn_] = F.in[I_W0][((size_t)l * 2 + (d_)) * DA + n_]; bia[nn_] = F.in[I_A0][((size_t)l * 2 + (d_)) * DA + n_]; \
            _Pragma("unroll") for (int ks_ = 0; ks_ < 2; ++ks_) { Bw[nn_][ks_] = *(const bf16x8*)(w2t + ((size_t)(d_) * 1024 + n_) * 64 + 8 * (lane0 >> 4) + 32 * ks_); Ba[nn_][ks_] = *(const bf16x8*)(a2t + ((size_t)(d_) * 1024 + n_) * 64 + 8 * (lane0 >> 4) + 32 * ks_); } } \
        const int tid_ = wave * 64 + lane0, tau_ = tid_ >> 3, pos_ = (d_) ? 63 - tau_ : tau_; const bf16* rrow_ = PS + (size_t)(R0_ + pos_) * CSH + 64 * h_ + (tid_ & 7) * 8; \
        pf_r = *(const u32x4*)rrow_; pf_k = *(const u32x4*)(rrow_ + DA); pf_v = *(const u32x4*)(rrow_ + 2 * DA); } while (0)
    if (bx < (M / 64) * NH) CA_ISSUE(bx, 0);
    int hcur = -1;
    LAS float* HC = (LAS float*)(lds + 14 * T16B + 1280);
    for (int item = bx; item < (M / 64) * NH; item += G) {
        const int ci = item >> 4, h = item & 15, R0 = ci * 64;
        { (void)hcur;
            LBAR();
            { const int t_ = wave * 64 + lane0; if (t_ < 192) { const int w_ = t_ >> 6, c_ = t_ & 63; HC[t_] = (w_ == 0 ? F.in[I_KK] : (w_ == 1 ? F.in[I_KA] : F.in[I_RK]))[(size_t)l * DA + 64 * h + c_]; } } }
#pragma unroll
        for (int d = 0; d < 2; ++d) {
            const size_t qi = ((size_t)ci * 16 + h) * 2 + d;
            const bf16x8 cBw[2][2] = {{Bw[0][0], Bw[0][1]}, {Bw[1][0], Bw[1][1]}}, cBa[2][2] = {{Ba[0][0], Ba[0][1]}, {Ba[1][0], Ba[1][1]}}; const float cbw[2] = {biw[0], biw[1]}, cba[2] = {bia[0], bia[1]};
            u32x4 cw[2] = {pf_w[0], pf_w[1]}, ca[2] = {pf_a[0], pf_a[1]}, cg[5] = {pf_g[0], pf_g[1], pf_g[2], pf_g[3], pf_g[4]}; const u32x4 cr = pf_r, ck = pf_k, cv = pf_v;
            for (int repA = 0; repA < (PROBE_SUB == 1 ? 2 : 1); ++repA) {
            { STG; LAS float* AL = SLOTF(5); LAS float* LW = SLOTF(7);
              bf16x8 aw[2], aa[2];
#pragma unroll
              for (int ks = 0; ks < 2; ++ks) { aw[ks] = as_frag(cw[ks]); aa[ks] = as_frag(ca[ks]); }
#pragma unroll
              for (int nn = 0; nn < 2; ++nn) { const int nl = 16 * (np + nn) + fr, n = 64 * h + nl;
                  const f32x4 accw = mm2(aw, cBw[nn], F4Z), acca = mm2(aa, cBa[nn], F4Z);
                  const float biasw = cbw[nn], biasa = cba[nn]; (void)n;
                  float lw[4], c[4];
#pragma unroll
                  for (int r = 0; r < 4; ++r) lw[r] = -0.8750345269f * fsigmoid(biasw + accw[r]);
                  if (d == 0) { c[0] = lw[0]; c[1] = c[0] + lw[1]; c[2] = c[1] + lw[2]; c[3] = c[2] + lw[3]; }
                  else { c[3] = lw[3]; c[2] = c[3] + lw[2]; c[1] = c[2] + lw[1]; c[0] = c[1] + lw[0]; }
                  const float tot = d == 0 ? c[3] : c[0];
                  const float t1 = SHX(tot, 16), t2 = SHX(tot, 32), t3 = SHX(tot, 48);
                  float off;
                  { const int sg = d ? -1 : 1, q1 = fq ^ 1, q2 = fq ^ 2, q3 = fq ^ 3;
                    const int k1 = (sg * (q1 - fq)) >> 31, k2 = (sg * (q2 - fq)) >> 31, k3 = (sg * (q3 - fq)) >> 31;
                    off = (__int_as_float(__float_as_int(t1) & k1) + __int_as_float(__float_as_int(t2) & k2)) + __int_as_float(__float_as_int(t3) & k3); }
#pragma unroll
                  for (int r = 0; r < 4; ++r) { const int pos = m0 + 4 * fq + r, tau = d ? 63 - pos : pos;
                      LW[tau * LD32 + nl] = c[r] + off; AL[tau * LD32 + nl] = fsigmoid(biasa + acca[r]); }
                  if (fq == 0) BT[(d ? 3 - mt : mt) * 64 + nl] = (tot + t1) + (t2 + t3); }
              if (d == 0) {
                  bf16x8 ag[5];
#pragma unroll
                  for (int ks = 0; ks < 5; ++ks) ag[ks] = as_frag(cg[ks]);
#pragma unroll
                  for (int nn = 0; nn < 2; ++nn) { const int n = 64 * h + 16 * (np + nn) + fr; f32x4 acc = F4Z;
#pragma unroll
                      for (int ks = 0; ks < 5; ++ks) acc = __builtin_amdgcn_mfma_f32_16x16x32_bf16(ag[ks], Bg[nn][ks], acc, 0, 0, 0);
#pragma unroll
                      for (int r = 0; r < 4; ++r) SLOT(11)[(m0 + 4 * fq + r) * LD16 + 16 * (np + nn) + fr] = (bf16)f2bf(acc[r]); (void)n; } } }
            LBAR();
            { STG; const LAS float* AL = SLOTF(5); const LAS float* LW = SLOTF(7);
              const int tau = tid >> 3, c8 = (tid & 7) * 8, pos = d ? 63 - tau : tau, row = R0 + pos, blk = wave >> 1;
              f32x2 r[4], k[4];
              { const u32x4 q = cr; r[0] = (f32x2){__uint_as_float(q.x << 16), __uint_as_float(q.x & 0xffff0000u)}; r[1] = (f32x2){__uint_as_float(q.y << 16), __uint_as_float(q.y & 0xffff0000u)};
                r[2] = (f32x2){__uint_as_float(q.z << 16), __uint_as_float(q.z & 0xffff0000u)}; r[3] = (f32x2){__uint_as_float(q.w << 16), __uint_as_float(q.w & 0xffff0000u)}; }
              { const u32x4 q = ck; k[0] = (f32x2){__uint_as_float(q.x << 16), __uint_as_float(q.x & 0xffff0000u)}; k[1] = (f32x2){__uint_as_float(q.y << 16), __uint_as_float(q.y & 0xffff0000u)};
                k[2] = (f32x2){__uint_as_float(q.z << 16), __uint_as_float(q.z & 0xffff0000u)}; k[3] = (f32x2){__uint_as_float(q.w << 16), __uint_as_float(q.w & 0xffff0000u)}; }
              f32x2 offb[4], totC[4];
#pragma unroll
              for (int j = 0; j < 4; ++j) { offb[j] = (f32x2){0.f, 0.f}; totC[j] = (f32x2){0.f, 0.f}; }
#pragma unroll
              for (int b = 0; b < 4; ++b) { const f32x4 x0 = *(const LAS f32x4*)(BT + b * 64 + c8), x1 = *(const LAS f32x4*)(BT + b * 64 + c8 + 4);
                  const f32x2 y[4] = {{x0[0], x0[1]}, {x0[2], x0[3]}, {x1[0], x1[1]}, {x1[2], x1[3]}};
                  const float fb = b < blk ? 1.0f : 0.0f;
#pragma unroll
                  for (int j = 0; j < 4; ++j) { totC[j] += y[j]; offb[j] += y[j] * fb; } }
              f32x2 ckk[4], cka[4], crk[4];
              { const f32x4 a0 = *(const LAS f32x4*)(HC + c8), a1 = *(const LAS f32x4*)(HC + c8 + 4), b0 = *(const LAS f32x4*)(HC + 64 + c8), b1 = *(const LAS f32x4*)(HC + 64 + c8 + 4), c0 = *(const LAS f32x4*)(HC + 128 + c8), c1 = *(const LAS f32x4*)(HC + 128 + c8 + 4);
                ckk[0] = (f32x2){a0[0], a0[1]}; ckk[1] = (f32x2){a0[2], a0[3]}; ckk[2] = (f32x2){a1[0], a1[1]}; ckk[3] = (f32x2){a1[2], a1[3]};
                cka[0] = (f32x2){b0[0], b0[1]}; cka[1] = (f32x2){b0[2], b0[3]}; cka[2] = (f32x2){b1[0], b1[1]}; cka[3] = (f32x2){b1[2], b1[3]};
                crk[0] = (f32x2){c0[0], c0[1]}; crk[1] = (f32x2){c0[2], c0[3]}; crk[2] = (f32x2){c1[0], c1[1]}; crk[3] = (f32x2){c1[2], c1[3]}; }
              f32x2 kk[4], s2 = (f32x2){0.f, 0.f};
#pragma unroll
              for (int j = 0; j < 4; ++j) { kk[j] = k[j] * ckk[j]; s2 += kk[j] * kk[j]; }
              float ss = s2.x + s2.y;
              ss += SHX(ss, 1); ss += SHX(ss, 2); ss += SHX(ss, 4);
              const float rn = 1.0f / sqrtf(fmaxf(ss, 1e-24f));
              f32x2 alv[4], csv[4], csm[4];
              { const f32x4 a0 = *(const LAS f32x4*)(AL + tau * LD32 + c8), a1 = *(const LAS f32x4*)(AL + tau * LD32 + c8 + 4), c0 = *(const LAS f32x4*)(LW + tau * LD32 + c8), c1 = *(const LAS f32x4*)(LW + tau * LD32 + c8 + 4);
                const int tm = (tau & 15) ? tau - 1 : tau; f32x4 e0 = *(const LAS f32x4*)(LW + tm * LD32 + c8), e1 = *(const LAS f32x4*)(LW + tm * LD32 + c8 + 4);
                if ((tau & 15) == 0) { e0 = F4Z; e1 = F4Z; }
                alv[0] = (f32x2){a0[0], a0[1]}; alv[1] = (f32x2){a0[2], a0[3]}; alv[2] = (f32x2){a1[0], a1[1]}; alv[3] = (f32x2){a1[2], a1[3]};
                csv[0] = (f32x2){c0[0], c0[1]} + offb[0]; csv[1] = (f32x2){c0[2], c0[3]} + offb[1]; csv[2] = (f32x2){c1[0], c1[1]} + offb[2]; csv[3] = (f32x2){c1[2], c1[3]} + offb[3];
                csm[0] = (f32x2){e0[0], e0[1]} + offb[0]; csm[1] = (f32x2){e0[2], e0[3]} + offb[1]; csm[2] = (f32x2){e1[0], e1[1]} + offb[2]; csm[3] = (f32x2){e1[2], e1[3]} + offb[3]; }
              f32x2 at[4], rt[4], bt[4], kt[4], bh[4], kh[4], bon2 = (f32x2){0.f, 0.f};
#pragma unroll
              for (int j = 0; j < 4; ++j) { const f32x2 al = alv[j], cs = csv[j], dh = totC[j] - cs;
                  const f32x2 kkn = kk[j] * rn, kd = k[j] * ((al - 1.0f) * cka[j] + 1.0f), bb = kkn * al;
                  bon2 += r[j] * kd * crk[j];
                  const f32x2 encs = (f32x2){__builtin_amdgcn_exp2f(-cs.x), __builtin_amdgcn_exp2f(-cs.y)}, eh = (f32x2){__builtin_amdgcn_exp2f(dh.x), __builtin_amdgcn_exp2f(dh.y)};
                  const f32x2 ecm = (f32x2){__builtin_amdgcn_exp2f(csm[j].x), __builtin_amdgcn_exp2f(csm[j].y)}, ecs = (f32x2){__builtin_amdgcn_exp2f(cs.x), __builtin_amdgcn_exp2f(cs.y)};
                  at[j] = -(ecm * kkn); rt[j] = ecs * r[j]; bt[j] = encs * bb; kt[j] = encs * kd; bh[j] = eh * bb; kh[j] = eh * kd; }
              if (tau == 63) {
#pragma unroll
                  for (int j = 0; j < 4; ++j) { gC[c8 + 2 * j] = __builtin_amdgcn_exp2f(totC[j].x); gC[c8 + 2 * j + 1] = __builtin_amdgcn_exp2f(totC[j].y); } }
#define PK8V(a) ((u32x4){pk2(a[0].x, a[0].y), pk2(a[1].x, a[1].y), pk2(a[2].x, a[2].y), pk2(a[3].x, a[3].y)})
              *(LAS u32x4*)(SLOT(0) + tau * LD16 + c8) = PK8V(at); *(LAS u32x4*)(SLOT(1) + tau * LD16 + c8) = PK8V(rt);
              *(LAS u32x4*)(SLOT(2) + tau * LD16 + c8) = PK8V(bt); *(LAS u32x4*)(SLOT(3) + tau * LD16 + c8) = PK8V(kt);
              *(LAS u32x4*)(SLOT(4) + tau * LD16 + c8) = PK8V(bh); *(LAS u32x4*)(SLOT(9) + tau * LD16 + c8) = PK8V(kh);
#undef PK8V
              *(LAS u32x4*)(SLOT(10) + tau * LD16 + c8) = cv;
              if (d == 0) *(u32x4*)(GATE + (size_t)row * DA + 64 * h + c8) = *(const LAS u32x4*)(SLOT(11) + pos * LD16 + c8);
              float bon = bon2.x + bon2.y;
              bon += SHX(bon, 1); bon += SHX(bon, 2); bon += SHX(bon, 4);
              BONUS[((size_t)d * M + row) * NH + h] = bon; }
            LBAR();
            }
            { int nitem = d == 0 ? item : item + G; const int nd = d ^ 1; if (nitem >= (M / 64) * NH) nitem = item; CA_ISSUE(nitem, nd); }
            for (int repB = 0; repB < (PROBE_SUB == 2 ? 2 : 1); ++repB) {
            { STG; bf16x8 aB[2], aA[2], aK[2];
#pragma unroll
              for (int ks = 0; ks < 2; ++ks) { aB[ks] = frag_rm(SLOT(2), m0, ks, fr, fq); aA[ks] = frag_rm(SLOT(0), m0, ks, fr, fq); aK[ks] = frag_rm(SLOT(3), m0, ks, fr, fq); }
#pragma unroll
              for (int nn = 0; nn < 2; ++nn) { const int n0 = 16 * (np + nn), n = n0 + fr; bf16x8 bA[2], bB[2], bK[2], bR[2];
#pragma unroll
                  for (int ks = 0; ks < 2; ++ks) { bA[ks] = frag_rm(SLOT(0), n0, ks, fr, fq); bB[ks] = frag_rm(SLOT(2), n0, ks, fr, fq); bK[ks] = frag_rm(SLOT(3), n0, ks, fr, fq); bR[ks] = frag_rm(SLOT(1), n0, ks, fr, fq); }
                  f32x4 p0 = mm2(aB, bA, F4Z), p1 = mm2(aA, bB, F4Z), p2 = mm2(aA, bK, F4Z), p3 = mm2(aB, bR, F4Z), p4 = mm2(aK, bR, F4Z), t0;
#pragma unroll
                  for (int r = 0; r < 4; ++r) { const int m = m0 + 4 * fq + r;
                      p0[r] = m < n ? p0[r] : 0.f; p1[r] = n < m ? p1[r] : 0.f; p2[r] = n < m ? p2[r] : 0.f; p3[r] = m <= n ? p3[r] : 0.f; p4[r] = m <= n ? p4[r] : 0.f;
                      t0[r] = p1[r] + (m == n ? 1.0f : 0.f); }
                  st_nat(SLOT(5), n0, m0, fr, fq, p0); st_nat(SLOT(6), n0, m0, fr, fq, p1); st_nat(SLOT(7), n0, m0, fr, fq, t0);
                  st_nat(SLOT(8), n0, m0, fr, fq, p2); st_nat(SLOT(11), n0, m0, fr, fq, p3); st_nat(SLOT(12), n0, m0, fr, fq, p4); } }
            LBAR();
#define MM1(a, b, c) __builtin_amdgcn_mfma_f32_16x16x32_bf16(a, b, c, 0, 0, 0)
            { STG; const int b = wave >> 2, bm0 = 32 * b + 16 * ((wave >> 1) & 1), bn0 = 32 * b + 16 * (wave & 1), oc = 32 * (1 - b) - 32 * b;
              const bf16x8 aT = frag_rm(SLOT(5), bm0, b, fr, fq), aR = frag_rm(SLOT(6), bm0, b, fr, fq), bR = frag_rm(SLOT(6), bn0, b, fr, fq), bT = frag_rm(SLOT(5), bn0, b, fr, fq);
              st_nat(SLOT(2), bn0, bm0, fr, fq, MM1(aT, bR, F4Z)); st_nat(SLOT(2), bn0, bm0 + oc, fr, fq, MM1(aR, bT, F4Z)); }
            LBAR();
#pragma unroll
            for (int kq = 1; kq <= 4; ++kq) {
                STG; const int b = wave >> 2, bm0 = 32 * b + 16 * ((wave >> 1) & 1), bn0 = 32 * b + 16 * (wave & 1), oc = 32 * (1 - b) - 32 * b;
                const int pin = (kq & 1) ? 2 : 3, pout = (kq & 1) ? 3 : 2, tin = (kq & 1) ? 7 : 13, tout = (kq & 1) ? 13 : 7;
                const bf16x8 aPT = frag_rm(SLOT(pin), bm0, 1 - b, fr, fq), bTn = frag_rm(SLOT(tin), bn0, b, fr, fq);
                st_nat(SLOT(tout), bn0, bm0, fr, fq, MM1(aPT, bTn, ld4bf(SLOT(tin) + (bn0 + fr) * LD16 + bm0 + 4 * fq)));
                if (kq < 4) { const bf16x8 aPR = frag_rm(SLOT(pin), bm0, b, fr, fq), bPR = frag_rm(SLOT(pin), bn0, b, fr, fq), bPT = frag_rm(SLOT(pin), bn0, 1 - b, fr, fq);
                    st_nat(SLOT(pout), bn0, bm0, fr, fq, MM1(aPT, bPR, F4Z));
                    st_nat(SLOT(pout), bn0, bm0 + oc, fr, fq, MM1(aPR, bPT, F4Z)); }
                LBAR();
            }
            { STG; if (wave < 4) { const int xm0 = 16 * ((wave >> 1) & 1), xn0 = 32 + 16 * (wave & 1);
                  const bf16x8 a = frag_rm(SLOT(6), xm0, 1, fr, fq), bb = frag_tr(SLOT(7), 32, xn0, fr, fq);
                  st_nat(SLOT(13), xn0, xm0, fr, fq, MM1(a, bb, F4Z)); } }
            LBAR();
            { STG; if (wave < 4) { const int tn0 = 32 + 16 * ((wave >> 1) & 1), tm0 = 16 * (wave & 1);
                  const bf16x8 a = frag_rm(SLOT(13), tn0, 0, fr, fq), bb = frag_rm(SLOT(7), tm0, 0, fr, fq);
                  st_nat(SLOT(7), tm0, tn0, fr, fq, MM1(a, bb, F4Z)); } }
            LBAR();
#undef MM1
            { STG; const int xt = wave, n0 = 16 * (xt & 3); bf16x8 b[2];
              if (xt < 4) { b[0] = frag_rm(SLOT(11), n0, 0, fr, fq); b[1] = frag_rm(SLOT(11), n0, 1, fr, fq); }
              else { b[0] = frag_tr(SLOT(4), 0, n0, fr, fq); b[1] = frag_tr(SLOT(4), 32, n0, fr, fq); }
#pragma unroll
              for (int mm = 0; mm < 4; ++mm) { bf16x8 a[2] = {frag_rm(SLOT(7), 16 * mm, 0, fr, fq), frag_rm(SLOT(7), 16 * mm, 1, fr, fq)};
                  st_nat(xt < 4 ? SLOT(5) : SLOT(6), n0, 16 * mm, fr, fq, mm2(a, b, F4Z)); } }
            LBAR();
            }
            for (int repC = 0; repC < (PROBE_SUB == 3 ? 2 : 1); ++repC) {
            { STG; bf16x8 aAt[2] = {frag_tr(SLOT(0), 0, m0, fr, fq), frag_tr(SLOT(0), 32, m0, fr, fq)}, aAk[2] = {frag_rm(SLOT(8), m0, 0, fr, fq), frag_rm(SLOT(8), m0, 1, fr, fq)};
              bf16* pyt = (bf16*)(F.ws + WS_PYT) + qi * 4096; bf16* qyt = (bf16*)(F.ws + WS_QYT) + qi * 4096; bf16* pst = (bf16*)(F.ws + WS_PST) + qi * 4096;
#pragma unroll
              for (int nn = 0; nn < 2; ++nn) { const int n0 = 16 * (np + nn), n = n0 + fr, mb = m0 + 4 * fq;
                  bf16x8 bRb[2] = {frag_rm(SLOT(5), n0, 0, fr, fq), frag_rm(SLOT(5), n0, 1, fr, fq)}, bBh[2] = {frag_rm(SLOT(6), n0, 0, fr, fq), frag_rm(SLOT(6), n0, 1, fr, fq)};
                  const f32x4 py = mm2(aAt, bRb, ld4bf(SLOT(1) + n * LD16 + mb)), qy = mm2(aAk, bRb, ld4bf(SLOT(12) + n * LD16 + mb));
                  f32x4 psi, qsi;
#pragma unroll
                  for (int r = 0; r < 4; ++r) { psi[r] = (mb + r == n) ? gC[n] : 0.f; qsi[r] = bf2f(SLOT(9)[(mb + r) * LD16 + n]); }
                  const f32x4 ps = mm2(aAt, bBh, psi), qs = mm2(aAk, bBh, qsi);
                  { const int fo = fm_off(n0, m0, fr, fq); *(u32x2*)(pyt + fo) = pk4(py); *(u32x2*)(qyt + fo) = pk4(qy); *(u32x2*)(pst + fo) = pk4(ps); }
                  st_nat(SLOT(2), n0, m0, fr, fq, qs); } }
            LBAR();
            { STG; bf16* nct = (bf16*)(F.ws + WS_NCT) + qi * 4096; bf16* vtg = (bf16*)(F.ws + WS_VTG) + qi * 4096;
              bf16x8 a[2] = {frag_rm(SLOT(2), m0, 0, fr, fq), frag_rm(SLOT(2), m0, 1, fr, fq)};
#pragma unroll
              for (int nn = 0; nn < 2; ++nn) { const int n0 = 16 * (np + nn); bf16x8 b[2] = {frag_tr(SLOT(10), 0, n0, fr, fq), frag_tr(SLOT(10), 32, n0, fr, fq)};
                  *(u32x2*)(nct + ((((n0 >> 4) * 4 + mt) * 64 + lane) << 2)) = pk4(mm2(a, b, F4Z));
                  if (nn == (mt >> 1)) { const bf16x8 bs = (mt & 1) ? b[1] : b[0]; *(bf16x8*)(vtg + ((((n0 >> 4) * 2 + (mt & 1)) * 64 + lane) << 3)) = bs; } } }
            LBAR();
            }
        }
    }
#undef STG
#undef CA_ISSUE
}

__device__ __forceinline__ void p_chunkB(Frame& F, int l) {
    PH_LOCALS(F); PH_LAYER(l);
    const int fr = lane & 15, fq = lane >> 4;
    LAS bf16* Sl = (LAS bf16*)(F.lds + wave * 2304);
    const bf16* PST = (const bf16*)(F.ws + WS_PST); const bf16* NCT = (const bf16*)(F.ws + WS_NCT); bf16* SC = (bf16*)(F.ws + WS_SC);
    for (int cp = bx; cp < 64; cp += G) {
        const int cslot = wave >> 2, chain = 2 * cp + cslot, vb = wave & 3, b = chain >> 5, h = (chain >> 1) & 15, d = chain & 1, cb = 64 + b * 64; constexpr int NC = 64;
        LAS bf16* AL = (LAS bf16*)(F.lds + 20480) + cslot * 3 * 4096;
        f32x4 S[4];
        { const float* src = F.in[I_STATE] + ((((size_t)b * NL + l) * 2 + d) * NH + h) * 4096 + (size_t)(16 * vb + fr) * 64 + 4 * fq;
#pragma unroll
          for (int T = 0; T < 4; ++T) S[T] = *(const f32x4*)(src + 16 * T); }
        bf16x8 Aq[8][2]; u32x2 Nq[8][4];
#define LB_QI(step) ((((size_t)(cb + (d ? NC - 1 - (step) : (step)))) * 16 + h) * 2 + d)
#define LB_LDA(u, step) do { const int st_ = (step) < NC ? (step) : NC - 1; const bf16* ps_ = PST + LB_QI(st_) * 4096 + vb * 1024 + lane * 8; Aq[u][0] = *(const bf16x8*)ps_; Aq[u][1] = *(const bf16x8*)(ps_ + 512); } while (0)
#define LB_LDN(u, step) do { const int st_ = (step) < NC ? (step) : NC - 1; const bf16* nc_ = NCT + LB_QI(st_) * 4096 + ((vb * 4 * 64 + lane) << 2); \
        _Pragma("unroll") for (int mt_ = 0; mt_ < 4; ++mt_) Nq[u][mt_] = *(const u32x2*)(nc_ + mt_ * 256); } while (0)
#pragma unroll
        for (int u = 0; u < 8; ++u) { LB_LDA(u, u); LB_LDN(u, u); }
        *(LAS bf16x8*)(AL + ((vb * 2 + 0) * 64 + lane) * 8) = Aq[0][0]; *(LAS bf16x8*)(AL + ((vb * 2 + 1) * 64 + lane) * 8) = Aq[0][1];
        LB_LDA(0, 8);
        for (int g = 0; g < NC; g += 8) {
#pragma unroll
            for (int u = 0; u < 8; ++u) {
                const int step = g + u; const size_t q = LB_QI(step); bf16* scg = SC + q * 4096;
#pragma unroll
                for (int T = 0; T < 4; ++T) { const u32x2 w = pk4(S[T]); *(LAS u32x2*)(Sl + fr * LD16 + 16 * T + 4 * fq) = w; *(u32x2*)(scg + fm_off(16 * vb, 16 * T, fr, fq)) = w; }
                { LAS bf16* nb_ = AL + ((step + 1) % 3) * 4096; const int u1 = (u + 1) & 7;
                  *(LAS bf16x8*)(nb_ + ((vb * 2 + 0) * 64 + lane) * 8) = Aq[u1][0]; *(LAS bf16x8*)(nb_ + ((vb * 2 + 1) * 64 + lane) * 8) = Aq[u1][1];
                  LB_LDA(u1, step + 9); }
                LBAR();
                const LAS bf16* cbuf = AL + (step % 3) * 4096 + lane * 8;
                const bf16x8 b0 = *(const LAS bf16x8*)(Sl + fr * LD16 + 8 * fq), b1 = *(const LAS bf16x8*)(Sl + fr * LD16 + 8 * fq + 32);
#pragma unroll
                for (int mt = 0; mt < 4; ++mt) { const u32x2 nw = Nq[u][mt];
                    f32x4 acc = (f32x4){__uint_as_float(nw.x << 16), __uint_as_float(nw.x & 0xffff0000u), __uint_as_float(nw.y << 16), __uint_as_float(nw.y & 0xffff0000u)};
                    acc = __builtin_amdgcn_mfma_f32_16x16x32_bf16(*(const LAS bf16x8*)(cbuf + (mt * 2) * 512), b0, acc, 0, 0, 0);
                    acc = __builtin_amdgcn_mfma_f32_16x16x32_bf16(*(const LAS bf16x8*)(cbuf + (mt * 2 + 1) * 512), b1, acc, 0, 0, 0);
                    S[mt] = acc; }
                LB_LDN(u, step + 8);
            }
        }
#undef LB_LDA
#undef LB_LDN
#undef LB_QI
        LBAR();
    }
    const int w0 = (G > 64) ? (bx - 64) * NWAVES + wave : bx * NWAVES + wave, wst = (G > 64) ? (G - 64) * NWAVES : G * NWAVES;
    if (G > 64 && bx < 64) return;
    for (int t = w0; t < 2048; t += wst) {
        const int chain = t >> 2, vb = t & 3, b = chain >> 5, h = (chain >> 1) & 15, d = chain & 1, cb = b * 4; constexpr int NC = 4;
        f32x4 S[4];
#pragma unroll
        for (int T = 0; T < 4; ++T) S[T] = (f32x4){0.f, 0.f, 0.f, 0.f};
        bf16x8 Apf[4][8]; u32x2 Npf[4][4];
#define CB_QI(step) ((((size_t)(cb + (d ? NC - 1 - (step) : (step)))) * 16 + h) * 2 + d)
#define CB_LOAD(u, step) do { const size_t q_ = CB_QI(step); const bf16* ps_ = PST + q_ * 4096 + lane * 8; const bf16* nc_ = NCT + q_ * 4096 + ((vb * 4 * 64 + lane) << 2); \
        _Pragma("unroll") for (int mt_ = 0; mt_ < 4; ++mt_) { Apf[u][2 * mt_] = *(const bf16x8*)(ps_ + mt_ * 1024); Apf[u][2 * mt_ + 1] = *(const bf16x8*)(ps_ + mt_ * 1024 + 512); Npf[u][mt_] = *(const u32x2*)(nc_ + mt_ * 256); } } while (0)
        CB_LOAD(0, 0); CB_LOAD(1, 1); CB_LOAD(2, 2); CB_LOAD(3, 3);
#pragma unroll
        for (int u = 0; u < 4; ++u) {
            const int step = u; const size_t q = CB_QI(step); bf16* scg = SC + q * 4096;
            asm volatile("" ::: "memory");
#pragma unroll
            for (int T = 0; T < 4; ++T) { const u32x2 w = pk4(S[T]); *(LAS u32x2*)(Sl + fr * LD16 + 16 * T + 4 * fq) = w; *(u32x2*)(scg + fm_off(16 * vb, 16 * T, fr, fq)) = w; }
            asm volatile("s_waitcnt lgkmcnt(0)" ::: "memory");
            const bf16x8 b0 = *(const LAS bf16x8*)(Sl + fr * LD16 + 8 * fq), b1 = *(const LAS bf16x8*)(Sl + fr * LD16 + 8 * fq + 32);
#pragma unroll
            for (int mt = 0; mt < 4; ++mt) { const u32x2 nw = Npf[u][mt];
                f32x4 acc = (f32x4){__uint_as_float(nw.x << 16), __uint_as_float(nw.x & 0xffff0000u), __uint_as_float(nw.y << 16), __uint_as_float(nw.y & 0xffff0000u)};
                acc = __builtin_amdgcn_mfma_f32_16x16x32_bf16(Apf[u][2 * mt], b0, acc, 0, 0, 0);
                acc = __builtin_amdgcn_mfma_f32_16x16x32_bf16(Apf[u][2 * mt + 1], b1, acc, 0, 0, 0);
                S[mt] = acc; }
            asm volatile("s_waitcnt lgkmcnt(0)" ::: "memory");
        }
#undef CB_LOAD
#undef CB_QI
        { float* dst = F.out + (size_t)M * D + ((((size_t)b * NL + l) * 2 + d) * NH + h) * 4096 + (size_t)(16 * vb + fr) * 64 + 4 * fq;
#pragma unroll
          for (int T = 0; T < 4; ++T) *(f32x4*)(dst + 16 * T) = S[T]; }
    }
}

__device__ __forceinline__ void p_chunkC(Frame& F, int l) {
    PH_LOCALS(F); PH_LAYER(l);
    LAS unsigned char* lds = F.lds;
    const int fr = lane & 15, fq = lane >> 4, d = wave >> 2, nb = wave & 3;
    const bf16* PS = (const bf16*)(F.ws + WS_PS); const bf16* GATE = (const bf16*)(F.ws + WS_GATE); const float* BONUS = (const float*)(F.ws + WS_BONUS);
    bf16* O = (bf16*)(F.ws + WS_O);
    constexpr int NIT = (M / 64) * NH;
    f32x4 gnw[4], gnb[4]; int hcur = -1;
    bf16x8 fa0[4][4], fb0[4]; u32x4 pv0, pg0; float pb00, pb01;
#define CC_ISSUE(item_, fa, fb, pv, pg, pb0, pb1) do { const int ci_ = (item_) >> 4, h_ = (item_) & 15; const size_t qi_ = ((size_t)ci_ * 16 + h_) * 2 + d; \
        const bf16* sc_ = (const bf16*)(F.ws + WS_SC) + qi_ * 4096 + lane * 8; const bf16* vt_ = (const bf16*)(F.ws + WS_VTG) + qi_ * 4096 + lane * 8; \
        const bf16* py_ = (const bf16*)(F.ws + WS_PYT) + qi_ * 4096 + nb * 1024 + lane * 8; const bf16* qy_ = (const bf16*)(F.ws + WS_QYT) + qi_ * 4096 + nb * 1024 + lane * 8; \
        fb[0] = *(const bf16x8*)py_; fb[1] = *(const bf16x8*)(py_ + 512); fb[2] = *(const bf16x8*)qy_; fb[3] = *(const bf16x8*)(qy_ + 512); \
        _Pragma("unroll") for (int vt4_ = 0; vt4_ < 4; ++vt4_) { fa[vt4_][0] = *(const bf16x8*)(sc_ + vt4_ * 1024); fa[vt4_][1] = *(const bf16x8*)(sc_ + vt4_ * 1024 + 512); fa[vt4_][2] = *(const bf16x8*)(vt_ + vt4_ * 1024); fa[vt4_][3] = *(const bf16x8*)(vt_ + vt4_ * 1024 + 512); } \
        const int row_ = ci_ * 64 + (tid >> 3), chn_ = 64 * h_ + (tid & 7) * 8; \
        pv = *(const u32x4*)(PS + (size_t)row_ * CSH + 2 * DA + chn_); pg = *(const u32x4*)(GATE + (size_t)row_ * DA + chn_); pb0 = BONUS[(size_t)row_ * NH + h_]; pb1 = BONUS[((size_t)M + row_) * NH + h_]; } while (0)
#define CC_BODY(item_, fa, fb, pv, pg, pb0, pb1, next_) do { const int ci = (item_) >> 4, h = (item_) & 15, R0 = ci * 64; \
        if (h != hcur) { hcur = h; _Pragma("unroll") for (int vtile = 0; vtile < 4; ++vtile) { gnw[vtile] = *(const f32x4*)(F.in[I_GNW] + (size_t)l * DA + 64 * h + 16 * vtile + 4 * fq); gnb[vtile] = *(const f32x4*)(F.in[I_GNB] + (size_t)l * DA + 64 * h + 16 * vtile + 4 * fq); } } \
        f32x4 acc[4]; float s = 0.f; \
        _Pragma("unroll") for (int vtile = 0; vtile < 4; ++vtile) { f32x4 a = F4Z; \
            _Pragma("unroll") for (int ks = 0; ks < 4; ++ks) a = __builtin_amdgcn_mfma_f32_16x16x32_bf16(fa[vtile][ks], fb[ks], a, 0, 0, 0); \
            acc[vtile] = a; s += (a[0] + a[1]) + (a[2] + a[3]); } \
        const u32x4 cv = pv, cgt = pg; const float bon = pb0 + pb1; \
        if ((next_) < NIT) CC_ISSUE((next_), fa, fb, pv, pg, pb0, pb1); \
        s += SHX(s, 16); s += SHX(s, 32); \
        const float mean = s * (1.0f / 64.0f); float qv = 0.f; \
        _Pragma("unroll") for (int vtile = 0; vtile < 4; ++vtile) { acc[vtile] = acc[vtile] - mean; const f32x4 a = acc[vtile]; qv += (a[0] * a[0] + a[1] * a[1]) + (a[2] * a[2] + a[3] * a[3]); } \
        qv += SHX(qv, 16); qv += SHX(qv, 32); \
        const float rstd = 1.0f / sqrtf(qv * (1.0f / 64.0f) + GN_EPS); \
        const int tau = 16 * nb + fr, pos = d ? 63 - tau : tau; \
        LAS float* Yd = (LAS float*)(lds + d * 17408); \
        _Pragma("unroll") for (int vtile = 0; vtile < 4; ++vtile) { const int v0 = 16 * vtile + 4 * fq; \
            *(LAS f32x4*)(Yd + pos * LD32 + v0) = acc[vtile] * rstd * gnw[vtile] + gnb[vtile]; } \
        LBAR(); \
        { const int pos2 = tid >> 3, c8 = (tid & 7) * 8, row = R0 + pos2, chn = 64 * h + c8; \
          const LAS float* Y0 = (const LAS float*)lds; const LAS float* Y1 = (const LAS float*)(lds + 17408); \
          float v[8], gt[8], o[8]; unpack8(cv, v); unpack8(cgt, gt); \
          const f32x4 y00 = *(const LAS f32x4*)(Y0 + pos2 * LD32 + c8), y01 = *(const LAS f32x4*)(Y0 + pos2 * LD32 + c8 + 4), y10 = *(const LAS f32x4*)(Y1 + pos2 * LD32 + c8), y11 = *(const LAS f32x4*)(Y1 + pos2 * LD32 + c8 + 4); \
          _Pragma("unroll") for (int j = 0; j < 4; ++j) { o[j] = (y00[j] + y10[j] + bon * v[j]) * gt[j]; o[4 + j] = (y01[j] + y11[j] + bon * v[4 + j]) * gt[4 + j]; } \
          *(u32x4*)(O + (size_t)row * D + chn) = pack8(o); } \
        LBAR(); } while (0)
    if (bx < NIT) CC_ISSUE(bx, fa0, fb0, pv0, pg0, pb00, pb01);
    for (int item = bx; item < NIT; item += G) {
        CC_BODY(item, fa0, fb0, pv0, pg0, pb00, pb01, item + G);
    }
#undef CC_BODY
#undef CC_ISSUE
}

__device__ __forceinline__ void p_final(Frame& F) {
    PH_LOCALS(F);
    const int gw = bx * NWAVES + wave, NGW = G * NWAVES;
    const float* fg = F.in[I_FNG];
    f32x4 fgv[8];
#pragma unroll
    for (int j = 0; j < 8; ++j) fgv[j] = *(const f32x4*)(fg + 4 * lane + 256 * j);
    for (int row = gw; row < M; row += NGW) {
        float* xr = F.out + (size_t)row * D;
        f32x4 v[8]; float ss = 0.f;
#pragma unroll
        for (int j = 0; j < 8; ++j) { v[j] = *(const f32x4*)(xr + 4 * lane + 256 * j); ss += (v[j].x * v[j].x + v[j].y * v[j].y) + (v[j].z * v[j].z + v[j].w * v[j].w); }
        WAVE_SUM(ss); const float rstd = 1.0f / sqrtf(ss * (1.0f / D) + RMS_EPS);
#pragma unroll
        for (int j = 0; j < 8; ++j) { const int c = 4 * lane + 256 * j; *(f32x4*)(xr + c) = v[j] * rstd * fgv[j]; }
    }
}

constexpr int PH_PER_LAYER = 10, N_PHASES = 2 + NL * PH_PER_LAYER;
__global__ void __launch_bounds__(NWAVES * 64, 2) hymba_fwd(Args args) {
    extern __shared__ __attribute__((aligned(16))) unsigned char lds[];
    Frame F;
    F.lds = (LAS unsigned char*)lds;
    F.tid = threadIdx.x; F.lane = F.tid & 63; F.wave = __builtin_amdgcn_readfirstlane(F.tid >> 6);
    F.G = gridDim.x; F.bx = blockIdx.x;
    F.in = args.in; F.out = args.out; F.ws = args.ws;
    for (int u = F.tid; u < (LDS_BYTES - LDSCTL_OFF) / 4; u += NWAVES * 64) ((LAS unsigned*)(F.lds + LDSCTL_OFF))[u] = 0u;
    __syncthreads();
    volatile LAS unsigned* MISC = (volatile LAS unsigned*)(F.lds + MISC_OFF);
    unsigned* barw = (unsigned*)(F.ws + WS_CTL) + CW_BAR;
    XcdBarrier bar; bar.bar = barw; bar.x = 0; bar.st = nullptr;
    if (MK_N_LAUNCHES == 1) bar = xcd_barrier_post(barw, MISC + 8);
    const int lo = args.ph_lo, hi = args.ph_hi;
#define IN(k) (lo <= (k) && (k) < hi)
#define SEAM(k) do { if (MK_N_LAUNCHES == 1 && IN(k) && IN((k) + 1)) xcd_barrier(bar); } while (0)

    for (int rep = 0; rep < ((PROBE_DUP == 30) ? 2 : 1); ++rep)
    if (IN(0)) { p0_prologue(F); __syncthreads(); } SEAM(0);
    bf16* H = (bf16*)(F.ws + WS_H); bf16* O = (bf16*)(F.ws + WS_O); bf16* P = (bf16*)(F.ws + WS_P); bf16* HID = (bf16*)(F.ws + WS_HID);
    const float* mod = (const float*)(F.ws + WS_MOD);
    for (int l = 0; l < NL; ++l) {
        const int pb = 1 + l * PH_PER_LAYER;
        const float* xlo = l == 0 ? F.in[I_XP] : F.out; const float* xhi = l == 0 ? F.in[I_XS] : F.out + (size_t)MCTX * D;
        float* dummy = (float*)(F.ws + WS_P);
        for (int rep = 0; rep < ((PROBE_DUP == 7) ? 2 : 1); ++rep)
        if (IN(pb + 0)) { p_adaln(F, l, 0, xlo, xhi); } SEAM(pb + 0);
        for (int rep = 0; rep < ((PROBE_DUP == 1 || PROBE_DUP == 20) ? 2 : 1); ++rep)
        if (IN(pb + 1)) { pg8::Gemm g{H, (const bf16*)(F.ws + WS_WIN + l * SZ_WIN), M, PINP, D}; pg8::StaticOrder S; { int cb_ = F.bx, cg_ = F.G; asm volatile("" : "+s"(cb_), "+s"(cg_)); S.init(M, PINP, cg_, cb_, D); }
            EpiP E{P, PINP, CSH}; pg8::gemm_phase<EpiP, pg8::StaticOrder, true, true>(F.lds, g, S, E, F.wave); } SEAM(pb + 1);
        for (int rep = 0; rep < ((PROBE_DUP == 2) ? 2 : 1); ++rep)
        if (IN(pb + 2)) { p_shift(F, l); } SEAM(pb + 2);
        if (IN(pb + 3)) { for (int rep = 0; rep < ((PROBE_DUP == 3) ? 2 : 1); ++rep) p_chunkA(F, l); } SEAM(pb + 3);
        for (int rep = 0; rep < ((PROBE_DUP == 4) ? 2 : 1); ++rep)
        if (IN(pb + 4)) { p_chunkB(F, l);
            for (int rep = 0; rep < ((PROBE_DUP == 13) ? 2 : 1); ++rep) p_gmlp(F, l, F.G > 64 ? (F.bx >= 64 ? F.bx - 64 : -1) : F.bx, F.G > 64 ? F.G - 64 : F.G); } SEAM(pb + 4);
        for (int rep = 0; rep < ((PROBE_DUP == 5) ? 2 : 1); ++rep)
        if (IN(pb + 5)) { p_chunkC(F, l); } SEAM(pb + 5);
        if ((PROBE_DUP == 6 || PROBE_DUP == 20) && IN(pb + 6)) { pg8::Gemm g{O, (const bf16*)(F.ws + WS_WOUT + l * SZ_WOUT), M, D, D}; pg8::StaticOrder S; { int cb_ = F.bx, cg_ = F.G; asm volatile("" : "+s"(cb_), "+s"(cg_)); S.init(M, D, cg_, cb_, D); }
            EpiRes E{xlo, xhi, dummy, mod + (size_t)l * 5 * MODW, 2 * D}; pg8::gemm_phase<EpiRes, pg8::StaticOrder, true, true>(F.lds, g, S, E, F.wave); }
        if (IN(pb + 6)) { pg8::Gemm g{O, (const bf16*)(F.ws + WS_WOUT + l * SZ_WOUT), M, D, D}; pg8::FullRoundsOrder S; pg8::TailHalfOrder S2; { int cb_ = F.bx, cg_ = F.G; asm volatile("" : "+s"(cb_), "+s"(cg_)); S.init(M, D, cg_, cb_, D); S2.init(M, D, cg_, cb_, D); }
            EpiRes E{xlo, xhi, F.out, mod + (size_t)l * 5 * MODW, 2 * D}; pg8::gemm_phase<EpiRes, pg8::FullRoundsOrder, true, true>(F.lds, g, S, E, F.wave);
            pg8::gemm_phase<EpiRes, pg8::TailHalfOrder, true, true, true>(F.lds, g, S2, E, F.wave); } SEAM(pb + 6);
        for (int rep = 0; rep < ((PROBE_DUP == 7) ? 2 : 1); ++rep)
        if (IN(pb + 7)) { p_adaln(F, l, 1, F.out, F.out + (size_t)MCTX * D); } SEAM(pb + 7);
        for (int rep = 0; rep < ((PROBE_DUP == 8 || PROBE_DUP == 20) ? 2 : 1); ++rep)
        if (IN(pb + 8)) { pg8::Gemm g{H, (const bf16*)(F.ws + WS_WGU + l * SZ_WGU), M, NGU, D}; pg8::StaticOrder S; { int cb_ = F.bx, cg_ = F.G; asm volatile("" : "+s"(cb_), "+s"(cg_)); S.init(M, NGU, cg_, cb_, D); }
            EpiSwi E{HID, DFF}; pg8::gemm_phase<EpiSwi, pg8::StaticOrder, true, true>(F.lds, g, S, E, F.wave); } SEAM(pb + 8);
        if ((PROBE_DUP == 9 || PROBE_DUP == 20) && IN(pb + 9)) { pg8::Gemm g{HID, (const bf16*)(F.ws + WS_WD + l * SZ_WD), M, D, DFF}; pg8::StaticOrder S; { int cb_ = F.bx, cg_ = F.G; asm volatile("" : "+s"(cb_), "+s"(cg_)); S.init(M, D, cg_, cb_, DFF); }
            EpiRes E{F.out, F.out + (size_t)MCTX * D, dummy, mod + (size_t)l * 5 * MODW, 5 * D}; pg8::gemm_phase<EpiRes, pg8::StaticOrder, true, true>(F.lds, g, S, E, F.wave); }
        if (IN(pb + 9)) { pg8::Gemm g{HID, (const bf16*)(F.ws + WS_WD + l * SZ_WD), M, D, DFF}; pg8::FullRoundsOrder S; pg8::TailHalfOrder S2; { int cb_ = F.bx, cg_ = F.G; asm volatile("" : "+s"(cb_), "+s"(cg_)); S.init(M, D, cg_, cb_, DFF); S2.init(M, D, cg_, cb_, DFF); }
            EpiRes E{F.out, F.out + (size_t)MCTX * D, F.out, mod + (size_t)l * 5 * MODW, 5 * D}; pg8::gemm_phase<EpiRes, pg8::FullRoundsOrder, true, true>(F.lds, g, S, E, F.wave);
            pg8::gemm_phase<EpiRes, pg8::TailHalfOrder, true, true, true>(F.lds, g, S2, E, F.wave); } SEAM(pb + 9);
    }
    if (IN(N_PHASES - 1)) { p_final(F); }
#undef IN
#undef SEAM
}

extern "C" void kernel_launch(void* const* d_in, const int* in_sizes, int n_in, void* d_out, int out_size, void* d_ws, size_t ws_size, hipStream_t stream) {
    static int grid = 0;
    if (grid == 0) {
        if (n_in != 30 || ws_size < WS_END) { fprintf(stderr, "kernel_launch: need 30 inputs and >= %zu bytes of workspace; got n_in %d, ws %zu\n", (size_t)WS_END, n_in, ws_size); grid = -1; return; }
        int dev = 0, cus = 0, per_cu = 0;
        if (hipGetDevice(&dev) != hipSuccess || hipDeviceGetAttribute(&cus, hipDeviceAttributeMultiprocessorCount, dev) != hipSuccess) { grid = -1; return; }
        if (hipFuncSetAttribute((const void*)hymba_fwd, hipFuncAttributeMaxDynamicSharedMemorySize, LDS_BYTES) != hipSuccess) { fprintf(stderr, "kernel_launch: hipFuncSetAttribute failed\n"); grid = -1; return; }
        if (hipOccupancyMaxActiveBlocksPerMultiprocessor(&per_cu, (const void*)hymba_fwd, NWAVES * 64, LDS_BYTES) != hipSuccess || per_cu < 1)
            fprintf(stderr, "kernel_launch: note: occupancy query reports %d workgroups per CU\n", per_cu);
        (void)hipGetLastError();
        grid = cus;
    }
    if (grid < 0) return;
    if (hipMemsetAsync((char*)d_ws + WS_CTL, 0, CTL_ZERO_BYTES, stream) != hipSuccess) return;
    Args a{};
    for (int i = 0; i < 30; ++i) a.in[i] = (const float*)d_in[i];
    a.out = (float*)d_out; a.ws = (unsigned char*)d_ws; a.pad = 0;
    if (MK_N_LAUNCHES == 1) {
        a.ph_lo = 0; a.ph_hi = N_PHASES; a.li = 0;
        hipLaunchKernelGGL(hymba_fwd, dim3(grid), dim3(NWAVES * 64), LDS_BYTES, stream, a);
    } else {
        for (int k = 0; k < N_PHASES; ++k) { a.ph_lo = k; a.ph_hi = k + 1; a.li = k;
            hipLaunchKernelGGL(hymba_fwd, dim3(grid), dim3(NWAVES * 64), LDS_BYTES, stream, a); }
    }
}
```

```cpp
#include <hip/hip_runtime.h>
#include <cstdio>
#include <cstdint>

#ifndef PROBE_DUP
#define PROBE_DUP -1
#endif
#ifndef PROBE_SUB
#define PROBE_SUB 0
#endif
#ifndef MK_N_LAUNCHES
#define MK_N_LAUNCHES 1
#endif

namespace pg8 {
#define PG8_LAS __attribute__((address_space(3)))
typedef unsigned short bf16_t;
typedef short bf16x8 __attribute__((ext_vector_type(8)));
typedef float f32x4 __attribute__((ext_vector_type(4)));
typedef unsigned u32x4 __attribute__((ext_vector_type(4)));
constexpr int BM = 256, BK = 64, HALF = 128, HTB = HALF * BK * 2  , STAGE_BYTES = 8 * HTB, NXCD = 8, WGM = 8;

__host__ __device__ __forceinline__ int lds_byte(int r, int c) { const int st = (r >> 4) * 2 + (c >> 5), rr = r & 15, cc = c & 31, ob = rr * 64 + cc * 2; return st * 1024 + (ob ^ (((ob >> 9) & 1) << 5)); }
__host__ __device__ __forceinline__ void stage_rc(int b, int& R, int& C) { const int st = b / 1024, sb = b % 1024, swz = sb ^ (((sb >> 9) & 1) << 5); R = (st >> 1) * 16 + swz / 64; C = (st & 1) * 32 + (swz % 64) / 2; }
__host__ __device__ __forceinline__ int perm32(int rho) { const int n = rho >> 4, i = rho & 15; return 8 * (i >> 2) + 4 * n + (i & 3); }

struct Unit { int pm, pn, k0, nk, bh; };
struct Gemm { const bf16_t* A; const bf16_t* Bt; int M, N, K; };

struct StaticOrder {
    int nM, nN, nwg, G, c, nkt, full, rem;
    __host__ __device__ void init(int M, int N, int G_, int c_, int K_) { nM = M / BM; nN = N / BM; nwg = nM * nN; G = G_; c = c_; nkt = K_ / BK; full = nwg / G; rem = nwg - full * G; }
    __host__ __device__ bool next(int i, Unit& u) const {
        const long L = (long)i * G + c; if (L >= nwg) return false;
        int wgid = (int)L; { const int q = nwg / NXCD, r = nwg % NXCD, xcd = wgid % NXCD, off = wgid / NXCD; wgid = (xcd < r ? xcd * (q + 1) : r * (q + 1) + (xcd - r) * q) + off; }
        const int nig = WGM * nN, gid = wgid / nig, fm = gid * WGM, gsz = (nM - fm) < WGM ? (nM - fm) : WGM;
        u.pm = fm + ((wgid % nig) % gsz); u.pn = (wgid % nig) / gsz; u.k0 = 0; u.nk = nkt; u.bh = -1;
#if defined(__HIP_DEVICE_COMPILE__)
        u.pm = __builtin_amdgcn_readfirstlane(u.pm); u.pn = __builtin_amdgcn_readfirstlane(u.pn);
#endif
        return true;
    }
    __device__ __forceinline__ void a_ready(const Unit&) const {}
    __device__ __forceinline__ void done(const Unit&) const {}
};
struct FullRoundsOrder : StaticOrder {
    __host__ __device__ bool split() const { return rem > 0 && 2 * rem <= G; }
    __host__ __device__ bool next(int i, Unit& u) const { if (split() && i >= full) return false; return StaticOrder::next(i, u); }
};
struct TailHalfOrder : StaticOrder {
    __host__ __device__ bool next(int i, Unit& u) const {
        if (!(rem > 0 && 2 * rem <= G) || i > 0 || c >= 2 * rem) return false;
        StaticOrder t = *this; t.c = c >> 1; if (!t.StaticOrder::next(full, u)) return false;
        u.bh = c & 1; return true;
    }
};

__device__ __forceinline__ unsigned cvt_pk_bf16(float lo, float hi) { unsigned r; asm volatile("v_cvt_pk_bf16_f32 %0, %1, %2" : "=v"(r) : "v"(lo), "v"(hi)); return r; }

template <class Epi, class Sched, bool ALIGN_EPI = false, bool SP2 = false, bool HALFB = false>
__device__ __forceinline__ void gemm_phase(PG8_LAS unsigned char* lds, const Gemm g, const Sched& S, const Epi& E, int wid) {
    asm volatile("" : "+s"(wid)); int lane; asm volatile("v_mbcnt_lo_u32_b32 %0, -1, 0\n\tv_mbcnt_hi_u32_b32 %0, -1, %0" : "=v"(lane));
    const int tid = wid * 64 + lane, wr = wid >> 2, wc = wid & 3, fr = lane & 15, fq = lane >> 4;
    const int K = g.K;
    unsigned voffA[2], voffB[2];
#pragma unroll
    for (int i = 0; i < 2; ++i) { int R, C; stage_rc(tid * 16 + i * 8192, R, C); const int Rb = Epi::PERM ? ((R & ~31) + perm32(R & 31)) : R;
        voffA[i] = (unsigned)(R * K + C) * 2u; voffB[i] = (unsigned)(Rb * K + C) * 2u; }
    const size_t kstep = (size_t)(BK * 2);
    const size_t hstep = (size_t)HALF * K * 2;
    const size_t tstep = 2 * hstep;
    const size_t bhs = HALFB ? 0 : hstep;
    const unsigned ldsw = (unsigned)wid * 1024u;
    const int aoff = lds_byte(wr * 64 + fr, fq * 8), boff = lds_byte(wc * 32 + fr, fq * 8);
#define PG8_SA(b, h) (((b) * 2 + (h)) * HTB)
#define PG8_SB(b, h) ((4 + (b) * 2 + (h)) * HTB)
#define PG8_STAGE(bufoff, gbase, voff) do { _Pragma("unroll") for (int _i = 0; _i < 2; ++_i) \
        __builtin_amdgcn_global_load_lds((const unsigned*)((const char*)(gbase) + (voff)[_i]), (PG8_LAS unsigned*)(lds + (bufoff) + ldsw + _i * 8192), 16, 0, 0); } while (0)
#define PG8_LDA(dst, b, h) do { _Pragma("unroll") for (int m = 0; m < 4; ++m) _Pragma("unroll") for (int k = 0; k < 2; ++k) dst[m][k] = *(const PG8_LAS bf16x8*)(lds + PG8_SA(b, h) + aoff + m * 2048 + k * 1024); } while (0)
#define PG8_LDB(dst, b, h) do { _Pragma("unroll") for (int n = 0; n < 2; ++n) _Pragma("unroll") for (int k = 0; k < 2; ++k) dst[n][k] = *(const PG8_LAS bf16x8*)(lds + PG8_SB(b, h) + boff + n * 2048 + k * 1024); } while (0)
#define PG8_MMA(ai, bj, At, Bt) do { __builtin_amdgcn_s_setprio(1); _Pragma("unroll") for (int m = 0; m < 4; ++m) _Pragma("unroll") for (int n = 0; n < 2; ++n) _Pragma("unroll") for (int k = 0; k < 2; ++k) \
        acc[ai][bj][m][n] = __builtin_amdgcn_mfma_f32_16x16x32_bf16(Bt[n][k], At[m][k], acc[ai][bj][m][n], 0, 0, 0); __builtin_amdgcn_s_setprio(0); } while (0)
#define PG8_WAIT_V(n) asm volatile("s_waitcnt vmcnt(" #n ")" ::: "memory")
#define PG8_WAIT_L(n) asm volatile("s_waitcnt lgkmcnt(" #n ")" ::: "memory")
#define PG8_BAR __builtin_amdgcn_s_barrier()
#define PG8_SCHED __builtin_amdgcn_sched_barrier(0)
    Unit cur, nxt; int ui = 0;
    if (!S.next(0, cur)) return;
    f32x4 acc[2][2][4][2];
#pragma unroll
    for (int a = 0; a < 2; ++a)
#pragma unroll
        for (int b = 0; b < 2; ++b)
#pragma unroll
            for (int m = 0; m < 4; ++m)
#pragma unroll
                for (int n = 0; n < 2; ++n) acc[a][b][m][n] = (f32x4){0.f, 0.f, 0.f, 0.f};
    bf16x8 At[4][2], B0[2][2], B1[2][2];
    const char* cA = (const char*)g.A + (size_t)cur.pm * tstep + (size_t)cur.k0 * kstep; const char* cB = (const char*)g.Bt + (size_t)cur.pn * tstep + (size_t)cur.k0 * kstep + (HALFB ? (size_t)cur.bh * hstep : 0);
    S.a_ready(cur);
    if constexpr (SP2) {
        PG8_STAGE(PG8_SB(0, 0), cB, voffB); PG8_STAGE(PG8_SB(0, 1), cB + bhs, voffB); PG8_STAGE(PG8_SA(0, 0), cA, voffA); PG8_STAGE(PG8_SA(0, 1), cA + hstep, voffA);
        if (wr == 1) PG8_BAR;
        PG8_WAIT_V(2); PG8_BAR;
        PG8_STAGE(PG8_SB(1, 0), cB + kstep, voffB); PG8_STAGE(PG8_SA(1, 0), cA + kstep, voffA); PG8_STAGE(PG8_SB(1, 1), cB + bhs + kstep, voffB);
        PG8_WAIT_V(6); PG8_BAR;
    } else {
        PG8_STAGE(PG8_SB(0, 0), cB, voffB); PG8_STAGE(PG8_SA(0, 0), cA, voffA); PG8_STAGE(PG8_SB(0, 1), cB + bhs, voffB); PG8_STAGE(PG8_SA(0, 1), cA + hstep, voffA);
        if (wr == 1) PG8_BAR;
        PG8_WAIT_V(4); PG8_BAR;
        PG8_STAGE(PG8_SB(1, 0), cB + kstep, voffB); PG8_STAGE(PG8_SA(1, 0), cA + kstep, voffA); PG8_STAGE(PG8_SB(1, 1), cB + bhs + kstep, voffB);
        PG8_WAIT_V(6); PG8_BAR;
    }
    for (;;) {
        const bool has_next = S.next(ui + 1, nxt);
        const char* nA = has_next ? (const char*)g.A + (size_t)nxt.pm * tstep + (size_t)nxt.k0 * kstep : cA; const char* nB = has_next ? (const char*)g.Bt + (size_t)nxt.pn * tstep + (size_t)nxt.k0 * kstep + (HALFB ? (size_t)nxt.bh * hstep : 0) : cB;
        const int nt = cur.nk;
        for (int t = 0; t < nt; t += 2) {
            const bool last = (t == nt - 2);
            const char* a1 = cA + (size_t)(t + 1) * kstep;
            const char* a2 = last ? nA : cA + (size_t)(t + 2) * kstep; const char* b2 = last ? nB : cB + (size_t)(t + 2) * kstep;
            const char* a3 = a2 + kstep; const char* b3 = b2 + kstep;
            if (last && has_next) S.a_ready(nxt);
            if constexpr (SP2) {
            PG8_LDB(B0, 0, 0); if constexpr (!HALFB) PG8_LDB(B1, 0, 1); PG8_SCHED; PG8_LDA(At, 0, 0); PG8_STAGE(PG8_SA(1, 1), a1 + hstep, voffA);
            PG8_WAIT_V(8); PG8_WAIT_L(0); PG8_BAR; PG8_MMA(0, 0, At, B0); if constexpr (!HALFB) PG8_MMA(0, 1, At, B1); PG8_BAR; PG8_SCHED;
            PG8_LDA(At, 0, 1); PG8_STAGE(PG8_SB(0, 0), b2, voffB); PG8_STAGE(PG8_SB(0, 1), b2 + bhs, voffB); PG8_STAGE(PG8_SA(0, 0), a2, voffA);
            PG8_WAIT_V(8); PG8_WAIT_L(0); PG8_BAR; PG8_MMA(1, 0, At, B0); if constexpr (!HALFB) PG8_MMA(1, 1, At, B1); PG8_BAR; PG8_SCHED;
            PG8_LDB(B0, 1, 0); if constexpr (!HALFB) PG8_LDB(B1, 1, 1); PG8_SCHED; PG8_LDA(At, 1, 0); PG8_STAGE(PG8_SA(0, 1), a2 + hstep, voffA);
            PG8_WAIT_V(8); PG8_WAIT_L(0); PG8_BAR; PG8_MMA(0, 0, At, B0); if constexpr (!HALFB) PG8_MMA(0, 1, At, B1); PG8_BAR; PG8_SCHED;
            PG8_LDA(At, 1, 1); PG8_STAGE(PG8_SB(1, 0), b3, voffB); PG8_STAGE(PG8_SB(1, 1), b3 + bhs, voffB); PG8_STAGE(PG8_SA(1, 0), a3, voffA);
            PG8_WAIT_V(8); PG8_WAIT_L(0); PG8_BAR; PG8_MMA(1, 0, At, B0); if constexpr (!HALFB) PG8_MMA(1, 1, At, B1); PG8_BAR; PG8_SCHED;
            } else {
            PG8_LDB(B0, 0, 0); PG8_SCHED; PG8_LDA(At, 0, 0); PG8_STAGE(PG8_SA(1, 1), a1 + hstep, voffA);
            PG8_WAIT_L(8); PG8_BAR; PG8_WAIT_L(0); PG8_MMA(0, 0, At, B0); PG8_BAR; PG8_SCHED;
            PG8_LDB(B1, 0, 1); PG8_STAGE(PG8_SB(0, 0), b2, voffB);
            PG8_BAR; PG8_WAIT_L(0); PG8_MMA(0, 1, At, B1); PG8_BAR;
            PG8_LDA(At, 0, 1); PG8_STAGE(PG8_SA(0, 0), a2, voffA);
            PG8_BAR; PG8_WAIT_L(0); PG8_MMA(1, 0, At, B0); PG8_BAR; PG8_SCHED;
            PG8_STAGE(PG8_SB(0, 1), b2 + bhs, voffB);
            PG8_WAIT_V(6); PG8_BAR; PG8_MMA(1, 1, At, B1); PG8_BAR;
            PG8_LDB(B0, 1, 0); PG8_SCHED; PG8_LDA(At, 1, 0); PG8_STAGE(PG8_SA(0, 1), a2 + hstep, voffA);
            PG8_WAIT_L(8); PG8_BAR; PG8_WAIT_L(0); PG8_MMA(0, 0, At, B0); PG8_BAR; PG8_SCHED;
            PG8_LDB(B1, 1, 1); PG8_STAGE(PG8_SB(1, 0), b3, voffB);
            PG8_BAR; PG8_WAIT_L(0); PG8_MMA(0, 1, At, B1); PG8_BAR;
            PG8_LDA(At, 1, 1); PG8_STAGE(PG8_SA(1, 0), a3, voffA);
            PG8_BAR; PG8_WAIT_L(0); PG8_MMA(1, 0, At, B0); PG8_BAR; PG8_SCHED;
            PG8_STAGE(PG8_SB(1, 1), b3 + bhs, voffB);
            PG8_WAIT_V(6); PG8_BAR; PG8_MMA(1, 1, At, B1); PG8_BAR;
            }
        }
        if constexpr (ALIGN_EPI) { if (wr == 0) PG8_BAR; }
        E(acc, cur, wr, wc, fr, fq); S.done(cur);
        if (!has_next) break;
#pragma unroll
        for (int a = 0; a < 2; ++a)
#pragma unroll
            for (int b = 0; b < 2; ++b)
#pragma unroll
                for (int m = 0; m < 4; ++m)
#pragma unroll
                    for (int n = 0; n < 2; ++n) acc[a][b][m][n] = (f32x4){0.f, 0.f, 0.f, 0.f};
        cur = nxt; cA = nA; cB = nB; ++ui;
        if constexpr (ALIGN_EPI) { if (wr == 1) PG8_BAR; }
    }
    PG8_WAIT_V(0);
    if constexpr (!ALIGN_EPI) { if (wr == 0) PG8_BAR; }
    PG8_BAR;
#undef PG8_SA
#undef PG8_SB
#undef PG8_STAGE
#undef PG8_LDA
#undef PG8_LDB
#undef PG8_MMA
#undef PG8_WAIT_V
#undef PG8_WAIT_L
#undef PG8_BAR
#undef PG8_SCHED
}
}

constexpr int NWAVES = 8;
constexpr int D = 2048, MCTX = 4096, MLAT = 16384, M = MCTX + MLAT, NL = 4;
constexpr int DA = 1024, NH = 16, DB = 1024, NG = 8, HB = 128;
constexpr int LW = 64, LAA = 64, LGT = 160;
constexpr int CSH = 3 * DA + LW + LAA + LGT;
constexpr int PIN = CSH + 2 * DB;
constexpr int PINP = 5632;
constexpr int DFF = 5632, NGU = 2 * DFF;
constexpr int MODW = 6 * D;
constexpr float RMS_EPS = 1e-6f, GN_EPS = 64.0f * 1e-5f, LN_EPS = 1e-5f;

constexpr size_t MiB = 1u << 20;
constexpr size_t WS_CTL = 0, CTL_ZERO_BYTES = 1 * MiB;
constexpr size_t WS_MOD = 1 * MiB;
constexpr size_t WS_W2T = 2 * MiB;
constexpr size_t WS_A2T = 3 * MiB;
constexpr size_t WS_G2T = 4 * MiB;
constexpr size_t WS_WSP = 6 * MiB;
constexpr size_t WS_BONUS = 7 * MiB;
constexpr size_t SZ_WIN = (size_t)PINP * D * 2, SZ_WOUT = (size_t)D * D * 2, SZ_WGU = (size_t)NGU * D * 2, SZ_WD = (size_t)D * DFF * 2;
constexpr size_t WS_WIN = 16 * MiB;
constexpr size_t WS_WOUT = WS_WIN + NL * SZ_WIN;
constexpr size_t WS_WGU = WS_WOUT + NL * SZ_WOUT;
constexpr size_t WS_WD = WS_WGU + NL * SZ_WGU;
constexpr size_t WS_H = WS_WD + NL * SZ_WD;
constexpr size_t WS_O = WS_H + (size_t)M * D * 2;
constexpr size_t WS_P = WS_O + (size_t)M * D * 2;
constexpr size_t WS_PS = WS_P + (size_t)M * PINP * 2;
constexpr size_t SZ_T16 = (size_t)M * DA * 2;
constexpr size_t WS_GATE = WS_PS + (size_t)M * CSH * 2;
constexpr size_t SZ_CH = (size_t)(M / 64) * NH * 2 * 8192;
constexpr size_t WS_PST = WS_GATE + SZ_T16;
constexpr size_t WS_NCT = WS_PST + SZ_CH;
constexpr size_t WS_PYT = WS_NCT + SZ_CH;
constexpr size_t WS_QYT = WS_PYT + SZ_CH;
constexpr size_t WS_VTG = WS_QYT + SZ_CH;
constexpr size_t WS_SC = WS_VTG + SZ_CH;
constexpr size_t WS_LORA = WS_SC + SZ_CH;
constexpr size_t WS_END1 = WS_LORA + (size_t)M * 288 * 2;
constexpr size_t WS_HID = WS_GATE;
constexpr size_t WS_END = WS_END1 > WS_HID + (size_t)M * DFF * 2 ? WS_END1 : WS_HID + (size_t)M * DFF * 2;
constexpr int CW_BAR = 4096;
constexpr int CW_SPLIT = 16384;
static_assert((CW_SPLIT + NL * 640 * 64) * 4 <= (int)CTL_ZERO_BYTES, "control words inside the memset region");

constexpr int RING_BYTES = 131072;
constexpr int LDSCTL_OFF = 15 * 9216, MISC_OFF = LDSCTL_OFF + 320;
constexpr int LDS_BYTES = 147456;

#define GAS __attribute__((address_space(1)))
#define LAS __attribute__((address_space(3)))
typedef unsigned short bf16;
typedef float f32x4 __attribute__((ext_vector_type(4)));
typedef float f32x2 __attribute__((ext_vector_type(2)));
typedef short bf16x8 __attribute__((ext_vector_type(8)));
typedef unsigned u32x4 __attribute__((ext_vector_type(4)));
typedef unsigned u32x2 __attribute__((ext_vector_type(2)));
#define LDS_WAIT() asm volatile("s_waitcnt lgkmcnt(0)" ::: "memory")
#define VM_WAIT() asm volatile("s_waitcnt vmcnt(0)" ::: "memory")
__device__ __forceinline__ unsigned f2bf(float f) { unsigned u = __builtin_bit_cast(unsigned, f); return (u + 0x7fffu + ((u >> 16) & 1u)) >> 16; }
typedef __bf16 bf16x2_t __attribute__((ext_vector_type(2)));
__device__ __forceinline__ unsigned pk2(float lo, float hi) { return __builtin_bit_cast(unsigned, __builtin_convertvector((f32x2){lo, hi}, bf16x2_t)); }
__device__ __forceinline__ float bf2f(unsigned short b) { return __uint_as_float(((unsigned)b) << 16); }
__device__ __forceinline__ void unpack8(const u32x4 q, float (&f)[8]) {
    f[0] = __uint_as_float(q.x << 16); f[1] = __uint_as_float(q.x & 0xffff0000u); f[2] = __uint_as_float(q.y << 16); f[3] = __uint_as_float(q.y & 0xffff0000u);
    f[4] = __uint_as_float(q.z << 16); f[5] = __uint_as_float(q.z & 0xffff0000u); f[6] = __uint_as_float(q.w << 16); f[7] = __uint_as_float(q.w & 0xffff0000u); }
__device__ __forceinline__ u32x4 pack8(const float (&f)[8]) { u32x4 o; o.x = pk2(f[0], f[1]); o.y = pk2(f[2], f[3]); o.z = pk2(f[4], f[5]); o.w = pk2(f[6], f[7]); return o; }
__device__ __forceinline__ float fsigmoid(float x) { return __builtin_amdgcn_rcpf(1.0f + __expf(-x)); }
__device__ __forceinline__ float ftanh(float x) { return 1.0f - 2.0f * __builtin_amdgcn_rcpf(1.0f + __expf(2.0f * x)); }
__device__ __forceinline__ float gelu_tanh(float x) { const float u = 1.5957691216057308f * (x + 0.044715f * x * x * x); return x * __builtin_amdgcn_rcpf(1.0f + __expf(-u)); }
__device__ __forceinline__ int hw_lane() { int l; asm volatile("v_mbcnt_lo_u32_b32 %0, -1, 0\n\tv_mbcnt_hi_u32_b32 %0, -1, %0" : "=v"(l)); return l; }
#define SHX(v, X) __int_as_float(__builtin_amdgcn_ds_bpermute((lane ^ (X)) << 2, __float_as_int(v)))
#define WAVE_SUM(v) do { v += SHX(v, 1); v += SHX(v, 2); v += SHX(v, 4); v += SHX(v, 8); v += SHX(v, 16); v += SHX(v, 32); } while (0)

#define PH_LOCALS(F) int wave = (F).wave; asm volatile("" : "+s"(wave)); const int lane = hw_lane(); const int tid = wave * 64 + lane; \
    int bx = (F).bx, G = (F).G; asm volatile("" : "+s"(bx), "+s"(G)); (void)lane; (void)tid;
#define PH_LAYER(l) asm volatile("" : "+s"(l))

#define XB_TMO      128
#define XB_XCNT(j)  (256  + 64 * (j))
#define XB_XSUB(j)  (1280 + 64 * (j))
#define XB_XGEN(j)  (2304 + 64 * (j))
#define XB_TOP      3328
#define XB_TOPGEN   3392
#define XCD_BAR_WORDS 3456
#define XB_SPIN_CAP (1u << 18)

__device__ __forceinline__ unsigned xb_ld(unsigned* p)              { return __hip_atomic_load(p, __ATOMIC_RELAXED, __HIP_MEMORY_SCOPE_AGENT); }
__device__ __forceinline__ unsigned xb_add(unsigned* p, unsigned v) { return __hip_atomic_fetch_add(p, v, __ATOMIC_RELAXED, __HIP_MEMORY_SCOPE_AGENT); }
__device__ __forceinline__ unsigned xb_xcc_id() { return (unsigned)__builtin_amdgcn_s_getreg((3 << 11) | 20) & 0xFu; }
#define XB_SPIN(cond, bar) do { unsigned _sp = 0; while (cond) { __builtin_amdgcn_s_sleep(1); \
    if ((++_sp & 255u) == 0u) { if (xb_ld(&(bar)[XB_TMO])) break; if (_sp > XB_SPIN_CAP) { atomicAdd(&(bar)[XB_TMO], 1u); break; } } } } while (0)

struct XcdBarrier {
    unsigned* bar; unsigned x;
    volatile LAS unsigned* st;
};
__device__ __forceinline__ XcdBarrier xcd_barrier_post(unsigned* bar, volatile LAS unsigned* st) {
    XcdBarrier b; b.bar = bar; b.x = xb_xcc_id(); b.st = st;
    if (threadIdx.x == 0) (void)xb_add(&bar[XB_XCNT(b.x)], 1u);
    return b;
}
__device__ __forceinline__ void xcd_barrier_complete(unsigned* bar, unsigned x, unsigned& nloc, unsigned& nx) {
    const unsigned G = gridDim.x * gridDim.y * gridDim.z;
    unsigned sum, cnt, mine, sp = 0u;
    for (;;) {
        sum = 0u; cnt = 0u; mine = 0u;
#pragma unroll
        for (unsigned j = 0; j < 16; ++j) { const unsigned c = xb_ld(&bar[XB_XCNT(j)]); sum += c; cnt += (c > 0u) ? 1u : 0u; mine = (j == x) ? c : mine; }
        if (sum == G) break;
        __builtin_amdgcn_s_sleep(1);
        if ((++sp & 255u) == 0u) { if (xb_ld(&bar[XB_TMO])) break; if (sp > XB_SPIN_CAP) { atomicAdd(&bar[XB_TMO], 1u); break; } }
    }
    nloc = mine > 0u ? mine : 1u; nx = cnt > 0u ? cnt : 1u;
}
__device__ __forceinline__ void xcd_barrier(const XcdBarrier& b) {
    asm volatile("s_waitcnt vmcnt(0)" ::: "memory");
    __syncthreads();
    if (threadIdx.x == 0) {
        unsigned* bar = b.bar;
        __builtin_amdgcn_s_waitcnt(0);
        unsigned nloc = b.st[0], nx = b.st[1];
        if (nloc == 0u) { xcd_barrier_complete(bar, b.x, nloc, nx); b.st[0] = nloc; b.st[1] = nx; }
        const unsigned old = xb_add(&bar[XB_XSUB(b.x)], 1u);
        const unsigned gen = old / nloc;
        if (old + 1u == (gen + 1u) * nloc) {
            __builtin_amdgcn_fence(__ATOMIC_RELEASE, "agent");
            asm volatile("s_waitcnt vmcnt(0)" ::: "memory");
            const unsigned og = xb_add(&bar[XB_TOP], 1u);
            const unsigned tg = og / nx;
            if (og + 1u == (tg + 1u) * nx) xb_add(&bar[XB_TOPGEN], 1u);
            else XB_SPIN(xb_ld(&bar[XB_TOPGEN]) == tg, bar);
            __builtin_amdgcn_fence(__ATOMIC_ACQUIRE, "agent");
            xb_add(&bar[XB_XGEN(b.x)], 1u);
            asm volatile("s_waitcnt vmcnt(0)" ::: "memory");
        } else {
            XB_SPIN(xb_ld(&bar[XB_XGEN(b.x)]) == gen, bar);
            __builtin_amdgcn_fence(__ATOMIC_ACQUIRE, "agent");
            asm volatile("s_waitcnt vmcnt(0)" ::: "memory");
        }
    }
    __syncthreads();
}

struct Args {
    const float* in[30];
    float* out; unsigned char* ws;
    int ph_lo, ph_hi, li, pad;
};
enum { I_XP = 0, I_XS, I_STATE, I_C, I_CCTX, I_WMOD, I_BMOD, I_N1G, I_WIN, I_MU, I_W0, I_W2, I_A0, I_A2, I_G2, I_KK, I_KA, I_RK, I_GNW, I_GNB, I_LNG, I_LNB, I_WSP, I_BSP, I_WOUT, I_N2G, I_WG, I_WU, I_WD, I_FNG };

struct Frame {
    LAS unsigned char* lds;
    int tid, lane, wave, G, bx;
    const float* const* in;
    float* out; unsigned char* ws;
};

struct EpiP {
    static constexpr bool PERM = true, AFTER_DRAIN = false;
    bf16* O; int ldc; int gelu_from;
    __device__ __forceinline__ void operator()(const f32x4 (&acc)[2][2][4][2], const pg8::Unit& u, int wr, int wc, int fr, int fq) const {
        const int row0 = u.pm * 256 + wr * 64 + fr, col0 = u.pn * 256 + wc * 32 + 8 * fq;
#pragma unroll
        for (int ai = 0; ai < 2; ++ai)
#pragma unroll
            for (int m = 0; m < 4; ++m) { bf16* rowp = O + (size_t)(row0 + ai * 128 + m * 16) * ldc + col0;
#pragma unroll
                for (int bj = 0; bj < 2; ++bj) { f32x4 v0 = acc[ai][bj][m][0], v1 = acc[ai][bj][m][1];
                    if (col0 + bj * 128 >= gelu_from) {
#pragma unroll
                        for (int j = 0; j < 4; ++j) { v0[j] = gelu_tanh(v0[j]); v1[j] = gelu_tanh(v1[j]); } }
                    u32x4 w; w.x = pg8::cvt_pk_bf16(v0[0], v0[1]); w.y = pg8::cvt_pk_bf16(v0[2], v0[3]); w.z = pg8::cvt_pk_bf16(v1[0], v1[1]); w.w = pg8::cvt_pk_bf16(v1[2], v1[3]);
                    *(u32x4*)(rowp + bj * 128) = w; } }
    }
};
struct EpiRes {
    static constexpr bool PERM = false, AFTER_DRAIN = false;
    const float* xlo; const float* xhi; float* xout; const float* modl; int goff;
    __device__ __forceinline__ void operator()(const f32x4 (&acc)[2][2][4][2], const pg8::Unit& u, int wr, int wc, int fr, int fq) const {
        const int pm = u.pm; const int midx = pm < 16 ? 0 : 1 + ((pm - 16) >> 4);
        const float* gv = modl + (size_t)midx * MODW + goff;
        const float* base = pm < 16 ? xlo + (size_t)pm * 256 * D : xhi + (size_t)(pm - 16) * 256 * D;
        float* ob = xout + (size_t)pm * 256 * D;
        const bool half = u.bh >= 0;
        const int col0 = u.pn * 256 + (u.bh > 0 ? 128 : 0) + wc * 32 + 4 * fq;
        f32x4 gvv[2][2];
#pragma unroll
        for (int bj = 0; bj < 2; ++bj)
#pragma unroll
            for (int n = 0; n < 2; ++n) gvv[bj][n] = (bj == 1 && half) ? (f32x4){0.f, 0.f, 0.f, 0.f} : *(const f32x4*)(gv + col0 + bj * 128 + n * 16);
        const size_t rbase = (size_t)(wr * 64 + fr) * D + col0;
        f32x4 xr[8][2][2];
#define ER_LOAD(g_) do { const size_t off_ = rbase + (size_t)(((g_) >> 2) * 128 + ((g_) & 3) * 16) * D; \
            _Pragma("unroll") for (int bj = 0; bj < 2; ++bj) { if (bj == 1 && half) continue; _Pragma("unroll") for (int n = 0; n < 2; ++n) xr[g_][bj][n] = *(const f32x4*)(base + off_ + bj * 128 + n * 16); } } while (0)
        ER_LOAD(0); ER_LOAD(1); ER_LOAD(2);
        asm volatile("" ::: "memory");
#pragma unroll
        for (int g = 0; g < 8; ++g) { const int ai = g >> 2, m = g & 3; const size_t off = rbase + (size_t)(ai * 128 + m * 16) * D;
#pragma unroll
            for (int bj = 0; bj < 2; ++bj) { if (bj == 1 && half) continue;
#pragma unroll
                for (int n = 0; n < 2; ++n) *(f32x4*)(ob + off + bj * 128 + n * 16) = xr[g][bj][n] + gvv[bj][n] * acc[ai][bj][m][n]; }
            asm volatile("" ::: "memory");
            if (g + 3 < 8) { ER_LOAD(g + 3); }
            asm volatile("" ::: "memory"); }
#undef ER_LOAD
    }
};
struct EpiSwi {
    static constexpr bool PERM = true, AFTER_DRAIN = false;
    bf16* O; int ldc;
    __device__ __forceinline__ void operator()(const f32x4 (&acc)[2][2][4][2], const pg8::Unit& u, int wr, int wc, int fr, int fq) const {
        const int row0 = u.pm * 256 + wr * 64 + fr, col0 = u.pn * 128 + wc * 32 + 8 * fq;
#pragma unroll
        for (int ai = 0; ai < 2; ++ai)
#pragma unroll
            for (int m = 0; m < 4; ++m) { bf16* rowp = O + (size_t)(row0 + ai * 128 + m * 16) * ldc + col0;
                float h[8];
#pragma unroll
                for (int n = 0; n < 2; ++n)
#pragma unroll
                    for (int j = 0; j < 4; ++j) { const float gt = acc[ai][0][m][n][j], up = acc[ai][1][m][n][j]; h[n * 4 + j] = gt * fsigmoid(gt) * up; }
                u32x4 w; w.x = pg8::cvt_pk_bf16(h[0], h[1]); w.y = pg8::cvt_pk_bf16(h[2], h[3]); w.z = pg8::cvt_pk_bf16(h[4], h[5]); w.w = pg8::cvt_pk_bf16(h[6], h[7]);
                *(u32x4*)rowp = w; }
    }
};

template <int MAP>
__device__ __forceinline__ void tr_item(const float* W, int K, int N, bf16* WT, LAS float* scr, int item, int lane) {
    const int nblk = N / 32, kb = item / nblk, nb = item % nblk, k0 = 64 * kb, n0 = 32 * nb;
#pragma unroll 8
    for (int i = 0; i < 32; ++i) { const int kk = 2 * i + (lane >> 5); scr[kk * 33 + (lane & 31)] = W[(size_t)(k0 + kk) * N + n0 + (lane & 31)]; }
    LDS_WAIT(); asm volatile("" ::: "memory");
    const int c = lane & 7;
#pragma unroll
    for (int j = 0; j < 4; ++j) { const int n = (lane >> 3) + 8 * j; const LAS float* s = scr + (8 * c) * 33 + n;
        u32x4 o; o.x = pk2(s[0 * 33], s[1 * 33]); o.y = pk2(s[2 * 33], s[3 * 33]); o.z = pk2(s[4 * 33], s[5 * 33]); o.w = pk2(s[6 * 33], s[7 * 33]);
        const int nn = n0 + n; const int orow = MAP == 0 ? nn : (256 * (nn >> 7) + (nn & 127) + (MAP == 2 ? 128 : 0));
        *(u32x4*)(WT + (size_t)orow * K + k0 + 8 * c) = o; }
    LDS_WAIT(); asm volatile("" ::: "memory");
}
__device__ __forceinline__ void p0_prologue(Frame& F) {
    PH_LOCALS(F);
    LAS float* scr = (LAS float*)(F.lds + wave * 16384);
    const int gw = bx * NWAVES + wave, NGW = G * NWAVES;
    constexpr int I_IN = (D / 64) * (PIN / 32), I_OUT = (D / 64) * (D / 32), I_GU = (D / 64) * (DFF / 32), I_DN = (DFF / 64) * (D / 32);
    constexpr int PL = I_IN + I_OUT + 2 * I_GU + I_DN;
    for (int it = gw; it < NL * PL; it += NGW) {
        const int l = it / PL; int r = it % PL;
        if (r < I_IN) { tr_item<0>(F.in[I_WIN] + (size_t)l * D * PIN, D, PIN, (bf16*)(F.ws + WS_WIN + l * SZ_WIN), scr, r, lane); continue; } r -= I_IN;
        if (r < I_OUT) { tr_item<0>(F.in[I_WOUT] + (size_t)l * D * D, D, D, (bf16*)(F.ws + WS_WOUT + l * SZ_WOUT), scr, r, lane); continue; } r -= I_OUT;
        if (r < I_GU) { tr_item<1>(F.in[I_WG] + (size_t)l * D * DFF, D, DFF, (bf16*)(F.ws + WS_WGU + l * SZ_WGU), scr, r, lane); continue; } r -= I_GU;
        if (r < I_GU) { tr_item<2>(F.in[I_WU] + (size_t)l * D * DFF, D, DFF, (bf16*)(F.ws + WS_WGU + l * SZ_WGU), scr, r, lane); continue; } r -= I_GU;
        tr_item<0>(F.in[I_WD] + (size_t)l * DFF * D, DFF, D, (bf16*)(F.ws + WS_WD + l * SZ_WD), scr, r, lane);
    }
    const int gt = bx * 512 + tid, NGT = G * 512;
    { constexpr int PADV = (PINP - PIN) * D * 2 / 16;
      for (int i = gt; i < NL * PADV; i += NGT) { const int l = i / PADV, r = i % PADV; ((u32x4*)(F.ws + WS_WIN + l * SZ_WIN + (size_t)PIN * D * 2))[r] = (u32x4){0u, 0u, 0u, 0u}; } }
    { bf16* w2t = (bf16*)(F.ws + WS_W2T); bf16* a2t = (bf16*)(F.ws + WS_A2T); bf16* g2t = (bf16*)(F.ws + WS_G2T); bf16* wsp = (bf16*)(F.ws + WS_WSP);
      for (int i = gt; i < NL * 2 * 1024 * 64; i += NGT) { const int k = i & 63, n = (i >> 6) & 1023, ld = i >> 16;
          w2t[i] = (bf16)f2bf(F.in[I_W2][((size_t)ld * 64 + k) * 1024 + n]); a2t[i] = (bf16)f2bf(F.in[I_A2][((size_t)ld * 64 + k) * 1024 + n]); }
      for (int i = gt; i < NL * 1024 * 160; i += NGT) { const int k = i % 160, n = (i / 160) & 1023, l = i / (160 * 1024);
          g2t[i] = (bf16)f2bf(F.in[I_G2][((size_t)l * 160 + k) * 1024 + n]); }
      for (int i = gt; i < NL * 8 * 128 * 128; i += NGT) wsp[i] = (bf16)f2bf(F.in[I_WSP][i]); }
    __syncthreads();
    { LAS float* sv = (LAS float*)F.lds;
      LAS float* red = (LAS float*)(F.lds + 40960);
      for (int i = tid; i < 5 * D; i += 512) { const int r = i / D, k = i % D; const float c = r == 0 ? F.in[I_CCTX][k] : F.in[I_C][(r - 1) * D + k]; sv[i] = c * fsigmoid(c); }
      __syncthreads();
      float* mod = (float*)(F.ws + WS_MOD);
      const int c4 = tid & 15, kg = tid >> 4;
      for (int item = bx; item < NL * (MODW / 64); item += G) {
          const int l = item / (MODW / 64), n0 = (item % (MODW / 64)) * 64;
          const float* W = F.in[I_WMOD] + (size_t)l * D * MODW + n0 + 4 * c4;
          f32x4 a[5];
#pragma unroll
          for (int r = 0; r < 5; ++r) a[r] = (f32x4){0.f, 0.f, 0.f, 0.f};
#pragma unroll 4
          for (int i = 0; i < 64; ++i) { const int k = i * 32 + kg; const f32x4 w = *(const f32x4*)(W + (size_t)k * MODW);
#pragma unroll
              for (int r = 0; r < 5; ++r) a[r] += w * sv[r * D + k]; }
#pragma unroll
          for (int r = 0; r < 5; ++r) *(LAS f32x4*)(red + (kg * 5 + r) * 64 + 4 * c4) = a[r];
          __syncthreads();
          if (tid < 320) { const int r = tid >> 6, n = tid & 63; float s = 0.f;
#pragma unroll 8
              for (int g = 0; g < 32; ++g) s += red[(g * 5 + r) * 64 + n];
              mod[((size_t)l * 5 + r) * MODW + n0 + n] = s + F.in[I_BMOD][(size_t)l * MODW + n0 + n]; }
          __syncthreads();
      } }
}

__device__ __forceinline__ void p_adaln(Frame& F, int l, int which, const float* xlo, const float* xhi) {
    PH_LOCALS(F); PH_LAYER(l);
    const int gw = bx * NWAVES + wave, NGW = G * NWAVES;
    const float* ng = (which == 0 ? F.in[I_N1G] : F.in[I_N2G]) + (size_t)l * D;
    const int shoff = which == 0 ? 0 : 3 * D, scoff = shoff + D;
    const float* mod = (const float*)(F.ws + WS_MOD);
    bf16* H = (bf16*)(F.ws + WS_H);
    const int rpw = (M + NGW - 1) / NGW, rbeg = gw * rpw, rend = rbeg + rpw < M ? rbeg + rpw : M;
    f32x4 ca[8], cb[8]; int mcur = -1;
    for (int row = rbeg; row < rend; ++row) {
        const float* xr = row < MCTX ? xlo + (size_t)row * D : xhi + (size_t)(row - MCTX) * D;
        const int midx = row < MCTX ? 0 : 1 + ((row - MCTX) >> 12);
        if (midx != mcur) { mcur = midx; const float* md = mod + ((size_t)l * 5 + midx) * MODW;
#pragma unroll
            for (int j = 0; j < 8; ++j) { const int c = 4 * lane + 256 * j; ca[j] = *(const f32x4*)(ng + c) * (*(const f32x4*)(md + scoff + c) + 1.0f); cb[j] = *(const f32x4*)(md + shoff + c); } }
        f32x4 v[8]; float ss = 0.f;
#pragma unroll
        for (int j = 0; j < 8; ++j) { v[j] = *(const f32x4*)(xr + 4 * lane + 256 * j); ss += (v[j].x * v[j].x + v[j].y * v[j].y) + (v[j].z * v[j].z + v[j].w * v[j].w); }
        WAVE_SUM(ss); const float rstd = 1.0f / sqrtf(ss * (1.0f / D) + RMS_EPS);
#pragma unroll
        for (int j = 0; j < 8; ++j) { const int c = 4 * lane + 256 * j;
            const f32x4 o = v[j] * rstd * ca[j] + cb[j];
            u32x2 w; w.x = pk2(o.x, o.y); w.y = pk2(o.z, o.w);
            *(u32x2*)(H + (size_t)row * D + c) = w; }
    }
}

__device__ __forceinline__ void load_shifted8(const bf16* P, const float* mu, int row, int col, float (&o)[8]) {
    float g[8]; unpack8(*(const u32x4*)(P + (size_t)row * PINP + col), g);
    float a[8];
#pragma unroll
    for (int j = 0; j < 8; ++j) a[j] = g[j];
    int nrow[4]; bool has[4]; int nn;
    if (row < MCTX) { const int t = row & 255; nn = 2; nrow[0] = row - 1; has[0] = t > 0; nrow[1] = row + 1; has[1] = t < 255; nrow[2] = row; has[2] = false; nrow[3] = row; has[3] = false; }
    else { const int t = (row - MCTX) & 4095, gc = t & 63, gr = t >> 6; nn = 4;
        nrow[0] = row - 1; has[0] = gc > 0; nrow[1] = row + 1; has[1] = gc < 63; nrow[2] = row - 64; has[2] = gr > 0; nrow[3] = row + 64; has[3] = gr < 63; }
#pragma unroll
    for (int q = 0; q < 4; ++q) {
        if (q < nn) {
            float nb[8];
            if (has[q]) unpack8(*(const u32x4*)(P + (size_t)nrow[q] * PINP + col), nb);
            else {
#pragma unroll
                for (int j = 0; j < 8; ++j) nb[j] = 0.f; }
            const f32x4 m0 = *(const f32x4*)(mu + q * CSH + col), m1 = *(const f32x4*)(mu + q * CSH + col + 4);
#pragma unroll
            for (int j = 0; j < 4; ++j) { a[j] += m0[j] * (nb[j] - g[j]); a[4 + j] += m1[j] * (nb[4 + j] - g[4 + j]); }
        }
    }
#pragma unroll
    for (int j = 0; j < 8; ++j) o[j] = a[j];
}
__device__ __forceinline__ void p_shift(Frame& F, int l) {
    PH_LOCALS(F); PH_LAYER(l);
    const bf16* P = (const bf16*)(F.ws + WS_P); bf16* PS = (bf16*)(F.ws + WS_PS); bf16* LORA = (bf16*)(F.ws + WS_LORA);
    const float* mu = F.in[I_MU] + (size_t)l * 4 * CSH;
    constexpr int CG = CSH / 8;
    if (tid >= CG) return;
    const int col = tid * 8; const int act = (col >= 3 * DA && col < 3 * DA + LW) ? 1 : (col >= 3 * DA + LW + LAA ? 2 : 0);
    f32x2 m[4][4];
#pragma unroll
    for (int q = 0; q < 4; ++q) { const f32x4 a = *(const f32x4*)(mu + q * CSH + col), b = *(const f32x4*)(mu + q * CSH + col + 4); m[q][0] = (f32x2){a[0], a[1]}; m[q][1] = (f32x2){a[2], a[3]}; m[q][2] = (f32x2){b[0], b[1]}; m[q][3] = (f32x2){b[2], b[3]}; }
#define SH_UNPK(q_, v_) do { v_[0] = (f32x2){__uint_as_float((q_).x << 16), __uint_as_float((q_).x & 0xffff0000u)}; v_[1] = (f32x2){__uint_as_float((q_).y << 16), __uint_as_float((q_).y & 0xffff0000u)}; \
        v_[2] = (f32x2){__uint_as_float((q_).z << 16), __uint_as_float((q_).z & 0xffff0000u)}; v_[3] = (f32x2){__uint_as_float((q_).w << 16), __uint_as_float((q_).w & 0xffff0000u)}; } while (0)
#define SH_STORE(row_, a_) do { float o_[8] = {a_[0].x, a_[0].y, a_[1].x, a_[1].y, a_[2].x, a_[2].y, a_[3].x, a_[3].y}; \
        if (act == 1) { _Pragma("unroll") for (int jx = 0; jx < 8; ++jx) o_[jx] = ftanh(o_[jx]); } else if (act == 2) { _Pragma("unroll") for (int jx = 0; jx < 8; ++jx) o_[jx] = fsigmoid(o_[jx]); } \
        if (col >= 3 * DA) { const int cgl = (col - 3 * DA) >> 3; *(u32x4*)(LORA + ((((size_t)((row_) >> 4) * 9 + (cgl >> 2)) * 64 + 16 * (cgl & 3) + ((row_) & 15)) << 3)) = pack8(o_); } \
        else *(u32x4*)(PS + (size_t)(row_) * CSH + col) = pack8(o_); } while (0)
    const u32x4 Z4 = (u32x4){0u, 0u, 0u, 0u};
    { f32x2 c0[4];
#pragma unroll
      for (int e = 0; e < 4; ++e) c0[e] = (f32x2){1.f, 1.f} - ((m[0][e] + m[1][e]) + (m[2][e] + m[3][e]));
      for (int u = bx; u < 256; u += G) {
          const int gc = u & 63; const bf16* pc = P + ((size_t)MCTX + (size_t)(u >> 6) * 4096 + gc) * PINP + col;
          const int rowb = MCTX + (u >> 6) * 4096 + gc;
          u32x4 up = Z4, cur = *(const u32x4*)pc;
          for (int g0 = 0; g0 < 64; g0 += 4) {
              u32x4 dn[4], lf[4], rt[4];
#pragma unroll
              for (int i = 0; i < 4; ++i) { const int gr = g0 + i; const bf16* pr = pc + (size_t)gr * 64 * PINP;
                  dn[i] = gr < 63 ? *(const u32x4*)(pr + (size_t)64 * PINP) : Z4; lf[i] = gc > 0 ? *(const u32x4*)(pr - PINP) : Z4; rt[i] = gc < 63 ? *(const u32x4*)(pr + PINP) : Z4; }
#pragma unroll
              for (int i = 0; i < 4; ++i) { f32x2 g[4], a[4], nb[4]; SH_UNPK(cur, g);
#pragma unroll
                  for (int e = 0; e < 4; ++e) a[e] = c0[e] * g[e];
                  SH_UNPK(lf[i], nb);
#pragma unroll
                  for (int e = 0; e < 4; ++e) a[e] += m[0][e] * nb[e];
                  SH_UNPK(rt[i], nb);
#pragma unroll
                  for (int e = 0; e < 4; ++e) a[e] += m[1][e] * nb[e];
                  SH_UNPK(up, nb);
#pragma unroll
                  for (int e = 0; e < 4; ++e) a[e] += m[2][e] * nb[e];
                  SH_UNPK(dn[i], nb);
#pragma unroll
                  for (int e = 0; e < 4; ++e) a[e] += m[3][e] * nb[e];
                  const int row = rowb + (g0 + i) * 64; SH_STORE(row, a);
                  up = cur; cur = dn[i]; }
          }
      } }
    { f32x2 c0[4];
#pragma unroll
      for (int e = 0; e < 4; ++e) c0[e] = (f32x2){1.f, 1.f} - (m[0][e] + m[1][e]);
      const int rpw = (MCTX + G - 1) / G, rbeg = bx * rpw, rend = rbeg + rpw < MCTX ? rbeg + rpw : MCTX;
      if (rbeg < rend) {
          const bf16* pc = P + (size_t)rbeg * PINP + col;
          u32x4 prev = (rbeg & 255) ? *(const u32x4*)(pc - PINP) : Z4, cur = *(const u32x4*)pc;
          for (int row = rbeg; row < rend; ++row) { const bf16* pr = P + (size_t)row * PINP + col;
              const u32x4 nxt = (row & 255) != 255 ? *(const u32x4*)(pr + PINP) : Z4;
              f32x2 g[4], a[4], nb[4]; SH_UNPK(cur, g);
#pragma unroll
              for (int e = 0; e < 4; ++e) a[e] = c0[e] * g[e];
              SH_UNPK(prev, nb);
#pragma unroll
              for (int e = 0; e < 4; ++e) a[e] += m[0][e] * nb[e];
              SH_UNPK(nxt, nb);
#pragma unroll
              for (int e = 0; e < 4; ++e) a[e] += m[1][e] * nb[e];
              SH_STORE(row, a);
              prev = (row & 255) != 255 ? cur : Z4; cur = ((row & 255) != 255 || row + 1 >= rend) ? nxt : *(const u32x4*)(pr + PINP); }
      } }
#undef SH_UNPK
#undef SH_STORE
}

#define F4Z ((f32x4){0.f, 0.f, 0.f, 0.f})
__device__ __forceinline__ u32x2 pk4(const f32x4 a) { u32x2 w; w.x = pk2(a[0], a[1]); w.y = pk2(a[2], a[3]); return w; }
#define LBAR() do { asm volatile("s_waitcnt lgkmcnt(0)" ::: "memory"); __builtin_amdgcn_s_barrier(); asm volatile("" ::: "memory"); } while (0)
constexpr int VTS = 136;
typedef short s16x4g __attribute__((ext_vector_type(4)));
__device__ __forceinline__ bf16x8 frag_tr_ld(const LAS bf16* X, int ld, int kbase, int c0, int fr, int fq) {
    const LAS bf16* p = X + (kbase + 8 * fq + (fr >> 2)) * ld + c0 + 4 * (fr & 3);
    const s16x4g lo = __builtin_amdgcn_ds_read_tr16_b64_v4i16((LAS s16x4g*)p);
    const s16x4g hi = __builtin_amdgcn_ds_read_tr16_b64_v4i16((LAS s16x4g*)(p + 4 * ld));
    return (bf16x8){lo[0], lo[1], lo[2], lo[3], hi[0], hi[1], hi[2], hi[3]};
}
__device__ __forceinline__ void p_gmlp(Frame& F, int l, int slot, int nslots) {
    PH_LOCALS(F); PH_LAYER(l); (void)bx; (void)G;
    const bf16* P = (const bf16*)(F.ws + WS_P); bf16* O = (bf16*)(F.ws + WS_O);
    const bf16* wsp = (const bf16*)(F.ws + WS_WSP) + (size_t)l * 8 * 128 * 128;
    LAS bf16* VN = (LAS bf16*)F.lds;
    LAS bf16* ST = (LAS bf16*)(F.lds + 34816);
    const int fr = lane & 15, fq = lane >> 4;
    constexpr int NIT = (M / 128) * NG;
    const int jrow = tid >> 2, q4 = tid & 3;
    u32x4 pvv[4]; f32x4 lgv[8], lbv[8]; bf16x8 bw[4]; float bsp = 0.f; int gcur = -1;
#define GM_ISSUE(item_) do { const bf16* src_ = P + (size_t)(((item_) >> 3) * 128 + jrow) * PINP + CSH + DB + 128 * ((item_) & 7) + 32 * q4; \
        _Pragma("unroll") for (int i_ = 0; i_ < 4; ++i_) pvv[i_] = *(const u32x4*)(src_ + 8 * i_); } while (0)
    if (slot < 0) return;
    LBAR();
    if (slot < NIT) GM_ISSUE(slot);
    for (int item = slot; item < NIT; item += nslots) {
        const int cb = item >> 3, g = item & 7, R0 = cb * 128;
        u32x4 pu[4]; { const bf16* up = P + (size_t)(R0 + jrow) * PINP + CSH + 128 * g + 32 * q4;
#pragma unroll
            for (int i = 0; i < 4; ++i) pu[i] = *(const u32x4*)(up + 8 * i); }
        if (g != gcur) { gcur = g; const bf16* wa = wsp + ((size_t)g * 128 + 16 * wave + fr) * 128 + 8 * fq;
#pragma unroll
            for (int ks = 0; ks < 4; ++ks) bw[ks] = *(const bf16x8*)(wa + 32 * ks);
            bsp = F.in[I_BSP][((size_t)l * 8 + g) * 128 + jrow];
            const float* lg = F.in[I_LNG] + ((size_t)l * 8 + g) * 128 + 32 * q4; const float* lb = F.in[I_LNB] + ((size_t)l * 8 + g) * 128 + 32 * q4;
#pragma unroll
            for (int i = 0; i < 8; ++i) { lgv[i] = *(const f32x4*)(lg + 4 * i); lbv[i] = *(const f32x4*)(lb + 4 * i); } }
        { float v[32];
#pragma unroll
          for (int i = 0; i < 4; ++i) { float f[8]; unpack8(pvv[i], f);
#pragma unroll
              for (int jj = 0; jj < 8; ++jj) v[8 * i + jj] = f[jj]; }
          float s = 0.f;
#pragma unroll
          for (int i = 0; i < 32; ++i) s += v[i];
          s += SHX(s, 1); s += SHX(s, 2);
          const float mean = s * (1.0f / 128.0f); float qq = 0.f;
#pragma unroll
          for (int i = 0; i < 32; ++i) { v[i] -= mean; qq += v[i] * v[i]; }
          qq += SHX(qq, 1); qq += SHX(qq, 2);
          const float rstd = 1.0f / sqrtf(qq * (1.0f / 128.0f) + LN_EPS);
#pragma unroll
          for (int i = 0; i < 4; ++i) { float o[8]; const f32x4 g0 = lgv[2 * i], g1 = lgv[2 * i + 1], b0 = lbv[2 * i], b1 = lbv[2 * i + 1];
#pragma unroll
              for (int jj = 0; jj < 4; ++jj) { o[jj] = v[8 * i + jj] * rstd * g0[jj] + b0[jj]; o[4 + jj] = v[8 * i + 4 + jj] * rstd * g1[jj] + b1[jj]; }
              *(LAS u32x4*)(VN + jrow * VTS + 32 * q4 + 8 * i) = pack8(o); } }
        if (item + nslots < NIT) GM_ISSUE(item + nslots);
        LBAR();
#pragma unroll
        for (int mt = 0; mt < 8; ++mt) { f32x4 acc = F4Z;
#pragma unroll
            for (int ks = 0; ks < 4; ++ks) acc = __builtin_amdgcn_mfma_f32_16x16x32_bf16(frag_tr_ld(VN, VTS, 32 * ks, 16 * mt, fr, fq), bw[ks], acc, 0, 0, 0);
            *(LAS u32x2*)(ST + (16 * wave + fr) * VTS + 16 * mt + 4 * fq) = pk4(acc); }
        LBAR();
        { bf16* op = O + (size_t)(R0 + jrow) * D + DA + 128 * g + 32 * q4;
#pragma unroll
          for (int i = 0; i < 4; ++i) { float sv[8], uv[8], o[8]; unpack8(*(const LAS u32x4*)(ST + jrow * VTS + 32 * q4 + 8 * i), sv); unpack8(pu[i], uv);
#pragma unroll
              for (int jj = 0; jj < 8; ++jj) o[jj] = uv[jj] * (sv[jj] + bsp);
              *(u32x4*)(op + 8 * i) = pack8(o); } }
    }
    LBAR();
#undef GM_ISSUE
}

constexpr int T16B = 9216, LD16 = 72, LD32 = 68;
#define SLOT(i) ((LAS bf16*)(lds + (i) * T16B))
#define SLOTF(i) ((LAS float*)(lds + (i) * T16B))
template <int NK>
__device__ __forceinline__ f32x4 tile_mm(const LAS bf16* A, int lda, const LAS bf16* B, int ldb, int fr, int fq, f32x4 acc) {
#pragma unroll
    for (int ks = 0; ks < NK; ++ks) { const bf16x8 a = *(const LAS bf16x8*)(A + fr * lda + 8 * fq + 32 * ks); const bf16x8 b = *(const LAS bf16x8*)(B + fr * ldb + 8 * fq + 32 * ks);
        acc = __builtin_amdgcn_mfma_f32_16x16x32_bf16(a, b, acc, 0, 0, 0); }
    return acc;
}
__device__ __forceinline__ void st_nat(LAS bf16* dst, int n0, int m0, int fr, int fq, const f32x4 a) { *(LAS u32x2*)(dst + (n0 + fr) * LD16 + m0 + 4 * fq) = pk4(a); }
__device__ __forceinline__ void st_rm(LAS bf16* dst, int n0, int m0, int fr, int fq, const f32x4 a) {
#pragma unroll
    for (int r = 0; r < 4; ++r) dst[(m0 + 4 * fq + r) * LD16 + n0 + fr] = (bf16)f2bf(a[r]); }
__device__ __forceinline__ f32x4 ld4bf(const LAS bf16* p) { const u32x2 w = *(const LAS u32x2*)p; return (f32x4){__uint_as_float(w.x << 16), __uint_as_float(w.x & 0xffff0000u), __uint_as_float(w.y << 16), __uint_as_float(w.y & 0xffff0000u)}; }

__device__ __forceinline__ int fm_off(int n0, int m0, int fr, int fq) { return ((((n0 >> 4) * 2 + (m0 >> 5)) * 64 + (2 * ((m0 >> 4) & 1) + (fq >> 1)) * 16 + fr) << 3) + 4 * (fq & 1); }
typedef short s16x4 __attribute__((ext_vector_type(4)));
__device__ __forceinline__ bf16x8 frag_tr(const LAS bf16* X, int kbase, int c0, int fr, int fq) {
    const LAS bf16* p = X + (kbase + 8 * fq + (fr >> 2)) * LD16 + c0 + 4 * (fr & 3);
    const s16x4 lo = __builtin_amdgcn_ds_read_tr16_b64_v4i16((LAS s16x4*)p);
    const s16x4 hi = __builtin_amdgcn_ds_read_tr16_b64_v4i16((LAS s16x4*)(p + 4 * LD16));
    return (bf16x8){lo[0], lo[1], lo[2], lo[3], hi[0], hi[1], hi[2], hi[3]};
}
__device__ __forceinline__ bf16x8 frag_rm(const LAS bf16* X, int r0, int ks, int fr, int fq) { return *(const LAS bf16x8*)(X + (r0 + fr) * LD16 + 8 * fq + 32 * ks); }
__device__ __forceinline__ f32x4 mm2(const bf16x8 (&a)[2], const bf16x8 (&b)[2], f32x4 acc) {
    acc = __builtin_amdgcn_mfma_f32_16x16x32_bf16(a[0], b[0], acc, 0, 0, 0); return __builtin_amdgcn_mfma_f32_16x16x32_bf16(a[1], b[1], acc, 0, 0, 0); }
__device__ __forceinline__ bf16x8 as_frag(const u32x4 q) { return __builtin_bit_cast(bf16x8, q); }

__device__ __forceinline__ void p_chunkA(Frame& F, int l) {
    PH_LOCALS(F); PH_LAYER(l);
    LAS unsigned char* lds = F.lds;
    const int lane0 = lane, lane00 = lane;
#define STG int lane_ = lane0; asm volatile("" : "+v"(lane_)); const int lane = lane_, fr = lane_ & 15, fq = lane_ >> 4, tid = wave * 64 + lane_, mt = wave >> 1, m0 = 16 * mt, np = (wave & 1) * 2; \
    (void)lane; (void)fr; (void)fq; (void)tid; (void)mt; (void)m0; (void)np;
    const bf16* PS = (const bf16*)(F.ws + WS_PS);
    const bf16* w2t = (const bf16*)(F.ws + WS_W2T) + (size_t)l * 2 * 1024 * 64;
    const bf16* a2t = (const bf16*)(F.ws + WS_A2T) + (size_t)l * 2 * 1024 * 64;
    const bf16* g2t = (const bf16*)(F.ws + WS_G2T) + (size_t)l * 1024 * 160;
    bf16* GATE = (bf16*)(F.ws + WS_GATE); float* BONUS = (float*)(F.ws + WS_BONUS);
    LAS float* gC = (LAS float*)(lds + 14 * T16B);
    LAS float* BT = (LAS float*)(lds + 14 * T16B + 256);
    u32x4 pf_w[2], pf_a[2], pf_g[5], pf_r, pf_k, pf_v; bf16x8 Bg[2][5], Bw[2][2], Ba[2][2]; float biw[2], bia[2];
#define CA_ISSUE(item_, d_) do { const int ci_ = (item_) >> 4, h_ = (item_) & 15, R0_ = ci_ * 64; int lane0 = lane00; asm volatile("" : "+v"(lane0)); \
        const bf16* arow_ = (const bf16*)(F.ws + WS_LORA) + ((((size_t)(R0_ >> 4) + (wave >> 1)) * 9 * 64 + lane0) << 3); \
        pf_w[0] = *(const u32x4*)arow_; pf_w[1] = *(const u32x4*)(arow_ + 512); pf_a[0] = *(const u32x4*)(arow_ + 1024); pf_a[1] = *(const u32x4*)(arow_ + 1536); \
        if ((d_) == 0) { _Pragma("unroll") for (int ks_ = 0; ks_ < 5; ++ks_) { pf_g[ks_] = *(const u32x4*)(arow_ + 2048 + 512 * ks_); \
            _Pragma("unroll") for (int nn_ = 0; nn_ < 2; ++nn_) Bg[nn_][ks_] = *(const bf16x8*)(g2t + (size_t)(64 * h_ + 16 * ((wave & 1) * 2 + nn_) + (lane0 & 15)) * 160 + 8 * (lane0 >> 4) + 32 * ks_); } } \
        _Pragma("unroll") for (int nn_ = 0; nn_ < 2; ++nn_) { const int n_ = 64 * h_ + 16 * ((wave & 1) * 2 + nn_) + (lane0 & 15); \
            biw[nn_] = F.in[I_W0][((size_t)l * 2 + (d_)) * DA + n_]; bia[nn_] = F.in[I_A0][((size_t)l * 2 + (d_)) * DA + n_]; \
            _Pragma("unroll") for (int ks_ = 0; ks_ < 2; ++ks_) { Bw[nn_][ks_] = *(const bf16x8*)(w2t + ((size_t)(d_) * 1024 + n_) * 64 + 8 * (lane0 >> 4) + 32 * ks_); Ba[nn_][ks_] = *(const bf16x8*)(a2t + ((size_t)(d_) * 1024 + n_) * 64 + 8 * (lane0 >> 4) + 32 * ks_); } } \
        const int tid_ = wave * 64 + lane0, tau_ = tid_ >> 3, pos_ = (d_) ? 63 - tau_ : tau_; const bf16* rrow_ = PS + (size_t)(R0_ + pos_) * CSH + 64 * h_ + (tid_ & 7) * 8; \
        pf_r = *(const u32x4*)rrow_; pf_k = *(const u32x4*)(rrow_ + DA); pf_v = *(const u32x4*)(rrow_ + 2 * DA); } while (0)
    if (bx < (M / 64) * NH) CA_ISSUE(bx, 0);
    int hcur = -1;
    LAS float* HC = (LAS float*)(lds + 14 * T16B + 1280);
    for (int item = bx; item < (M / 64) * NH; item += G) {
        const int ci = item >> 4, h = item & 15, R0 = ci * 64;
        { (void)hcur;
            LBAR();
            { const int t_ = wave * 64 + lane0; if (t_ < 192) { const int w_ = t_ >> 6, c_ = t_ & 63; HC[t_] = (w_ == 0 ? F.in[I_KK] : (w_ == 1 ? F.in[I_KA] : F.in[I_RK]))[(size_t)l * DA + 64 * h + c_]; } } }
#pragma unroll
        for (int d = 0; d < 2; ++d) {
            const size_t qi = ((size_t)ci * 16 + h) * 2 + d;
            const bf16x8 cBw[2][2] = {{Bw[0][0], Bw[0][1]}, {Bw[1][0], Bw[1][1]}}, cBa[2][2] = {{Ba[0][0], Ba[0][1]}, {Ba[1][0], Ba[1][1]}}; const float cbw[2] = {biw[0], biw[1]}, cba[2] = {bia[0], bia[1]};
            u32x4 cw[2] = {pf_w[0], pf_w[1]}, ca[2] = {pf_a[0], pf_a[1]}, cg[5] = {pf_g[0], pf_g[1], pf_g[2], pf_g[3], pf_g[4]}; const u32x4 cr = pf_r, ck = pf_k, cv = pf_v;
            for (int repA = 0; repA < (PROBE_SUB == 1 ? 2 : 1); ++repA) {
            { STG; LAS float* AL = SLOTF(5); LAS float* LW = SLOTF(7);
              bf16x8 aw[2], aa[2];
#pragma unroll
              for (int ks = 0; ks < 2; ++ks) { aw[ks] = as_frag(cw[ks]); aa[ks] = as_frag(ca[ks]); }
#pragma unroll
              for (int nn = 0; nn < 2; ++nn) { const int nl = 16 * (np + nn) + fr, n = 64 * h + nl;
                  const f32x4 accw = mm2(aw, cBw[nn], F4Z), acca = mm2(aa, cBa[nn], F4Z);
                  const float biasw = cbw[nn], biasa = cba[nn]; (void)n;
                  float lw[4], c[4];
#pragma unroll
                  for (int r = 0; r < 4; ++r) lw[r] = -0.8750345269f * fsigmoid(biasw + accw[r]);
                  if (d == 0) { c[0] = lw[0]; c[1] = c[0] + lw[1]; c[2] = c[1] + lw[2]; c[3] = c[2] + lw[3]; }
                  else { c[3] = lw[3]; c[2] = c[3] + lw[2]; c[1] = c[2] + lw[1]; c[0] = c[1] + lw[0]; }
                  const float tot = d == 0 ? c[3] : c[0];
                  const float t1 = SHX(tot, 16), t2 = SHX(tot, 32), t3 = SHX(tot, 48);
                  float off;
                  { const int sg = d ? -1 : 1, q1 = fq ^ 1, q2 = fq ^ 2, q3 = fq ^ 3;
                    const int k1 = (sg * (q1 - fq)) >> 31, k2 = (sg * (q2 - fq)) >> 31, k3 = (sg * (q3 - fq)) >> 31;
                    off = (__int_as_float(__float_as_int(t1) & k1) + __int_as_float(__float_as_int(t2) & k2)) + __int_as_float(__float_as_int(t3) & k3); }
#pragma unroll
                  for (int r = 0; r < 4; ++r) { const int pos = m0 + 4 * fq + r, tau = d ? 63 - pos : pos;
                      LW[tau * LD32 + nl] = c[r] + off; AL[tau * LD32 + nl] = fsigmoid(biasa + acca[r]); }
                  if (fq == 0) BT[(d ? 3 - mt : mt) * 64 + nl] = (tot + t1) + (t2 + t3); }
              if (d == 0) {
                  bf16x8 ag[5];
#pragma unroll
                  for (int ks = 0; ks < 5; ++ks) ag[ks] = as_frag(cg[ks]);
#pragma unroll
                  for (int nn = 0; nn < 2; ++nn) { const int n = 64 * h + 16 * (np + nn) + fr; f32x4 acc = F4Z;
#pragma unroll
                      for (int ks = 0; ks < 5; ++ks) acc = __builtin_amdgcn_mfma_f32_16x16x32_bf16(ag[ks], Bg[nn][ks], acc, 0, 0, 0);
#pragma unroll
                      for (int r = 0; r < 4; ++r) SLOT(11)[(m0 + 4 * fq + r) * LD16 + 16 * (np + nn) + fr] = (bf16)f2bf(acc[r]); (void)n; } } }
            LBAR();
            { STG; const LAS float* AL = SLOTF(5); const LAS float* LW = SLOTF(7);
              const int tau = tid >> 3, c8 = (tid & 7) * 8, pos = d ? 63 - tau : tau, row = R0 + pos, blk = wave >> 1;
              f32x2 r[4], k[4];
              { const u32x4 q = cr; r[0] = (f32x2){__uint_as_float(q.x << 16), __uint_as_float(q.x & 0xffff0000u)}; r[1] = (f32x2){__uint_as_float(q.y << 16), __uint_as_float(q.y & 0xffff0000u)};
                r[2] = (f32x2){__uint_as_float(q.z << 16), __uint_as_float(q.z & 0xffff0000u)}; r[3] = (f32x2){__uint_as_float(q.w << 16), __uint_as_float(q.w & 0xffff0000u)}; }
              { const u32x4 q = ck; k[0] = (f32x2){__uint_as_float(q.x << 16), __uint_as_float(q.x & 0xffff0000u)}; k[1] = (f32x2){__uint_as_float(q.y << 16), __uint_as_float(q.y & 0xffff0000u)};
                k[2] = (f32x2){__uint_as_float(q.z << 16), __uint_as_float(q.z & 0xffff0000u)}; k[3] = (f32x2){__uint_as_float(q.w << 16), __uint_as_float(q.w & 0xffff0000u)}; }
              f32x2 offb[4], totC[4];
#pragma unroll
              for (int j = 0; j < 4; ++j) { offb[j] = (f32x2){0.f, 0.f}; totC[j] = (f32x2){0.f, 0.f}; }
#pragma unroll
              for (int b = 0; b < 4; ++b) { const f32x4 x0 = *(const LAS f32x4*)(BT + b * 64 + c8), x1 = *(const LAS f32x4*)(BT + b * 64 + c8 + 4);
                  const f32x2 y[4] = {{x0[0], x0[1]}, {x0[2], x0[3]}, {x1[0], x1[1]}, {x1[2], x1[3]}};
                  const float fb = b < blk ? 1.0f : 0.0f;
#pragma unroll
                  for (int j = 0; j < 4; ++j) { totC[j] += y[j]; offb[j] += y[j] * fb; } }
              f32x2 ckk[4], cka[4], crk[4];
              { const f32x4 a0 = *(const LAS f32x4*)(HC + c8), a1 = *(const LAS f32x4*)(HC + c8 + 4), b0 = *(const LAS f32x4*)(HC + 64 + c8), b1 = *(const LAS f32x4*)(HC + 64 + c8 + 4), c0 = *(const LAS f32x4*)(HC + 128 + c8), c1 = *(const LAS f32x4*)(HC + 128 + c8 + 4);
                ckk[0] = (f32x2){a0[0], a0[1]}; ckk[1] = (f32x2){a0[2], a0[3]}; ckk[2] = (f32x2){a1[0], a1[1]}; ckk[3] = (f32x2){a1[2], a1[3]};
                cka[0] = (f32x2){b0[0], b0[1]}; cka[1] = (f32x2){b0[2], b0[3]}; cka[2] = (f32x2){b1[0], b1[1]}; cka[3] = (f32x2){b1[2], b1[3]};
                crk[0] = (f32x2){c0[0], c0[1]}; crk[1] = (f32x2){c0[2], c0[3]}; crk[2] = (f32x2){c1[0], c1[1]}; crk[3] = (f32x2){c1[2], c1[3]}; }
              f32x2 kk[4], s2 = (f32x2){0.f, 0.f};
#pragma unroll
              for (int j = 0; j < 4; ++j) { kk[j] = k[j] * ckk[j]; s2 += kk[j] * kk[j]; }
              float ss = s2.x + s2.y;
              ss += SHX(ss, 1); ss += SHX(ss, 2); ss += SHX(ss, 4);
              const float rn = 1.0f / sqrtf(fmaxf(ss, 1e-24f));
              f32x2 alv[4], csv[4], csm[4];
              { const f32x4 a0 = *(const LAS f32x4*)(AL + tau * LD32 + c8), a1 = *(const LAS f32x4*)(AL + tau * LD32 + c8 + 4), c0 = *(const LAS f32x4*)(LW + tau * LD32 + c8), c1 = *(const LAS f32x4*)(LW + tau * LD32 + c8 + 4);
                const int tm = (tau & 15) ? tau - 1 : tau; f32x4 e0 = *(const LAS f32x4*)(LW + tm * LD32 + c8), e1 = *(const LAS f32x4*)(LW + tm * LD32 + c8 + 4);
                if ((tau & 15) == 0) { e0 = F4Z; e1 = F4Z; }
                alv[0] = (f32x2){a0[0], a0[1]}; alv[1] = (f32x2){a0[2], a0[3]}; alv[2] = (f32x2){a1[0], a1[1]}; alv[3] = (f32x2){a1[2], a1[3]};
                csv[0] = (f32x2){c0[0], c0[1]} + offb[0]; csv[1] = (f32x2){c0[2], c0[3]} + offb[1]; csv[2] = (f32x2){c1[0], c1[1]} + offb[2]; csv[3] = (f32x2){c1[2], c1[3]} + offb[3];
                csm[0] = (f32x2){e0[0], e0[1]} + offb[0]; csm[1] = (f32x2){e0[2], e0[3]} + offb[1]; csm[2] = (f32x2){e1[0], e1[1]} + offb[2]; csm[3] = (f32x2){e1[2], e1[3]} + offb[3]; }
              f32x2 at[4], rt[4], bt[4], kt[4], bh[4], kh[4], bon2 = (f32x2){0.f, 0.f};
#pragma unroll
              for (int j = 0; j < 4; ++j) { const f32x2 al = alv[j], cs = csv[j], dh = totC[j] - cs;
                  const f32x2 kkn = kk[j] * rn, kd = k[j] * ((al - 1.0f) * cka[j] + 1.0f), bb = kkn * al;
                  bon2 += r[j] * kd * crk[j];
                  const f32x2 encs = (f32x2){__builtin_amdgcn_exp2f(-cs.x), __builtin_amdgcn_exp2f(-cs.y)}, eh = (f32x2){__builtin_amdgcn_exp2f(dh.x), __builtin_amdgcn_exp2f(dh.y)};
                  const f32x2 ecm = (f32x2){__builtin_amdgcn_exp2f(csm[j].x), __builtin_amdgcn_exp2f(csm[j].y)}, ecs = (f32x2){__builtin_amdgcn_exp2f(cs.x), __builtin_amdgcn_exp2f(cs.y)};
                  at[j] = -(ecm * kkn); rt[j] = ecs * r[j]; bt[j] = encs * bb; kt[j] = encs * kd; bh[j] = eh * bb; kh[j] = eh * kd; }
              if (tau == 63) {
#pragma unroll
                  for (int j = 0; j < 4; ++j) { gC[c8 + 2 * j] = __builtin_amdgcn_exp2f(totC[j].x); gC[c8 + 2 * j + 1] = __builtin_amdgcn_exp2f(totC[j].y); } }
#define PK8V(a) ((u32x4){pk2(a[0].x, a[0].y), pk2(a[1].x, a[1].y), pk2(a[2].x, a[2].y), pk2(a[3].x, a[3].y)})
              *(LAS u32x4*)(SLOT(0) + tau * LD16 + c8) = PK8V(at); *(LAS u32x4*)(SLOT(1) + tau * LD16 + c8) = PK8V(rt);
              *(LAS u32x4*)(SLOT(2) + tau * LD16 + c8) = PK8V(bt); *(LAS u32x4*)(SLOT(3) + tau * LD16 + c8) = PK8V(kt);
              *(LAS u32x4*)(SLOT(4) + tau * LD16 + c8) = PK8V(bh); *(LAS u32x4*)(SLOT(9) + tau * LD16 + c8) = PK8V(kh);
#undef PK8V
              *(LAS u32x4*)(SLOT(10) + tau * LD16 + c8) = cv;
              if (d == 0) *(u32x4*)(GATE + (size_t)row * DA + 64 * h + c8) = *(const LAS u32x4*)(SLOT(11) + pos * LD16 + c8);
              float bon = bon2.x + bon2.y;
              bon += SHX(bon, 1); bon += SHX(bon, 2); bon += SHX(bon, 4);
              BONUS[((size_t)d * M + row) * NH + h] = bon; }
            LBAR();
            }
            { int nitem = d == 0 ? item : item + G; const int nd = d ^ 1; if (nitem >= (M / 64) * NH) nitem = item; CA_ISSUE(nitem, nd); }
            for (int repB = 0; repB < (PROBE_SUB == 2 ? 2 : 1); ++repB) {
            { STG; bf16x8 aB[2], aA[2], aK[2];
#pragma unroll
              for (int ks = 0; ks < 2; ++ks) { aB[ks] = frag_rm(SLOT(2), m0, ks, fr, fq); aA[ks] = frag_rm(SLOT(0), m0, ks, fr, fq); aK[ks] = frag_rm(SLOT(3), m0, ks, fr, fq); }
#pragma unroll
              for (int nn = 0; nn < 2; ++nn) { const int n0 = 16 * (np + nn), n = n0 + fr; bf16x8 bA[2], bB[2], bK[2], bR[2];
#pragma unroll
                  for (int ks = 0; ks < 2; ++ks) { bA[ks] = frag_rm(SLOT(0), n0, ks, fr, fq); bB[ks] = frag_rm(SLOT(2), n0, ks, fr, fq); bK[ks] = frag_rm(SLOT(3), n0, ks, fr, fq); bR[ks] = frag_rm(SLOT(1), n0, ks, fr, fq); }
                  f32x4 p0 = mm2(aB, bA, F4Z), p1 = mm2(aA, bB, F4Z), p2 = mm2(aA, bK, F4Z), p3 = mm2(aB, bR, F4Z), p4 = mm2(aK, bR, F4Z), t0;
#pragma unroll
                  for (int r = 0; r < 4; ++r) { const int m = m0 + 4 * fq + r;
                      p0[r] = m < n ? p0[r] : 0.f; p1[r] = n < m ? p1[r] : 0.f; p2[r] = n < m ? p2[r] : 0.f; p3[r] = m <= n ? p3[r] : 0.f; p4[r] = m <= n ? p4[r] : 0.f;
                      t0[r] = p1[r] + (m == n ? 1.0f : 0.f); }
                  st_nat(SLOT(5), n0, m0, fr, fq, p0); st_nat(SLOT(6), n0, m0, fr, fq, p1); st_nat(SLOT(7), n0, m0, fr, fq, t0);
                  st_nat(SLOT(8), n0, m0, fr, fq, p2); st_nat(SLOT(11), n0, m0, fr, fq, p3); st_nat(SLOT(12), n0, m0, fr, fq, p4); } }
            LBAR();
#define MM1(a, b, c) __builtin_amdgcn_mfma_f32_16x16x32_bf16(a, b, c, 0, 0, 0)
            { STG; const int b = wave >> 2, bm0 = 32 * b + 16 * ((wave >> 1) & 1), bn0 = 32 * b + 16 * (wave & 1), oc = 32 * (1 - b) - 32 * b;
              const bf16x8 aT = frag_rm(SLOT(5), bm0, b, fr, fq), aR = frag_rm(SLOT(6), bm0, b, fr, fq), bR = frag_rm(SLOT(6), bn0, b, fr, fq), bT = frag_rm(SLOT(5), bn0, b, fr, fq);
              st_nat(SLOT(2), bn0, bm0, fr, fq, MM1(aT, bR, F4Z)); st_nat(SLOT(2), bn0, bm0 + oc, fr, fq, MM1(aR, bT, F4Z)); }
            LBAR();
#pragma unroll
            for (int kq = 1; kq <= 4; ++kq) {
                STG; const int b = wave >> 2, bm0 = 32 * b + 16 * ((wave >> 1) & 1), bn0 = 32 * b + 16 * (wave & 1), oc = 32 * (1 - b) - 32 * b;
                const int pin = (kq & 1) ? 2 : 3, pout = (kq & 1) ? 3 : 2, tin = (kq & 1) ? 7 : 13, tout = (kq & 1) ? 13 : 7;
                const bf16x8 aPT = frag_rm(SLOT(pin), bm0, 1 - b, fr, fq), bTn = frag_rm(SLOT(tin), bn0, b, fr, fq);
                st_nat(SLOT(tout), bn0, bm0, fr, fq, MM1(aPT, bTn, ld4bf(SLOT(tin) + (bn0 + fr) * LD16 + bm0 + 4 * fq)));
                if (kq < 4) { const bf16x8 aPR = frag_rm(SLOT(pin), bm0, b, fr, fq), bPR = frag_rm(SLOT(pin), bn0, b, fr, fq), bPT = frag_rm(SLOT(pin), bn0, 1 - b, fr, fq);
                    st_nat(SLOT(pout), bn0, bm0, fr, fq, MM1(aPT, bPR, F4Z));
                    st_nat(SLOT(pout), bn0, bm0 + oc, fr, fq, MM1(aPR, bPT, F4Z)); }
                LBAR();
            }
            { STG; if (wave < 4) { const int xm0 = 16 * ((wave >> 1) & 1), xn0 = 32 + 16 * (wave & 1);
                  const bf16x8 a = frag_rm(SLOT(6), xm0, 1, fr, fq), bb = frag_tr(SLOT(7), 32, xn0, fr, fq);
                  st_nat(SLOT(13), xn0, xm0, fr, fq, MM1(a, bb, F4Z)); } }
            LBAR();
            { STG; if (wave < 4) { const int tn0 = 32 + 16 * ((wave >> 1) & 1), tm0 = 16 * (wave & 1);
                  const bf16x8 a = frag_rm(SLOT(13), tn0, 0, fr, fq), bb = frag_rm(SLOT(7), tm0, 0, fr, fq);
                  st_nat(SLOT(7), tm0, tn0, fr, fq, MM1(a, bb, F4Z)); } }
            LBAR();
#undef MM1
            { STG; const int xt = wave, n0 = 16 * (xt & 3); bf16x8 b[2];
              if (xt < 4) { b[0] = frag_rm(SLOT(11), n0, 0, fr, fq); b[1] = frag_rm(SLOT(11), n0, 1, fr, fq); }
              else { b[0] = frag_tr(SLOT(4), 0, n0, fr, fq); b[1] = frag_tr(SLOT(4), 32, n0, fr, fq); }
#pragma unroll
              for (int mm = 0; mm < 4; ++mm) { bf16x8 a[2] = {frag_rm(SLOT(7), 16 * mm, 0, fr, fq), frag_rm(SLOT(7), 16 * mm, 1, fr, fq)};
                  st_nat(xt < 4 ? SLOT(5) : SLOT(6), n0, 16 * mm, fr, fq, mm2(a, b, F4Z)); } }
            LBAR();
            }
            for (int repC = 0; repC < (PROBE_SUB == 3 ? 2 : 1); ++repC) {
            { STG; bf16x8 aAt[2] = {frag_tr(SLOT(0), 0, m0, fr, fq), frag_tr(SLOT(0), 32, m0, fr, fq)}, aAk[2] = {frag_rm(SLOT(8), m0, 0, fr, fq), frag_rm(SLOT(8), m0, 1, fr, fq)};
              bf16* pyt = (bf16*)(F.ws + WS_PYT) + qi * 4096; bf16* qyt = (bf16*)(F.ws + WS_QYT) + qi * 4096; bf16* pst = (bf16*)(F.ws + WS_PST) + qi * 4096;
#pragma unroll
              for (int nn = 0; nn < 2; ++nn) { const int n0 = 16 * (np + nn), n = n0 + fr, mb = m0 + 4 * fq;
                  bf16x8 bRb[2] = {frag_rm(SLOT(5), n0, 0, fr, fq), frag_rm(SLOT(5), n0, 1, fr, fq)}, bBh[2] = {frag_rm(SLOT(6), n0, 0, fr, fq), frag_rm(SLOT(6), n0, 1, fr, fq)};
                  const f32x4 py = mm2(aAt, bRb, ld4bf(SLOT(1) + n * LD16 + mb)), qy = mm2(aAk, bRb, ld4bf(SLOT(12) + n * LD16 + mb));
                  f32x4 psi, qsi;
#pragma unroll
                  for (int r = 0; r < 4; ++r) { psi[r] = (mb + r == n) ? gC[n] : 0.f; qsi[r] = bf2f(SLOT(9)[(mb + r) * LD16 + n]); }
                  const f32x4 ps = mm2(aAt, bBh, psi), qs = mm2(aAk, bBh, qsi);
                  { const int fo = fm_off(n0, m0, fr, fq); *(u32x2*)(pyt + fo) = pk4(py); *(u32x2*)(qyt + fo) = pk4(qy); *(u32x2*)(pst + fo) = pk4(ps); }
                  st_nat(SLOT(2), n0, m0, fr, fq, qs); } }
            LBAR();
            { STG; bf16* nct = (bf16*)(F.ws + WS_NCT) + qi * 4096; bf16* vtg = (bf16*)(F.ws + WS_VTG) + qi * 4096;
              bf16x8 a[2] = {frag_rm(SLOT(2), m0, 0, fr, fq), frag_rm(SLOT(2), m0, 1, fr, fq)};
#pragma unroll
              for (int nn = 0; nn < 2; ++nn) { const int n0 = 16 * (np + nn); bf16x8 b[2] = {frag_tr(SLOT(10), 0, n0, fr, fq), frag_tr(SLOT(10), 32, n0, fr, fq)};
                  *(u32x2*)(nct + ((((n0 >> 4) * 4 + mt) * 64 + lane) << 2)) = pk4(mm2(a, b, F4Z));
                  if (nn == (mt >> 1)) { const bf16x8 bs = (mt & 1) ? b[1] : b[0]; *(bf16x8*)(vtg + ((((n0 >> 4) * 2 + (mt & 1)) * 64 + lane) << 3)) = bs; } } }
            LBAR();
            }
        }
    }
#undef STG
#undef CA_ISSUE
}

__device__ __forceinline__ void p_chunkB(Frame& F, int l) {
    PH_LOCALS(F); PH_LAYER(l);
    const int fr = lane & 15, fq = lane >> 4;
    LAS bf16* Sl = (LAS bf16*)(F.lds + wave * 2304);
    const bf16* PST = (const bf16*)(F.ws + WS_PST); const bf16* NCT = (const bf16*)(F.ws + WS_NCT); bf16* SC = (bf16*)(F.ws + WS_SC);
    for (int cp = bx; cp < 64; cp += G) {
        const int cslot = wave >> 2, chain = 2 * cp + cslot, vb = wave & 3, b = chain >> 5, h = (chain >> 1) & 15, d = chain & 1, cb = 64 + b * 64; constexpr int NC = 64;
        LAS bf16* AL = (LAS bf16*)(F.lds + 20480) + cslot * 3 * 4096;
        f32x4 S[4];
        { const float* src = F.in[I_STATE] + ((((size_t)b * NL + l) * 2 + d) * NH + h) * 4096 + (size_t)(16 * vb + fr) * 64 + 4 * fq;
#pragma unroll
          for (int T = 0; T < 4; ++T) S[T] = *(const f32x4*)(src + 16 * T); }
        bf16x8 Aq[8][2]; u32x2 Nq[8][4];
#define LB_QI(step) ((((size_t)(cb + (d ? NC - 1 - (step) : (step)))) * 16 + h) * 2 + d)
#define LB_LDA(u, step) do { const int st_ = (step) < NC ? (step) : NC - 1; const bf16* ps_ = PST + LB_QI(st_) * 4096 + vb * 1024 + lane * 8; Aq[u][0] = *(const bf16x8*)ps_; Aq[u][1] = *(const bf16x8*)(ps_ + 512); } while (0)
#define LB_LDN(u, step) do { const int st_ = (step) < NC ? (step) : NC - 1; const bf16* nc_ = NCT + LB_QI(st_) * 4096 + ((vb * 4 * 64 + lane) << 2); \
        _Pragma("unroll") for (int mt_ = 0; mt_ < 4; ++mt_) Nq[u][mt_] = *(const u32x2*)(nc_ + mt_ * 256); } while (0)
#pragma unroll
        for (int u = 0; u < 8; ++u) { LB_LDA(u, u); LB_LDN(u, u); }
        *(LAS bf16x8*)(AL + ((vb * 2 + 0) * 64 + lane) * 8) = Aq[0][0]; *(LAS bf16x8*)(AL + ((vb * 2 + 1) * 64 + lane) * 8) = Aq[0][1];
        LB_LDA(0, 8);
        for (int g = 0; g < NC; g += 8) {
#pragma unroll
            for (int u = 0; u < 8; ++u) {
                const int step = g + u; const size_t q = LB_QI(step); bf16* scg = SC + q * 4096;
#pragma unroll
                for (int T = 0; T < 4; ++T) { const u32x2 w = pk4(S[T]); *(LAS u32x2*)(Sl + fr * LD16 + 16 * T + 4 * fq) = w; *(u32x2*)(scg + fm_off(16 * vb, 16 * T, fr, fq)) = w; }
                { LAS bf16* nb_ = AL + ((step + 1) % 3) * 4096; const int u1 = (u + 1) & 7;
                  *(LAS bf16x8*)(nb_ + ((vb * 2 + 0) * 64 + lane) * 8) = Aq[u1][0]; *(LAS bf16x8*)(nb_ + ((vb * 2 + 1) * 64 + lane) * 8) = Aq[u1][1];
                  LB_LDA(u1, step + 9); }
                LBAR();
                const LAS bf16* cbuf = AL + (step % 3) * 4096 + lane * 8;
                const bf16x8 b0 = *(const LAS bf16x8*)(Sl + fr * LD16 + 8 * fq), b1 = *(const LAS bf16x8*)(Sl + fr * LD16 + 8 * fq + 32);
#pragma unroll
                for (int mt = 0; mt < 4; ++mt) { const u32x2 nw = Nq[u][mt];
                    f32x4 acc = (f32x4){__uint_as_float(nw.x << 16), __uint_as_float(nw.x & 0xffff0000u), __uint_as_float(nw.y << 16), __uint_as_float(nw.y & 0xffff0000u)};
                    acc = __builtin_amdgcn_mfma_f32_16x16x32_bf16(*(const LAS bf16x8*)(cbuf + (mt * 2) * 512), b0, acc, 0, 0, 0);
                    acc = __builtin_amdgcn_mfma_f32_16x16x32_bf16(*(const LAS bf16x8*)(cbuf + (mt * 2 + 1) * 512), b1, acc, 0, 0, 0);
                    S[mt] = acc; }
                LB_LDN(u, step + 8);
            }
        }
#undef LB_LDA
#undef LB_LDN
#undef LB_QI
        LBAR();
    }
    const int w0 = (G > 64) ? (bx - 64) * NWAVES + wave : bx * NWAVES + wave, wst = (G > 64) ? (G - 64) * NWAVES : G * NWAVES;
    if (G > 64 && bx < 64) return;
    for (int t = w0; t < 2048; t += wst) {
        const int chain = t >> 2, vb = t & 3, b = chain >> 5, h = (chain >> 1) & 15, d = chain & 1, cb = b * 4; constexpr int NC = 4;
        f32x4 S[4];
#pragma unroll
        for (int T = 0; T < 4; ++T) S[T] = (f32x4){0.f, 0.f, 0.f, 0.f};
        bf16x8 Apf[4][8]; u32x2 Npf[4][4];
#define CB_QI(step) ((((size_t)(cb + (d ? NC - 1 - (step) : (step)))) * 16 + h) * 2 + d)
#define CB_LOAD(u, step) do { const size_t q_ = CB_QI(step); const bf16* ps_ = PST + q_ * 4096 + lane * 8; const bf16* nc_ = NCT + q_ * 4096 + ((vb * 4 * 64 + lane) << 2); \
        _Pragma("unroll") for (int mt_ = 0; mt_ < 4; ++mt_) { Apf[u][2 * mt_] = *(const bf16x8*)(ps_ + mt_ * 1024); Apf[u][2 * mt_ + 1] = *(const bf16x8*)(ps_ + mt_ * 1024 + 512); Npf[u][mt_] = *(const u32x2*)(nc_ + mt_ * 256); } } while (0)
        CB_LOAD(0, 0); CB_LOAD(1, 1); CB_LOAD(2, 2); CB_LOAD(3, 3);
#pragma unroll
        for (int u = 0; u < 4; ++u) {
            const int step = u; const size_t q = CB_QI(step); bf16* scg = SC + q * 4096;
            asm volatile("" ::: "memory");
#pragma unroll
            for (int T = 0; T < 4; ++T) { const u32x2 w = pk4(S[T]); *(LAS u32x2*)(Sl + fr * LD16 + 16 * T + 4 * fq) = w; *(u32x2*)(scg + fm_off(16 * vb, 16 * T, fr, fq)) = w; }
            asm volatile("s_waitcnt lgkmcnt(0)" ::: "memory");
            const bf16x8 b0 = *(const LAS bf16x8*)(Sl + fr * LD16 + 8 * fq), b1 = *(const LAS bf16x8*)(Sl + fr * LD16 + 8 * fq + 32);
#pragma unroll
            for (int mt = 0; mt < 4; ++mt) { const u32x2 nw = Npf[u][mt];
                f32x4 acc = (f32x4){__uint_as_float(nw.x << 16), __uint_as_float(nw.x & 0xffff0000u), __uint_as_float(nw.y << 16), __uint_as_float(nw.y & 0xffff0000u)};
                acc = __builtin_amdgcn_mfma_f32_16x16x32_bf16(Apf[u][2 * mt], b0, acc, 0, 0, 0);
                acc = __builtin_amdgcn_mfma_f32_16x16x32_bf16(Apf[u][2 * mt + 1], b1, acc, 0, 0, 0);
                S[mt] = acc; }
            asm volatile("s_waitcnt lgkmcnt(0)" ::: "memory");
        }
#undef CB_LOAD
#undef CB_QI
        { float* dst = F.out + (size_t)M * D + ((((size_t)b * NL + l) * 2 + d) * NH + h) * 4096 + (size_t)(16 * vb + fr) * 64 + 4 * fq;
#pragma unroll
          for (int T = 0; T < 4; ++T) *(f32x4*)(dst + 16 * T) = S[T]; }
    }
}

__device__ __forceinline__ void p_chunkC(Frame& F, int l) {
    PH_LOCALS(F); PH_LAYER(l);
    LAS unsigned char* lds = F.lds;
    const int fr = lane & 15, fq = lane >> 4, d = wave >> 2, nb = wave & 3;
    const bf16* PS = (const bf16*)(F.ws + WS_PS); const bf16* GATE = (const bf16*)(F.ws + WS_GATE); const float* BONUS = (const float*)(F.ws + WS_BONUS);
    bf16* O = (bf16*)(F.ws + WS_O);
    constexpr int NIT = (M / 64) * NH;
    f32x4 gnw[4], gnb[4]; int hcur = -1;
    bf16x8 fa0[4][4], fb0[4]; u32x4 pv0, pg0; float pb00, pb01;
#define CC_ISSUE(item_, fa, fb, pv, pg, pb0, pb1) do { const int ci_ = (item_) >> 4, h_ = (item_) & 15; const size_t qi_ = ((size_t)ci_ * 16 + h_) * 2 + d; \
        const bf16* sc_ = (const bf16*)(F.ws + WS_SC) + qi_ * 4096 + lane * 8; const bf16* vt_ = (const bf16*)(F.ws + WS_VTG) + qi_ * 4096 + lane * 8; \
        const bf16* py_ = (const bf16*)(F.ws + WS_PYT) + qi_ * 4096 + nb * 1024 + lane * 8; const bf16* qy_ = (const bf16*)(F.ws + WS_QYT) + qi_ * 4096 + nb * 1024 + lane * 8; \
        fb[0] = *(const bf16x8*)py_; fb[1] = *(const bf16x8*)(py_ + 512); fb[2] = *(const bf16x8*)qy_; fb[3] = *(const bf16x8*)(qy_ + 512); \
        _Pragma("unroll") for (int vt4_ = 0; vt4_ < 4; ++vt4_) { fa[vt4_][0] = *(const bf16x8*)(sc_ + vt4_ * 1024); fa[vt4_][1] = *(const bf16x8*)(sc_ + vt4_ * 1024 + 512); fa[vt4_][2] = *(const bf16x8*)(vt_ + vt4_ * 1024); fa[vt4_][3] = *(const bf16x8*)(vt_ + vt4_ * 1024 + 512); } \
        const int row_ = ci_ * 64 + (tid >> 3), chn_ = 64 * h_ + (tid & 7) * 8; \
        pv = *(const u32x4*)(PS + (size_t)row_ * CSH + 2 * DA + chn_); pg = *(const u32x4*)(GATE + (size_t)row_ * DA + chn_); pb0 = BONUS[(size_t)row_ * NH + h_]; pb1 = BONUS[((size_t)M + row_) * NH + h_]; } while (0)
#define CC_BODY(item_, fa, fb, pv, pg, pb0, pb1, next_) do { const int ci = (item_) >> 4, h = (item_) & 15, R0 = ci * 64; \
        if (h != hcur) { hcur = h; _Pragma("unroll") for (int vtile = 0; vtile < 4; ++vtile) { gnw[vtile] = *(const f32x4*)(F.in[I_GNW] + (size_t)l * DA + 64 * h + 16 * vtile + 4 * fq); gnb[vtile] = *(const f32x4*)(F.in[I_GNB] + (size_t)l * DA + 64 * h + 16 * vtile + 4 * fq); } } \
        f32x4 acc[4]; float s = 0.f; \
        _Pragma("unroll") for (int vtile = 0; vtile < 4; ++vtile) { f32x4 a = F4Z; \
            _Pragma("unroll") for (int ks = 0; ks < 4; ++ks) a = __builtin_amdgcn_mfma_f32_16x16x32_bf16(fa[vtile][ks], fb[ks], a, 0, 0, 0); \
            acc[vtile] = a; s += (a[0] + a[1]) + (a[2] + a[3]); } \
        const u32x4 cv = pv, cgt = pg; const float bon = pb0 + pb1; \
        if ((next_) < NIT) CC_ISSUE((next_), fa, fb, pv, pg, pb0, pb1); \
        s += SHX(s, 16); s += SHX(s, 32); \
        const float mean = s * (1.0f / 64.0f); float qv = 0.f; \
        _Pragma("unroll") for (int vtile = 0; vtile < 4; ++vtile) { acc[vtile] = acc[vtile] - mean; const f32x4 a = acc[vtile]; qv += (a[0] * a[0] + a[1] * a[1]) + (a[2] * a[2] + a[3] * a[3]); } \
        qv += SHX(qv, 16); qv += SHX(qv, 32); \
        const float rstd = 1.0f / sqrtf(qv * (1.0f / 64.0f) + GN_EPS); \
        const int tau = 16 * nb + fr, pos = d ? 63 - tau : tau; \
        LAS float* Yd = (LAS float*)(lds + d * 17408); \
        _Pragma("unroll") for (int vtile = 0; vtile < 4; ++vtile) { const int v0 = 16 * vtile + 4 * fq; \
            *(LAS f32x4*)(Yd + pos * LD32 + v0) = acc[vtile] * rstd * gnw[vtile] + gnb[vtile]; } \
        LBAR(); \
        { const int pos2 = tid >> 3, c8 = (tid & 7) * 8, row = R0 + pos2, chn = 64 * h + c8; \
          const LAS float* Y0 = (const LAS float*)lds; const LAS float* Y1 = (const LAS float*)(lds + 17408); \
          float v[8], gt[8], o[8]; unpack8(cv, v); unpack8(cgt, gt); \
          const f32x4 y00 = *(const LAS f32x4*)(Y0 + pos2 * LD32 + c8), y01 = *(const LAS f32x4*)(Y0 + pos2 * LD32 + c8 + 4), y10 = *(const LAS f32x4*)(Y1 + pos2 * LD32 + c8), y11 = *(const LAS f32x4*)(Y1 + pos2 * LD32 + c8 + 4); \
          _Pragma("unroll") for (int j = 0; j < 4; ++j) { o[j] = (y00[j] + y10[j] + bon * v[j]) * gt[j]; o[4 + j] = (y01[j] + y11[j] + bon * v[4 + j]) * gt[4 + j]; } \
          *(u32x4*)(O + (size_t)row * D + chn) = pack8(o); } \
        LBAR(); } while (0)
    if (bx < NIT) CC_ISSUE(bx, fa0, fb0, pv0, pg0, pb00, pb01);
    for (int item = bx; item < NIT; item += G) {
        CC_BODY(item, fa0, fb0, pv0, pg0, pb00, pb01, item + G);
    }
#undef CC_BODY
#undef CC_ISSUE
}

__device__ __forceinline__ void p_final(Frame& F) {
    PH_LOCALS(F);
    const int gw = bx * NWAVES + wave, NGW = G * NWAVES;
    const float* fg = F.in[I_FNG];
    f32x4 fgv[8];
#pragma unroll
    for (int j = 0; j < 8; ++j) fgv[j] = *(const f32x4*)(fg + 4 * lane + 256 * j);
    for (int row = gw; row < M; row += NGW) {
        float* xr = F.out + (size_t)row * D;
        f32x4 v[8]; float ss = 0.f;
#pragma unroll
        for (int j = 0; j < 8; ++j) { v[j] = *(const f32x4*)(xr + 4 * lane + 256 * j); ss += (v[j].x * v[j].x + v[j].y * v[j].y) + (v[j].z * v[j].z + v[j].w * v[j].w); }
        WAVE_SUM(ss); const float rstd = 1.0f / sqrtf(ss * (1.0f / D) + RMS_EPS);
#pragma unroll
        for (int j = 0; j < 8; ++j) { const int c = 4 * lane + 256 * j; *(f32x4*)(xr + c) = v[j] * rstd * fgv[j]; }
    }
}

constexpr int PH_PER_LAYER = 10, N_PHASES = 2 + NL * PH_PER_LAYER;
__global__ void __launch_bounds__(NWAVES * 64, 2) hymba_fwd(Args args) {
    extern __shared__ __attribute__((aligned(16))) unsigned char lds[];
    Frame F;
    F.lds = (LAS unsigned char*)lds;
    F.tid = threadIdx.x; F.lane = F.tid & 63; F.wave = __builtin_amdgcn_readfirstlane(F.tid >> 6);
    F.G = gridDim.x; F.bx = blockIdx.x;
    F.in = args.in; F.out = args.out; F.ws = args.ws;
    for (int u = F.tid; u < (LDS_BYTES - LDSCTL_OFF) / 4; u += NWAVES * 64) ((LAS unsigned*)(F.lds + LDSCTL_OFF))[u] = 0u;
    __syncthreads();
    volatile LAS unsigned* MISC = (volatile LAS unsigned*)(F.lds + MISC_OFF);
    unsigned* barw = (unsigned*)(F.ws + WS_CTL) + CW_BAR;
    XcdBarrier bar; bar.bar = barw; bar.x = 0; bar.st = nullptr;
    if (MK_N_LAUNCHES == 1) bar = xcd_barrier_post(barw, MISC + 8);
    const int lo = args.ph_lo, hi = args.ph_hi;
#define IN(k) (lo <= (k) && (k) < hi)
#define SEAM(k) do { if (MK_N_LAUNCHES == 1 && IN(k) && IN((k) + 1)) xcd_barrier(bar); } while (0)

    for (int rep = 0; rep < ((PROBE_DUP == 30) ? 2 : 1); ++rep)
    if (IN(0)) { p0_prologue(F); __syncthreads(); } SEAM(0);
    bf16* H = (bf16*)(F.ws + WS_H); bf16* O = (bf16*)(F.ws + WS_O); bf16* P = (bf16*)(F.ws + WS_P); bf16* HID = (bf16*)(F.ws + WS_HID);
    const float* mod = (const float*)(F.ws + WS_MOD);
    for (int l = 0; l < NL; ++l) {
        const int pb = 1 + l * PH_PER_LAYER;
        const float* xlo = l == 0 ? F.in[I_XP] : F.out; const float* xhi = l == 0 ? F.in[I_XS] : F.out + (size_t)MCTX * D;
        float* dummy = (float*)(F.ws + WS_P);
        for (int rep = 0; rep < ((PROBE_DUP == 7) ? 2 : 1); ++rep)
        if (IN(pb + 0)) { p_adaln(F, l, 0, xlo, xhi); } SEAM(pb + 0);
        for (int rep = 0; rep < ((PROBE_DUP == 1 || PROBE_DUP == 20) ? 2 : 1); ++rep)
        if (IN(pb + 1)) { pg8::Gemm g{H, (const bf16*)(F.ws + WS_WIN + l * SZ_WIN), M, PINP, D}; pg8::StaticOrder S; { int cb_ = F.bx, cg_ = F.G; asm volatile("" : "+s"(cb_), "+s"(cg_)); S.init(M, PINP, cg_, cb_, D); }
            EpiP E{P, PINP, CSH}; pg8::gemm_phase<EpiP, pg8::StaticOrder, true, true>(F.lds, g, S, E, F.wave); } SEAM(pb + 1);
        for (int rep = 0; rep < ((PROBE_DUP == 2) ? 2 : 1); ++rep)
        if (IN(pb + 2)) { p_shift(F, l); } SEAM(pb + 2);
        if (IN(pb + 3)) { for (int rep = 0; rep < ((PROBE_DUP == 3) ? 2 : 1); ++rep) p_chunkA(F, l); } SEAM(pb + 3);
        for (int rep = 0; rep < ((PROBE_DUP == 4) ? 2 : 1); ++rep)
        if (IN(pb + 4)) { p_chunkB(F, l);
            for (int rep = 0; rep < ((PROBE_DUP == 13) ? 2 : 1); ++rep) p_gmlp(F, l, F.G > 64 ? (F.bx >= 64 ? F.bx - 64 : -1) : F.bx, F.G > 64 ? F.G - 64 : F.G); } SEAM(pb + 4);
        for (int rep = 0; rep < ((PROBE_DUP == 5) ? 2 : 1); ++rep)
        if (IN(pb + 5)) { p_chunkC(F, l); } SEAM(pb + 5);
        if ((PROBE_DUP == 6 || PROBE_DUP == 20) && IN(pb + 6)) { pg8::Gemm g{O, (const bf16*)(F.ws + WS_WOUT + l * SZ_WOUT), M, D, D}; pg8::StaticOrder S; { int cb_ = F.bx, cg_ = F.G; asm volatile("" : "+s"(cb_), "+s"(cg_)); S.init(M, D, cg_, cb_, D); }
            EpiRes E{xlo, xhi, dummy, mod + (size_t)l * 5 * MODW, 2 * D}; pg8::gemm_phase<EpiRes, pg8::StaticOrder, true, true>(F.lds, g, S, E, F.wave); }
        if (IN(pb + 6)) { pg8::Gemm g{O, (const bf16*)(F.ws + WS_WOUT + l * SZ_WOUT), M, D, D}; pg8::FullRoundsOrder S; pg8::TailHalfOrder S2; { int cb_ = F.bx, cg_ = F.G; asm volatile("" : "+s"(cb_), "+s"(cg_)); S.init(M, D, cg_, cb_, D); S2.init(M, D, cg_, cb_, D); }
            EpiRes E{xlo, xhi, F.out, mod + (size_t)l * 5 * MODW, 2 * D}; pg8::gemm_phase<EpiRes, pg8::FullRoundsOrder, true, true>(F.lds, g, S, E, F.wave);
            pg8::gemm_phase<EpiRes, pg8::TailHalfOrder, true, true, true>(F.lds, g, S2, E, F.wave); } SEAM(pb + 6);
        for (int rep = 0; rep < ((PROBE_DUP == 7) ? 2 : 1); ++rep)
        if (IN(pb + 7)) { p_adaln(F, l, 1, F.out, F.out + (size_t)MCTX * D); } SEAM(pb + 7);
        for (int rep = 0; rep < ((PROBE_DUP == 8 || PROBE_DUP == 20) ? 2 : 1); ++rep)
        if (IN(pb + 8)) { pg8::Gemm g{H, (const bf16*)(F.ws + WS_WGU + l * SZ_WGU), M, NGU, D}; pg8::StaticOrder S; { int cb_ = F.bx, cg_ = F.G; asm volatile("" : "+s"(cb_), "+s"(cg_)); S.init(M, NGU, cg_, cb_, D); }
            EpiSwi E{HID, DFF}; pg8::gemm_phase<EpiSwi, pg8::StaticOrder, true, true>(F.lds, g, S, E, F.wave); } SEAM(pb + 8);
        if ((PROBE_DUP == 9 || PROBE_DUP == 20) && IN(pb + 9)) { pg8::Gemm g{HID, (const bf16*)(F.ws + WS_WD + l * SZ_WD), M, D, DFF}; pg8::StaticOrder S; { int cb_ = F.bx, cg_ = F.G; asm volatile("" : "+s"(cb_), "+s"(cg_)); S.init(M, D, cg_, cb_, DFF); }
            EpiRes E{F.out, F.out + (size_t)MCTX * D, dummy, mod + (size_t)l * 5 * MODW, 5 * D}; pg8::gemm_phase<EpiRes, pg8::StaticOrder, true, true>(F.lds, g, S, E, F.wave); }
        if (IN(pb + 9)) { pg8::Gemm g{HID, (const bf16*)(F.ws + WS_WD + l * SZ_WD), M, D, DFF}; pg8::FullRoundsOrder S; pg8::TailHalfOrder S2; { int cb_ = F.bx, cg_ = F.G; asm volatile("" : "+s"(cb_), "+s"(cg_)); S.init(M, D, cg_, cb_, DFF); S2.init(M, D, cg_, cb_, DFF); }
            EpiRes E{F.out, F.out + (size_t)MCTX * D, F.out, mod + (size_t)l * 5 * MODW, 5 * D}; pg8::gemm_phase<EpiRes, pg8::FullRoundsOrder, true, true>(F.lds, g, S, E, F.wave);
            pg8::gemm_phase<EpiRes, pg8::TailHalfOrder, true, true, true>(F.lds, g, S2, E, F.wave); } SEAM(pb + 9);
    }
    if (IN(N_PHASES - 1)) { p_final(F); }
#undef IN
#undef SEAM
}

extern "C" void kernel_launch(void* const* d_in, const int* in_sizes, int n_in, void* d_out, int out_size, void* d_ws, size_t ws_size, hipStream_t stream) {
    static int grid = 0;
    if (grid == 0) {
        if (n_in != 30 || ws_size < WS_END) { fprintf(stderr, "kernel_launch: need 30 inputs and >= %zu bytes of workspace; got n_in %d, ws %zu\n", (size_t)WS_END, n_in, ws_size); grid = -1; return; }
        int dev = 0, cus = 0, per_cu = 0;
        if (hipGetDevice(&dev) != hipSuccess || hipDeviceGetAttribute(&cus, hipDeviceAttributeMultiprocessorCount, dev) != hipSuccess) { grid = -1; return; }
        if (hipFuncSetAttribute((const void*)hymba_fwd, hipFuncAttributeMaxDynamicSharedMemorySize, LDS_BYTES) != hipSuccess) { fprintf(stderr, "kernel_launch: hipFuncSetAttribute failed\n"); grid = -1; return; }
        if (hipOccupancyMaxActiveBlocksPerMultiprocessor(&per_cu, (const void*)hymba_fwd, NWAVES * 64, LDS_BYTES) != hipSuccess || per_cu < 1)
            fprintf(stderr, "kernel_launch: note: occupancy query reports %d workgroups per CU\n", per_cu);
        (void)hipGetLastError();
        grid = cus;
    }
    if (grid < 0) return;
    if (hipMemsetAsync((char*)d_ws + WS_CTL, 0, CTL_ZERO_BYTES, stream) != hipSuccess) return;
    Args a{};
    for (int i = 0; i < 30; ++i) a.in[i] = (const float*)d_in[i];
    a.out = (float*)d_out; a.ws = (unsigned char*)d_ws; a.pad = 0;
    if (MK_N_LAUNCHES == 1) {
        a.ph_lo = 0; a.ph_hi = N_PHASES; a.li = 0;
        hipLaunchKernelGGL(hymba_fwd, dim3(grid), dim3(NWAVES * 64), LDS_BYTES, stream, a);
    } else {
        for (int k = 0; k < N_PHASES; ++k) { a.ph_lo = k; a.ph_hi = k + 1; a.li = k;
            hipLaunchKernelGGL(hymba_fwd, dim3(grid), dim3(NWAVES * 64), LDS_BYTES, stream, a); }
    }
}
```

```cpp
#include <hip/hip_runtime.h>
#include <cstdio>
#include <cstdint>

#ifndef PROBE_DUP
#define PROBE_DUP -1
#endif
#ifndef PROBE_SUB
#define PROBE_SUB 0
#endif
#ifndef MK_N_LAUNCHES
#define MK_N_LAUNCHES 1
#endif

namespace pg8 {
#define PG8_LAS __attribute__((address_space(3)))
typedef unsigned short bf16_t;
typedef short bf16x8 __attribute__((ext_vector_type(8)));
typedef float f32x4 __attribute__((ext_vector_type(4)));
typedef unsigned u32x4 __attribute__((ext_vector_type(4)));
constexpr int BM = 256, BK = 64, HALF = 128, HTB = HALF * BK * 2  , STAGE_BYTES = 8 * HTB, NXCD = 8, WGM = 8;

__host__ __device__ __forceinline__ int lds_byte(int r, int c) { const int st = (r >> 4) * 2 + (c >> 5), rr = r & 15, cc = c & 31, ob = rr * 64 + cc * 2; return st * 1024 + (ob ^ (((ob >> 9) & 1) << 5)); }
__host__ __device__ __forceinline__ void stage_rc(int b, int& R, int& C) { const int st = b / 1024, sb = b % 1024, swz = sb ^ (((sb >> 9) & 1) << 5); R = (st >> 1) * 16 + swz / 64; C = (st & 1) * 32 + (swz % 64) / 2; }
__host__ __device__ __forceinline__ int perm32(int rho) { const int n = rho >> 4, i = rho & 15; return 8 * (i >> 2) + 4 * n + (i & 3); }

struct Unit { int pm, pn, k0, nk, bh; };
struct Gemm { const bf16_t* A; const bf16_t* Bt; int M, N, K; };

struct StaticOrder {
    int nM, nN, nwg, G, c, nkt, full, rem;
    __host__ __device__ void init(int M, int N, int G_, int c_, int K_) { nM = M / BM; nN = N / BM; nwg = nM * nN; G = G_; c = c_; nkt = K_ / BK; full = nwg / G; rem = nwg - full * G; }
    __host__ __device__ bool next(int i, Unit& u) const {
        const long L = (long)i * G + c; if (L >= nwg) return false;
        int wgid = (int)L; { const int q = nwg / NXCD, r = nwg % NXCD, xcd = wgid % NXCD, off = wgid / NXCD; wgid = (xcd < r ? xcd * (q + 1) : r * (q + 1) + (xcd - r) * q) + off; }
        const int nig = WGM * nN, gid = wgid / nig, fm = gid * WGM, gsz = (nM - fm) < WGM ? (nM - fm) : WGM;
        u.pm = fm + ((wgid % nig) % gsz); u.pn = (wgid % nig) / gsz; u.k0 = 0; u.nk = nkt; u.bh = -1;
#if defined(__HIP_DEVICE_COMPILE__)
        u.pm = __builtin_amdgcn_readfirstlane(u.pm); u.pn = __builtin_amdgcn_readfirstlane(u.pn);
#endif
        return true;
    }
    __device__ __forceinline__ void a_ready(const Unit&) const {}
    __device__ __forceinline__ void done(const Unit&) const {}
};
struct FullRoundsOrder : StaticOrder {
    __host__ __device__ bool split() const { return rem > 0 && 2 * rem <= G; }
    __host__ __device__ bool next(int i, Unit& u) const { if (split() && i >= full) return false; return StaticOrder::next(i, u); }
};
struct TailHalfOrder : StaticOrder {
    __host__ __device__ bool next(int i, Unit& u) const {
        if (!(rem > 0 && 2 * rem <= G) || i > 0 || c >= 2 * rem) return false;
        StaticOrder t = *this; t.c = c >> 1; if (!t.StaticOrder::next(full, u)) return false;
        u.bh = c & 1; return true;
    }
};

__device__ __forceinline__ unsigned cvt_pk_bf16(float lo, float hi) { unsigned r; asm volatile("v_cvt_pk_bf16_f32 %0, %1, %2" : "=v"(r) : "v"(lo), "v"(hi)); return r; }

template <class Epi, class Sched, bool ALIGN_EPI = false, bool SP2 = false, bool HALFB = false>
__device__ __forceinline__ void gemm_phase(PG8_LAS unsigned char* lds, const Gemm g, const Sched& S, const Epi& E, int wid) {
    asm volatile("" : "+s"(wid)); int lane; asm volatile("v_mbcnt_lo_u32_b32 %0, -1, 0\n\tv_mbcnt_hi_u32_b32 %0, -1, %0" : "=v"(lane));
    const int tid = wid * 64 + lane, wr = wid >> 2, wc = wid & 3, fr = lane & 15, fq = lane >> 4;
    const int K = g.K;
    unsigned voffA[2], voffB[2];
#pragma unroll
    for (int i = 0; i < 2; ++i) { int R, C; stage_rc(tid * 16 + i * 8192, R, C); const int Rb = Epi::PERM ? ((R & ~31) + perm32(R & 31)) : R;
        voffA[i] = (unsigned)(R * K + C) * 2u; voffB[i] = (unsigned)(Rb * K + C) * 2u; }
    const size_t kstep = (size_t)(BK * 2);
    const size_t hstep = (size_t)HALF * K * 2;
    const size_t tstep = 2 * hstep;
    const size_t bhs = HALFB ? 0 : hstep;
    const unsigned ldsw = (unsigned)wid * 1024u;
    const int aoff = lds_byte(wr * 64 + fr, fq * 8), boff = lds_byte(wc * 32 + fr, fq * 8);
#define PG8_SA(b, h) (((b) * 2 + (h)) * HTB)
#define PG8_SB(b, h) ((4 + (b) * 2 + (h)) * HTB)
#define PG8_STAGE(bufoff, gbase, voff) do { _Pragma("unroll") for (int _i = 0; _i < 2; ++_i) \
        __builtin_amdgcn_global_load_lds((const unsigned*)((const char*)(gbase) + (voff)[_i]), (PG8_LAS unsigned*)(lds + (bufoff) + ldsw + _i * 8192), 16, 0, 0); } while (0)
#define PG8_LDA(dst, b, h) do { _Pragma("unroll") for (int m = 0; m < 4; ++m) _Pragma("unroll") for (int k = 0; k < 2; ++k) dst[m][k] = *(const PG8_LAS bf16x8*)(lds + PG8_SA(b, h) + aoff + m * 2048 + k * 1024); } while (0)
#define PG8_LDB(dst, b, h) do { _Pragma("unroll") for (int n = 0; n < 2; ++n) _Pragma("unroll") for (int k = 0; k < 2; ++k) dst[n][k] = *(const PG8_LAS bf16x8*)(lds + PG8_SB(b, h) + boff + n * 2048 + k * 1024); } while (0)
#define PG8_MMA(ai, bj, At, Bt) do { __builtin_amdgcn_s_setprio(1); _Pragma("unroll") for (int m = 0; m < 4; ++m) _Pragma("unroll") for (int n = 0; n < 2; ++n) _Pragma("unroll") for (int k = 0; k < 2; ++k) \
        acc[ai][bj][m][n] = __builtin_amdgcn_mfma_f32_16x16x32_bf16(Bt[n][k], At[m][k], acc[ai][bj][m][n], 0, 0, 0); __builtin_amdgcn_s_setprio(0); } while (0)
#define PG8_WAIT_V(n) asm volatile("s_waitcnt vmcnt(" #n ")" ::: "memory")
#define PG8_WAIT_L(n) asm volatile("s_waitcnt lgkmcnt(" #n ")" ::: "memory")
#define PG8_BAR __builtin_amdgcn_s_barrier()
#define PG8_SCHED __builtin_amdgcn_sched_barrier(0)
    Unit cur, nxt; int ui = 0;
    if (!S.next(0, cur)) return;
    f32x4 acc[2][2][4][2];
#pragma unroll
    for (int a = 0; a < 2; ++a)
#pragma unroll
        for (int b = 0; b < 2; ++b)
#pragma unroll
            for (int m = 0; m < 4; ++m)
#pragma unroll
                for (int n = 0; n < 2; ++n) acc[a][b][m][n] = (f32x4){0.f, 0.f, 0.f, 0.f};
    bf16x8 At[4][2], B0[2][2], B1[2][2];
    const char* cA = (const char*)g.A + (size_t)cur.pm * tstep + (size_t)cur.k0 * kstep; const char* cB = (const char*)g.Bt + (size_t)cur.pn * tstep + (size_t)cur.k0 * kstep + (HALFB ? (size_t)cur.bh * hstep : 0);
    S.a_ready(cur);
    if constexpr (SP2) {
        PG8_STAGE(PG8_SB(0, 0), cB, voffB); PG8_STAGE(PG8_SB(0, 1), cB + bhs, voffB); PG8_STAGE(PG8_SA(0, 0), cA, voffA); PG8_STAGE(PG8_SA(0, 1), cA + hstep, voffA);
        if (wr == 1) PG8_BAR;
        PG8_WAIT_V(2); PG8_BAR;
        PG8_STAGE(PG8_SB(1, 0), cB + kstep, voffB); PG8_STAGE(PG8_SA(1, 0), cA + kstep, voffA); PG8_STAGE(PG8_SB(1, 1), cB + bhs + kstep, voffB);
        PG8_WAIT_V(6); PG8_BAR;
    } else {
        PG8_STAGE(PG8_SB(0, 0), cB, voffB); PG8_STAGE(PG8_SA(0, 0), cA, voffA); PG8_STAGE(PG8_SB(0, 1), cB + bhs, voffB); PG8_STAGE(PG8_SA(0, 1), cA + hstep, voffA);
        if (wr == 1) PG8_BAR;
        PG8_WAIT_V(4); PG8_BAR;
        PG8_STAGE(PG8_SB(1, 0), cB + kstep, voffB); PG8_STAGE(PG8_SA(1, 0), cA + kstep, voffA); PG8_STAGE(PG8_SB(1, 1), cB + bhs + kstep, voffB);
        PG8_WAIT_V(6); PG8_BAR;
    }
    for (;;) {
        const bool has_next = S.next(ui + 1, nxt);
        const char* nA = has_next ? (const char*)g.A + (size_t)nxt.pm * tstep + (size_t)nxt.k0 * kstep : cA; const char* nB = has_next ? (const char*)g.Bt + (size_t)nxt.pn * tstep + (size_t)nxt.k0 * kstep + (HALFB ? (size_t)nxt.bh * hstep : 0) : cB;
        const int nt = cur.nk;
        for (int t = 0; t < nt; t += 2) {
            const bool last = (t == nt - 2);
            const char* a1 = cA + (size_t)(t + 1) * kstep;
            const char* a2 = last ? nA : cA + (size_t)(t + 2) * kstep; const char* b2 = last ? nB : cB + (size_t)(t + 2) * kstep;
            const char* a3 = a2 + kstep; const char* b3 = b2 + kstep;
            if (last && has_next) S.a_ready(nxt);
            if constexpr (SP2) {
            PG8_LDB(B0, 0, 0); if constexpr (!HALFB) PG8_LDB(B1, 0, 1); PG8_SCHED; PG8_LDA(At, 0, 0); PG8_STAGE(PG8_SA(1, 1), a1 + hstep, voffA);
            PG8_WAIT_V(8); PG8_WAIT_L(0); PG8_BAR; PG8_MMA(0, 0, At, B0); if constexpr (!HALFB) PG8_MMA(0, 1, At, B1); PG8_BAR; PG8_SCHED;
            PG8_LDA(At, 0, 1); PG8_STAGE(PG8_SB(0, 0), b2, voffB); PG8_STAGE(PG8_SB(0, 1), b2 + bhs, voffB); PG8_STAGE(PG8_SA(0, 0), a2, voffA);
            PG8_WAIT_V(8); PG8_WAIT_L(0); PG8_BAR; PG8_MMA(1, 0, At, B0); if constexpr (!HALFB) PG8_MMA(1, 1, At, B1); PG8_BAR; PG8_SCHED;
            PG8_LDB(B0, 1, 0); if constexpr (!HALFB) PG8_LDB(B1, 1, 1); PG8_SCHED; PG8_LDA(At, 1, 0); PG8_STAGE(PG8_SA(0, 1), a2 + hstep, voffA);
            PG8_WAIT_V(8); PG8_WAIT_L(0); PG8_BAR; PG8_MMA(0, 0, At, B0); if constexpr (!HALFB) PG8_MMA(0, 1, At, B1); PG8_BAR; PG8_SCHED;
            PG8_LDA(At, 1, 1); PG8_STAGE(PG8_SB(1, 0), b3, voffB); PG8_STAGE(PG8_SB(1, 1), b3 + bhs, voffB); PG8_STAGE(PG8_SA(1, 0), a3, voffA);
            PG8_WAIT_V(8); PG8_WAIT_L(0); PG8_BAR; PG8_MMA(1, 0, At, B0); if constexpr (!HALFB) PG8_MMA(1, 1, At, B1); PG8_BAR; PG8_SCHED;
            } else {
            PG8_LDB(B0, 0, 0); PG8_SCHED; PG8_LDA(At, 0, 0); PG8_STAGE(PG8_SA(1, 1), a1 + hstep, voffA);
            PG8_WAIT_L(8); PG8_BAR; PG8_WAIT_L(0); PG8_MMA(0, 0, At, B0); PG8_BAR; PG8_SCHED;
            PG8_LDB(B1, 0, 1); PG8_STAGE(PG8_SB(0, 0), b2, voffB);
            PG8_BAR; PG8_WAIT_L(0); PG8_MMA(0, 1, At, B1); PG8_BAR;
            PG8_LDA(At, 0, 1); PG8_STAGE(PG8_SA(0, 0), a2, voffA);
            PG8_BAR; PG8_WAIT_L(0); PG8_MMA(1, 0, At, B0); PG8_BAR; PG8_SCHED;
            PG8_STAGE(PG8_SB(0, 1), b2 + bhs, voffB);
            PG8_WAIT_V(6); PG8_BAR; PG8_MMA(1, 1, At, B1); PG8_BAR;
            PG8_LDB(B0, 1, 0); PG8_SCHED; PG8_LDA(At, 1, 0); PG8_STAGE(PG8_SA(0, 1), a2 + hstep, voffA);
            PG8_WAIT_L(8); PG8_BAR; PG8_WAIT_L(0); PG8_MMA(0, 0, At, B0); PG8_BAR; PG8_SCHED;
            PG8_LDB(B1, 1, 1); PG8_STAGE(PG8_SB(1, 0), b3, voffB);
            PG8_BAR; PG8_WAIT_L(0); PG8_MMA(0, 1, At, B1); PG8_BAR;
            PG8_LDA(At, 1, 1); PG8_STAGE(PG8_SA(1, 0), a3, voffA);
            PG8_BAR; PG8_WAIT_L(0); PG8_MMA(1, 0, At, B0); PG8_BAR; PG8_SCHED;
            PG8_STAGE(PG8_SB(1, 1), b3 + bhs, voffB);
            PG8_WAIT_V(6); PG8_BAR; PG8_MMA(1, 1, At, B1); PG8_BAR;
            }
        }
        if constexpr (ALIGN_EPI) { if (wr == 0) PG8_BAR; }
        E(acc, cur, wr, wc, fr, fq); S.done(cur);
        if (!has_next) break;
#pragma unroll
        for (int a = 0; a < 2; ++a)
#pragma unroll
            for (int b = 0; b < 2; ++b)
#pragma unroll
                for (int m = 0; m < 4; ++m)
#pragma unroll
                    for (int n = 0; n < 2; ++n) acc[a][b][m][n] = (f32x4){0.f, 0.f, 0.f, 0.f};
        cur = nxt; cA = nA; cB = nB; ++ui;
        if constexpr (ALIGN_EPI) { if (wr == 1) PG8_BAR; }
    }
    PG8_WAIT_V(0);
    if constexpr (!ALIGN_EPI) { if (wr == 0) PG8_BAR; }
    PG8_BAR;
#undef PG8_SA
#undef PG8_SB
#undef PG8_STAGE
#undef PG8_LDA
#undef PG8_LDB
#undef PG8_MMA
#undef PG8_WAIT_V
#undef PG8_WAIT_L
#undef PG8_BAR
#undef PG8_SCHED
}
}

constexpr int NWAVES = 8;
constexpr int D = 2048, MCTX = 4096, MLAT = 16384, M = MCTX + MLAT, NL = 4;
constexpr int DA = 1024, NH = 16, DB = 1024, NG = 8, HB = 128;
constexpr int LW = 64, LAA = 64, LGT = 160;
constexpr int CSH = 3 * DA + LW + LAA + LGT;
constexpr int PIN = CSH + 2 * DB;
constexpr int PINP = 5632;
constexpr int DFF = 5632, NGU = 2 * DFF;
constexpr int MODW = 6 * D;
constexpr float RMS_EPS = 1e-6f, GN_EPS = 64.0f * 1e-5f, LN_EPS = 1e-5f;

constexpr size_t MiB = 1u << 20;
constexpr size_t WS_CTL = 0, CTL_ZERO_BYTES = 1 * MiB;
constexpr size_t WS_MOD = 1 * MiB;
constexpr size_t WS_W2T = 2 * MiB;
constexpr size_t WS_A2T = 3 * MiB;
constexpr size_t WS_G2T = 4 * MiB;
constexpr size_t WS_WSP = 6 * MiB;
constexpr size_t WS_BONUS = 7 * MiB;
constexpr size_t SZ_WIN = (size_t)PINP * D * 2, SZ_WOUT = (size_t)D * D * 2, SZ_WGU = (size_t)NGU * D * 2, SZ_WD = (size_t)D * DFF * 2;
constexpr size_t WS_WIN = 16 * MiB;
constexpr size_t WS_WOUT = WS_WIN + NL * SZ_WIN;
constexpr size_t WS_WGU = WS_WOUT + NL * SZ_WOUT;
constexpr size_t WS_WD = WS_WGU + NL * SZ_WGU;
constexpr size_t WS_H = WS_WD + NL * SZ_WD;
constexpr size_t WS_O = WS_H + (size_t)M * D * 2;
constexpr size_t WS_P = WS_O + (size_t)M * D * 2;
constexpr size_t WS_PS = WS_P + (size_t)M * PINP * 2;
constexpr size_t SZ_T16 = (size_t)M * DA * 2;
constexpr size_t WS_GATE = WS_PS + (size_t)M * CSH * 2;
constexpr size_t SZ_CH = (size_t)(M / 64) * NH * 2 * 8192;
constexpr size_t WS_PST = WS_GATE + SZ_T16;
constexpr size_t WS_NCT = WS_PST + SZ_CH;
constexpr size_t WS_PYT = WS_NCT + SZ_CH;
constexpr size_t WS_QYT = WS_PYT + SZ_CH;
constexpr size_t WS_VTG = WS_QYT + SZ_CH;
constexpr size_t WS_SC = WS_VTG + SZ_CH;
constexpr size_t WS_LORA = WS_SC + SZ_CH;
constexpr size_t WS_END1 = WS_LORA + (size_t)M * 288 * 2;
constexpr size_t WS_HID = WS_GATE;
constexpr size_t WS_END = WS_END1 > WS_HID + (size_t)M * DFF * 2 ? WS_END1 : WS_HID + (size_t)M * DFF * 2;
constexpr int CW_BAR = 4096;
constexpr int CW_SPLIT = 16384;
static_assert((CW_SPLIT + NL * 640 * 64) * 4 <= (int)CTL_ZERO_BYTES, "control words inside the memset region");

constexpr int RING_BYTES = 131072;
constexpr int LDSCTL_OFF = 15 * 9216, MISC_OFF = LDSCTL_OFF + 320;
constexpr int LDS_BYTES = 147456;

#define GAS __attribute__((address_space(1)))
#define LAS __attribute__((address_space(3)))
typedef unsigned short bf16;
typedef float f32x4 __attribute__((ext_vector_type(4)));
typedef float f32x2 __attribute__((ext_vector_type(2)));
typedef short bf16x8 __attribute__((ext_vector_type(8)));
typedef unsigned u32x4 __attribute__((ext_vector_type(4)));
typedef unsigned u32x2 __attribute__((ext_vector_type(2)));
#define LDS_WAIT() asm volatile("s_waitcnt lgkmcnt(0)" ::: "memory")
#define VM_WAIT() asm volatile("s_waitcnt vmcnt(0)" ::: "memory")
__device__ __forceinline__ unsigned f2bf(float f) { unsigned u = __builtin_bit_cast(unsigned, f); return (u + 0x7fffu + ((u >> 16) & 1u)) >> 16; }
typedef __bf16 bf16x2_t __attribute__((ext_vector_type(2)));
__device__ __forceinline__ unsigned pk2(float lo, float hi) { return __builtin_bit_cast(unsigned, __builtin_convertvector((f32x2){lo, hi}, bf16x2_t)); }
__device__ __forceinline__ float bf2f(unsigned short b) { return __uint_as_float(((unsigned)b) << 16); }
__device__ __forceinline__ void unpack8(const u32x4 q, float (&f)[8]) {
    f[0] = __uint_as_float(q.x << 16); f[1] = __uint_as_float(q.x & 0xffff0000u); f[2] = __uint_as_float(q.y << 16); f[3] = __uint_as_float(q.y & 0xffff0000u);
    f[4] = __uint_as_float(q.z << 16); f[5] = __uint_as_float(q.z & 0xffff0000u); f[6] = __uint_as_float(q.w << 16); f[7] = __uint_as_float(q.w & 0xffff0000u); }
__device__ __forceinline__ u32x4 pack8(const float (&f)[8]) { u32x4 o; o.x = pk2(f[0], f[1]); o.y = pk2(f[2], f[3]); o.z = pk2(f[4], f[5]); o.w = pk2(f[6], f[7]); return o; }
__device__ __forceinline__ float fsigmoid(float x) { return __builtin_amdgcn_rcpf(1.0f + __expf(-x)); }
__device__ __forceinline__ float ftanh(float x) { return 1.0f - 2.0f * __builtin_amdgcn_rcpf(1.0f + __expf(2.0f * x)); }
__device__ __forceinline__ float gelu_tanh(float x) { const float u = 1.5957691216057308f * (x + 0.044715f * x * x * x); return x * __builtin_amdgcn_rcpf(1.0f + __expf(-u)); }
__device__ __forceinline__ int hw_lane() { int l; asm volatile("v_mbcnt_lo_u32_b32 %0, -1, 0\n\tv_mbcnt_hi_u32_b32 %0, -1, %0" : "=v"(l)); return l; }
#define SHX(v, X) __int_as_float(__builtin_amdgcn_ds_bpermute((lane ^ (X)) << 2, __float_as_int(v)))
#define WAVE_SUM(v) do { v += SHX(v, 1); v += SHX(v, 2); v += SHX(v, 4); v += SHX(v, 8); v += SHX(v, 16); v += SHX(v, 32); } while (0)

#define PH_LOCALS(F) int wave = (F).wave; asm volatile("" : "+s"(wave)); const int lane = hw_lane(); const int tid = wave * 64 + lane; \
    int bx = (F).bx, G = (F).G; asm volatile("" : "+s"(bx), "+s"(G)); (void)lane; (void)tid;
#define PH_LAYER(l) asm volatile("" : "+s"(l))

#define XB_TMO      128
#define XB_XCNT(j)  (256  + 64 * (j))
#define XB_XSUB(j)  (1280 + 64 * (j))
#define XB_XGEN(j)  (2304 + 64 * (j))
#define XB_TOP      3328
#define XB_TOPGEN   3392
#define XCD_BAR_WORDS 3456
#define XB_SPIN_CAP (1u << 18)

__device__ __forceinline__ unsigned xb_ld(unsigned* p)              { return __hip_atomic_load(p, __ATOMIC_RELAXED, __HIP_MEMORY_SCOPE_AGENT); }
__device__ __forceinline__ unsigned xb_add(unsigned* p, unsigned v) { return __hip_atomic_fetch_add(p, v, __ATOMIC_RELAXED, __HIP_MEMORY_SCOPE_AGENT); }
__device__ __forceinline__ unsigned xb_xcc_id() { return (unsigned)__builtin_amdgcn_s_getreg((3 << 11) | 20) & 0xFu; }
#define XB_SPIN(cond, bar) do { unsigned _sp = 0; while (cond) { __builtin_amdgcn_s_sleep(1); \
    if ((++_sp & 255u) == 0u) { if (xb_ld(&(bar)[XB_TMO])) break; if (_sp > XB_SPIN_CAP) { atomicAdd(&(bar)[XB_TMO], 1u); break; } } } } while (0)

struct XcdBarrier {
    unsigned* bar; unsigned x;
    volatile LAS unsigned* st;
};
__device__ __forceinline__ XcdBarrier xcd_barrier_post(unsigned* bar, volatile LAS unsigned* st) {
    XcdBarrier b; b.bar = bar; b.x = xb_xcc_id(); b.st = st;
    if (threadIdx.x == 0) (void)xb_add(&bar[XB_XCNT(b.x)], 1u);
    return b;
}
__device__ __forceinline__ void xcd_barrier_complete(unsigned* bar, unsigned x, unsigned& nloc, unsigned& nx) {
    const unsigned G = gridDim.x * gridDim.y * gridDim.z;
    unsigned sum, cnt, mine, sp = 0u;
    for (;;) {
        sum = 0u; cnt = 0u; mine = 0u;
#pragma unroll
        for (unsigned j = 0; j < 16; ++j) { const unsigned c = xb_ld(&bar[XB_XCNT(j)]); sum += c; cnt += (c > 0u) ? 1u : 0u; mine = (j == x) ? c : mine; }
        if (sum == G) break;
        __builtin_amdgcn_s_sleep(1);
        if ((++sp & 255u) == 0u) { if (xb_ld(&bar[XB_TMO])) break; if (sp > XB_SPIN_CAP) { atomicAdd(&bar[XB_TMO], 1u); break; } }
    }
    nloc = mine > 0u ? mine : 1u; nx = cnt > 0u ? cnt : 1u;
}
__device__ __forceinline__ void xcd_barrier(const XcdBarrier& b) {
    asm volatile("s_waitcnt vmcnt(0)" ::: "memory");
    __syncthreads();
    if (threadIdx.x == 0) {
        unsigned* bar = b.bar;
        __builtin_amdgcn_s_waitcnt(0);
        unsigned nloc = b.st[0], nx = b.st[1];
        if (nloc == 0u) { xcd_barrier_complete(bar, b.x, nloc, nx); b.st[0] = nloc; b.st[1] = nx; }
        const unsigned old = xb_add(&bar[XB_XSUB(b.x)], 1u);
        const unsigned gen = old / nloc;
        if (old + 1u == (gen + 1u) * nloc) {
            __builtin_amdgcn_fence(__ATOMIC_RELEASE, "agent");
            asm volatile("s_waitcnt vmcnt(0)" ::: "memory");
            const unsigned og = xb_add(&bar[XB_TOP], 1u);
            const unsigned tg = og / nx;
            if (og + 1u == (tg + 1u) * nx) xb_add(&bar[XB_TOPGEN], 1u);
            else XB_SPIN(xb_ld(&bar[XB_TOPGEN]) == tg, bar);
            __builtin_amdgcn_fence(__ATOMIC_ACQUIRE, "agent");
            xb_add(&bar[XB_XGEN(b.x)], 1u);
            asm volatile("s_waitcnt vmcnt(0)" ::: "memory");
        } else {
            XB_SPIN(xb_ld(&bar[XB_XGEN(b.x)]) == gen, bar);
            __builtin_amdgcn_fence(__ATOMIC_ACQUIRE, "agent");
            asm volatile("s_waitcnt vmcnt(0)" ::: "memory");
        }
    }
    __syncthreads();
}

struct Args {
    const float* in[30];
    float* out; unsigned char* ws;
    int ph_lo, ph_hi, li, pad;
};
enum { I_XP = 0, I_XS, I_STATE, I_C, I_CCTX, I_WMOD, I_BMOD, I_N1G, I_WIN, I_MU, I_W0, I_W2, I_A0, I_A2, I_G2, I_KK, I_KA, I_RK, I_GNW, I_GNB, I_LNG, I_LNB, I_WSP, I_BSP, I_WOUT, I_N2G, I_WG, I_WU, I_WD, I_FNG };

struct Frame {
    LAS unsigned char* lds;
    int tid, lane, wave, G, bx;
    const float* const* in;
    float* out; unsigned char* ws;
};

struct EpiP {
    static constexpr bool PERM = true, AFTER_DRAIN = false;
    bf16* O; int ldc; int gelu_from;
    __device__ __forceinline__ void operator()(const f32x4 (&acc)[2][2][4][2], const pg8::Unit& u, int wr, int wc, int fr, int fq) const {
        const int row0 = u.pm * 256 + wr * 64 + fr, col0 = u.pn * 256 + wc * 32 + 8 * fq;
#pragma unroll
        for (int ai = 0; ai < 2; ++ai)
#pragma unroll
            for (int m = 0; m < 4; ++m) { bf16* rowp = O + (size_t)(row0 + ai * 128 + m * 16) * ldc + col0;
#pragma unroll
                for (int bj = 0; bj < 2; ++bj) { f32x4 v0 = acc[ai][bj][m][0], v1 = acc[ai][bj][m][1];
                    if (col0 + bj * 128 >= gelu_from) {
#pragma unroll
                        for (int j = 0; j < 4; ++j) { v0[j] = gelu_tanh(v0[j]); v1[j] = gelu_tanh(v1[j]); } }
                    u32x4 w; w.x = pg8::cvt_pk_bf16(v0[0], v0[1]); w.y = pg8::cvt_pk_bf16(v0[2], v0[3]); w.z = pg8::cvt_pk_bf16(v1[0], v1[1]); w.w = pg8::cvt_pk_bf16(v1[2], v1[3]);
                    *(u32x4*)(rowp + bj * 128) = w; } }
    }
};
struct EpiRes {
    static constexpr bool PERM = false, AFTER_DRAIN = false;
    const float* xlo; const float* xhi; float* xout; const float* modl; int goff;
    __device__ __forceinline__ void operator()(const f32x4 (&acc)[2][2][4][2], const pg8::Unit& u, int wr, int wc, int fr, int fq) const {
        const int pm = u.pm; const int midx = pm < 16 ? 0 : 1 + ((pm - 16) >> 4);
        const float* gv = modl + (size_t)midx * MODW + goff;
        const float* base = pm < 16 ? xlo + (size_t)pm * 256 * D : xhi + (size_t)(pm - 16) * 256 * D;
        float* ob = xout + (size_t)pm * 256 * D;
        const bool half = u.bh >= 0;
        const int col0 = u.pn * 256 + (u.bh > 0 ? 128 : 0) + wc * 32 + 4 * fq;
        f32x4 gvv[2][2];
#pragma unroll
        for (int bj = 0; bj < 2; ++bj)
#pragma unroll
            for (int n = 0; n < 2; ++n) gvv[bj][n] = (bj == 1 && half) ? (f32x4){0.f, 0.f, 0.f, 0.f} : *(const f32x4*)(gv + col0 + bj * 128 + n * 16);
        const size_t rbase = (size_t)(wr * 64 + fr) * D + col0;
        f32x4 xr[8][2][2];
#define ER_LOAD(g_) do { const size_t off_ = rbase + (size_t)(((g_) >> 2) * 128 + ((g_) & 3) * 16) * D; \
            _Pragma("unroll") for (int bj = 0; bj < 2; ++bj) { if (bj == 1 && half) continue; _Pragma("unroll") for (int n = 0; n < 2; ++n) xr[g_][bj][n] = *(const f32x4*)(base + off_ + bj * 128 + n * 16); } } while (0)
        ER_LOAD(0); ER_LOAD(1); ER_LOAD(2);
        asm volatile("" ::: "memory");
#pragma unroll
        for (int g = 0; g < 8; ++g) { const int ai = g >> 2, m = g & 3; const size_t off = rbase + (size_t)(ai * 128 + m * 16) * D;
#pragma unroll
            for (int bj = 0; bj < 2; ++bj) { if (bj == 1 && half) continue;
#pragma unroll
                for (int n = 0; n < 2; ++n) *(f32x4*)(ob + off + bj * 128 + n * 16) = xr[g][bj][n] + gvv[bj][n] * acc[ai][bj][m][n]; }
            asm volatile("" ::: "memory");
            if (g + 3 < 8) { ER_LOAD(g + 3); }
            asm volatile("" ::: "memory"); }
#undef ER_LOAD
    }
};
struct EpiSwi {
    static constexpr bool PERM = true, AFTER_DRAIN = false;
    bf16* O; int ldc;
    __device__ __forceinline__ void operator()(const f32x4 (&acc)[2][2][4][2], const pg8::Unit& u, int wr, int wc, int fr, int fq) const {
        const int row0 = u.pm * 256 + wr * 64 + fr, col0 = u.pn * 128 + wc * 32 + 8 * fq;
#pragma unroll
        for (int ai = 0; ai < 2; ++ai)
#pragma unroll
            for (int m = 0; m < 4; ++m) { bf16* rowp = O + (size_t)(row0 + ai * 128 + m * 16) * ldc + col0;
                float h[8];
#pragma unroll
                for (int n = 0; n < 2; ++n)
#pragma unroll
                    for (int j = 0; j < 4; ++j) { const float gt = acc[ai][0][m][n][j], up = acc[ai][1][m][n][j]; h[n * 4 + j] = gt * fsigmoid(gt) * up; }
                u32x4 w; w.x = pg8::cvt_pk_bf16(h[0], h[1]); w.y = pg8::cvt_pk_bf16(h[2], h[3]); w.z = pg8::cvt_pk_bf16(h[4], h[5]); w.w = pg8::cvt_pk_bf16(h[6], h[7]);
                *(u32x4*)rowp = w; }
    }
};

template <int MAP>
__device__ __forceinline__ void tr_item(const float* W, int K, int N, bf16* WT, LAS float* scr, int item, int lane) {
    const int nblk = N / 32, kb = item / nblk, nb = item % nblk, k0 = 64 * kb, n0 = 32 * nb;
#pragma unroll 8
    for (int i = 0; i < 32; ++i) { const int kk = 2 * i + (lane >> 5); scr[kk * 33 + (lane & 31)] = W[(size_t)(k0 + kk) * N + n0 + (lane & 31)]; }
    LDS_WAIT(); asm volatile("" ::: "memory");
    const int c = lane & 7;
#pragma unroll
    for (int j = 0; j < 4; ++j) { const int n = (lane >> 3) + 8 * j; const LAS float* s = scr + (8 * c) * 33 + n;
        u32x4 o; o.x = pk2(s[0 * 33], s[1 * 33]); o.y = pk2(s[2 * 33], s[3 * 33]); o.z = pk2(s[4 * 33], s[5 * 33]); o.w = pk2(s[6 * 33], s[7 * 33]);
        const int nn = n0 + n; const int orow = MAP == 0 ? nn : (256 * (nn >> 7) + (nn & 127) + (MAP == 2 ? 128 : 0));
        *(u32x4*)(WT + (size_t)orow * K + k0 + 8 * c) = o; }
    LDS_WAIT(); asm volatile("" ::: "memory");
}
__device__ __forceinline__ void p0_prologue(Frame& F) {
    PH_LOCALS(F);
    LAS float* scr = (LAS float*)(F.lds + wave * 16384);
    const int gw = bx * NWAVES + wave, NGW = G * NWAVES;
    constexpr int I_IN = (D / 64) * (PIN / 32), I_OUT = (D / 64) * (D / 32), I_GU = (D / 64) * (DFF / 32), I_DN = (DFF / 64) * (D / 32);
    constexpr int PL = I_IN + I_OUT + 2 * I_GU + I_DN;
    for (int it = gw; it < NL * PL; it += NGW) {
        const int l = it / PL; int r = it % PL;
        if (r < I_IN) { tr_item<0>(F.in[I_WIN] + (size_t)l * D * PIN, D, PIN, (bf16*)(F.ws + WS_WIN + l * SZ_WIN), scr, r, lane); continue; } r -= I_IN;
        if (r < I_OUT) { tr_item<0>(F.in[I_WOUT] + (size_t)l * D * D, D, D, (bf16*)(F.ws + WS_WOUT + l * SZ_WOUT), scr, r, lane); continue; } r -= I_OUT;
        if (r < I_GU) { tr_item<1>(F.in[I_WG] + (size_t)l * D * DFF, D, DFF, (bf16*)(F.ws + WS_WGU + l * SZ_WGU), scr, r, lane); continue; } r -= I_GU;
        if (r < I_GU) { tr_item<2>(F.in[I_WU] + (size_t)l * D * DFF, D, DFF, (bf16*)(F.ws + WS_WGU + l * SZ_WGU), scr, r, lane); continue; } r -= I_GU;
        tr_item<0>(F.in[I_WD] + (size_t)l * DFF * D, DFF, D, (bf16*)(F.ws + WS_WD + l * SZ_WD), scr, r, lane);
    }
    const int gt = bx * 512 + tid, NGT = G * 512;
    { constexpr int PADV = (PINP - PIN) * D * 2 / 16;
      for (int i = gt; i < NL * PADV; i += NGT) { const int l = i / PADV, r = i % PADV; ((u32x4*)(F.ws + WS_WIN + l * SZ_WIN + (size_t)PIN * D * 2))[r] = (u32x4){0u, 0u, 0u, 0u}; } }
    { bf16* w2t = (bf16*)(F.ws + WS_W2T); bf16* a2t = (bf16*)(F.ws + WS_A2T); bf16* g2t = (bf16*)(F.ws + WS_G2T); bf16* wsp = (bf16*)(F.ws + WS_WSP);
      for (int i = gt; i < NL * 2 * 1024 * 64; i += NGT) { const int k = i & 63, n = (i >> 6) & 1023, ld = i >> 16;
          w2t[i] = (bf16)f2bf(F.in[I_W2][((size_t)ld * 64 + k) * 1024 + n]); a2t[i] = (bf16)f2bf(F.in[I_A2][((size_t)ld * 64 + k) * 1024 + n]); }
      for (int i = gt; i < NL * 1024 * 160; i += NGT) { const int k = i % 160, n = (i / 160) & 1023, l = i / (160 * 1024);
          g2t[i] = (bf16)f2bf(F.in[I_G2][((size_t)l * 160 + k) * 1024 + n]); }
      for (int i = gt; i < NL * 8 * 128 * 128; i += NGT) wsp[i] = (bf16)f2bf(F.in[I_WSP][i]); }
    __syncthreads();
    { LAS float* sv = (LAS float*)F.lds;
      LAS float* red = (LAS float*)(F.lds + 40960);
      for (int i = tid; i < 5 * D; i += 512) { const int r = i / D, k = i % D; const float c = r == 0 ? F.in[I_CCTX][k] : F.in[I_C][(r - 1) * D + k]; sv[i] = c * fsigmoid(c); }
      __syncthreads();
      float* mod = (float*)(F.ws + WS_MOD);
      const int c4 = tid & 15, kg = tid >> 4;
      for (int item = bx; item < NL * (MODW / 64); item += G) {
          const int l = item / (MODW / 64), n0 = (item % (MODW / 64)) * 64;
          const float* W = F.in[I_WMOD] + (size_t)l * D * MODW + n0 + 4 * c4;
          f32x4 a[5];
#pragma unroll
          for (int r = 0; r < 5; ++r) a[r] = (f32x4){0.f, 0.f, 0.f, 0.f};
#pragma unroll 4
          for (int i = 0; i < 64; ++i) { const int k = i * 32 + kg; const f32x4 w = *(const f32x4*)(W + (size_t)k * MODW);
#pragma unroll
              for (int r = 0; r < 5; ++r) a[r] += w * sv[r * D + k]; }
#pragma unroll
          for (int r = 0; r < 5; ++r) *(LAS f32x4*)(red + (kg * 5 + r) * 64 + 4 * c4) = a[r];
          __syncthreads();
          if (tid < 320) { const int r = tid >> 6, n = tid & 63; float s = 0.f;
#pragma unroll 8
              for (int g = 0; g < 32; ++g) s += red[(g * 5 + r) * 64 + n];
              mod[((size_t)l * 5 + r) * MODW + n0 + n] = s + F.in[I_BMOD][(size_t)l * MODW + n0 + n]; }
          __syncthreads();
      } }
}

__device__ __forceinline__ void p_adaln(Frame& F, int l, int which, const float* xlo, const float* xhi) {
    PH_LOCALS(F); PH_LAYER(l);
    const int gw = bx * NWAVES + wave, NGW = G * NWAVES;
    const float* ng = (which == 0 ? F.in[I_N1G] : F.in[I_N2G]) + (size_t)l * D;
    const int shoff = which == 0 ? 0 : 3 * D, scoff = shoff + D;
    const float* mod = (const float*)(F.ws + WS_MOD);
    bf16* H = (bf16*)(F.ws + WS_H);
    const int rpw = (M + NGW - 1) / NGW, rbeg = gw * rpw, rend = rbeg + rpw < M ? rbeg + rpw : M;
    f32x4 ca[8], cb[8], nx[8]; int mcur = -1;
#define AL_ROWPTR(row_) ((row_) < MCTX ? xlo + (size_t)(row_) * D : xhi + (size_t)((row_) - MCTX) * D)
    if (rbeg < rend) { const float* xr = AL_ROWPTR(rbeg);
#pragma unroll
        for (int j = 0; j < 8; ++j) nx[j] = *(const f32x4*)(xr + 4 * lane + 256 * j); }
    for (int row = rbeg; row < rend; ++row) {
        const int midx = row < MCTX ? 0 : 1 + ((row - MCTX) >> 12);
        if (midx != mcur) { mcur = midx; const float* md = mod + ((size_t)l * 5 + midx) * MODW;
#pragma unroll
            for (int j = 0; j < 8; ++j) { const int c = 4 * lane + 256 * j; ca[j] = *(const f32x4*)(ng + c) * (*(const f32x4*)(md + scoff + c) + 1.0f); cb[j] = *(const f32x4*)(md + shoff + c); } }
        f32x4 v[8]; float ss = 0.f;
#pragma unroll
        for (int j = 0; j < 8; ++j) { v[j] = nx[j]; ss += (v[j].x * v[j].x + v[j].y * v[j].y) + (v[j].z * v[j].z + v[j].w * v[j].w); }
        { const int nr = row + 1 < rend ? row + 1 : row; const float* xr = AL_ROWPTR(nr);
#pragma unroll
          for (int j = 0; j < 8; ++j) nx[j] = *(const f32x4*)(xr + 4 * lane + 256 * j); }
        WAVE_SUM(ss); const float rstd = 1.0f / sqrtf(ss * (1.0f / D) + RMS_EPS);
#pragma unroll
        for (int j = 0; j < 8; ++j) { const int c = 4 * lane + 256 * j;
            const f32x4 o = v[j] * rstd * ca[j] + cb[j];
            u32x2 w; w.x = pk2(o.x, o.y); w.y = pk2(o.z, o.w);
            *(u32x2*)(H + (size_t)row * D + c) = w; }
    }
#undef AL_ROWPTR
}

__device__ __forceinline__ void load_shifted8(const bf16* P, const float* mu, int row, int col, float (&o)[8]) {
    float g[8]; unpack8(*(const u32x4*)(P + (size_t)row * PINP + col), g);
    float a[8];
#pragma unroll
    for (int j = 0; j < 8; ++j) a[j] = g[j];
    int nrow[4]; bool has[4]; int nn;
    if (row < MCTX) { const int t = row & 255; nn = 2; nrow[0] = row - 1; has[0] = t > 0; nrow[1] = row + 1; has[1] = t < 255; nrow[2] = row; has[2] = false; nrow[3] = row; has[3] = false; }
    else { const int t = (row - MCTX) & 4095, gc = t & 63, gr = t >> 6; nn = 4;
        nrow[0] = row - 1; has[0] = gc > 0; nrow[1] = row + 1; has[1] = gc < 63; nrow[2] = row - 64; has[2] = gr > 0; nrow[3] = row + 64; has[3] = gr < 63; }
#pragma unroll
    for (int q = 0; q < 4; ++q) {
        if (q < nn) {
            float nb[8];
            if (has[q]) unpack8(*(const u32x4*)(P + (size_t)nrow[q] * PINP + col), nb);
            else {
#pragma unroll
                for (int j = 0; j < 8; ++j) nb[j] = 0.f; }
            const f32x4 m0 = *(const f32x4*)(mu + q * CSH + col), m1 = *(const f32x4*)(mu + q * CSH + col + 4);
#pragma unroll
            for (int j = 0; j < 4; ++j) { a[j] += m0[j] * (nb[j] - g[j]); a[4 + j] += m1[j] * (nb[4 + j] - g[4 + j]); }
        }
    }
#pragma unroll
    for (int j = 0; j < 8; ++j) o[j] = a[j];
}
__device__ __forceinline__ void p_shift(Frame& F, int l) {
    PH_LOCALS(F); PH_LAYER(l);
    const bf16* P = (const bf16*)(F.ws + WS_P); bf16* PS = (bf16*)(F.ws + WS_PS); bf16* LORA = (bf16*)(F.ws + WS_LORA);
    const float* mu = F.in[I_MU] + (size_t)l * 4 * CSH;
    constexpr int CG = CSH / 8;
    if (tid >= CG) return;
    const int col = tid * 8; const int act = (col >= 3 * DA && col < 3 * DA + LW) ? 1 : (col >= 3 * DA + LW + LAA ? 2 : 0);
    f32x2 m[4][4];
#pragma unroll
    for (int q = 0; q < 4; ++q) { const f32x4 a = *(const f32x4*)(mu + q * CSH + col), b = *(const f32x4*)(mu + q * CSH + col + 4); m[q][0] = (f32x2){a[0], a[1]}; m[q][1] = (f32x2){a[2], a[3]}; m[q][2] = (f32x2){b[0], b[1]}; m[q][3] = (f32x2){b[2], b[3]}; }
#define SH_UNPK(q_, v_) do { v_[0] = (f32x2){__uint_as_float((q_).x << 16), __uint_as_float((q_).x & 0xffff0000u)}; v_[1] = (f32x2){__uint_as_float((q_).y << 16), __uint_as_float((q_).y & 0xffff0000u)}; \
        v_[2] = (f32x2){__uint_as_float((q_).z << 16), __uint_as_float((q_).z & 0xffff0000u)}; v_[3] = (f32x2){__uint_as_float((q_).w << 16), __uint_as_float((q_).w & 0xffff0000u)}; } while (0)
#define SH_STORE(row_, a_) do { float o_[8] = {a_[0].x, a_[0].y, a_[1].x, a_[1].y, a_[2].x, a_[2].y, a_[3].x, a_[3].y}; \
        if (act == 1) { _Pragma("unroll") for (int jx = 0; jx < 8; ++jx) o_[jx] = ftanh(o_[jx]); } else if (act == 2) { _Pragma("unroll") for (int jx = 0; jx < 8; ++jx) o_[jx] = fsigmoid(o_[jx]); } \
        if (col >= 3 * DA) { const int cgl = (col - 3 * DA) >> 3; *(u32x4*)(LORA + ((((size_t)((row_) >> 4) * 9 + (cgl >> 2)) * 64 + 16 * (cgl & 3) + ((row_) & 15)) << 3)) = pack8(o_); } \
        else *(u32x4*)(PS + (size_t)(row_) * CSH + col) = pack8(o_); } while (0)
    const u32x4 Z4 = (u32x4){0u, 0u, 0u, 0u};
    { f32x2 c0[4];
#pragma unroll
      for (int e = 0; e < 4; ++e) c0[e] = (f32x2){1.f, 1.f} - ((m[0][e] + m[1][e]) + (m[2][e] + m[3][e]));
      for (int u = bx; u < 256; u += G) {
          const int gc = u & 63; const bf16* pc = P + ((size_t)MCTX + (size_t)(u >> 6) * 4096 + gc) * PINP + col;
          const int rowb = MCTX + (u >> 6) * 4096 + gc;
          u32x4 up = Z4, cur = *(const u32x4*)pc;
          for (int g0 = 0; g0 < 64; g0 += 4) {
              u32x4 dn[4], lf[4], rt[4];
#pragma unroll
              for (int i = 0; i < 4; ++i) { const int gr = g0 + i; const bf16* pr = pc + (size_t)gr * 64 * PINP;
                  dn[i] = gr < 63 ? *(const u32x4*)(pr + (size_t)64 * PINP) : Z4; lf[i] = gc > 0 ? *(const u32x4*)(pr - PINP) : Z4; rt[i] = gc < 63 ? *(const u32x4*)(pr + PINP) : Z4; }
#pragma unroll
              for (int i = 0; i < 4; ++i) { f32x2 g[4], a[4], nb[4]; SH_UNPK(cur, g);
#pragma unroll
                  for (int e = 0; e < 4; ++e) a[e] = c0[e] * g[e];
                  SH_UNPK(lf[i], nb);
#pragma unroll
                  for (int e = 0; e < 4; ++e) a[e] += m[0][e] * nb[e];
                  SH_UNPK(rt[i], nb);
#pragma unroll
                  for (int e = 0; e < 4; ++e) a[e] += m[1][e] * nb[e];
                  SH_UNPK(up, nb);
#pragma unroll
                  for (int e = 0; e < 4; ++e) a[e] += m[2][e] * nb[e];
                  SH_UNPK(dn[i], nb);
#pragma unroll
                  for (int e = 0; e < 4; ++e) a[e] += m[3][e] * nb[e];
                  const int row = rowb + (g0 + i) * 64; SH_STORE(row, a);
                  up = cur; cur = dn[i]; }
          }
      } }
    { f32x2 c0[4];
#pragma unroll
      for (int e = 0; e < 4; ++e) c0[e] = (f32x2){1.f, 1.f} - (m[0][e] + m[1][e]);
      const int rpw = (MCTX + G - 1) / G, rbeg = bx * rpw, rend = rbeg + rpw < MCTX ? rbeg + rpw : MCTX;
      if (rbeg < rend) {
          const bf16* pc = P + (size_t)rbeg * PINP + col;
          u32x4 prev = (rbeg & 255) ? *(const u32x4*)(pc - PINP) : Z4, cur = *(const u32x4*)pc;
          for (int row = rbeg; row < rend; ++row) { const bf16* pr = P + (size_t)row * PINP + col;
              const u32x4 nxt = (row & 255) != 255 ? *(const u32x4*)(pr + PINP) : Z4;
              f32x2 g[4], a[4], nb[4]; SH_UNPK(cur, g);
#pragma unroll
              for (int e = 0; e < 4; ++e) a[e] = c0[e] * g[e];
              SH_UNPK(prev, nb);
#pragma unroll
              for (int e = 0; e < 4; ++e) a[e] += m[0][e] * nb[e];
              SH_UNPK(nxt, nb);
#pragma unroll
              for (int e = 0; e < 4; ++e) a[e] += m[1][e] * nb[e];
              SH_STORE(row, a);
              prev = (row & 255) != 255 ? cur : Z4; cur = ((row & 255) != 255 || row + 1 >= rend) ? nxt : *(const u32x4*)(pr + PINP); }
      } }
#undef SH_UNPK
#undef SH_STORE
}

#define F4Z ((f32x4){0.f, 0.f, 0.f, 0.f})
__device__ __forceinline__ u32x2 pk4(const f32x4 a) { u32x2 w; w.x = pk2(a[0], a[1]); w.y = pk2(a[2], a[3]); return w; }
#define LBAR() do { asm volatile("s_waitcnt lgkmcnt(0)" ::: "memory"); __builtin_amdgcn_s_barrier(); asm volatile("" ::: "memory"); } while (0)
constexpr int VTS = 136;
typedef short s16x4g __attribute__((ext_vector_type(4)));
__device__ __forceinline__ bf16x8 frag_tr_ld(const LAS bf16* X, int ld, int kbase, int c0, int fr, int fq) {
    const LAS bf16* p = X + (kbase + 8 * fq + (fr >> 2)) * ld + c0 + 4 * (fr & 3);
    const s16x4g lo = __builtin_amdgcn_ds_read_tr16_b64_v4i16((LAS s16x4g*)p);
    const s16x4g hi = __builtin_amdgcn_ds_read_tr16_b64_v4i16((LAS s16x4g*)(p + 4 * ld));
    return (bf16x8){lo[0], lo[1], lo[2], lo[3], hi[0], hi[1], hi[2], hi[3]};
}
__device__ __forceinline__ void p_gmlp(Frame& F, int l, int slot, int nslots) {
    PH_LOCALS(F); PH_LAYER(l); (void)bx; (void)G;
    const bf16* P = (const bf16*)(F.ws + WS_P); bf16* O = (bf16*)(F.ws + WS_O);
    const bf16* wsp = (const bf16*)(F.ws + WS_WSP) + (size_t)l * 8 * 128 * 128;
    LAS bf16* VN = (LAS bf16*)F.lds;
    LAS bf16* ST = (LAS bf16*)(F.lds + 34816);
    const int fr = lane & 15, fq = lane >> 4;
    constexpr int NIT = (M / 128) * NG;
    const int jrow = tid >> 2, q4 = tid & 3;
    u32x4 pvv[4]; f32x4 lgv[8], lbv[8]; bf16x8 bw[4]; float bsp = 0.f; int gcur = -1;
#define GM_ISSUE(item_) do { const bf16* src_ = P + (size_t)(((item_) >> 3) * 128 + jrow) * PINP + CSH + DB + 128 * ((item_) & 7) + 32 * q4; \
        _Pragma("unroll") for (int i_ = 0; i_ < 4; ++i_) pvv[i_] = *(const u32x4*)(src_ + 8 * i_); } while (0)
    if (slot < 0) return;
    LBAR();
    if (slot < NIT) GM_ISSUE(slot);
    for (int item = slot; item < NIT; item += nslots) {
        const int cb = item >> 3, g = item & 7, R0 = cb * 128;
        u32x4 pu[4]; { const bf16* up = P + (size_t)(R0 + jrow) * PINP + CSH + 128 * g + 32 * q4;
#pragma unroll
            for (int i = 0; i < 4; ++i) pu[i] = *(const u32x4*)(up + 8 * i); }
        if (g != gcur) { gcur = g; const bf16* wa = wsp + ((size_t)g * 128 + 16 * wave + fr) * 128 + 8 * fq;
#pragma unroll
            for (int ks = 0; ks < 4; ++ks) bw[ks] = *(const bf16x8*)(wa + 32 * ks);
            bsp = F.in[I_BSP][((size_t)l * 8 + g) * 128 + jrow];
            const float* lg = F.in[I_LNG] + ((size_t)l * 8 + g) * 128 + 32 * q4; const float* lb = F.in[I_LNB] + ((size_t)l * 8 + g) * 128 + 32 * q4;
#pragma unroll
            for (int i = 0; i < 8; ++i) { lgv[i] = *(const f32x4*)(lg + 4 * i); lbv[i] = *(const f32x4*)(lb + 4 * i); } }
        { float v[32];
#pragma unroll
          for (int i = 0; i < 4; ++i) { float f[8]; unpack8(pvv[i], f);
#pragma unroll
              for (int jj = 0; jj < 8; ++jj) v[8 * i + jj] = f[jj]; }
          float s = 0.f;
#pragma unroll
          for (int i = 0; i < 32; ++i) s += v[i];
          s += SHX(s, 1); s += SHX(s, 2);
          const float mean = s * (1.0f / 128.0f); float qq = 0.f;
#pragma unroll
          for (int i = 0; i < 32; ++i) { v[i] -= mean; qq += v[i] * v[i]; }
          qq += SHX(qq, 1); qq += SHX(qq, 2);
          const float rstd = 1.0f / sqrtf(qq * (1.0f / 128.0f) + LN_EPS);
#pragma unroll
          for (int i = 0; i < 4; ++i) { float o[8]; const f32x4 g0 = lgv[2 * i], g1 = lgv[2 * i + 1], b0 = lbv[2 * i], b1 = lbv[2 * i + 1];
#pragma unroll
              for (int jj = 0; jj < 4; ++jj) { o[jj] = v[8 * i + jj] * rstd * g0[jj] + b0[jj]; o[4 + jj] = v[8 * i + 4 + jj] * rstd * g1[jj] + b1[jj]; }
              *(LAS u32x4*)(VN + jrow * VTS + 32 * q4 + 8 * i) = pack8(o); } }
        if (item + nslots < NIT) GM_ISSUE(item + nslots);
        LBAR();
#pragma unroll
        for (int mt = 0; mt < 8; ++mt) { f32x4 acc = F4Z;
#pragma unroll
            for (int ks = 0; ks < 4; ++ks) acc = __builtin_amdgcn_mfma_f32_16x16x32_bf16(frag_tr_ld(VN, VTS, 32 * ks, 16 * mt, fr, fq), bw[ks], acc, 0, 0, 0);
            *(LAS u32x2*)(ST + (16 * wave + fr) * VTS + 16 * mt + 4 * fq) = pk4(acc); }
        LBAR();
        { bf16* op = O + (size_t)(R0 + jrow) * D + DA + 128 * g + 32 * q4;
#pragma unroll
          for (int i = 0; i < 4; ++i) { float sv[8], uv[8], o[8]; unpack8(*(const LAS u32x4*)(ST + jrow * VTS + 32 * q4 + 8 * i), sv); unpack8(pu[i], uv);
#pragma unroll
              for (int jj = 0; jj < 8; ++jj) o[jj] = uv[jj] * (sv[jj] + bsp);
              *(u32x4*)(op + 8 * i) = pack8(o); } }
    }
    LBAR();
#undef GM_ISSUE
}

constexpr int T16B = 9216, LD16 = 72, LD32 = 68;
#define SLOT(i) ((LAS bf16*)(lds + (i) * T16B))
#define SLOTF(i) ((LAS float*)(lds + (i) * T16B))
template <int NK>
__device__ __forceinline__ f32x4 tile_mm(const LAS bf16* A, int lda, const LAS bf16* B, int ldb, int fr, int fq, f32x4 acc) {
#pragma unroll
    for (int ks = 0; ks < NK; ++ks) { const bf16x8 a = *(const LAS bf16x8*)(A + fr * lda + 8 * fq + 32 * ks); const bf16x8 b = *(const LAS bf16x8*)(B + fr * ldb + 8 * fq + 32 * ks);
        acc = __builtin_amdgcn_mfma_f32_16x16x32_bf16(a, b, acc, 0, 0, 0); }
    return acc;
}
__device__ __forceinline__ void st_nat(LAS bf16* dst, int n0, int m0, int fr, int fq, const f32x4 a) { *(LAS u32x2*)(dst + (n0 + fr) * LD16 + m0 + 4 * fq) = pk4(a); }
__device__ __forceinline__ void st_rm(LAS bf16* dst, int n0, int m0, int fr, int fq, const f32x4 a) {
#pragma unroll
    for (int r = 0; r < 4; ++r) dst[(m0 + 4 * fq + r) * LD16 + n0 + fr] = (bf16)f2bf(a[r]); }
__device__ __forceinline__ f32x4 ld4bf(const LAS bf16* p) { const u32x2 w = *(const LAS u32x2*)p; return (f32x4){__uint_as_float(w.x << 16), __uint_as_float(w.x & 0xffff0000u), __uint_as_float(w.y << 16), __uint_as_float(w.y & 0xffff0000u)}; }

__device__ __forceinline__ int fm_off(int n0, int m0, int fr, int fq) { return ((((n0 >> 4) * 2 + (m0 >> 5)) * 64 + (2 * ((m0 >> 4) & 1) + (fq >> 1)) * 16 + fr) << 3) + 4 * (fq & 1); }
typedef short s16x4 __attribute__((ext_vector_type(4)));
__device__ __forceinline__ bf16x8 frag_tr(const LAS bf16* X, int kbase, int c0, int fr, int fq) {
    const LAS bf16* p = X + (kbase + 8 * fq + (fr >> 2)) * LD16 + c0 + 4 * (fr & 3);
    const s16x4 lo = __builtin_amdgcn_ds_read_tr16_b64_v4i16((LAS s16x4*)p);
    const s16x4 hi = __builtin_amdgcn_ds_read_tr16_b64_v4i16((LAS s16x4*)(p + 4 * LD16));
    return (bf16x8){lo[0], lo[1], lo[2], lo[3], hi[0], hi[1], hi[2], hi[3]};
}
__device__ __forceinline__ bf16x8 frag_rm(const LAS bf16* X, int r0, int ks, int fr, int fq) { return *(const LAS bf16x8*)(X + (r0 + fr) * LD16 + 8 * fq + 32 * ks); }
__device__ __forceinline__ f32x4 mm2(const bf16x8 (&a)[2], const bf16x8 (&b)[2], f32x4 acc) {
    acc = __builtin_amdgcn_mfma_f32_16x16x32_bf16(a[0], b[0], acc, 0, 0, 0); return __builtin_amdgcn_mfma_f32_16x16x32_bf16(a[1], b[1], acc, 0, 0, 0); }
__device__ __forceinline__ bf16x8 as_frag(const u32x4 q) { return __builtin_bit_cast(bf16x8, q); }

__device__ __forceinline__ void p_chunkA(Frame& F, int l) {
    PH_LOCALS(F); PH_LAYER(l);
    LAS unsigned char* lds = F.lds;
    const int lane0 = lane, lane00 = lane;
#define STG int lane_ = lane0; asm volatile("" : "+v"(lane_)); const int lane = lane_, fr = lane_ & 15, fq = lane_ >> 4, tid = wave * 64 + lane_, mt = wave >> 1, m0 = 16 * mt, np = (wave & 1) * 2; \
    (void)lane; (void)fr; (void)fq; (void)tid; (void)mt; (void)m0; (void)np;
    const bf16* PS = (const bf16*)(F.ws + WS_PS);
    const bf16* w2t = (const bf16*)(F.ws + WS_W2T) + (size_t)l * 2 * 1024 * 64;
    const bf16* a2t = (const bf16*)(F.ws + WS_A2T) + (size_t)l * 2 * 1024 * 64;
    const bf16* g2t = (const bf16*)(F.ws + WS_G2T) + (size_t)l * 1024 * 160;
    bf16* GATE = (bf16*)(F.ws + WS_GATE); float* BONUS = (float*)(F.ws + WS_BONUS);
    LAS float* gC = (LAS float*)(lds + 14 * T16B);
    LAS float* BT = (LAS float*)(lds + 14 * T16B + 256);
    u32x4 pf_w[2], pf_a[2], pf_g[5], pf_r, pf_k, pf_v; bf16x8 Bg[2][5], Bw[2][2], Ba[2][2]; float biw[2], bia[2];
#define CA_ISSUE(item_, d_) do { const int ci_ = (item_) >> 4, h_ = (item_) & 15, R0_ = ci_ * 64; int lane0 = lane00; asm volatile("" : "+v"(lane0)); \
        const bf16* arow_ = (const bf16*)(F.ws + WS_LORA) + ((((size_t)(R0_ >> 4) + (wave >> 1)) * 9 * 64 + lane0) << 3); \
        pf_w[0] = *(const u32x4*)arow_; pf_w[1] = *(const u32x4*)(arow_ + 512); pf_a[0] = *(const u32x4*)(arow_ + 1024); pf_a[1] = *(const u32x4*)(arow_ + 1536); \
        if ((d_) == 0) { _Pragma("unroll") for (int ks_ = 0; ks_ < 5; ++ks_) { pf_g[ks_] = *(const u32x4*)(arow_ + 2048 + 512 * ks_); \
            _Pragma("unroll") for (int nn_ = 0; nn_ < 2; ++nn_) Bg[nn_][ks_] = *(const bf16x8*)(g2t + (size_t)(64 * h_ + 16 * ((wave & 1) * 2 + nn_) + (lane0 & 15)) * 160 + 8 * (lane0 >> 4) + 32 * ks_); } } \
        _Pragma("unroll") for (int nn_ = 0; nn_ < 2; ++nn_) { const int n_ = 64 * h_ + 16 * ((wave & 1) * 2 + nn_) + (lane0 & 15); \
            biw[nn_] = F.in[I_W0][((size_t)l * 2 + (d_)) * DA + n_]; bia[nn_] = F.in[I_A0][((size_t)l * 2 + (d_)) * DA + n_]; \
            _Pragma("unroll") for (int ks_ = 0; ks_ < 2; ++ks_) { Bw[nn_][ks_] = *(const bf16x8*)(w2t + ((size_t)(d_) * 1024 + n_) * 64 + 8 * (lane0 >> 4) + 32 * ks_); Ba[nn_][ks_] = *(const bf16x8*)(a2t + ((size_t)(d_) * 1024 + n_) * 64 + 8 * (lane0 >> 4) + 32 * ks_); } } \
        const int tid_ = wave * 64 + lane0, tau_ = tid_ >> 3, pos_ = (d_) ? 63 - tau_ : tau_; const bf16* rrow_ = PS + (size_t)(R0_ + pos_) * CSH + 64 * h_ + (tid_ & 7) * 8; \
        pf_r = *(const u32x4*)rrow_; pf_k = *(const u32x4*)(rrow_ + DA); pf_v = *(const u32x4*)(rrow_ + 2 * DA); } while (0)
    if (bx < (M / 64) * NH) CA_ISSUE(bx, 0);
    int hcur = -1;
    LAS float* HC = (LAS float*)(lds + 14 * T16B + 1280);
    for (int item = bx; item < (M / 64) * NH; item += G) {
        const int ci = item >> 4, h = item & 15, R0 = ci * 64;
        { (void)hcur;
            LBAR();
            { const int t_ = wave * 64 + lane0; if (t_ < 192) { const int w_ = t_ >> 6, c_ = t_ & 63; HC[t_] = (w_ == 0 ? F.in[I_KK] : (w_ == 1 ? F.in[I_KA] : F.in[I_RK]))[(size_t)l * DA + 64 * h + c_]; } } }
#pragma unroll
        for (int d = 0; d < 2; ++d) {
            const size_t qi = ((size_t)ci * 16 + h) * 2 + d;
            const bf16x8 cBw[2][2] = {{Bw[0][0], Bw[0][1]}, {Bw[1][0], Bw[1][1]}}, cBa[2][2] = {{Ba[0][0], Ba[0][1]}, {Ba[1][0], Ba[1][1]}}; const float cbw[2] = {biw[0], biw[1]}, cba[2] = {bia[0], bia[1]};
            u32x4 cw[2] = {pf_w[0], pf_w[1]}, ca[2] = {pf_a[0], pf_a[1]}, cg[5] = {pf_g[0], pf_g[1], pf_g[2], pf_g[3], pf_g[4]}; const u32x4 cr = pf_r, ck = pf_k, cv = pf_v;
            for (int repA = 0; repA < (PROBE_SUB == 1 ? 2 : 1); ++repA) {
            { STG; LAS float* AL = SLOTF(5); LAS float* LW = SLOTF(7);
              bf16x8 aw[2], aa[2];
#pragma unroll
              for (int ks = 0; ks < 2; ++ks) { aw[ks] = as_frag(cw[ks]); aa[ks] = as_frag(ca[ks]); }
#pragma unroll
              for (int nn = 0; nn < 2; ++nn) { const int nl = 16 * (np + nn) + fr, n = 64 * h + nl;
                  const f32x4 accw = mm2(aw, cBw[nn], F4Z), acca = mm2(aa, cBa[nn], F4Z);
                  const float biasw = cbw[nn], biasa = cba[nn]; (void)n;
                  float lw[4], c[4];
#pragma unroll
                  for (int r = 0; r < 4; ++r) lw[r] = -0.8750345269f * fsigmoid(biasw + accw[r]);
                  if (d == 0) { c[0] = lw[0]; c[1] = c[0] + lw[1]; c[2] = c[1] + lw[2]; c[3] = c[2] + lw[3]; }
                  else { c[3] = lw[3]; c[2] = c[3] + lw[2]; c[1] = c[2] + lw[1]; c[0] = c[1] + lw[0]; }
                  const float tot = d == 0 ? c[3] : c[0];
                  const float t1 = SHX(tot, 16), t2 = SHX(tot, 32), t3 = SHX(tot, 48);
                  float off;
                  { const int sg = d ? -1 : 1, q1 = fq ^ 1, q2 = fq ^ 2, q3 = fq ^ 3;
                    const int k1 = (sg * (q1 - fq)) >> 31, k2 = (sg * (q2 - fq)) >> 31, k3 = (sg * (q3 - fq)) >> 31;
                    off = (__int_as_float(__float_as_int(t1) & k1) + __int_as_float(__float_as_int(t2) & k2)) + __int_as_float(__float_as_int(t3) & k3); }
#pragma unroll
                  for (int r = 0; r < 4; ++r) { const int pos = m0 + 4 * fq + r, tau = d ? 63 - pos : pos;
                      LW[tau * LD32 + nl] = c[r] + off; AL[tau * LD32 + nl] = fsigmoid(biasa + acca[r]); }
                  if (fq == 0) BT[(d ? 3 - mt : mt) * 64 + nl] = (tot + t1) + (t2 + t3); }
              if (d == 0) {
                  bf16x8 ag[5];
#pragma unroll
                  for (int ks = 0; ks < 5; ++ks) ag[ks] = as_frag(cg[ks]);
#pragma unroll
                  for (int nn = 0; nn < 2; ++nn) { const int n = 64 * h + 16 * (np + nn) + fr; f32x4 acc = F4Z;
#pragma unroll
                      for (int ks = 0; ks < 5; ++ks) acc = __builtin_amdgcn_mfma_f32_16x16x32_bf16(ag[ks], Bg[nn][ks], acc, 0, 0, 0);
#pragma unroll
                      for (int r = 0; r < 4; ++r) SLOT(11)[(m0 + 4 * fq + r) * LD16 + 16 * (np + nn) + fr] = (bf16)f2bf(acc[r]); (void)n; } } }
            LBAR();
            { STG; const LAS float* AL = SLOTF(5); const LAS float* LW = SLOTF(7);
              const int tau = tid >> 3, c8 = (tid & 7) * 8, pos = d ? 63 - tau : tau, row = R0 + pos, blk = wave >> 1;
              f32x2 r[4], k[4];
              { const u32x4 q = cr; r[0] = (f32x2){__uint_as_float(q.x << 16), __uint_as_float(q.x & 0xffff0000u)}; r[1] = (f32x2){__uint_as_float(q.y << 16), __uint_as_float(q.y & 0xffff0000u)};
                r[2] = (f32x2){__uint_as_float(q.z << 16), __uint_as_float(q.z & 0xffff0000u)}; r[3] = (f32x2){__uint_as_float(q.w << 16), __uint_as_float(q.w & 0xffff0000u)}; }
              { const u32x4 q = ck; k[0] = (f32x2){__uint_as_float(q.x << 16), __uint_as_float(q.x & 0xffff0000u)}; k[1] = (f32x2){__uint_as_float(q.y << 16), __uint_as_float(q.y & 0xffff0000u)};
                k[2] = (f32x2){__uint_as_float(q.z << 16), __uint_as_float(q.z & 0xffff0000u)}; k[3] = (f32x2){__uint_as_float(q.w << 16), __uint_as_float(q.w & 0xffff0000u)}; }
              f32x2 offb[4], totC[4];
#pragma unroll
              for (int j = 0; j < 4; ++j) { offb[j] = (f32x2){0.f, 0.f}; totC[j] = (f32x2){0.f, 0.f}; }
#pragma unroll
              for (int b = 0; b < 4; ++b) { const f32x4 x0 = *(const LAS f32x4*)(BT + b * 64 + c8), x1 = *(const LAS f32x4*)(BT + b * 64 + c8 + 4);
                  const f32x2 y[4] = {{x0[0], x0[1]}, {x0[2], x0[3]}, {x1[0], x1[1]}, {x1[2], x1[3]}};
                  const float fb = b < blk ? 1.0f : 0.0f;
#pragma unroll
                  for (int j = 0; j < 4; ++j) { totC[j] += y[j]; offb[j] += y[j] * fb; } }
              f32x2 ckk[4], cka[4], crk[4];
              { const f32x4 a0 = *(const LAS f32x4*)(HC + c8), a1 = *(const LAS f32x4*)(HC + c8 + 4), b0 = *(const LAS f32x4*)(HC + 64 + c8), b1 = *(const LAS f32x4*)(HC + 64 + c8 + 4), c0 = *(const LAS f32x4*)(HC + 128 + c8), c1 = *(const LAS f32x4*)(HC + 128 + c8 + 4);
                ckk[0] = (f32x2){a0[0], a0[1]}; ckk[1] = (f32x2){a0[2], a0[3]}; ckk[2] = (f32x2){a1[0], a1[1]}; ckk[3] = (f32x2){a1[2], a1[3]};
                cka[0] = (f32x2){b0[0], b0[1]}; cka[1] = (f32x2){b0[2], b0[3]}; cka[2] = (f32x2){b1[0], b1[1]}; cka[3] = (f32x2){b1[2], b1[3]};
                crk[0] = (f32x2){c0[0], c0[1]}; crk[1] = (f32x2){c0[2], c0[3]}; crk[2] = (f32x2){c1[0], c1[1]}; crk[3] = (f32x2){c1[2], c1[3]}; }
              f32x2 kk[4], s2 = (f32x2){0.f, 0.f};
#pragma unroll
              for (int j = 0; j < 4; ++j) { kk[j] = k[j] * ckk[j]; s2 += kk[j] * kk[j]; }
              float ss = s2.x + s2.y;
              ss += SHX(ss, 1); ss += SHX(ss, 2); ss += SHX(ss, 4);
              const float rn = 1.0f / sqrtf(fmaxf(ss, 1e-24f));
              f32x2 alv[4], csv[4], csm[4];
              { const f32x4 a0 = *(const LAS f32x4*)(AL + tau * LD32 + c8), a1 = *(const LAS f32x4*)(AL + tau * LD32 + c8 + 4), c0 = *(const LAS f32x4*)(LW + tau * LD32 + c8), c1 = *(const LAS f32x4*)(LW + tau * LD32 + c8 + 4);
                const int tm = (tau & 15) ? tau - 1 : tau; f32x4 e0 = *(const LAS f32x4*)(LW + tm * LD32 + c8), e1 = *(const LAS f32x4*)(LW + tm * LD32 + c8 + 4);
                if ((tau & 15) == 0) { e0 = F4Z; e1 = F4Z; }
                alv[0] = (f32x2){a0[0], a0[1]}; alv[1] = (f32x2){a0[2], a0[3]}; alv[2] = (f32x2){a1[0], a1[1]}; alv[3] = (f32x2){a1[2], a1[3]};
                csv[0] = (f32x2){c0[0], c0[1]} + offb[0]; csv[1] = (f32x2){c0[2], c0[3]} + offb[1]; csv[2] = (f32x2){c1[0], c1[1]} + offb[2]; csv[3] = (f32x2){c1[2], c1[3]} + offb[3];
                csm[0] = (f32x2){e0[0], e0[1]} + offb[0]; csm[1] = (f32x2){e0[2], e0[3]} + offb[1]; csm[2] = (f32x2){e1[0], e1[1]} + offb[2]; csm[3] = (f32x2){e1[2], e1[3]} + offb[3]; }
              f32x2 at[4], rt[4], bt[4], kt[4], bh[4], kh[4], bon2 = (f32x2){0.f, 0.f};
#pragma unroll
              for (int j = 0; j < 4; ++j) { const f32x2 al = alv[j], cs = csv[j], dh = totC[j] - cs;
                  const f32x2 kkn = kk[j] * rn, kd = k[j] * ((al - 1.0f) * cka[j] + 1.0f), bb = kkn * al;
                  bon2 += r[j] * kd * crk[j];
                  const f32x2 encs = (f32x2){__builtin_amdgcn_exp2f(-cs.x), __builtin_amdgcn_exp2f(-cs.y)}, eh = (f32x2){__builtin_amdgcn_exp2f(dh.x), __builtin_amdgcn_exp2f(dh.y)};
                  const f32x2 ecm = (f32x2){__builtin_amdgcn_exp2f(csm[j].x), __builtin_amdgcn_exp2f(csm[j].y)}, ecs = (f32x2){__builtin_amdgcn_exp2f(cs.x), __builtin_amdgcn_exp2f(cs.y)};
                  at[j] = -(ecm * kkn); rt[j] = ecs * r[j]; bt[j] = encs * bb; kt[j] = encs * kd; bh[j] = eh * bb; kh[j] = eh * kd; }
              if (tau == 63) {
#pragma unroll
                  for (int j = 0; j < 4; ++j) { gC[c8 + 2 * j] = __builtin_amdgcn_exp2f(totC[j].x); gC[c8 + 2 * j + 1] = __builtin_amdgcn_exp2f(totC[j].y); } }
#define PK8V(a) ((u32x4){pk2(a[0].x, a[0].y), pk2(a[1].x, a[1].y), pk2(a[2].x, a[2].y), pk2(a[3].x, a[3].y)})
              *(LAS u32x4*)(SLOT(0) + tau * LD16 + c8) = PK8V(at); *(LAS u32x4*)(SLOT(1) + tau * LD16 + c8) = PK8V(rt);
              *(LAS u32x4*)(SLOT(2) + tau * LD16 + c8) = PK8V(bt); *(LAS u32x4*)(SLOT(3) + tau * LD16 + c8) = PK8V(kt);
              *(LAS u32x4*)(SLOT(4) + tau * LD16 + c8) = PK8V(bh); *(LAS u32x4*)(SLOT(9) + tau * LD16 + c8) = PK8V(kh);
#undef PK8V
              *(LAS u32x4*)(SLOT(10) + tau * LD16 + c8) = cv;
              if (d == 0) *(u32x4*)(GATE + (size_t)row * DA + 64 * h + c8) = *(const LAS u32x4*)(SLOT(11) + pos * LD16 + c8);
              float bon = bon2.x + bon2.y;
              bon += SHX(bon, 1); bon += SHX(bon, 2); bon += SHX(bon, 4);
              BONUS[((size_t)d * M + row) * NH + h] = bon; }
            LBAR();
            }
            { int nitem = d == 0 ? item : item + G; const int nd = d ^ 1; if (nitem >= (M / 64) * NH) nitem = item; CA_ISSUE(nitem, nd); }
            for (int repB = 0; repB < (PROBE_SUB == 2 ? 2 : 1); ++repB) {
            { STG; bf16x8 aB[2], aA[2], aK[2];
#pragma unroll
              for (int ks = 0; ks < 2; ++ks) { aB[ks] = frag_rm(SLOT(2), m0, ks, fr, fq); aA[ks] = frag_rm(SLOT(0), m0, ks, fr, fq); aK[ks] = frag_rm(SLOT(3), m0, ks, fr, fq); }
#pragma unroll
              for (int nn = 0; nn < 2; ++nn) { const int n0 = 16 * (np + nn), n = n0 + fr; bf16x8 bA[2], bB[2], bK[2], bR[2];
#pragma unroll
                  for (int ks = 0; ks < 2; ++ks) { bA[ks] = frag_rm(SLOT(0), n0, ks, fr, fq); bB[ks] = frag_rm(SLOT(2), n0, ks, fr, fq); bK[ks] = frag_rm(SLOT(3), n0, ks, fr, fq); bR[ks] = frag_rm(SLOT(1), n0, ks, fr, fq); }
                  f32x4 p0 = mm2(aB, bA, F4Z), p1 = mm2(aA, bB, F4Z), p2 = mm2(aA, bK, F4Z), p3 = mm2(aB, bR, F4Z), p4 = mm2(aK, bR, F4Z), t0;
#pragma unroll
                  for (int r = 0; r < 4; ++r) { const int m = m0 + 4 * fq + r;
                      p0[r] = m < n ? p0[r] : 0.f; p1[r] = n < m ? p1[r] : 0.f; p2[r] = n < m ? p2[r] : 0.f; p3[r] = m <= n ? p3[r] : 0.f; p4[r] = m <= n ? p4[r] : 0.f;
                      t0[r] = p1[r] + (m == n ? 1.0f : 0.f); }
                  st_nat(SLOT(5), n0, m0, fr, fq, p0); st_nat(SLOT(6), n0, m0, fr, fq, p1); st_nat(SLOT(7), n0, m0, fr, fq, t0);
                  st_nat(SLOT(8), n0, m0, fr, fq, p2); st_nat(SLOT(11), n0, m0, fr, fq, p3); st_nat(SLOT(12), n0, m0, fr, fq, p4); } }
            LBAR();
#define MM1(a, b, c) __builtin_amdgcn_mfma_f32_16x16x32_bf16(a, b, c, 0, 0, 0)
            { STG; const int b = wave >> 2, bm0 = 32 * b + 16 * ((wave >> 1) & 1), bn0 = 32 * b + 16 * (wave & 1), oc = 32 * (1 - b) - 32 * b;
              const bf16x8 aT = frag_rm(SLOT(5), bm0, b, fr, fq), aR = frag_rm(SLOT(6), bm0, b, fr, fq), bR = frag_rm(SLOT(6), bn0, b, fr, fq), bT = frag_rm(SLOT(5), bn0, b, fr, fq);
              st_nat(SLOT(2), bn0, bm0, fr, fq, MM1(aT, bR, F4Z)); st_nat(SLOT(2), bn0, bm0 + oc, fr, fq, MM1(aR, bT, F4Z)); }
            LBAR();
#pragma unroll
            for (int kq = 1; kq <= 4; ++kq) {
                STG; const int b = wave >> 2, bm0 = 32 * b + 16 * ((wave >> 1) & 1), bn0 = 32 * b + 16 * (wave & 1), oc = 32 * (1 - b) - 32 * b;
                const int pin = (kq & 1) ? 2 : 3, pout = (kq & 1) ? 3 : 2, tin = (kq & 1) ? 7 : 13, tout = (kq & 1) ? 13 : 7;
                const bf16x8 aPT = frag_rm(SLOT(pin), bm0, 1 - b, fr, fq), bTn = frag_rm(SLOT(tin), bn0, b, fr, fq);
                st_nat(SLOT(tout), bn0, bm0, fr, fq, MM1(aPT, bTn, ld4bf(SLOT(tin) + (bn0 + fr) * LD16 + bm0 + 4 * fq)));
                if (kq < 4) { const bf16x8 aPR = frag_rm(SLOT(pin), bm0, b, fr, fq), bPR = frag_rm(SLOT(pin), bn0, b, fr, fq), bPT = frag_rm(SLOT(pin), bn0, 1 - b, fr, fq);
                    st_nat(SLOT(pout), bn0, bm0, fr, fq, MM1(aPT, bPR, F4Z));
                    st_nat(SLOT(pout), bn0, bm0 + oc, fr, fq, MM1(aPR, bPT, F4Z)); }
                LBAR();
            }
            { STG; if (wave < 4) { const int xm0 = 16 * ((wave >> 1) & 1), xn0 = 32 + 16 * (wave & 1);
                  const bf16x8 a = frag_rm(SLOT(6), xm0, 1, fr, fq), bb = frag_tr(SLOT(7), 32, xn0, fr, fq);
                  st_nat(SLOT(13), xn0, xm0, fr, fq, MM1(a, bb, F4Z)); } }
            LBAR();
            { STG; if (wave < 4) { const int tn0 = 32 + 16 * ((wave >> 1) & 1), tm0 = 16 * (wave & 1);
                  const bf16x8 a = frag_rm(SLOT(13), tn0, 0, fr, fq), bb = frag_rm(SLOT(7), tm0, 0, fr, fq);
                  st_nat(SLOT(7), tm0, tn0, fr, fq, MM1(a, bb, F4Z)); } }
            LBAR();
#undef MM1
            { STG; const int xt = wave, n0 = 16 * (xt & 3); bf16x8 b[2];
              if (xt < 4) { b[0] = frag_rm(SLOT(11), n0, 0, fr, fq); b[1] = frag_rm(SLOT(11), n0, 1, fr, fq); }
              else { b[0] = frag_tr(SLOT(4), 0, n0, fr, fq); b[1] = frag_tr(SLOT(4), 32, n0, fr, fq); }
#pragma unroll
              for (int mm = 0; mm < 4; ++mm) { bf16x8 a[2] = {frag_rm(SLOT(7), 16 * mm, 0, fr, fq), frag_rm(SLOT(7), 16 * mm, 1, fr, fq)};
                  st_nat(xt < 4 ? SLOT(5) : SLOT(6), n0, 16 * mm, fr, fq, mm2(a, b, F4Z)); } }
            LBAR();
            }
            for (int repC = 0; repC < (PROBE_SUB == 3 ? 2 : 1); ++repC) {
            { STG; bf16x8 aAt[2] = {frag_tr(SLOT(0), 0, m0, fr, fq), frag_tr(SLOT(0), 32, m0, fr, fq)}, aAk[2] = {frag_rm(SLOT(8), m0, 0, fr, fq), frag_rm(SLOT(8), m0, 1, fr, fq)};
              bf16* pyt = (bf16*)(F.ws + WS_PYT) + qi * 4096; bf16* qyt = (bf16*)(F.ws + WS_QYT) + qi * 4096; bf16* pst = (bf16*)(F.ws + WS_PST) + qi * 4096;
#pragma unroll
              for (int nn = 0; nn < 2; ++nn) { const int n0 = 16 * (np + nn), n = n0 + fr, mb = m0 + 4 * fq;
                  bf16x8 bRb[2] = {frag_rm(SLOT(5), n0, 0, fr, fq), frag_rm(SLOT(5), n0, 1, fr, fq)}, bBh[2] = {frag_rm(SLOT(6), n0, 0, fr, fq), frag_rm(SLOT(6), n0, 1, fr, fq)};
                  const f32x4 py = mm2(aAt, bRb, ld4bf(SLOT(1) + n * LD16 + mb)), qy = mm2(aAk, bRb, ld4bf(SLOT(12) + n * LD16 + mb));
                  f32x4 psi, qsi;
#pragma unroll
                  for (int r = 0; r < 4; ++r) { psi[r] = (mb + r == n) ? gC[n] : 0.f; qsi[r] = bf2f(SLOT(9)[(mb + r) * LD16 + n]); }
                  const f32x4 ps = mm2(aAt, bBh, psi), qs = mm2(aAk, bBh, qsi);
                  { const int fo = fm_off(n0, m0, fr, fq); *(u32x2*)(pyt + fo) = pk4(py); *(u32x2*)(qyt + fo) = pk4(qy); *(u32x2*)(pst + fo) = pk4(ps); }
                  st_nat(SLOT(2), n0, m0, fr, fq, qs); } }
            LBAR();
            { STG; bf16* nct = (bf16*)(F.ws + WS_NCT) + qi * 4096;
              bf16x8 a[2] = {frag_rm(SLOT(2), m0, 0, fr, fq), frag_rm(SLOT(2), m0, 1, fr, fq)};
#pragma unroll
              for (int nn = 0; nn < 2; ++nn) { const int n0 = 16 * (np + nn); bf16x8 b[2] = {frag_tr(SLOT(10), 0, n0, fr, fq), frag_tr(SLOT(10), 32, n0, fr, fq)};
                  *(u32x2*)(nct + ((((n0 >> 4) * 4 + mt) * 64 + lane) << 2)) = pk4(mm2(a, b, F4Z));
                  } }
            LBAR();
            }
        }
    }
#undef STG
#undef CA_ISSUE
}

__device__ __forceinline__ void p_chunkB(Frame& F, int l) {
    PH_LOCALS(F); PH_LAYER(l);
    const int fr = lane & 15, fq = lane >> 4;
    LAS bf16* Sl = (LAS bf16*)(F.lds + wave * 2304);
    const bf16* PST = (const bf16*)(F.ws + WS_PST); const bf16* NCT = (const bf16*)(F.ws + WS_NCT); bf16* SC = (bf16*)(F.ws + WS_SC);
    for (int cp = bx; cp < 64; cp += G) {
        const int cslot = wave >> 2, chain = 2 * cp + cslot, vb = wave & 3, b = chain >> 5, h = (chain >> 1) & 15, d = chain & 1, cb = 64 + b * 64; constexpr int NC = 64;
        LAS bf16* AL = (LAS bf16*)(F.lds + 20480) + cslot * 3 * 4096;
        f32x4 S[4];
        { const float* src = F.in[I_STATE] + ((((size_t)b * NL + l) * 2 + d) * NH + h) * 4096 + (size_t)(16 * vb + fr) * 64 + 4 * fq;
#pragma unroll
          for (int T = 0; T < 4; ++T) S[T] = *(const f32x4*)(src + 16 * T); }
        bf16x8 Aq[8][2]; u32x2 Nq[8][4];
#define LB_QI(step) ((((size_t)(cb + (d ? NC - 1 - (step) : (step)))) * 16 + h) * 2 + d)
#define LB_LDA(u, step) do { const int st_ = (step) < NC ? (step) : NC - 1; const bf16* ps_ = PST + LB_QI(st_) * 4096 + vb * 1024 + lane * 8; Aq[u][0] = *(const bf16x8*)ps_; Aq[u][1] = *(const bf16x8*)(ps_ + 512); } while (0)
#define LB_LDN(u, step) do { const int st_ = (step) < NC ? (step) : NC - 1; const bf16* nc_ = NCT + LB_QI(st_) * 4096 + ((vb * 4 * 64 + lane) << 2); \
        _Pragma("unroll") for (int mt_ = 0; mt_ < 4; ++mt_) Nq[u][mt_] = *(const u32x2*)(nc_ + mt_ * 256); } while (0)
#pragma unroll
        for (int u = 0; u < 8; ++u) { LB_LDA(u, u); LB_LDN(u, u); }
        *(LAS bf16x8*)(AL + ((vb * 2 + 0) * 64 + lane) * 8) = Aq[0][0]; *(LAS bf16x8*)(AL + ((vb * 2 + 1) * 64 + lane) * 8) = Aq[0][1];
        LB_LDA(0, 8);
        for (int g = 0; g < NC; g += 8) {
#pragma unroll
            for (int u = 0; u < 8; ++u) {
                const int step = g + u; const size_t q = LB_QI(step); bf16* scg = SC + q * 4096;
#pragma unroll
                for (int T = 0; T < 4; ++T) { const u32x2 w = pk4(S[T]); *(LAS u32x2*)(Sl + fr * LD16 + 16 * T + 4 * fq) = w; *(u32x2*)(scg + fm_off(16 * vb, 16 * T, fr, fq)) = w; }
                { LAS bf16* nb_ = AL + ((step + 1) % 3) * 4096; const int u1 = (u + 1) & 7;
                  *(LAS bf16x8*)(nb_ + ((vb * 2 + 0) * 64 + lane) * 8) = Aq[u1][0]; *(LAS bf16x8*)(nb_ + ((vb * 2 + 1) * 64 + lane) * 8) = Aq[u1][1];
                  LB_LDA(u1, step + 9); }
                LBAR();
                const LAS bf16* cbuf = AL + (step % 3) * 4096 + lane * 8;
                const bf16x8 b0 = *(const LAS bf16x8*)(Sl + fr * LD16 + 8 * fq), b1 = *(const LAS bf16x8*)(Sl + fr * LD16 + 8 * fq + 32);
#pragma unroll
                for (int mt = 0; mt < 4; ++mt) { const u32x2 nw = Nq[u][mt];
                    f32x4 acc = (f32x4){__uint_as_float(nw.x << 16), __uint_as_float(nw.x & 0xffff0000u), __uint_as_float(nw.y << 16), __uint_as_float(nw.y & 0xffff0000u)};
                    acc = __builtin_amdgcn_mfma_f32_16x16x32_bf16(*(const LAS bf16x8*)(cbuf + (mt * 2) * 512), b0, acc, 0, 0, 0);
                    acc = __builtin_amdgcn_mfma_f32_16x16x32_bf16(*(const LAS bf16x8*)(cbuf + (mt * 2 + 1) * 512), b1, acc, 0, 0, 0);
                    S[mt] = acc; }
                LB_LDN(u, step + 8);
            }
        }
#undef LB_LDA
#undef LB_LDN
#undef LB_QI
        LBAR();
    }
    const int w0 = (G > 64) ? (bx - 64) * NWAVES + wave : bx * NWAVES + wave, wst = (G > 64) ? (G - 64) * NWAVES : G * NWAVES;
    if (G > 64 && bx < 64) return;
    for (int t = w0; t < 2048; t += wst) {
        const int chain = t >> 2, vb = t & 3, b = chain >> 5, h = (chain >> 1) & 15, d = chain & 1, cb = b * 4; constexpr int NC = 4;
        f32x4 S[4];
#pragma unroll
        for (int T = 0; T < 4; ++T) S[T] = (f32x4){0.f, 0.f, 0.f, 0.f};
        bf16x8 Apf[4][8]; u32x2 Npf[4][4];
#define CB_QI(step) ((((size_t)(cb + (d ? NC - 1 - (step) : (step)))) * 16 + h) * 2 + d)
#define CB_LOAD(u, step) do { const size_t q_ = CB_QI(step); const bf16* ps_ = PST + q_ * 4096 + lane * 8; const bf16* nc_ = NCT + q_ * 4096 + ((vb * 4 * 64 + lane) << 2); \
        _Pragma("unroll") for (int mt_ = 0; mt_ < 4; ++mt_) { Apf[u][2 * mt_] = *(const bf16x8*)(ps_ + mt_ * 1024); Apf[u][2 * mt_ + 1] = *(const bf16x8*)(ps_ + mt_ * 1024 + 512); Npf[u][mt_] = *(const u32x2*)(nc_ + mt_ * 256); } } while (0)
        CB_LOAD(0, 0); CB_LOAD(1, 1); CB_LOAD(2, 2); CB_LOAD(3, 3);
#pragma unroll
        for (int u = 0; u < 4; ++u) {
            const int step = u; const size_t q = CB_QI(step); bf16* scg = SC + q * 4096;
            asm volatile("" ::: "memory");
#pragma unroll
            for (int T = 0; T < 4; ++T) { const u32x2 w = pk4(S[T]); *(LAS u32x2*)(Sl + fr * LD16 + 16 * T + 4 * fq) = w; *(u32x2*)(scg + fm_off(16 * vb, 16 * T, fr, fq)) = w; }
            asm volatile("s_waitcnt lgkmcnt(0)" ::: "memory");
            const bf16x8 b0 = *(const LAS bf16x8*)(Sl + fr * LD16 + 8 * fq), b1 = *(const LAS bf16x8*)(Sl + fr * LD16 + 8 * fq + 32);
#pragma unroll
            for (int mt = 0; mt < 4; ++mt) { const u32x2 nw = Npf[u][mt];
                f32x4 acc = (f32x4){__uint_as_float(nw.x << 16), __uint_as_float(nw.x & 0xffff0000u), __uint_as_float(nw.y << 16), __uint_as_float(nw.y & 0xffff0000u)};
                acc = __builtin_amdgcn_mfma_f32_16x16x32_bf16(Apf[u][2 * mt], b0, acc, 0, 0, 0);
                acc = __builtin_amdgcn_mfma_f32_16x16x32_bf16(Apf[u][2 * mt + 1], b1, acc, 0, 0, 0);
                S[mt] = acc; }
            asm volatile("s_waitcnt lgkmcnt(0)" ::: "memory");
        }
#undef CB_LOAD
#undef CB_QI
        { float* dst = F.out + (size_t)M * D + ((((size_t)b * NL + l) * 2 + d) * NH + h) * 4096 + (size_t)(16 * vb + fr) * 64 + 4 * fq;
#pragma unroll
          for (int T = 0; T < 4; ++T) *(f32x4*)(dst + 16 * T) = S[T]; }
    }
}

__device__ __forceinline__ void p_chunkC(Frame& F, int l) {
    PH_LOCALS(F); PH_LAYER(l);
    LAS unsigned char* lds = F.lds;
    const int fr = lane & 15, fq = lane >> 4, d = wave >> 2, nb = wave & 3;
    const bf16* PS = (const bf16*)(F.ws + WS_PS); const bf16* GATE = (const bf16*)(F.ws + WS_GATE); const float* BONUS = (const float*)(F.ws + WS_BONUS);
    bf16* O = (bf16*)(F.ws + WS_O);
    constexpr int NIT = (M / 64) * NH;
    f32x4 gnw[4], gnb[4]; int hcur = -1;
    bf16x8 fa0[4][2], fb0[4]; u32x4 pv0, pg0; float pb00, pb01;
    LAS bf16* VT0 = (LAS bf16*)(lds + 2 * 17408);
#define CC_ISSUE(item_, fa, fb, pv, pg, pb0, pb1) do { const int ci_ = (item_) >> 4, h_ = (item_) & 15; const size_t qi_ = ((size_t)ci_ * 16 + h_) * 2 + d; \
        const bf16* sc_ = (const bf16*)(F.ws + WS_SC) + qi_ * 4096 + lane * 8; \
        const bf16* py_ = (const bf16*)(F.ws + WS_PYT) + qi_ * 4096 + nb * 1024 + lane * 8; const bf16* qy_ = (const bf16*)(F.ws + WS_QYT) + qi_ * 4096 + nb * 1024 + lane * 8; \
        fb[0] = *(const bf16x8*)py_; fb[1] = *(const bf16x8*)(py_ + 512); fb[2] = *(const bf16x8*)qy_; fb[3] = *(const bf16x8*)(qy_ + 512); \
        _Pragma("unroll") for (int vt4_ = 0; vt4_ < 4; ++vt4_) { fa[vt4_][0] = *(const bf16x8*)(sc_ + vt4_ * 1024); fa[vt4_][1] = *(const bf16x8*)(sc_ + vt4_ * 1024 + 512); } \
        const int row_ = ci_ * 64 + (tid >> 3), chn_ = 64 * h_ + (tid & 7) * 8; \
        pv = *(const u32x4*)(PS + (size_t)row_ * CSH + 2 * DA + chn_); pg = *(const u32x4*)(GATE + (size_t)row_ * DA + chn_); pb0 = BONUS[(size_t)row_ * NH + h_]; pb1 = BONUS[((size_t)M + row_) * NH + h_]; } while (0)
#define CC_BODY(item_, fa, fb, pv, pg, pb0, pb1, next_) do { const int ci = (item_) >> 4, h = (item_) & 15, R0 = ci * 64; \
        if (h != hcur) { hcur = h; _Pragma("unroll") for (int vtile = 0; vtile < 4; ++vtile) { gnw[vtile] = *(const f32x4*)(F.in[I_GNW] + (size_t)l * DA + 64 * h + 16 * vtile + 4 * fq); gnb[vtile] = *(const f32x4*)(F.in[I_GNB] + (size_t)l * DA + 64 * h + 16 * vtile + 4 * fq); } } \
        const u32x4 cv = pv, cgt = pg; const float bon = pb0 + pb1; \
        { const int p_ = tid >> 3, c_ = (tid & 7) * 8; *(LAS u32x4*)(VT0 + p_ * LD16 + c_) = cv; *(LAS u32x4*)(VT0 + (64 + 63 - p_) * LD16 + c_) = cv; } \
        LBAR(); \
        f32x4 acc[4]; float s = 0.f; \
        _Pragma("unroll") for (int vtile = 0; vtile < 4; ++vtile) { f32x4 a = F4Z; \
            a = __builtin_amdgcn_mfma_f32_16x16x32_bf16(fa[vtile][0], fb[0], a, 0, 0, 0); a = __builtin_amdgcn_mfma_f32_16x16x32_bf16(fa[vtile][1], fb[1], a, 0, 0, 0); \
            a = __builtin_amdgcn_mfma_f32_16x16x32_bf16(frag_tr(VT0 + d * 64 * LD16, 0, 16 * vtile, fr, fq), fb[2], a, 0, 0, 0); a = __builtin_amdgcn_mfma_f32_16x16x32_bf16(frag_tr(VT0 + d * 64 * LD16, 32, 16 * vtile, fr, fq), fb[3], a, 0, 0, 0); \
            acc[vtile] = a; s += (a[0] + a[1]) + (a[2] + a[3]); } \
        if ((next_) < NIT) CC_ISSUE((next_), fa, fb, pv, pg, pb0, pb1); \
        s += SHX(s, 16); s += SHX(s, 32); \
        const float mean = s * (1.0f / 64.0f); float qv = 0.f; \
        _Pragma("unroll") for (int vtile = 0; vtile < 4; ++vtile) { acc[vtile] = acc[vtile] - mean; const f32x4 a = acc[vtile]; qv += (a[0] * a[0] + a[1] * a[1]) + (a[2] * a[2] + a[3] * a[3]); } \
        qv += SHX(qv, 16); qv += SHX(qv, 32); \
        const float rstd = 1.0f / sqrtf(qv * (1.0f / 64.0f) + GN_EPS); \
        const int tau = 16 * nb + fr, pos = d ? 63 - tau : tau; \
        LAS float* Yd = (LAS float*)(lds + d * 17408); \
        _Pragma("unroll") for (int vtile = 0; vtile < 4; ++vtile) { const int v0 = 16 * vtile + 4 * fq; \
            *(LAS f32x4*)(Yd + pos * LD32 + v0) = acc[vtile] * rstd * gnw[vtile] + gnb[vtile]; } \
        LBAR(); \
        { const int pos2 = tid >> 3, c8 = (tid & 7) * 8, row = R0 + pos2, chn = 64 * h + c8; \
          const LAS float* Y0 = (const LAS float*)lds; const LAS float* Y1 = (const LAS float*)(lds + 17408); \
          float v[8], gt[8], o[8]; unpack8(cv, v); unpack8(cgt, gt); \
          const f32x4 y00 = *(const LAS f32x4*)(Y0 + pos2 * LD32 + c8), y01 = *(const LAS f32x4*)(Y0 + pos2 * LD32 + c8 + 4), y10 = *(const LAS f32x4*)(Y1 + pos2 * LD32 + c8), y11 = *(const LAS f32x4*)(Y1 + pos2 * LD32 + c8 + 4); \
          _Pragma("unroll") for (int j = 0; j < 4; ++j) { o[j] = (y00[j] + y10[j] + bon * v[j]) * gt[j]; o[4 + j] = (y01[j] + y11[j] + bon * v[4 + j]) * gt[4 + j]; } \
          *(u32x4*)(O + (size_t)row * D + chn) = pack8(o); } \
        LBAR(); } while (0)
    if (bx < NIT) CC_ISSUE(bx, fa0, fb0, pv0, pg0, pb00, pb01);
    for (int item = bx; item < NIT; item += G) {
        CC_BODY(item, fa0, fb0, pv0, pg0, pb00, pb01, item + G);
    }
#undef CC_BODY
#undef CC_ISSUE
}

__device__ __forceinline__ void p_final(Frame& F) {
    PH_LOCALS(F);
    const int gw = bx * NWAVES + wave, NGW = G * NWAVES;
    const float* fg = F.in[I_FNG];
    f32x4 fgv[8];
#pragma unroll
    for (int j = 0; j < 8; ++j) fgv[j] = *(const f32x4*)(fg + 4 * lane + 256 * j);
    for (int row = gw; row < M; row += NGW) {
        float* xr = F.out + (size_t)row * D;
        f32x4 v[8]; float ss = 0.f;
#pragma unroll
        for (int j = 0; j < 8; ++j) { v[j] = *(const f32x4*)(xr + 4 * lane + 256 * j); ss += (v[j].x * v[j].x + v[j].y * v[j].y) + (v[j].z * v[j].z + v[j].w * v[j].w); }
        WAVE_SUM(ss); const float rstd = 1.0f / sqrtf(ss * (1.0f / D) + RMS_EPS);
#pragma unroll
        for (int j = 0; j < 8; ++j) { const int c = 4 * lane + 256 * j; *(f32x4*)(xr + c) = v[j] * rstd * fgv[j]; }
    }
}

constexpr int PH_PER_LAYER = 10, N_PHASES = 2 + NL * PH_PER_LAYER;
__global__ void __launch_bounds__(NWAVES * 64, 2) hymba_fwd(Args args) {
    extern __shared__ __attribute__((aligned(16))) unsigned char lds[];
    Frame F;
    F.lds = (LAS unsigned char*)lds;
    F.tid = threadIdx.x; F.lane = F.tid & 63; F.wave = __builtin_amdgcn_readfirstlane(F.tid >> 6);
    F.G = gridDim.x; F.bx = blockIdx.x;
    F.in = args.in; F.out = args.out; F.ws = args.ws;
    for (int u = F.tid; u < (LDS_BYTES - LDSCTL_OFF) / 4; u += NWAVES * 64) ((LAS unsigned*)(F.lds + LDSCTL_OFF))[u] = 0u;
    __syncthreads();
    volatile LAS unsigned* MISC = (volatile LAS unsigned*)(F.lds + MISC_OFF);
    unsigned* barw = (unsigned*)(F.ws + WS_CTL) + CW_BAR;
    XcdBarrier bar; bar.bar = barw; bar.x = 0; bar.st = nullptr;
    if (MK_N_LAUNCHES == 1) bar = xcd_barrier_post(barw, MISC + 8);
    const int lo = args.ph_lo, hi = args.ph_hi;
#define IN(k) (lo <= (k) && (k) < hi)
#define SEAM(k) do { if (MK_N_LAUNCHES == 1 && IN(k) && IN((k) + 1)) xcd_barrier(bar); } while (0)

    for (int rep = 0; rep < ((PROBE_DUP == 30) ? 2 : 1); ++rep)
    if (IN(0)) { p0_prologue(F); __syncthreads(); } SEAM(0);
    bf16* H = (bf16*)(F.ws + WS_H); bf16* O = (bf16*)(F.ws + WS_O); bf16* P = (bf16*)(F.ws + WS_P); bf16* HID = (bf16*)(F.ws + WS_HID);
    const float* mod = (const float*)(F.ws + WS_MOD);
    for (int l = 0; l < NL; ++l) {
        const int pb = 1 + l * PH_PER_LAYER;
        const float* xlo = l == 0 ? F.in[I_XP] : F.out; const float* xhi = l == 0 ? F.in[I_XS] : F.out + (size_t)MCTX * D;
        float* dummy = (float*)(F.ws + WS_P);
        for (int rep = 0; rep < ((PROBE_DUP == 7) ? 2 : 1); ++rep)
        if (IN(pb + 0)) { p_adaln(F, l, 0, xlo, xhi); } SEAM(pb + 0);
        for (int rep = 0; rep < ((PROBE_DUP == 1 || PROBE_DUP == 20) ? 2 : 1); ++rep)
        if (IN(pb + 1)) { pg8::Gemm g{H, (const bf16*)(F.ws + WS_WIN + l * SZ_WIN), M, PINP, D}; pg8::StaticOrder S; { int cb_ = F.bx, cg_ = F.G; asm volatile("" : "+s"(cb_), "+s"(cg_)); S.init(M, PINP, cg_, cb_, D); }
            EpiP E{P, PINP, CSH}; pg8::gemm_phase<EpiP, pg8::StaticOrder, true, true>(F.lds, g, S, E, F.wave); } SEAM(pb + 1);
        for (int rep = 0; rep < ((PROBE_DUP == 2) ? 2 : 1); ++rep)
        if (IN(pb + 2)) { p_shift(F, l); } SEAM(pb + 2);
        if (IN(pb + 3)) { for (int rep = 0; rep < ((PROBE_DUP == 3) ? 2 : 1); ++rep) p_chunkA(F, l); } SEAM(pb + 3);
        for (int rep = 0; rep < ((PROBE_DUP == 4) ? 2 : 1); ++rep)
        if (IN(pb + 4)) { p_chunkB(F, l);
            for (int rep = 0; rep < ((PROBE_DUP == 13) ? 2 : 1); ++rep) p_gmlp(F, l, F.G > 64 ? (F.bx >= 64 ? F.bx - 64 : -1) : F.bx, F.G > 64 ? F.G - 64 : F.G); } SEAM(pb + 4);
        for (int rep = 0; rep < ((PROBE_DUP == 5) ? 2 : 1); ++rep)
        if (IN(pb + 5)) { p_chunkC(F, l); } SEAM(pb + 5);
        if ((PROBE_DUP == 6 || PROBE_DUP == 20) && IN(pb + 6)) { pg8::Gemm g{O, (const bf16*)(F.ws + WS_WOUT + l * SZ_WOUT), M, D, D}; pg8::StaticOrder S; { int cb_ = F.bx, cg_ = F.G; asm volatile("" : "+s"(cb_), "+s"(cg_)); S.init(M, D, cg_, cb_, D); }
            EpiRes E{xlo, xhi, dummy, mod + (size_t)l * 5 * MODW, 2 * D}; pg8::gemm_phase<EpiRes, pg8::StaticOrder, true, true>(F.lds, g, S, E, F.wave); }
        if (IN(pb + 6)) { pg8::Gemm g{O, (const bf16*)(F.ws + WS_WOUT + l * SZ_WOUT), M, D, D}; pg8::FullRoundsOrder S; pg8::TailHalfOrder S2; { int cb_ = F.bx, cg_ = F.G; asm volatile("" : "+s"(cb_), "+s"(cg_)); S.init(M, D, cg_, cb_, D); S2.init(M, D, cg_, cb_, D); }
            EpiRes E{xlo, xhi, F.out, mod + (size_t)l * 5 * MODW, 2 * D}; pg8::gemm_phase<EpiRes, pg8::FullRoundsOrder, true, true>(F.lds, g, S, E, F.wave);
            pg8::gemm_phase<EpiRes, pg8::TailHalfOrder, true, true, true>(F.lds, g, S2, E, F.wave); } SEAM(pb + 6);
        for (int rep = 0; rep < ((PROBE_DUP == 7) ? 2 : 1); ++rep)
        if (IN(pb + 7)) { p_adaln(F, l, 1, F.out, F.out + (size_t)MCTX * D); } SEAM(pb + 7);
        for (int rep = 0; rep < ((PROBE_DUP == 8 || PROBE_DUP == 20) ? 2 : 1); ++rep)
        if (IN(pb + 8)) { pg8::Gemm g{H, (const bf16*)(F.ws + WS_WGU + l * SZ_WGU), M, NGU, D}; pg8::StaticOrder S; { int cb_ = F.bx, cg_ = F.G; asm volatile("" : "+s"(cb_), "+s"(cg_)); S.init(M, NGU, cg_, cb_, D); }
            EpiSwi E{HID, DFF}; pg8::gemm_phase<EpiSwi, pg8::StaticOrder, true, true>(F.lds, g, S, E, F.wave); } SEAM(pb + 8);
        if ((PROBE_DUP == 9 || PROBE_DUP == 20) && IN(pb + 9)) { pg8::Gemm g{HID, (const bf16*)(F.ws + WS_WD + l * SZ_WD), M, D, DFF}; pg8::StaticOrder S; { int cb_ = F.bx, cg_ = F.G; asm volatile("" : "+s"(cb_), "+s"(cg_)); S.init(M, D, cg_, cb_, DFF); }
            EpiRes E{F.out, F.out + (size_t)MCTX * D, dummy, mod + (size_t)l * 5 * MODW, 5 * D}; pg8::gemm_phase<EpiRes, pg8::StaticOrder, true, true>(F.lds, g, S, E, F.wave); }
        if (IN(pb + 9)) { pg8::Gemm g{HID, (const bf16*)(F.ws + WS_WD + l * SZ_WD), M, D, DFF}; pg8::FullRoundsOrder S; pg8::TailHalfOrder S2; { int cb_ = F.bx, cg_ = F.G; asm volatile("" : "+s"(cb_), "+s"(cg_)); S.init(M, D, cg_, cb_, DFF); S2.init(M, D, cg_, cb_, DFF); }
            EpiRes E{F.out, F.out + (size_t)MCTX * D, F.out, mod + (size_t)l * 5 * MODW, 5 * D}; pg8::gemm_phase<EpiRes, pg8::FullRoundsOrder, true, true>(F.lds, g, S, E, F.wave);
            pg8::gemm_phase<EpiRes, pg8::TailHalfOrder, true, true, true>(F.lds, g, S2, E, F.wave); } SEAM(pb + 9);
    }
    if (IN(N_PHASES - 1)) { p_final(F); }
#undef IN
#undef SEAM
}

extern "C" void kernel_launch(void* const* d_in, const int* in_sizes, int n_in, void* d_out, int out_size, void* d_ws, size_t ws_size, hipStream_t stream) {
    static int grid = 0;
    if (grid == 0) {
        if (n_in != 30 || ws_size < WS_END) { fprintf(stderr, "kernel_launch: need 30 inputs and >= %zu bytes of workspace; got n_in %d, ws %zu\n", (size_t)WS_END, n_in, ws_size); grid = -1; return; }
        int dev = 0, cus = 0, per_cu = 0;
        if (hipGetDevice(&dev) != hipSuccess || hipDeviceGetAttribute(&cus, hipDeviceAttributeMultiprocessorCount, dev) != hipSuccess) { grid = -1; return; }
        if (hipFuncSetAttribute((const void*)hymba_fwd, hipFuncAttributeMaxDynamicSharedMemorySize, LDS_BYTES) != hipSuccess) { fprintf(stderr, "kernel_launch: hipFuncSetAttribute failed\n"); grid = -1; return; }
        if (hipOccupancyMaxActiveBlocksPerMultiprocessor(&per_cu, (const void*)hymba_fwd, NWAVES * 64, LDS_BYTES) != hipSuccess || per_cu < 1)
            fprintf(stderr, "kernel_launch: note: occupancy query reports %d workgroups per CU\n", per_cu);
        (void)hipGetLastError();
        grid = cus;
    }
    if (grid < 0) return;
    if (hipMemsetAsync((char*)d_ws + WS_CTL, 0, CTL_ZERO_BYTES, stream) != hipSuccess) return;
    Args a{};
    for (int i = 0; i < 30; ++i) a.in[i] = (const float*)d_in[i];
    a.out = (float*)d_out; a.ws = (unsigned char*)d_ws; a.pad = 0;
    if (MK_N_LAUNCHES == 1) {
        a.ph_lo = 0; a.ph_hi = N_PHASES; a.li = 0;
        hipLaunchKernelGGL(hymba_fwd, dim3(grid), dim3(NWAVES * 64), LDS_BYTES, stream, a);
    } else {
        for (int k = 0; k < N_PHASES; ++k) { a.ph_lo = k; a.ph_hi = k + 1; a.li = k;
            hipLaunchKernelGGL(hymba_fwd, dim3(grid), dim3(NWAVES * 64), LDS_BYTES, stream, a); }
    }
}
```

```cpp
#include <hip/hip_runtime.h>
#include <cstdio>
#include <cstdint>

#ifndef PROBE_DUP
#define PROBE_DUP -1
#endif
#ifndef PROBE_SUB
#define PROBE_SUB 0
#endif
#ifndef MK_N_LAUNCHES
#define MK_N_LAUNCHES 1
#endif

namespace pg8 {
#define PG8_LAS __attribute__((address_space(3)))
typedef unsigned short bf16_t;
typedef short bf16x8 __attribute__((ext_vector_type(8)));
typedef float f32x4 __attribute__((ext_vector_type(4)));
typedef unsigned u32x4 __attribute__((ext_vector_type(4)));
constexpr int BM = 256, BK = 64, HALF = 128, HTB = HALF * BK * 2  , STAGE_BYTES = 8 * HTB, NXCD = 8, WGM = 8;

__host__ __device__ __forceinline__ int lds_byte(int r, int c) { const int st = (r >> 4) * 2 + (c >> 5), rr = r & 15, cc = c & 31, ob = rr * 64 + cc * 2; return st * 1024 + (ob ^ (((ob >> 9) & 1) << 5)); }
__host__ __device__ __forceinline__ void stage_rc(int b, int& R, int& C) { const int st = b / 1024, sb = b % 1024, swz = sb ^ (((sb >> 9) & 1) << 5); R = (st >> 1) * 16 + swz / 64; C = (st & 1) * 32 + (swz % 64) / 2; }
__host__ __device__ __forceinline__ int perm32(int rho) { const int n = rho >> 4, i = rho & 15; return 8 * (i >> 2) + 4 * n + (i & 3); }

struct Unit { int pm, pn, k0, nk, bh; };
struct Gemm { const bf16_t* A; const bf16_t* Bt; int M, N, K; };

struct StaticOrder {
    int nM, nN, nwg, G, c, nkt, full, rem;
    __host__ __device__ void init(int M, int N, int G_, int c_, int K_) { nM = M / BM; nN = N / BM; nwg = nM * nN; G = G_; c = c_; nkt = K_ / BK; full = nwg / G; rem = nwg - full * G; }
    __host__ __device__ bool next(int i, Unit& u) const {
        const long L = (long)i * G + c; if (L >= nwg) return false;
        int wgid = (int)L; { const int q = nwg / NXCD, r = nwg % NXCD, xcd = wgid % NXCD, off = wgid / NXCD; wgid = (xcd < r ? xcd * (q + 1) : r * (q + 1) + (xcd - r) * q) + off; }
        const int nig = WGM * nN, gid = wgid / nig, fm = gid * WGM, gsz = (nM - fm) < WGM ? (nM - fm) : WGM;
        u.pm = fm + ((wgid % nig) % gsz); u.pn = (wgid % nig) / gsz; u.k0 = 0; u.nk = nkt; u.bh = -1;
#if defined(__HIP_DEVICE_COMPILE__)
        u.pm = __builtin_amdgcn_readfirstlane(u.pm); u.pn = __builtin_amdgcn_readfirstlane(u.pn);
#endif
        return true;
    }
    __device__ __forceinline__ void a_ready(const Unit&) const {}
    __device__ __forceinline__ void done(const Unit&) const {}
};
struct FullRoundsOrder : StaticOrder {
    __host__ __device__ bool split() const { return rem > 0 && 2 * rem <= G; }
    __host__ __device__ bool next(int i, Unit& u) const { if (split() && i >= full) return false; return StaticOrder::next(i, u); }
};
struct TailHalfOrder : StaticOrder {
    __host__ __device__ bool next(int i, Unit& u) const {
        if (!(rem > 0 && 2 * rem <= G) || i > 0 || c >= 2 * rem) return false;
        StaticOrder t = *this; t.c = c >> 1; if (!t.StaticOrder::next(full, u)) return false;
        u.bh = c & 1; return true;
    }
};

__device__ __forceinline__ unsigned cvt_pk_bf16(float lo, float hi) { unsigned r; asm volatile("v_cvt_pk_bf16_f32 %0, %1, %2" : "=v"(r) : "v"(lo), "v"(hi)); return r; }

template <class Epi, class Sched, bool ALIGN_EPI = false, bool SP2 = false, bool HALFB = false>
__device__ __forceinline__ void gemm_phase(PG8_LAS unsigned char* lds, const Gemm g, const Sched& S, const Epi& E, int wid) {
    asm volatile("" : "+s"(wid)); int lane; asm volatile("v_mbcnt_lo_u32_b32 %0, -1, 0\n\tv_mbcnt_hi_u32_b32 %0, -1, %0" : "=v"(lane));
    const int tid = wid * 64 + lane, wr = wid >> 2, wc = wid & 3, fr = lane & 15, fq = lane >> 4;
    const int K = g.K;
    unsigned voffA[2], voffB[2];
#pragma unroll
    for (int i = 0; i < 2; ++i) { int R, C; stage_rc(tid * 16 + i * 8192, R, C); const int Rb = Epi::PERM ? ((R & ~31) + perm32(R & 31)) : R;
        voffA[i] = (unsigned)(R * K + C) * 2u; voffB[i] = (unsigned)(Rb * K + C) * 2u; }
    const size_t kstep = (size_t)(BK * 2);
    const size_t hstep = (size_t)HALF * K * 2;
    const size_t tstep = 2 * hstep;
    const size_t bhs = HALFB ? 0 : hstep;
    const unsigned ldsw = (unsigned)wid * 1024u;
    const int aoff = lds_byte(wr * 64 + fr, fq * 8), boff = lds_byte(wc * 32 + fr, fq * 8);
#define PG8_SA(b, h) (((b) * 2 + (h)) * HTB)
#define PG8_SB(b, h) ((4 + (b) * 2 + (h)) * HTB)
#define PG8_STAGE(bufoff, gbase, voff) do { _Pragma("unroll") for (int _i = 0; _i < 2; ++_i) \
        __builtin_amdgcn_global_load_lds((const unsigned*)((const char*)(gbase) + (voff)[_i]), (PG8_LAS unsigned*)(lds + (bufoff) + ldsw + _i * 8192), 16, 0, 0); } while (0)
#define PG8_LDA(dst, b, h) do { _Pragma("unroll") for (int m = 0; m < 4; ++m) _Pragma("unroll") for (int k = 0; k < 2; ++k) dst[m][k] = *(const PG8_LAS bf16x8*)(lds + PG8_SA(b, h) + aoff + m * 2048 + k * 1024); } while (0)
#define PG8_LDB(dst, b, h) do { _Pragma("unroll") for (int n = 0; n < 2; ++n) _Pragma("unroll") for (int k = 0; k < 2; ++k) dst[n][k] = *(const PG8_LAS bf16x8*)(lds + PG8_SB(b, h) + boff + n * 2048 + k * 1024); } while (0)
#define PG8_MMA(ai, bj, At, Bt) do { __builtin_amdgcn_s_setprio(1); _Pragma("unroll") for (int m = 0; m < 4; ++m) _Pragma("unroll") for (int n = 0; n < 2; ++n) _Pragma("unroll") for (int k = 0; k < 2; ++k) \
        acc[ai][bj][m][n] = __builtin_amdgcn_mfma_f32_16x16x32_bf16(Bt[n][k], At[m][k], acc[ai][bj][m][n], 0, 0, 0); __builtin_amdgcn_s_setprio(0); } while (0)
#define PG8_WAIT_V(n) asm volatile("s_waitcnt vmcnt(" #n ")" ::: "memory")
#define PG8_WAIT_L(n) asm volatile("s_waitcnt lgkmcnt(" #n ")" ::: "memory")
#define PG8_BAR __builtin_amdgcn_s_barrier()
#define PG8_SCHED __builtin_amdgcn_sched_barrier(0)
    Unit cur, nxt; int ui = 0;
    if (!S.next(0, cur)) return;
    f32x4 acc[2][2][4][2];
#pragma unroll
    for (int a = 0; a < 2; ++a)
#pragma unroll
        for (int b = 0; b < 2; ++b)
#pragma unroll
            for (int m = 0; m < 4; ++m)
#pragma unroll
                for (int n = 0; n < 2; ++n) acc[a][b][m][n] = (f32x4){0.f, 0.f, 0.f, 0.f};
    bf16x8 At[4][2], B0[2][2], B1[2][2];
    const char* cA = (const char*)g.A + (size_t)cur.pm * tstep + (size_t)cur.k0 * kstep; const char* cB = (const char*)g.Bt + (size_t)cur.pn * tstep + (size_t)cur.k0 * kstep + (HALFB ? (size_t)cur.bh * hstep : 0);
    S.a_ready(cur);
    if constexpr (SP2) {
        PG8_STAGE(PG8_SB(0, 0), cB, voffB); PG8_STAGE(PG8_SB(0, 1), cB + bhs, voffB); PG8_STAGE(PG8_SA(0, 0), cA, voffA); PG8_STAGE(PG8_SA(0, 1), cA + hstep, voffA);
        if (wr == 1) PG8_BAR;
        PG8_WAIT_V(2); PG8_BAR;
        PG8_STAGE(PG8_SB(1, 0), cB + kstep, voffB); PG8_STAGE(PG8_SA(1, 0), cA + kstep, voffA); PG8_STAGE(PG8_SB(1, 1), cB + bhs + kstep, voffB);
        PG8_WAIT_V(6); PG8_BAR;
    } else {
        PG8_STAGE(PG8_SB(0, 0), cB, voffB); PG8_STAGE(PG8_SA(0, 0), cA, voffA); PG8_STAGE(PG8_SB(0, 1), cB + bhs, voffB); PG8_STAGE(PG8_SA(0, 1), cA + hstep, voffA);
        if (wr == 1) PG8_BAR;
        PG8_WAIT_V(4); PG8_BAR;
        PG8_STAGE(PG8_SB(1, 0), cB + kstep, voffB); PG8_STAGE(PG8_SA(1, 0), cA + kstep, voffA); PG8_STAGE(PG8_SB(1, 1), cB + bhs + kstep, voffB);
        PG8_WAIT_V(6); PG8_BAR;
    }
    for (;;) {
        const bool has_next = S.next(ui + 1, nxt);
        const char* nA = has_next ? (const char*)g.A + (size_t)nxt.pm * tstep + (size_t)nxt.k0 * kstep : cA; const char* nB = has_next ? (const char*)g.Bt + (size_t)nxt.pn * tstep + (size_t)nxt.k0 * kstep + (HALFB ? (size_t)nxt.bh * hstep : 0) : cB;
        const int nt = cur.nk;
        for (int t = 0; t < nt; t += 2) {
            const bool last = (t == nt - 2);
            const char* a1 = cA + (size_t)(t + 1) * kstep;
            const char* a2 = last ? nA : cA + (size_t)(t + 2) * kstep; const char* b2 = last ? nB : cB + (size_t)(t + 2) * kstep;
            const char* a3 = a2 + kstep; const char* b3 = b2 + kstep;
            if (last && has_next) S.a_ready(nxt);
            if constexpr (SP2) {
            PG8_LDB(B0, 0, 0); if constexpr (!HALFB) PG8_LDB(B1, 0, 1); PG8_SCHED; PG8_LDA(At, 0, 0); PG8_STAGE(PG8_SA(1, 1), a1 + hstep, voffA);
            PG8_WAIT_V(8); PG8_WAIT_L(0); PG8_BAR; PG8_MMA(0, 0, At, B0); if constexpr (!HALFB) PG8_MMA(0, 1, At, B1); PG8_BAR; PG8_SCHED;
            PG8_LDA(At, 0, 1); PG8_STAGE(PG8_SB(0, 0), b2, voffB); PG8_STAGE(PG8_SB(0, 1), b2 + bhs, voffB); PG8_STAGE(PG8_SA(0, 0), a2, voffA);
            PG8_WAIT_V(8); PG8_WAIT_L(0); PG8_BAR; PG8_MMA(1, 0, At, B0); if constexpr (!HALFB) PG8_MMA(1, 1, At, B1); PG8_BAR; PG8_SCHED;
            PG8_LDB(B0, 1, 0); if constexpr (!HALFB) PG8_LDB(B1, 1, 1); PG8_SCHED; PG8_LDA(At, 1, 0); PG8_STAGE(PG8_SA(0, 1), a2 + hstep, voffA);
            PG8_WAIT_V(8); PG8_WAIT_L(0); PG8_BAR; PG8_MMA(0, 0, At, B0); if constexpr (!HALFB) PG8_MMA(0, 1, At, B1); PG8_BAR; PG8_SCHED;
            PG8_LDA(At, 1, 1); PG8_STAGE(PG8_SB(1, 0), b3, voffB); PG8_STAGE(PG8_SB(1, 1), b3 + bhs, voffB); PG8_STAGE(PG8_SA(1, 0), a3, voffA);
            PG8_WAIT_V(8); PG8_WAIT_L(0); PG8_BAR; PG8_MMA(1, 0, At, B0); if constexpr (!HALFB) PG8_MMA(1, 1, At, B1); PG8_BAR; PG8_SCHED;
            } else {
            PG8_LDB(B0, 0, 0); PG8_SCHED; PG8_LDA(At, 0, 0); PG8_STAGE(PG8_SA(1, 1), a1 + hstep, voffA);
            PG8_WAIT_L(8); PG8_BAR; PG8_WAIT_L(0); PG8_MMA(0, 0, At, B0); PG8_BAR; PG8_SCHED;
            PG8_LDB(B1, 0, 1); PG8_STAGE(PG8_SB(0, 0), b2, voffB);
            PG8_BAR; PG8_WAIT_L(0); PG8_MMA(0, 1, At, B1); PG8_BAR;
            PG8_LDA(At, 0, 1); PG8_STAGE(PG8_SA(0, 0), a2, voffA);
            PG8_BAR; PG8_WAIT_L(0); PG8_MMA(1, 0, At, B0); PG8_BAR; PG8_SCHED;
            PG8_STAGE(PG8_SB(0, 1), b2 + bhs, voffB);
            PG8_WAIT_V(6); PG8_BAR; PG8_MMA(1, 1, At, B1); PG8_BAR;
            PG8_LDB(B0, 1, 0); PG8_SCHED; PG8_LDA(At, 1, 0); PG8_STAGE(PG8_SA(0, 1), a2 + hstep, voffA);
            PG8_WAIT_L(8); PG8_BAR; PG8_WAIT_L(0); PG8_MMA(0, 0, At, B0); PG8_BAR; PG8_SCHED;
            PG8_LDB(B1, 1, 1); PG8_STAGE(PG8_SB(1, 0), b3, voffB);
            PG8_BAR; PG8_WAIT_L(0); PG8_MMA(0, 1, At, B1); PG8_BAR;
            PG8_LDA(At, 1, 1); PG8_STAGE(PG8_SA(1, 0), a3, voffA);
            PG8_BAR; PG8_WAIT_L(0); PG8_MMA(1, 0, At, B0); PG8_BAR; PG8_SCHED;
            PG8_STAGE(PG8_SB(1, 1), b3 + bhs, voffB);
            PG8_WAIT_V(6); PG8_BAR; PG8_MMA(1, 1, At, B1); PG8_BAR;
            }
        }
        if constexpr (ALIGN_EPI) { if (wr == 0) PG8_BAR; }
        E(acc, cur, wr, wc, fr, fq); S.done(cur);
        if (!has_next) break;
#pragma unroll
        for (int a = 0; a < 2; ++a)
#pragma unroll
            for (int b = 0; b < 2; ++b)
#pragma unroll
                for (int m = 0; m < 4; ++m)
#pragma unroll
                    for (int n = 0; n < 2; ++n) acc[a][b][m][n] = (f32x4){0.f, 0.f, 0.f, 0.f};
        cur = nxt; cA = nA; cB = nB; ++ui;
        if constexpr (ALIGN_EPI) { if (wr == 1) PG8_BAR; }
    }
    PG8_WAIT_V(0);
    if constexpr (!ALIGN_EPI) { if (wr == 0) PG8_BAR; }
    PG8_BAR;
#undef PG8_SA
#undef PG8_SB
#undef PG8_STAGE
#undef PG8_LDA
#undef PG8_LDB
#undef PG8_MMA
#undef PG8_WAIT_V
#undef PG8_WAIT_L
#undef PG8_BAR
#undef PG8_SCHED
}
}

constexpr int NWAVES = 8;
constexpr int D = 2048, MCTX = 4096, MLAT = 16384, M = MCTX + MLAT, NL = 4;
constexpr int DA = 1024, NH = 16, DB = 1024, NG = 8, HB = 128;
constexpr int LW = 64, LAA = 64, LGT = 160;
constexpr int CSH = 3 * DA + LW + LAA + LGT;
constexpr int PIN = CSH + 2 * DB;
constexpr int PINP = 5632;
constexpr int DFF = 5632, NGU = 2 * DFF;
constexpr int MODW = 6 * D;
constexpr float RMS_EPS = 1e-6f, GN_EPS = 64.0f * 1e-5f, LN_EPS = 1e-5f;

constexpr size_t MiB = 1u << 20;
constexpr size_t WS_CTL = 0, CTL_ZERO_BYTES = 1 * MiB;
constexpr size_t WS_MOD = 1 * MiB;
constexpr size_t WS_W2T = 2 * MiB;
constexpr size_t WS_A2T = 3 * MiB;
constexpr size_t WS_G2T = 4 * MiB;
constexpr size_t WS_WSP = 6 * MiB;
constexpr size_t WS_BONUS = 7 * MiB;
constexpr size_t SZ_WIN = (size_t)PINP * D * 2, SZ_WOUT = (size_t)D * D * 2, SZ_WGU = (size_t)NGU * D * 2, SZ_WD = (size_t)D * DFF * 2;
constexpr size_t WS_WIN = 16 * MiB;
constexpr size_t WS_WOUT = WS_WIN + NL * SZ_WIN;
constexpr size_t WS_WGU = WS_WOUT + NL * SZ_WOUT;
constexpr size_t WS_WD = WS_WGU + NL * SZ_WGU;
constexpr size_t WS_H = WS_WD + NL * SZ_WD;
constexpr size_t WS_O = WS_H + (size_t)M * D * 2;
constexpr size_t WS_P = WS_O + (size_t)M * D * 2;
constexpr size_t WS_PS = WS_P + (size_t)M * PINP * 2;
constexpr size_t SZ_T16 = (size_t)M * DA * 2;
constexpr size_t WS_GATE = WS_PS + (size_t)M * CSH * 2;
constexpr size_t SZ_CH = (size_t)(M / 64) * NH * 2 * 8192;
constexpr size_t WS_PST = WS_GATE + SZ_T16;
constexpr size_t WS_NCT = WS_PST + SZ_CH;
constexpr size_t WS_PYT = WS_NCT + SZ_CH;
constexpr size_t WS_QYT = WS_PYT + SZ_CH;
constexpr size_t WS_VTG = WS_QYT + SZ_CH;
constexpr size_t WS_SC = WS_VTG + SZ_CH;
constexpr size_t WS_LORA = WS_SC + SZ_CH;
constexpr size_t WS_X = WS_LORA + (size_t)M * 288 * 2;
constexpr size_t WS_END1 = WS_X + (size_t)M * D * 2;
constexpr size_t WS_HID = WS_GATE;
constexpr size_t WS_END = WS_END1 > WS_HID + (size_t)M * DFF * 2 ? WS_END1 : WS_HID + (size_t)M * DFF * 2;
constexpr int CW_BAR = 4096;
constexpr int CW_SPLIT = 16384;
static_assert((CW_SPLIT + NL * 640 * 64) * 4 <= (int)CTL_ZERO_BYTES, "control words inside the memset region");

constexpr int RING_BYTES = 131072;
constexpr int LDSCTL_OFF = 15 * 9216, MISC_OFF = LDSCTL_OFF + 320;
constexpr int LDS_BYTES = 147456;

#define GAS __attribute__((address_space(1)))
#define LAS __attribute__((address_space(3)))
typedef unsigned short bf16;
typedef float f32x4 __attribute__((ext_vector_type(4)));
typedef float f32x2 __attribute__((ext_vector_type(2)));
typedef short bf16x8 __attribute__((ext_vector_type(8)));
typedef unsigned u32x4 __attribute__((ext_vector_type(4)));
typedef unsigned u32x2 __attribute__((ext_vector_type(2)));
#define LDS_WAIT() asm volatile("s_waitcnt lgkmcnt(0)" ::: "memory")
#define VM_WAIT() asm volatile("s_waitcnt vmcnt(0)" ::: "memory")
__device__ __forceinline__ unsigned f2bf(float f) { unsigned u = __builtin_bit_cast(unsigned, f); return (u + 0x7fffu + ((u >> 16) & 1u)) >> 16; }
typedef __bf16 bf16x2_t __attribute__((ext_vector_type(2)));
__device__ __forceinline__ unsigned pk2(float lo, float hi) { return __builtin_bit_cast(unsigned, __builtin_convertvector((f32x2){lo, hi}, bf16x2_t)); }
__device__ __forceinline__ float bf2f(unsigned short b) { return __uint_as_float(((unsigned)b) << 16); }
__device__ __forceinline__ void unpack8(const u32x4 q, float (&f)[8]) {
    f[0] = __uint_as_float(q.x << 16); f[1] = __uint_as_float(q.x & 0xffff0000u); f[2] = __uint_as_float(q.y << 16); f[3] = __uint_as_float(q.y & 0xffff0000u);
    f[4] = __uint_as_float(q.z << 16); f[5] = __uint_as_float(q.z & 0xffff0000u); f[6] = __uint_as_float(q.w << 16); f[7] = __uint_as_float(q.w & 0xffff0000u); }
__device__ __forceinline__ u32x4 pack8(const float (&f)[8]) { u32x4 o; o.x = pk2(f[0], f[1]); o.y = pk2(f[2], f[3]); o.z = pk2(f[4], f[5]); o.w = pk2(f[6], f[7]); return o; }
__device__ __forceinline__ float fsigmoid(float x) { return __builtin_amdgcn_rcpf(1.0f + __expf(-x)); }
__device__ __forceinline__ float ftanh(float x) { return 1.0f - 2.0f * __builtin_amdgcn_rcpf(1.0f + __expf(2.0f * x)); }
__device__ __forceinline__ float gelu_tanh(float x) { const float u = 1.5957691216057308f * (x + 0.044715f * x * x * x); return x * __builtin_amdgcn_rcpf(1.0f + __expf(-u)); }
__device__ __forceinline__ int hw_lane() { int l; asm volatile("v_mbcnt_lo_u32_b32 %0, -1, 0\n\tv_mbcnt_hi_u32_b32 %0, -1, %0" : "=v"(l)); return l; }
#define SHX(v, X) __int_as_float(__builtin_amdgcn_ds_bpermute((lane ^ (X)) << 2, __float_as_int(v)))
#define WAVE_SUM(v) do { v += SHX(v, 1); v += SHX(v, 2); v += SHX(v, 4); v += SHX(v, 8); v += SHX(v, 16); v += SHX(v, 32); } while (0)

#define PH_LOCALS(F) int wave = (F).wave; asm volatile("" : "+s"(wave)); const int lane = hw_lane(); const int tid = wave * 64 + lane; \
    int bx = (F).bx, G = (F).G; asm volatile("" : "+s"(bx), "+s"(G)); (void)lane; (void)tid;
#define PH_LAYER(l) asm volatile("" : "+s"(l))

#define XB_TMO      128
#define XB_XCNT(j)  (256  + 64 * (j))
#define XB_XSUB(j)  (1280 + 64 * (j))
#define XB_XGEN(j)  (2304 + 64 * (j))
#define XB_TOP      3328
#define XB_TOPGEN   3392
#define XCD_BAR_WORDS 3456
#define XB_SPIN_CAP (1u << 18)

__device__ __forceinline__ unsigned xb_ld(unsigned* p)              { return __hip_atomic_load(p, __ATOMIC_RELAXED, __HIP_MEMORY_SCOPE_AGENT); }
__device__ __forceinline__ unsigned xb_add(unsigned* p, unsigned v) { return __hip_atomic_fetch_add(p, v, __ATOMIC_RELAXED, __HIP_MEMORY_SCOPE_AGENT); }
__device__ __forceinline__ unsigned xb_xcc_id() { return (unsigned)__builtin_amdgcn_s_getreg((3 << 11) | 20) & 0xFu; }
#define XB_SPIN(cond, bar) do { unsigned _sp = 0; while (cond) { __builtin_amdgcn_s_sleep(1); \
    if ((++_sp & 255u) == 0u) { if (xb_ld(&(bar)[XB_TMO])) break; if (_sp > XB_SPIN_CAP) { atomicAdd(&(bar)[XB_TMO], 1u); break; } } } } while (0)

struct XcdBarrier {
    unsigned* bar; unsigned x;
    volatile LAS unsigned* st;
};
__device__ __forceinline__ XcdBarrier xcd_barrier_post(unsigned* bar, volatile LAS unsigned* st) {
    XcdBarrier b; b.bar = bar; b.x = xb_xcc_id(); b.st = st;
    if (threadIdx.x == 0) (void)xb_add(&bar[XB_XCNT(b.x)], 1u);
    return b;
}
__device__ __forceinline__ void xcd_barrier_complete(unsigned* bar, unsigned x, unsigned& nloc, unsigned& nx) {
    const unsigned G = gridDim.x * gridDim.y * gridDim.z;
    unsigned sum, cnt, mine, sp = 0u;
    for (;;) {
        sum = 0u; cnt = 0u; mine = 0u;
#pragma unroll
        for (unsigned j = 0; j < 16; ++j) { const unsigned c = xb_ld(&bar[XB_XCNT(j)]); sum += c; cnt += (c > 0u) ? 1u : 0u; mine = (j == x) ? c : mine; }
        if (sum == G) break;
        __builtin_amdgcn_s_sleep(1);
        if ((++sp & 255u) == 0u) { if (xb_ld(&bar[XB_TMO])) break; if (sp > XB_SPIN_CAP) { atomicAdd(&bar[XB_TMO], 1u); break; } }
    }
    nloc = mine > 0u ? mine : 1u; nx = cnt > 0u ? cnt : 1u;
}
__device__ __forceinline__ void xcd_barrier(const XcdBarrier& b) {
    asm volatile("s_waitcnt vmcnt(0)" ::: "memory");
    __syncthreads();
    if (threadIdx.x == 0) {
        unsigned* bar = b.bar;
        __builtin_amdgcn_s_waitcnt(0);
        unsigned nloc = b.st[0], nx = b.st[1];
        if (nloc == 0u) { xcd_barrier_complete(bar, b.x, nloc, nx); b.st[0] = nloc; b.st[1] = nx; }
        const unsigned old = xb_add(&bar[XB_XSUB(b.x)], 1u);
        const unsigned gen = old / nloc;
        if (old + 1u == (gen + 1u) * nloc) {
            __builtin_amdgcn_fence(__ATOMIC_RELEASE, "agent");
            asm volatile("s_waitcnt vmcnt(0)" ::: "memory");
            const unsigned og = xb_add(&bar[XB_TOP], 1u);
            const unsigned tg = og / nx;
            if (og + 1u == (tg + 1u) * nx) xb_add(&bar[XB_TOPGEN], 1u);
            else XB_SPIN(xb_ld(&bar[XB_TOPGEN]) == tg, bar);
            __builtin_amdgcn_fence(__ATOMIC_ACQUIRE, "agent");
            xb_add(&bar[XB_XGEN(b.x)], 1u);
            asm volatile("s_waitcnt vmcnt(0)" ::: "memory");
        } else {
            XB_SPIN(xb_ld(&bar[XB_XGEN(b.x)]) == gen, bar);
            __builtin_amdgcn_fence(__ATOMIC_ACQUIRE, "agent");
            asm volatile("s_waitcnt vmcnt(0)" ::: "memory");
        }
    }
    __syncthreads();
}

struct Args {
    const float* in[30];
    float* out; unsigned char* ws;
    int ph_lo, ph_hi, li, pad;
};
enum { I_XP = 0, I_XS, I_STATE, I_C, I_CCTX, I_WMOD, I_BMOD, I_N1G, I_WIN, I_MU, I_W0, I_W2, I_A0, I_A2, I_G2, I_KK, I_KA, I_RK, I_GNW, I_GNB, I_LNG, I_LNB, I_WSP, I_BSP, I_WOUT, I_N2G, I_WG, I_WU, I_WD, I_FNG };

struct Frame {
    LAS unsigned char* lds;
    int tid, lane, wave, G, bx;
    const float* const* in;
    float* out; unsigned char* ws;
};

struct EpiP {
    static constexpr bool PERM = true, AFTER_DRAIN = false;
    bf16* O; int ldc; int gelu_from;
    __device__ __forceinline__ void operator()(const f32x4 (&acc)[2][2][4][2], const pg8::Unit& u, int wr, int wc, int fr, int fq) const {
        const int row0 = u.pm * 256 + wr * 64 + fr, col0 = u.pn * 256 + wc * 32 + 8 * fq;
#pragma unroll
        for (int ai = 0; ai < 2; ++ai)
#pragma unroll
            for (int m = 0; m < 4; ++m) { bf16* rowp = O + (size_t)(row0 + ai * 128 + m * 16) * ldc + col0;
#pragma unroll
                for (int bj = 0; bj < 2; ++bj) { f32x4 v0 = acc[ai][bj][m][0], v1 = acc[ai][bj][m][1];
                    if (col0 + bj * 128 >= gelu_from) {
#pragma unroll
                        for (int j = 0; j < 4; ++j) { v0[j] = gelu_tanh(v0[j]); v1[j] = gelu_tanh(v1[j]); } }
                    u32x4 w; w.x = pg8::cvt_pk_bf16(v0[0], v0[1]); w.y = pg8::cvt_pk_bf16(v0[2], v0[3]); w.z = pg8::cvt_pk_bf16(v1[0], v1[1]); w.w = pg8::cvt_pk_bf16(v1[2], v1[3]);
                    *(u32x4*)(rowp + bj * 128) = w; } }
    }
};
struct EpiRes {
    static constexpr bool PERM = false, AFTER_DRAIN = false;
    const float* xlo; const float* xhi; const bf16* xb_in; bf16* xb_out; const float* modl; int goff;
    __device__ __forceinline__ void operator()(const f32x4 (&acc)[2][2][4][2], const pg8::Unit& u, int wr, int wc, int fr, int fq) const {
        const int pm = u.pm; const int midx = pm < 16 ? 0 : 1 + ((pm - 16) >> 4);
        const float* gv = modl + (size_t)midx * MODW + goff;
        const bool f32in = xb_in == nullptr;
        const float* base = pm < 16 ? xlo + (size_t)pm * 256 * D : xhi + (size_t)(pm - 16) * 256 * D;
        const bf16* bbase = xb_in + (size_t)pm * 256 * D;
        bf16* ob = xb_out + (size_t)pm * 256 * D;
        const bool half = u.bh >= 0;
        const int col0 = u.pn * 256 + (u.bh > 0 ? 128 : 0) + wc * 32 + 4 * fq;
        f32x4 gvv[2][2];
#pragma unroll
        for (int bj = 0; bj < 2; ++bj)
#pragma unroll
            for (int n = 0; n < 2; ++n) gvv[bj][n] = (bj == 1 && half) ? (f32x4){0.f, 0.f, 0.f, 0.f} : *(const f32x4*)(gv + col0 + bj * 128 + n * 16);
        const size_t rbase = (size_t)(wr * 64 + fr) * D + col0;
        u32x4 xr[8][2][2];
#define ER_LOAD(g_) do { const size_t off_ = rbase + (size_t)(((g_) >> 2) * 128 + ((g_) & 3) * 16) * D; \
            _Pragma("unroll") for (int bj = 0; bj < 2; ++bj) { if (bj == 1 && half) continue; _Pragma("unroll") for (int n = 0; n < 2; ++n) { \
                if (f32in) xr[g_][bj][n] = *(const u32x4*)(base + off_ + bj * 128 + n * 16); \
                else { const u32x2 t_ = *(const u32x2*)(bbase + off_ + bj * 128 + n * 16); xr[g_][bj][n].x = t_.x; xr[g_][bj][n].y = t_.y; } } } } while (0)
        ER_LOAD(0); ER_LOAD(1); ER_LOAD(2);
        asm volatile("" ::: "memory");
#pragma unroll
        for (int g = 0; g < 8; ++g) { const int ai = g >> 2, m = g & 3; const size_t off = rbase + (size_t)(ai * 128 + m * 16) * D;
#pragma unroll
            for (int bj = 0; bj < 2; ++bj) { if (bj == 1 && half) continue;
#pragma unroll
                for (int n = 0; n < 2; ++n) { const u32x4 r = xr[g][bj][n];
                    const f32x4 xo = f32in ? (f32x4){__uint_as_float(r.x), __uint_as_float(r.y), __uint_as_float(r.z), __uint_as_float(r.w)}
                                           : (f32x4){__uint_as_float(r.x << 16), __uint_as_float(r.x & 0xffff0000u), __uint_as_float(r.y << 16), __uint_as_float(r.y & 0xffff0000u)};
                    const f32x4 xn = xo + gvv[bj][n] * acc[ai][bj][m][n];
                    u32x2 w; w.x = pg8::cvt_pk_bf16(xn[0], xn[1]); w.y = pg8::cvt_pk_bf16(xn[2], xn[3]); *(u32x2*)(ob + off + bj * 128 + n * 16) = w; } }
            asm volatile("" ::: "memory");
            if (g + 3 < 8) { ER_LOAD(g + 3); }
            asm volatile("" ::: "memory"); }
#undef ER_LOAD
    }
};
struct EpiSwi {
    static constexpr bool PERM = true, AFTER_DRAIN = false;
    bf16* O; int ldc;
    __device__ __forceinline__ void operator()(const f32x4 (&acc)[2][2][4][2], const pg8::Unit& u, int wr, int wc, int fr, int fq) const {
        const int row0 = u.pm * 256 + wr * 64 + fr, col0 = u.pn * 128 + wc * 32 + 8 * fq;
#pragma unroll
        for (int ai = 0; ai < 2; ++ai)
#pragma unroll
            for (int m = 0; m < 4; ++m) { bf16* rowp = O + (size_t)(row0 + ai * 128 + m * 16) * ldc + col0;
                float h[8];
#pragma unroll
                for (int n = 0; n < 2; ++n)
#pragma unroll
                    for (int j = 0; j < 4; ++j) { const float gt = acc[ai][0][m][n][j], up = acc[ai][1][m][n][j]; h[n * 4 + j] = gt * fsigmoid(gt) * up; }
                u32x4 w; w.x = pg8::cvt_pk_bf16(h[0], h[1]); w.y = pg8::cvt_pk_bf16(h[2], h[3]); w.z = pg8::cvt_pk_bf16(h[4], h[5]); w.w = pg8::cvt_pk_bf16(h[6], h[7]);
                *(u32x4*)rowp = w; }
    }
};

template <int MAP>
__device__ __forceinline__ void tr_item(const float* W, int K, int N, bf16* WT, LAS float* scr, int item, int lane) {
    const int nblk = N / 32, kb = item / nblk, nb = item % nblk, k0 = 64 * kb, n0 = 32 * nb;
#pragma unroll 8
    for (int i = 0; i < 32; ++i) { const int kk = 2 * i + (lane >> 5); scr[kk * 33 + (lane & 31)] = W[(size_t)(k0 + kk) * N + n0 + (lane & 31)]; }
    LDS_WAIT(); asm volatile("" ::: "memory");
    const int c = lane & 7;
#pragma unroll
    for (int j = 0; j < 4; ++j) { const int n = (lane >> 3) + 8 * j; const LAS float* s = scr + (8 * c) * 33 + n;
        u32x4 o; o.x = pk2(s[0 * 33], s[1 * 33]); o.y = pk2(s[2 * 33], s[3 * 33]); o.z = pk2(s[4 * 33], s[5 * 33]); o.w = pk2(s[6 * 33], s[7 * 33]);
        const int nn = n0 + n; const int orow = MAP == 0 ? nn : (256 * (nn >> 7) + (nn & 127) + (MAP == 2 ? 128 : 0));
        *(u32x4*)(WT + (size_t)orow * K + k0 + 8 * c) = o; }
    LDS_WAIT(); asm volatile("" ::: "memory");
}
__device__ __forceinline__ void p0_prologue(Frame& F) {
    PH_LOCALS(F);
    LAS float* scr = (LAS float*)(F.lds + wave * 16384);
    const int gw = bx * NWAVES + wave, NGW = G * NWAVES;
    constexpr int I_IN = (D / 64) * (PIN / 32), I_OUT = (D / 64) * (D / 32), I_GU = (D / 64) * (DFF / 32), I_DN = (DFF / 64) * (D / 32);
    constexpr int PL = I_IN + I_OUT + 2 * I_GU + I_DN;
    for (int it = gw; it < NL * PL; it += NGW) {
        const int l = it / PL; int r = it % PL;
        if (r < I_IN) { tr_item<0>(F.in[I_WIN] + (size_t)l * D * PIN, D, PIN, (bf16*)(F.ws + WS_WIN + l * SZ_WIN), scr, r, lane); continue; } r -= I_IN;
        if (r < I_OUT) { tr_item<0>(F.in[I_WOUT] + (size_t)l * D * D, D, D, (bf16*)(F.ws + WS_WOUT + l * SZ_WOUT), scr, r, lane); continue; } r -= I_OUT;
        if (r < I_GU) { tr_item<1>(F.in[I_WG] + (size_t)l * D * DFF, D, DFF, (bf16*)(F.ws + WS_WGU + l * SZ_WGU), scr, r, lane); continue; } r -= I_GU;
        if (r < I_GU) { tr_item<2>(F.in[I_WU] + (size_t)l * D * DFF, D, DFF, (bf16*)(F.ws + WS_WGU + l * SZ_WGU), scr, r, lane); continue; } r -= I_GU;
        tr_item<0>(F.in[I_WD] + (size_t)l * DFF * D, DFF, D, (bf16*)(F.ws + WS_WD + l * SZ_WD), scr, r, lane);
    }
    const int gt = bx * 512 + tid, NGT = G * 512;
    { constexpr int PADV = (PINP - PIN) * D * 2 / 16;
      for (int i = gt; i < NL * PADV; i += NGT) { const int l = i / PADV, r = i % PADV; ((u32x4*)(F.ws + WS_WIN + l * SZ_WIN + (size_t)PIN * D * 2))[r] = (u32x4){0u, 0u, 0u, 0u}; } }
    { bf16* w2t = (bf16*)(F.ws + WS_W2T); bf16* a2t = (bf16*)(F.ws + WS_A2T); bf16* g2t = (bf16*)(F.ws + WS_G2T); bf16* wsp = (bf16*)(F.ws + WS_WSP);
      for (int i = gt; i < NL * 2 * 1024 * 64; i += NGT) { const int k = i & 63, n = (i >> 6) & 1023, ld = i >> 16;
          w2t[i] = (bf16)f2bf(F.in[I_W2][((size_t)ld * 64 + k) * 1024 + n]); a2t[i] = (bf16)f2bf(F.in[I_A2][((size_t)ld * 64 + k) * 1024 + n]); }
      for (int i = gt; i < NL * 1024 * 160; i += NGT) { const int k = i % 160, n = (i / 160) & 1023, l = i / (160 * 1024);
          g2t[i] = (bf16)f2bf(F.in[I_G2][((size_t)l * 160 + k) * 1024 + n]); }
      for (int i = gt; i < NL * 8 * 128 * 128; i += NGT) wsp[i] = (bf16)f2bf(F.in[I_WSP][i]); }
    __syncthreads();
    { LAS float* sv = (LAS float*)F.lds;
      LAS float* red = (LAS float*)(F.lds + 40960);
      for (int i = tid; i < 5 * D; i += 512) { const int r = i / D, k = i % D; const float c = r == 0 ? F.in[I_CCTX][k] : F.in[I_C][(r - 1) * D + k]; sv[i] = c * fsigmoid(c); }
      __syncthreads();
      float* mod = (float*)(F.ws + WS_MOD);
      const int c4 = tid & 15, kg = tid >> 4;
      for (int item = bx; item < NL * (MODW / 64); item += G) {
          const int l = item / (MODW / 64), n0 = (item % (MODW / 64)) * 64;
          const float* W = F.in[I_WMOD] + (size_t)l * D * MODW + n0 + 4 * c4;
          f32x4 a[5];
#pragma unroll
          for (int r = 0; r < 5; ++r) a[r] = (f32x4){0.f, 0.f, 0.f, 0.f};
#pragma unroll 4
          for (int i = 0; i < 64; ++i) { const int k = i * 32 + kg; const f32x4 w = *(const f32x4*)(W + (size_t)k * MODW);
#pragma unroll
              for (int r = 0; r < 5; ++r) a[r] += w * sv[r * D + k]; }
#pragma unroll
          for (int r = 0; r < 5; ++r) *(LAS f32x4*)(red + (kg * 5 + r) * 64 + 4 * c4) = a[r];
          __syncthreads();
          if (tid < 320) { const int r = tid >> 6, n = tid & 63; float s = 0.f;
#pragma unroll 8
              for (int g = 0; g < 32; ++g) s += red[(g * 5 + r) * 64 + n];
              mod[((size_t)l * 5 + r) * MODW + n0 + n] = s + F.in[I_BMOD][(size_t)l * MODW + n0 + n]; }
          __syncthreads();
      } }
}

__device__ __forceinline__ void p_adaln(Frame& F, int l, int which, const float* xlo, const float* xhi, const bf16* xb) {
    PH_LOCALS(F); PH_LAYER(l);
    const int gw = bx * NWAVES + wave, NGW = G * NWAVES;
    const float* ng = (which == 0 ? F.in[I_N1G] : F.in[I_N2G]) + (size_t)l * D;
    const int shoff = which == 0 ? 0 : 3 * D, scoff = shoff + D;
    const float* mod = (const float*)(F.ws + WS_MOD);
    bf16* H = (bf16*)(F.ws + WS_H);
    const int rpw = (M + NGW - 1) / NGW, rbeg = gw * rpw, rend = rbeg + rpw < M ? rbeg + rpw : M;
    f32x4 ca[8], cb[8]; int mcur = -1;
    if (xb == nullptr) {
        f32x4 nx[8];
#define AL_ROWPTR(row_) ((row_) < MCTX ? xlo + (size_t)(row_) * D : xhi + (size_t)((row_) - MCTX) * D)
        if (rbeg < rend) { const float* xr = AL_ROWPTR(rbeg);
#pragma unroll
            for (int j = 0; j < 8; ++j) nx[j] = *(const f32x4*)(xr + 4 * lane + 256 * j); }
        for (int row = rbeg; row < rend; ++row) {
            const int midx = row < MCTX ? 0 : 1 + ((row - MCTX) >> 12);
            if (midx != mcur) { mcur = midx; const float* md = mod + ((size_t)l * 5 + midx) * MODW;
#pragma unroll
                for (int j = 0; j < 8; ++j) { const int c = 4 * lane + 256 * j; ca[j] = *(const f32x4*)(ng + c) * (*(const f32x4*)(md + scoff + c) + 1.0f); cb[j] = *(const f32x4*)(md + shoff + c); } }
            f32x4 v[8]; float ss = 0.f;
#pragma unroll
            for (int j = 0; j < 8; ++j) { v[j] = nx[j]; ss += (v[j].x * v[j].x + v[j].y * v[j].y) + (v[j].z * v[j].z + v[j].w * v[j].w); }
            { const int nr = row + 1 < rend ? row + 1 : row; const float* xr = AL_ROWPTR(nr);
#pragma unroll
              for (int j = 0; j < 8; ++j) nx[j] = *(const f32x4*)(xr + 4 * lane + 256 * j); }
            WAVE_SUM(ss); const float rstd = 1.0f / sqrtf(ss * (1.0f / D) + RMS_EPS);
#pragma unroll
            for (int j = 0; j < 8; ++j) { const int c = 4 * lane + 256 * j;
                const f32x4 o = v[j] * rstd * ca[j] + cb[j];
                u32x2 w; w.x = pk2(o.x, o.y); w.y = pk2(o.z, o.w);
                *(u32x2*)(H + (size_t)row * D + c) = w; }
        }
#undef AL_ROWPTR
    } else {
        u32x4 nx[4];
        if (rbeg < rend) { const bf16* xr = xb + (size_t)rbeg * D;
#pragma unroll
            for (int j = 0; j < 4; ++j) nx[j] = *(const u32x4*)(xr + 8 * lane + 512 * j); }
        for (int row = rbeg; row < rend; ++row) {
            const int midx = row < MCTX ? 0 : 1 + ((row - MCTX) >> 12);
            if (midx != mcur) { mcur = midx; const float* md = mod + ((size_t)l * 5 + midx) * MODW;
#pragma unroll
                for (int j = 0; j < 8; ++j) { const int c = 8 * lane + 512 * (j >> 1) + 4 * (j & 1); ca[j] = *(const f32x4*)(ng + c) * (*(const f32x4*)(md + scoff + c) + 1.0f); cb[j] = *(const f32x4*)(md + shoff + c); } }
            float v[4][8]; float ss = 0.f;
#pragma unroll
            for (int j = 0; j < 4; ++j) { unpack8(nx[j], v[j]);
#pragma unroll
                for (int e = 0; e < 8; ++e) ss += v[j][e] * v[j][e]; }
            { const int nr = row + 1 < rend ? row + 1 : row; const bf16* xr = xb + (size_t)nr * D;
#pragma unroll
              for (int j = 0; j < 4; ++j) nx[j] = *(const u32x4*)(xr + 8 * lane + 512 * j); }
            WAVE_SUM(ss); const float rstd = 1.0f / sqrtf(ss * (1.0f / D) + RMS_EPS);
#pragma unroll
            for (int j = 0; j < 4; ++j) { float o[8];
#pragma unroll
                for (int e = 0; e < 4; ++e) { o[e] = v[j][e] * rstd * ca[2 * j][e] + cb[2 * j][e]; o[4 + e] = v[j][4 + e] * rstd * ca[2 * j + 1][e] + cb[2 * j + 1][e]; }
                *(u32x4*)(H + (size_t)row * D + 8 * lane + 512 * j) = pack8(o); }
        }
    }
}

__device__ __forceinline__ void load_shifted8(const bf16* P, const float* mu, int row, int col, float (&o)[8]) {
    float g[8]; unpack8(*(const u32x4*)(P + (size_t)row * PINP + col), g);
    float a[8];
#pragma unroll
    for (int j = 0; j < 8; ++j) a[j] = g[j];
    int nrow[4]; bool has[4]; int nn;
    if (row < MCTX) { const int t = row & 255; nn = 2; nrow[0] = row - 1; has[0] = t > 0; nrow[1] = row + 1; has[1] = t < 255; nrow[2] = row; has[2] = false; nrow[3] = row; has[3] = false; }
    else { const int t = (row - MCTX) & 4095, gc = t & 63, gr = t >> 6; nn = 4;
        nrow[0] = row - 1; has[0] = gc > 0; nrow[1] = row + 1; has[1] = gc < 63; nrow[2] = row - 64; has[2] = gr > 0; nrow[3] = row + 64; has[3] = gr < 63; }
#pragma unroll
    for (int q = 0; q < 4; ++q) {
        if (q < nn) {
            float nb[8];
            if (has[q]) unpack8(*(const u32x4*)(P + (size_t)nrow[q] * PINP + col), nb);
            else {
#pragma unroll
                for (int j = 0; j < 8; ++j) nb[j] = 0.f; }
            const f32x4 m0 = *(const f32x4*)(mu + q * CSH + col), m1 = *(const f32x4*)(mu + q * CSH + col + 4);
#pragma unroll
            for (int j = 0; j < 4; ++j) { a[j] += m0[j] * (nb[j] - g[j]); a[4 + j] += m1[j] * (nb[4 + j] - g[4 + j]); }
        }
    }
#pragma unroll
    for (int j = 0; j < 8; ++j) o[j] = a[j];
}
__device__ __forceinline__ void p_shift(Frame& F, int l) {
    PH_LOCALS(F); PH_LAYER(l);
    const bf16* P = (const bf16*)(F.ws + WS_P); bf16* PS = (bf16*)(F.ws + WS_PS); bf16* LORA = (bf16*)(F.ws + WS_LORA);
    const float* mu = F.in[I_MU] + (size_t)l * 4 * CSH;
    constexpr int CG = CSH / 8;
    if (tid >= CG) return;
    const int col = tid * 8; const int act = (col >= 3 * DA && col < 3 * DA + LW) ? 1 : (col >= 3 * DA + LW + LAA ? 2 : 0);
    f32x2 m[4][4];
#pragma unroll
    for (int q = 0; q < 4; ++q) { const f32x4 a = *(const f32x4*)(mu + q * CSH + col), b = *(const f32x4*)(mu + q * CSH + col + 4); m[q][0] = (f32x2){a[0], a[1]}; m[q][1] = (f32x2){a[2], a[3]}; m[q][2] = (f32x2){b[0], b[1]}; m[q][3] = (f32x2){b[2], b[3]}; }
#define SH_UNPK(q_, v_) do { v_[0] = (f32x2){__uint_as_float((q_).x << 16), __uint_as_float((q_).x & 0xffff0000u)}; v_[1] = (f32x2){__uint_as_float((q_).y << 16), __uint_as_float((q_).y & 0xffff0000u)}; \
        v_[2] = (f32x2){__uint_as_float((q_).z << 16), __uint_as_float((q_).z & 0xffff0000u)}; v_[3] = (f32x2){__uint_as_float((q_).w << 16), __uint_as_float((q_).w & 0xffff0000u)}; } while (0)
#define SH_STORE(row_, a_) do { float o_[8] = {a_[0].x, a_[0].y, a_[1].x, a_[1].y, a_[2].x, a_[2].y, a_[3].x, a_[3].y}; \
        if (act == 1) { _Pragma("unroll") for (int jx = 0; jx < 8; ++jx) o_[jx] = ftanh(o_[jx]); } else if (act == 2) { _Pragma("unroll") for (int jx = 0; jx < 8; ++jx) o_[jx] = fsigmoid(o_[jx]); } \
        if (col >= 3 * DA) { const int cgl = (col - 3 * DA) >> 3; *(u32x4*)(LORA + ((((size_t)((row_) >> 4) * 9 + (cgl >> 2)) * 64 + 16 * (cgl & 3) + ((row_) & 15)) << 3)) = pack8(o_); } \
        else *(u32x4*)(PS + (size_t)(row_) * CSH + col) = pack8(o_); } while (0)
    const u32x4 Z4 = (u32x4){0u, 0u, 0u, 0u};
    { f32x2 c0[4];
#pragma unroll
      for (int e = 0; e < 4; ++e) c0[e] = (f32x2){1.f, 1.f} - ((m[0][e] + m[1][e]) + (m[2][e] + m[3][e]));
      for (int u = bx; u < 256; u += G) {
          const int gc = u & 63; const bf16* pc = P + ((size_t)MCTX + (size_t)(u >> 6) * 4096 + gc) * PINP + col;
          const int rowb = MCTX + (u >> 6) * 4096 + gc;
          u32x4 up = Z4, cur = *(const u32x4*)pc;
          for (int g0 = 0; g0 < 64; g0 += 4) {
              u32x4 dn[4], lf[4], rt[4];
#pragma unroll
              for (int i = 0; i < 4; ++i) { const int gr = g0 + i; const bf16* pr = pc + (size_t)gr * 64 * PINP;
                  dn[i] = gr < 63 ? *(const u32x4*)(pr + (size_t)64 * PINP) : Z4; lf[i] = gc > 0 ? *(const u32x4*)(pr - PINP) : Z4; rt[i] = gc < 63 ? *(const u32x4*)(pr + PINP) : Z4; }
#pragma unroll
              for (int i = 0; i < 4; ++i) { f32x2 g[4], a[4], nb[4]; SH_UNPK(cur, g);
#pragma unroll
                  for (int e = 0; e < 4; ++e) a[e] = c0[e] * g[e];
                  SH_UNPK(lf[i], nb);
#pragma unroll
                  for (int e = 0; e < 4; ++e) a[e] += m[0][e] * nb[e];
                  SH_UNPK(rt[i], nb);
#pragma unroll
                  for (int e = 0; e < 4; ++e) a[e] += m[1][e] * nb[e];
                  SH_UNPK(up, nb);
#pragma unroll
                  for (int e = 0; e < 4; ++e) a[e] += m[2][e] * nb[e];
                  SH_UNPK(dn[i], nb);
#pragma unroll
                  for (int e = 0; e < 4; ++e) a[e] += m[3][e] * nb[e];
                  const int row = rowb + (g0 + i) * 64; SH_STORE(row, a);
                  up = cur; cur = dn[i]; }
          }
      } }
    { f32x2 c0[4];
#pragma unroll
      for (int e = 0; e < 4; ++e) c0[e] = (f32x2){1.f, 1.f} - (m[0][e] + m[1][e]);
      const int rpw = (MCTX + G - 1) / G, rbeg = bx * rpw, rend = rbeg + rpw < MCTX ? rbeg + rpw : MCTX;
      if (rbeg < rend) {
          const bf16* pc = P + (size_t)rbeg * PINP + col;
          u32x4 prev = (rbeg & 255) ? *(const u32x4*)(pc - PINP) : Z4, cur = *(const u32x4*)pc;
          for (int row = rbeg; row < rend; ++row) { const bf16* pr = P + (size_t)row * PINP + col;
              const u32x4 nxt = (row & 255) != 255 ? *(const u32x4*)(pr + PINP) : Z4;
              f32x2 g[4], a[4], nb[4]; SH_UNPK(cur, g);
#pragma unroll
              for (int e = 0; e < 4; ++e) a[e] = c0[e] * g[e];
              SH_UNPK(prev, nb);
#pragma unroll
              for (int e = 0; e < 4; ++e) a[e] += m[0][e] * nb[e];
              SH_UNPK(nxt, nb);
#pragma unroll
              for (int e = 0; e < 4; ++e) a[e] += m[1][e] * nb[e];
              SH_STORE(row, a);
              prev = (row & 255) != 255 ? cur : Z4; cur = ((row & 255) != 255 || row + 1 >= rend) ? nxt : *(const u32x4*)(pr + PINP); }
      } }
#undef SH_UNPK
#undef SH_STORE
}

#define F4Z ((f32x4){0.f, 0.f, 0.f, 0.f})
__device__ __forceinline__ u32x2 pk4(const f32x4 a) { u32x2 w; w.x = pk2(a[0], a[1]); w.y = pk2(a[2], a[3]); return w; }
#define LBAR() do { asm volatile("s_waitcnt lgkmcnt(0)" ::: "memory"); __builtin_amdgcn_s_barrier(); asm volatile("" ::: "memory"); } while (0)
constexpr int VTS = 136;
typedef short s16x4g __attribute__((ext_vector_type(4)));
__device__ __forceinline__ bf16x8 frag_tr_ld(const LAS bf16* X, int ld, int kbase, int c0, int fr, int fq) {
    const LAS bf16* p = X + (kbase + 8 * fq + (fr >> 2)) * ld + c0 + 4 * (fr & 3);
    const s16x4g lo = __builtin_amdgcn_ds_read_tr16_b64_v4i16((LAS s16x4g*)p);
    const s16x4g hi = __builtin_amdgcn_ds_read_tr16_b64_v4i16((LAS s16x4g*)(p + 4 * ld));
    return (bf16x8){lo[0], lo[1], lo[2], lo[3], hi[0], hi[1], hi[2], hi[3]};
}
__device__ __forceinline__ void p_gmlp(Frame& F, int l, int slot, int nslots) {
    PH_LOCALS(F); PH_LAYER(l); (void)bx; (void)G;
    const bf16* P = (const bf16*)(F.ws + WS_P); bf16* O = (bf16*)(F.ws + WS_O);
    const bf16* wsp = (const bf16*)(F.ws + WS_WSP) + (size_t)l * 8 * 128 * 128;
    LAS bf16* VN = (LAS bf16*)F.lds;
    LAS bf16* ST = (LAS bf16*)(F.lds + 34816);
    const int fr = lane & 15, fq = lane >> 4;
    constexpr int NIT = (M / 128) * NG;
    const int jrow = tid >> 2, q4 = tid & 3;
    u32x4 pvv[4]; f32x4 lgv[8], lbv[8]; bf16x8 bw[4]; float bsp = 0.f; int gcur = -1;
#define GM_ISSUE(item_) do { const bf16* src_ = P + (size_t)(((item_) >> 3) * 128 + jrow) * PINP + CSH + DB + 128 * ((item_) & 7) + 32 * q4; \
        _Pragma("unroll") for (int i_ = 0; i_ < 4; ++i_) pvv[i_] = *(const u32x4*)(src_ + 8 * i_); } while (0)
    if (slot < 0) return;
    LBAR();
    if (slot < NIT) GM_ISSUE(slot);
    for (int item = slot; item < NIT; item += nslots) {
        const int cb = item >> 3, g = item & 7, R0 = cb * 128;
        u32x4 pu[4]; { const bf16* up = P + (size_t)(R0 + jrow) * PINP + CSH + 128 * g + 32 * q4;
#pragma unroll
            for (int i = 0; i < 4; ++i) pu[i] = *(const u32x4*)(up + 8 * i); }
        if (g != gcur) { gcur = g; const bf16* wa = wsp + ((size_t)g * 128 + 16 * wave + fr) * 128 + 8 * fq;
#pragma unroll
            for (int ks = 0; ks < 4; ++ks) bw[ks] = *(const bf16x8*)(wa + 32 * ks);
            bsp = F.in[I_BSP][((size_t)l * 8 + g) * 128 + jrow];
            const float* lg = F.in[I_LNG] + ((size_t)l * 8 + g) * 128 + 32 * q4; const float* lb = F.in[I_LNB] + ((size_t)l * 8 + g) * 128 + 32 * q4;
#pragma unroll
            for (int i = 0; i < 8; ++i) { lgv[i] = *(const f32x4*)(lg + 4 * i); lbv[i] = *(const f32x4*)(lb + 4 * i); } }
        { float v[32];
#pragma unroll
          for (int i = 0; i < 4; ++i) { float f[8]; unpack8(pvv[i], f);
#pragma unroll
              for (int jj = 0; jj < 8; ++jj) v[8 * i + jj] = f[jj]; }
          float s = 0.f;
#pragma unroll
          for (int i = 0; i < 32; ++i) s += v[i];
          s += SHX(s, 1); s += SHX(s, 2);
          const float mean = s * (1.0f / 128.0f); float qq = 0.f;
#pragma unroll
          for (int i = 0; i < 32; ++i) { v[i] -= mean; qq += v[i] * v[i]; }
          qq += SHX(qq, 1); qq += SHX(qq, 2);
          const float rstd = 1.0f / sqrtf(qq * (1.0f / 128.0f) + LN_EPS);
#pragma unroll
          for (int i = 0; i < 4; ++i) { float o[8]; const f32x4 g0 = lgv[2 * i], g1 = lgv[2 * i + 1], b0 = lbv[2 * i], b1 = lbv[2 * i + 1];
#pragma unroll
              for (int jj = 0; jj < 4; ++jj) { o[jj] = v[8 * i + jj] * rstd * g0[jj] + b0[jj]; o[4 + jj] = v[8 * i + 4 + jj] * rstd * g1[jj] + b1[jj]; }
              *(LAS u32x4*)(VN + jrow * VTS + 32 * q4 + 8 * i) = pack8(o); } }
        if (item + nslots < NIT) GM_ISSUE(item + nslots);
        LBAR();
#pragma unroll
        for (int mt = 0; mt < 8; ++mt) { f32x4 acc = F4Z;
#pragma unroll
            for (int ks = 0; ks < 4; ++ks) acc = __builtin_amdgcn_mfma_f32_16x16x32_bf16(frag_tr_ld(VN, VTS, 32 * ks, 16 * mt, fr, fq), bw[ks], acc, 0, 0, 0);
            *(LAS u32x2*)(ST + (16 * wave + fr) * VTS + 16 * mt + 4 * fq) = pk4(acc); }
        LBAR();
        { bf16* op = O + (size_t)(R0 + jrow) * D + DA + 128 * g + 32 * q4;
#pragma unroll
          for (int i = 0; i < 4; ++i) { float sv[8], uv[8], o[8]; unpack8(*(const LAS u32x4*)(ST + jrow * VTS + 32 * q4 + 8 * i), sv); unpack8(pu[i], uv);
#pragma unroll
              for (int jj = 0; jj < 8; ++jj) o[jj] = uv[jj] * (sv[jj] + bsp);
              *(u32x4*)(op + 8 * i) = pack8(o); } }
    }
    LBAR();
#undef GM_ISSUE
}

constexpr int T16B = 9216, LD16 = 72, LD32 = 68;
#define SLOT(i) ((LAS bf16*)(lds + (i) * T16B))
#define SLOTF(i) ((LAS float*)(lds + (i) * T16B))
template <int NK>
__device__ __forceinline__ f32x4 tile_mm(const LAS bf16* A, int lda, const LAS bf16* B, int ldb, int fr, int fq, f32x4 acc) {
#pragma unroll
    for (int ks = 0; ks < NK; ++ks) { const bf16x8 a = *(const LAS bf16x8*)(A + fr * lda + 8 * fq + 32 * ks); const bf16x8 b = *(const LAS bf16x8*)(B + fr * ldb + 8 * fq + 32 * ks);
        acc = __builtin_amdgcn_mfma_f32_16x16x32_bf16(a, b, acc, 0, 0, 0); }
    return acc;
}
__device__ __forceinline__ void st_nat(LAS bf16* dst, int n0, int m0, int fr, int fq, const f32x4 a) { *(LAS u32x2*)(dst + (n0 + fr) * LD16 + m0 + 4 * fq) = pk4(a); }
__device__ __forceinline__ void st_rm(LAS bf16* dst, int n0, int m0, int fr, int fq, const f32x4 a) {
#pragma unroll
    for (int r = 0; r < 4; ++r) dst[(m0 + 4 * fq + r) * LD16 + n0 + fr] = (bf16)f2bf(a[r]); }
__device__ __forceinline__ f32x4 ld4bf(const LAS bf16* p) { const u32x2 w = *(const LAS u32x2*)p; return (f32x4){__uint_as_float(w.x << 16), __uint_as_float(w.x & 0xffff0000u), __uint_as_float(w.y << 16), __uint_as_float(w.y & 0xffff0000u)}; }

__device__ __forceinline__ int fm_off(int n0, int m0, int fr, int fq) { return ((((n0 >> 4) * 2 + (m0 >> 5)) * 64 + (2 * ((m0 >> 4) & 1) + (fq >> 1)) * 16 + fr) << 3) + 4 * (fq & 1); }
typedef short s16x4 __attribute__((ext_vector_type(4)));
__device__ __forceinline__ bf16x8 frag_tr(const LAS bf16* X, int kbase, int c0, int fr, int fq) {
    const LAS bf16* p = X + (kbase + 8 * fq + (fr >> 2)) * LD16 + c0 + 4 * (fr & 3);
    const s16x4 lo = __builtin_amdgcn_ds_read_tr16_b64_v4i16((LAS s16x4*)p);
    const s16x4 hi = __builtin_amdgcn_ds_read_tr16_b64_v4i16((LAS s16x4*)(p + 4 * LD16));
    return (bf16x8){lo[0], lo[1], lo[2], lo[3], hi[0], hi[1], hi[2], hi[3]};
}
__device__ __forceinline__ bf16x8 frag_rm(const LAS bf16* X, int r0, int ks, int fr, int fq) { return *(const LAS bf16x8*)(X + (r0 + fr) * LD16 + 8 * fq + 32 * ks); }
__device__ __forceinline__ f32x4 mm2(const bf16x8 (&a)[2], const bf16x8 (&b)[2], f32x4 acc) {
    acc = __builtin_amdgcn_mfma_f32_16x16x32_bf16(a[0], b[0], acc, 0, 0, 0); return __builtin_amdgcn_mfma_f32_16x16x32_bf16(a[1], b[1], acc, 0, 0, 0); }
__device__ __forceinline__ bf16x8 as_frag(const u32x4 q) { return __builtin_bit_cast(bf16x8, q); }

__device__ __forceinline__ void p_chunkA(Frame& F, int l) {
    PH_LOCALS(F); PH_LAYER(l);
    LAS unsigned char* lds = F.lds;
    const int lane0 = lane, lane00 = lane;
#define STG int lane_ = lane0; asm volatile("" : "+v"(lane_)); const int lane = lane_, fr = lane_ & 15, fq = lane_ >> 4, tid = wave * 64 + lane_, mt = wave >> 1, m0 = 16 * mt, np = (wave & 1) * 2; \
    (void)lane; (void)fr; (void)fq; (void)tid; (void)mt; (void)m0; (void)np;
    const bf16* PS = (const bf16*)(F.ws + WS_PS);
    const bf16* w2t = (const bf16*)(F.ws + WS_W2T) + (size_t)l * 2 * 1024 * 64;
    const bf16* a2t = (const bf16*)(F.ws + WS_A2T) + (size_t)l * 2 * 1024 * 64;
    const bf16* g2t = (const bf16*)(F.ws + WS_G2T) + (size_t)l * 1024 * 160;
    bf16* GATE = (bf16*)(F.ws + WS_GATE); float* BONUS = (float*)(F.ws + WS_BONUS);
    LAS float* gC = (LAS float*)(lds + 14 * T16B);
    LAS float* BT = (LAS float*)(lds + 14 * T16B + 256);
    u32x4 pf_w[2], pf_a[2], pf_g[5], pf_r, pf_k, pf_v; bf16x8 Bg[2][5], Bw[2][2], Ba[2][2]; float biw[2], bia[2];
#define CA_ISSUE(item_, d_) do { const int ci_ = (item_) >> 4, h_ = (item_) & 15, R0_ = ci_ * 64; int lane0 = lane00; asm volatile("" : "+v"(lane0)); \
        const bf16* arow_ = (const bf16*)(F.ws + WS_LORA) + ((((size_t)(R0_ >> 4) + (wave >> 1)) * 9 * 64 + lane0) << 3); \
        pf_w[0] = *(const u32x4*)arow_; pf_w[1] = *(const u32x4*)(arow_ + 512); pf_a[0] = *(const u32x4*)(arow_ + 1024); pf_a[1] = *(const u32x4*)(arow_ + 1536); \
        if ((d_) == 0) { _Pragma("unroll") for (int ks_ = 0; ks_ < 5; ++ks_) { pf_g[ks_] = *(const u32x4*)(arow_ + 2048 + 512 * ks_); \
            _Pragma("unroll") for (int nn_ = 0; nn_ < 2; ++nn_) Bg[nn_][ks_] = *(const bf16x8*)(g2t + (size_t)(64 * h_ + 16 * ((wave & 1) * 2 + nn_) + (lane0 & 15)) * 160 + 8 * (lane0 >> 4) + 32 * ks_); } } \
        _Pragma("unroll") for (int nn_ = 0; nn_ < 2; ++nn_) { const int n_ = 64 * h_ + 16 * ((wave & 1) * 2 + nn_) + (lane0 & 15); \
            biw[nn_] = F.in[I_W0][((size_t)l * 2 + (d_)) * DA + n_]; bia[nn_] = F.in[I_A0][((size_t)l * 2 + (d_)) * DA + n_]; \
            _Pragma("unroll") for (int ks_ = 0; ks_ < 2; ++ks_) { Bw[nn_][ks_] = *(const bf16x8*)(w2t + ((size_t)(d_) * 1024 + n_) * 64 + 8 * (lane0 >> 4) + 32 * ks_); Ba[nn_][ks_] = *(const bf16x8*)(a2t + ((size_t)(d_) * 1024 + n_) * 64 + 8 * (lane0 >> 4) + 32 * ks_); } } \
        const int tid_ = wave * 64 + lane0, tau_ = tid_ >> 3, pos_ = (d_) ? 63 - tau_ : tau_; const bf16* rrow_ = PS + (size_t)(R0_ + pos_) * CSH + 64 * h_ + (tid_ & 7) * 8; \
        pf_r = *(const u32x4*)rrow_; pf_k = *(const u32x4*)(rrow_ + DA); pf_v = *(const u32x4*)(rrow_ + 2 * DA); } while (0)
    if (bx < (M / 64) * NH) CA_ISSUE(bx, 0);
    int hcur = -1;
    LAS float* HC = (LAS float*)(lds + 14 * T16B + 1280);
    for (int item = bx; item < (M / 64) * NH; item += G) {
        const int ci = item >> 4, h = item & 15, R0 = ci * 64;
        { (void)hcur;
            LBAR();
            { const int t_ = wave * 64 + lane0; if (t_ < 192) { const int w_ = t_ >> 6, c_ = t_ & 63; HC[t_] = (w_ == 0 ? F.in[I_KK] : (w_ == 1 ? F.in[I_KA] : F.in[I_RK]))[(size_t)l * DA + 64 * h + c_]; } } }
#pragma unroll
        for (int d = 0; d < 2; ++d) {
            const size_t qi = ((size_t)ci * 16 + h) * 2 + d;
            const bf16x8 cBw[2][2] = {{Bw[0][0], Bw[0][1]}, {Bw[1][0], Bw[1][1]}}, cBa[2][2] = {{Ba[0][0], Ba[0][1]}, {Ba[1][0], Ba[1][1]}}; const float cbw[2] = {biw[0], biw[1]}, cba[2] = {bia[0], bia[1]};
            u32x4 cw[2] = {pf_w[0], pf_w[1]}, ca[2] = {pf_a[0], pf_a[1]}, cg[5] = {pf_g[0], pf_g[1], pf_g[2], pf_g[3], pf_g[4]}; const u32x4 cr = pf_r, ck = pf_k, cv = pf_v;
            for (int repA = 0; repA < (PROBE_SUB == 1 ? 2 : 1); ++repA) {
            { STG; LAS float* AL = SLOTF(5); LAS float* LW = SLOTF(7);
              bf16x8 aw[2], aa[2];
#pragma unroll
              for (int ks = 0; ks < 2; ++ks) { aw[ks] = as_frag(cw[ks]); aa[ks] = as_frag(ca[ks]); }
#pragma unroll
              for (int nn = 0; nn < 2; ++nn) { const int nl = 16 * (np + nn) + fr, n = 64 * h + nl;
                  const f32x4 accw = mm2(aw, cBw[nn], F4Z), acca = mm2(aa, cBa[nn], F4Z);
                  const float biasw = cbw[nn], biasa = cba[nn]; (void)n;
                  float lw[4], c[4];
#pragma unroll
                  for (int r = 0; r < 4; ++r) lw[r] = -0.8750345269f * fsigmoid(biasw + accw[r]);
                  if (d == 0) { c[0] = lw[0]; c[1] = c[0] + lw[1]; c[2] = c[1] + lw[2]; c[3] = c[2] + lw[3]; }
                  else { c[3] = lw[3]; c[2] = c[3] + lw[2]; c[1] = c[2] + lw[1]; c[0] = c[1] + lw[0]; }
                  const float tot = d == 0 ? c[3] : c[0];
                  const float t1 = SHX(tot, 16), t2 = SHX(tot, 32), t3 = SHX(tot, 48);
                  float off;
                  { const int sg = d ? -1 : 1, q1 = fq ^ 1, q2 = fq ^ 2, q3 = fq ^ 3;
                    const int k1 = (sg * (q1 - fq)) >> 31, k2 = (sg * (q2 - fq)) >> 31, k3 = (sg * (q3 - fq)) >> 31;
                    off = (__int_as_float(__float_as_int(t1) & k1) + __int_as_float(__float_as_int(t2) & k2)) + __int_as_float(__float_as_int(t3) & k3); }
#pragma unroll
                  for (int r = 0; r < 4; ++r) { const int pos = m0 + 4 * fq + r, tau = d ? 63 - pos : pos;
                      LW[tau * LD32 + nl] = c[r] + off; AL[tau * LD32 + nl] = fsigmoid(biasa + acca[r]); }
                  if (fq == 0) BT[(d ? 3 - mt : mt) * 64 + nl] = (tot + t1) + (t2 + t3); }
              if (d == 0) {
                  bf16x8 ag[5];
#pragma unroll
                  for (int ks = 0; ks < 5; ++ks) ag[ks] = as_frag(cg[ks]);
#pragma unroll
                  for (int nn = 0; nn < 2; ++nn) { const int n = 64 * h + 16 * (np + nn) + fr; f32x4 acc = F4Z;
#pragma unroll
                      for (int ks = 0; ks < 5; ++ks) acc = __builtin_amdgcn_mfma_f32_16x16x32_bf16(ag[ks], Bg[nn][ks], acc, 0, 0, 0);
#pragma unroll
                      for (int r = 0; r < 4; ++r) SLOT(11)[(m0 + 4 * fq + r) * LD16 + 16 * (np + nn) + fr] = (bf16)f2bf(acc[r]); (void)n; } } }
            LBAR();
            { STG; const LAS float* AL = SLOTF(5); const LAS float* LW = SLOTF(7);
              const int tau = tid >> 3, c8 = (tid & 7) * 8, pos = d ? 63 - tau : tau, row = R0 + pos, blk = wave >> 1;
              f32x2 r[4], k[4];
              { const u32x4 q = cr; r[0] = (f32x2){__uint_as_float(q.x << 16), __uint_as_float(q.x & 0xffff0000u)}; r[1] = (f32x2){__uint_as_float(q.y << 16), __uint_as_float(q.y & 0xffff0000u)};
                r[2] = (f32x2){__uint_as_float(q.z << 16), __uint_as_float(q.z & 0xffff0000u)}; r[3] = (f32x2){__uint_as_float(q.w << 16), __uint_as_float(q.w & 0xffff0000u)}; }
              { const u32x4 q = ck; k[0] = (f32x2){__uint_as_float(q.x << 16), __uint_as_float(q.x & 0xffff0000u)}; k[1] = (f32x2){__uint_as_float(q.y << 16), __uint_as_float(q.y & 0xffff0000u)};
                k[2] = (f32x2){__uint_as_float(q.z << 16), __uint_as_float(q.z & 0xffff0000u)}; k[3] = (f32x2){__uint_as_float(q.w << 16), __uint_as_float(q.w & 0xffff0000u)}; }
              f32x2 offb[4], totC[4];
#pragma unroll
              for (int j = 0; j < 4; ++j) { offb[j] = (f32x2){0.f, 0.f}; totC[j] = (f32x2){0.f, 0.f}; }
#pragma unroll
              for (int b = 0; b < 4; ++b) { const f32x4 x0 = *(const LAS f32x4*)(BT + b * 64 + c8), x1 = *(const LAS f32x4*)(BT + b * 64 + c8 + 4);
                  const f32x2 y[4] = {{x0[0], x0[1]}, {x0[2], x0[3]}, {x1[0], x1[1]}, {x1[2], x1[3]}};
                  const float fb = b < blk ? 1.0f : 0.0f;
#pragma unroll
                  for (int j = 0; j < 4; ++j) { totC[j] += y[j]; offb[j] += y[j] * fb; } }
              f32x2 ckk[4], cka[4], crk[4];
              { const f32x4 a0 = *(const LAS f32x4*)(HC + c8), a1 = *(const LAS f32x4*)(HC + c8 + 4), b0 = *(const LAS f32x4*)(HC + 64 + c8), b1 = *(const LAS f32x4*)(HC + 64 + c8 + 4), c0 = *(const LAS f32x4*)(HC + 128 + c8), c1 = *(const LAS f32x4*)(HC + 128 + c8 + 4);
                ckk[0] = (f32x2){a0[0], a0[1]}; ckk[1] = (f32x2){a0[2], a0[3]}; ckk[2] = (f32x2){a1[0], a1[1]}; ckk[3] = (f32x2){a1[2], a1[3]};
                cka[0] = (f32x2){b0[0], b0[1]}; cka[1] = (f32x2){b0[2], b0[3]}; cka[2] = (f32x2){b1[0], b1[1]}; cka[3] = (f32x2){b1[2], b1[3]};
                crk[0] = (f32x2){c0[0], c0[1]}; crk[1] = (f32x2){c0[2], c0[3]}; crk[2] = (f32x2){c1[0], c1[1]}; crk[3] = (f32x2){c1[2], c1[3]}; }
              f32x2 kk[4], s2 = (f32x2){0.f, 0.f};
#pragma unroll
              for (int j = 0; j < 4; ++j) { kk[j] = k[j] * ckk[j]; s2 += kk[j] * kk[j]; }
              float ss = s2.x + s2.y;
              ss += SHX(ss, 1); ss += SHX(ss, 2); ss += SHX(ss, 4);
              const float rn = 1.0f / sqrtf(fmaxf(ss, 1e-24f));
              f32x2 alv[4], csv[4], csm[4];
              { const f32x4 a0 = *(const LAS f32x4*)(AL + tau * LD32 + c8), a1 = *(const LAS f32x4*)(AL + tau * LD32 + c8 + 4), c0 = *(const LAS f32x4*)(LW + tau * LD32 + c8), c1 = *(const LAS f32x4*)(LW + tau * LD32 + c8 + 4);
                const int tm = (tau & 15) ? tau - 1 : tau; f32x4 e0 = *(const LAS f32x4*)(LW + tm * LD32 + c8), e1 = *(const LAS f32x4*)(LW + tm * LD32 + c8 + 4);
                if ((tau & 15) == 0) { e0 = F4Z; e1 = F4Z; }
                alv[0] = (f32x2){a0[0], a0[1]}; alv[1] = (f32x2){a0[2], a0[3]}; alv[2] = (f32x2){a1[0], a1[1]}; alv[3] = (f32x2){a1[2], a1[3]};
                csv[0] = (f32x2){c0[0], c0[1]} + offb[0]; csv[1] = (f32x2){c0[2], c0[3]} + offb[1]; csv[2] = (f32x2){c1[0], c1[1]} + offb[2]; csv[3] = (f32x2){c1[2], c1[3]} + offb[3];
                csm[0] = (f32x2){e0[0], e0[1]} + offb[0]; csm[1] = (f32x2){e0[2], e0[3]} + offb[1]; csm[2] = (f32x2){e1[0], e1[1]} + offb[2]; csm[3] = (f32x2){e1[2], e1[3]} + offb[3]; }
              f32x2 at[4], rt[4], bt[4], kt[4], bh[4], kh[4], bon2 = (f32x2){0.f, 0.f};
#pragma unroll
              for (int j = 0; j < 4; ++j) { const f32x2 al = alv[j], cs = csv[j], dh = totC[j] - cs;
                  const f32x2 kkn = kk[j] * rn, kd = k[j] * ((al - 1.0f) * cka[j] + 1.0f), bb = kkn * al;
                  bon2 += r[j] * kd * crk[j];
                  const f32x2 encs = (f32x2){__builtin_amdgcn_exp2f(-cs.x), __builtin_amdgcn_exp2f(-cs.y)}, eh = (f32x2){__builtin_amdgcn_exp2f(dh.x), __builtin_amdgcn_exp2f(dh.y)};
                  const f32x2 ecm = (f32x2){__builtin_amdgcn_exp2f(csm[j].x), __builtin_amdgcn_exp2f(csm[j].y)}, ecs = (f32x2){__builtin_amdgcn_exp2f(cs.x), __builtin_amdgcn_exp2f(cs.y)};
                  at[j] = -(ecm * kkn); rt[j] = ecs * r[j]; bt[j] = encs * bb; kt[j] = encs * kd; bh[j] = eh * bb; kh[j] = eh * kd; }
              if (tau == 63) {
#pragma unroll
                  for (int j = 0; j < 4; ++j) { gC[c8 + 2 * j] = __builtin_amdgcn_exp2f(totC[j].x); gC[c8 + 2 * j + 1] = __builtin_amdgcn_exp2f(totC[j].y); } }
#define PK8V(a) ((u32x4){pk2(a[0].x, a[0].y), pk2(a[1].x, a[1].y), pk2(a[2].x, a[2].y), pk2(a[3].x, a[3].y)})
              *(LAS u32x4*)(SLOT(0) + tau * LD16 + c8) = PK8V(at); *(LAS u32x4*)(SLOT(1) + tau * LD16 + c8) = PK8V(rt);
              *(LAS u32x4*)(SLOT(2) + tau * LD16 + c8) = PK8V(bt); *(LAS u32x4*)(SLOT(3) + tau * LD16 + c8) = PK8V(kt);
              *(LAS u32x4*)(SLOT(4) + tau * LD16 + c8) = PK8V(bh); *(LAS u32x4*)(SLOT(9) + tau * LD16 + c8) = PK8V(kh);
#undef PK8V
              *(LAS u32x4*)(SLOT(10) + tau * LD16 + c8) = cv;
              if (d == 0) *(u32x4*)(GATE + (size_t)row * DA + 64 * h + c8) = *(const LAS u32x4*)(SLOT(11) + pos * LD16 + c8);
              float bon = bon2.x + bon2.y;
              bon += SHX(bon, 1); bon += SHX(bon, 2); bon += SHX(bon, 4);
              BONUS[((size_t)d * M + row) * NH + h] = bon; }
            LBAR();
            }
            { int nitem = d == 0 ? item : item + G; const int nd = d ^ 1; if (nitem >= (M / 64) * NH) nitem = item; CA_ISSUE(nitem, nd); }
            for (int repB = 0; repB < (PROBE_SUB == 2 ? 2 : 1); ++repB) {
            { STG; bf16x8 aB[2], aA[2], aK[2];
#pragma unroll
              for (int ks = 0; ks < 2; ++ks) { aB[ks] = frag_rm(SLOT(2), m0, ks, fr, fq); aA[ks] = frag_rm(SLOT(0), m0, ks, fr, fq); aK[ks] = frag_rm(SLOT(3), m0, ks, fr, fq); }
#pragma unroll
              for (int nn = 0; nn < 2; ++nn) { const int n0 = 16 * (np + nn), n = n0 + fr; bf16x8 bA[2], bB[2], bK[2], bR[2];
#pragma unroll
                  for (int ks = 0; ks < 2; ++ks) { bA[ks] = frag_rm(SLOT(0), n0, ks, fr, fq); bB[ks] = frag_rm(SLOT(2), n0, ks, fr, fq); bK[ks] = frag_rm(SLOT(3), n0, ks, fr, fq); bR[ks] = frag_rm(SLOT(1), n0, ks, fr, fq); }
                  f32x4 p0 = mm2(aB, bA, F4Z), p1 = mm2(aA, bB, F4Z), p2 = mm2(aA, bK, F4Z), p3 = mm2(aB, bR, F4Z), p4 = mm2(aK, bR, F4Z), t0;
#pragma unroll
                  for (int r = 0; r < 4; ++r) { const int m = m0 + 4 * fq + r;
                      p0[r] = m < n ? p0[r] : 0.f; p1[r] = n < m ? p1[r] : 0.f; p2[r] = n < m ? p2[r] : 0.f; p3[r] = m <= n ? p3[r] : 0.f; p4[r] = m <= n ? p4[r] : 0.f;
                      t0[r] = p1[r] + (m == n ? 1.0f : 0.f); }
                  st_nat(SLOT(5), n0, m0, fr, fq, p0); st_nat(SLOT(6), n0, m0, fr, fq, p1); st_nat(SLOT(7), n0, m0, fr, fq, t0);
                  st_nat(SLOT(8), n0, m0, fr, fq, p2); st_nat(SLOT(11), n0, m0, fr, fq, p3); st_nat(SLOT(12), n0, m0, fr, fq, p4); } }
            LBAR();
#define MM1(a, b, c) __builtin_amdgcn_mfma_f32_16x16x32_bf16(a, b, c, 0, 0, 0)
            { STG; const int b = wave >> 2, bm0 = 32 * b + 16 * ((wave >> 1) & 1), bn0 = 32 * b + 16 * (wave & 1), oc = 32 * (1 - b) - 32 * b;
              const bf16x8 aT = frag_rm(SLOT(5), bm0, b, fr, fq), aR = frag_rm(SLOT(6), bm0, b, fr, fq), bR = frag_rm(SLOT(6), bn0, b, fr, fq), bT = frag_rm(SLOT(5), bn0, b, fr, fq);
              st_nat(SLOT(2), bn0, bm0, fr, fq, MM1(aT, bR, F4Z)); st_nat(SLOT(2), bn0, bm0 + oc, fr, fq, MM1(aR, bT, F4Z)); }
            LBAR();
#pragma unroll
            for (int kq = 1; kq <= 4; ++kq) {
                STG; const int b = wave >> 2, bm0 = 32 * b + 16 * ((wave >> 1) & 1), bn0 = 32 * b + 16 * (wave & 1), oc = 32 * (1 - b) - 32 * b;
                const int pin = (kq & 1) ? 2 : 3, pout = (kq & 1) ? 3 : 2, tin = (kq & 1) ? 7 : 13, tout = (kq & 1) ? 13 : 7;
                const bf16x8 aPT = frag_rm(SLOT(pin), bm0, 1 - b, fr, fq), bTn = frag_rm(SLOT(tin), bn0, b, fr, fq);
                st_nat(SLOT(tout), bn0, bm0, fr, fq, MM1(aPT, bTn, ld4bf(SLOT(tin) + (bn0 + fr) * LD16 + bm0 + 4 * fq)));
                if (kq < 4) { const bf16x8 aPR = frag_rm(SLOT(pin), bm0, b, fr, fq), bPR = frag_rm(SLOT(pin), bn0, b, fr, fq), bPT = frag_rm(SLOT(pin), bn0, 1 - b, fr, fq);
                    st_nat(SLOT(pout), bn0, bm0, fr, fq, MM1(aPT, bPR, F4Z));
                    st_nat(SLOT(pout), bn0, bm0 + oc, fr, fq, MM1(aPR, bPT, F4Z)); }
                LBAR();
            }
            { STG; if (wave < 4) { const int xm0 = 16 * ((wave >> 1) & 1), xn0 = 32 + 16 * (wave & 1);
                  const bf16x8 a = frag_rm(SLOT(6), xm0, 1, fr, fq), bb = frag_tr(SLOT(7), 32, xn0, fr, fq);
                  st_nat(SLOT(13), xn0, xm0, fr, fq, MM1(a, bb, F4Z)); } }
            LBAR();
            { STG; if (wave < 4) { const int tn0 = 32 + 16 * ((wave >> 1) & 1), tm0 = 16 * (wave & 1);
                  const bf16x8 a = frag_rm(SLOT(13), tn0, 0, fr, fq), bb = frag_rm(SLOT(7), tm0, 0, fr, fq);
                  st_nat(SLOT(7), tm0, tn0, fr, fq, MM1(a, bb, F4Z)); } }
            LBAR();
#undef MM1
            { STG; const int xt = wave, n0 = 16 * (xt & 3); bf16x8 b[2];
              if (xt < 4) { b[0] = frag_rm(SLOT(11), n0, 0, fr, fq); b[1] = frag_rm(SLOT(11), n0, 1, fr, fq); }
              else { b[0] = frag_tr(SLOT(4), 0, n0, fr, fq); b[1] = frag_tr(SLOT(4), 32, n0, fr, fq); }
#pragma unroll
              for (int mm = 0; mm < 4; ++mm) { bf16x8 a[2] = {frag_rm(SLOT(7), 16 * mm, 0, fr, fq), frag_rm(SLOT(7), 16 * mm, 1, fr, fq)};
                  st_nat(xt < 4 ? SLOT(5) : SLOT(6), n0, 16 * mm, fr, fq, mm2(a, b, F4Z)); } }
            LBAR();
            }
            for (int repC = 0; repC < (PROBE_SUB == 3 ? 2 : 1); ++repC) {
            { STG; bf16x8 aAt[2] = {frag_tr(SLOT(0), 0, m0, fr, fq), frag_tr(SLOT(0), 32, m0, fr, fq)}, aAk[2] = {frag_rm(SLOT(8), m0, 0, fr, fq), frag_rm(SLOT(8), m0, 1, fr, fq)};
              bf16* pyt = (bf16*)(F.ws + WS_PYT) + qi * 4096; bf16* qyt = (bf16*)(F.ws + WS_QYT) + qi * 4096; bf16* pst = (bf16*)(F.ws + WS_PST) + qi * 4096;
#pragma unroll
              for (int nn = 0; nn < 2; ++nn) { const int n0 = 16 * (np + nn), n = n0 + fr, mb = m0 + 4 * fq;
                  bf16x8 bRb[2] = {frag_rm(SLOT(5), n0, 0, fr, fq), frag_rm(SLOT(5), n0, 1, fr, fq)}, bBh[2] = {frag_rm(SLOT(6), n0, 0, fr, fq), frag_rm(SLOT(6), n0, 1, fr, fq)};
                  const f32x4 py = mm2(aAt, bRb, ld4bf(SLOT(1) + n * LD16 + mb)), qy = mm2(aAk, bRb, ld4bf(SLOT(12) + n * LD16 + mb));
                  f32x4 psi, qsi;
#pragma unroll
                  for (int r = 0; r < 4; ++r) { psi[r] = (mb + r == n) ? gC[n] : 0.f; qsi[r] = bf2f(SLOT(9)[(mb + r) * LD16 + n]); }
                  const f32x4 ps = mm2(aAt, bBh, psi), qs = mm2(aAk, bBh, qsi);
                  { const int fo = fm_off(n0, m0, fr, fq); *(u32x2*)(pyt + fo) = pk4(py); *(u32x2*)(qyt + fo) = pk4(qy); *(u32x2*)(pst + fo) = pk4(ps); }
                  st_nat(SLOT(2), n0, m0, fr, fq, qs); } }
            LBAR();
            { STG; bf16* nct = (bf16*)(F.ws + WS_NCT) + qi * 4096;
              bf16x8 a[2] = {frag_rm(SLOT(2), m0, 0, fr, fq), frag_rm(SLOT(2), m0, 1, fr, fq)};
#pragma unroll
              for (int nn = 0; nn < 2; ++nn) { const int n0 = 16 * (np + nn); bf16x8 b[2] = {frag_tr(SLOT(10), 0, n0, fr, fq), frag_tr(SLOT(10), 32, n0, fr, fq)};
                  *(u32x2*)(nct + ((((n0 >> 4) * 4 + mt) * 64 + lane) << 2)) = pk4(mm2(a, b, F4Z));
                  } }
            LBAR();
            }
        }
    }
#undef STG
#undef CA_ISSUE
}

__device__ __forceinline__ void p_chunkB(Frame& F, int l) {
    PH_LOCALS(F); PH_LAYER(l);
    const int fr = lane & 15, fq = lane >> 4;
    LAS bf16* Sl = (LAS bf16*)(F.lds + wave * 2304);
    const bf16* PST = (const bf16*)(F.ws + WS_PST); const bf16* NCT = (const bf16*)(F.ws + WS_NCT); bf16* SC = (bf16*)(F.ws + WS_SC);
    for (int cp = bx; cp < 64; cp += G) {
        const int cslot = wave >> 2, chain = 2 * cp + cslot, vb = wave & 3, b = chain >> 5, h = (chain >> 1) & 15, d = chain & 1, cb = 64 + b * 64; constexpr int NC = 64;
        LAS bf16* AL = (LAS bf16*)(F.lds + 20480) + cslot * 3 * 4096;
        f32x4 S[4];
        { const float* src = F.in[I_STATE] + ((((size_t)b * NL + l) * 2 + d) * NH + h) * 4096 + (size_t)(16 * vb + fr) * 64 + 4 * fq;
#pragma unroll
          for (int T = 0; T < 4; ++T) S[T] = *(const f32x4*)(src + 16 * T); }
        bf16x8 Aq[8][2]; u32x2 Nq[8][4];
#define LB_QI(step) ((((size_t)(cb + (d ? NC - 1 - (step) : (step)))) * 16 + h) * 2 + d)
#define LB_LDA(u, step) do { const int st_ = (step) < NC ? (step) : NC - 1; const bf16* ps_ = PST + LB_QI(st_) * 4096 + vb * 1024 + lane * 8; Aq[u][0] = *(const bf16x8*)ps_; Aq[u][1] = *(const bf16x8*)(ps_ + 512); } while (0)
#define LB_LDN(u, step) do { const int st_ = (step) < NC ? (step) : NC - 1; const bf16* nc_ = NCT + LB_QI(st_) * 4096 + ((vb * 4 * 64 + lane) << 2); \
        _Pragma("unroll") for (int mt_ = 0; mt_ < 4; ++mt_) Nq[u][mt_] = *(const u32x2*)(nc_ + mt_ * 256); } while (0)
#pragma unroll
        for (int u = 0; u < 8; ++u) { LB_LDA(u, u); LB_LDN(u, u); }
        *(LAS bf16x8*)(AL + ((vb * 2 + 0) * 64 + lane) * 8) = Aq[0][0]; *(LAS bf16x8*)(AL + ((vb * 2 + 1) * 64 + lane) * 8) = Aq[0][1];
        LB_LDA(0, 8);
        for (int g = 0; g < NC; g += 8) {
#pragma unroll
            for (int u = 0; u < 8; ++u) {
                const int step = g + u; const size_t q = LB_QI(step); bf16* scg = SC + q * 4096;
#pragma unroll
                for (int T = 0; T < 4; ++T) { const u32x2 w = pk4(S[T]); *(LAS u32x2*)(Sl + fr * LD16 + 16 * T + 4 * fq) = w; *(u32x2*)(scg + fm_off(16 * vb, 16 * T, fr, fq)) = w; }
                { LAS bf16* nb_ = AL + ((step + 1) % 3) * 4096; const int u1 = (u + 1) & 7;
                  *(LAS bf16x8*)(nb_ + ((vb * 2 + 0) * 64 + lane) * 8) = Aq[u1][0]; *(LAS bf16x8*)(nb_ + ((vb * 2 + 1) * 64 + lane) * 8) = Aq[u1][1];
                  LB_LDA(u1, step + 9); }
                LBAR();
                const LAS bf16* cbuf = AL + (step % 3) * 4096 + lane * 8;
                const bf16x8 b0 = *(const LAS bf16x8*)(Sl + fr * LD16 + 8 * fq), b1 = *(const LAS bf16x8*)(Sl + fr * LD16 + 8 * fq + 32);
#pragma unroll
                for (int mt = 0; mt < 4; ++mt) { const u32x2 nw = Nq[u][mt];
                    f32x4 acc = (f32x4){__uint_as_float(nw.x << 16), __uint_as_float(nw.x & 0xffff0000u), __uint_as_float(nw.y << 16), __uint_as_float(nw.y & 0xffff0000u)};
                    acc = __builtin_amdgcn_mfma_f32_16x16x32_bf16(*(const LAS bf16x8*)(cbuf + (mt * 2) * 512), b0, acc, 0, 0, 0);
                    acc = __builtin_amdgcn_mfma_f32_16x16x32_bf16(*(const LAS bf16x8*)(cbuf + (mt * 2 + 1) * 512), b1, acc, 0, 0, 0);
                    S[mt] = acc; }
                LB_LDN(u, step + 8);
            }
        }
#undef LB_LDA
#undef LB_LDN
#undef LB_QI
        LBAR();
    }
    const int w0 = (G > 64) ? (bx - 64) * NWAVES + wave : bx * NWAVES + wave, wst = (G > 64) ? (G - 64) * NWAVES : G * NWAVES;
    if (G > 64 && bx < 64) return;
    for (int t = w0; t < 2048; t += wst) {
        const int chain = t >> 2, vb = t & 3, b = chain >> 5, h = (chain >> 1) & 15, d = chain & 1, cb = b * 4; constexpr int NC = 4;
        f32x4 S[4];
#pragma unroll
        for (int T = 0; T < 4; ++T) S[T] = (f32x4){0.f, 0.f, 0.f, 0.f};
        bf16x8 Apf[4][8]; u32x2 Npf[4][4];
#define CB_QI(step) ((((size_t)(cb + (d ? NC - 1 - (step) : (step)))) * 16 + h) * 2 + d)
#define CB_LOAD(u, step) do { const size_t q_ = CB_QI(step); const bf16* ps_ = PST + q_ * 4096 + lane * 8; const bf16* nc_ = NCT + q_ * 4096 + ((vb * 4 * 64 + lane) << 2); \
        _Pragma("unroll") for (int mt_ = 0; mt_ < 4; ++mt_) { Apf[u][2 * mt_] = *(const bf16x8*)(ps_ + mt_ * 1024); Apf[u][2 * mt_ + 1] = *(const bf16x8*)(ps_ + mt_ * 1024 + 512); Npf[u][mt_] = *(const u32x2*)(nc_ + mt_ * 256); } } while (0)
        CB_LOAD(0, 0); CB_LOAD(1, 1); CB_LOAD(2, 2); CB_LOAD(3, 3);
#pragma unroll
        for (int u = 0; u < 4; ++u) {
            const int step = u; const size_t q = CB_QI(step); bf16* scg = SC + q * 4096;
            asm volatile("" ::: "memory");
#pragma unroll
            for (int T = 0; T < 4; ++T) { const u32x2 w = pk4(S[T]); *(LAS u32x2*)(Sl + fr * LD16 + 16 * T + 4 * fq) = w; *(u32x2*)(scg + fm_off(16 * vb, 16 * T, fr, fq)) = w; }
            asm volatile("s_waitcnt lgkmcnt(0)" ::: "memory");
            const bf16x8 b0 = *(const LAS bf16x8*)(Sl + fr * LD16 + 8 * fq), b1 = *(const LAS bf16x8*)(Sl + fr * LD16 + 8 * fq + 32);
#pragma unroll
            for (int mt = 0; mt < 4; ++mt) { const u32x2 nw = Npf[u][mt];
                f32x4 acc = (f32x4){__uint_as_float(nw.x << 16), __uint_as_float(nw.x & 0xffff0000u), __uint_as_float(nw.y << 16), __uint_as_float(nw.y & 0xffff0000u)};
                acc = __builtin_amdgcn_mfma_f32_16x16x32_bf16(Apf[u][2 * mt], b0, acc, 0, 0, 0);
                acc = __builtin_amdgcn_mfma_f32_16x16x32_bf16(Apf[u][2 * mt + 1], b1, acc, 0, 0, 0);
                S[mt] = acc; }
            asm volatile("s_waitcnt lgkmcnt(0)" ::: "memory");
        }
#undef CB_LOAD
#undef CB_QI
        { float* dst = F.out + (size_t)M * D + ((((size_t)b * NL + l) * 2 + d) * NH + h) * 4096 + (size_t)(16 * vb + fr) * 64 + 4 * fq;
#pragma unroll
          for (int T = 0; T < 4; ++T) *(f32x4*)(dst + 16 * T) = S[T]; }
    }
}

__device__ __forceinline__ void p_chunkC(Frame& F, int l) {
    PH_LOCALS(F); PH_LAYER(l);
    LAS unsigned char* lds = F.lds;
    const int fr = lane & 15, fq = lane >> 4, d = wave >> 2, nb = wave & 3;
    const bf16* PS = (const bf16*)(F.ws + WS_PS); const bf16* GATE = (const bf16*)(F.ws + WS_GATE); const float* BONUS = (const float*)(F.ws + WS_BONUS);
    bf16* O = (bf16*)(F.ws + WS_O);
    constexpr int NIT = (M / 64) * NH;
    f32x4 gnw[4], gnb[4]; int hcur = -1;
    bf16x8 fa0[4][2], fb0[4]; u32x4 pv0, pg0; float pb00, pb01;
    LAS bf16* VT0 = (LAS bf16*)(lds + 2 * 17408);
#define CC_ISSUE(item_, fa, fb, pv, pg, pb0, pb1) do { const int ci_ = (item_) >> 4, h_ = (item_) & 15; const size_t qi_ = ((size_t)ci_ * 16 + h_) * 2 + d; \
        const bf16* sc_ = (const bf16*)(F.ws + WS_SC) + qi_ * 4096 + lane * 8; \
        const bf16* py_ = (const bf16*)(F.ws + WS_PYT) + qi_ * 4096 + nb * 1024 + lane * 8; const bf16* qy_ = (const bf16*)(F.ws + WS_QYT) + qi_ * 4096 + nb * 1024 + lane * 8; \
        fb[0] = *(const bf16x8*)py_; fb[1] = *(const bf16x8*)(py_ + 512); fb[2] = *(const bf16x8*)qy_; fb[3] = *(const bf16x8*)(qy_ + 512); \
        _Pragma("unroll") for (int vt4_ = 0; vt4_ < 4; ++vt4_) { fa[vt4_][0] = *(const bf16x8*)(sc_ + vt4_ * 1024); fa[vt4_][1] = *(const bf16x8*)(sc_ + vt4_ * 1024 + 512); } \
        const int row_ = ci_ * 64 + (tid >> 3), chn_ = 64 * h_ + (tid & 7) * 8; \
        pv = *(const u32x4*)(PS + (size_t)row_ * CSH + 2 * DA + chn_); pg = *(const u32x4*)(GATE + (size_t)row_ * DA + chn_); pb0 = BONUS[(size_t)row_ * NH + h_]; pb1 = BONUS[((size_t)M + row_) * NH + h_]; } while (0)
#define CC_BODY(item_, fa, fb, pv, pg, pb0, pb1, next_) do { const int ci = (item_) >> 4, h = (item_) & 15, R0 = ci * 64; \
        if (h != hcur) { hcur = h; _Pragma("unroll") for (int vtile = 0; vtile < 4; ++vtile) { gnw[vtile] = *(const f32x4*)(F.in[I_GNW] + (size_t)l * DA + 64 * h + 16 * vtile + 4 * fq); gnb[vtile] = *(const f32x4*)(F.in[I_GNB] + (size_t)l * DA + 64 * h + 16 * vtile + 4 * fq); } } \
        const u32x4 cv = pv, cgt = pg; const float bon = pb0 + pb1; \
        { const int p_ = tid >> 3, c_ = (tid & 7) * 8; *(LAS u32x4*)(VT0 + p_ * LD16 + c_) = cv; *(LAS u32x4*)(VT0 + (64 + 63 - p_) * LD16 + c_) = cv; } \
        LBAR(); \
        f32x4 acc[4]; float s = 0.f; \
        _Pragma("unroll") for (int vtile = 0; vtile < 4; ++vtile) { f32x4 a = F4Z; \
            a = __builtin_amdgcn_mfma_f32_16x16x32_bf16(fa[vtile][0], fb[0], a, 0, 0, 0); a = __builtin_amdgcn_mfma_f32_16x16x32_bf16(fa[vtile][1], fb[1], a, 0, 0, 0); \
            a = __builtin_amdgcn_mfma_f32_16x16x32_bf16(frag_tr(VT0 + d * 64 * LD16, 0, 16 * vtile, fr, fq), fb[2], a, 0, 0, 0); a = __builtin_amdgcn_mfma_f32_16x16x32_bf16(frag_tr(VT0 + d * 64 * LD16, 32, 16 * vtile, fr, fq), fb[3], a, 0, 0, 0); \
            acc[vtile] = a; s += (a[0] + a[1]) + (a[2] + a[3]); } \
        if ((next_) < NIT) CC_ISSUE((next_), fa, fb, pv, pg, pb0, pb1); \
        s += SHX(s, 16); s += SHX(s, 32); \
        const float mean = s * (1.0f / 64.0f); float qv = 0.f; \
        _Pragma("unroll") for (int vtile = 0; vtile < 4; ++vtile) { acc[vtile] = acc[vtile] - mean; const f32x4 a = acc[vtile]; qv += (a[0] * a[0] + a[1] * a[1]) + (a[2] * a[2] + a[3] * a[3]); } \
        qv += SHX(qv, 16); qv += SHX(qv, 32); \
        const float rstd = 1.0f / sqrtf(qv * (1.0f / 64.0f) + GN_EPS); \
        const int tau = 16 * nb + fr, pos = d ? 63 - tau : tau; \
        LAS float* Yd = (LAS float*)(lds + d * 17408); \
        _Pragma("unroll") for (int vtile = 0; vtile < 4; ++vtile) { const int v0 = 16 * vtile + 4 * fq; \
            *(LAS f32x4*)(Yd + pos * LD32 + v0) = acc[vtile] * rstd * gnw[vtile] + gnb[vtile]; } \
        LBAR(); \
        { const int pos2 = tid >> 3, c8 = (tid & 7) * 8, row = R0 + pos2, chn = 64 * h + c8; \
          const LAS float* Y0 = (const LAS float*)lds; const LAS float* Y1 = (const LAS float*)(lds + 17408); \
          float v[8], gt[8], o[8]; unpack8(cv, v); unpack8(cgt, gt); \
          const f32x4 y00 = *(const LAS f32x4*)(Y0 + pos2 * LD32 + c8), y01 = *(const LAS f32x4*)(Y0 + pos2 * LD32 + c8 + 4), y10 = *(const LAS f32x4*)(Y1 + pos2 * LD32 + c8), y11 = *(const LAS f32x4*)(Y1 + pos2 * LD32 + c8 + 4); \
          _Pragma("unroll") for (int j = 0; j < 4; ++j) { o[j] = (y00[j] + y10[j] + bon * v[j]) * gt[j]; o[4 + j] = (y01[j] + y11[j] + bon * v[4 + j]) * gt[4 + j]; } \
          *(u32x4*)(O + (size_t)row * D + chn) = pack8(o); } \
        LBAR(); } while (0)
    if (bx < NIT) CC_ISSUE(bx, fa0, fb0, pv0, pg0, pb00, pb01);
    for (int item = bx; item < NIT; item += G) {
        CC_BODY(item, fa0, fb0, pv0, pg0, pb00, pb01, item + G);
    }
#undef CC_BODY
#undef CC_ISSUE
}

__device__ __forceinline__ void p_final(Frame& F) {
    PH_LOCALS(F);
    const int gw = bx * NWAVES + wave, NGW = G * NWAVES;
    const float* fg = F.in[I_FNG]; const bf16* X = (const bf16*)(F.ws + WS_X);
    f32x4 fgv[8];
#pragma unroll
    for (int j = 0; j < 8; ++j) fgv[j] = *(const f32x4*)(fg + 8 * lane + 512 * (j >> 1) + 4 * (j & 1));
    for (int row = gw; row < M; row += NGW) {
        const bf16* xr = X + (size_t)row * D; float* orow = F.out + (size_t)row * D;
        float v[4][8]; float ss = 0.f;
#pragma unroll
        for (int j = 0; j < 4; ++j) { unpack8(*(const u32x4*)(xr + 8 * lane + 512 * j), v[j]);
#pragma unroll
            for (int e = 0; e < 8; ++e) ss += v[j][e] * v[j][e]; }
        WAVE_SUM(ss); const float rstd = 1.0f / sqrtf(ss * (1.0f / D) + RMS_EPS);
#pragma unroll
        for (int j = 0; j < 4; ++j) { const int c = 8 * lane + 512 * j;
            *(f32x4*)(orow + c) = (f32x4){v[j][0], v[j][1], v[j][2], v[j][3]} * rstd * fgv[2 * j];
            *(f32x4*)(orow + c + 4) = (f32x4){v[j][4], v[j][5], v[j][6], v[j][7]} * rstd * fgv[2 * j + 1]; }
    }
}

constexpr int PH_PER_LAYER = 10, N_PHASES = 2 + NL * PH_PER_LAYER;
__global__ void __launch_bounds__(NWAVES * 64, 2) hymba_fwd(Args args) {
    extern __shared__ __attribute__((aligned(16))) unsigned char lds[];
    Frame F;
    F.lds = (LAS unsigned char*)lds;
    F.tid = threadIdx.x; F.lane = F.tid & 63; F.wave = __builtin_amdgcn_readfirstlane(F.tid >> 6);
    F.G = gridDim.x; F.bx = blockIdx.x;
    F.in = args.in; F.out = args.out; F.ws = args.ws;
    for (int u = F.tid; u < (LDS_BYTES - LDSCTL_OFF) / 4; u += NWAVES * 64) ((LAS unsigned*)(F.lds + LDSCTL_OFF))[u] = 0u;
    __syncthreads();
    volatile LAS unsigned* MISC = (volatile LAS unsigned*)(F.lds + MISC_OFF);
    unsigned* barw = (unsigned*)(F.ws + WS_CTL) + CW_BAR;
    XcdBarrier bar; bar.bar = barw; bar.x = 0; bar.st = nullptr;
    if (MK_N_LAUNCHES == 1) bar = xcd_barrier_post(barw, MISC + 8);
    const int lo = args.ph_lo, hi = args.ph_hi;
#define IN(k) (lo <= (k) && (k) < hi)
#define SEAM(k) do { if (MK_N_LAUNCHES == 1 && IN(k) && IN((k) + 1)) xcd_barrier(bar); } while (0)

    for (int rep = 0; rep < ((PROBE_DUP == 30) ? 2 : 1); ++rep)
    if (IN(0)) { p0_prologue(F); __syncthreads(); } SEAM(0);
    bf16* H = (bf16*)(F.ws + WS_H); bf16* O = (bf16*)(F.ws + WS_O); bf16* P = (bf16*)(F.ws + WS_P); bf16* HID = (bf16*)(F.ws + WS_HID);
    const float* mod = (const float*)(F.ws + WS_MOD);
    for (int l = 0; l < NL; ++l) {
        const int pb = 1 + l * PH_PER_LAYER;
        const float* xlo = F.in[I_XP]; const float* xhi = F.in[I_XS]; bf16* XS = (bf16*)(F.ws + WS_X);
        float* dummy = (float*)(F.ws + WS_P);
        for (int rep = 0; rep < ((PROBE_DUP == 7) ? 2 : 1); ++rep)
        if (IN(pb + 0)) { p_adaln(F, l, 0, xlo, xhi, l == 0 ? nullptr : XS); } SEAM(pb + 0);
        for (int rep = 0; rep < ((PROBE_DUP == 1 || PROBE_DUP == 20) ? 2 : 1); ++rep)
        if (IN(pb + 1)) { pg8::Gemm g{H, (const bf16*)(F.ws + WS_WIN + l * SZ_WIN), M, PINP, D}; pg8::StaticOrder S; { int cb_ = F.bx, cg_ = F.G; asm volatile("" : "+s"(cb_), "+s"(cg_)); S.init(M, PINP, cg_, cb_, D); }
            EpiP E{P, PINP, CSH}; pg8::gemm_phase<EpiP, pg8::StaticOrder, true, true>(F.lds, g, S, E, F.wave); } SEAM(pb + 1);
        for (int rep = 0; rep < ((PROBE_DUP == 2) ? 2 : 1); ++rep)
        if (IN(pb + 2)) { p_shift(F, l); } SEAM(pb + 2);
        if (IN(pb + 3)) { for (int rep = 0; rep < ((PROBE_DUP == 3) ? 2 : 1); ++rep) p_chunkA(F, l); } SEAM(pb + 3);
        for (int rep = 0; rep < ((PROBE_DUP == 4) ? 2 : 1); ++rep)
        if (IN(pb + 4)) { p_chunkB(F, l);
            for (int rep = 0; rep < ((PROBE_DUP == 13) ? 2 : 1); ++rep) p_gmlp(F, l, F.G > 64 ? (F.bx >= 64 ? F.bx - 64 : -1) : F.bx, F.G > 64 ? F.G - 64 : F.G); } SEAM(pb + 4);
        for (int rep = 0; rep < ((PROBE_DUP == 5) ? 2 : 1); ++rep)
        if (IN(pb + 5)) { p_chunkC(F, l); } SEAM(pb + 5);
        if ((PROBE_DUP == 6 || PROBE_DUP == 20) && IN(pb + 6)) { pg8::Gemm g{O, (const bf16*)(F.ws + WS_WOUT + l * SZ_WOUT), M, D, D}; pg8::StaticOrder S; { int cb_ = F.bx, cg_ = F.G; asm volatile("" : "+s"(cb_), "+s"(cg_)); S.init(M, D, cg_, cb_, D); }
            EpiRes E{xlo, xhi, l == 0 ? nullptr : XS, (bf16*)dummy, mod + (size_t)l * 5 * MODW, 2 * D}; pg8::gemm_phase<EpiRes, pg8::StaticOrder, true, true>(F.lds, g, S, E, F.wave); }
        if (IN(pb + 6)) { pg8::Gemm g{O, (const bf16*)(F.ws + WS_WOUT + l * SZ_WOUT), M, D, D}; pg8::FullRoundsOrder S; pg8::TailHalfOrder S2; { int cb_ = F.bx, cg_ = F.G; asm volatile("" : "+s"(cb_), "+s"(cg_)); S.init(M, D, cg_, cb_, D); S2.init(M, D, cg_, cb_, D); }
            EpiRes E{xlo, xhi, l == 0 ? nullptr : XS, XS, mod + (size_t)l * 5 * MODW, 2 * D}; pg8::gemm_phase<EpiRes, pg8::FullRoundsOrder, true, true>(F.lds, g, S, E, F.wave);
            pg8::gemm_phase<EpiRes, pg8::TailHalfOrder, true, true, true>(F.lds, g, S2, E, F.wave); } SEAM(pb + 6);
        for (int rep = 0; rep < ((PROBE_DUP == 7) ? 2 : 1); ++rep)
        if (IN(pb + 7)) { p_adaln(F, l, 1, xlo, xhi, XS); } SEAM(pb + 7);
        for (int rep = 0; rep < ((PROBE_DUP == 8 || PROBE_DUP == 20) ? 2 : 1); ++rep)
        if (IN(pb + 8)) { pg8::Gemm g{H, (const bf16*)(F.ws + WS_WGU + l * SZ_WGU), M, NGU, D}; pg8::StaticOrder S; { int cb_ = F.bx, cg_ = F.G; asm volatile("" : "+s"(cb_), "+s"(cg_)); S.init(M, NGU, cg_, cb_, D); }
            EpiSwi E{HID, DFF}; pg8::gemm_phase<EpiSwi, pg8::StaticOrder, true, true>(F.lds, g, S, E, F.wave); } SEAM(pb + 8);
        if ((PROBE_DUP == 9 || PROBE_DUP == 20) && IN(pb + 9)) { pg8::Gemm g{HID, (const bf16*)(F.ws + WS_WD + l * SZ_WD), M, D, DFF}; pg8::StaticOrder S; { int cb_ = F.bx, cg_ = F.G; asm volatile("" : "+s"(cb_), "+s"(cg_)); S.init(M, D, cg_, cb_, DFF); }
            EpiRes E{xlo, xhi, XS, (bf16*)dummy, mod + (size_t)l * 5 * MODW, 5 * D}; pg8::gemm_phase<EpiRes, pg8::StaticOrder, true, true>(F.lds, g, S, E, F.wave); }
        if (IN(pb + 9)) { pg8::Gemm g{HID, (const bf16*)(F.ws + WS_WD + l * SZ_WD), M, D, DFF}; pg8::FullRoundsOrder S; pg8::TailHalfOrder S2; { int cb_ = F.bx, cg_ = F.G; asm volatile("" : "+s"(cb_), "+s"(cg_)); S.init(M, D, cg_, cb_, DFF); S2.init(M, D, cg_, cb_, DFF); }
            EpiRes E{xlo, xhi, XS, XS, mod + (size_t)l * 5 * MODW, 5 * D}; pg8::gemm_phase<EpiRes, pg8::FullRoundsOrder, true, true>(F.lds, g, S, E, F.wave);
            pg8::gemm_phase<EpiRes, pg8::TailHalfOrder, true, true, true>(F.lds, g, S2, E, F.wave); } SEAM(pb + 9);
    }
    if (IN(N_PHASES - 1)) { p_final(F); }
#undef IN
#undef SEAM
}

extern "C" void kernel_launch(void* const* d_in, const int* in_sizes, int n_in, void* d_out, int out_size, void* d_ws, size_t ws_size, hipStream_t stream) {
    static int grid = 0;
    if (grid == 0) {
        if (n_in != 30 || ws_size < WS_END) { fprintf(stderr, "kernel_launch: need 30 inputs and >= %zu bytes of workspace; got n_in %d, ws %zu\n", (size_t)WS_END, n_in, ws_size); grid = -1; return; }
        int dev = 0, cus = 0, per_cu = 0;
        if (hipGetDevice(&dev) != hipSuccess || hipDeviceGetAttribute(&cus, hipDeviceAttributeMultiprocessorCount, dev) != hipSuccess) { grid = -1; return; }
        if (hipFuncSetAttribute((const void*)hymba_fwd, hipFuncAttributeMaxDynamicSharedMemorySize, LDS_BYTES) != hipSuccess) { fprintf(stderr, "kernel_launch: hipFuncSetAttribute failed\n"); grid = -1; return; }
        if (hipOccupancyMaxActiveBlocksPerMultiprocessor(&per_cu, (const void*)hymba_fwd, NWAVES * 64, LDS_BYTES) != hipSuccess || per_cu < 1)
            fprintf(stderr, "kernel_launch: note: occupancy query reports %d workgroups per CU\n", per_cu);
        (void)hipGetLastError();
        grid = cus;
    }
    if (grid < 0) return;
    if (hipMemsetAsync((char*)d_ws + WS_CTL, 0, CTL_ZERO_BYTES, stream) != hipSuccess) return;
    Args a{};
    for (int i = 0; i < 30; ++i) a.in[i] = (const float*)d_in[i];
    a.out = (float*)d_out; a.ws = (unsigned char*)d_ws; a.pad = 0;
    if (MK_N_LAUNCHES == 1) {
        a.ph_lo = 0; a.ph_hi = N_PHASES; a.li = 0;
        hipLaunchKernelGGL(hymba_fwd, dim3(grid), dim3(NWAVES * 64), LDS_BYTES, stream, a);
    } else {
        for (int k = 0; k < N_PHASES; ++k) { a.ph_lo = k; a.ph_hi = k + 1; a.li = k;
            hipLaunchKernelGGL(hymba_fwd, dim3(grid), dim3(NWAVES * 64), LDS_BYTES, stream, a); }
    }
}
```

```cpp
#include <hip/hip_runtime.h>
#include <cstdio>
#include <cstdint>

#ifndef PROBE_DUP
#define PROBE_DUP -1
#endif
#ifndef PROBE_SUB
#define PROBE_SUB 0
#endif
#ifndef MK_N_LAUNCHES
#define MK_N_LAUNCHES 1
#endif

namespace pg8 {
#define PG8_LAS __attribute__((address_space(3)))
typedef unsigned short bf16_t;
typedef short bf16x8 __attribute__((ext_vector_type(8)));
typedef float f32x4 __attribute__((ext_vector_type(4)));
typedef unsigned u32x4 __attribute__((ext_vector_type(4)));
constexpr int BM = 256, BK = 64, HALF = 128, HTB = HALF * BK * 2  , STAGE_BYTES = 8 * HTB, NXCD = 8, WGM = 8;

__host__ __device__ __forceinline__ int lds_byte(int r, int c) { const int st = (r >> 4) * 2 + (c >> 5), rr = r & 15, cc = c & 31, ob = rr * 64 + cc * 2; return st * 1024 + (ob ^ (((ob >> 9) & 1) << 5)); }
__host__ __device__ __forceinline__ void stage_rc(int b, int& R, int& C) { const int st = b / 1024, sb = b % 1024, swz = sb ^ (((sb >> 9) & 1) << 5); R = (st >> 1) * 16 + swz / 64; C = (st & 1) * 32 + (swz % 64) / 2; }
__host__ __device__ __forceinline__ int perm32(int rho) { const int n = rho >> 4, i = rho & 15; return 8 * (i >> 2) + 4 * n + (i & 3); }

struct Unit { int pm, pn, k0, nk, bh; };
struct Gemm { const bf16_t* A; const bf16_t* Bt; int M, N, K; };

struct StaticOrder {
    int nM, nN, nwg, G, c, nkt, full, rem;
    __host__ __device__ void init(int M, int N, int G_, int c_, int K_) { nM = M / BM; nN = N / BM; nwg = nM * nN; G = G_; c = c_; nkt = K_ / BK; full = nwg / G; rem = nwg - full * G; }
    __host__ __device__ bool next(int i, Unit& u) const {
        const long L = (long)i * G + c; if (L >= nwg) return false;
        int wgid = (int)L; { const int q = nwg / NXCD, r = nwg % NXCD, xcd = wgid % NXCD, off = wgid / NXCD; wgid = (xcd < r ? xcd * (q + 1) : r * (q + 1) + (xcd - r) * q) + off; }
        const int nig = WGM * nN, gid = wgid / nig, fm = gid * WGM, gsz = (nM - fm) < WGM ? (nM - fm) : WGM;
        u.pm = fm + ((wgid % nig) % gsz); u.pn = (wgid % nig) / gsz; u.k0 = 0; u.nk = nkt; u.bh = -1;
#if defined(__HIP_DEVICE_COMPILE__)
        u.pm = __builtin_amdgcn_readfirstlane(u.pm); u.pn = __builtin_amdgcn_readfirstlane(u.pn);
#endif
        return true;
    }
    __device__ __forceinline__ void a_ready(const Unit&) const {}
    __device__ __forceinline__ void done(const Unit&) const {}
};
struct FullRoundsOrder : StaticOrder {
    __host__ __device__ bool split() const { return rem > 0 && 2 * rem <= G; }
    __host__ __device__ bool next(int i, Unit& u) const { if (split() && i >= full) return false; return StaticOrder::next(i, u); }
};
struct TailHalfOrder : StaticOrder {
    __host__ __device__ bool next(int i, Unit& u) const {
        if (!(rem > 0 && 2 * rem <= G) || i > 0 || c >= 2 * rem) return false;
        StaticOrder t = *this; t.c = c >> 1; if (!t.StaticOrder::next(full, u)) return false;
        u.bh = c & 1; return true;
    }
};

__device__ __forceinline__ unsigned cvt_pk_bf16(float lo, float hi) { unsigned r; asm volatile("v_cvt_pk_bf16_f32 %0, %1, %2" : "=v"(r) : "v"(lo), "v"(hi)); return r; }

template <class Epi, class Sched, bool ALIGN_EPI = false, bool SP2 = false, bool HALFB = false>
__device__ __forceinline__ void gemm_phase(PG8_LAS unsigned char* lds, const Gemm g, const Sched& S, const Epi& E, int wid) {
    asm volatile("" : "+s"(wid)); int lane; asm volatile("v_mbcnt_lo_u32_b32 %0, -1, 0\n\tv_mbcnt_hi_u32_b32 %0, -1, %0" : "=v"(lane));
    const int tid = wid * 64 + lane, wr = wid >> 2, wc = wid & 3, fr = lane & 15, fq = lane >> 4;
    const int K = g.K;
    unsigned voffA[2], voffB[2];
#pragma unroll
    for (int i = 0; i < 2; ++i) { int R, C; stage_rc(tid * 16 + i * 8192, R, C); const int Rb = Epi::PERM ? ((R & ~31) + perm32(R & 31)) : R;
        voffA[i] = (unsigned)(R * K + C) * 2u; voffB[i] = (unsigned)(Rb * K + C) * 2u; }
    const size_t kstep = (size_t)(BK * 2);
    const size_t hstep = (size_t)HALF * K * 2;
    const size_t tstep = 2 * hstep;
    const size_t bhs = HALFB ? 0 : hstep;
    const unsigned ldsw = (unsigned)wid * 1024u;
    const int aoff = lds_byte(wr * 64 + fr, fq * 8), boff = lds_byte(wc * 32 + fr, fq * 8);
#define PG8_SA(b, h) (((b) * 2 + (h)) * HTB)
#define PG8_SB(b, h) ((4 + (b) * 2 + (h)) * HTB)
#define PG8_STAGE(bufoff, gbase, voff) do { _Pragma("unroll") for (int _i = 0; _i < 2; ++_i) \
        __builtin_amdgcn_global_load_lds((const unsigned*)((const char*)(gbase) + (voff)[_i]), (PG8_LAS unsigned*)(lds + (bufoff) + ldsw + _i * 8192), 16, 0, 0); } while (0)
#define PG8_LDA(dst, b, h) do { _Pragma("unroll") for (int m = 0; m < 4; ++m) _Pragma("unroll") for (int k = 0; k < 2; ++k) dst[m][k] = *(const PG8_LAS bf16x8*)(lds + PG8_SA(b, h) + aoff + m * 2048 + k * 1024); } while (0)
#define PG8_LDB(dst, b, h) do { _Pragma("unroll") for (int n = 0; n < 2; ++n) _Pragma("unroll") for (int k = 0; k < 2; ++k) dst[n][k] = *(const PG8_LAS bf16x8*)(lds + PG8_SB(b, h) + boff + n * 2048 + k * 1024); } while (0)
#define PG8_MMA(ai, bj, At, Bt) do { __builtin_amdgcn_s_setprio(1); _Pragma("unroll") for (int m = 0; m < 4; ++m) _Pragma("unroll") for (int n = 0; n < 2; ++n) _Pragma("unroll") for (int k = 0; k < 2; ++k) \
        acc[ai][bj][m][n] = __builtin_amdgcn_mfma_f32_16x16x32_bf16(Bt[n][k], At[m][k], acc[ai][bj][m][n], 0, 0, 0); __builtin_amdgcn_s_setprio(0); } while (0)
#define PG8_WAIT_V(n) asm volatile("s_waitcnt vmcnt(" #n ")" ::: "memory")
#define PG8_WAIT_L(n) asm volatile("s_waitcnt lgkmcnt(" #n ")" ::: "memory")
#define PG8_BAR __builtin_amdgcn_s_barrier()
#define PG8_SCHED __builtin_amdgcn_sched_barrier(0)
    Unit cur, nxt; int ui = 0;
    if (!S.next(0, cur)) return;
    f32x4 acc[2][2][4][2];
#pragma unroll
    for (int a = 0; a < 2; ++a)
#pragma unroll
        for (int b = 0; b < 2; ++b)
#pragma unroll
            for (int m = 0; m < 4; ++m)
#pragma unroll
                for (int n = 0; n < 2; ++n) acc[a][b][m][n] = (f32x4){0.f, 0.f, 0.f, 0.f};
    bf16x8 At[4][2], B0[2][2], B1[2][2];
    const char* cA = (const char*)g.A + (size_t)cur.pm * tstep + (size_t)cur.k0 * kstep; const char* cB = (const char*)g.Bt + (size_t)cur.pn * tstep + (size_t)cur.k0 * kstep + (HALFB ? (size_t)cur.bh * hstep : 0);
    S.a_ready(cur);
    if constexpr (SP2) {
        PG8_STAGE(PG8_SB(0, 0), cB, voffB); PG8_STAGE(PG8_SB(0, 1), cB + bhs, voffB); PG8_STAGE(PG8_SA(0, 0), cA, voffA); PG8_STAGE(PG8_SA(0, 1), cA + hstep, voffA);
        if (wr == 1) PG8_BAR;
        PG8_WAIT_V(2); PG8_BAR;
        PG8_STAGE(PG8_SB(1, 0), cB + kstep, voffB); PG8_STAGE(PG8_SA(1, 0), cA + kstep, voffA); PG8_STAGE(PG8_SB(1, 1), cB + bhs + kstep, voffB);
        PG8_WAIT_V(6); PG8_BAR;
    } else {
        PG8_STAGE(PG8_SB(0, 0), cB, voffB); PG8_STAGE(PG8_SA(0, 0), cA, voffA); PG8_STAGE(PG8_SB(0, 1), cB + bhs, voffB); PG8_STAGE(PG8_SA(0, 1), cA + hstep, voffA);
        if (wr == 1) PG8_BAR;
        PG8_WAIT_V(4); PG8_BAR;
        PG8_STAGE(PG8_SB(1, 0), cB + kstep, voffB); PG8_STAGE(PG8_SA(1, 0), cA + kstep, voffA); PG8_STAGE(PG8_SB(1, 1), cB + bhs + kstep, voffB);
        PG8_WAIT_V(6); PG8_BAR;
    }
    for (;;) {
        const bool has_next = S.next(ui + 1, nxt);
        const char* nA = has_next ? (const char*)g.A + (size_t)nxt.pm * tstep + (size_t)nxt.k0 * kstep : cA; const char* nB = has_next ? (const char*)g.Bt + (size_t)nxt.pn * tstep + (size_t)nxt.k0 * kstep + (HALFB ? (size_t)nxt.bh * hstep : 0) : cB;
        const int nt = cur.nk;
        for (int t = 0; t < nt; t += 2) {
            const bool last = (t == nt - 2);
            const char* a1 = cA + (size_t)(t + 1) * kstep;
            const char* a2 = last ? nA : cA + (size_t)(t + 2) * kstep; const char* b2 = last ? nB : cB + (size_t)(t + 2) * kstep;
            const char* a3 = a2 + kstep; const char* b3 = b2 + kstep;
            if (last && has_next) S.a_ready(nxt);
            if constexpr (SP2) {
            PG8_LDB(B0, 0, 0); if constexpr (!HALFB) PG8_LDB(B1, 0, 1); PG8_SCHED; PG8_LDA(At, 0, 0); PG8_STAGE(PG8_SA(1, 1), a1 + hstep, voffA);
            PG8_WAIT_V(8); PG8_WAIT_L(0); PG8_BAR; PG8_MMA(0, 0, At, B0); if constexpr (!HALFB) PG8_MMA(0, 1, At, B1); PG8_BAR; PG8_SCHED;
            PG8_LDA(At, 0, 1); PG8_STAGE(PG8_SB(0, 0), b2, voffB); PG8_STAGE(PG8_SB(0, 1), b2 + bhs, voffB); PG8_STAGE(PG8_SA(0, 0), a2, voffA);
            PG8_WAIT_V(8); PG8_WAIT_L(0); PG8_BAR; PG8_MMA(1, 0, At, B0); if constexpr (!HALFB) PG8_MMA(1, 1, At, B1); PG8_BAR; PG8_SCHED;
            PG8_LDB(B0, 1, 0); if constexpr (!HALFB) PG8_LDB(B1, 1, 1); PG8_SCHED; PG8_LDA(At, 1, 0); PG8_STAGE(PG8_SA(0, 1), a2 + hstep, voffA);
            PG8_WAIT_V(8); PG8_WAIT_L(0); PG8_BAR; PG8_MMA(0, 0, At, B0); if constexpr (!HALFB) PG8_MMA(0, 1, At, B1); PG8_BAR; PG8_SCHED;
            PG8_LDA(At, 1, 1); PG8_STAGE(PG8_SB(1, 0), b3, voffB); PG8_STAGE(PG8_SB(1, 1), b3 + bhs, voffB); PG8_STAGE(PG8_SA(1, 0), a3, voffA);
            PG8_WAIT_V(8); PG8_WAIT_L(0); PG8_BAR; PG8_MMA(1, 0, At, B0); if constexpr (!HALFB) PG8_MMA(1, 1, At, B1); PG8_BAR; PG8_SCHED;
            } else {
            PG8_LDB(B0, 0, 0); PG8_SCHED; PG8_LDA(At, 0, 0); PG8_STAGE(PG8_SA(1, 1), a1 + hstep, voffA);
            PG8_WAIT_L(8); PG8_BAR; PG8_WAIT_L(0); PG8_MMA(0, 0, At, B0); PG8_BAR; PG8_SCHED;
            PG8_LDB(B1, 0, 1); PG8_STAGE(PG8_SB(0, 0), b2, voffB);
            PG8_BAR; PG8_WAIT_L(0); PG8_MMA(0, 1, At, B1); PG8_BAR;
            PG8_LDA(At, 0, 1); PG8_STAGE(PG8_SA(0, 0), a2, voffA);
            PG8_BAR; PG8_WAIT_L(0); PG8_MMA(1, 0, At, B0); PG8_BAR; PG8_SCHED;
            PG8_STAGE(PG8_SB(0, 1), b2 + bhs, voffB);
            PG8_WAIT_V(6); PG8_BAR; PG8_MMA(1, 1, At, B1); PG8_BAR;
            PG8_LDB(B0, 1, 0); PG8_SCHED; PG8_LDA(At, 1, 0); PG8_STAGE(PG8_SA(0, 1), a2 + hstep, voffA);
            PG8_WAIT_L(8); PG8_BAR; PG8_WAIT_L(0); PG8_MMA(0, 0, At, B0); PG8_BAR; PG8_SCHED;
            PG8_LDB(B1, 1, 1); PG8_STAGE(PG8_SB(1, 0), b3, voffB);
            PG8_BAR; PG8_WAIT_L(0); PG8_MMA(0, 1, At, B1); PG8_BAR;
            PG8_LDA(At, 1, 1); PG8_STAGE(PG8_SA(1, 0), a3, voffA);
            PG8_BAR; PG8_WAIT_L(0); PG8_MMA(1, 0, At, B0); PG8_BAR; PG8_SCHED;
            PG8_STAGE(PG8_SB(1, 1), b3 + bhs, voffB);
            PG8_WAIT_V(6); PG8_BAR; PG8_MMA(1, 1, At, B1); PG8_BAR;
            }
        }
        if constexpr (ALIGN_EPI) { if (wr == 0) PG8_BAR; }
        E(acc, cur, wr, wc, fr, fq); S.done(cur);
        if (!has_next) break;
#pragma unroll
        for (int a = 0; a < 2; ++a)
#pragma unroll
            for (int b = 0; b < 2; ++b)
#pragma unroll
                for (int m = 0; m < 4; ++m)
#pragma unroll
                    for (int n = 0; n < 2; ++n) acc[a][b][m][n] = (f32x4){0.f, 0.f, 0.f, 0.f};
        cur = nxt; cA = nA; cB = nB; ++ui;
        if constexpr (ALIGN_EPI) { if (wr == 1) PG8_BAR; }
    }
    PG8_WAIT_V(0);
    if constexpr (!ALIGN_EPI) { if (wr == 0) PG8_BAR; }
    PG8_BAR;
#undef PG8_SA
#undef PG8_SB
#undef PG8_STAGE
#undef PG8_LDA
#undef PG8_LDB
#undef PG8_MMA
#undef PG8_WAIT_V
#undef PG8_WAIT_L
#undef PG8_BAR
#undef PG8_SCHED
}
}

constexpr int NWAVES = 8;
constexpr int D = 2048, MCTX = 4096, MLAT = 16384, M = MCTX + MLAT, NL = 4;
constexpr int DA = 1024, NH = 16, DB = 1024, NG = 8, HB = 128;
constexpr int LW = 64, LAA = 64, LGT = 160;
constexpr int CSH = 3 * DA + LW + LAA + LGT;
constexpr int PIN = CSH + 2 * DB;
constexpr int PINP = 5632;
constexpr int DFF = 5632, NGU = 2 * DFF;
constexpr int MODW = 6 * D;
constexpr float RMS_EPS = 1e-6f, GN_EPS = 64.0f * 1e-5f, LN_EPS = 1e-5f;

constexpr size_t MiB = 1u << 20;
constexpr size_t WS_CTL = 0, CTL_ZERO_BYTES = 1 * MiB;
constexpr size_t WS_MOD = 1 * MiB;
constexpr size_t WS_W2T = 2 * MiB;
constexpr size_t WS_A2T = 3 * MiB;
constexpr size_t WS_G2T = 4 * MiB;
constexpr size_t WS_WSP = 6 * MiB;
constexpr size_t WS_BONUS = 7 * MiB;
constexpr size_t SZ_WIN = (size_t)PINP * D * 2, SZ_WOUT = (size_t)D * D * 2, SZ_WGU = (size_t)NGU * D * 2, SZ_WD = (size_t)D * DFF * 2;
constexpr size_t WS_WIN = 16 * MiB;
constexpr size_t WS_WOUT = WS_WIN + NL * SZ_WIN;
constexpr size_t WS_WGU = WS_WOUT + NL * SZ_WOUT;
constexpr size_t WS_WD = WS_WGU + NL * SZ_WGU;
constexpr size_t WS_H = WS_WD + NL * SZ_WD;
constexpr size_t WS_O = WS_H + (size_t)M * D * 2;
constexpr size_t WS_P = WS_O + (size_t)M * D * 2;
constexpr size_t WS_PS = WS_P + (size_t)M * PINP * 2;
constexpr size_t SZ_T16 = (size_t)M * DA * 2;
constexpr size_t WS_GATE = WS_PS + (size_t)M * CSH * 2;
constexpr size_t SZ_CH = (size_t)(M / 64) * NH * 2 * 8192;
constexpr size_t WS_PST = WS_GATE + SZ_T16;
constexpr size_t WS_NCT = WS_PST + SZ_CH;
constexpr size_t WS_PYT = WS_NCT + SZ_CH;
constexpr size_t WS_QYT = WS_PYT + SZ_CH;
constexpr size_t WS_VTG = WS_QYT + SZ_CH;
constexpr size_t WS_SC = WS_VTG + SZ_CH;
constexpr size_t WS_LORA = WS_SC + SZ_CH;
constexpr size_t WS_X = WS_LORA + (size_t)M * 288 * 2;
constexpr size_t WS_END1 = WS_X + (size_t)M * D * 2;
constexpr size_t WS_HID = WS_GATE;
constexpr size_t WS_END = WS_END1 > WS_HID + (size_t)M * DFF * 2 ? WS_END1 : WS_HID + (size_t)M * DFF * 2;
constexpr int CW_BAR = 4096;
constexpr int CW_SPLIT = 16384;
static_assert((CW_SPLIT + NL * 640 * 64) * 4 <= (int)CTL_ZERO_BYTES, "control words inside the memset region");

constexpr int RING_BYTES = 131072;
constexpr int LDSCTL_OFF = 15 * 9216, MISC_OFF = LDSCTL_OFF + 320;
constexpr int LDS_BYTES = 147456;

#define GAS __attribute__((address_space(1)))
#define LAS __attribute__((address_space(3)))
typedef unsigned short bf16;
typedef float f32x4 __attribute__((ext_vector_type(4)));
typedef float f32x2 __attribute__((ext_vector_type(2)));
typedef short bf16x8 __attribute__((ext_vector_type(8)));
typedef unsigned u32x4 __attribute__((ext_vector_type(4)));
typedef unsigned u32x2 __attribute__((ext_vector_type(2)));
#define LDS_WAIT() asm volatile("s_waitcnt lgkmcnt(0)" ::: "memory")
#define VM_WAIT() asm volatile("s_waitcnt vmcnt(0)" ::: "memory")
__device__ __forceinline__ unsigned f2bf(float f) { unsigned u = __builtin_bit_cast(unsigned, f); return (u + 0x7fffu + ((u >> 16) & 1u)) >> 16; }
typedef __bf16 bf16x2_t __attribute__((ext_vector_type(2)));
__device__ __forceinline__ unsigned pk2(float lo, float hi) { return __builtin_bit_cast(unsigned, __builtin_convertvector((f32x2){lo, hi}, bf16x2_t)); }
__device__ __forceinline__ float bf2f(unsigned short b) { return __uint_as_float(((unsigned)b) << 16); }
__device__ __forceinline__ void unpack8(const u32x4 q, float (&f)[8]) {
    f[0] = __uint_as_float(q.x << 16); f[1] = __uint_as_float(q.x & 0xffff0000u); f[2] = __uint_as_float(q.y << 16); f[3] = __uint_as_float(q.y & 0xffff0000u);
    f[4] = __uint_as_float(q.z << 16); f[5] = __uint_as_float(q.z & 0xffff0000u); f[6] = __uint_as_float(q.w << 16); f[7] = __uint_as_float(q.w & 0xffff0000u); }
__device__ __forceinline__ u32x4 pack8(const float (&f)[8]) { u32x4 o; o.x = pk2(f[0], f[1]); o.y = pk2(f[2], f[3]); o.z = pk2(f[4], f[5]); o.w = pk2(f[6], f[7]); return o; }
__device__ __forceinline__ float fsigmoid(float x) { return __builtin_amdgcn_rcpf(1.0f + __expf(-x)); }
__device__ __forceinline__ float ftanh(float x) { return 1.0f - 2.0f * __builtin_amdgcn_rcpf(1.0f + __expf(2.0f * x)); }
__device__ __forceinline__ float gelu_tanh(float x) {
    constexpr float c1 = -1.5957691216057308f * 1.4426950408889634f, c2 = c1 * 0.044715f; const float p = __builtin_fmaf(x * x, c2, c1); return x * __builtin_amdgcn_rcpf(1.0f + __builtin_amdgcn_exp2f(x * p)); }
__device__ __forceinline__ int hw_lane() { int l; asm volatile("v_mbcnt_lo_u32_b32 %0, -1, 0\n\tv_mbcnt_hi_u32_b32 %0, -1, %0" : "=v"(l)); return l; }
#define SHX(v, X) __int_as_float(__builtin_amdgcn_ds_bpermute((lane ^ (X)) << 2, __float_as_int(v)))
#define WAVE_SUM(v) do { v += SHX(v, 1); v += SHX(v, 2); v += SHX(v, 4); v += SHX(v, 8); v += SHX(v, 16); v += SHX(v, 32); } while (0)

#define PH_LOCALS(F) int wave = (F).wave; asm volatile("" : "+s"(wave)); const int lane = hw_lane(); const int tid = wave * 64 + lane; \
    int bx = (F).bx, G = (F).G; asm volatile("" : "+s"(bx), "+s"(G)); (void)lane; (void)tid;
#define PH_LAYER(l) asm volatile("" : "+s"(l))

#define XB_TMO      128
#define XB_XCNT(j)  (256  + 64 * (j))
#define XB_XSUB(j)  (1280 + 64 * (j))
#define XB_XGEN(j)  (2304 + 64 * (j))
#define XB_TOP      3328
#define XB_TOPGEN   3392
#define XCD_BAR_WORDS 3456
#define XB_SPIN_CAP (1u << 18)

__device__ __forceinline__ unsigned xb_ld(unsigned* p)              { return __hip_atomic_load(p, __ATOMIC_RELAXED, __HIP_MEMORY_SCOPE_AGENT); }
__device__ __forceinline__ unsigned xb_add(unsigned* p, unsigned v) { return __hip_atomic_fetch_add(p, v, __ATOMIC_RELAXED, __HIP_MEMORY_SCOPE_AGENT); }
__device__ __forceinline__ unsigned xb_xcc_id() { return (unsigned)__builtin_amdgcn_s_getreg((3 << 11) | 20) & 0xFu; }
#define XB_SPIN(cond, bar) do { unsigned _sp = 0; while (cond) { __builtin_amdgcn_s_sleep(1); \
    if ((++_sp & 255u) == 0u) { if (xb_ld(&(bar)[XB_TMO])) break; if (_sp > XB_SPIN_CAP) { atomicAdd(&(bar)[XB_TMO], 1u); break; } } } } while (0)

struct XcdBarrier {
    unsigned* bar; unsigned x;
    volatile LAS unsigned* st;
};
__device__ __forceinline__ XcdBarrier xcd_barrier_post(unsigned* bar, volatile LAS unsigned* st) {
    XcdBarrier b; b.bar = bar; b.x = xb_xcc_id(); b.st = st;
    if (threadIdx.x == 0) (void)xb_add(&bar[XB_XCNT(b.x)], 1u);
    return b;
}
__device__ __forceinline__ void xcd_barrier_complete(unsigned* bar, unsigned x, unsigned& nloc, unsigned& nx) {
    const unsigned G = gridDim.x * gridDim.y * gridDim.z;
    unsigned sum, cnt, mine, sp = 0u;
    for (;;) {
        sum = 0u; cnt = 0u; mine = 0u;
#pragma unroll
        for (unsigned j = 0; j < 16; ++j) { const unsigned c = xb_ld(&bar[XB_XCNT(j)]); sum += c; cnt += (c > 0u) ? 1u : 0u; mine = (j == x) ? c : mine; }
        if (sum == G) break;
        __builtin_amdgcn_s_sleep(1);
        if ((++sp & 255u) == 0u) { if (xb_ld(&bar[XB_TMO])) break; if (sp > XB_SPIN_CAP) { atomicAdd(&bar[XB_TMO], 1u); break; } }
    }
    nloc = mine > 0u ? mine : 1u; nx = cnt > 0u ? cnt : 1u;
}
__device__ __forceinline__ void xcd_barrier(const XcdBarrier& b) {
    asm volatile("s_waitcnt vmcnt(0)" ::: "memory");
    __syncthreads();
    if (threadIdx.x == 0) {
        unsigned* bar = b.bar;
        __builtin_amdgcn_s_waitcnt(0);
        unsigned nloc = b.st[0], nx = b.st[1];
        if (nloc == 0u) { xcd_barrier_complete(bar, b.x, nloc, nx); b.st[0] = nloc; b.st[1] = nx; }
        const unsigned old = xb_add(&bar[XB_XSUB(b.x)], 1u);
        const unsigned gen = old / nloc;
        if (old + 1u == (gen + 1u) * nloc) {
            __builtin_amdgcn_fence(__ATOMIC_RELEASE, "agent");
            asm volatile("s_waitcnt vmcnt(0)" ::: "memory");
            const unsigned og = xb_add(&bar[XB_TOP], 1u);
            const unsigned tg = og / nx;
            if (og + 1u == (tg + 1u) * nx) xb_add(&bar[XB_TOPGEN], 1u);
            else XB_SPIN(xb_ld(&bar[XB_TOPGEN]) == tg, bar);
            __builtin_amdgcn_fence(__ATOMIC_ACQUIRE, "agent");
            xb_add(&bar[XB_XGEN(b.x)], 1u);
            asm volatile("s_waitcnt vmcnt(0)" ::: "memory");
        } else {
            XB_SPIN(xb_ld(&bar[XB_XGEN(b.x)]) == gen, bar);
            __builtin_amdgcn_fence(__ATOMIC_ACQUIRE, "agent");
            asm volatile("s_waitcnt vmcnt(0)" ::: "memory");
        }
    }
    __syncthreads();
}

struct Args {
    const float* in[30];
    float* out; unsigned char* ws;
    int ph_lo, ph_hi, li, pad;
};
enum { I_XP = 0, I_XS, I_STATE, I_C, I_CCTX, I_WMOD, I_BMOD, I_N1G, I_WIN, I_MU, I_W0, I_W2, I_A0, I_A2, I_G2, I_KK, I_KA, I_RK, I_GNW, I_GNB, I_LNG, I_LNB, I_WSP, I_BSP, I_WOUT, I_N2G, I_WG, I_WU, I_WD, I_FNG };

struct Frame {
    LAS unsigned char* lds;
    int tid, lane, wave, G, bx;
    const float* const* in;
    float* out; unsigned char* ws;
};

struct EpiP {
    static constexpr bool PERM = true, AFTER_DRAIN = false;
    bf16* O; int ldc; int gelu_from;
    __device__ __forceinline__ void operator()(const f32x4 (&acc)[2][2][4][2], const pg8::Unit& u, int wr, int wc, int fr, int fq) const {
        const int row0 = u.pm * 256 + wr * 64 + fr, col0 = u.pn * 256 + wc * 32 + 8 * fq;
#pragma unroll
        for (int ai = 0; ai < 2; ++ai)
#pragma unroll
            for (int m = 0; m < 4; ++m) { bf16* rowp = O + (size_t)(row0 + ai * 128 + m * 16) * ldc + col0;
#pragma unroll
                for (int bj = 0; bj < 2; ++bj) { f32x4 v0 = acc[ai][bj][m][0], v1 = acc[ai][bj][m][1];
                    if (col0 + bj * 128 >= gelu_from) {
#pragma unroll
                        for (int j = 0; j < 4; ++j) { v0[j] = gelu_tanh(v0[j]); v1[j] = gelu_tanh(v1[j]); } }
                    u32x4 w; w.x = pg8::cvt_pk_bf16(v0[0], v0[1]); w.y = pg8::cvt_pk_bf16(v0[2], v0[3]); w.z = pg8::cvt_pk_bf16(v1[0], v1[1]); w.w = pg8::cvt_pk_bf16(v1[2], v1[3]);
                    *(u32x4*)(rowp + bj * 128) = w; } }
    }
};
struct EpiRes {
    static constexpr bool PERM = true, AFTER_DRAIN = false;
    const float* xlo; const float* xhi; const bf16* xb_in; bf16* xb_out; const float* modl; int goff;
    __device__ __forceinline__ void operator()(const f32x4 (&acc)[2][2][4][2], const pg8::Unit& u, int wr, int wc, int fr, int fq) const {
        const int pm = u.pm; const int midx = pm < 16 ? 0 : 1 + ((pm - 16) >> 4);
        const float* gv = modl + (size_t)midx * MODW + goff;
        const bool f32in = xb_in == nullptr;
        const float* base = pm < 16 ? xlo + (size_t)pm * 256 * D : xhi + (size_t)(pm - 16) * 256 * D;
        const bf16* bbase = xb_in + (size_t)pm * 256 * D;
        bf16* ob = xb_out + (size_t)pm * 256 * D;
        const bool half = u.bh >= 0;
        const int col0 = u.pn * 256 + (u.bh > 0 ? 128 : 0) + wc * 32 + 8 * fq;
        f32x4 gvv[2][2];
#pragma unroll
        for (int bj = 0; bj < 2; ++bj)
#pragma unroll
            for (int n = 0; n < 2; ++n) gvv[bj][n] = (bj == 1 && half) ? (f32x4){0.f, 0.f, 0.f, 0.f} : *(const f32x4*)(gv + col0 + bj * 128 + n * 4);
        const size_t rbase = (size_t)(wr * 64 + fr) * D + col0;
        u32x4 xr[8][2][2];
#define ER_LOAD(g_) do { const size_t off_ = rbase + (size_t)(((g_) >> 2) * 128 + ((g_) & 3) * 16) * D; \
            _Pragma("unroll") for (int bj = 0; bj < 2; ++bj) { if (bj == 1 && half) continue; \
                if (f32in) { xr[g_][bj][0] = *(const u32x4*)(base + off_ + bj * 128); xr[g_][bj][1] = *(const u32x4*)(base + off_ + bj * 128 + 4); } \
                else xr[g_][bj][0] = *(const u32x4*)(bbase + off_ + bj * 128); } } while (0)
        ER_LOAD(0); ER_LOAD(1); ER_LOAD(2);
        asm volatile("" ::: "memory");
#pragma unroll
        for (int g = 0; g < 8; ++g) { const int ai = g >> 2, m = g & 3; const size_t off = rbase + (size_t)(ai * 128 + m * 16) * D;
#pragma unroll
            for (int bj = 0; bj < 2; ++bj) { if (bj == 1 && half) continue;
                const u32x4 r0 = xr[g][bj][0], r1 = xr[g][bj][1];
                const f32x4 xo0 = f32in ? (f32x4){__uint_as_float(r0.x), __uint_as_float(r0.y), __uint_as_float(r0.z), __uint_as_float(r0.w)}
                                        : (f32x4){__uint_as_float(r0.x << 16), __uint_as_float(r0.x & 0xffff0000u), __uint_as_float(r0.y << 16), __uint_as_float(r0.y & 0xffff0000u)};
                const f32x4 xo1 = f32in ? (f32x4){__uint_as_float(r1.x), __uint_as_float(r1.y), __uint_as_float(r1.z), __uint_as_float(r1.w)}
                                        : (f32x4){__uint_as_float(r0.z << 16), __uint_as_float(r0.z & 0xffff0000u), __uint_as_float(r0.w << 16), __uint_as_float(r0.w & 0xffff0000u)};
                const f32x4 xn0 = xo0 + gvv[bj][0] * acc[ai][bj][m][0], xn1 = xo1 + gvv[bj][1] * acc[ai][bj][m][1];
                u32x4 w; w.x = pg8::cvt_pk_bf16(xn0[0], xn0[1]); w.y = pg8::cvt_pk_bf16(xn0[2], xn0[3]); w.z = pg8::cvt_pk_bf16(xn1[0], xn1[1]); w.w = pg8::cvt_pk_bf16(xn1[2], xn1[3]);
                *(u32x4*)(ob + off + bj * 128) = w; }
            asm volatile("" ::: "memory");
            if (g + 3 < 8) { ER_LOAD(g + 3); }
            asm volatile("" ::: "memory"); }
#undef ER_LOAD
    }
};
struct EpiSwi {
    static constexpr bool PERM = true, AFTER_DRAIN = false;
    bf16* O; int ldc;
    __device__ __forceinline__ void operator()(const f32x4 (&acc)[2][2][4][2], const pg8::Unit& u, int wr, int wc, int fr, int fq) const {
        const int row0 = u.pm * 256 + wr * 64 + fr, col0 = u.pn * 128 + wc * 32 + 8 * fq;
#pragma unroll
        for (int ai = 0; ai < 2; ++ai)
#pragma unroll
            for (int m = 0; m < 4; ++m) { bf16* rowp = O + (size_t)(row0 + ai * 128 + m * 16) * ldc + col0;
                float h[8];
#pragma unroll
                for (int n = 0; n < 2; ++n)
#pragma unroll
                    for (int j = 0; j < 4; ++j) { const float gt = acc[ai][0][m][n][j], up = acc[ai][1][m][n][j]; h[n * 4 + j] = gt * fsigmoid(gt) * up; }
                u32x4 w; w.x = pg8::cvt_pk_bf16(h[0], h[1]); w.y = pg8::cvt_pk_bf16(h[2], h[3]); w.z = pg8::cvt_pk_bf16(h[4], h[5]); w.w = pg8::cvt_pk_bf16(h[6], h[7]);
                *(u32x4*)rowp = w; }
    }
};

template <int MAP>
__device__ __forceinline__ void tr_item(const float* W, int K, int N, bf16* WT, LAS float* scr, int item, int lane) {
    const int nblk = (N + 63) >> 6, kb = item / nblk, nb = item - kb * nblk, k0 = 64 * kb, n0 = 64 * nb;
    const int lr = lane >> 4, lc = 4 * (lane & 15); const bool okc = n0 + lc < N;
    f32x4 v[16];
#pragma unroll
    for (int i = 0; i < 16; ++i) v[i] = okc ? __builtin_nontemporal_load((const f32x4*)(W + (size_t)(k0 + 4 * i + lr) * N + n0 + lc)) : (f32x4){0.f, 0.f, 0.f, 0.f};
#pragma unroll
    for (int i = 0; i < 16; ++i) { const int kk = 4 * i + lr; *(LAS f32x4*)(scr + kk * 64 + (lc ^ (8 * (kk >> 3)))) = v[i]; }
    LDS_WAIT(); asm volatile("" ::: "memory");
    const int c = lane & 7;
#pragma unroll
    for (int i = 0; i < 8; ++i) { const int n = (lane >> 3) + 8 * i; const LAS float* sp = scr + (8 * c) * 64 + (n ^ (8 * c));
        u32x4 o; o.x = pk2(sp[0 * 64], sp[1 * 64]); o.y = pk2(sp[2 * 64], sp[3 * 64]); o.z = pk2(sp[4 * 64], sp[5 * 64]); o.w = pk2(sp[6 * 64], sp[7 * 64]);
        const int nn = n0 + n; const int orow = MAP == 0 ? nn : (256 * (nn >> 7) + (nn & 127) + (MAP == 2 ? 128 : 0));
        if (nn < N) *(u32x4*)(WT + (size_t)orow * K + k0 + 8 * c) = o; }
    LDS_WAIT(); asm volatile("" ::: "memory");
}
__device__ __forceinline__ void p0_prologue(Frame& F) {
    PH_LOCALS(F);
    LAS float* scr = (LAS float*)(F.lds + wave * 16384);
    const int gw = bx * NWAVES + wave, NGW = G * NWAVES;
    constexpr int I_IN = (D / 64) * ((PIN + 63) / 64), I_OUT = (D / 64) * (D / 64), I_GU = (D / 64) * (DFF / 64), I_DN = (DFF / 64) * (D / 64);
    constexpr int PL = I_IN + I_OUT + 2 * I_GU + I_DN;
    for (int repc = 0; repc < (PROBE_DUP == 31 ? 4 : 1); ++repc)
    for (int it = gw; it < NL * PL; it += NGW) {
        const int l = it / PL; int r = it % PL;
        if (r < I_IN) { tr_item<0>(F.in[I_WIN] + (size_t)l * D * PIN, D, PIN, (bf16*)(F.ws + WS_WIN + l * SZ_WIN), scr, r, lane); continue; } r -= I_IN;
        if (r < I_OUT) { tr_item<0>(F.in[I_WOUT] + (size_t)l * D * D, D, D, (bf16*)(F.ws + WS_WOUT + l * SZ_WOUT), scr, r, lane); continue; } r -= I_OUT;
        if (r < I_GU) { tr_item<1>(F.in[I_WG] + (size_t)l * D * DFF, D, DFF, (bf16*)(F.ws + WS_WGU + l * SZ_WGU), scr, r, lane); continue; } r -= I_GU;
        if (r < I_GU) { tr_item<2>(F.in[I_WU] + (size_t)l * D * DFF, D, DFF, (bf16*)(F.ws + WS_WGU + l * SZ_WGU), scr, r, lane); continue; } r -= I_GU;
        tr_item<0>(F.in[I_WD] + (size_t)l * DFF * D, DFF, D, (bf16*)(F.ws + WS_WD + l * SZ_WD), scr, r, lane);
    }
    const int gt = bx * 512 + tid, NGT = G * 512;
    { constexpr int PADV = (PINP - PIN) * D * 2 / 16;
      for (int i = gt; i < NL * PADV; i += NGT) { const int l = i / PADV, r = i % PADV; ((u32x4*)(F.ws + WS_WIN + l * SZ_WIN + (size_t)PIN * D * 2))[r] = (u32x4){0u, 0u, 0u, 0u}; } }
    { bf16* w2t = (bf16*)(F.ws + WS_W2T); bf16* a2t = (bf16*)(F.ws + WS_A2T); bf16* g2t = (bf16*)(F.ws + WS_G2T); bf16* wsp = (bf16*)(F.ws + WS_WSP);
      for (int i = gt; i < NL * 2 * 8 * 1024; i += NGT) { const int n = i & 1023, kg = (i >> 10) & 7, ld = i >> 13; float w[8], a[8];
#pragma unroll
          for (int j = 0; j < 8; ++j) { const size_t o = ((size_t)ld * 64 + 8 * kg + j) * 1024 + n; w[j] = F.in[I_W2][o]; a[j] = F.in[I_A2][o]; }
          const size_t fo = ((((size_t)ld * 64 + (n >> 4)) * 2 + (kg >> 2)) * 64 + 16 * (kg & 3) + (n & 15)) * 8;
          *(u32x4*)(w2t + fo) = pack8(w); *(u32x4*)(a2t + fo) = pack8(a); }
      for (int i = gt; i < NL * 20 * 1024; i += NGT) { const int n = i & 1023, kg = (i >> 10) % 20, l = (i >> 10) / 20; float g[8];
#pragma unroll
          for (int j = 0; j < 8; ++j) g[j] = F.in[I_G2][((size_t)l * 160 + 8 * kg + j) * 1024 + n];
          *(u32x4*)(g2t + ((size_t)l * 1024 + n) * 160 + 8 * kg) = pack8(g); }
      for (int i = gt; i < NL * 8 * 128 * 128; i += NGT) wsp[i] = (bf16)f2bf(F.in[I_WSP][i]); }
    __syncthreads();
    { LAS float* sv = (LAS float*)F.lds;
      LAS float* red = (LAS float*)(F.lds + 40960);
      for (int i = tid; i < 5 * D; i += 512) { const int r = i / D, k = i % D; const float c = r == 0 ? F.in[I_CCTX][k] : F.in[I_C][(r - 1) * D + k]; sv[i] = c * fsigmoid(c); }
      __syncthreads();
      float* mod = (float*)(F.ws + WS_MOD);
      const int c4 = tid & 15, kg = tid >> 4;
      for (int repm = 0; repm < (PROBE_DUP == 32 ? 4 : 1); ++repm)
      for (int item = bx; item < NL * (MODW / 64); item += G) {
          const int l = item / (MODW / 64), n0 = (item % (MODW / 64)) * 64;
          const float* W = F.in[I_WMOD] + (size_t)l * D * MODW + n0 + 4 * c4;
          f32x4 a[5];
#pragma unroll
          for (int r = 0; r < 5; ++r) a[r] = (f32x4){0.f, 0.f, 0.f, 0.f};
#pragma unroll 4
          for (int i = 0; i < 64; ++i) { const int k = i * 32 + kg; const f32x4 w = *(const f32x4*)(W + (size_t)k * MODW);
#pragma unroll
              for (int r = 0; r < 5; ++r) a[r] += w * sv[r * D + k]; }
#pragma unroll
          for (int r = 0; r < 5; ++r) *(LAS f32x4*)(red + (kg * 5 + r) * 64 + 4 * c4) = a[r];
          __syncthreads();
          if (tid < 320) { const int r = tid >> 6, n = tid & 63; float s = 0.f;
#pragma unroll 8
              for (int g = 0; g < 32; ++g) s += red[(g * 5 + r) * 64 + n];
              mod[((size_t)l * 5 + r) * MODW + n0 + n] = s + F.in[I_BMOD][(size_t)l * MODW + n0 + n]; }
          __syncthreads();
      } }
}

__device__ __forceinline__ void p_adaln(Frame& F, int l, int which, const float* xlo, const float* xhi, const bf16* xb) {
    PH_LOCALS(F); PH_LAYER(l);
    const int gw = bx * NWAVES + wave, NGW = G * NWAVES;
    const float* ng = (which == 0 ? F.in[I_N1G] : F.in[I_N2G]) + (size_t)l * D;
    const int shoff = which == 0 ? 0 : 3 * D, scoff = shoff + D;
    const float* mod = (const float*)(F.ws + WS_MOD);
    bf16* H = (bf16*)(F.ws + WS_H);
    const int rpw = (M + NGW - 1) / NGW, rbeg = gw * rpw, rend = rbeg + rpw < M ? rbeg + rpw : M;
    f32x4 ca[8], cb[8]; int mcur = -1;
    if (xb == nullptr) {
        f32x4 nx[8];
#define AL_ROWPTR(row_) ((row_) < MCTX ? xlo + (size_t)(row_) * D : xhi + (size_t)((row_) - MCTX) * D)
        if (rbeg < rend) { const float* xr = AL_ROWPTR(rbeg);
#pragma unroll
            for (int j = 0; j < 8; ++j) nx[j] = *(const f32x4*)(xr + 4 * lane + 256 * j); }
        for (int row = rbeg; row < rend; ++row) {
            const int midx = row < MCTX ? 0 : 1 + ((row - MCTX) >> 12);
            if (midx != mcur) { mcur = midx; const float* md = mod + ((size_t)l * 5 + midx) * MODW;
#pragma unroll
                for (int j = 0; j < 8; ++j) { const int c = 4 * lane + 256 * j; ca[j] = *(const f32x4*)(ng + c) * (*(const f32x4*)(md + scoff + c) + 1.0f); cb[j] = *(const f32x4*)(md + shoff + c); } }
            f32x4 v[8]; float ss = 0.f;
#pragma unroll
            for (int j = 0; j < 8; ++j) { v[j] = nx[j]; ss += (v[j].x * v[j].x + v[j].y * v[j].y) + (v[j].z * v[j].z + v[j].w * v[j].w); }
            { const int nr = row + 1 < rend ? row + 1 : row; const float* xr = AL_ROWPTR(nr);
#pragma unroll
              for (int j = 0; j < 8; ++j) nx[j] = *(const f32x4*)(xr + 4 * lane + 256 * j); }
            WAVE_SUM(ss); const float rstd = __builtin_amdgcn_rsqf(ss * (1.0f / D) + RMS_EPS);
#pragma unroll
            for (int j = 0; j < 8; ++j) { const int c = 4 * lane + 256 * j;
                const f32x4 o = v[j] * rstd * ca[j] + cb[j];
                u32x2 w; w.x = pk2(o.x, o.y); w.y = pk2(o.z, o.w);
                *(u32x2*)(H + (size_t)row * D + c) = w; }
        }
#undef AL_ROWPTR
    } else {
        u32x4 nx[4];
        if (rbeg < rend) { const bf16* xr = xb + (size_t)rbeg * D;
#pragma unroll
            for (int j = 0; j < 4; ++j) nx[j] = *(const u32x4*)(xr + 8 * lane + 512 * j); }
        for (int row = rbeg; row < rend; ++row) {
            const int midx = row < MCTX ? 0 : 1 + ((row - MCTX) >> 12);
            if (midx != mcur) { mcur = midx; const float* md = mod + ((size_t)l * 5 + midx) * MODW;
#pragma unroll
                for (int j = 0; j < 8; ++j) { const int c = 8 * lane + 512 * (j >> 1) + 4 * (j & 1); ca[j] = *(const f32x4*)(ng + c) * (*(const f32x4*)(md + scoff + c) + 1.0f); cb[j] = *(const f32x4*)(md + shoff + c); } }
            float v[4][8]; float ss = 0.f;
#pragma unroll
            for (int j = 0; j < 4; ++j) { unpack8(nx[j], v[j]);
#pragma unroll
                for (int e = 0; e < 8; ++e) ss += v[j][e] * v[j][e]; }
            { const int nr = row + 1 < rend ? row + 1 : row; const bf16* xr = xb + (size_t)nr * D;
#pragma unroll
              for (int j = 0; j < 4; ++j) nx[j] = *(const u32x4*)(xr + 8 * lane + 512 * j); }
            WAVE_SUM(ss); const float rstd = __builtin_amdgcn_rsqf(ss * (1.0f / D) + RMS_EPS);
#pragma unroll
            for (int j = 0; j < 4; ++j) { float o[8];
#pragma unroll
                for (int e = 0; e < 4; ++e) { o[e] = v[j][e] * rstd * ca[2 * j][e] + cb[2 * j][e]; o[4 + e] = v[j][4 + e] * rstd * ca[2 * j + 1][e] + cb[2 * j + 1][e]; }
                *(u32x4*)(H + (size_t)row * D + 8 * lane + 512 * j) = pack8(o); }
        }
    }
}

__device__ __forceinline__ void load_shifted8(const bf16* P, const float* mu, int row, int col, float (&o)[8]) {
    float g[8]; unpack8(*(const u32x4*)(P + (size_t)row * PINP + col), g);
    float a[8];
#pragma unroll
    for (int j = 0; j < 8; ++j) a[j] = g[j];
    int nrow[4]; bool has[4]; int nn;
    if (row < MCTX) { const int t = row & 255; nn = 2; nrow[0] = row - 1; has[0] = t > 0; nrow[1] = row + 1; has[1] = t < 255; nrow[2] = row; has[2] = false; nrow[3] = row; has[3] = false; }
    else { const int t = (row - MCTX) & 4095, gc = t & 63, gr = t >> 6; nn = 4;
        nrow[0] = row - 1; has[0] = gc > 0; nrow[1] = row + 1; has[1] = gc < 63; nrow[2] = row - 64; has[2] = gr > 0; nrow[3] = row + 64; has[3] = gr < 63; }
#pragma unroll
    for (int q = 0; q < 4; ++q) {
        if (q < nn) {
            float nb[8];
            if (has[q]) unpack8(*(const u32x4*)(P + (size_t)nrow[q] * PINP + col), nb);
            else {
#pragma unroll
                for (int j = 0; j < 8; ++j) nb[j] = 0.f; }
            const f32x4 m0 = *(const f32x4*)(mu + q * CSH + col), m1 = *(const f32x4*)(mu + q * CSH + col + 4);
#pragma unroll
            for (int j = 0; j < 4; ++j) { a[j] += m0[j] * (nb[j] - g[j]); a[4 + j] += m1[j] * (nb[4 + j] - g[4 + j]); }
        }
    }
#pragma unroll
    for (int j = 0; j < 8; ++j) o[j] = a[j];
}
__device__ __forceinline__ void p_shift(Frame& F, int l) {
    PH_LOCALS(F); PH_LAYER(l);
    const bf16* P = (const bf16*)(F.ws + WS_P); bf16* PS = (bf16*)(F.ws + WS_PS); bf16* LORA = (bf16*)(F.ws + WS_LORA);
    const float* mu = F.in[I_MU] + (size_t)l * 4 * CSH;
    constexpr int CG = CSH / 8;
#define SH_UNPK(q_, v_) do { v_[0] = (f32x2){__uint_as_float((q_).x << 16), __uint_as_float((q_).x & 0xffff0000u)}; v_[1] = (f32x2){__uint_as_float((q_).y << 16), __uint_as_float((q_).y & 0xffff0000u)}; \
        v_[2] = (f32x2){__uint_as_float((q_).z << 16), __uint_as_float((q_).z & 0xffff0000u)}; v_[3] = (f32x2){__uint_as_float((q_).w << 16), __uint_as_float((q_).w & 0xffff0000u)}; } while (0)
#define SH_LDMU(col_, m_, c0_, four_) do { _Pragma("unroll") for (int q = 0; q < 4; ++q) { const f32x4 a_ = *(const f32x4*)(mu + q * CSH + (col_)), b_ = *(const f32x4*)(mu + q * CSH + (col_) + 4); \
            m_[q][0] = (f32x2){a_[0], a_[1]}; m_[q][1] = (f32x2){a_[2], a_[3]}; m_[q][2] = (f32x2){b_[0], b_[1]}; m_[q][3] = (f32x2){b_[2], b_[3]}; } \
        _Pragma("unroll") for (int e = 0; e < 4; ++e) c0_[e] = (f32x2){1.f, 1.f} - ((four_) ? ((m_[0][e] + m_[1][e]) + (m_[2][e] + m_[3][e])) : (m_[0][e] + m_[1][e])); } while (0)
    const u32x4 Z4 = (u32x4){0u, 0u, 0u, 0u};
    for (int u0 = bx; u0 < 256; u0 += G) {
        const int u = G == 256 ? ((u0 & 7) >> 1) * 64 + 32 * (u0 & 1) + (u0 >> 3) : u0;
        const int gr = u & 63, rowb = MCTX + (u >> 6) * 4096 + gr * 64;
        const bf16* pu_ = P + (size_t)rowb * PINP;
        { u32x4 dn[2][4], lf[2][4], rt[2][4], ru[2], rc[2]; f32x2 m[4][4], c0[4], up[4], cur[4];
#define SJ_COL(it_) (8 * ((((3 * wave + ((it_) >> 2)) >> 2) * 64) + lane))
#define SJ_G0(it_) (16 * ((3 * wave + ((it_) >> 2)) & 3) + 4 * ((it_) & 3))
#define SJ_LOAD(it_, b_) do { const int g_ = SJ_G0(it_); const bf16* pr0_ = pu_ + (size_t)g_ * PINP + SJ_COL(it_); \
            _Pragma("unroll") for (int i = 0; i < 4; ++i) { const int gc = g_ + i; const bf16* pr = pr0_ + (size_t)i * PINP; \
                dn[b_][i] = gc < 63 ? *(const u32x4*)(pr + PINP) : Z4; lf[b_][i] = gr > 0 ? *(const u32x4*)(pr - (size_t)64 * PINP) : Z4; rt[b_][i] = gr < 63 ? *(const u32x4*)(pr + (size_t)64 * PINP) : Z4; } \
            if (((it_) & 3) == 0) { ru[b_] = g_ > 0 ? *(const u32x4*)(pr0_ - PINP) : Z4; rc[b_] = *(const u32x4*)pr0_; } } while (0)
          SJ_LOAD(0, 0);
#pragma unroll
          for (int it = 0; it < 12; ++it) { const int b = it & 1, col = SJ_COL(it), g0 = SJ_G0(it);
              if (it + 1 < 12) SJ_LOAD(it + 1, (it + 1) & 1);
              if ((it & 3) == 0) { SH_LDMU(col, m, c0, true); SH_UNPK(ru[b], up); SH_UNPK(rc[b], cur); }
#pragma unroll
              for (int i = 0; i < 4; ++i) { f32x2 a[4], nb[4], dv[4];
#pragma unroll
                  for (int e = 0; e < 4; ++e) a[e] = c0[e] * cur[e] + m[0][e] * up[e];
                  SH_UNPK(lf[b][i], nb);
#pragma unroll
                  for (int e = 0; e < 4; ++e) a[e] += m[2][e] * nb[e];
                  SH_UNPK(rt[b][i], nb);
#pragma unroll
                  for (int e = 0; e < 4; ++e) a[e] += m[3][e] * nb[e];
                  SH_UNPK(dn[b][i], dv);
#pragma unroll
                  for (int e = 0; e < 4; ++e) a[e] += m[1][e] * dv[e];
                  const int row = rowb + g0 + i;
                  *(u32x4*)(PS + (size_t)row * CSH + col) = (u32x4){pk2(a[0].x, a[0].y), pk2(a[1].x, a[1].y), pk2(a[2].x, a[2].y), pk2(a[3].x, a[3].y)};
#pragma unroll
                  for (int e = 0; e < 4; ++e) { up[e] = cur[e]; cur[e] = dv[e]; } } }
#undef SJ_LOAD
#undef SJ_G0
#undef SJ_COL
        }
        if (tid < 504) {
            const int rs = tid / 36, lg = tid - rs * 36, col = 3 * DA + 8 * lg; const int act = lg < LW / 8 ? 1 : (lg >= (LW + LAA) / 8 ? 2 : 0);
            f32x2 m[4][4], c0[4]; SH_LDMU(col, m, c0, true);
            u32x4 q5[5][5];
#define SL_LOAD(k_, b_) do { const int gc_ = rs + 14 * (k_) < 64 ? rs + 14 * (k_) : 63; const bf16* pr = pu_ + (size_t)gc_ * PINP + col; \
            q5[b_][0] = *(const u32x4*)pr; q5[b_][1] = gc_ > 0 ? *(const u32x4*)(pr - PINP) : Z4; q5[b_][2] = gc_ < 63 ? *(const u32x4*)(pr + PINP) : Z4; \
            q5[b_][3] = gr > 0 ? *(const u32x4*)(pr - (size_t)64 * PINP) : Z4; q5[b_][4] = gr < 63 ? *(const u32x4*)(pr + (size_t)64 * PINP) : Z4; } while (0)
            SL_LOAD(0, 0); SL_LOAD(1, 1); SL_LOAD(2, 2); SL_LOAD(3, 3); SL_LOAD(4, 4);
#pragma unroll
            for (int k = 0; k < 5; ++k) { const int gcx = rs + 14 * k, b = k;
                f32x2 a[4], nb[4];
                SH_UNPK(q5[b][0], nb);
#pragma unroll
                for (int e = 0; e < 4; ++e) a[e] = c0[e] * nb[e];
#pragma unroll
                for (int q = 0; q < 4; ++q) { SH_UNPK(q5[b][1 + q], nb);
#pragma unroll
                    for (int e = 0; e < 4; ++e) a[e] += m[q][e] * nb[e]; }
                float o_[8] = {a[0].x, a[0].y, a[1].x, a[1].y, a[2].x, a[2].y, a[3].x, a[3].y};
                if (act == 1) {
#pragma unroll
                    for (int jx = 0; jx < 8; ++jx) o_[jx] = ftanh(o_[jx]); }
                else if (act == 2) {
#pragma unroll
                    for (int jx = 0; jx < 8; ++jx) o_[jx] = fsigmoid(o_[jx]); }
                const int row = rowb + gcx;
                if (gcx < 64) *(u32x4*)(LORA + ((((size_t)(row >> 4) * 9 + (lg >> 2)) * 64 + 16 * (lg & 3) + (row & 15)) << 3)) = pack8(o_); }
#undef SL_LOAD
        }
    }
    if (tid >= CG) return;
    { const int col = tid * 8; const int act = (col >= 3 * DA && col < 3 * DA + LW) ? 1 : (col >= 3 * DA + LW + LAA ? 2 : 0);
      f32x2 m[4][4], c0[4]; SH_LDMU(col, m, c0, false);
      const int rpw = (MCTX + G - 1) / G, rbeg = bx * rpw, rend = rbeg + rpw < MCTX ? rbeg + rpw : MCTX;
      for (int r0 = rbeg; r0 < rend; r0 += 8) {
          u32x4 raw[10];
#pragma unroll
          for (int i = 0; i < 10; ++i) { int r = r0 - 1 + i; r = r < 0 ? 0 : (r > MCTX - 1 ? MCTX - 1 : r); raw[i] = *(const u32x4*)(P + (size_t)r * PINP + col); }
#pragma unroll
          for (int i = 0; i < 8; ++i) { const int row = r0 + i; f32x2 a[4], nb[4];
              SH_UNPK(raw[i + 1], nb);
#pragma unroll
              for (int e = 0; e < 4; ++e) a[e] = c0[e] * nb[e];
              if ((row & 255) != 0) { SH_UNPK(raw[i], nb);
#pragma unroll
                  for (int e = 0; e < 4; ++e) a[e] += m[0][e] * nb[e]; }
              if ((row & 255) != 255) { SH_UNPK(raw[i + 2], nb);
#pragma unroll
                  for (int e = 0; e < 4; ++e) a[e] += m[1][e] * nb[e]; }
              float o_[8] = {a[0].x, a[0].y, a[1].x, a[1].y, a[2].x, a[2].y, a[3].x, a[3].y};
              if (act == 1) {
#pragma unroll
                  for (int jx = 0; jx < 8; ++jx) o_[jx] = ftanh(o_[jx]); }
              else if (act == 2) {
#pragma unroll
                  for (int jx = 0; jx < 8; ++jx) o_[jx] = fsigmoid(o_[jx]); }
              if (row < rend) {
                  if (col >= 3 * DA) { const int cgl = (col - 3 * DA) >> 3; *(u32x4*)(LORA + ((((size_t)(row >> 4) * 9 + (cgl >> 2)) * 64 + 16 * (cgl & 3) + (row & 15)) << 3)) = pack8(o_); }
                  else *(u32x4*)(PS + (size_t)row * CSH + col) = pack8(o_); } }
      } }
#undef SH_UNPK
#undef SH_LDMU
}

#define F4Z ((f32x4){0.f, 0.f, 0.f, 0.f})
__device__ __forceinline__ u32x2 pk4(const f32x4 a) { u32x2 w; w.x = pk2(a[0], a[1]); w.y = pk2(a[2], a[3]); return w; }
#define LBAR() do { asm volatile("s_waitcnt lgkmcnt(0)" ::: "memory"); __builtin_amdgcn_s_barrier(); asm volatile("" ::: "memory"); } while (0)
constexpr int VTS = 136;
typedef short s16x4g __attribute__((ext_vector_type(4)));
__device__ __forceinline__ bf16x8 frag_tr_ld(const LAS bf16* X, int ld, int kbase, int c0, int fr, int fq) {
    const LAS bf16* p = X + (kbase + 8 * fq + (fr >> 2)) * ld + c0 + 4 * (fr & 3);
    const s16x4g lo = __builtin_amdgcn_ds_read_tr16_b64_v4i16((LAS s16x4g*)p);
    const s16x4g hi = __builtin_amdgcn_ds_read_tr16_b64_v4i16((LAS s16x4g*)(p + 4 * ld));
    return (bf16x8){lo[0], lo[1], lo[2], lo[3], hi[0], hi[1], hi[2], hi[3]};
}
__device__ __forceinline__ void p_gmlp(Frame& F, int l, int slot, int nslots) {
    PH_LOCALS(F); PH_LAYER(l); (void)bx; (void)G;
    const bf16* P = (const bf16*)(F.ws + WS_P); bf16* O = (bf16*)(F.ws + WS_O);
    const bf16* wsp = (const bf16*)(F.ws + WS_WSP) + (size_t)l * 8 * 128 * 128;
    LAS bf16* VN = (LAS bf16*)F.lds;
    LAS bf16* ST = (LAS bf16*)(F.lds + 34816);
    const int fr = lane & 15, fq = lane >> 4;
    constexpr int NIT = (M / 128) * NG;
    const int jrow = tid >> 2, q4 = tid & 3;
    u32x4 pvv[4]; f32x4 lgv[8], lbv[8]; bf16x8 bw[4]; float bsp = 0.f; int gcur = -1;
#define GM_ISSUE(item_) do { const bf16* src_ = P + (size_t)(((item_) >> 3) * 128 + jrow) * PINP + CSH + DB + 128 * ((item_) & 7) + 32 * q4; \
        _Pragma("unroll") for (int i_ = 0; i_ < 4; ++i_) pvv[i_] = *(const u32x4*)(src_ + 8 * i_); } while (0)
    if (slot < 0) return;
    LBAR();
    if (slot < NIT) GM_ISSUE(slot);
    for (int item = slot; item < NIT; item += nslots) {
        const int cb = item >> 3, g = item & 7, R0 = cb * 128;
        u32x4 pu[4]; { const bf16* up = P + (size_t)(R0 + jrow) * PINP + CSH + 128 * g + 32 * q4;
#pragma unroll
            for (int i = 0; i < 4; ++i) pu[i] = *(const u32x4*)(up + 8 * i); }
        if (g != gcur) { gcur = g; const bf16* wa = wsp + ((size_t)g * 128 + 16 * wave + fr) * 128 + 8 * fq;
#pragma unroll
            for (int ks = 0; ks < 4; ++ks) bw[ks] = *(const bf16x8*)(wa + 32 * ks);
            bsp = F.in[I_BSP][((size_t)l * 8 + g) * 128 + jrow];
            const float* lg = F.in[I_LNG] + ((size_t)l * 8 + g) * 128 + 32 * q4; const float* lb = F.in[I_LNB] + ((size_t)l * 8 + g) * 128 + 32 * q4;
#pragma unroll
            for (int i = 0; i < 8; ++i) { lgv[i] = *(const f32x4*)(lg + 4 * i); lbv[i] = *(const f32x4*)(lb + 4 * i); } }
        { float v[32];
#pragma unroll
          for (int i = 0; i < 4; ++i) { float f[8]; unpack8(pvv[i], f);
#pragma unroll
              for (int jj = 0; jj < 8; ++jj) v[8 * i + jj] = f[jj]; }
          float s = 0.f;
#pragma unroll
          for (int i = 0; i < 32; ++i) s += v[i];
          s += SHX(s, 1); s += SHX(s, 2);
          const float mean = s * (1.0f / 128.0f); float qq = 0.f;
#pragma unroll
          for (int i = 0; i < 32; ++i) { v[i] -= mean; qq += v[i] * v[i]; }
          qq += SHX(qq, 1); qq += SHX(qq, 2);
          const float rstd = __builtin_amdgcn_rsqf(qq * (1.0f / 128.0f) + LN_EPS);
#pragma unroll
          for (int i = 0; i < 4; ++i) { float o[8]; const f32x4 g0 = lgv[2 * i], g1 = lgv[2 * i + 1], b0 = lbv[2 * i], b1 = lbv[2 * i + 1];
#pragma unroll
              for (int jj = 0; jj < 4; ++jj) { o[jj] = v[8 * i + jj] * rstd * g0[jj] + b0[jj]; o[4 + jj] = v[8 * i + 4 + jj] * rstd * g1[jj] + b1[jj]; }
              *(LAS u32x4*)(VN + jrow * VTS + 32 * q4 + 8 * i) = pack8(o); } }
        if (item + nslots < NIT) GM_ISSUE(item + nslots);
        LBAR();
#pragma unroll
        for (int mt = 0; mt < 8; ++mt) { f32x4 acc = F4Z;
#pragma unroll
            for (int ks = 0; ks < 4; ++ks) acc = __builtin_amdgcn_mfma_f32_16x16x32_bf16(frag_tr_ld(VN, VTS, 32 * ks, 16 * mt, fr, fq), bw[ks], acc, 0, 0, 0);
            *(LAS u32x2*)(ST + (16 * wave + fr) * VTS + 16 * mt + 4 * fq) = pk4(acc); }
        LBAR();
        { bf16* op = O + (size_t)(R0 + jrow) * D + DA + 128 * g + 32 * q4;
#pragma unroll
          for (int i = 0; i < 4; ++i) { float sv[8], uv[8], o[8]; unpack8(*(const LAS u32x4*)(ST + jrow * VTS + 32 * q4 + 8 * i), sv); unpack8(pu[i], uv);
#pragma unroll
              for (int jj = 0; jj < 8; ++jj) o[jj] = uv[jj] * (sv[jj] + bsp);
              *(u32x4*)(op + 8 * i) = pack8(o); } }
    }
    LBAR();
#undef GM_ISSUE
}

constexpr int T16B = 9216, LD16 = 72, LD32 = 68;
#define SLOT(i) ((LAS bf16*)(lds + (i) * T16B))
#define SLOTF(i) ((LAS float*)(lds + (i) * T16B))
template <int NK>
__device__ __forceinline__ f32x4 tile_mm(const LAS bf16* A, int lda, const LAS bf16* B, int ldb, int fr, int fq, f32x4 acc) {
#pragma unroll
    for (int ks = 0; ks < NK; ++ks) { const bf16x8 a = *(const LAS bf16x8*)(A + fr * lda + 8 * fq + 32 * ks); const bf16x8 b = *(const LAS bf16x8*)(B + fr * ldb + 8 * fq + 32 * ks);
        acc = __builtin_amdgcn_mfma_f32_16x16x32_bf16(a, b, acc, 0, 0, 0); }
    return acc;
}
__device__ __forceinline__ void st_nat(LAS bf16* dst, int n0, int m0, int fr, int fq, const f32x4 a) { *(LAS u32x2*)(dst + (n0 + fr) * LD16 + m0 + 4 * fq) = pk4(a); }
__device__ __forceinline__ void st_rm(LAS bf16* dst, int n0, int m0, int fr, int fq, const f32x4 a) {
#pragma unroll
    for (int r = 0; r < 4; ++r) dst[(m0 + 4 * fq + r) * LD16 + n0 + fr] = (bf16)f2bf(a[r]); }
__device__ __forceinline__ f32x4 ld4bf(const LAS bf16* p) { const u32x2 w = *(const LAS u32x2*)p; return (f32x4){__uint_as_float(w.x << 16), __uint_as_float(w.x & 0xffff0000u), __uint_as_float(w.y << 16), __uint_as_float(w.y & 0xffff0000u)}; }

__device__ __forceinline__ int fm_off(int n0, int m0, int fr, int fq) { return ((((n0 >> 4) * 2 + (m0 >> 5)) * 64 + (2 * ((m0 >> 4) & 1) + (fq >> 1)) * 16 + fr) << 3) + 4 * (fq & 1); }
typedef short s16x4 __attribute__((ext_vector_type(4)));
__device__ __forceinline__ bf16x8 frag_tr(const LAS bf16* X, int kbase, int c0, int fr, int fq) {
    const LAS bf16* p = X + (kbase + 8 * fq + (fr >> 2)) * LD16 + c0 + 4 * (fr & 3);
    const s16x4 lo = __builtin_amdgcn_ds_read_tr16_b64_v4i16((LAS s16x4*)p);
    const s16x4 hi = __builtin_amdgcn_ds_read_tr16_b64_v4i16((LAS s16x4*)(p + 4 * LD16));
    return (bf16x8){lo[0], lo[1], lo[2], lo[3], hi[0], hi[1], hi[2], hi[3]};
}
__device__ __forceinline__ bf16x8 frag_rm(const LAS bf16* X, int r0, int ks, int fr, int fq) { return *(const LAS bf16x8*)(X + (r0 + fr) * LD16 + 8 * fq + 32 * ks); }
__device__ __forceinline__ f32x4 mm2(const bf16x8 (&a)[2], const bf16x8 (&b)[2], f32x4 acc) {
    acc = __builtin_amdgcn_mfma_f32_16x16x32_bf16(a[0], b[0], acc, 0, 0, 0); return __builtin_amdgcn_mfma_f32_16x16x32_bf16(a[1], b[1], acc, 0, 0, 0); }
__device__ __forceinline__ bf16x8 as_frag(const u32x4 q) { return __builtin_bit_cast(bf16x8, q); }

__device__ __forceinline__ void p_chunkA(Frame& F, int l, const bool fixh) {
    PH_LOCALS(F); PH_LAYER(l);
    LAS unsigned char* lds = F.lds;
    const int lane0 = lane, lane00 = lane;
#define STG int lane_ = lane0; asm volatile("" : "+v"(lane_)); const int lane = lane_, fr = lane_ & 15, fq = lane_ >> 4, tid = wave * 64 + lane_, mt = wave >> 1, m0 = 16 * mt, np = (wave & 1) * 2; \
    (void)lane; (void)fr; (void)fq; (void)tid; (void)mt; (void)m0; (void)np;
    const bf16* PS = (const bf16*)(F.ws + WS_PS);
    const bf16* w2t = (const bf16*)(F.ws + WS_W2T) + (size_t)l * 2 * 1024 * 64;
    const bf16* a2t = (const bf16*)(F.ws + WS_A2T) + (size_t)l * 2 * 1024 * 64;
    const bf16* g2t = (const bf16*)(F.ws + WS_G2T) + (size_t)l * 1024 * 160;
    bf16* GATE = (bf16*)(F.ws + WS_GATE); float* BONUS = (float*)(F.ws + WS_BONUS);
    LAS float* gC = (LAS float*)(lds + 14 * T16B);
    LAS float* BT = (LAS float*)(lds + 14 * T16B + 256);
    u32x4 pf_w[2], pf_a[2], pf_g[5], pf_r, pf_k, pf_v; bf16x8 Bg[2][5], Bw[2][2], Ba[2][2]; float biw[2], bia[2];
#define CA_ISSUE(item_, d_) do { const int ci_ = (item_) >> 4, h_ = (item_) & 15, R0_ = ci_ * 64; int lane0 = lane00; asm volatile("" : "+v"(lane0)); \
        const bf16* arow_ = (const bf16*)(F.ws + WS_LORA) + ((((size_t)(R0_ >> 4) + (wave >> 1)) * 9 * 64 + lane0) << 3); \
        if ((d_) == 0) { pf_w[0] = *(const u32x4*)arow_; pf_w[1] = *(const u32x4*)(arow_ + 512); pf_a[0] = *(const u32x4*)(arow_ + 1024); pf_a[1] = *(const u32x4*)(arow_ + 1536);     \
            _Pragma("unroll") for (int ks_ = 0; ks_ < 5; ++ks_) { pf_g[ks_] = *(const u32x4*)(arow_ + 2048 + 512 * ks_); \
            if (!fixh) { _Pragma("unroll") for (int nn_ = 0; nn_ < 2; ++nn_) Bg[nn_][ks_] = *(const bf16x8*)(g2t + (size_t)(64 * h_ + 16 * ((wave & 1) * 2 + nn_) + (lane0 & 15)) * 160 + 8 * (lane0 >> 4) + 32 * ks_); } } } \
        _Pragma("unroll") for (int nn_ = 0; nn_ < 2; ++nn_) { const int n_ = 64 * h_ + 16 * ((wave & 1) * 2 + nn_) + (lane0 & 15); \
            if (!fixh) { biw[nn_] = F.in[I_W0][((size_t)l * 2 + (d_)) * DA + n_]; bia[nn_] = F.in[I_A0][((size_t)l * 2 + (d_)) * DA + n_]; } \
            _Pragma("unroll") for (int ks_ = 0; ks_ < 2; ++ks_) { const size_t fo_ = ((((size_t)(d_) * 64 + (n_ >> 4)) * 2 + ks_) * 64 + lane0) * 8; Bw[nn_][ks_] = *(const bf16x8*)(w2t + fo_); Ba[nn_][ks_] = *(const bf16x8*)(a2t + fo_); } } \
        const int tid_ = wave * 64 + lane0, tau_ = tid_ >> 3, pos_ = (d_) ? 63 - tau_ : tau_; const bf16* rrow_ = PS + (size_t)(R0_ + pos_) * CSH + 64 * h_ + (tid_ & 7) * 8; \
        pf_r = *(const u32x4*)rrow_; pf_k = *(const u32x4*)(rrow_ + DA); pf_v = *(const u32x4*)(rrow_ + 2 * DA); } while (0)
    float biw2[2][2], bia2[2][2];
    if (fixh) { int lane0 = lane00; asm volatile("" : "+v"(lane0));
#pragma unroll
        for (int dd_ = 0; dd_ < 2; ++dd_)
#pragma unroll
            for (int nn_ = 0; nn_ < 2; ++nn_) { const int n_ = 64 * (bx & 15) + 16 * ((wave & 1) * 2 + nn_) + (lane0 & 15); biw2[dd_][nn_] = F.in[I_W0][((size_t)l * 2 + dd_) * DA + n_]; bia2[dd_][nn_] = F.in[I_A0][((size_t)l * 2 + dd_) * DA + n_]; }
#pragma unroll
        for (int ks_ = 0; ks_ < 5; ++ks_)
#pragma unroll
            for (int nn_ = 0; nn_ < 2; ++nn_) Bg[nn_][ks_] = *(const bf16x8*)(g2t + (size_t)(64 * (bx & 15) + 16 * ((wave & 1) * 2 + nn_) + (lane0 & 15)) * 160 + 8 * (lane0 >> 4) + 32 * ks_); }
    if (bx < (M / 64) * NH) CA_ISSUE(bx, 0);
    int hcur = -1;
    LAS float* HC = (LAS float*)(lds + 14 * T16B + 1280);
    for (int item = bx; item < (M / 64) * NH; item += G) {
        const int ci = item >> 4, h = item & 15, R0 = ci * 64;
        { (void)hcur;
            LBAR();
            { const int t_ = wave * 64 + lane0; if (t_ < 192) { const int w_ = t_ >> 6, c_ = t_ & 63; HC[t_] = (w_ == 0 ? F.in[I_KK] : (w_ == 1 ? F.in[I_KA] : F.in[I_RK]))[(size_t)l * DA + 64 * h + c_]; } } }
#pragma unroll
        for (int d = 0; d < 2; ++d) {
            const size_t qi = ((size_t)ci * 16 + h) * 2 + d;
            const bf16x8 cBw[2][2] = {{Bw[0][0], Bw[0][1]}, {Bw[1][0], Bw[1][1]}}, cBa[2][2] = {{Ba[0][0], Ba[0][1]}, {Ba[1][0], Ba[1][1]}}; const float cbw[2] = {fixh ? biw2[d][0] : biw[0], fixh ? biw2[d][1] : biw[1]}, cba[2] = {fixh ? bia2[d][0] : bia[0], fixh ? bia2[d][1] : bia[1]};
            u32x4 cw[2] = {pf_w[0], pf_w[1]}, ca[2] = {pf_a[0], pf_a[1]}, cg[5] = {pf_g[0], pf_g[1], pf_g[2], pf_g[3], pf_g[4]}; const u32x4 cr = pf_r, ck = pf_k, cv = pf_v;
            for (int repA = 0; repA < (PROBE_SUB == 1 ? 2 : 1); ++repA) {
            { STG; LAS float* AL = SLOTF(5); LAS float* LW = SLOTF(7);
              bf16x8 aw[2], aa[2];
#pragma unroll
              for (int ks = 0; ks < 2; ++ks) { aw[ks] = as_frag(cw[ks]); aa[ks] = as_frag(ca[ks]); }
#pragma unroll
              for (int nn = 0; nn < 2; ++nn) { const int nl = 16 * (np + nn) + fr, n = 64 * h + nl;
                  const f32x4 accw = mm2(aw, cBw[nn], F4Z), acca = mm2(aa, cBa[nn], F4Z);
                  const float biasw = cbw[nn], biasa = cba[nn]; (void)n;
                  float lw[4], c[4];
#pragma unroll
                  for (int r = 0; r < 4; ++r) lw[r] = -0.8750345269f * fsigmoid(biasw + accw[r]);
                  if (d == 0) { c[0] = lw[0]; c[1] = c[0] + lw[1]; c[2] = c[1] + lw[2]; c[3] = c[2] + lw[3]; }
                  else { c[3] = lw[3]; c[2] = c[3] + lw[2]; c[1] = c[2] + lw[1]; c[0] = c[1] + lw[0]; }
                  const float tot = d == 0 ? c[3] : c[0];
                  const float t1 = SHX(tot, 16), t2 = SHX(tot, 32), t3 = SHX(tot, 48);
                  float off;
                  { const int sg = d ? -1 : 1, q1 = fq ^ 1, q2 = fq ^ 2, q3 = fq ^ 3;
                    const int k1 = (sg * (q1 - fq)) >> 31, k2 = (sg * (q2 - fq)) >> 31, k3 = (sg * (q3 - fq)) >> 31;
                    off = (__int_as_float(__float_as_int(t1) & k1) + __int_as_float(__float_as_int(t2) & k2)) + __int_as_float(__float_as_int(t3) & k3); }
#pragma unroll
                  for (int r = 0; r < 4; ++r) { const int pos = m0 + 4 * fq + r, tau = d ? 63 - pos : pos;
                      LW[tau * LD32 + nl] = c[r] + off; AL[tau * LD32 + nl] = fsigmoid(biasa + acca[r]); }
                  if (fq == 0) BT[(d ? 3 - mt : mt) * 64 + nl] = (tot + t1) + (t2 + t3); }
              if (d == 0) {
                  bf16x8 ag[5];
#pragma unroll
                  for (int ks = 0; ks < 5; ++ks) ag[ks] = as_frag(cg[ks]);
#pragma unroll
                  for (int nn = 0; nn < 2; ++nn) { const int n = 64 * h + 16 * (np + nn) + fr; f32x4 acc = F4Z;
#pragma unroll
                      for (int ks = 0; ks < 5; ++ks) acc = __builtin_amdgcn_mfma_f32_16x16x32_bf16(ag[ks], Bg[nn][ks], acc, 0, 0, 0);
#pragma unroll
                      for (int r = 0; r < 4; ++r) SLOT(11)[(m0 + 4 * fq + r) * LD16 + 16 * (np + nn) + fr] = (bf16)f2bf(acc[r]); (void)n; } } }
            LBAR();
            { STG; const LAS float* AL = SLOTF(5); const LAS float* LW = SLOTF(7);
              const int tau = tid >> 3, c8 = (tid & 7) * 8, pos = d ? 63 - tau : tau, row = R0 + pos, blk = wave >> 1;
              f32x2 r[4], k[4];
              { const u32x4 q = cr; r[0] = (f32x2){__uint_as_float(q.x << 16), __uint_as_float(q.x & 0xffff0000u)}; r[1] = (f32x2){__uint_as_float(q.y << 16), __uint_as_float(q.y & 0xffff0000u)};
                r[2] = (f32x2){__uint_as_float(q.z << 16), __uint_as_float(q.z & 0xffff0000u)}; r[3] = (f32x2){__uint_as_float(q.w << 16), __uint_as_float(q.w & 0xffff0000u)}; }
              { const u32x4 q = ck; k[0] = (f32x2){__uint_as_float(q.x << 16), __uint_as_float(q.x & 0xffff0000u)}; k[1] = (f32x2){__uint_as_float(q.y << 16), __uint_as_float(q.y & 0xffff0000u)};
                k[2] = (f32x2){__uint_as_float(q.z << 16), __uint_as_float(q.z & 0xffff0000u)}; k[3] = (f32x2){__uint_as_float(q.w << 16), __uint_as_float(q.w & 0xffff0000u)}; }
              f32x2 offb[4], totC[4];
#pragma unroll
              for (int j = 0; j < 4; ++j) { offb[j] = (f32x2){0.f, 0.f}; totC[j] = (f32x2){0.f, 0.f}; }
#pragma unroll
              for (int b = 0; b < 4; ++b) { const f32x4 x0 = *(const LAS f32x4*)(BT + b * 64 + c8), x1 = *(const LAS f32x4*)(BT + b * 64 + c8 + 4);
                  const f32x2 y[4] = {{x0[0], x0[1]}, {x0[2], x0[3]}, {x1[0], x1[1]}, {x1[2], x1[3]}};
                  const float fb = b < blk ? 1.0f : 0.0f;
#pragma unroll
                  for (int j = 0; j < 4; ++j) { totC[j] += y[j]; offb[j] += y[j] * fb; } }
              f32x2 ckk[4], cka[4], crk[4];
              { const f32x4 a0 = *(const LAS f32x4*)(HC + c8), a1 = *(const LAS f32x4*)(HC + c8 + 4), b0 = *(const LAS f32x4*)(HC + 64 + c8), b1 = *(const LAS f32x4*)(HC + 64 + c8 + 4), c0 = *(const LAS f32x4*)(HC + 128 + c8), c1 = *(const LAS f32x4*)(HC + 128 + c8 + 4);
                ckk[0] = (f32x2){a0[0], a0[1]}; ckk[1] = (f32x2){a0[2], a0[3]}; ckk[2] = (f32x2){a1[0], a1[1]}; ckk[3] = (f32x2){a1[2], a1[3]};
                cka[0] = (f32x2){b0[0], b0[1]}; cka[1] = (f32x2){b0[2], b0[3]}; cka[2] = (f32x2){b1[0], b1[1]}; cka[3] = (f32x2){b1[2], b1[3]};
                crk[0] = (f32x2){c0[0], c0[1]}; crk[1] = (f32x2){c0[2], c0[3]}; crk[2] = (f32x2){c1[0], c1[1]}; crk[3] = (f32x2){c1[2], c1[3]}; }
              f32x2 kk[4], s2 = (f32x2){0.f, 0.f};
#pragma unroll
              for (int j = 0; j < 4; ++j) { kk[j] = k[j] * ckk[j]; s2 += kk[j] * kk[j]; }
              float ss = s2.x + s2.y;
              ss += SHX(ss, 1); ss += SHX(ss, 2); ss += SHX(ss, 4);
              const float rn = __builtin_amdgcn_rsqf(fmaxf(ss, 1e-24f));
              f32x2 alv[4], csv[4], csm[4];
              { const f32x4 a0 = *(const LAS f32x4*)(AL + tau * LD32 + c8), a1 = *(const LAS f32x4*)(AL + tau * LD32 + c8 + 4), c0 = *(const LAS f32x4*)(LW + tau * LD32 + c8), c1 = *(const LAS f32x4*)(LW + tau * LD32 + c8 + 4);
                const int tm = (tau & 15) ? tau - 1 : tau; f32x4 e0 = *(const LAS f32x4*)(LW + tm * LD32 + c8), e1 = *(const LAS f32x4*)(LW + tm * LD32 + c8 + 4);
                if ((tau & 15) == 0) { e0 = F4Z; e1 = F4Z; }
                alv[0] = (f32x2){a0[0], a0[1]}; alv[1] = (f32x2){a0[2], a0[3]}; alv[2] = (f32x2){a1[0], a1[1]}; alv[3] = (f32x2){a1[2], a1[3]};
                csv[0] = (f32x2){c0[0], c0[1]} + offb[0]; csv[1] = (f32x2){c0[2], c0[3]} + offb[1]; csv[2] = (f32x2){c1[0], c1[1]} + offb[2]; csv[3] = (f32x2){c1[2], c1[3]} + offb[3];
                csm[0] = (f32x2){e0[0], e0[1]} + offb[0]; csm[1] = (f32x2){e0[2], e0[3]} + offb[1]; csm[2] = (f32x2){e1[0], e1[1]} + offb[2]; csm[3] = (f32x2){e1[2], e1[3]} + offb[3]; }
              f32x2 at[4], rt[4], bt[4], kt[4], bh[4], kh[4], bon2 = (f32x2){0.f, 0.f};
#pragma unroll
              for (int j = 0; j < 4; ++j) { const f32x2 al = alv[j], cs = csv[j], dh = totC[j] - cs;
                  const f32x2 kkn = kk[j] * rn, kd = k[j] * ((al - 1.0f) * cka[j] + 1.0f), bb = kkn * al;
                  bon2 += r[j] * kd * crk[j];
                  const f32x2 encs = (f32x2){__builtin_amdgcn_exp2f(-cs.x), __builtin_amdgcn_exp2f(-cs.y)}, eh = (f32x2){__builtin_amdgcn_exp2f(dh.x), __builtin_amdgcn_exp2f(dh.y)};
                  const f32x2 ecm = (f32x2){__builtin_amdgcn_exp2f(csm[j].x), __builtin_amdgcn_exp2f(csm[j].y)}, ecs = (f32x2){__builtin_amdgcn_exp2f(cs.x), __builtin_amdgcn_exp2f(cs.y)};
                  at[j] = -(ecm * kkn); rt[j] = ecs * r[j]; bt[j] = encs * bb; kt[j] = encs * kd; bh[j] = eh * bb; kh[j] = eh * kd; }
              if (tau == 63) {
#pragma unroll
                  for (int j = 0; j < 4; ++j) { gC[c8 + 2 * j] = __builtin_amdgcn_exp2f(totC[j].x); gC[c8 + 2 * j + 1] = __builtin_amdgcn_exp2f(totC[j].y); } }
#define PK8V(a) ((u32x4){pk2(a[0].x, a[0].y), pk2(a[1].x, a[1].y), pk2(a[2].x, a[2].y), pk2(a[3].x, a[3].y)})
              *(LAS u32x4*)(SLOT(0) + tau * LD16 + c8) = PK8V(at); *(LAS u32x4*)(SLOT(1) + tau * LD16 + c8) = PK8V(rt);
              *(LAS u32x4*)(SLOT(2) + tau * LD16 + c8) = PK8V(bt); *(LAS u32x4*)(SLOT(3) + tau * LD16 + c8) = PK8V(kt);
              *(LAS u32x4*)(SLOT(4) + tau * LD16 + c8) = PK8V(bh); *(LAS u32x4*)(SLOT(9) + tau * LD16 + c8) = PK8V(kh);
#undef PK8V
              *(LAS u32x4*)(SLOT(10) + tau * LD16 + c8) = cv;
              if (d == 0) *(u32x4*)(GATE + (size_t)row * DA + 64 * h + c8) = *(const LAS u32x4*)(SLOT(11) + pos * LD16 + c8);
              float bon = bon2.x + bon2.y;
              bon += SHX(bon, 1); bon += SHX(bon, 2); bon += SHX(bon, 4);
              BONUS[((size_t)d * M + row) * NH + h] = bon; }
            LBAR();
            }
            { int nitem = d == 0 ? item : item + G; const int nd = d ^ 1; if (nitem >= (M / 64) * NH) nitem = item; CA_ISSUE(nitem, nd); }
            for (int repB = 0; repB < (PROBE_SUB == 2 ? 2 : 1); ++repB) {
            { STG; bf16x8 aB[2], aA[2], aK[2];
              const bool needU = np + 1 >= mt, needL = np <= mt;
#pragma unroll
              for (int ks = 0; ks < 2; ++ks) { if (needU) { aB[ks] = frag_rm(SLOT(2), m0, ks, fr, fq); aK[ks] = frag_rm(SLOT(3), m0, ks, fr, fq); } if (needL) aA[ks] = frag_rm(SLOT(0), m0, ks, fr, fq); }
#pragma unroll
              for (int nn = 0; nn < 2; ++nn) { const int nt = np + nn, n0 = 16 * nt, n = n0 + fr;
                  f32x4 p0 = F4Z, p1 = F4Z, p2 = F4Z, p3 = F4Z, p4 = F4Z, t0;
                  if (nt >= mt) { bf16x8 bA[2], bR[2];
#pragma unroll
                      for (int ks = 0; ks < 2; ++ks) { bA[ks] = frag_rm(SLOT(0), n0, ks, fr, fq); bR[ks] = frag_rm(SLOT(1), n0, ks, fr, fq); }
                      p0 = mm2(aB, bA, F4Z); p3 = mm2(aB, bR, F4Z); p4 = mm2(aK, bR, F4Z); }
                  if (nt <= mt) { bf16x8 bB[2], bK[2];
#pragma unroll
                      for (int ks = 0; ks < 2; ++ks) { bB[ks] = frag_rm(SLOT(2), n0, ks, fr, fq); bK[ks] = frag_rm(SLOT(3), n0, ks, fr, fq); }
                      p1 = mm2(aA, bB, F4Z); p2 = mm2(aA, bK, F4Z); }
                  t0 = p1;
                  if (nt == mt) {
#pragma unroll
                      for (int r = 0; r < 4; ++r) { const int m = m0 + 4 * fq + r;
                          p0[r] = m < n ? p0[r] : 0.f; p1[r] = n < m ? p1[r] : 0.f; p2[r] = n < m ? p2[r] : 0.f; p3[r] = m <= n ? p3[r] : 0.f; p4[r] = m <= n ? p4[r] : 0.f;
                          t0[r] = p1[r] + (m == n ? 1.0f : 0.f); } }
                  st_nat(SLOT(5), n0, m0, fr, fq, p0); st_nat(SLOT(6), n0, m0, fr, fq, p1); st_nat(SLOT(7), n0, m0, fr, fq, t0);
                  st_nat(SLOT(8), n0, m0, fr, fq, p2); st_nat(SLOT(11), n0, m0, fr, fq, p3); st_nat(SLOT(12), n0, m0, fr, fq, p4); } }
            LBAR();
#define MM1(a, b, c) __builtin_amdgcn_mfma_f32_16x16x32_bf16(a, b, c, 0, 0, 0)
            { STG; const int b = wave >> 2, bm0 = 32 * b + 16 * ((wave >> 1) & 1), bn0 = 32 * b + 16 * (wave & 1), oc = 32 * (1 - b) - 32 * b;
              const bf16x8 aT = frag_rm(SLOT(5), bm0, b, fr, fq), aR = frag_rm(SLOT(6), bm0, b, fr, fq), bR = frag_rm(SLOT(6), bn0, b, fr, fq), bT = frag_rm(SLOT(5), bn0, b, fr, fq);
              st_nat(SLOT(2), bn0, bm0, fr, fq, MM1(aT, bR, F4Z)); st_nat(SLOT(2), bn0, bm0 + oc, fr, fq, MM1(aR, bT, F4Z)); }
            LBAR();
#pragma unroll
            for (int kq = 1; kq <= 4; ++kq) {
                STG; const int b = wave >> 2, bm0 = 32 * b + 16 * ((wave >> 1) & 1), bn0 = 32 * b + 16 * (wave & 1), oc = 32 * (1 - b) - 32 * b;
                const int pin = (kq & 1) ? 2 : 3, pout = (kq & 1) ? 3 : 2, tin = (kq & 1) ? 7 : 13, tout = (kq & 1) ? 13 : 7;
                const bf16x8 aPT = frag_rm(SLOT(pin), bm0, 1 - b, fr, fq), bTn = frag_rm(SLOT(tin), bn0, b, fr, fq);
                st_nat(SLOT(tout), bn0, bm0, fr, fq, MM1(aPT, bTn, ld4bf(SLOT(tin) + (bn0 + fr) * LD16 + bm0 + 4 * fq)));
                if (kq < 4) { const bf16x8 aPR = frag_rm(SLOT(pin), bm0, b, fr, fq), bPR = frag_rm(SLOT(pin), bn0, b, fr, fq), bPT = frag_rm(SLOT(pin), bn0, 1 - b, fr, fq);
                    st_nat(SLOT(pout), bn0, bm0, fr, fq, MM1(aPT, bPR, F4Z));
                    st_nat(SLOT(pout), bn0, bm0 + oc, fr, fq, MM1(aPR, bPT, F4Z)); }
                LBAR();
            }
            { STG; if (wave < 4) { const int xm0 = 16 * ((wave >> 1) & 1), xn0 = 32 + 16 * (wave & 1);
                  const bf16x8 a = frag_rm(SLOT(6), xm0, 1, fr, fq), bb = frag_tr(SLOT(7), 32, xn0, fr, fq);
                  st_nat(SLOT(13), xn0, xm0, fr, fq, MM1(a, bb, F4Z)); } }
            LBAR();
            { STG; if (wave < 4) { const int tn0 = 32 + 16 * ((wave >> 1) & 1), tm0 = 16 * (wave & 1);
                  const bf16x8 a = frag_rm(SLOT(13), tn0, 0, fr, fq), bb = frag_rm(SLOT(7), tm0, 0, fr, fq);
                  st_nat(SLOT(7), tm0, tn0, fr, fq, MM1(a, bb, F4Z)); } }
            LBAR();
#undef MM1
            { STG; const int xt = wave, n0 = 16 * (xt & 3); bf16x8 b[2];
              if (xt < 4) { b[0] = frag_rm(SLOT(11), n0, 0, fr, fq); b[1] = frag_rm(SLOT(11), n0, 1, fr, fq); }
              else { b[0] = frag_tr(SLOT(4), 0, n0, fr, fq); b[1] = frag_tr(SLOT(4), 32, n0, fr, fq); }
#pragma unroll
              for (int mm = 0; mm < 4; ++mm) { bf16x8 a[2] = {frag_rm(SLOT(7), 16 * mm, 0, fr, fq), frag_rm(SLOT(7), 16 * mm, 1, fr, fq)};
                  st_nat(xt < 4 ? SLOT(5) : SLOT(6), n0, 16 * mm, fr, fq, mm2(a, b, F4Z)); } }
            LBAR();
            }
            for (int repC = 0; repC < (PROBE_SUB == 3 ? 2 : 1); ++repC) {
            { STG; bf16x8 aAt[2] = {frag_tr(SLOT(0), 0, m0, fr, fq), frag_tr(SLOT(0), 32, m0, fr, fq)}, aAk[2] = {frag_rm(SLOT(8), m0, 0, fr, fq), frag_rm(SLOT(8), m0, 1, fr, fq)};
              bf16* pyt = (bf16*)(F.ws + WS_PYT) + qi * 4096; bf16* qyt = (bf16*)(F.ws + WS_QYT) + qi * 4096; bf16* pst = (bf16*)(F.ws + WS_PST) + qi * 4096;
#pragma unroll
              for (int nn = 0; nn < 2; ++nn) { const int n0 = 16 * (np + nn), n = n0 + fr, mb = m0 + 4 * fq;
                  bf16x8 bRb[2] = {frag_rm(SLOT(5), n0, 0, fr, fq), frag_rm(SLOT(5), n0, 1, fr, fq)}, bBh[2] = {frag_rm(SLOT(6), n0, 0, fr, fq), frag_rm(SLOT(6), n0, 1, fr, fq)};
                  const f32x4 py = mm2(aAt, bRb, ld4bf(SLOT(1) + n * LD16 + mb)), qy = mm2(aAk, bRb, ld4bf(SLOT(12) + n * LD16 + mb));
                  f32x4 psi, qsi;
#pragma unroll
                  for (int r = 0; r < 4; ++r) { psi[r] = (mb + r == n) ? gC[n] : 0.f; qsi[r] = bf2f(SLOT(9)[(mb + r) * LD16 + n]); }
                  const f32x4 ps = mm2(aAt, bBh, psi), qs = mm2(aAk, bBh, qsi);
                  { const int fo = fm_off(n0, m0, fr, fq); *(u32x2*)(pyt + fo) = pk4(py); *(u32x2*)(qyt + fo) = pk4(qy); *(u32x2*)(pst + fo) = pk4(ps); }
                  st_nat(SLOT(2), n0, m0, fr, fq, qs); } }
            LBAR();
            { STG; bf16* nct = (bf16*)(F.ws + WS_NCT) + qi * 4096;
              bf16x8 a[2] = {frag_rm(SLOT(2), m0, 0, fr, fq), frag_rm(SLOT(2), m0, 1, fr, fq)};
#pragma unroll
              for (int nn = 0; nn < 2; ++nn) { const int n0 = 16 * (np + nn); bf16x8 b[2] = {frag_tr(SLOT(10), 0, n0, fr, fq), frag_tr(SLOT(10), 32, n0, fr, fq)};
                  *(u32x2*)(nct + ((((n0 >> 4) * 4 + mt) * 64 + lane) << 2)) = pk4(mm2(a, b, F4Z));
                  } }
            LBAR();
            }
        }
    }
#undef STG
#undef CA_ISSUE
}

__device__ __forceinline__ void p_chunkB(Frame& F, int l) {
    PH_LOCALS(F); PH_LAYER(l);
    const int fr = lane & 15, fq = lane >> 4;
    LAS bf16* Sl = (LAS bf16*)(F.lds + wave * 2304);
    const bf16* PST = (const bf16*)(F.ws + WS_PST); const bf16* NCT = (const bf16*)(F.ws + WS_NCT); bf16* SC = (bf16*)(F.ws + WS_SC);
    for (int cp = bx; cp < 64; cp += G) {
        const int cslot = wave >> 2, chain = 2 * cp + cslot, vb = wave & 3, b = chain >> 5, h = (chain >> 1) & 15, d = chain & 1, cb = 64 + b * 64; constexpr int NC = 64;
        LAS bf16* AL = (LAS bf16*)(F.lds + 20480) + cslot * 3 * 4096;
        f32x4 S[4];
        { const float* src = F.in[I_STATE] + ((((size_t)b * NL + l) * 2 + d) * NH + h) * 4096 + (size_t)(16 * vb + fr) * 64 + 4 * fq;
#pragma unroll
          for (int T = 0; T < 4; ++T) S[T] = *(const f32x4*)(src + 16 * T); }
        bf16x8 Aq[8][2]; u32x2 Nq[8][4];
#define LB_QI(step) ((((size_t)(cb + (d ? NC - 1 - (step) : (step)))) * 16 + h) * 2 + d)
#define LB_LDA(u, step) do { const int st_ = (step) < NC ? (step) : NC - 1; const bf16* ps_ = PST + LB_QI(st_) * 4096 + vb * 1024 + lane * 8; Aq[u][0] = *(const bf16x8*)ps_; Aq[u][1] = *(const bf16x8*)(ps_ + 512); } while (0)
#define LB_LDN(u, step) do { const int st_ = (step) < NC ? (step) : NC - 1; const bf16* nc_ = NCT + LB_QI(st_) * 4096 + ((vb * 4 * 64 + lane) << 2); \
        _Pragma("unroll") for (int mt_ = 0; mt_ < 4; ++mt_) Nq[u][mt_] = *(const u32x2*)(nc_ + mt_ * 256); } while (0)
#pragma unroll
        for (int u = 0; u < 8; ++u) { LB_LDA(u, u); LB_LDN(u, u); }
        *(LAS bf16x8*)(AL + ((vb * 2 + 0) * 64 + lane) * 8) = Aq[0][0]; *(LAS bf16x8*)(AL + ((vb * 2 + 1) * 64 + lane) * 8) = Aq[0][1];
        LB_LDA(0, 8);
        for (int g = 0; g < NC; g += 8) {
#pragma unroll
            for (int u = 0; u < 8; ++u) {
                const int step = g + u; const size_t q = LB_QI(step); bf16* scg = SC + q * 4096;
#pragma unroll
                for (int T = 0; T < 4; ++T) { const u32x2 w = pk4(S[T]); *(LAS u32x2*)(Sl + fr * LD16 + 16 * T + 4 * fq) = w; *(u32x2*)(scg + fm_off(16 * vb, 16 * T, fr, fq)) = w; }
                { LAS bf16* nb_ = AL + ((step + 1) % 3) * 4096; const int u1 = (u + 1) & 7;
                  *(LAS bf16x8*)(nb_ + ((vb * 2 + 0) * 64 + lane) * 8) = Aq[u1][0]; *(LAS bf16x8*)(nb_ + ((vb * 2 + 1) * 64 + lane) * 8) = Aq[u1][1];
                  LB_LDA(u1, step + 9); }
                LBAR();
                const LAS bf16* cbuf = AL + (step % 3) * 4096 + lane * 8;
                const bf16x8 b0 = *(const LAS bf16x8*)(Sl + fr * LD16 + 8 * fq), b1 = *(const LAS bf16x8*)(Sl + fr * LD16 + 8 * fq + 32);
#pragma unroll
                for (int mt = 0; mt < 4; ++mt) { const u32x2 nw = Nq[u][mt];
                    f32x4 acc = (f32x4){__uint_as_float(nw.x << 16), __uint_as_float(nw.x & 0xffff0000u), __uint_as_float(nw.y << 16), __uint_as_float(nw.y & 0xffff0000u)};
                    acc = __builtin_amdgcn_mfma_f32_16x16x32_bf16(*(const LAS bf16x8*)(cbuf + (mt * 2) * 512), b0, acc, 0, 0, 0);
                    acc = __builtin_amdgcn_mfma_f32_16x16x32_bf16(*(const LAS bf16x8*)(cbuf + (mt * 2 + 1) * 512), b1, acc, 0, 0, 0);
                    S[mt] = acc; }
                LB_LDN(u, step + 8);
            }
        }
#undef LB_LDA
#undef LB_LDN
#undef LB_QI
        LBAR();
    }
    const int w0 = (G > 64) ? (bx - 64) * NWAVES + wave : bx * NWAVES + wave, wst = (G > 64) ? (G - 64) * NWAVES : G * NWAVES;
    if (G > 64 && bx < 64) return;
    for (int t = w0; t < 2048; t += wst) {
        const int chain = t >> 2, vb = t & 3, b = chain >> 5, h = (chain >> 1) & 15, d = chain & 1, cb = b * 4; constexpr int NC = 4;
        f32x4 S[4];
#pragma unroll
        for (int T = 0; T < 4; ++T) S[T] = (f32x4){0.f, 0.f, 0.f, 0.f};
        bf16x8 Apf[4][8]; u32x2 Npf[4][4];
#define CB_QI(step) ((((size_t)(cb + (d ? NC - 1 - (step) : (step)))) * 16 + h) * 2 + d)
#define CB_LOAD(u, step) do { const size_t q_ = CB_QI(step); const bf16* ps_ = PST + q_ * 4096 + lane * 8; const bf16* nc_ = NCT + q_ * 4096 + ((vb * 4 * 64 + lane) << 2); \
        _Pragma("unroll") for (int mt_ = 0; mt_ < 4; ++mt_) { Apf[u][2 * mt_] = *(const bf16x8*)(ps_ + mt_ * 1024); Apf[u][2 * mt_ + 1] = *(const bf16x8*)(ps_ + mt_ * 1024 + 512); Npf[u][mt_] = *(const u32x2*)(nc_ + mt_ * 256); } } while (0)
        CB_LOAD(0, 0); CB_LOAD(1, 1); CB_LOAD(2, 2); CB_LOAD(3, 3);
#pragma unroll
        for (int u = 0; u < 4; ++u) {
            const int step = u; const size_t q = CB_QI(step); bf16* scg = SC + q * 4096;
            asm volatile("" ::: "memory");
#pragma unroll
            for (int T = 0; T < 4; ++T) { const u32x2 w = pk4(S[T]); *(LAS u32x2*)(Sl + fr * LD16 + 16 * T + 4 * fq) = w; *(u32x2*)(scg + fm_off(16 * vb, 16 * T, fr, fq)) = w; }
            asm volatile("s_waitcnt lgkmcnt(0)" ::: "memory");
            const bf16x8 b0 = *(const LAS bf16x8*)(Sl + fr * LD16 + 8 * fq), b1 = *(const LAS bf16x8*)(Sl + fr * LD16 + 8 * fq + 32);
#pragma unroll
            for (int mt = 0; mt < 4; ++mt) { const u32x2 nw = Npf[u][mt];
                f32x4 acc = (f32x4){__uint_as_float(nw.x << 16), __uint_as_float(nw.x & 0xffff0000u), __uint_as_float(nw.y << 16), __uint_as_float(nw.y & 0xffff0000u)};
                acc = __builtin_amdgcn_mfma_f32_16x16x32_bf16(Apf[u][2 * mt], b0, acc, 0, 0, 0);
                acc = __builtin_amdgcn_mfma_f32_16x16x32_bf16(Apf[u][2 * mt + 1], b1, acc, 0, 0, 0);
                S[mt] = acc; }
            asm volatile("s_waitcnt lgkmcnt(0)" ::: "memory");
        }
#undef CB_LOAD
#undef CB_QI
        { float* dst = F.out + (size_t)M * D + ((((size_t)b * NL + l) * 2 + d) * NH + h) * 4096 + (size_t)(16 * vb + fr) * 64 + 4 * fq;
#pragma unroll
          for (int T = 0; T < 4; ++T) *(f32x4*)(dst + 16 * T) = S[T]; }
    }
}

__device__ __forceinline__ void p_chunkC(Frame& F, int l) {
    PH_LOCALS(F); PH_LAYER(l);
    LAS unsigned char* lds = F.lds;
    const int fr = lane & 15, fq = lane >> 4, d = wave >> 2, nb = wave & 3;
    const bf16* PS = (const bf16*)(F.ws + WS_PS); const bf16* GATE = (const bf16*)(F.ws + WS_GATE); const float* BONUS = (const float*)(F.ws + WS_BONUS);
    bf16* O = (bf16*)(F.ws + WS_O);
    constexpr int NIT = (M / 64) * NH;
    f32x4 gnw[4], gnb[4]; int hcur = -1;
    bf16x8 fa0[4][2], fb0[4]; u32x4 pv0, pg0; float pb00, pb01;
    LAS bf16* VT0 = (LAS bf16*)(lds + 2 * 17408);
#define CC_ISSUE(item_, fa, fb, pv, pg, pb0, pb1) do { const int ci_ = (item_) >> 4, h_ = (item_) & 15; const size_t qi_ = ((size_t)ci_ * 16 + h_) * 2 + d; \
        const bf16* sc_ = (const bf16*)(F.ws + WS_SC) + qi_ * 4096 + lane * 8; \
        const bf16* py_ = (const bf16*)(F.ws + WS_PYT) + qi_ * 4096 + nb * 1024 + lane * 8; const bf16* qy_ = (const bf16*)(F.ws + WS_QYT) + qi_ * 4096 + nb * 1024 + lane * 8; \
        fb[0] = *(const bf16x8*)py_; fb[1] = *(const bf16x8*)(py_ + 512); fb[2] = *(const bf16x8*)qy_; fb[3] = *(const bf16x8*)(qy_ + 512); \
        _Pragma("unroll") for (int vt4_ = 0; vt4_ < 4; ++vt4_) { fa[vt4_][0] = *(const bf16x8*)(sc_ + vt4_ * 1024); fa[vt4_][1] = *(const bf16x8*)(sc_ + vt4_ * 1024 + 512); } \
        const int row_ = ci_ * 64 + (tid >> 3), chn_ = 64 * h_ + (tid & 7) * 8; \
        pv = *(const u32x4*)(PS + (size_t)row_ * CSH + 2 * DA + chn_); pg = *(const u32x4*)(GATE + (size_t)row_ * DA + chn_); pb0 = BONUS[(size_t)row_ * NH + h_]; pb1 = BONUS[((size_t)M + row_) * NH + h_]; } while (0)
#define CC_BODY(item_, fa, fb, pv, pg, pb0, pb1, next_) do { const int ci = (item_) >> 4, h = (item_) & 15, R0 = ci * 64; \
        if (h != hcur) { hcur = h; _Pragma("unroll") for (int vtile = 0; vtile < 4; ++vtile) { gnw[vtile] = *(const f32x4*)(F.in[I_GNW] + (size_t)l * DA + 64 * h + 16 * vtile + 4 * fq); gnb[vtile] = *(const f32x4*)(F.in[I_GNB] + (size_t)l * DA + 64 * h + 16 * vtile + 4 * fq); } } \
        const u32x4 cv = pv, cgt = pg; const float bon = pb0 + pb1; \
        { const int p_ = tid >> 3, c_ = (tid & 7) * 8; *(LAS u32x4*)(VT0 + p_ * LD16 + c_) = cv; *(LAS u32x4*)(VT0 + (64 + 63 - p_) * LD16 + c_) = cv; } \
        LBAR(); \
        f32x4 acc[4]; float s = 0.f; \
        _Pragma("unroll") for (int vtile = 0; vtile < 4; ++vtile) { f32x4 a = F4Z; \
            a = __builtin_amdgcn_mfma_f32_16x16x32_bf16(fa[vtile][0], fb[0], a, 0, 0, 0); a = __builtin_amdgcn_mfma_f32_16x16x32_bf16(fa[vtile][1], fb[1], a, 0, 0, 0); \
            a = __builtin_amdgcn_mfma_f32_16x16x32_bf16(frag_tr(VT0 + d * 64 * LD16, 0, 16 * vtile, fr, fq), fb[2], a, 0, 0, 0); a = __builtin_amdgcn_mfma_f32_16x16x32_bf16(frag_tr(VT0 + d * 64 * LD16, 32, 16 * vtile, fr, fq), fb[3], a, 0, 0, 0); \
            acc[vtile] = a; s += (a[0] + a[1]) + (a[2] + a[3]); } \
        if ((next_) < NIT) CC_ISSUE((next_), fa, fb, pv, pg, pb0, pb1); \
        s += SHX(s, 16); s += SHX(s, 32); \
        const float mean = s * (1.0f / 64.0f); float qv = 0.f; \
        _Pragma("unroll") for (int vtile = 0; vtile < 4; ++vtile) { acc[vtile] = acc[vtile] - mean; const f32x4 a = acc[vtile]; qv += (a[0] * a[0] + a[1] * a[1]) + (a[2] * a[2] + a[3] * a[3]); } \
        qv += SHX(qv, 16); qv += SHX(qv, 32); \
        const float rstd = __builtin_amdgcn_rsqf(qv * (1.0f / 64.0f) + GN_EPS); \
        const int tau = 16 * nb + fr, pos = d ? 63 - tau : tau; \
        LAS float* Yd = (LAS float*)(lds + d * 17408); \
        _Pragma("unroll") for (int vtile = 0; vtile < 4; ++vtile) { const int v0 = 16 * vtile + 4 * fq; \
            *(LAS f32x4*)(Yd + pos * LD32 + v0) = acc[vtile] * rstd * gnw[vtile] + gnb[vtile]; } \
        LBAR(); \
        { const int pos2 = tid >> 3, c8 = (tid & 7) * 8, row = R0 + pos2, chn = 64 * h + c8; \
          const LAS float* Y0 = (const LAS float*)lds; const LAS float* Y1 = (const LAS float*)(lds + 17408); \
          float v[8], gt[8], o[8]; unpack8(cv, v); unpack8(cgt, gt); \
          const f32x4 y00 = *(const LAS f32x4*)(Y0 + pos2 * LD32 + c8), y01 = *(const LAS f32x4*)(Y0 + pos2 * LD32 + c8 + 4), y10 = *(const LAS f32x4*)(Y1 + pos2 * LD32 + c8), y11 = *(const LAS f32x4*)(Y1 + pos2 * LD32 + c8 + 4); \
          _Pragma("unroll") for (int j = 0; j < 4; ++j) { o[j] = (y00[j] + y10[j] + bon * v[j]) * gt[j]; o[4 + j] = (y01[j] + y11[j] + bon * v[4 + j]) * gt[4 + j]; } \
          *(u32x4*)(O + (size_t)row * D + chn) = pack8(o); } \
        LBAR(); } while (0)
    if (bx < NIT) CC_ISSUE(bx, fa0, fb0, pv0, pg0, pb00, pb01);
    for (int item = bx; item < NIT; item += G) {
        CC_BODY(item, fa0, fb0, pv0, pg0, pb00, pb01, item + G);
    }
#undef CC_BODY
#undef CC_ISSUE
}

__device__ __forceinline__ void p_final(Frame& F) {
    PH_LOCALS(F);
    const int gw = bx * NWAVES + wave, NGW = G * NWAVES;
    const float* fg = F.in[I_FNG]; const bf16* X = (const bf16*)(F.ws + WS_X);
    f32x4 fgv[8];
#pragma unroll
    for (int j = 0; j < 8; ++j) fgv[j] = *(const f32x4*)(fg + 8 * lane + 512 * (j >> 1) + 4 * (j & 1));
    for (int row = gw; row < M; row += NGW) {
        const bf16* xr = X + (size_t)row * D; float* orow = F.out + (size_t)row * D;
        float v[4][8]; float ss = 0.f;
#pragma unroll
        for (int j = 0; j < 4; ++j) { unpack8(*(const u32x4*)(xr + 8 * lane + 512 * j), v[j]);
#pragma unroll
            for (int e = 0; e < 8; ++e) ss += v[j][e] * v[j][e]; }
        WAVE_SUM(ss); const float rstd = __builtin_amdgcn_rsqf(ss * (1.0f / D) + RMS_EPS);
#pragma unroll
        for (int j = 0; j < 4; ++j) { const int c = 8 * lane + 512 * j;
            *(f32x4*)(orow + c) = (f32x4){v[j][0], v[j][1], v[j][2], v[j][3]} * rstd * fgv[2 * j];
            *(f32x4*)(orow + c + 4) = (f32x4){v[j][4], v[j][5], v[j][6], v[j][7]} * rstd * fgv[2 * j + 1]; }
    }
}

constexpr int PH_PER_LAYER = 10, N_PHASES = 2 + NL * PH_PER_LAYER;
__global__ void __launch_bounds__(NWAVES * 64, 2) hymba_fwd(Args args) {
    extern __shared__ __attribute__((aligned(16))) unsigned char lds[];
    Frame F;
    F.lds = (LAS unsigned char*)lds;
    F.tid = threadIdx.x; F.lane = F.tid & 63; F.wave = __builtin_amdgcn_readfirstlane(F.tid >> 6);
    F.G = gridDim.x; F.bx = blockIdx.x;
    F.in = args.in; F.out = args.out; F.ws = args.ws;
    for (int u = F.tid; u < (LDS_BYTES - LDSCTL_OFF) / 4; u += NWAVES * 64) ((LAS unsigned*)(F.lds + LDSCTL_OFF))[u] = 0u;
    __syncthreads();
    volatile LAS unsigned* MISC = (volatile LAS unsigned*)(F.lds + MISC_OFF);
    unsigned* barw = (unsigned*)(F.ws + WS_CTL) + CW_BAR;
    XcdBarrier bar; bar.bar = barw; bar.x = 0; bar.st = nullptr;
    if (MK_N_LAUNCHES == 1) bar = xcd_barrier_post(barw, MISC + 8);
    const int lo = args.ph_lo, hi = args.ph_hi;
#define IN(k) (lo <= (k) && (k) < hi)
#define SEAM(k) do { if (MK_N_LAUNCHES == 1 && IN(k) && IN((k) + 1)) xcd_barrier(bar); } while (0)

    for (int rep = 0; rep < ((PROBE_DUP == 30) ? 2 : 1); ++rep)
    if (IN(0)) { p0_prologue(F); __syncthreads(); } SEAM(0);
    bf16* H = (bf16*)(F.ws + WS_H); bf16* O = (bf16*)(F.ws + WS_O); bf16* P = (bf16*)(F.ws + WS_P); bf16* HID = (bf16*)(F.ws + WS_HID);
    const float* mod = (const float*)(F.ws + WS_MOD);
    for (int l = 0; l < NL; ++l) {
        const int pb = 1 + l * PH_PER_LAYER;
        const float* xlo = F.in[I_XP]; const float* xhi = F.in[I_XS]; bf16* XS = (bf16*)(F.ws + WS_X);
        float* dummy = (float*)(F.ws + WS_P);
        for (int rep = 0; rep < ((PROBE_DUP == 7) ? 2 : 1); ++rep)
        if (IN(pb + 0)) { p_adaln(F, l, 0, xlo, xhi, l == 0 ? nullptr : XS); } SEAM(pb + 0);
        for (int rep = 0; rep < ((PROBE_DUP == 1 || PROBE_DUP == 20) ? 2 : 1); ++rep)
        if (IN(pb + 1)) { pg8::Gemm g{H, (const bf16*)(F.ws + WS_WIN + l * SZ_WIN), M, PINP, D}; pg8::StaticOrder S; { int cb_ = F.bx, cg_ = F.G; asm volatile("" : "+s"(cb_), "+s"(cg_)); S.init(M, PINP, cg_, cb_, D); }
            EpiP E{P, PINP, CSH}; pg8::gemm_phase<EpiP, pg8::StaticOrder, true, true>(F.lds, g, S, E, F.wave); } SEAM(pb + 1);
        for (int rep = 0; rep < ((PROBE_DUP == 2) ? 2 : 1); ++rep)
        if (IN(pb + 2)) { p_shift(F, l); } SEAM(pb + 2);
        if (IN(pb + 3)) { for (int rep = 0; rep < ((PROBE_DUP == 3) ? 2 : 1); ++rep) { if (F.G % 16 == 0) p_chunkA(F, l, true); else p_chunkA(F, l, false); } } SEAM(pb + 3);
        for (int rep = 0; rep < ((PROBE_DUP == 4) ? 2 : 1); ++rep)
        if (IN(pb + 4)) { p_chunkB(F, l);
            for (int rep = 0; rep < ((PROBE_DUP == 13) ? 2 : 1); ++rep) p_gmlp(F, l, F.G > 64 ? (F.bx >= 64 ? F.bx - 64 : -1) : F.bx, F.G > 64 ? F.G - 64 : F.G); } SEAM(pb + 4);
        for (int rep = 0; rep < ((PROBE_DUP == 5) ? 2 : 1); ++rep)
        if (IN(pb + 5)) { p_chunkC(F, l); } SEAM(pb + 5);
        if ((PROBE_DUP == 6 || PROBE_DUP == 20) && IN(pb + 6)) { pg8::Gemm g{O, (const bf16*)(F.ws + WS_WOUT + l * SZ_WOUT), M, D, D}; pg8::StaticOrder S; { int cb_ = F.bx, cg_ = F.G; asm volatile("" : "+s"(cb_), "+s"(cg_)); S.init(M, D, cg_, cb_, D); }
            EpiRes E{xlo, xhi, l == 0 ? nullptr : XS, (bf16*)dummy, mod + (size_t)l * 5 * MODW, 2 * D}; pg8::gemm_phase<EpiRes, pg8::StaticOrder, true, true>(F.lds, g, S, E, F.wave); }
        if (IN(pb + 6)) { pg8::Gemm g{O, (const bf16*)(F.ws + WS_WOUT + l * SZ_WOUT), M, D, D}; pg8::FullRoundsOrder S; pg8::TailHalfOrder S2; { int cb_ = F.bx, cg_ = F.G; asm volatile("" : "+s"(cb_), "+s"(cg_)); S.init(M, D, cg_, cb_, D); S2.init(M, D, cg_, cb_, D); }
            EpiRes E{xlo, xhi, l == 0 ? nullptr : XS, XS, mod + (size_t)l * 5 * MODW, 2 * D}; pg8::gemm_phase<EpiRes, pg8::FullRoundsOrder, true, true>(F.lds, g, S, E, F.wave);
            pg8::gemm_phase<EpiRes, pg8::TailHalfOrder, true, true, true>(F.lds, g, S2, E, F.wave); } SEAM(pb + 6);
        for (int rep = 0; rep < ((PROBE_DUP == 7) ? 2 : 1); ++rep)
        if (IN(pb + 7)) { p_adaln(F, l, 1, xlo, xhi, XS); } SEAM(pb + 7);
        for (int rep = 0; rep < ((PROBE_DUP == 8 || PROBE_DUP == 20) ? 2 : 1); ++rep)
        if (IN(pb + 8)) { pg8::Gemm g{H, (const bf16*)(F.ws + WS_WGU + l * SZ_WGU), M, NGU, D}; pg8::StaticOrder S; { int cb_ = F.bx, cg_ = F.G; asm volatile("" : "+s"(cb_), "+s"(cg_)); S.init(M, NGU, cg_, cb_, D); }
            EpiSwi E{HID, DFF}; pg8::gemm_phase<EpiSwi, pg8::StaticOrder, true, true>(F.lds, g, S, E, F.wave); } SEAM(pb + 8);
        if ((PROBE_DUP == 9 || PROBE_DUP == 20) && IN(pb + 9)) { pg8::Gemm g{HID, (const bf16*)(F.ws + WS_WD + l * SZ_WD), M, D, DFF}; pg8::StaticOrder S; { int cb_ = F.bx, cg_ = F.G; asm volatile("" : "+s"(cb_), "+s"(cg_)); S.init(M, D, cg_, cb_, DFF); }
            EpiRes E{xlo, xhi, XS, (bf16*)dummy, mod + (size_t)l * 5 * MODW, 5 * D}; pg8::gemm_phase<EpiRes, pg8::StaticOrder, true, true>(F.lds, g, S, E, F.wave); }
        if (IN(pb + 9)) { pg8::Gemm g{HID, (const bf16*)(F.ws + WS_WD + l * SZ_WD), M, D, DFF}; pg8::FullRoundsOrder S; pg8::TailHalfOrder S2; { int cb_ = F.bx, cg_ = F.G; asm volatile("" : "+s"(cb_), "+s"(cg_)); S.init(M, D, cg_, cb_, DFF); S2.init(M, D, cg_, cb_, DFF); }
            EpiRes E{xlo, xhi, XS, XS, mod + (size_t)l * 5 * MODW, 5 * D}; pg8::gemm_phase<EpiRes, pg8::FullRoundsOrder, true, true>(F.lds, g, S, E, F.wave);
            pg8::gemm_phase<EpiRes, pg8::TailHalfOrder, true, true, true>(F.lds, g, S2, E, F.wave); } SEAM(pb + 9);
    }
    if (IN(N_PHASES - 1)) { p_final(F); }
#undef IN
#undef SEAM
}

extern "C" void kernel_launch(void* const* d_in, const int* in_sizes, int n_in, void* d_out, int out_size, void* d_ws, size_t ws_size, hipStream_t stream) {
    static int grid = 0;
    if (grid == 0) {
        if (n_in != 30 || ws_size < WS_END) { fprintf(stderr, "kernel_launch: need 30 inputs and >= %zu bytes of workspace; got n_in %d, ws %zu\n", (size_t)WS_END, n_in, ws_size); grid = -1; return; }
        int dev = 0, cus = 0, per_cu = 0;
        if (hipGetDevice(&dev) != hipSuccess || hipDeviceGetAttribute(&cus, hipDeviceAttributeMultiprocessorCount, dev) != hipSuccess) { grid = -1; return; }
        if (hipFuncSetAttribute((const void*)hymba_fwd, hipFuncAttributeMaxDynamicSharedMemorySize, LDS_BYTES) != hipSuccess) { fprintf(stderr, "kernel_launch: hipFuncSetAttribute failed\n"); grid = -1; return; }
        if (hipOccupancyMaxActiveBlocksPerMultiprocessor(&per_cu, (const void*)hymba_fwd, NWAVES * 64, LDS_BYTES) != hipSuccess || per_cu < 1)
            fprintf(stderr, "kernel_launch: note: occupancy query reports %d workgroups per CU\n", per_cu);
        (void)hipGetLastError();
        grid = cus;
    }
    if (grid < 0) return;
    if (hipMemsetAsync((char*)d_ws + WS_CTL, 0, CTL_ZERO_BYTES, stream) != hipSuccess) return;
    Args a{};
    for (int i = 0; i < 30; ++i) a.in[i] = (const float*)d_in[i];
    a.out = (float*)d_out; a.ws = (unsigned char*)d_ws; a.pad = 0;
    if (MK_N_LAUNCHES == 1) {
        a.ph_lo = 0; a.ph_hi = N_PHASES; a.li = 0;
        hipLaunchKernelGGL(hymba_fwd, dim3(grid), dim3(NWAVES * 64), LDS_BYTES, stream, a);
    } else {
        for (int k = 0; k < N_PHASES; ++k) { a.ph_lo = k; a.ph_hi = k + 1; a.li = k;
            hipLaunchKernelGGL(hymba_fwd, dim3(grid), dim3(NWAVES * 64), LDS_BYTES, stream, a); }
    }
}
```

```cpp
#include <hip/hip_runtime.h>
#include <cstdio>
#include <cstdint>

#ifndef PROBE_DUP
#define PROBE_DUP -1
#endif
#ifndef PROBE_SUB
#define PROBE_SUB 0
#endif
#ifndef MK_N_LAUNCHES
#define MK_N_LAUNCHES 1
#endif

namespace pg8 {
#define PG8_LAS __attribute__((address_space(3)))
typedef unsigned short bf16_t;
typedef short bf16x8 __attribute__((ext_vector_type(8)));
typedef float f32x4 __attribute__((ext_vector_type(4)));
typedef unsigned u32x4 __attribute__((ext_vector_type(4)));
constexpr int BM = 256, BK = 64, HALF = 128, HTB = HALF * BK * 2  , STAGE_BYTES = 8 * HTB, NXCD = 8, WGM = 8;

__host__ __device__ __forceinline__ int lds_byte(int r, int c) { const int st = (r >> 4) * 2 + (c >> 5), rr = r & 15, cc = c & 31, ob = rr * 64 + cc * 2; return st * 1024 + (ob ^ (((ob >> 9) & 1) << 5)); }
__host__ __device__ __forceinline__ void stage_rc(int b, int& R, int& C) { const int st = b / 1024, sb = b % 1024, swz = sb ^ (((sb >> 9) & 1) << 5); R = (st >> 1) * 16 + swz / 64; C = (st & 1) * 32 + (swz % 64) / 2; }
__host__ __device__ __forceinline__ int perm32(int rho) { const int n = rho >> 4, i = rho & 15; return 8 * (i >> 2) + 4 * n + (i & 3); }

struct Unit { int pm, pn, k0, nk, bh; };
struct Gemm { const bf16_t* A; const bf16_t* Bt; int M, N, K; };

struct StaticOrder {
    int nM, nN, nwg, G, c, nkt, full, rem;
    __host__ __device__ void init(int M, int N, int G_, int c_, int K_) { nM = M / BM; nN = N / BM; nwg = nM * nN; G = G_; c = c_; nkt = K_ / BK; full = nwg / G; rem = nwg - full * G; }
    __host__ __device__ bool next(int i, Unit& u) const {
        const long L = (long)i * G + c; if (L >= nwg) return false;
        int wgid = (int)L; { const int q = nwg / NXCD, r = nwg % NXCD, xcd = wgid % NXCD, off = wgid / NXCD; wgid = (xcd < r ? xcd * (q + 1) : r * (q + 1) + (xcd - r) * q) + off; }
        const int nig = WGM * nN, gid = wgid / nig, fm = gid * WGM, gsz = (nM - fm) < WGM ? (nM - fm) : WGM;
        u.pm = fm + ((wgid % nig) % gsz); u.pn = (wgid % nig) / gsz; u.k0 = 0; u.nk = nkt; u.bh = -1;
#if defined(__HIP_DEVICE_COMPILE__)
        u.pm = __builtin_amdgcn_readfirstlane(u.pm); u.pn = __builtin_amdgcn_readfirstlane(u.pn);
#endif
        return true;
    }
    __device__ __forceinline__ void a_ready(const Unit&) const {}
    __device__ __forceinline__ void done(const Unit&) const {}
};
struct FullRoundsOrder : StaticOrder {
    __host__ __device__ bool split() const { return rem > 0 && 2 * rem <= G; }
    __host__ __device__ bool next(int i, Unit& u) const { if (split() && i >= full) return false; return StaticOrder::next(i, u); }
};
struct TailHalfOrder : StaticOrder {
    __host__ __device__ bool next(int i, Unit& u) const {
        if (!(rem > 0 && 2 * rem <= G) || i > 0 || c >= 2 * rem) return false;
        StaticOrder t = *this; t.c = c >> 1; if (!t.StaticOrder::next(full, u)) return false;
        u.bh = c & 1; return true;
    }
};

__device__ __forceinline__ unsigned cvt_pk_bf16(float lo, float hi) { unsigned r; asm volatile("v_cvt_pk_bf16_f32 %0, %1, %2" : "=v"(r) : "v"(lo), "v"(hi)); return r; }

template <class Epi, class Sched, bool ALIGN_EPI = false, bool SP2 = false, bool HALFB = false>
__device__ __forceinline__ void gemm_phase(PG8_LAS unsigned char* lds, const Gemm g, const Sched& S, const Epi& E, int wid) {
    asm volatile("" : "+s"(wid)); int lane; asm volatile("v_mbcnt_lo_u32_b32 %0, -1, 0\n\tv_mbcnt_hi_u32_b32 %0, -1, %0" : "=v"(lane));
    const int tid = wid * 64 + lane, wr = wid >> 2, wc = wid & 3, fr = lane & 15, fq = lane >> 4;
    const int K = g.K;
    unsigned voffA[2], voffB[2];
#pragma unroll
    for (int i = 0; i < 2; ++i) { int R, C; stage_rc(tid * 16 + i * 8192, R, C); const int Rb = Epi::PERM ? ((R & ~31) + perm32(R & 31)) : R;
        voffA[i] = (unsigned)(R * K + C) * 2u; voffB[i] = (unsigned)(Rb * K + C) * 2u; }
    const size_t kstep = (size_t)(BK * 2);
    const size_t hstep = (size_t)HALF * K * 2;
    const size_t tstep = 2 * hstep;
    const size_t bhs = HALFB ? 0 : hstep;
    const unsigned ldsw = (unsigned)wid * 1024u;
    const int aoff = lds_byte(wr * 64 + fr, fq * 8), boff = lds_byte(wc * 32 + fr, fq * 8);
#define PG8_SA(b, h) (((b) * 2 + (h)) * HTB)
#define PG8_SB(b, h) ((4 + (b) * 2 + (h)) * HTB)
#define PG8_STAGE(bufoff, gbase, voff) do { _Pragma("unroll") for (int _i = 0; _i < 2; ++_i) \
        __builtin_amdgcn_global_load_lds((const unsigned*)((const char*)(gbase) + (voff)[_i]), (PG8_LAS unsigned*)(lds + (bufoff) + ldsw + _i * 8192), 16, 0, 0); } while (0)
#define PG8_LDA(dst, b, h) do { _Pragma("unroll") for (int m = 0; m < 4; ++m) _Pragma("unroll") for (int k = 0; k < 2; ++k) dst[m][k] = *(const PG8_LAS bf16x8*)(lds + PG8_SA(b, h) + aoff + m * 2048 + k * 1024); } while (0)
#define PG8_LDB(dst, b, h) do { _Pragma("unroll") for (int n = 0; n < 2; ++n) _Pragma("unroll") for (int k = 0; k < 2; ++k) dst[n][k] = *(const PG8_LAS bf16x8*)(lds + PG8_SB(b, h) + boff + n * 2048 + k * 1024); } while (0)
#define PG8_MMA(ai, bj, At, Bt) do { __builtin_amdgcn_s_setprio(1); _Pragma("unroll") for (int m = 0; m < 4; ++m) _Pragma("unroll") for (int n = 0; n < 2; ++n) _Pragma("unroll") for (int k = 0; k < 2; ++k) \
        acc[ai][bj][m][n] = __builtin_amdgcn_mfma_f32_16x16x32_bf16(Bt[n][k], At[m][k], acc[ai][bj][m][n], 0, 0, 0); __builtin_amdgcn_s_setprio(0); } while (0)
#define PG8_WAIT_V(n) asm volatile("s_waitcnt vmcnt(" #n ")" ::: "memory")
#define PG8_WAIT_L(n) asm volatile("s_waitcnt lgkmcnt(" #n ")" ::: "memory")
#define PG8_BAR __builtin_amdgcn_s_barrier()
#define PG8_SCHED __builtin_amdgcn_sched_barrier(0)
    Unit cur, nxt; int ui = 0;
    if (!S.next(0, cur)) return;
    f32x4 acc[2][2][4][2];
#pragma unroll
    for (int a = 0; a < 2; ++a)
#pragma unroll
        for (int b = 0; b < 2; ++b)
#pragma unroll
            for (int m = 0; m < 4; ++m)
#pragma unroll
                for (int n = 0; n < 2; ++n) acc[a][b][m][n] = (f32x4){0.f, 0.f, 0.f, 0.f};
    bf16x8 At[4][2], B0[2][2], B1[2][2];
    const char* cA = (const char*)g.A + (size_t)cur.pm * tstep + (size_t)cur.k0 * kstep; const char* cB = (const char*)g.Bt + (size_t)cur.pn * tstep + (size_t)cur.k0 * kstep + (HALFB ? (size_t)cur.bh * hstep : 0);
    S.a_ready(cur);
    if constexpr (SP2) {
        PG8_STAGE(PG8_SB(0, 0), cB, voffB); PG8_STAGE(PG8_SB(0, 1), cB + bhs, voffB); PG8_STAGE(PG8_SA(0, 0), cA, voffA); PG8_STAGE(PG8_SA(0, 1), cA + hstep, voffA);
        if (wr == 1) PG8_BAR;
        PG8_WAIT_V(2); PG8_BAR;
        PG8_STAGE(PG8_SB(1, 0), cB + kstep, voffB); PG8_STAGE(PG8_SA(1, 0), cA + kstep, voffA); PG8_STAGE(PG8_SB(1, 1), cB + bhs + kstep, voffB);
        PG8_WAIT_V(6); PG8_BAR;
    } else {
        PG8_STAGE(PG8_SB(0, 0), cB, voffB); PG8_STAGE(PG8_SA(0, 0), cA, voffA); PG8_STAGE(PG8_SB(0, 1), cB + bhs, voffB); PG8_STAGE(PG8_SA(0, 1), cA + hstep, voffA);
        if (wr == 1) PG8_BAR;
        PG8_WAIT_V(4); PG8_BAR;
        PG8_STAGE(PG8_SB(1, 0), cB + kstep, voffB); PG8_STAGE(PG8_SA(1, 0), cA + kstep, voffA); PG8_STAGE(PG8_SB(1, 1), cB + bhs + kstep, voffB);
        PG8_WAIT_V(6); PG8_BAR;
    }
    for (;;) {
        const bool has_next = S.next(ui + 1, nxt);
        const char* nA = has_next ? (const char*)g.A + (size_t)nxt.pm * tstep + (size_t)nxt.k0 * kstep : cA; const char* nB = has_next ? (const char*)g.Bt + (size_t)nxt.pn * tstep + (size_t)nxt.k0 * kstep + (HALFB ? (size_t)nxt.bh * hstep : 0) : cB;
        const int nt = cur.nk;
        for (int t = 0; t < nt; t += 2) {
            const bool last = (t == nt - 2);
            const char* a1 = cA + (size_t)(t + 1) * kstep;
            const char* a2 = last ? nA : cA + (size_t)(t + 2) * kstep; const char* b2 = last ? nB : cB + (size_t)(t + 2) * kstep;
            const char* a3 = a2 + kstep; const char* b3 = b2 + kstep;
            if (last && has_next) S.a_ready(nxt);
            if constexpr (SP2) {
            PG8_LDB(B0, 0, 0); if constexpr (!HALFB) PG8_LDB(B1, 0, 1); PG8_SCHED; PG8_LDA(At, 0, 0); PG8_STAGE(PG8_SA(1, 1), a1 + hstep, voffA);
            PG8_WAIT_V(8); PG8_WAIT_L(0); PG8_BAR; PG8_MMA(0, 0, At, B0); if constexpr (!HALFB) PG8_MMA(0, 1, At, B1); PG8_BAR; PG8_SCHED;
            PG8_LDA(At, 0, 1); PG8_STAGE(PG8_SB(0, 0), b2, voffB); PG8_STAGE(PG8_SB(0, 1), b2 + bhs, voffB); PG8_STAGE(PG8_SA(0, 0), a2, voffA);
            PG8_WAIT_V(8); PG8_WAIT_L(0); PG8_BAR; PG8_MMA(1, 0, At, B0); if constexpr (!HALFB) PG8_MMA(1, 1, At, B1); PG8_BAR; PG8_SCHED;
            PG8_LDB(B0, 1, 0); if constexpr (!HALFB) PG8_LDB(B1, 1, 1); PG8_SCHED; PG8_LDA(At, 1, 0); PG8_STAGE(PG8_SA(0, 1), a2 + hstep, voffA);
            PG8_WAIT_V(8); PG8_WAIT_L(0); PG8_BAR; PG8_MMA(0, 0, At, B0); if constexpr (!HALFB) PG8_MMA(0, 1, At, B1); PG8_BAR; PG8_SCHED;
            PG8_LDA(At, 1, 1); PG8_STAGE(PG8_SB(1, 0), b3, voffB); PG8_STAGE(PG8_SB(1, 1), b3 + bhs, voffB); PG8_STAGE(PG8_SA(1, 0), a3, voffA);
            PG8_WAIT_V(8); PG8_WAIT_L(0); PG8_BAR; PG8_MMA(1, 0, At, B0); if constexpr (!HALFB) PG8_MMA(1, 1, At, B1); PG8_BAR; PG8_SCHED;
            } else {
            PG8_LDB(B0, 0, 0); PG8_SCHED; PG8_LDA(At, 0, 0); PG8_STAGE(PG8_SA(1, 1), a1 + hstep, voffA);
            PG8_WAIT_L(8); PG8_BAR; PG8_WAIT_L(0); PG8_MMA(0, 0, At, B0); PG8_BAR; PG8_SCHED;
            PG8_LDB(B1, 0, 1); PG8_STAGE(PG8_SB(0, 0), b2, voffB);
            PG8_BAR; PG8_WAIT_L(0); PG8_MMA(0, 1, At, B1); PG8_BAR;
            PG8_LDA(At, 0, 1); PG8_STAGE(PG8_SA(0, 0), a2, voffA);
            PG8_BAR; PG8_WAIT_L(0); PG8_MMA(1, 0, At, B0); PG8_BAR; PG8_SCHED;
            PG8_STAGE(PG8_SB(0, 1), b2 + bhs, voffB);
            PG8_WAIT_V(6); PG8_BAR; PG8_MMA(1, 1, At, B1); PG8_BAR;
            PG8_LDB(B0, 1, 0); PG8_SCHED; PG8_LDA(At, 1, 0); PG8_STAGE(PG8_SA(0, 1), a2 + hstep, voffA);
            PG8_WAIT_L(8); PG8_BAR; PG8_WAIT_L(0); PG8_MMA(0, 0, At, B0); PG8_BAR; PG8_SCHED;
            PG8_LDB(B1, 1, 1); PG8_STAGE(PG8_SB(1, 0), b3, voffB);
            PG8_BAR; PG8_WAIT_L(0); PG8_MMA(0, 1, At, B1); PG8_BAR;
            PG8_LDA(At, 1, 1); PG8_STAGE(PG8_SA(1, 0), a3, voffA);
            PG8_BAR; PG8_WAIT_L(0); PG8_MMA(1, 0, At, B0); PG8_BAR; PG8_SCHED;
            PG8_STAGE(PG8_SB(1, 1), b3 + bhs, voffB);
            PG8_WAIT_V(6); PG8_BAR; PG8_MMA(1, 1, At, B1); PG8_BAR;
            }
        }
        if constexpr (ALIGN_EPI) { if (wr == 0) PG8_BAR; }
        E(acc, cur, wr, wc, fr, fq); S.done(cur);
        if (!has_next) break;
#pragma unroll
        for (int a = 0; a < 2; ++a)
#pragma unroll
            for (int b = 0; b < 2; ++b)
#pragma unroll
                for (int m = 0; m < 4; ++m)
#pragma unroll
                    for (int n = 0; n < 2; ++n) acc[a][b][m][n] = (f32x4){0.f, 0.f, 0.f, 0.f};
        cur = nxt; cA = nA; cB = nB; ++ui;
        if constexpr (ALIGN_EPI) { if (wr == 1) PG8_BAR; }
    }
    PG8_WAIT_V(0);
    if constexpr (!ALIGN_EPI) { if (wr == 0) PG8_BAR; }
    PG8_BAR;
#undef PG8_SA
#undef PG8_SB
#undef PG8_STAGE
#undef PG8_LDA
#undef PG8_LDB
#undef PG8_MMA
#undef PG8_WAIT_V
#undef PG8_WAIT_L
#undef PG8_BAR
#undef PG8_SCHED
}
}

constexpr int NWAVES = 8;
constexpr int D = 2048, MCTX = 4096, MLAT = 16384, M = MCTX + MLAT, NL = 4;
constexpr int DA = 1024, NH = 16, DB = 1024, NG = 8, HB = 128;
constexpr int LW = 64, LAA = 64, LGT = 160;
constexpr int CSH = 3 * DA + LW + LAA + LGT;
constexpr int PIN = CSH + 2 * DB;
constexpr int PINP = 5632;
constexpr int DFF = 5632, NGU = 2 * DFF;
constexpr int MODW = 6 * D;
constexpr float RMS_EPS = 1e-6f, GN_EPS = 64.0f * 1e-5f, LN_EPS = 1e-5f;

constexpr size_t MiB = 1u << 20;
constexpr size_t WS_CTL = 0, CTL_ZERO_BYTES = 1 * MiB;
constexpr size_t WS_MOD = 1 * MiB;
constexpr size_t WS_W2T = 2 * MiB;
constexpr size_t WS_A2T = 3 * MiB;
constexpr size_t WS_G2T = 4 * MiB;
constexpr size_t WS_WSP = 6 * MiB;
constexpr size_t WS_BONUS = 7 * MiB;
constexpr size_t SZ_WIN = (size_t)PINP * D * 2, SZ_WOUT = (size_t)D * D * 2, SZ_WGU = (size_t)NGU * D * 2, SZ_WD = (size_t)D * DFF * 2;
constexpr size_t WS_WIN = 16 * MiB;
constexpr size_t WS_WOUT = WS_WIN + NL * SZ_WIN;
constexpr size_t WS_WGU = WS_WOUT + NL * SZ_WOUT;
constexpr size_t WS_WD = WS_WGU + NL * SZ_WGU;
constexpr size_t WS_H = WS_WD + NL * SZ_WD;
constexpr size_t WS_O = WS_H + (size_t)M * D * 2;
constexpr size_t WS_P = WS_O + (size_t)M * D * 2;
constexpr size_t WS_PS = WS_P + (size_t)M * PINP * 2;
constexpr size_t SZ_T16 = (size_t)M * DA * 2;
constexpr size_t WS_GATE = WS_PS + (size_t)M * CSH * 2;
constexpr size_t SZ_CH = (size_t)(M / 64) * NH * 2 * 8192;
constexpr size_t WS_PST = WS_GATE + SZ_T16;
constexpr size_t WS_NCT = WS_PST + SZ_CH;
constexpr size_t WS_PYT = WS_NCT + SZ_CH;
constexpr size_t WS_QYT = WS_PYT + SZ_CH;
constexpr size_t WS_VTG = WS_QYT + SZ_CH;
constexpr size_t WS_SC = WS_VTG + SZ_CH;
constexpr size_t WS_LORA = WS_SC + SZ_CH;
constexpr size_t WS_X = WS_LORA + (size_t)M * 288 * 2;
constexpr size_t WS_END1 = WS_X + (size_t)M * D * 2;
constexpr size_t WS_HID = WS_GATE;
constexpr size_t WS_END = WS_END1 > WS_HID + (size_t)M * DFF * 2 ? WS_END1 : WS_HID + (size_t)M * DFF * 2;
constexpr int CW_BAR = 4096;
constexpr int CW_SPLIT = 16384;
static_assert((CW_SPLIT + NL * 640 * 64) * 4 <= (int)CTL_ZERO_BYTES, "control words inside the memset region");

constexpr int RING_BYTES = 131072;
constexpr int LDSCTL_OFF = 15 * 9216, MISC_OFF = LDSCTL_OFF + 320;
constexpr int LDS_BYTES = 147456;

#define GAS __attribute__((address_space(1)))
#define LAS __attribute__((address_space(3)))
typedef unsigned short bf16;
typedef float f32x4 __attribute__((ext_vector_type(4)));
typedef float f32x2 __attribute__((ext_vector_type(2)));
typedef short bf16x8 __attribute__((ext_vector_type(8)));
typedef unsigned u32x4 __attribute__((ext_vector_type(4)));
typedef unsigned u32x2 __attribute__((ext_vector_type(2)));
#define LDS_WAIT() asm volatile("s_waitcnt lgkmcnt(0)" ::: "memory")
#define VM_WAIT() asm volatile("s_waitcnt vmcnt(0)" ::: "memory")
__device__ __forceinline__ unsigned f2bf(float f) { unsigned u = __builtin_bit_cast(unsigned, f); return (u + 0x7fffu + ((u >> 16) & 1u)) >> 16; }
typedef __bf16 bf16x2_t __attribute__((ext_vector_type(2)));
__device__ __forceinline__ unsigned pk2(float lo, float hi) { return __builtin_bit_cast(unsigned, __builtin_convertvector((f32x2){lo, hi}, bf16x2_t)); }
__device__ __forceinline__ float bf2f(unsigned short b) { return __uint_as_float(((unsigned)b) << 16); }
__device__ __forceinline__ void unpack8(const u32x4 q, float (&f)[8]) {
    f[0] = __uint_as_float(q.x << 16); f[1] = __uint_as_float(q.x & 0xffff0000u); f[2] = __uint_as_float(q.y << 16); f[3] = __uint_as_float(q.y & 0xffff0000u);
    f[4] = __uint_as_float(q.z << 16); f[5] = __uint_as_float(q.z & 0xffff0000u); f[6] = __uint_as_float(q.w << 16); f[7] = __uint_as_float(q.w & 0xffff0000u); }
__device__ __forceinline__ u32x4 pack8(const float (&f)[8]) { u32x4 o; o.x = pk2(f[0], f[1]); o.y = pk2(f[2], f[3]); o.z = pk2(f[4], f[5]); o.w = pk2(f[6], f[7]); return o; }
__device__ __forceinline__ float fsigmoid(float x) { return __builtin_amdgcn_rcpf(1.0f + __expf(-x)); }
__device__ __forceinline__ float ftanh(float x) { return 1.0f - 2.0f * __builtin_amdgcn_rcpf(1.0f + __expf(2.0f * x)); }
__device__ __forceinline__ float gelu_tanh(float x) {
    constexpr float c1 = -1.5957691216057308f * 1.4426950408889634f, c2 = c1 * 0.044715f; const float p = __builtin_fmaf(x * x, c2, c1); return x * __builtin_amdgcn_rcpf(1.0f + __builtin_amdgcn_exp2f(x * p)); }
__device__ __forceinline__ int hw_lane() { int l; asm volatile("v_mbcnt_lo_u32_b32 %0, -1, 0\n\tv_mbcnt_hi_u32_b32 %0, -1, %0" : "=v"(l)); return l; }
#define SHX(v, X) __int_as_float(__builtin_amdgcn_ds_bpermute((lane ^ (X)) << 2, __float_as_int(v)))
#define WAVE_SUM(v) do { v += SHX(v, 1); v += SHX(v, 2); v += SHX(v, 4); v += SHX(v, 8); v += SHX(v, 16); v += SHX(v, 32); } while (0)

#define PH_LOCALS(F) int wave = (F).wave; asm volatile("" : "+s"(wave)); const int lane = hw_lane(); const int tid = wave * 64 + lane; \
    int bx = (F).bx, G = (F).G; asm volatile("" : "+s"(bx), "+s"(G)); (void)lane; (void)tid;
#define PH_LAYER(l) asm volatile("" : "+s"(l))

#define XB_TMO      128
#define XB_XCNT(j)  (256  + 64 * (j))
#define XB_XSUB(j)  (1280 + 64 * (j))
#define XB_XGEN(j)  (2304 + 64 * (j))
#define XB_TOP      3328
#define XB_TOPGEN   3392
#define XCD_BAR_WORDS 3456
#define XB_SPIN_CAP (1u << 18)

__device__ __forceinline__ unsigned xb_ld(unsigned* p)              { return __hip_atomic_load(p, __ATOMIC_RELAXED, __HIP_MEMORY_SCOPE_AGENT); }
__device__ __forceinline__ unsigned xb_add(unsigned* p, unsigned v) { return __hip_atomic_fetch_add(p, v, __ATOMIC_RELAXED, __HIP_MEMORY_SCOPE_AGENT); }
__device__ __forceinline__ unsigned xb_xcc_id() { return (unsigned)__builtin_amdgcn_s_getreg((3 << 11) | 20) & 0xFu; }
#define XB_SPIN(cond, bar) do { unsigned _sp = 0; while (cond) { __builtin_amdgcn_s_sleep(1); \
    if ((++_sp & 255u) == 0u) { if (xb_ld(&(bar)[XB_TMO])) break; if (_sp > XB_SPIN_CAP) { atomicAdd(&(bar)[XB_TMO], 1u); break; } } } } while (0)

struct XcdBarrier {
    unsigned* bar; unsigned x;
    volatile LAS unsigned* st;
};
__device__ __forceinline__ XcdBarrier xcd_barrier_post(unsigned* bar, volatile LAS unsigned* st) {
    XcdBarrier b; b.bar = bar; b.x = xb_xcc_id(); b.st = st;
    if (threadIdx.x == 0) (void)xb_add(&bar[XB_XCNT(b.x)], 1u);
    return b;
}
__device__ __forceinline__ void xcd_barrier_complete(unsigned* bar, unsigned x, unsigned& nloc, unsigned& nx) {
    const unsigned G = gridDim.x * gridDim.y * gridDim.z;
    unsigned sum, cnt, mine, sp = 0u;
    for (;;) {
        sum = 0u; cnt = 0u; mine = 0u;
#pragma unroll
        for (unsigned j = 0; j < 16; ++j) { const unsigned c = xb_ld(&bar[XB_XCNT(j)]); sum += c; cnt += (c > 0u) ? 1u : 0u; mine = (j == x) ? c : mine; }
        if (sum == G) break;
        __builtin_amdgcn_s_sleep(1);
        if ((++sp & 255u) == 0u) { if (xb_ld(&bar[XB_TMO])) break; if (sp > XB_SPIN_CAP) { atomicAdd(&bar[XB_TMO], 1u); break; } }
    }
    nloc = mine > 0u ? mine : 1u; nx = cnt > 0u ? cnt : 1u;
}
__device__ __forceinline__ void xcd_barrier(const XcdBarrier& b) {
    asm volatile("s_waitcnt vmcnt(0)" ::: "memory");
    __syncthreads();
    if (threadIdx.x == 0) {
        unsigned* bar = b.bar;
        __builtin_amdgcn_s_waitcnt(0);
        unsigned nloc = b.st[0], nx = b.st[1];
        if (nloc == 0u) { xcd_barrier_complete(bar, b.x, nloc, nx); b.st[0] = nloc; b.st[1] = nx; }
        const unsigned old = xb_add(&bar[XB_XSUB(b.x)], 1u);
        const unsigned gen = old / nloc;
        if (old + 1u == (gen + 1u) * nloc) {
            __builtin_amdgcn_fence(__ATOMIC_RELEASE, "agent");
            asm volatile("s_waitcnt vmcnt(0)" ::: "memory");
            const unsigned og = xb_add(&bar[XB_TOP], 1u);
            const unsigned tg = og / nx;
            if (og + 1u == (tg + 1u) * nx) xb_add(&bar[XB_TOPGEN], 1u);
            else XB_SPIN(xb_ld(&bar[XB_TOPGEN]) == tg, bar);
            __builtin_amdgcn_fence(__ATOMIC_ACQUIRE, "agent");
            xb_add(&bar[XB_XGEN(b.x)], 1u);
            asm volatile("s_waitcnt vmcnt(0)" ::: "memory");
        } else {
            XB_SPIN(xb_ld(&bar[XB_XGEN(b.x)]) == gen, bar);
            __builtin_amdgcn_fence(__ATOMIC_ACQUIRE, "agent");
            asm volatile("s_waitcnt vmcnt(0)" ::: "memory");
        }
    }
    __syncthreads();
}

struct Args {
    const float* in[30];
    float* out; unsigned char* ws;
    int ph_lo, ph_hi, li, pad;
};
enum { I_XP = 0, I_XS, I_STATE, I_C, I_CCTX, I_WMOD, I_BMOD, I_N1G, I_WIN, I_MU, I_W0, I_W2, I_A0, I_A2, I_G2, I_KK, I_KA, I_RK, I_GNW, I_GNB, I_LNG, I_LNB, I_WSP, I_BSP, I_WOUT, I_N2G, I_WG, I_WU, I_WD, I_FNG };

struct Frame {
    LAS unsigned char* lds;
    int tid, lane, wave, G, bx;
    const float* const* in;
    float* out; unsigned char* ws;
};

struct EpiP {
    static constexpr bool PERM = true, AFTER_DRAIN = false;
    bf16* O; int ldc; int gelu_from;
    __device__ __forceinline__ void operator()(const f32x4 (&acc)[2][2][4][2], const pg8::Unit& u, int wr, int wc, int fr, int fq) const {
        const int row0 = u.pm * 256 + wr * 64 + fr, col0 = u.pn * 256 + wc * 32 + 8 * fq;
#pragma unroll
        for (int ai = 0; ai < 2; ++ai)
#pragma unroll
            for (int m = 0; m < 4; ++m) { bf16* rowp = O + (size_t)(row0 + ai * 128 + m * 16) * ldc + col0;
#pragma unroll
                for (int bj = 0; bj < 2; ++bj) { f32x4 v0 = acc[ai][bj][m][0], v1 = acc[ai][bj][m][1];
                    if (col0 + bj * 128 >= gelu_from) {
#pragma unroll
                        for (int j = 0; j < 4; ++j) { v0[j] = gelu_tanh(v0[j]); v1[j] = gelu_tanh(v1[j]); } }
                    u32x4 w; w.x = pg8::cvt_pk_bf16(v0[0], v0[1]); w.y = pg8::cvt_pk_bf16(v0[2], v0[3]); w.z = pg8::cvt_pk_bf16(v1[0], v1[1]); w.w = pg8::cvt_pk_bf16(v1[2], v1[3]);
                    *(u32x4*)(rowp + bj * 128) = w; } }
    }
};
struct EpiRes {
    static constexpr bool PERM = true, AFTER_DRAIN = false;
    const float* xlo; const float* xhi; const bf16* xb_in; bf16* xb_out; const float* modl; int goff;
    __device__ __forceinline__ void operator()(const f32x4 (&acc)[2][2][4][2], const pg8::Unit& u, int wr, int wc, int fr, int fq) const {
        const int pm = u.pm; const int midx = pm < 16 ? 0 : 1 + ((pm - 16) >> 4);
        const float* gv = modl + (size_t)midx * MODW + goff;
        const bool f32in = xb_in == nullptr;
        const float* base = pm < 16 ? xlo + (size_t)pm * 256 * D : xhi + (size_t)(pm - 16) * 256 * D;
        const bf16* bbase = xb_in + (size_t)pm * 256 * D;
        bf16* ob = xb_out + (size_t)pm * 256 * D;
        const bool half = u.bh >= 0;
        const int col0 = u.pn * 256 + (u.bh > 0 ? 128 : 0) + wc * 32 + 8 * fq;
        f32x4 gvv[2][2];
#pragma unroll
        for (int bj = 0; bj < 2; ++bj)
#pragma unroll
            for (int n = 0; n < 2; ++n) gvv[bj][n] = (bj == 1 && half) ? (f32x4){0.f, 0.f, 0.f, 0.f} : *(const f32x4*)(gv + col0 + bj * 128 + n * 4);
        const size_t rbase = (size_t)(wr * 64 + fr) * D + col0;
        u32x4 xr[8][2][2];
#define ER_LOAD(g_) do { const size_t off_ = rbase + (size_t)(((g_) >> 2) * 128 + ((g_) & 3) * 16) * D; \
            _Pragma("unroll") for (int bj = 0; bj < 2; ++bj) { if (bj == 1 && half) continue; \
                if (f32in) { xr[g_][bj][0] = *(const u32x4*)(base + off_ + bj * 128); xr[g_][bj][1] = *(const u32x4*)(base + off_ + bj * 128 + 4); } \
                else xr[g_][bj][0] = *(const u32x4*)(bbase + off_ + bj * 128); } } while (0)
        ER_LOAD(0); ER_LOAD(1); ER_LOAD(2);
        asm volatile("" ::: "memory");
#pragma unroll
        for (int g = 0; g < 8; ++g) { const int ai = g >> 2, m = g & 3; const size_t off = rbase + (size_t)(ai * 128 + m * 16) * D;
#pragma unroll
            for (int bj = 0; bj < 2; ++bj) { if (bj == 1 && half) continue;
                const u32x4 r0 = xr[g][bj][0], r1 = xr[g][bj][1];
                const f32x4 xo0 = f32in ? (f32x4){__uint_as_float(r0.x), __uint_as_float(r0.y), __uint_as_float(r0.z), __uint_as_float(r0.w)}
                                        : (f32x4){__uint_as_float(r0.x << 16), __uint_as_float(r0.x & 0xffff0000u), __uint_as_float(r0.y << 16), __uint_as_float(r0.y & 0xffff0000u)};
                const f32x4 xo1 = f32in ? (f32x4){__uint_as_float(r1.x), __uint_as_float(r1.y), __uint_as_float(r1.z), __uint_as_float(r1.w)}
                                        : (f32x4){__uint_as_float(r0.z << 16), __uint_as_float(r0.z & 0xffff0000u), __uint_as_float(r0.w << 16), __uint_as_float(r0.w & 0xffff0000u)};
                const f32x4 xn0 = xo0 + gvv[bj][0] * acc[ai][bj][m][0], xn1 = xo1 + gvv[bj][1] * acc[ai][bj][m][1];
                u32x4 w; w.x = pg8::cvt_pk_bf16(xn0[0], xn0[1]); w.y = pg8::cvt_pk_bf16(xn0[2], xn0[3]); w.z = pg8::cvt_pk_bf16(xn1[0], xn1[1]); w.w = pg8::cvt_pk_bf16(xn1[2], xn1[3]);
                *(u32x4*)(ob + off + bj * 128) = w; }
            asm volatile("" ::: "memory");
            if (g + 3 < 8) { ER_LOAD(g + 3); }
            asm volatile("" ::: "memory"); }
#undef ER_LOAD
    }
};
struct EpiSwi {
    static constexpr bool PERM = true, AFTER_DRAIN = false;
    bf16* O; int ldc;
    __device__ __forceinline__ void operator()(const f32x4 (&acc)[2][2][4][2], const pg8::Unit& u, int wr, int wc, int fr, int fq) const {
        const int row0 = u.pm * 256 + wr * 64 + fr, col0 = u.pn * 128 + wc * 32 + 8 * fq;
#pragma unroll
        for (int ai = 0; ai < 2; ++ai)
#pragma unroll
            for (int m = 0; m < 4; ++m) { bf16* rowp = O + (size_t)(row0 + ai * 128 + m * 16) * ldc + col0;
                float h[8];
#pragma unroll
                for (int n = 0; n < 2; ++n)
#pragma unroll
                    for (int j = 0; j < 4; ++j) { const float gt = acc[ai][0][m][n][j], up = acc[ai][1][m][n][j]; h[n * 4 + j] = gt * fsigmoid(gt) * up; }
                u32x4 w; w.x = pg8::cvt_pk_bf16(h[0], h[1]); w.y = pg8::cvt_pk_bf16(h[2], h[3]); w.z = pg8::cvt_pk_bf16(h[4], h[5]); w.w = pg8::cvt_pk_bf16(h[6], h[7]);
                *(u32x4*)rowp = w; }
    }
};

template <int MAP>
__device__ __forceinline__ void tr_item(const float* W, int K, int N, bf16* WT, LAS float* scr, int item, int lane) {
    const int nblk = (N + 63) >> 6, kb = item / nblk, nb = item - kb * nblk, k0 = 64 * kb, n0 = 64 * nb;
    const int lr = lane >> 4, lc = 4 * (lane & 15); const bool okc = n0 + lc < N;
    f32x4 v[16];
#pragma unroll
    for (int i = 0; i < 16; ++i) v[i] = okc ? __builtin_nontemporal_load((const f32x4*)(W + (size_t)(k0 + 4 * i + lr) * N + n0 + lc)) : (f32x4){0.f, 0.f, 0.f, 0.f};
#pragma unroll
    for (int i = 0; i < 16; ++i) { const int kk = 4 * i + lr; *(LAS f32x4*)(scr + kk * 64 + (lc ^ (8 * (kk >> 3)))) = v[i]; }
    LDS_WAIT(); asm volatile("" ::: "memory");
    const int c = lane & 7;
#pragma unroll
    for (int i = 0; i < 8; ++i) { const int n = (lane >> 3) + 8 * i; const LAS float* sp = scr + (8 * c) * 64 + (n ^ (8 * c));
        u32x4 o; o.x = pk2(sp[0 * 64], sp[1 * 64]); o.y = pk2(sp[2 * 64], sp[3 * 64]); o.z = pk2(sp[4 * 64], sp[5 * 64]); o.w = pk2(sp[6 * 64], sp[7 * 64]);
        const int nn = n0 + n; const int orow = MAP == 0 ? nn : (256 * (nn >> 7) + (nn & 127) + (MAP == 2 ? 128 : 0));
        if (nn < N) *(u32x4*)(WT + (size_t)orow * K + k0 + 8 * c) = o; }
    LDS_WAIT(); asm volatile("" ::: "memory");
}
__device__ __forceinline__ void p0_prologue(Frame& F) {
    PH_LOCALS(F);
    LAS float* scr = (LAS float*)(F.lds + wave * 16384);
    const int gw = bx * NWAVES + wave, NGW = G * NWAVES;
    constexpr int I_IN = (D / 64) * ((PIN + 63) / 64), I_OUT = (D / 64) * (D / 64), I_GU = (D / 64) * (DFF / 64), I_DN = (DFF / 64) * (D / 64);
    constexpr int PL = I_IN + I_OUT + 2 * I_GU + I_DN;
    for (int repc = 0; repc < (PROBE_DUP == 31 ? 4 : 1); ++repc)
    for (int it = gw; it < NL * PL; it += NGW) {
        const int l = it / PL; int r = it % PL;
        if (r < I_IN) { tr_item<0>(F.in[I_WIN] + (size_t)l * D * PIN, D, PIN, (bf16*)(F.ws + WS_WIN + l * SZ_WIN), scr, r, lane); continue; } r -= I_IN;
        if (r < I_OUT) { tr_item<0>(F.in[I_WOUT] + (size_t)l * D * D, D, D, (bf16*)(F.ws + WS_WOUT + l * SZ_WOUT), scr, r, lane); continue; } r -= I_OUT;
        if (r < I_GU) { tr_item<1>(F.in[I_WG] + (size_t)l * D * DFF, D, DFF, (bf16*)(F.ws + WS_WGU + l * SZ_WGU), scr, r, lane); continue; } r -= I_GU;
        if (r < I_GU) { tr_item<2>(F.in[I_WU] + (size_t)l * D * DFF, D, DFF, (bf16*)(F.ws + WS_WGU + l * SZ_WGU), scr, r, lane); continue; } r -= I_GU;
        tr_item<0>(F.in[I_WD] + (size_t)l * DFF * D, DFF, D, (bf16*)(F.ws + WS_WD + l * SZ_WD), scr, r, lane);
    }
    const int gt = bx * 512 + tid, NGT = G * 512;
    { constexpr int PADV = (PINP - PIN) * D * 2 / 16;
      for (int i = gt; i < NL * PADV; i += NGT) { const int l = i / PADV, r = i % PADV; ((u32x4*)(F.ws + WS_WIN + l * SZ_WIN + (size_t)PIN * D * 2))[r] = (u32x4){0u, 0u, 0u, 0u}; } }
    { bf16* w2t = (bf16*)(F.ws + WS_W2T); bf16* a2t = (bf16*)(F.ws + WS_A2T); bf16* g2t = (bf16*)(F.ws + WS_G2T); bf16* wsp = (bf16*)(F.ws + WS_WSP);
      for (int i = gt; i < NL * 2 * 8 * 1024; i += NGT) { const int n = i & 1023, kg = (i >> 10) & 7, ld = i >> 13; float w[8], a[8];
#pragma unroll
          for (int j = 0; j < 8; ++j) { const size_t o = ((size_t)ld * 64 + 8 * kg + j) * 1024 + n; w[j] = F.in[I_W2][o]; a[j] = F.in[I_A2][o]; }
          const size_t fo = ((((size_t)ld * 64 + (n >> 4)) * 2 + (kg >> 2)) * 64 + 16 * (kg & 3) + (n & 15)) * 8;
          *(u32x4*)(w2t + fo) = pack8(w); *(u32x4*)(a2t + fo) = pack8(a); }
      for (int i = gt; i < NL * 20 * 1024; i += NGT) { const int n = i & 1023, kg = (i >> 10) % 20, l = (i >> 10) / 20; float g[8];
#pragma unroll
          for (int j = 0; j < 8; ++j) g[j] = F.in[I_G2][((size_t)l * 160 + 8 * kg + j) * 1024 + n];
          *(u32x4*)(g2t + ((size_t)l * 1024 + n) * 160 + 8 * kg) = pack8(g); }
      for (int i = gt; i < NL * 8 * 128 * 128; i += NGT) wsp[i] = (bf16)f2bf(F.in[I_WSP][i]); }
    __syncthreads();
    { LAS float* sv = (LAS float*)F.lds;
      LAS float* red = (LAS float*)(F.lds + 40960);
      for (int i = tid; i < 5 * D; i += 512) { const int r = i / D, k = i % D; const float c = r == 0 ? F.in[I_CCTX][k] : F.in[I_C][(r - 1) * D + k]; sv[i] = c * fsigmoid(c); }
      __syncthreads();
      float* mod = (float*)(F.ws + WS_MOD);
      const int c4 = tid & 15, kg = tid >> 4;
      for (int repm = 0; repm < (PROBE_DUP == 32 ? 4 : 1); ++repm)
      for (int item = bx; item < NL * (MODW / 64); item += G) {
          const int l = item / (MODW / 64), n0 = (item % (MODW / 64)) * 64;
          const float* W = F.in[I_WMOD] + (size_t)l * D * MODW + n0 + 4 * c4;
          f32x4 a[5];
#pragma unroll
          for (int r = 0; r < 5; ++r) a[r] = (f32x4){0.f, 0.f, 0.f, 0.f};
#pragma unroll 4
          for (int i = 0; i < 64; ++i) { const int k = i * 32 + kg; const f32x4 w = *(const f32x4*)(W + (size_t)k * MODW);
#pragma unroll
              for (int r = 0; r < 5; ++r) a[r] += w * sv[r * D + k]; }
#pragma unroll
          for (int r = 0; r < 5; ++r) *(LAS f32x4*)(red + (kg * 5 + r) * 64 + 4 * c4) = a[r];
          __syncthreads();
          if (tid < 320) { const int r = tid >> 6, n = tid & 63; float s = 0.f;
#pragma unroll 8
              for (int g = 0; g < 32; ++g) s += red[(g * 5 + r) * 64 + n];
              mod[((size_t)l * 5 + r) * MODW + n0 + n] = s + F.in[I_BMOD][(size_t)l * MODW + n0 + n]; }
          __syncthreads();
      } }
}

__device__ __forceinline__ void p_adaln(Frame& F, int l, int which, const float* xlo, const float* xhi, const bf16* xb) {
    PH_LOCALS(F); PH_LAYER(l);
    const int gw = bx * NWAVES + wave, NGW = G * NWAVES;
    const float* ng = (which == 0 ? F.in[I_N1G] : F.in[I_N2G]) + (size_t)l * D;
    const int shoff = which == 0 ? 0 : 3 * D, scoff = shoff + D;
    const float* mod = (const float*)(F.ws + WS_MOD);
    bf16* H = (bf16*)(F.ws + WS_H);
    const int rpw = (M + NGW - 1) / NGW, rbeg = gw * rpw, rend = rbeg + rpw < M ? rbeg + rpw : M;
    f32x4 ca[8], cb[8]; int mcur = -1;
    if (xb == nullptr) {
        f32x4 nx[8];
#define AL_ROWPTR(row_) ((row_) < MCTX ? xlo + (size_t)(row_) * D : xhi + (size_t)((row_) - MCTX) * D)
        if (rbeg < rend) { const float* xr = AL_ROWPTR(rbeg);
#pragma unroll
            for (int j = 0; j < 8; ++j) nx[j] = *(const f32x4*)(xr + 4 * lane + 256 * j); }
        for (int row = rbeg; row < rend; ++row) {
            const int midx = row < MCTX ? 0 : 1 + ((row - MCTX) >> 12);
            if (midx != mcur) { mcur = midx; const float* md = mod + ((size_t)l * 5 + midx) * MODW;
#pragma unroll
                for (int j = 0; j < 8; ++j) { const int c = 4 * lane + 256 * j; ca[j] = *(const f32x4*)(ng + c) * (*(const f32x4*)(md + scoff + c) + 1.0f); cb[j] = *(const f32x4*)(md + shoff + c); } }
            f32x4 v[8]; float ss = 0.f;
#pragma unroll
            for (int j = 0; j < 8; ++j) { v[j] = nx[j]; ss += (v[j].x * v[j].x + v[j].y * v[j].y) + (v[j].z * v[j].z + v[j].w * v[j].w); }
            { const int nr = row + 1 < rend ? row + 1 : row; const float* xr = AL_ROWPTR(nr);
#pragma unroll
              for (int j = 0; j < 8; ++j) nx[j] = *(const f32x4*)(xr + 4 * lane + 256 * j); }
            WAVE_SUM(ss); const float rstd = __builtin_amdgcn_rsqf(ss * (1.0f / D) + RMS_EPS);
#pragma unroll
            for (int j = 0; j < 8; ++j) { const int c = 4 * lane + 256 * j;
                const f32x4 o = v[j] * rstd * ca[j] + cb[j];
                u32x2 w; w.x = pk2(o.x, o.y); w.y = pk2(o.z, o.w);
                *(u32x2*)(H + (size_t)row * D + c) = w; }
        }
#undef AL_ROWPTR
    } else {
        u32x4 nx[4];
        if (rbeg < rend) { const bf16* xr = xb + (size_t)rbeg * D;
#pragma unroll
            for (int j = 0; j < 4; ++j) nx[j] = *(const u32x4*)(xr + 8 * lane + 512 * j); }
        for (int row = rbeg; row < rend; ++row) {
            const int midx = row < MCTX ? 0 : 1 + ((row - MCTX) >> 12);
            if (midx != mcur) { mcur = midx; const float* md = mod + ((size_t)l * 5 + midx) * MODW;
#pragma unroll
                for (int j = 0; j < 8; ++j) { const int c = 8 * lane + 512 * (j >> 1) + 4 * (j & 1); ca[j] = *(const f32x4*)(ng + c) * (*(const f32x4*)(md + scoff + c) + 1.0f); cb[j] = *(const f32x4*)(md + shoff + c); } }
            float v[4][8]; float ss = 0.f;
#pragma unroll
            for (int j = 0; j < 4; ++j) { unpack8(nx[j], v[j]);
#pragma unroll
                for (int e = 0; e < 8; ++e) ss += v[j][e] * v[j][e]; }
            { const int nr = row + 1 < rend ? row + 1 : row; const bf16* xr = xb + (size_t)nr * D;
#pragma unroll
              for (int j = 0; j < 4; ++j) nx[j] = *(const u32x4*)(xr + 8 * lane + 512 * j); }
            WAVE_SUM(ss); const float rstd = __builtin_amdgcn_rsqf(ss * (1.0f / D) + RMS_EPS);
#pragma unroll
            for (int j = 0; j < 4; ++j) { float o[8];
#pragma unroll
                for (int e = 0; e < 4; ++e) { o[e] = v[j][e] * rstd * ca[2 * j][e] + cb[2 * j][e]; o[4 + e] = v[j][4 + e] * rstd * ca[2 * j + 1][e] + cb[2 * j + 1][e]; }
                *(u32x4*)(H + (size_t)row * D + 8 * lane + 512 * j) = pack8(o); }
        }
    }
}

__device__ __forceinline__ void load_shifted8(const bf16* P, const float* mu, int row, int col, float (&o)[8]) {
    float g[8]; unpack8(*(const u32x4*)(P + (size_t)row * PINP + col), g);
    float a[8];
#pragma unroll
    for (int j = 0; j < 8; ++j) a[j] = g[j];
    int nrow[4]; bool has[4]; int nn;
    if (row < MCTX) { const int t = row & 255; nn = 2; nrow[0] = row - 1; has[0] = t > 0; nrow[1] = row + 1; has[1] = t < 255; nrow[2] = row; has[2] = false; nrow[3] = row; has[3] = false; }
    else { const int t = (row - MCTX) & 4095, gc = t & 63, gr = t >> 6; nn = 4;
        nrow[0] = row - 1; has[0] = gc > 0; nrow[1] = row + 1; has[1] = gc < 63; nrow[2] = row - 64; has[2] = gr > 0; nrow[3] = row + 64; has[3] = gr < 63; }
#pragma unroll
    for (int q = 0; q < 4; ++q) {
        if (q < nn) {
            float nb[8];
            if (has[q]) unpack8(*(const u32x4*)(P + (size_t)nrow[q] * PINP + col), nb);
            else {
#pragma unroll
                for (int j = 0; j < 8; ++j) nb[j] = 0.f; }
            const f32x4 m0 = *(const f32x4*)(mu + q * CSH + col), m1 = *(const f32x4*)(mu + q * CSH + col + 4);
#pragma unroll
            for (int j = 0; j < 4; ++j) { a[j] += m0[j] * (nb[j] - g[j]); a[4 + j] += m1[j] * (nb[4 + j] - g[4 + j]); }
        }
    }
#pragma unroll
    for (int j = 0; j < 8; ++j) o[j] = a[j];
}
__device__ __forceinline__ int sj_lane(int lane) { asm volatile("" : "+v"(lane)); return lane; }
__device__ __forceinline__ void p_shift(Frame& F, int l) {
    PH_LOCALS(F); PH_LAYER(l);
    const bf16* P = (const bf16*)(F.ws + WS_P); bf16* PS = (bf16*)(F.ws + WS_PS); bf16* LORA = (bf16*)(F.ws + WS_LORA);
    const float* mu = F.in[I_MU] + (size_t)l * 4 * CSH;
    constexpr int CG = CSH / 8;
#define SH_UNPK(q_, v_) do { v_[0] = (f32x2){__uint_as_float((q_).x << 16), __uint_as_float((q_).x & 0xffff0000u)}; v_[1] = (f32x2){__uint_as_float((q_).y << 16), __uint_as_float((q_).y & 0xffff0000u)}; \
        v_[2] = (f32x2){__uint_as_float((q_).z << 16), __uint_as_float((q_).z & 0xffff0000u)}; v_[3] = (f32x2){__uint_as_float((q_).w << 16), __uint_as_float((q_).w & 0xffff0000u)}; } while (0)
#define SH_LDMU(col_, m_, c0_, four_) do { _Pragma("unroll") for (int q = 0; q < 4; ++q) { const f32x4 a_ = *(const f32x4*)(mu + q * CSH + (col_)), b_ = *(const f32x4*)(mu + q * CSH + (col_) + 4); \
            m_[q][0] = (f32x2){a_[0], a_[1]}; m_[q][1] = (f32x2){a_[2], a_[3]}; m_[q][2] = (f32x2){b_[0], b_[1]}; m_[q][3] = (f32x2){b_[2], b_[3]}; } \
        _Pragma("unroll") for (int e = 0; e < 4; ++e) c0_[e] = (f32x2){1.f, 1.f} - ((four_) ? ((m_[0][e] + m_[1][e]) + (m_[2][e] + m_[3][e])) : (m_[0][e] + m_[1][e])); } while (0)
    const u32x4 Z4 = (u32x4){0u, 0u, 0u, 0u};
    for (int u0 = bx; u0 < 256; u0 += G) {
        const int u = G == 256 ? ((u0 & 7) >> 1) * 64 + 32 * (u0 & 1) + (u0 >> 3) : u0;
        const int gr = u & 63, rowb = MCTX + (u >> 6) * 4096 + gr * 64;
        const bf16* pu_ = P + (size_t)rowb * PINP;
        { u32x4 dn[3][4], lf[2][4], rt[2][4], ru, rc; f32x2 m[4][4], c0[4], up[4], cur[4];
#define SJ_COL(it_) (8 * ((((3 * wave + ((it_) >> 2)) >> 2) * 64) + sj_lane(lane)))
#define SJ_G0(it_) (16 * ((3 * wave + ((it_) >> 2)) & 3) + 4 * ((it_) & 3))
#define SJ_LOAD(it_, b_) do { const int g_ = SJ_G0(it_); const bf16* pr0_ = pu_ + (size_t)g_ * PINP + SJ_COL(it_); \
            _Pragma("unroll") for (int i = 0; i < 4; ++i) { const int gc = g_ + i; const bf16* pr = pr0_ + (size_t)i * PINP; \
                dn[b_][i] = gc < 63 ? *(const u32x4*)(pr + PINP) : Z4; } \
            if (((it_) & 3) == 0) { ru = g_ > 0 ? *(const u32x4*)(pr0_ - PINP) : Z4; rc = *(const u32x4*)pr0_; } } while (0)
#define SJ_LOADB(it_, b_) do { const int g_ = SJ_G0(it_); const bf16* pr0_ = pu_ + (size_t)g_ * PINP + SJ_COL(it_); \
            _Pragma("unroll") for (int i = 0; i < 4; ++i) { const bf16* pr = pr0_ + (size_t)i * PINP; \
                lf[b_][i] = gr > 0 ? *(const u32x4*)(pr - (size_t)64 * PINP) : Z4; rt[b_][i] = gr < 63 ? *(const u32x4*)(pr + (size_t)64 * PINP) : Z4; } } while (0)
          SJ_LOAD(0, 0); SJ_LOADB(0, 0); SJ_LOAD(1, 1);
#pragma unroll
          for (int it = 0; it < 12; ++it) { const int b = it & 1, b3 = it % 3, col = SJ_COL(it), g0 = SJ_G0(it);
              if (it + 2 < 12) SJ_LOAD(it + 2, (it + 2) % 3);
              if (it + 1 < 12) SJ_LOADB(it + 1, (it + 1) & 1);
              if ((it & 3) == 0) { SH_LDMU(col, m, c0, true); SH_UNPK(ru, up); SH_UNPK(rc, cur); }
#pragma unroll
              for (int i = 0; i < 4; ++i) { f32x2 a[4], nb[4], dv[4];
#pragma unroll
                  for (int e = 0; e < 4; ++e) a[e] = c0[e] * cur[e] + m[0][e] * up[e];
                  SH_UNPK(lf[b][i], nb);
#pragma unroll
                  for (int e = 0; e < 4; ++e) a[e] += m[2][e] * nb[e];
                  SH_UNPK(rt[b][i], nb);
#pragma unroll
                  for (int e = 0; e < 4; ++e) a[e] += m[3][e] * nb[e];
                  SH_UNPK(dn[b3][i], dv);
#pragma unroll
                  for (int e = 0; e < 4; ++e) a[e] += m[1][e] * dv[e];
                  const int row = rowb + g0 + i;
                  *(u32x4*)(PS + (size_t)row * CSH + col) = (u32x4){pk2(a[0].x, a[0].y), pk2(a[1].x, a[1].y), pk2(a[2].x, a[2].y), pk2(a[3].x, a[3].y)};
#pragma unroll
                  for (int e = 0; e < 4; ++e) { up[e] = cur[e]; cur[e] = dv[e]; } } }
#undef SJ_LOAD
#undef SJ_LOADB
#undef SJ_G0
#undef SJ_COL
        }
        if (tid < 504) {
            const int rs = tid / 36, lg = tid - rs * 36, col = 3 * DA + 8 * lg; const int act = lg < LW / 8 ? 1 : (lg >= (LW + LAA) / 8 ? 2 : 0);
            f32x2 m[4][4], c0[4]; SH_LDMU(col, m, c0, true);
            u32x4 q5[2][5];
#define SL_LOAD(k_, b_) do { const int gc_ = rs + 14 * (k_) < 64 ? rs + 14 * (k_) : 63; const bf16* pr = pu_ + (size_t)gc_ * PINP + col; \
            q5[b_][0] = *(const u32x4*)pr; q5[b_][1] = gc_ > 0 ? *(const u32x4*)(pr - PINP) : Z4; q5[b_][2] = gc_ < 63 ? *(const u32x4*)(pr + PINP) : Z4; \
            q5[b_][3] = gr > 0 ? *(const u32x4*)(pr - (size_t)64 * PINP) : Z4; q5[b_][4] = gr < 63 ? *(const u32x4*)(pr + (size_t)64 * PINP) : Z4; } while (0)
            SL_LOAD(0, 0);
#pragma unroll
            for (int k = 0; k < 5; ++k) { const int gcx = rs + 14 * k, b = k & 1;
                if (k + 1 < 5) SL_LOAD(k + 1, (k + 1) & 1);
                f32x2 a[4], nb[4];
                SH_UNPK(q5[b][0], nb);
#pragma unroll
                for (int e = 0; e < 4; ++e) a[e] = c0[e] * nb[e];
#pragma unroll
                for (int q = 0; q < 4; ++q) { SH_UNPK(q5[b][1 + q], nb);
#pragma unroll
                    for (int e = 0; e < 4; ++e) a[e] += m[q][e] * nb[e]; }
                float o_[8] = {a[0].x, a[0].y, a[1].x, a[1].y, a[2].x, a[2].y, a[3].x, a[3].y};
                if (act == 1) {
#pragma unroll
                    for (int jx = 0; jx < 8; ++jx) o_[jx] = ftanh(o_[jx]); }
                else if (act == 2) {
#pragma unroll
                    for (int jx = 0; jx < 8; ++jx) o_[jx] = fsigmoid(o_[jx]); }
                const int row = rowb + gcx;
                if (gcx < 64) *(u32x4*)(LORA + ((((size_t)(row >> 4) * 9 + (lg >> 2)) * 64 + 16 * (lg & 3) + (row & 15)) << 3)) = pack8(o_); }
#undef SL_LOAD
        }
    }
    if (tid >= CG) return;
    { const int col = tid * 8; const int act = (col >= 3 * DA && col < 3 * DA + LW) ? 1 : (col >= 3 * DA + LW + LAA ? 2 : 0);
      f32x2 m[4][4], c0[4]; SH_LDMU(col, m, c0, false);
      const int rpw = (MCTX + G - 1) / G, rbeg = bx * rpw, rend = rbeg + rpw < MCTX ? rbeg + rpw : MCTX;
      for (int r0 = rbeg; r0 < rend; r0 += 8) {
          u32x4 raw[10];
#pragma unroll
          for (int i = 0; i < 10; ++i) { int r = r0 - 1 + i; r = r < 0 ? 0 : (r > MCTX - 1 ? MCTX - 1 : r); raw[i] = *(const u32x4*)(P + (size_t)r * PINP + col); }
#pragma unroll
          for (int i = 0; i < 8; ++i) { const int row = r0 + i; f32x2 a[4], nb[4];
              SH_UNPK(raw[i + 1], nb);
#pragma unroll
              for (int e = 0; e < 4; ++e) a[e] = c0[e] * nb[e];
              if ((row & 255) != 0) { SH_UNPK(raw[i], nb);
#pragma unroll
                  for (int e = 0; e < 4; ++e) a[e] += m[0][e] * nb[e]; }
              if ((row & 255) != 255) { SH_UNPK(raw[i + 2], nb);
#pragma unroll
                  for (int e = 0; e < 4; ++e) a[e] += m[1][e] * nb[e]; }
              float o_[8] = {a[0].x, a[0].y, a[1].x, a[1].y, a[2].x, a[2].y, a[3].x, a[3].y};
              if (act == 1) {
#pragma unroll
                  for (int jx = 0; jx < 8; ++jx) o_[jx] = ftanh(o_[jx]); }
              else if (act == 2) {
#pragma unroll
                  for (int jx = 0; jx < 8; ++jx) o_[jx] = fsigmoid(o_[jx]); }
              if (row < rend) {
                  if (col >= 3 * DA) { const int cgl = (col - 3 * DA) >> 3; *(u32x4*)(LORA + ((((size_t)(row >> 4) * 9 + (cgl >> 2)) * 64 + 16 * (cgl & 3) + (row & 15)) << 3)) = pack8(o_); }
                  else *(u32x4*)(PS + (size_t)row * CSH + col) = pack8(o_); } }
      } }
#undef SH_UNPK
#undef SH_LDMU
}

#define F4Z ((f32x4){0.f, 0.f, 0.f, 0.f})
__device__ __forceinline__ u32x2 pk4(const f32x4 a) { u32x2 w; w.x = pk2(a[0], a[1]); w.y = pk2(a[2], a[3]); return w; }
#define LBAR() do { asm volatile("s_waitcnt lgkmcnt(0)" ::: "memory"); __builtin_amdgcn_s_barrier(); asm volatile("" ::: "memory"); } while (0)
constexpr int VTS = 136;
typedef short s16x4g __attribute__((ext_vector_type(4)));
__device__ __forceinline__ bf16x8 frag_tr_ld(const LAS bf16* X, int ld, int kbase, int c0, int fr, int fq) {
    const LAS bf16* p = X + (kbase + 8 * fq + (fr >> 2)) * ld + c0 + 4 * (fr & 3);
    const s16x4g lo = __builtin_amdgcn_ds_read_tr16_b64_v4i16((LAS s16x4g*)p);
    const s16x4g hi = __builtin_amdgcn_ds_read_tr16_b64_v4i16((LAS s16x4g*)(p + 4 * ld));
    return (bf16x8){lo[0], lo[1], lo[2], lo[3], hi[0], hi[1], hi[2], hi[3]};
}
__device__ __forceinline__ void p_gmlp(Frame& F, int l, int slot, int nslots) {
    PH_LOCALS(F); PH_LAYER(l); (void)bx; (void)G;
    const bf16* P = (const bf16*)(F.ws + WS_P); bf16* O = (bf16*)(F.ws + WS_O);
    const bf16* wsp = (const bf16*)(F.ws + WS_WSP) + (size_t)l * 8 * 128 * 128;
    LAS bf16* VN = (LAS bf16*)F.lds;
    LAS bf16* ST = (LAS bf16*)(F.lds + 34816);
    const int fr = lane & 15, fq = lane >> 4;
    constexpr int NIT = (M / 128) * NG;
    const int jrow = tid >> 2, q4 = tid & 3;
    u32x4 pvv[4]; f32x4 lgv[8], lbv[8]; bf16x8 bw[4]; float bsp = 0.f; int gcur = -1;
#define GM_ISSUE(item_) do { const bf16* src_ = P + (size_t)(((item_) >> 3) * 128 + jrow) * PINP + CSH + DB + 128 * ((item_) & 7) + 32 * q4; \
        _Pragma("unroll") for (int i_ = 0; i_ < 4; ++i_) pvv[i_] = *(const u32x4*)(src_ + 8 * i_); } while (0)
    if (slot < 0) return;
    LBAR();
    if (slot < NIT) GM_ISSUE(slot);
    for (int item = slot; item < NIT; item += nslots) {
        const int cb = item >> 3, g = item & 7, R0 = cb * 128;
        u32x4 pu[4]; { const bf16* up = P + (size_t)(R0 + jrow) * PINP + CSH + 128 * g + 32 * q4;
#pragma unroll
            for (int i = 0; i < 4; ++i) pu[i] = *(const u32x4*)(up + 8 * i); }
        if (g != gcur) { gcur = g; const bf16* wa = wsp + ((size_t)g * 128 + 16 * wave + fr) * 128 + 8 * fq;
#pragma unroll
            for (int ks = 0; ks < 4; ++ks) bw[ks] = *(const bf16x8*)(wa + 32 * ks);
            bsp = F.in[I_BSP][((size_t)l * 8 + g) * 128 + jrow];
            const float* lg = F.in[I_LNG] + ((size_t)l * 8 + g) * 128 + 32 * q4; const float* lb = F.in[I_LNB] + ((size_t)l * 8 + g) * 128 + 32 * q4;
#pragma unroll
            for (int i = 0; i < 8; ++i) { lgv[i] = *(const f32x4*)(lg + 4 * i); lbv[i] = *(const f32x4*)(lb + 4 * i); } }
        { float v[32];
#pragma unroll
          for (int i = 0; i < 4; ++i) { float f[8]; unpack8(pvv[i], f);
#pragma unroll
              for (int jj = 0; jj < 8; ++jj) v[8 * i + jj] = f[jj]; }
          float s = 0.f;
#pragma unroll
          for (int i = 0; i < 32; ++i) s += v[i];
          s += SHX(s, 1); s += SHX(s, 2);
          const float mean = s * (1.0f / 128.0f); float qq = 0.f;
#pragma unroll
          for (int i = 0; i < 32; ++i) { v[i] -= mean; qq += v[i] * v[i]; }
          qq += SHX(qq, 1); qq += SHX(qq, 2);
          const float rstd = __builtin_amdgcn_rsqf(qq * (1.0f / 128.0f) + LN_EPS);
#pragma unroll
          for (int i = 0; i < 4; ++i) { float o[8]; const f32x4 g0 = lgv[2 * i], g1 = lgv[2 * i + 1], b0 = lbv[2 * i], b1 = lbv[2 * i + 1];
#pragma unroll
              for (int jj = 0; jj < 4; ++jj) { o[jj] = v[8 * i + jj] * rstd * g0[jj] + b0[jj]; o[4 + jj] = v[8 * i + 4 + jj] * rstd * g1[jj] + b1[jj]; }
              *(LAS u32x4*)(VN + jrow * VTS + 32 * q4 + 8 * i) = pack8(o); } }
        if (item + nslots < NIT) GM_ISSUE(item + nslots);
        LBAR();
#pragma unroll
        for (int mt = 0; mt < 8; ++mt) { f32x4 acc = F4Z;
#pragma unroll
            for (int ks = 0; ks < 4; ++ks) acc = __builtin_amdgcn_mfma_f32_16x16x32_bf16(frag_tr_ld(VN, VTS, 32 * ks, 16 * mt, fr, fq), bw[ks], acc, 0, 0, 0);
            *(LAS u32x2*)(ST + (16 * wave + fr) * VTS + 16 * mt + 4 * fq) = pk4(acc); }
        LBAR();
        { bf16* op = O + (size_t)(R0 + jrow) * D + DA + 128 * g + 32 * q4;
#pragma unroll
          for (int i = 0; i < 4; ++i) { float sv[8], uv[8], o[8]; unpack8(*(const LAS u32x4*)(ST + jrow * VTS + 32 * q4 + 8 * i), sv); unpack8(pu[i], uv);
#pragma unroll
              for (int jj = 0; jj < 8; ++jj) o[jj] = uv[jj] * (sv[jj] + bsp);
              *(u32x4*)(op + 8 * i) = pack8(o); } }
    }
    LBAR();
#undef GM_ISSUE
}

constexpr int T16B = 9216, LD16 = 72, LD32 = 68;
#define SLOT(i) ((LAS bf16*)(lds + (i) * T16B))
#define SLOTF(i) ((LAS float*)(lds + (i) * T16B))
template <int NK>
__device__ __forceinline__ f32x4 tile_mm(const LAS bf16* A, int lda, const LAS bf16* B, int ldb, int fr, int fq, f32x4 acc) {
#pragma unroll
    for (int ks = 0; ks < NK; ++ks) { const bf16x8 a = *(const LAS bf16x8*)(A + fr * lda + 8 * fq + 32 * ks); const bf16x8 b = *(const LAS bf16x8*)(B + fr * ldb + 8 * fq + 32 * ks);
        acc = __builtin_amdgcn_mfma_f32_16x16x32_bf16(a, b, acc, 0, 0, 0); }
    return acc;
}
__device__ __forceinline__ void st_nat(LAS bf16* dst, int n0, int m0, int fr, int fq, const f32x4 a) { *(LAS u32x2*)(dst + (n0 + fr) * LD16 + m0 + 4 * fq) = pk4(a); }
__device__ __forceinline__ void st_rm(LAS bf16* dst, int n0, int m0, int fr, int fq, const f32x4 a) {
#pragma unroll
    for (int r = 0; r < 4; ++r) dst[(m0 + 4 * fq + r) * LD16 + n0 + fr] = (bf16)f2bf(a[r]); }
__device__ __forceinline__ f32x4 ld4bf(const LAS bf16* p) { const u32x2 w = *(const LAS u32x2*)p; return (f32x4){__uint_as_float(w.x << 16), __uint_as_float(w.x & 0xffff0000u), __uint_as_float(w.y << 16), __uint_as_float(w.y & 0xffff0000u)}; }

__device__ __forceinline__ int fm_off(int n0, int m0, int fr, int fq) { return ((((n0 >> 4) * 2 + (m0 >> 5)) * 64 + (2 * ((m0 >> 4) & 1) + (fq >> 1)) * 16 + fr) << 3) + 4 * (fq & 1); }
typedef short s16x4 __attribute__((ext_vector_type(4)));
__device__ __forceinline__ bf16x8 frag_tr(const LAS bf16* X, int kbase, int c0, int fr, int fq) {
    const LAS bf16* p = X + (kbase + 8 * fq + (fr >> 2)) * LD16 + c0 + 4 * (fr & 3);
    const s16x4 lo = __builtin_amdgcn_ds_read_tr16_b64_v4i16((LAS s16x4*)p);
    const s16x4 hi = __builtin_amdgcn_ds_read_tr16_b64_v4i16((LAS s16x4*)(p + 4 * LD16));
    return (bf16x8){lo[0], lo[1], lo[2], lo[3], hi[0], hi[1], hi[2], hi[3]};
}
__device__ __forceinline__ bf16x8 frag_rm(const LAS bf16* X, int r0, int ks, int fr, int fq) { return *(const LAS bf16x8*)(X + (r0 + fr) * LD16 + 8 * fq + 32 * ks); }
__device__ __forceinline__ f32x4 mm2(const bf16x8 (&a)[2], const bf16x8 (&b)[2], f32x4 acc) {
    acc = __builtin_amdgcn_mfma_f32_16x16x32_bf16(a[0], b[0], acc, 0, 0, 0); return __builtin_amdgcn_mfma_f32_16x16x32_bf16(a[1], b[1], acc, 0, 0, 0); }
__device__ __forceinline__ bf16x8 as_frag(const u32x4 q) { return __builtin_bit_cast(bf16x8, q); }

__device__ __forceinline__ void p_chunkA(Frame& F, int l, const bool fixh) {
    PH_LOCALS(F); PH_LAYER(l);
    LAS unsigned char* lds = F.lds;
    const int lane0 = lane, lane00 = lane;
#define STG int lane_ = lane0; asm volatile("" : "+v"(lane_)); const int lane = lane_, fr = lane_ & 15, fq = lane_ >> 4, tid = wave * 64 + lane_, mt = wave >> 1, m0 = 16 * mt, np = (wave & 1) * 2; \
    (void)lane; (void)fr; (void)fq; (void)tid; (void)mt; (void)m0; (void)np;
    const bf16* PS = (const bf16*)(F.ws + WS_PS);
    const bf16* w2t = (const bf16*)(F.ws + WS_W2T) + (size_t)l * 2 * 1024 * 64;
    const bf16* a2t = (const bf16*)(F.ws + WS_A2T) + (size_t)l * 2 * 1024 * 64;
    const bf16* g2t = (const bf16*)(F.ws + WS_G2T) + (size_t)l * 1024 * 160;
    bf16* GATE = (bf16*)(F.ws + WS_GATE); float* BONUS = (float*)(F.ws + WS_BONUS);
    LAS float* gC = (LAS float*)(lds + 14 * T16B);
    LAS float* BT = (LAS float*)(lds + 14 * T16B + 256);
    u32x4 pf_w[2], pf_a[2], pf_g[5], pf_r, pf_k, pf_v; bf16x8 Bg[2][5], Bw[2][2], Ba[2][2]; float biw[2], bia[2];
#define CA_ISSUE(item_, d_) do { const int ci_ = (item_) >> 4, h_ = (item_) & 15, R0_ = ci_ * 64; int lane0 = lane00; asm volatile("" : "+v"(lane0)); \
        const bf16* arow_ = (const bf16*)(F.ws + WS_LORA) + ((((size_t)(R0_ >> 4) + (wave >> 1)) * 9 * 64 + lane0) << 3); \
        if ((d_) == 0) { pf_w[0] = *(const u32x4*)arow_; pf_w[1] = *(const u32x4*)(arow_ + 512); pf_a[0] = *(const u32x4*)(arow_ + 1024); pf_a[1] = *(const u32x4*)(arow_ + 1536);     \
            _Pragma("unroll") for (int ks_ = 0; ks_ < 5; ++ks_) { pf_g[ks_] = *(const u32x4*)(arow_ + 2048 + 512 * ks_); \
            if (!fixh) { _Pragma("unroll") for (int nn_ = 0; nn_ < 2; ++nn_) Bg[nn_][ks_] = *(const bf16x8*)(g2t + (size_t)(64 * h_ + 16 * ((wave & 1) * 2 + nn_) + (lane0 & 15)) * 160 + 8 * (lane0 >> 4) + 32 * ks_); } } } \
        _Pragma("unroll") for (int nn_ = 0; nn_ < 2; ++nn_) { const int n_ = 64 * h_ + 16 * ((wave & 1) * 2 + nn_) + (lane0 & 15); \
            if (!fixh) { biw[nn_] = F.in[I_W0][((size_t)l * 2 + (d_)) * DA + n_]; bia[nn_] = F.in[I_A0][((size_t)l * 2 + (d_)) * DA + n_]; } \
            _Pragma("unroll") for (int ks_ = 0; ks_ < 2; ++ks_) { const size_t fo_ = ((((size_t)(d_) * 64 + (n_ >> 4)) * 2 + ks_) * 64 + lane0) * 8; Bw[nn_][ks_] = *(const bf16x8*)(w2t + fo_); Ba[nn_][ks_] = *(const bf16x8*)(a2t + fo_); } } \
        const int tid_ = wave * 64 + lane0, tau_ = tid_ >> 3, pos_ = (d_) ? 63 - tau_ : tau_; const bf16* rrow_ = PS + (size_t)(R0_ + pos_) * CSH + 64 * h_ + (tid_ & 7) * 8; \
        pf_r = *(const u32x4*)rrow_; pf_k = *(const u32x4*)(rrow_ + DA); pf_v = *(const u32x4*)(rrow_ + 2 * DA); } while (0)
    float biw2[2][2], bia2[2][2];
    if (fixh) { int lane0 = lane00; asm volatile("" : "+v"(lane0));
#pragma unroll
        for (int dd_ = 0; dd_ < 2; ++dd_)
#pragma unroll
            for (int nn_ = 0; nn_ < 2; ++nn_) { const int n_ = 64 * (bx & 15) + 16 * ((wave & 1) * 2 + nn_) + (lane0 & 15); biw2[dd_][nn_] = F.in[I_W0][((size_t)l * 2 + dd_) * DA + n_]; bia2[dd_][nn_] = F.in[I_A0][((size_t)l * 2 + dd_) * DA + n_]; }
#pragma unroll
        for (int ks_ = 0; ks_ < 5; ++ks_)
#pragma unroll
            for (int nn_ = 0; nn_ < 2; ++nn_) Bg[nn_][ks_] = *(const bf16x8*)(g2t + (size_t)(64 * (bx & 15) + 16 * ((wave & 1) * 2 + nn_) + (lane0 & 15)) * 160 + 8 * (lane0 >> 4) + 32 * ks_); }
    if (bx < (M / 64) * NH) CA_ISSUE(bx, 0);
    int hcur = -1;
    LAS float* HC = (LAS float*)(lds + 14 * T16B + 1280);
    for (int item = bx; item < (M / 64) * NH; item += G) {
        const int ci = item >> 4, h = item & 15, R0 = ci * 64;
        { (void)hcur;
            LBAR();
            { const int t_ = wave * 64 + lane0; if (t_ < 192) { const int w_ = t_ >> 6, c_ = t_ & 63; HC[t_] = (w_ == 0 ? F.in[I_KK] : (w_ == 1 ? F.in[I_KA] : F.in[I_RK]))[(size_t)l * DA + 64 * h + c_]; } } }
#pragma unroll
        for (int d = 0; d < 2; ++d) {
            const size_t qi = ((size_t)ci * 16 + h) * 2 + d;
            const bf16x8 cBw[2][2] = {{Bw[0][0], Bw[0][1]}, {Bw[1][0], Bw[1][1]}}, cBa[2][2] = {{Ba[0][0], Ba[0][1]}, {Ba[1][0], Ba[1][1]}}; const float cbw[2] = {fixh ? biw2[d][0] : biw[0], fixh ? biw2[d][1] : biw[1]}, cba[2] = {fixh ? bia2[d][0] : bia[0], fixh ? bia2[d][1] : bia[1]};
            u32x4 cw[2] = {pf_w[0], pf_w[1]}, ca[2] = {pf_a[0], pf_a[1]}, cg[5] = {pf_g[0], pf_g[1], pf_g[2], pf_g[3], pf_g[4]}; const u32x4 cr = pf_r, ck = pf_k, cv = pf_v;
            for (int repA = 0; repA < (PROBE_SUB == 1 ? 2 : 1); ++repA) {
            { STG; LAS float* AL = SLOTF(5); LAS float* LW = SLOTF(7);
              bf16x8 aw[2], aa[2];
#pragma unroll
              for (int ks = 0; ks < 2; ++ks) { aw[ks] = as_frag(cw[ks]); aa[ks] = as_frag(ca[ks]); }
#pragma unroll
              for (int nn = 0; nn < 2; ++nn) { const int nl = 16 * (np + nn) + fr, n = 64 * h + nl;
                  const f32x4 accw = mm2(aw, cBw[nn], F4Z), acca = mm2(aa, cBa[nn], F4Z);
                  const float biasw = cbw[nn], biasa = cba[nn]; (void)n;
                  float lw[4], c[4];
#pragma unroll
                  for (int r = 0; r < 4; ++r) lw[r] = -0.8750345269f * fsigmoid(biasw + accw[r]);
                  if (d == 0) { c[0] = lw[0]; c[1] = c[0] + lw[1]; c[2] = c[1] + lw[2]; c[3] = c[2] + lw[3]; }
                  else { c[3] = lw[3]; c[2] = c[3] + lw[2]; c[1] = c[2] + lw[1]; c[0] = c[1] + lw[0]; }
                  const float tot = d == 0 ? c[3] : c[0];
                  const float t1 = SHX(tot, 16), t2 = SHX(tot, 32), t3 = SHX(tot, 48);
                  float off;
                  { const int sg = d ? -1 : 1, q1 = fq ^ 1, q2 = fq ^ 2, q3 = fq ^ 3;
                    const int k1 = (sg * (q1 - fq)) >> 31, k2 = (sg * (q2 - fq)) >> 31, k3 = (sg * (q3 - fq)) >> 31;
                    off = (__int_as_float(__float_as_int(t1) & k1) + __int_as_float(__float_as_int(t2) & k2)) + __int_as_float(__float_as_int(t3) & k3); }
#pragma unroll
                  for (int r = 0; r < 4; ++r) { const int pos = m0 + 4 * fq + r, tau = d ? 63 - pos : pos;
                      LW[tau * LD32 + nl] = c[r] + off; AL[tau * LD32 + nl] = fsigmoid(biasa + acca[r]); }
                  if (fq == 0) BT[(d ? 3 - mt : mt) * 64 + nl] = (tot + t1) + (t2 + t3); }
              if (d == 0) {
                  bf16x8 ag[5];
#pragma unroll
                  for (int ks = 0; ks < 5; ++ks) ag[ks] = as_frag(cg[ks]);
#pragma unroll
                  for (int nn = 0; nn < 2; ++nn) { const int n = 64 * h + 16 * (np + nn) + fr; f32x4 acc = F4Z;
#pragma unroll
                      for (int ks = 0; ks < 5; ++ks) acc = __builtin_amdgcn_mfma_f32_16x16x32_bf16(ag[ks], Bg[nn][ks], acc, 0, 0, 0);
#pragma unroll
                      for (int r = 0; r < 4; ++r) SLOT(11)[(m0 + 4 * fq + r) * LD16 + 16 * (np + nn) + fr] = (bf16)f2bf(acc[r]); (void)n; } } }
            LBAR();
            { STG; const LAS float* AL = SLOTF(5); const LAS float* LW = SLOTF(7);
              const int tau = tid >> 3, c8 = (tid & 7) * 8, pos = d ? 63 - tau : tau, row = R0 + pos, blk = wave >> 1;
              f32x2 r[4], k[4];
              { const u32x4 q = cr; r[0] = (f32x2){__uint_as_float(q.x << 16), __uint_as_float(q.x & 0xffff0000u)}; r[1] = (f32x2){__uint_as_float(q.y << 16), __uint_as_float(q.y & 0xffff0000u)};
                r[2] = (f32x2){__uint_as_float(q.z << 16), __uint_as_float(q.z & 0xffff0000u)}; r[3] = (f32x2){__uint_as_float(q.w << 16), __uint_as_float(q.w & 0xffff0000u)}; }
              { const u32x4 q = ck; k[0] = (f32x2){__uint_as_float(q.x << 16), __uint_as_float(q.x & 0xffff0000u)}; k[1] = (f32x2){__uint_as_float(q.y << 16), __uint_as_float(q.y & 0xffff0000u)};
                k[2] = (f32x2){__uint_as_float(q.z << 16), __uint_as_float(q.z & 0xffff0000u)}; k[3] = (f32x2){__uint_as_float(q.w << 16), __uint_as_float(q.w & 0xffff0000u)}; }
              f32x2 offb[4], totC[4];
#pragma unroll
              for (int j = 0; j < 4; ++j) { offb[j] = (f32x2){0.f, 0.f}; totC[j] = (f32x2){0.f, 0.f}; }
#pragma unroll
              for (int b = 0; b < 4; ++b) { const f32x4 x0 = *(const LAS f32x4*)(BT + b * 64 + c8), x1 = *(const LAS f32x4*)(BT + b * 64 + c8 + 4);
                  const f32x2 y[4] = {{x0[0], x0[1]}, {x0[2], x0[3]}, {x1[0], x1[1]}, {x1[2], x1[3]}};
                  const float fb = b < blk ? 1.0f : 0.0f;
#pragma unroll
                  for (int j = 0; j < 4; ++j) { totC[j] += y[j]; offb[j] += y[j] * fb; } }
              f32x2 ckk[4], cka[4], crk[4];
              { const f32x4 a0 = *(const LAS f32x4*)(HC + c8), a1 = *(const LAS f32x4*)(HC + c8 + 4), b0 = *(const LAS f32x4*)(HC + 64 + c8), b1 = *(const LAS f32x4*)(HC + 64 + c8 + 4), c0 = *(const LAS f32x4*)(HC + 128 + c8), c1 = *(const LAS f32x4*)(HC + 128 + c8 + 4);
                ckk[0] = (f32x2){a0[0], a0[1]}; ckk[1] = (f32x2){a0[2], a0[3]}; ckk[2] = (f32x2){a1[0], a1[1]}; ckk[3] = (f32x2){a1[2], a1[3]};
                cka[0] = (f32x2){b0[0], b0[1]}; cka[1] = (f32x2){b0[2], b0[3]}; cka[2] = (f32x2){b1[0], b1[1]}; cka[3] = (f32x2){b1[2], b1[3]};
                crk[0] = (f32x2){c0[0], c0[1]}; crk[1] = (f32x2){c0[2], c0[3]}; crk[2] = (f32x2){c1[0], c1[1]}; crk[3] = (f32x2){c1[2], c1[3]}; }
              f32x2 kk[4], s2 = (f32x2){0.f, 0.f};
#pragma unroll
              for (int j = 0; j < 4; ++j) { kk[j] = k[j] * ckk[j]; s2 += kk[j] * kk[j]; }
              float ss = s2.x + s2.y;
              ss += SHX(ss, 1); ss += SHX(ss, 2); ss += SHX(ss, 4);
              const float rn = __builtin_amdgcn_rsqf(fmaxf(ss, 1e-24f));
              f32x2 alv[4], csv[4], csm[4];
              { const f32x4 a0 = *(const LAS f32x4*)(AL + tau * LD32 + c8), a1 = *(const LAS f32x4*)(AL + tau * LD32 + c8 + 4), c0 = *(const LAS f32x4*)(LW + tau * LD32 + c8), c1 = *(const LAS f32x4*)(LW + tau * LD32 + c8 + 4);
                const int tm = (tau & 15) ? tau - 1 : tau; f32x4 e0 = *(const LAS f32x4*)(LW + tm * LD32 + c8), e1 = *(const LAS f32x4*)(LW + tm * LD32 + c8 + 4);
                if ((tau & 15) == 0) { e0 = F4Z; e1 = F4Z; }
                alv[0] = (f32x2){a0[0], a0[1]}; alv[1] = (f32x2){a0[2], a0[3]}; alv[2] = (f32x2){a1[0], a1[1]}; alv[3] = (f32x2){a1[2], a1[3]};
                csv[0] = (f32x2){c0[0], c0[1]} + offb[0]; csv[1] = (f32x2){c0[2], c0[3]} + offb[1]; csv[2] = (f32x2){c1[0], c1[1]} + offb[2]; csv[3] = (f32x2){c1[2], c1[3]} + offb[3];
                csm[0] = (f32x2){e0[0], e0[1]} + offb[0]; csm[1] = (f32x2){e0[2], e0[3]} + offb[1]; csm[2] = (f32x2){e1[0], e1[1]} + offb[2]; csm[3] = (f32x2){e1[2], e1[3]} + offb[3]; }
              f32x2 at[4], rt[4], bt[4], kt[4], bh[4], kh[4], bon2 = (f32x2){0.f, 0.f};
#pragma unroll
              for (int j = 0; j < 4; ++j) { const f32x2 al = alv[j], cs = csv[j], dh = totC[j] - cs;
                  const f32x2 kkn = kk[j] * rn, kd = k[j] * ((al - 1.0f) * cka[j] + 1.0f), bb = kkn * al;
                  bon2 += r[j] * kd * crk[j];
                  const f32x2 encs = (f32x2){__builtin_amdgcn_exp2f(-cs.x), __builtin_amdgcn_exp2f(-cs.y)}, eh = (f32x2){__builtin_amdgcn_exp2f(dh.x), __builtin_amdgcn_exp2f(dh.y)};
                  const f32x2 ecm = (f32x2){__builtin_amdgcn_exp2f(csm[j].x), __builtin_amdgcn_exp2f(csm[j].y)}, ecs = (f32x2){__builtin_amdgcn_exp2f(cs.x), __builtin_amdgcn_exp2f(cs.y)};
                  at[j] = -(ecm * kkn); rt[j] = ecs * r[j]; bt[j] = encs * bb; kt[j] = encs * kd; bh[j] = eh * bb; kh[j] = eh * kd; }
              if (tau == 63) {
#pragma unroll
                  for (int j = 0; j < 4; ++j) { gC[c8 + 2 * j] = __builtin_amdgcn_exp2f(totC[j].x); gC[c8 + 2 * j + 1] = __builtin_amdgcn_exp2f(totC[j].y); } }
#define PK8V(a) ((u32x4){pk2(a[0].x, a[0].y), pk2(a[1].x, a[1].y), pk2(a[2].x, a[2].y), pk2(a[3].x, a[3].y)})
              *(LAS u32x4*)(SLOT(0) + tau * LD16 + c8) = PK8V(at); *(LAS u32x4*)(SLOT(1) + tau * LD16 + c8) = PK8V(rt);
              *(LAS u32x4*)(SLOT(2) + tau * LD16 + c8) = PK8V(bt); *(LAS u32x4*)(SLOT(3) + tau * LD16 + c8) = PK8V(kt);
              *(LAS u32x4*)(SLOT(4) + tau * LD16 + c8) = PK8V(bh); *(LAS u32x4*)(SLOT(9) + tau * LD16 + c8) = PK8V(kh);
#undef PK8V
              *(LAS u32x4*)(SLOT(10) + tau * LD16 + c8) = cv;
              if (d == 0) *(u32x4*)(GATE + (size_t)row * DA + 64 * h + c8) = *(const LAS u32x4*)(SLOT(11) + pos * LD16 + c8);
              float bon = bon2.x + bon2.y;
              bon += SHX(bon, 1); bon += SHX(bon, 2); bon += SHX(bon, 4);
              BONUS[((size_t)d * M + row) * NH + h] = bon; }
            LBAR();
            }
            { int nitem = d == 0 ? item : item + G; const int nd = d ^ 1; if (nitem >= (M / 64) * NH) nitem = item; CA_ISSUE(nitem, nd); }
            for (int repB = 0; repB < (PROBE_SUB == 2 ? 2 : 1); ++repB) {
            { STG; bf16x8 aB[2], aA[2], aK[2];
              const bool needU = np + 1 >= mt, needL = np <= mt;
#pragma unroll
              for (int ks = 0; ks < 2; ++ks) { if (needU) { aB[ks] = frag_rm(SLOT(2), m0, ks, fr, fq); aK[ks] = frag_rm(SLOT(3), m0, ks, fr, fq); } if (needL) aA[ks] = frag_rm(SLOT(0), m0, ks, fr, fq); }
#pragma unroll
              for (int nn = 0; nn < 2; ++nn) { const int nt = np + nn, n0 = 16 * nt, n = n0 + fr;
                  f32x4 p0 = F4Z, p1 = F4Z, p2 = F4Z, p3 = F4Z, p4 = F4Z, t0;
                  if (nt >= mt) { bf16x8 bA[2], bR[2];
#pragma unroll
                      for (int ks = 0; ks < 2; ++ks) { bA[ks] = frag_rm(SLOT(0), n0, ks, fr, fq); bR[ks] = frag_rm(SLOT(1), n0, ks, fr, fq); }
                      p0 = mm2(aB, bA, F4Z); p3 = mm2(aB, bR, F4Z); p4 = mm2(aK, bR, F4Z); }
                  if (nt <= mt) { bf16x8 bB[2], bK[2];
#pragma unroll
                      for (int ks = 0; ks < 2; ++ks) { bB[ks] = frag_rm(SLOT(2), n0, ks, fr, fq); bK[ks] = frag_rm(SLOT(3), n0, ks, fr, fq); }
                      p1 = mm2(aA, bB, F4Z); p2 = mm2(aA, bK, F4Z); }
                  t0 = p1;
                  if (nt == mt) {
#pragma unroll
                      for (int r = 0; r < 4; ++r) { const int m = m0 + 4 * fq + r;
                          p0[r] = m < n ? p0[r] : 0.f; p1[r] = n < m ? p1[r] : 0.f; p2[r] = n < m ? p2[r] : 0.f; p3[r] = m <= n ? p3[r] : 0.f; p4[r] = m <= n ? p4[r] : 0.f;
                          t0[r] = p1[r] + (m == n ? 1.0f : 0.f); } }
                  st_nat(SLOT(5), n0, m0, fr, fq, p0); st_nat(SLOT(6), n0, m0, fr, fq, p1); st_nat(SLOT(7), n0, m0, fr, fq, t0);
                  st_nat(SLOT(8), n0, m0, fr, fq, p2); st_nat(SLOT(11), n0, m0, fr, fq, p3); st_nat(SLOT(12), n0, m0, fr, fq, p4); } }
            LBAR();
#define MM1(a, b, c) __builtin_amdgcn_mfma_f32_16x16x32_bf16(a, b, c, 0, 0, 0)
            { STG; const int b = wave >> 2, bm0 = 32 * b + 16 * ((wave >> 1) & 1), bn0 = 32 * b + 16 * (wave & 1), oc = 32 * (1 - b) - 32 * b;
              const bf16x8 aT = frag_rm(SLOT(5), bm0, b, fr, fq), aR = frag_rm(SLOT(6), bm0, b, fr, fq), bR = frag_rm(SLOT(6), bn0, b, fr, fq), bT = frag_rm(SLOT(5), bn0, b, fr, fq);
              st_nat(SLOT(2), bn0, bm0, fr, fq, MM1(aT, bR, F4Z)); st_nat(SLOT(2), bn0, bm0 + oc, fr, fq, MM1(aR, bT, F4Z)); }
            LBAR();
#pragma unroll
            for (int kq = 1; kq <= 4; ++kq) {
                STG; const int b = wave >> 2, bm0 = 32 * b + 16 * ((wave >> 1) & 1), bn0 = 32 * b + 16 * (wave & 1), oc = 32 * (1 - b) - 32 * b;
                const int pin = (kq & 1) ? 2 : 3, pout = (kq & 1) ? 3 : 2, tin = (kq & 1) ? 7 : 13, tout = (kq & 1) ? 13 : 7;
                const bf16x8 aPT = frag_rm(SLOT(pin), bm0, 1 - b, fr, fq), bTn = frag_rm(SLOT(tin), bn0, b, fr, fq);
                st_nat(SLOT(tout), bn0, bm0, fr, fq, MM1(aPT, bTn, ld4bf(SLOT(tin) + (bn0 + fr) * LD16 + bm0 + 4 * fq)));
                if (kq < 4) { const bf16x8 aPR = frag_rm(SLOT(pin), bm0, b, fr, fq), bPR = frag_rm(SLOT(pin), bn0, b, fr, fq), bPT = frag_rm(SLOT(pin), bn0, 1 - b, fr, fq);
                    st_nat(SLOT(pout), bn0, bm0, fr, fq, MM1(aPT, bPR, F4Z));
                    st_nat(SLOT(pout), bn0, bm0 + oc, fr, fq, MM1(aPR, bPT, F4Z)); }
                LBAR();
            }
            { STG; if (wave < 4) { const int xm0 = 16 * ((wave >> 1) & 1), xn0 = 32 + 16 * (wave & 1);
                  const bf16x8 a = frag_rm(SLOT(6), xm0, 1, fr, fq), bb = frag_tr(SLOT(7), 32, xn0, fr, fq);
                  st_nat(SLOT(13), xn0, xm0, fr, fq, MM1(a, bb, F4Z)); } }
            LBAR();
            { STG; if (wave < 4) { const int tn0 = 32 + 16 * ((wave >> 1) & 1), tm0 = 16 * (wave & 1);
                  const bf16x8 a = frag_rm(SLOT(13), tn0, 0, fr, fq), bb = frag_rm(SLOT(7), tm0, 0, fr, fq);
                  st_nat(SLOT(7), tm0, tn0, fr, fq, MM1(a, bb, F4Z)); } }
            LBAR();
#undef MM1
            { STG; const int xt = wave, n0 = 16 * (xt & 3); bf16x8 b[2];
              if (xt < 4) { b[0] = frag_rm(SLOT(11), n0, 0, fr, fq); b[1] = frag_rm(SLOT(11), n0, 1, fr, fq); }
              else { b[0] = frag_tr(SLOT(4), 0, n0, fr, fq); b[1] = frag_tr(SLOT(4), 32, n0, fr, fq); }
#pragma unroll
              for (int mm = 0; mm < 4; ++mm) { bf16x8 a[2] = {frag_rm(SLOT(7), 16 * mm, 0, fr, fq), frag_rm(SLOT(7), 16 * mm, 1, fr, fq)};
                  st_nat(xt < 4 ? SLOT(5) : SLOT(6), n0, 16 * mm, fr, fq, mm2(a, b, F4Z)); } }
            LBAR();
            }
            for (int repC = 0; repC < (PROBE_SUB == 3 ? 2 : 1); ++repC) {
            { STG; bf16x8 aAt[2] = {frag_tr(SLOT(0), 0, m0, fr, fq), frag_tr(SLOT(0), 32, m0, fr, fq)}, aAk[2] = {frag_rm(SLOT(8), m0, 0, fr, fq), frag_rm(SLOT(8), m0, 1, fr, fq)};
              bf16* pyt = (bf16*)(F.ws + WS_PYT) + qi * 4096; bf16* qyt = (bf16*)(F.ws + WS_QYT) + qi * 4096; bf16* pst = (bf16*)(F.ws + WS_PST) + qi * 4096;
#pragma unroll
              for (int nn = 0; nn < 2; ++nn) { const int n0 = 16 * (np + nn), n = n0 + fr, mb = m0 + 4 * fq;
                  bf16x8 bRb[2] = {frag_rm(SLOT(5), n0, 0, fr, fq), frag_rm(SLOT(5), n0, 1, fr, fq)}, bBh[2] = {frag_rm(SLOT(6), n0, 0, fr, fq), frag_rm(SLOT(6), n0, 1, fr, fq)};
                  const f32x4 py = mm2(aAt, bRb, ld4bf(SLOT(1) + n * LD16 + mb)), qy = mm2(aAk, bRb, ld4bf(SLOT(12) + n * LD16 + mb));
                  f32x4 psi, qsi;
#pragma unroll
                  for (int r = 0; r < 4; ++r) { psi[r] = (mb + r == n) ? gC[n] : 0.f; qsi[r] = bf2f(SLOT(9)[(mb + r) * LD16 + n]); }
                  const f32x4 ps = mm2(aAt, bBh, psi), qs = mm2(aAk, bBh, qsi);
                  { const int fo = fm_off(n0, m0, fr, fq); *(u32x2*)(pyt + fo) = pk4(py); *(u32x2*)(qyt + fo) = pk4(qy); *(u32x2*)(pst + fo) = pk4(ps); }
                  st_nat(SLOT(2), n0, m0, fr, fq, qs); } }
            LBAR();
            { STG; bf16* nct = (bf16*)(F.ws + WS_NCT) + qi * 4096;
              bf16x8 a[2] = {frag_rm(SLOT(2), m0, 0, fr, fq), frag_rm(SLOT(2), m0, 1, fr, fq)};
#pragma unroll
              for (int nn = 0; nn < 2; ++nn) { const int n0 = 16 * (np + nn); bf16x8 b[2] = {frag_tr(SLOT(10), 0, n0, fr, fq), frag_tr(SLOT(10), 32, n0, fr, fq)};
                  *(u32x2*)(nct + ((((n0 >> 4) * 4 + mt) * 64 + lane) << 2)) = pk4(mm2(a, b, F4Z));
                  } }
            LBAR();
            }
        }
    }
#undef STG
#undef CA_ISSUE
}

__device__ __forceinline__ void p_chunkB(Frame& F, int l) {
    PH_LOCALS(F); PH_LAYER(l);
    const int fr = lane & 15, fq = lane >> 4;
    LAS bf16* Sl = (LAS bf16*)(F.lds + wave * 2304);
    const bf16* PST = (const bf16*)(F.ws + WS_PST); const bf16* NCT = (const bf16*)(F.ws + WS_NCT); bf16* SC = (bf16*)(F.ws + WS_SC);
    for (int cp = bx; cp < 64; cp += G) {
        const int cslot = wave >> 2, chain = 2 * cp + cslot, vb = wave & 3, b = chain >> 5, h = (chain >> 1) & 15, d = chain & 1, cb = 64 + b * 64; constexpr int NC = 64;
        LAS bf16* AL = (LAS bf16*)(F.lds + 20480) + cslot * 3 * 4096;
        f32x4 S[4];
        { const float* src = F.in[I_STATE] + ((((size_t)b * NL + l) * 2 + d) * NH + h) * 4096 + (size_t)(16 * vb + fr) * 64 + 4 * fq;
#pragma unroll
          for (int T = 0; T < 4; ++T) S[T] = *(const f32x4*)(src + 16 * T); }
        bf16x8 Aq[8][2]; u32x2 Nq[8][4];
#define LB_QI(step) ((((size_t)(cb + (d ? NC - 1 - (step) : (step)))) * 16 + h) * 2 + d)
#define LB_LDA(u, step) do { const int st_ = (step) < NC ? (step) : NC - 1; const bf16* ps_ = PST + LB_QI(st_) * 4096 + vb * 1024 + lane * 8; Aq[u][0] = *(const bf16x8*)ps_; Aq[u][1] = *(const bf16x8*)(ps_ + 512); } while (0)
#define LB_LDN(u, step) do { const int st_ = (step) < NC ? (step) : NC - 1; const bf16* nc_ = NCT + LB_QI(st_) * 4096 + ((vb * 4 * 64 + lane) << 2); \
        _Pragma("unroll") for (int mt_ = 0; mt_ < 4; ++mt_) Nq[u][mt_] = *(const u32x2*)(nc_ + mt_ * 256); } while (0)
#pragma unroll
        for (int u = 0; u < 8; ++u) { LB_LDA(u, u); LB_LDN(u, u); }
        *(LAS bf16x8*)(AL + ((vb * 2 + 0) * 64 + lane) * 8) = Aq[0][0]; *(LAS bf16x8*)(AL + ((vb * 2 + 1) * 64 + lane) * 8) = Aq[0][1];
        LB_LDA(0, 8);
        for (int g = 0; g < NC; g += 8) {
#pragma unroll
            for (int u = 0; u < 8; ++u) {
                const int step = g + u; const size_t q = LB_QI(step); bf16* scg = SC + q * 4096;
#pragma unroll
                for (int T = 0; T < 4; ++T) { const u32x2 w = pk4(S[T]); *(LAS u32x2*)(Sl + fr * LD16 + 16 * T + 4 * fq) = w; *(u32x2*)(scg + fm_off(16 * vb, 16 * T, fr, fq)) = w; }
                { LAS bf16* nb_ = AL + ((step + 1) % 3) * 4096; const int u1 = (u + 1) & 7;
                  *(LAS bf16x8*)(nb_ + ((vb * 2 + 0) * 64 + lane) * 8) = Aq[u1][0]; *(LAS bf16x8*)(nb_ + ((vb * 2 + 1) * 64 + lane) * 8) = Aq[u1][1];
                  LB_LDA(u1, step + 9); }
                LBAR();
                const LAS bf16* cbuf = AL + (step % 3) * 4096 + lane * 8;
                const bf16x8 b0 = *(const LAS bf16x8*)(Sl + fr * LD16 + 8 * fq), b1 = *(const LAS bf16x8*)(Sl + fr * LD16 + 8 * fq + 32);
#pragma unroll
                for (int mt = 0; mt < 4; ++mt) { const u32x2 nw = Nq[u][mt];
                    f32x4 acc = (f32x4){__uint_as_float(nw.x << 16), __uint_as_float(nw.x & 0xffff0000u), __uint_as_float(nw.y << 16), __uint_as_float(nw.y & 0xffff0000u)};
                    acc = __builtin_amdgcn_mfma_f32_16x16x32_bf16(*(const LAS bf16x8*)(cbuf + (mt * 2) * 512), b0, acc, 0, 0, 0);
                    acc = __builtin_amdgcn_mfma_f32_16x16x32_bf16(*(const LAS bf16x8*)(cbuf + (mt * 2 + 1) * 512), b1, acc, 0, 0, 0);
                    S[mt] = acc; }
                LB_LDN(u, step + 8);
            }
        }
#undef LB_LDA
#undef LB_LDN
#undef LB_QI
        LBAR();
    }
    const int w0 = (G > 64) ? (bx - 64) * NWAVES + wave : bx * NWAVES + wave, wst = (G > 64) ? (G - 64) * NWAVES : G * NWAVES;
    if (G > 64 && bx < 64) return;
    for (int t = w0; t < 2048; t += wst) {
        const int chain = t >> 2, vb = t & 3, b = chain >> 5, h = (chain >> 1) & 15, d = chain & 1, cb = b * 4; constexpr int NC = 4;
        f32x4 S[4];
#pragma unroll
        for (int T = 0; T < 4; ++T) S[T] = (f32x4){0.f, 0.f, 0.f, 0.f};
        bf16x8 Apf[4][8]; u32x2 Npf[4][4];
#define CB_QI(step) ((((size_t)(cb + (d ? NC - 1 - (step) : (step)))) * 16 + h) * 2 + d)
#define CB_LOAD(u, step) do { const size_t q_ = CB_QI(step); const bf16* ps_ = PST + q_ * 4096 + lane * 8; const bf16* nc_ = NCT + q_ * 4096 + ((vb * 4 * 64 + lane) << 2); \
        _Pragma("unroll") for (int mt_ = 0; mt_ < 4; ++mt_) { Apf[u][2 * mt_] = *(const bf16x8*)(ps_ + mt_ * 1024); Apf[u][2 * mt_ + 1] = *(const bf16x8*)(ps_ + mt_ * 1024 + 512); Npf[u][mt_] = *(const u32x2*)(nc_ + mt_ * 256); } } while (0)
        CB_LOAD(0, 0); CB_LOAD(1, 1); CB_LOAD(2, 2); CB_LOAD(3, 3);
#pragma unroll
        for (int u = 0; u < 4; ++u) {
            const int step = u; const size_t q = CB_QI(step); bf16* scg = SC + q * 4096;
            asm volatile("" ::: "memory");
#pragma unroll
            for (int T = 0; T < 4; ++T) { const u32x2 w = pk4(S[T]); *(LAS u32x2*)(Sl + fr * LD16 + 16 * T + 4 * fq) = w; *(u32x2*)(scg + fm_off(16 * vb, 16 * T, fr, fq)) = w; }
            asm volatile("s_waitcnt lgkmcnt(0)" ::: "memory");
            const bf16x8 b0 = *(const LAS bf16x8*)(Sl + fr * LD16 + 8 * fq), b1 = *(const LAS bf16x8*)(Sl + fr * LD16 + 8 * fq + 32);
#pragma unroll
            for (int mt = 0; mt < 4; ++mt) { const u32x2 nw = Npf[u][mt];
                f32x4 acc = (f32x4){__uint_as_float(nw.x << 16), __uint_as_float(nw.x & 0xffff0000u), __uint_as_float(nw.y << 16), __uint_as_float(nw.y & 0xffff0000u)};
                acc = __builtin_amdgcn_mfma_f32_16x16x32_bf16(Apf[u][2 * mt], b0, acc, 0, 0, 0);
                acc = __builtin_amdgcn_mfma_f32_16x16x32_bf16(Apf[u][2 * mt + 1], b1, acc, 0, 0, 0);
                S[mt] = acc; }
            asm volatile("s_waitcnt lgkmcnt(0)" ::: "memory");
        }
#undef CB_LOAD
#undef CB_QI
        { float* dst = F.out + (size_t)M * D + ((((size_t)b * NL + l) * 2 + d) * NH + h) * 4096 + (size_t)(16 * vb + fr) * 64 + 4 * fq;
#pragma unroll
          for (int T = 0; T < 4; ++T) *(f32x4*)(dst + 16 * T) = S[T]; }
    }
}

__device__ __forceinline__ void p_chunkC(Frame& F, int l) {
    PH_LOCALS(F); PH_LAYER(l);
    LAS unsigned char* lds = F.lds;
    const int fr = lane & 15, fq = lane >> 4, d = wave >> 2, nb = wave & 3;
    const bf16* PS = (const bf16*)(F.ws + WS_PS); const bf16* GATE = (const bf16*)(F.ws + WS_GATE); const float* BONUS = (const float*)(F.ws + WS_BONUS);
    bf16* O = (bf16*)(F.ws + WS_O);
    constexpr int NIT = (M / 64) * NH;
    f32x4 gnw[4], gnb[4]; int hcur = -1;
    bf16x8 fa0[4][2], fb0[4]; u32x4 pv0, pg0; float pb00, pb01;
    LAS bf16* VT0 = (LAS bf16*)(lds + 2 * 17408);
#define CC_ISSUE(item_, fa, fb, pv, pg, pb0, pb1) do { const int ci_ = (item_) >> 4, h_ = (item_) & 15; const size_t qi_ = ((size_t)ci_ * 16 + h_) * 2 + d; \
        const bf16* sc_ = (const bf16*)(F.ws + WS_SC) + qi_ * 4096 + lane * 8; \
        const bf16* py_ = (const bf16*)(F.ws + WS_PYT) + qi_ * 4096 + nb * 1024 + lane * 8; const bf16* qy_ = (const bf16*)(F.ws + WS_QYT) + qi_ * 4096 + nb * 1024 + lane * 8; \
        fb[0] = *(const bf16x8*)py_; fb[1] = *(const bf16x8*)(py_ + 512); fb[2] = *(const bf16x8*)qy_; fb[3] = *(const bf16x8*)(qy_ + 512); \
        _Pragma("unroll") for (int vt4_ = 0; vt4_ < 4; ++vt4_) { fa[vt4_][0] = *(const bf16x8*)(sc_ + vt4_ * 1024); fa[vt4_][1] = *(const bf16x8*)(sc_ + vt4_ * 1024 + 512); } \
        const int row_ = ci_ * 64 + (tid >> 3), chn_ = 64 * h_ + (tid & 7) * 8; \
        pv = *(const u32x4*)(PS + (size_t)row_ * CSH + 2 * DA + chn_); pg = *(const u32x4*)(GATE + (size_t)row_ * DA + chn_); pb0 = BONUS[(size_t)row_ * NH + h_]; pb1 = BONUS[((size_t)M + row_) * NH + h_]; } while (0)
#define CC_BODY(item_, fa, fb, pv, pg, pb0, pb1, next_) do { const int ci = (item_) >> 4, h = (item_) & 15, R0 = ci * 64; \
        if (h != hcur) { hcur = h; _Pragma("unroll") for (int vtile = 0; vtile < 4; ++vtile) { gnw[vtile] = *(const f32x4*)(F.in[I_GNW] + (size_t)l * DA + 64 * h + 16 * vtile + 4 * fq); gnb[vtile] = *(const f32x4*)(F.in[I_GNB] + (size_t)l * DA + 64 * h + 16 * vtile + 4 * fq); } } \
        const u32x4 cv = pv, cgt = pg; const float bon = pb0 + pb1; \
        { const int p_ = tid >> 3, c_ = (tid & 7) * 8; *(LAS u32x4*)(VT0 + p_ * LD16 + c_) = cv; *(LAS u32x4*)(VT0 + (64 + 63 - p_) * LD16 + c_) = cv; } \
        LBAR(); \
        f32x4 acc[4]; float s = 0.f; \
        _Pragma("unroll") for (int vtile = 0; vtile < 4; ++vtile) { f32x4 a = F4Z; \
            a = __builtin_amdgcn_mfma_f32_16x16x32_bf16(fa[vtile][0], fb[0], a, 0, 0, 0); a = __builtin_amdgcn_mfma_f32_16x16x32_bf16(fa[vtile][1], fb[1], a, 0, 0, 0); \
            a = __builtin_amdgcn_mfma_f32_16x16x32_bf16(frag_tr(VT0 + d * 64 * LD16, 0, 16 * vtile, fr, fq), fb[2], a, 0, 0, 0); a = __builtin_amdgcn_mfma_f32_16x16x32_bf16(frag_tr(VT0 + d * 64 * LD16, 32, 16 * vtile, fr, fq), fb[3], a, 0, 0, 0); \
            acc[vtile] = a; s += (a[0] + a[1]) + (a[2] + a[3]); } \
        if ((next_) < NIT) CC_ISSUE((next_), fa, fb, pv, pg, pb0, pb1); \
        s += SHX(s, 16); s += SHX(s, 32); \
        const float mean = s * (1.0f / 64.0f); float qv = 0.f; \
        _Pragma("unroll") for (int vtile = 0; vtile < 4; ++vtile) { acc[vtile] = acc[vtile] - mean; const f32x4 a = acc[vtile]; qv += (a[0] * a[0] + a[1] * a[1]) + (a[2] * a[2] + a[3] * a[3]); } \
        qv += SHX(qv, 16); qv += SHX(qv, 32); \
        const float rstd = __builtin_amdgcn_rsqf(qv * (1.0f / 64.0f) + GN_EPS); \
        const int tau = 16 * nb + fr, pos = d ? 63 - tau : tau; \
        LAS float* Yd = (LAS float*)(lds + d * 17408); \
        _Pragma("unroll") for (int vtile = 0; vtile < 4; ++vtile) { const int v0 = 16 * vtile + 4 * fq; \
            *(LAS f32x4*)(Yd + pos * LD32 + v0) = acc[vtile] * rstd * gnw[vtile] + gnb[vtile]; } \
        LBAR(); \
        { const int pos2 = tid >> 3, c8 = (tid & 7) * 8, row = R0 + pos2, chn = 64 * h + c8; \
          const LAS float* Y0 = (const LAS float*)lds; const LAS float* Y1 = (const LAS float*)(lds + 17408); \
          float v[8], gt[8], o[8]; unpack8(cv, v); unpack8(cgt, gt); \
          const f32x4 y00 = *(const LAS f32x4*)(Y0 + pos2 * LD32 + c8), y01 = *(const LAS f32x4*)(Y0 + pos2 * LD32 + c8 + 4), y10 = *(const LAS f32x4*)(Y1 + pos2 * LD32 + c8), y11 = *(const LAS f32x4*)(Y1 + pos2 * LD32 + c8 + 4); \
          _Pragma("unroll") for (int j = 0; j < 4; ++j) { o[j] = (y00[j] + y10[j] + bon * v[j]) * gt[j]; o[4 + j] = (y01[j] + y11[j] + bon * v[4 + j]) * gt[4 + j]; } \
          *(u32x4*)(O + (size_t)row * D + chn) = pack8(o); } \
        LBAR(); } while (0)
    if (bx < NIT) CC_ISSUE(bx, fa0, fb0, pv0, pg0, pb00, pb01);
    for (int item = bx; item < NIT; item += G) {
        CC_BODY(item, fa0, fb0, pv0, pg0, pb00, pb01, item + G);
    }
#undef CC_BODY
#undef CC_ISSUE
}

__device__ __forceinline__ void p_final(Frame& F) {
    PH_LOCALS(F);
    const int gw = bx * NWAVES + wave, NGW = G * NWAVES;
    const float* fg = F.in[I_FNG]; const bf16* X = (const bf16*)(F.ws + WS_X);
    f32x4 fgv[8];
#pragma unroll
    for (int j = 0; j < 8; ++j) fgv[j] = *(const f32x4*)(fg + 8 * lane + 512 * (j >> 1) + 4 * (j & 1));
    for (int row = gw; row < M; row += NGW) {
        const bf16* xr = X + (size_t)row * D; float* orow = F.out + (size_t)row * D;
        float v[4][8]; float ss = 0.f;
#pragma unroll
        for (int j = 0; j < 4; ++j) { unpack8(*(const u32x4*)(xr + 8 * lane + 512 * j), v[j]);
#pragma unroll
            for (int e = 0; e < 8; ++e) ss += v[j][e] * v[j][e]; }
        WAVE_SUM(ss); const float rstd = __builtin_amdgcn_rsqf(ss * (1.0f / D) + RMS_EPS);
#pragma unroll
        for (int j = 0; j < 4; ++j) { const int c = 8 * lane + 512 * j;
            *(f32x4*)(orow + c) = (f32x4){v[j][0], v[j][1], v[j][2], v[j][3]} * rstd * fgv[2 * j];
            *(f32x4*)(orow + c + 4) = (f32x4){v[j][4], v[j][5], v[j][6], v[j][7]} * rstd * fgv[2 * j + 1]; }
    }
}

constexpr int PH_PER_LAYER = 10, N_PHASES = 2 + NL * PH_PER_LAYER;
__global__ void __launch_bounds__(NWAVES * 64, 2) hymba_fwd(Args args) {
    extern __shared__ __attribute__((aligned(16))) unsigned char lds[];
    Frame F;
    F.lds = (LAS unsigned char*)lds;
    F.tid = threadIdx.x; F.lane = F.tid & 63; F.wave = __builtin_amdgcn_readfirstlane(F.tid >> 6);
    F.G = gridDim.x; F.bx = blockIdx.x;
    F.in = args.in; F.out = args.out; F.ws = args.ws;
    for (int u = F.tid; u < (LDS_BYTES - LDSCTL_OFF) / 4; u += NWAVES * 64) ((LAS unsigned*)(F.lds + LDSCTL_OFF))[u] = 0u;
    __syncthreads();
    volatile LAS unsigned* MISC = (volatile LAS unsigned*)(F.lds + MISC_OFF);
    unsigned* barw = (unsigned*)(F.ws + WS_CTL) + CW_BAR;
    XcdBarrier bar; bar.bar = barw; bar.x = 0; bar.st = nullptr;
    if (MK_N_LAUNCHES == 1) bar = xcd_barrier_post(barw, MISC + 8);
    const int lo = args.ph_lo, hi = args.ph_hi;
#define IN(k) (lo <= (k) && (k) < hi)
#define SEAM(k) do { if (MK_N_LAUNCHES == 1 && IN(k) && IN((k) + 1)) xcd_barrier(bar); } while (0)

    for (int rep = 0; rep < ((PROBE_DUP == 30) ? 2 : 1); ++rep)
    if (IN(0)) { p0_prologue(F); __syncthreads(); } SEAM(0);
    bf16* H = (bf16*)(F.ws + WS_H); bf16* O = (bf16*)(F.ws + WS_O); bf16* P = (bf16*)(F.ws + WS_P); bf16* HID = (bf16*)(F.ws + WS_HID);
    const float* mod = (const float*)(F.ws + WS_MOD);
    for (int l = 0; l < NL; ++l) {
        const int pb = 1 + l * PH_PER_LAYER;
        const float* xlo = F.in[I_XP]; const float* xhi = F.in[I_XS]; bf16* XS = (bf16*)(F.ws + WS_X);
        float* dummy = (float*)(F.ws + WS_P);
        for (int rep = 0; rep < ((PROBE_DUP == 7) ? 2 : 1); ++rep)
        if (IN(pb + 0)) { p_adaln(F, l, 0, xlo, xhi, l == 0 ? nullptr : XS); } SEAM(pb + 0);
        for (int rep = 0; rep < ((PROBE_DUP == 1 || PROBE_DUP == 20) ? 2 : 1); ++rep)
        if (IN(pb + 1)) { pg8::Gemm g{H, (const bf16*)(F.ws + WS_WIN + l * SZ_WIN), M, PINP, D}; pg8::StaticOrder S; { int cb_ = F.bx, cg_ = F.G; asm volatile("" : "+s"(cb_), "+s"(cg_)); S.init(M, PINP, cg_, cb_, D); }
            EpiP E{P, PINP, CSH}; pg8::gemm_phase<EpiP, pg8::StaticOrder, true, true>(F.lds, g, S, E, F.wave); } SEAM(pb + 1);
        for (int rep = 0; rep < ((PROBE_DUP == 2) ? 2 : 1); ++rep)
        if (IN(pb + 2)) { p_shift(F, l); } SEAM(pb + 2);
        if (IN(pb + 3)) { for (int rep = 0; rep < ((PROBE_DUP == 3) ? 2 : 1); ++rep) { if (F.G % 16 == 0) p_chunkA(F, l, true); else p_chunkA(F, l, false); } } SEAM(pb + 3);
        for (int rep = 0; rep < ((PROBE_DUP == 4) ? 2 : 1); ++rep)
        if (IN(pb + 4)) { p_chunkB(F, l);
            for (int rep = 0; rep < ((PROBE_DUP == 13) ? 2 : 1); ++rep) p_gmlp(F, l, F.G > 64 ? (F.bx >= 64 ? F.bx - 64 : -1) : F.bx, F.G > 64 ? F.G - 64 : F.G); } SEAM(pb + 4);
        for (int rep = 0; rep < ((PROBE_DUP == 5) ? 2 : 1); ++rep)
        if (IN(pb + 5)) { p_chunkC(F, l); } SEAM(pb + 5);
        if ((PROBE_DUP == 6 || PROBE_DUP == 20) && IN(pb + 6)) { pg8::Gemm g{O, (const bf16*)(F.ws + WS_WOUT + l * SZ_WOUT), M, D, D}; pg8::StaticOrder S; { int cb_ = F.bx, cg_ = F.G; asm volatile("" : "+s"(cb_), "+s"(cg_)); S.init(M, D, cg_, cb_, D); }
            EpiRes E{xlo, xhi, l == 0 ? nullptr : XS, (bf16*)dummy, mod + (size_t)l * 5 * MODW, 2 * D}; pg8::gemm_phase<EpiRes, pg8::StaticOrder, true, true>(F.lds, g, S, E, F.wave); }
        if (IN(pb + 6)) { pg8::Gemm g{O, (const bf16*)(F.ws + WS_WOUT + l * SZ_WOUT), M, D, D}; pg8::FullRoundsOrder S; pg8::TailHalfOrder S2; { int cb_ = F.bx, cg_ = F.G; asm volatile("" : "+s"(cb_), "+s"(cg_)); S.init(M, D, cg_, cb_, D); S2.init(M, D, cg_, cb_, D); }
            EpiRes E{xlo, xhi, l == 0 ? nullptr : XS, XS, mod + (size_t)l * 5 * MODW, 2 * D}; pg8::gemm_phase<EpiRes, pg8::FullRoundsOrder, true, true>(F.lds, g, S, E, F.wave);
            pg8::gemm_phase<EpiRes, pg8::TailHalfOrder, true, true, true>(F.lds, g, S2, E, F.wave); } SEAM(pb + 6);
        for (int rep = 0; rep < ((PROBE_DUP == 7) ? 2 : 1); ++rep)
        if (IN(pb + 7)) { p_adaln(F, l, 1, xlo, xhi, XS); } SEAM(pb + 7);
        for (int rep = 0; rep < ((PROBE_DUP == 8 || PROBE_DUP == 20) ? 2 : 1); ++rep)
        if (IN(pb + 8)) { pg8::Gemm g{H, (const bf16*)(F.ws + WS_WGU + l * SZ_WGU), M, NGU, D}; pg8::StaticOrder S; { int cb_ = F.bx, cg_ = F.G; asm volatile("" : "+s"(cb_), "+s"(cg_)); S.init(M, NGU, cg_, cb_, D); }
            EpiSwi E{HID, DFF}; pg8::gemm_phase<EpiSwi, pg8::StaticOrder, true, true>(F.lds, g, S, E, F.wave); } SEAM(pb + 8);
        if ((PROBE_DUP == 9 || PROBE_DUP == 20) && IN(pb + 9)) { pg8::Gemm g{HID, (const bf16*)(F.ws + WS_WD + l * SZ_WD), M, D, DFF}; pg8::StaticOrder S; { int cb_ = F.bx, cg_ = F.G; asm volatile("" : "+s"(cb_), "+s"(cg_)); S.init(M, D, cg_, cb_, DFF); }
            EpiRes E{xlo, xhi, XS, (bf16*)dummy, mod + (size_t)l * 5 * MODW, 5 * D}; pg8::gemm_phase<EpiRes, pg8::StaticOrder, true, true>(F.lds, g, S, E, F.wave); }
        if (IN(pb + 9)) { pg8::Gemm g{HID, (const bf16*)(F.ws + WS_WD + l * SZ_WD), M, D, DFF}; pg8::FullRoundsOrder S; pg8::TailHalfOrder S2; { int cb_ = F.bx, cg_ = F.G; asm volatile("" : "+s"(cb_), "+s"(cg_)); S.init(M, D, cg_, cb_, DFF); S2.init(M, D, cg_, cb_, DFF); }
            EpiRes E{xlo, xhi, XS, XS, mod + (size_t)l * 5 * MODW, 5 * D}; pg8::gemm_phase<EpiRes, pg8::FullRoundsOrder, true, true>(F.lds, g, S, E, F.wave);
            pg8::gemm_phase<EpiRes, pg8::TailHalfOrder, true, true, true>(F.lds, g, S2, E, F.wave); } SEAM(pb + 9);
    }
    if (IN(N_PHASES - 1)) { p_final(F); }
#undef IN
#undef SEAM
}

extern "C" void kernel_launch(void* const* d_in, const int* in_sizes, int n_in, void* d_out, int out_size, void* d_ws, size_t ws_size, hipStream_t stream) {
    static int grid = 0;
    if (grid == 0) {
        if (n_in != 30 || ws_size < WS_END) { fprintf(stderr, "kernel_launch: need 30 inputs and >= %zu bytes of workspace; got n_in %d, ws %zu\n", (size_t)WS_END, n_in, ws_size); grid = -1; return; }
        int dev = 0, cus = 0, per_cu = 0;
        if (hipGetDevice(&dev) != hipSuccess || hipDeviceGetAttribute(&cus, hipDeviceAttributeMultiprocessorCount, dev) != hipSuccess) { grid = -1; return; }
        if (hipFuncSetAttribute((const void*)hymba_fwd, hipFuncAttributeMaxDynamicSharedMemorySize, LDS_BYTES) != hipSuccess) { fprintf(stderr, "kernel_launch: hipFuncSetAttribute failed\n"); grid = -1; return; }
        if (hipOccupancyMaxActiveBlocksPerMultiprocessor(&per_cu, (const void*)hymba_fwd, NWAVES * 64, LDS_BYTES) != hipSuccess || per_cu < 1)
            fprintf(stderr, "kernel_launch: note: occupancy query reports %d workgroups per CU\n", per_cu);
        (void)hipGetLastError();
        grid = cus;
    }
    if (grid < 0) return;
    if (hipMemsetAsync((char*)d_ws + WS_CTL, 0, CTL_ZERO_BYTES, stream) != hipSuccess) return;
    Args a{};
    for (int i = 0; i < 30; ++i) a.in[i] = (const float*)d_in[i];
    a.out = (float*)d_out; a.ws = (unsigned char*)d_ws; a.pad = 0;
    if (MK_N_LAUNCHES == 1) {
        a.ph_lo = 0; a.ph_hi = N_PHASES; a.li = 0;
        hipLaunchKernelGGL(hymba_fwd, dim3(grid), dim3(NWAVES * 64), LDS_BYTES, stream, a);
    } else {
        for (int k = 0; k < N_PHASES; ++k) { a.ph_lo = k; a.ph_hi = k + 1; a.li = k;
            hipLaunchKernelGGL(hymba_fwd, dim3(grid), dim3(NWAVES * 64), LDS_BYTES, stream, a); }
    }
}
```
